# Optimizing an MI355X kernel written in HIP

```python
import jax
import jax.numpy as jnp
from jax import lax
import numpy as np

D_MODEL = 1024
BATCH = 8
SEQ = 2048
DEPTH = 4

N_A_LAYERS = DEPTH // 2
N_B_LAYERS = DEPTH - N_A_LAYERS
EPS = 1e-6
D_RNN = D_MODEL
RG_HEADS = 4
RG_BLOCK = D_RNN // RG_HEADS
CONV_W = 4
RG_C = 8.0
HEAD_DIM = 128
N_HEADS = D_MODEL // HEAD_DIM
D_ATT = N_HEADS * HEAD_DIM
MOBA_BLOCK = 256
MOBA_TOPK = 3
Q_CHUNK = 16
NEG_INF = -1e30

kernel_name = 'hawk_moba_yoco_hybrid'


def _rmsnorm(x, g):
    xf = x.astype(jnp.float32)
    y = xf * lax.rsqrt(jnp.mean(xf * xf, axis=-1, keepdims=True) + EPS)
    return (y * g.astype(jnp.float32)).astype(x.dtype)


def _modulate(h, shift, scale):
    return h * (1.0 + scale[:, None, :]) + shift[:, None, :]


def _lin_combine(left, right):
    a_l, b_l = left
    a_r, b_r = right
    return a_l * a_r, a_r * b_l + b_r


def _block_diag(u, w):
    b, s, _ = u.shape
    ub = u.reshape(b, s, RG_HEADS, RG_BLOCK)
    return jnp.einsum('bshi,hij->bshj', ub, w).reshape(b, s, D_RNN)


def _rglru_mixer(h, w_in, conv_w, conv_b, w_a, b_a, w_x, b_x, lam, w_out):
    u, g = jnp.split(h @ w_in, 2, axis=-1)
    u = lax.conv_general_dilated(
        u, conv_w[:, None, :], window_strides=(1,), padding=[(CONV_W - 1, 0)],
        dimension_numbers=('NWC', 'WIO', 'NWC'), feature_group_count=D_RNN) + conv_b
    r = jax.nn.sigmoid((_block_diag(u, w_a) + b_a).astype(jnp.float32))
    gi = jax.nn.sigmoid((_block_diag(u, w_x) + b_x).astype(jnp.float32))
    log_a = -RG_C * r * jax.nn.softplus(-lam.astype(jnp.float32))
    a = jnp.exp(log_a)
    b_in = jnp.sqrt(-jnp.expm1(2.0 * log_a)) * (gi * u.astype(jnp.float32))
    _, hs = lax.associative_scan(_lin_combine, (a, b_in), axis=1)
    y = hs.astype(h.dtype) * jax.nn.silu(g)
    return y @ w_out


def _shared_kv(x, cs, kv_norm_g, kv_mod_w, kv_mod_b, w_kv):
    b, s, _ = x.shape
    shift, scale = jnp.split(cs @ kv_mod_w + kv_mod_b, 2, axis=-1)
    h = _modulate(_rmsnorm(x, kv_norm_g), shift, scale)
    k, v = jnp.split(h @ w_kv, 2, axis=-1)
    k = k.reshape(b, s, N_HEADS, HEAD_DIM).transpose(0, 2, 1, 3)
    v = v.reshape(b, s, N_HEADS, HEAD_DIM).transpose(0, 2, 1, 3)
    s_pad = -(-s // MOBA_BLOCK) * MOBA_BLOCK
    pad = ((0, 0), (0, 0), (0, s_pad - s), (0, 0))
    k = jnp.pad(k, pad)
    v = jnp.pad(v, pad)
    n_blk = s_pad // MOBA_BLOCK
    k_mean = k.astype(jnp.float32).reshape(b, N_HEADS, n_blk, MOBA_BLOCK, HEAD_DIM).mean(axis=3)
    return k, v, k_mean.astype(k.dtype)


def _moba_attention(q, k, v, k_mean):
    b, nh, s, dh = q.shape
    n = b * nh
    s_pad = k.shape[2]
    n_blk = s_pad // MOBA_BLOCK
    k_sel = min(MOBA_TOPK, n_blk)
    qf = q.reshape(n, s, dh)
    kf = k.reshape(n, s_pad, dh)
    vf = v.reshape(n, s_pad, dh)
    kb = k.reshape(n * n_blk, MOBA_BLOCK, dh)
    vb = v.reshape(n * n_blk, MOBA_BLOCK, dh)
    km = k_mean.reshape(n, n_blk, dh)
    base = (jnp.arange(n, dtype=jnp.int32) * n_blk)[:, None, None]
    blk_ids = jnp.arange(n_blk, dtype=jnp.int32)
    sm_scale = dh ** -0.5

    def one_chunk(ci):
        q0 = ci * Q_CHUNK
        blk = q0 // MOBA_BLOCK
        qc = lax.dynamic_slice_in_dim(qf, q0, Q_CHUNK, axis=1)
        gate = jnp.einsum('nqd,nbd->nqb', qc, km).astype(jnp.float32)
        gate = jnp.where(blk_ids < blk, gate, NEG_INF)
        _, idx = lax.top_k(gate, k_sel)
        valid = idx < blk
        kg = kb[base + idx]
        vg = vb[base + idx]
        s_sel = jnp.einsum('nqd,nqkld->nqkl', qc, kg).astype(jnp.float32) * sm_scale
        s_sel = jnp.where(valid[..., None], s_sel, NEG_INF).reshape(n, Q_CHUNK, k_sel * MOBA_BLOCK)
        k_own = lax.dynamic_slice_in_dim(kf, blk * MOBA_BLOCK, MOBA_BLOCK, axis=1)
        v_own = lax.dynamic_slice_in_dim(vf, blk * MOBA_BLOCK, MOBA_BLOCK, axis=1)
        s_own = jnp.einsum('nqd,nld->nql', qc, k_own).astype(jnp.float32) * sm_scale
        q_pos = q0 + jnp.arange(Q_CHUNK, dtype=jnp.int32)
        k_pos = blk * MOBA_BLOCK + jnp.arange(MOBA_BLOCK, dtype=jnp.int32)
        s_own = jnp.where(k_pos[None, None, :] <= q_pos[None, :, None], s_own, NEG_INF)
        p = jax.nn.softmax(jnp.concatenate([s_sel, s_own], axis=-1), axis=-1).astype(v.dtype)
        p_sel = p[..., :k_sel * MOBA_BLOCK].reshape(n, Q_CHUNK, k_sel, MOBA_BLOCK)
        p_own = p[..., k_sel * MOBA_BLOCK:]
        return (jnp.einsum('nqkl,nqkld->nqd', p_sel, vg)
                + jnp.einsum('nql,nld->nqd', p_own, v_own))

    out = lax.map(one_chunk, jnp.arange(s // Q_CHUNK, dtype=jnp.int32))
    return out.transpose(1, 0, 2, 3).reshape(b, nh, s, dh)


def _moba_mixer(h, k, v, k_mean, w_in, w_out):
    b, s, _ = h.shape
    q, g = jnp.split(h @ w_in, 2, axis=-1)
    q = q.reshape(b, s, N_HEADS, HEAD_DIM).transpose(0, 2, 1, 3)
    o = _moba_attention(q, k, v, k_mean).transpose(0, 2, 1, 3).reshape(b, s, D_ATT)
    return (o * jax.nn.silu(g)) @ w_out


def setup_inputs(seed: int = 0) -> dict:
    key = jax.random.key(seed)
    ks = jax.random.split(key, 24)
    f32 = jnp.float32

    def nrm(k, shape, scale):
        return scale * jax.random.normal(k, shape, f32)

    a0 = jax.random.uniform(ks[12], (N_A_LAYERS, D_RNN), f32, 0.9, 0.999)
    s0 = a0 ** (1.0 / RG_C)
    return {
        'x': nrm(ks[0], (BATCH, SEQ, D_MODEL), 1.0),
        'c': nrm(ks[1], (BATCH, D_MODEL), 1.0),
        'mod_w': nrm(ks[2], (DEPTH, D_MODEL, 3 * D_MODEL), 0.5 * D_MODEL ** -0.5),
        'mod_b': nrm(ks[3], (DEPTH, 3 * D_MODEL), 0.02),
        'norm_g': 1.0 + nrm(ks[4], (DEPTH, D_MODEL), 0.02),
        'rg_w_in': nrm(ks[5], (N_A_LAYERS, D_MODEL, 2 * D_RNN), D_MODEL ** -0.5),
        'rg_conv_w': nrm(ks[6], (N_A_LAYERS, CONV_W, D_RNN), CONV_W ** -0.5),
        'rg_conv_b': nrm(ks[7], (N_A_LAYERS, D_RNN), 0.01),
        'rg_w_a': nrm(ks[8], (N_A_LAYERS, RG_HEADS, RG_BLOCK, RG_BLOCK), RG_BLOCK ** -0.5),
        'rg_b_a': nrm(ks[9], (N_A_LAYERS, D_RNN), 0.01),
        'rg_w_x': nrm(ks[10], (N_A_LAYERS, RG_HEADS, RG_BLOCK, RG_BLOCK), RG_BLOCK ** -0.5),
        'rg_b_x': nrm(ks[11], (N_A_LAYERS, D_RNN), 0.01),
        'rg_lambda': jnp.log(s0) - jnp.log1p(-s0),
        'rg_w_out': nrm(ks[13], (N_A_LAYERS, D_RNN, D_MODEL), D_RNN ** -0.5),
        'kv_norm_g': 1.0 + nrm(ks[14], (D_MODEL,), 0.02),
        'kv_mod_w': nrm(ks[15], (D_MODEL, 2 * D_MODEL), 0.5 * D_MODEL ** -0.5),
        'kv_mod_b': nrm(ks[16], (2 * D_MODEL,), 0.02),
        'w_kv': nrm(ks[17], (D_MODEL, 2 * D_ATT), D_MODEL ** -0.5),
        'att_w_in': nrm(ks[18], (N_B_LAYERS, D_MODEL, 2 * D_ATT), D_MODEL ** -0.5),
        'att_w_out': nrm(ks[19], (N_B_LAYERS, D_ATT, D_MODEL), D_ATT ** -0.5),
        'final_norm_g': 1.0 + nrm(ks[20], (D_MODEL,), 0.02),
    }


def reference(x, c, mod_w, mod_b, norm_g, rg_w_in, rg_conv_w, rg_conv_b, rg_w_a, rg_b_a,
              rg_w_x, rg_b_x, rg_lambda, rg_w_out, kv_norm_g, kv_mod_w, kv_mod_b, w_kv,
              att_w_in, att_w_out, final_norm_g):
    cs = jax.nn.silu(c)
    k_sh = v_sh = km_sh = None
    for layer in range(DEPTH):
        shift, scale, gate = jnp.split(cs @ mod_w[layer] + mod_b[layer], 3, axis=-1)
        h = _modulate(_rmsnorm(x, norm_g[layer]), shift, scale)
        if layer < N_A_LAYERS:
            i = layer
            y = _rglru_mixer(h, rg_w_in[i], rg_conv_w[i], rg_conv_b[i], rg_w_a[i], rg_b_a[i],
                             rg_w_x[i], rg_b_x[i], rg_lambda[i], rg_w_out[i])
        else:
            if layer == N_A_LAYERS:
                k_sh, v_sh, km_sh = _shared_kv(x, cs, kv_norm_g, kv_mod_w, kv_mod_b, w_kv)
            i = layer - N_A_LAYERS
            y = _moba_mixer(h, k_sh, v_sh, km_sh, att_w_in[i], att_w_out[i])
        x = x + gate[:, None, :] * y
    return _rmsnorm(x, final_norm_g)
```

```cpp
#include <hip/hip_runtime.h>
#include <hip/hip_cooperative_groups.h>
#include <cstdio>
#include <cstdint>
namespace cg = cooperative_groups;

#ifndef MK_MULTI_LAUNCH
#define MK_MULTI_LAUNCH 1
#endif

constexpr int DM = 1024, NB = 8, SEQ = 2048, MTOK = NB * SEQ, NH = 8, DH = 128;
constexpr int MODV_LD = 14336;
constexpr float EPS = 1e-6f;
constexpr int NWAVES = 8, NTHR = 512;
constexpr int LDS_BYTES = 147456;

constexpr size_t MiB = 1u << 20;
constexpr size_t WS_CTL = 0, CTL_ZERO_BYTES = 1 * MiB;
constexpr size_t WS_MODV = 64 * 1024;
constexpr size_t WS_KMEAN = 512 * 1024;
constexpr size_t WS_AGGA = 1 * MiB, WS_AGGB = 2 * MiB;
constexpr size_t WS_WIN = 3 * MiB;
constexpr size_t WS_WG = 11 * MiB;
constexpr size_t WS_WOUT = 13 * MiB;
constexpr size_t WS_ATTIN0 = 17 * MiB, WS_WKV = 21 * MiB, WS_ATTIN1 = 25 * MiB;
constexpr size_t WS_ATTOUT = 29 * MiB;
constexpr size_t WS_HN = 33 * MiB;
constexpr size_t WS_HKV = 65 * MiB;
constexpr size_t WS_UPRE = 97 * MiB;
constexpr size_t WS_G = 129 * MiB;
constexpr size_t WS_LA = 161 * MiB;
constexpr size_t WS_BIN = 193 * MiB;
constexpr size_t WS_END = 225 * MiB;

typedef unsigned short bf16_t;
typedef short bf16x8 __attribute__((ext_vector_type(8)));
typedef short s16x4 __attribute__((ext_vector_type(4)));
typedef float f32x4 __attribute__((ext_vector_type(4)));
typedef float f32x2 __attribute__((ext_vector_type(2)));
typedef float f32x16 __attribute__((ext_vector_type(16)));
typedef unsigned u32x4 __attribute__((ext_vector_type(4)));
typedef unsigned u32x2 __attribute__((ext_vector_type(2)));
#define LAS __attribute__((address_space(3)))

__device__ __forceinline__ unsigned cvt_pk_bf16(float lo, float hi) { unsigned r; asm volatile("v_cvt_pk_bf16_f32 %0, %1, %2" : "=v"(r) : "v"(lo), "v"(hi)); return r; }
__device__ __forceinline__ float bf_lo(unsigned w) { return __uint_as_float(w << 16); }
__device__ __forceinline__ float bf_hi(unsigned w) { return __uint_as_float(w & 0xffff0000u); }
__device__ __forceinline__ float bf1(bf16_t h) { return __uint_as_float((unsigned)h << 16); }
__device__ __forceinline__ float fsigmoid(float x) { return __builtin_amdgcn_rcpf(1.f + __expf(-x)); }
__device__ __forceinline__ float fsilu(float x) { return x * fsigmoid(x); }
__device__ __forceinline__ int opq_tid(int wv) { int l; asm volatile("v_mbcnt_lo_u32_b32 %0, -1, 0\n\tv_mbcnt_hi_u32_b32 %0, -1, %0" : "=v"(l)); return wv * 64 + l; }
__device__ __forceinline__ int opq_bid() { int b = blockIdx.x; asm volatile("" : "+s"(b)); return b; }
__device__ __forceinline__ float wave_sum(float v) {
#pragma unroll
    for (int o = 1; o < 64; o <<= 1) v += __shfl_xor(v, o);
    return v;
}

namespace pg8 {
constexpr int BM = 256, BK = 64, HALF = 128, HTB = HALF * BK * 2, STAGE_BYTES = 8 * HTB, NXCD = 8, WGM = 8;
__host__ __device__ __forceinline__ int lds_byte(int r, int c) { const int st = (r >> 4) * 2 + (c >> 5), rr = r & 15, cc = c & 31, ob = rr * 64 + cc * 2; return st * 1024 + (ob ^ (((ob >> 9) & 1) << 5)); }
__host__ __device__ __forceinline__ void stage_rc(int b, int& R, int& C) { const int st = b / 1024, sb = b % 1024, swz = sb ^ (((sb >> 9) & 1) << 5); R = (st >> 1) * 16 + swz / 64; C = (st & 1) * 32 + (swz % 64) / 2; }
__host__ __device__ __forceinline__ int perm32(int rho) { const int n = rho >> 4, i = rho & 15; return 8 * (i >> 2) + 4 * n + (i & 3); }

struct Unit { int pm, pn, sub; };
struct Gemm { const bf16_t* A; const bf16_t* Bt; int lda, ldb, K; long a_sub, b_sub; };

struct MultiOrder {
    int nM, nN, nwg, nsub, G, c;
    __device__ void init(int M, int N, int nsub_, int G_, int c_) { nM = M / BM; nN = N / BM; nwg = nM * nN; nsub = nsub_; G = G_; c = c_; }
    __device__ bool next(int i, Unit& u) const {
        const long L = (long)i * G + c; if (L >= (long)nwg * nsub) return false;
        u.sub = (int)(L / nwg);
        int wgid = (int)(L % nwg); { const int q = nwg / NXCD, r = nwg % NXCD, xcd = wgid % NXCD, off = wgid / NXCD; wgid = (xcd < r ? xcd * (q + 1) : r * (q + 1) + (xcd - r) * q) + off; }
        const int nig = WGM * nN, gid = wgid / nig, fm = gid * WGM, gsz = (nM - fm) < WGM ? (nM - fm) : WGM;
        u.pm = fm + ((wgid % nig) % gsz); u.pn = (wgid % nig) / gsz; return true;
    }
};


struct EpiSplit {
    static constexpr bool PERM = true;
    bf16_t* O0; bf16_t* O1;
    __device__ __forceinline__ void operator()(const f32x4 (&acc)[2][2][4][2], const Unit& u, int wr, int wc, int fr, int fq) const {
        const int row0 = u.pm * BM + wr * 64 + fr; int colt = u.pn * BM; bf16_t* base = O0;
        if (colt >= DM) { base = O1; colt -= DM; }
        const int col0 = colt + wc * 32 + 8 * fq;
#pragma unroll
        for (int ai = 0; ai < 2; ++ai)
#pragma unroll
            for (int m = 0; m < 4; ++m) { bf16_t* rowp = base + (size_t)(row0 + ai * HALF + m * 16) * DM + col0;
#pragma unroll
                for (int bj = 0; bj < 2; ++bj) { const f32x4 v0 = acc[ai][bj][m][0], v1 = acc[ai][bj][m][1];
                    u32x4 w; w.x = cvt_pk_bf16(v0[0], v0[1]); w.y = cvt_pk_bf16(v0[2], v0[3]); w.z = cvt_pk_bf16(v1[0], v1[1]); w.w = cvt_pk_bf16(v1[2], v1[3]);
                    *(u32x4*)(rowp + bj * HALF) = w; } }
    }
};

struct EpiRes {
    static constexpr bool PERM = false;
    const float* xin; float* out; const float* gate;
    __device__ __forceinline__ void operator()(const f32x4 (&acc)[2][2][4][2], const Unit& u, int wr, int wc, int fr, int fq) const {
        const int b = u.pm >> 3, col0 = u.pn * BM + wc * 32 + 4 * fq;
        f32x4 gv[2][2];
#pragma unroll
        for (int bj = 0; bj < 2; ++bj)
#pragma unroll
            for (int n = 0; n < 2; ++n) gv[bj][n] = *(const f32x4*)(gate + (size_t)b * MODV_LD + col0 + bj * HALF + n * 16);
#pragma unroll
        for (int ai = 0; ai < 2; ++ai)
#pragma unroll
            for (int m = 0; m < 4; ++m) { const size_t off = (size_t)(u.pm * BM + ai * HALF + wr * 64 + m * 16 + fr) * DM + col0;
#pragma unroll
                for (int bj = 0; bj < 2; ++bj)
#pragma unroll
                    for (int n = 0; n < 2; ++n) { const f32x4 xv = *(const f32x4*)(xin + off + bj * HALF + n * 16);
                        *(f32x4*)(out + off + bj * HALF + n * 16) = xv + gv[bj][n] * acc[ai][bj][m][n]; } }
    }
};

struct EpiGates {
    static constexpr bool PERM = true;
    const bf16_t* U; bf16_t* LA; bf16_t* BIN; const float* ba; const float* bx; const float* lam;
    __device__ __forceinline__ void operator()(const f32x4 (&acc)[2][2][4][2], const Unit& u, int wr, int wc, int fr, int fq) const {
        const int ch0 = u.sub * 256 + u.pn * 128 + wc * 32 + 8 * fq;
        float pba[8], pbx[8], psp[8];
#pragma unroll
        for (int j = 0; j < 8; ++j) { pba[j] = ba[ch0 + j]; pbx[j] = bx[ch0 + j]; const float z = -lam[ch0 + j];
            psp[j] = 8.f * (z > 20.f ? z : __logf(1.f + __expf(z))); }
#pragma unroll
        for (int ai = 0; ai < 2; ++ai)
#pragma unroll
            for (int m = 0; m < 4; ++m) { const size_t off = (size_t)(u.pm * BM + ai * HALF + wr * 64 + m * 16 + fr) * DM + ch0;
                const u32x4 uw = *(const u32x4*)(U + off);
                const float uv[8] = {bf_lo(uw.x), bf_hi(uw.x), bf_lo(uw.y), bf_hi(uw.y), bf_lo(uw.z), bf_hi(uw.z), bf_lo(uw.w), bf_hi(uw.w)};
                float lav[8], bnv[8];
#pragma unroll
                for (int j = 0; j < 8; ++j) { const float r = fsigmoid(acc[ai][0][m][j >> 2][j & 3] + pba[j]), gi = fsigmoid(acc[ai][1][m][j >> 2][j & 3] + pbx[j]);
                    const float la = -psp[j] * r, z = 2.f * la;
                    const float om = (z > -0.03f) ? -z * (1.f + z * (0.5f + z * (0.16666667f + z * 0.041666667f))) : 1.f - __expf(z);
                    lav[j] = la; bnv[j] = __builtin_sqrtf(om) * gi * uv[j]; }
                u32x4 w0, w1;
                w0.x = cvt_pk_bf16(lav[0], lav[1]); w0.y = cvt_pk_bf16(lav[2], lav[3]); w0.z = cvt_pk_bf16(lav[4], lav[5]); w0.w = cvt_pk_bf16(lav[6], lav[7]);
                w1.x = cvt_pk_bf16(bnv[0], bnv[1]); w1.y = cvt_pk_bf16(bnv[2], bnv[3]); w1.z = cvt_pk_bf16(bnv[4], bnv[5]); w1.w = cvt_pk_bf16(bnv[6], bnv[7]);
                *(u32x4*)(LA + off) = w0; *(u32x4*)(BIN + off) = w1;
                asm volatile("" ::: "memory"); __builtin_amdgcn_sched_barrier(0); }
    }
};

struct EpiQKV {
    static constexpr bool PERM = true;
    unsigned char* ws; float* kmean;
    __device__ __forceinline__ void operator()(const f32x4 (&acc)[2][2][4][2], const Unit& u, int wr, int wc, int fr, int fq) const {
        const int b = u.pm >> 3, sblk = u.pm & 7, pq = u.pn & 3; const bool second = u.pn >= 4;
        const int dcol = wc * 32 + 8 * fq;
        if (u.sub == 0 && second) {
#pragma unroll
            for (int ai = 0; ai < 2; ++ai)
#pragma unroll
                for (int m = 0; m < 4; ++m) { bf16_t* rowp = (bf16_t*)(ws + WS_G) + (size_t)(u.pm * BM + ai * HALF + wr * 64 + m * 16 + fr) * DM + pq * 256 + dcol;
#pragma unroll
                    for (int bj = 0; bj < 2; ++bj) { const f32x4 v0 = acc[ai][bj][m][0], v1 = acc[ai][bj][m][1];
                        u32x4 w; w.x = cvt_pk_bf16(v0[0], v0[1]); w.y = cvt_pk_bf16(v0[2], v0[3]); w.z = cvt_pk_bf16(v1[0], v1[1]); w.w = cvt_pk_bf16(v1[2], v1[3]);
                        *(u32x4*)(rowp + bj * HALF) = w; } }
            return;
        }
        const size_t boff = (u.sub == 0) ? WS_UPRE : (second ? WS_BIN : WS_LA);
        bf16_t* base = (bf16_t*)(ws + boff);
#pragma unroll
        for (int bj = 0; bj < 2; ++bj) { const int head = 2 * pq + bj;
            bf16_t* hb = base + ((size_t)(b * NH + head) * SEQ + sblk * 256) * DH + dcol;
#pragma unroll
            for (int ai = 0; ai < 2; ++ai)
#pragma unroll
                for (int m = 0; m < 4; ++m) { const f32x4 v0 = acc[ai][bj][m][0], v1 = acc[ai][bj][m][1];
                    u32x4 w; w.x = cvt_pk_bf16(v0[0], v0[1]); w.y = cvt_pk_bf16(v0[2], v0[3]); w.z = cvt_pk_bf16(v1[0], v1[1]); w.w = cvt_pk_bf16(v1[2], v1[3]);
                    *(u32x4*)(hb + (size_t)(ai * HALF + wr * 64 + m * 16 + fr) * DH) = w; } }
        if (u.sub == 1 && !second) {
#pragma unroll
            for (int bj = 0; bj < 2; ++bj) { const int head = 2 * pq + bj;
#pragma unroll
                for (int n = 0; n < 2; ++n) { f32x4 s = (f32x4){0.f, 0.f, 0.f, 0.f};
#pragma unroll
                    for (int ai = 0; ai < 2; ++ai)
#pragma unroll
                        for (int m = 0; m < 4; ++m) s += acc[ai][bj][m][n];
#pragma unroll
                    for (int j = 0; j < 4; ++j) { float t = s[j]; t += __shfl_xor(t, 1); t += __shfl_xor(t, 2); t += __shfl_xor(t, 4); t += __shfl_xor(t, 8);
                        if (fr == 0) atomicAdd(kmean + ((size_t)(b * NH + head) * 8 + sblk) * DH + dcol + 4 * n + j, t * (1.f / 256.f)); } } }
        }
    }
};

template <class Epi, class Sched>
__device__ __forceinline__ void gemm_phase(LAS unsigned char* lds, const Gemm g, const Sched& S, const Epi& E, int wv) {
    const int tid = opq_tid(wv), wid = __builtin_amdgcn_readfirstlane(tid >> 6), lane = tid & 63, wr = wid >> 2, wc = wid & 3, fr = lane & 15, fq = lane >> 4;
    const int K = g.K, nt = K / BK;
    unsigned voffA[2], voffB[2];
#pragma unroll
    for (int i = 0; i < 2; ++i) { int R, C; stage_rc(tid * 16 + i * 8192, R, C); const int Rb = Epi::PERM ? ((R & ~31) + perm32(R & 31)) : R;
        voffA[i] = (unsigned)(R * g.lda + C) * 2u; voffB[i] = (unsigned)(Rb * g.ldb + C) * 2u; }
    const size_t kstep = (size_t)(BK * 2);
    const size_t hstepA = (size_t)HALF * g.lda * 2, hstepB = (size_t)HALF * g.ldb * 2;
    const size_t tstepA = 2 * hstepA, tstepB = 2 * hstepB;
    const unsigned ldsw = (unsigned)wid * 1024u;
    const int aoff = lds_byte(wr * 64 + fr, fq * 8), boff = lds_byte(wc * 32 + fr, fq * 8);
#define PG8_SA(b, h) (((b) * 2 + (h)) * HTB)
#define PG8_SB(b, h) ((4 + (b) * 2 + (h)) * HTB)
#define PG8_STAGE(bufoff, gbase, voff) do { _Pragma("unroll") for (int _i = 0; _i < 2; ++_i) \
        __builtin_amdgcn_global_load_lds((const unsigned*)((const char*)(gbase) + (voff)[_i]), (LAS unsigned*)(lds + (bufoff) + ldsw + _i * 8192), 16, 0, 0); } while (0)
#define PG8_LDA(dst, b, h) do { _Pragma("unroll") for (int m = 0; m < 4; ++m) _Pragma("unroll") for (int k = 0; k < 2; ++k) dst[m][k] = *(const LAS bf16x8*)(lds + PG8_SA(b, h) + aoff + m * 2048 + k * 1024); } while (0)
#define PG8_LDB(dst, b, h) do { _Pragma("unroll") for (int n = 0; n < 2; ++n) _Pragma("unroll") for (int k = 0; k < 2; ++k) dst[n][k] = *(const LAS bf16x8*)(lds + PG8_SB(b, h) + boff + n * 2048 + k * 1024); } while (0)
#define PG8_MMA(ai, bj, At, Bt) do { __builtin_amdgcn_s_setprio(1); _Pragma("unroll") for (int m = 0; m < 4; ++m) _Pragma("unroll") for (int n = 0; n < 2; ++n) _Pragma("unroll") for (int k = 0; k < 2; ++k) \
        acc[ai][bj][m][n] = __builtin_amdgcn_mfma_f32_16x16x32_bf16(Bt[n][k], At[m][k], acc[ai][bj][m][n], 0, 0, 0); __builtin_amdgcn_s_setprio(0); } while (0)
#define PG8_WAIT_V(n) asm volatile("s_waitcnt vmcnt(" #n ")" ::: "memory")
#define PG8_WAIT_L(n) asm volatile("s_waitcnt lgkmcnt(" #n ")" ::: "memory")
#define PG8_BAR __builtin_amdgcn_s_barrier()
#define PG8_SCHED __builtin_amdgcn_sched_barrier(0)
#define PG8_UA(u) ((const char*)g.A + (size_t)(u).sub * g.a_sub + (size_t)(u).pm * tstepA)
#define PG8_UB(u) ((const char*)g.Bt + (size_t)(u).sub * g.b_sub + (size_t)(u).pn * tstepB)
    Unit cur, nxt; int ui = 0;
    if (!S.next(0, cur)) return;
    f32x4 acc[2][2][4][2];
#pragma unroll
    for (int a = 0; a < 2; ++a)
#pragma unroll
        for (int b = 0; b < 2; ++b)
#pragma unroll
            for (int m = 0; m < 4; ++m)
#pragma unroll
                for (int n = 0; n < 2; ++n) acc[a][b][m][n] = (f32x4){0.f, 0.f, 0.f, 0.f};
    bf16x8 At[4][2], B0[2][2], B1[2][2];
    const char* cA = PG8_UA(cur); const char* cB = PG8_UB(cur);
    PG8_STAGE(PG8_SB(0, 0), cB, voffB); PG8_STAGE(PG8_SB(0, 1), cB + hstepB, voffB); PG8_STAGE(PG8_SA(0, 0), cA, voffA); PG8_STAGE(PG8_SA(0, 1), cA + hstepA, voffA);
    if (wr == 1) PG8_BAR;
    PG8_WAIT_V(2); PG8_BAR;
    PG8_STAGE(PG8_SB(1, 0), cB + kstep, voffB); PG8_STAGE(PG8_SA(1, 0), cA + kstep, voffA); PG8_STAGE(PG8_SB(1, 1), cB + hstepB + kstep, voffB);
    PG8_WAIT_V(6); PG8_BAR;
    for (;;) {
        const bool has_next = S.next(ui + 1, nxt);
        const char* nA = has_next ? PG8_UA(nxt) : cA; const char* nB = has_next ? PG8_UB(nxt) : cB;
        for (int t = 0; t < nt; t += 2) {
            const bool last = (t == nt - 2);
            const char* a1 = cA + (size_t)(t + 1) * kstep;
            const char* a2 = last ? nA : cA + (size_t)(t + 2) * kstep; const char* b2 = last ? nB : cB + (size_t)(t + 2) * kstep;
            const char* a3 = a2 + kstep; const char* b3 = b2 + kstep;
            PG8_LDB(B0, 0, 0); PG8_LDB(B1, 0, 1); PG8_SCHED; PG8_LDA(At, 0, 0); PG8_STAGE(PG8_SA(1, 1), a1 + hstepA, voffA);
            PG8_WAIT_V(8); PG8_WAIT_L(0); PG8_BAR; PG8_MMA(0, 0, At, B0); PG8_MMA(0, 1, At, B1); PG8_BAR; PG8_SCHED;
            PG8_LDA(At, 0, 1); PG8_STAGE(PG8_SB(0, 0), b2, voffB); PG8_STAGE(PG8_SB(0, 1), b2 + hstepB, voffB); PG8_STAGE(PG8_SA(0, 0), a2, voffA);
            PG8_WAIT_V(8); PG8_WAIT_L(0); PG8_BAR; PG8_MMA(1, 0, At, B0); PG8_MMA(1, 1, At, B1); PG8_BAR; PG8_SCHED;
            PG8_LDB(B0, 1, 0); PG8_LDB(B1, 1, 1); PG8_SCHED; PG8_LDA(At, 1, 0); PG8_STAGE(PG8_SA(0, 1), a2 + hstepA, voffA);
            PG8_WAIT_V(8); PG8_WAIT_L(0); PG8_BAR; PG8_MMA(0, 0, At, B0); PG8_MMA(0, 1, At, B1); PG8_BAR; PG8_SCHED;
            PG8_LDA(At, 1, 1); PG8_STAGE(PG8_SB(1, 0), b3, voffB); PG8_STAGE(PG8_SB(1, 1), b3 + hstepB, voffB); PG8_STAGE(PG8_SA(1, 0), a3, voffA);
            PG8_WAIT_V(8); PG8_WAIT_L(0); PG8_BAR; PG8_MMA(1, 0, At, B0); PG8_MMA(1, 1, At, B1); PG8_BAR; PG8_SCHED;
        }
        if (wr == 0) PG8_BAR;
        { const int t2 = opq_tid(wv), w2 = __builtin_amdgcn_readfirstlane(t2 >> 6), l2 = t2 & 63; E(acc, cur, w2 >> 2, w2 & 3, l2 & 15, l2 >> 4); }
        if (!has_next) break;
#pragma unroll
        for (int a = 0; a < 2; ++a)
#pragma unroll
            for (int b = 0; b < 2; ++b)
#pragma unroll
                for (int m = 0; m < 4; ++m)
#pragma unroll
                    for (int n = 0; n < 2; ++n) acc[a][b][m][n] = (f32x4){0.f, 0.f, 0.f, 0.f};
        cur = nxt; cA = nA; cB = nB; ++ui;
        if (wr == 1) PG8_BAR;
    }
    PG8_WAIT_V(0);
    PG8_BAR;
#undef PG8_SA
#undef PG8_SB
#undef PG8_STAGE
#undef PG8_LDA
#undef PG8_LDB
#undef PG8_MMA
#undef PG8_WAIT_V
#undef PG8_WAIT_L
#undef PG8_BAR
#undef PG8_SCHED
#undef PG8_UA
#undef PG8_UB
}
}

namespace att {
constexpr float SCALE = 0.08838834764831845f;
constexpr float THR = 8.f;
constexpr int NW = 8, QBLK = 32, KVBLK = 64, QB = NW * QBLK, D = 128;
constexpr int SHM_V = KVBLK * D * 2, SHM_K = KVBLK * D * 2;
constexpr int ATT_LDS = 2 * SHM_V + 2 * SHM_K + NW * 64 * 4;
#define KSWZ(row, colB) ((row) * 256 + ((colB) ^ (((row) & 7) << 4)))
#define SBAR() __builtin_amdgcn_sched_barrier(0)
__device__ __forceinline__ int v_st(int k, int c) { const int kk = (k & ~0xC) | ((k & 4) << 1) | ((k & 8) >> 1); return ((kk >> 3) * 4 + (c >> 5)) * 512 + ((kk & 7) * 32 + (c & 31)) * 2; }
__device__ __forceinline__ int v_rd_base(int lane) { return ((lane & 3) << 3) | (((lane >> 2) & 3) << 6) | (((lane >> 4) & 1) << 5) | (((lane >> 5) & 1) << 8); }
constexpr int v_rd_off(int d0, int ks, int half) { return d0 * 512 + ks * 4096 + half * 2048; }
__device__ __forceinline__ int crow(int r, int hi) { return (r & 3) + 8 * (r >> 2) + 4 * hi; }
__device__ __forceinline__ bf16x8 load8(const bf16_t* p) { return *reinterpret_cast<const bf16x8*>(p); }
__device__ __forceinline__ void mask_tile(f32x16& p0, f32x16& p1, int dq) {
    const float NEG = -__builtin_inff();
#pragma unroll
    for (int r = 0; r < 16; ++r) {
        const int c = (r & 3) + 8 * (r >> 2);
        if (dq - c < 0) p0[r] = NEG;
        if (dq - c - 32 < 0) p1[r] = NEG;
    }
}
__device__ __forceinline__ void mask_all(f32x16& p0, f32x16& p1, bool off) {
    const float NEG = -__builtin_inff();
#pragma unroll
    for (int r = 0; r < 16; ++r) { p0[r] = off ? NEG : p0[r]; p1[r] = off ? NEG : p1[r]; }
}
__device__ __forceinline__ void partialSM(f32x16& p0, f32x16& p1, float& m_reg, float& mn, float& alpha) {
    float pmax = p0[0];
#pragma unroll
    for (int r = 1; r < 16; ++r) pmax = fmaxf(pmax, p0[r]);
#pragma unroll
    for (int r = 0; r < 16; ++r) pmax = fmaxf(pmax, p1[r]);
    { auto rr = __builtin_amdgcn_permlane32_swap(__float_as_uint(pmax), __float_as_uint(pmax), false, false);
      pmax = fmaxf(__uint_as_float(rr[0]), __uint_as_float(rr[1])); }
    constexpr float C2 = 1.4426950408889634f * SCALE;
    if (__builtin_expect(__all((pmax - m_reg) * SCALE <= THR), 1)) { mn = m_reg; alpha = 1.f; }
    else { mn = fmaxf(m_reg, pmax); alpha = __builtin_amdgcn_exp2f((m_reg - mn) * C2); m_reg = mn; }
    const float mnL = -mn * C2;
#pragma unroll
    for (int r = 0; r < 16; ++r) p0[r] = fmaf(p0[r], C2, mnL);
#pragma unroll
    for (int r = 0; r < 16; ++r) p1[r] = fmaf(p1[r], C2, mnL);
#pragma unroll
    for (int r = 0; r < 16; ++r) p0[r] = __builtin_amdgcn_exp2f(p0[r]);
}
__device__ __forceinline__ void finishSM(f32x16& p0, f32x16& p1, float alpha, float& l_reg, bf16x8& pa0, bf16x8& pa1, bf16x8& pa2, bf16x8& pa3) {
#pragma unroll
    for (int r = 0; r < 16; ++r) p1[r] = __builtin_amdgcn_exp2f(p1[r]);
    float ps = 0;
#pragma unroll
    for (int r = 0; r < 16; ++r) ps += p0[r];
#pragma unroll
    for (int r = 0; r < 16; ++r) ps += p1[r];
    { auto rr = __builtin_amdgcn_permlane32_swap(__float_as_uint(ps), __float_as_uint(ps), false, false);
      ps = __uint_as_float(rr[0]) + __uint_as_float(rr[1]); }
    l_reg = l_reg * alpha + ps;
#define PK4(P, B_, OUT) do { unsigned a0 = cvt_pk_bf16(P[B_+0], P[B_+1]), a1 = cvt_pk_bf16(P[B_+2], P[B_+3]);                          \
        unsigned b0 = cvt_pk_bf16(P[B_+4], P[B_+5]), b1 = cvt_pk_bf16(P[B_+6], P[B_+7]);                                             \
        auto r0 = __builtin_amdgcn_permlane32_swap(a0, b0, false, false); auto r1 = __builtin_amdgcn_permlane32_swap(a1, b1, false, false); \
        u32x4 w = {r0[0], r1[0], r0[1], r1[1]}; OUT = *reinterpret_cast<bf16x8*>(&w); } while (0)
    PK4(p0, 0, pa0); PK4(p0, 8, pa1); PK4(p1, 0, pa2); PK4(p1, 8, pa3);
#undef PK4
}
template <int KB>
__device__ __forceinline__ void qkt(f32x16& p0, f32x16& p1, const char* K_lds, int r32, int hi, const bf16x8* qr) {
    p0 = f32x16{}; p1 = f32x16{};
    const char* kb[4];
#pragma unroll
    for (int dd = 0; dd < 4; ++dd) kb[dd] = K_lds + KB * SHM_K + KSWZ(r32, (dd * 16 + hi * 8) * 2);
#pragma unroll
    for (int d0 = 0; d0 < 8; ++d0) { const char* a = kb[d0 & 3] + (d0 >> 2) * 128;
        bf16x8 b0 = *reinterpret_cast<const bf16x8*>(a);
        bf16x8 b1 = *reinterpret_cast<const bf16x8*>(a + 32 * 256);
        p0 = __builtin_amdgcn_mfma_f32_32x32x16_bf16(b0, qr[d0], p0, 0, 0, 0);
        p1 = __builtin_amdgcn_mfma_f32_32x32x16_bf16(b1, qr[d0], p1, 0, 0, 0); }
}
template <int VB>
__device__ __forceinline__ void pv_tile(f32x16* o, int vb0, bf16x8 pa0, bf16x8 pa1, bf16x8 pa2, bf16x8 pa3) {
#define TRRD(dst, off) asm volatile("ds_read_b64_tr_b16 %0, %1 offset:%2" : "=&v"(dst) : "v"(vb0), "i"(off) : "memory")
#define PV_D0(d0) do { s16x4 l0, l1, l2, l3, h0, h1, h2, h3; constexpr int b_ = VB * SHM_V + v_rd_off(d0, 0, 0); \
        TRRD(l0, b_); TRRD(h0, b_ + 2048); TRRD(l1, b_ + 4096); TRRD(h1, b_ + 6144); TRRD(l2, b_ + 8192); TRRD(h2, b_ + 10240); TRRD(l3, b_ + 12288); TRRD(h3, b_ + 14336); \
        asm volatile("s_waitcnt lgkmcnt(0)" ::: "memory"); SBAR();   \
        o[d0] = __builtin_amdgcn_mfma_f32_32x32x16_bf16(pa0, (bf16x8){l0[0], l0[1], l0[2], l0[3], h0[0], h0[1], h0[2], h0[3]}, o[d0], 0, 0, 0);   \
        o[d0] = __builtin_amdgcn_mfma_f32_32x32x16_bf16(pa1, (bf16x8){l1[0], l1[1], l1[2], l1[3], h1[0], h1[1], h1[2], h1[3]}, o[d0], 0, 0, 0);   \
        o[d0] = __builtin_amdgcn_mfma_f32_32x32x16_bf16(pa2, (bf16x8){l2[0], l2[1], l2[2], l2[3], h2[0], h2[1], h2[2], h2[3]}, o[d0], 0, 0, 0);   \
        o[d0] = __builtin_amdgcn_mfma_f32_32x32x16_bf16(pa3, (bf16x8){l3[0], l3[1], l3[2], l3[3], h3[0], h3[1], h3[2], h3[3]}, o[d0], 0, 0, 0); } while (0)
    PV_D0(0); PV_D0(1); PV_D0(2); PV_D0(3);
#undef PV_D0
#undef TRRD
}

struct BlockRef { const bf16_t* Q; const bf16_t* K; const bf16_t* V; bf16_t* O; const bf16_t* Gt; const float* KM; int P0; };
struct Seam { bf16x8 qr[8]; bf16x8 st_v0, st_v1, st_k0, st_k1; };
#define ROW(p, k0, rr) ((p) + (size_t)((k0) + (rr)) * D + sc)
#define VMW() asm volatile("s_waitcnt vmcnt(0)" ::: "memory")
#define VMWN(n) asm volatile("s_waitcnt vmcnt(%0)" :: "i"(n) : "memory")
#define SLOAD_H(Kp, Vp, k0) do { S.st_v0 = load8(ROW(Vp, k0, sr)); S.st_v1 = load8(ROW(Vp, k0, 32 + sr));              \
                         S.st_k0 = load8(ROW(Kp, k0, sr)); S.st_k1 = load8(ROW(Kp, k0, 32 + sr)); } while (0)
#define SWRITE_HK(bf) do { *(bf16x8*)(K_lds + (bf) * SHM_K + kws) = S.st_k0; *(bf16x8*)(K_lds + (bf) * SHM_K + kws + 32 * 256) = S.st_k1; } while (0)
#define SWRITE_HV(bf) do { *(bf16x8*)(V_lds + (bf) * SHM_V + vst0) = S.st_v0; *(bf16x8*)(V_lds + (bf) * SHM_V + vst1) = S.st_v1; } while (0)
#define SWRITE_H(bf) do { SWRITE_HV(bf); SWRITE_HK(bf); } while (0)
__device__ __forceinline__ void moba_prime(const BlockRef& cur, char* lds, Seam& S, int wv) {
    const int tid = opq_tid(wv), wid = __builtin_amdgcn_readfirstlane(tid >> 6), lane = tid & 63, r32 = lane & 31, hi = lane >> 5;
    const int sr = tid >> 4, sc = (tid & 15) * 8, kws = KSWZ(sr, sc * 2); char* K_lds = lds + 2 * SHM_V;
#pragma unroll
    for (int d0 = 0; d0 < 8; ++d0) S.qr[d0] = load8(cur.Q + (size_t)(wid * QBLK + r32) * D + d0 * 16 + hi * 8);
    SLOAD_H(cur.K, cur.V, 0); VMW(); SWRITE_HK(0);
    __syncthreads();
}
__device__ __forceinline__ unsigned moba_select(const Seam& S, const float* KM, int qb, int hi) {
    if (qb <= 3) return (1u << qb) - 1u;
    float sc_[8];
#pragma unroll
    for (int j = 0; j < 8; ++j) sc_[j] = 0.f;
#pragma unroll
    for (int j = 0; j < 7; ++j) {
        if (j < qb) {
            float s = 0.f;
#pragma unroll
            for (int d0 = 0; d0 < 8; ++d0) {
                const f32x4 k0 = *(const f32x4*)(KM + j * D + d0 * 16 + hi * 8), k1 = *(const f32x4*)(KM + j * D + d0 * 16 + hi * 8 + 4);
                const bf16x8 q = S.qr[d0];
                s += bf1((bf16_t)q[0]) * k0[0] + bf1((bf16_t)q[1]) * k0[1] + bf1((bf16_t)q[2]) * k0[2] + bf1((bf16_t)q[3]) * k0[3]
                   + bf1((bf16_t)q[4]) * k1[0] + bf1((bf16_t)q[5]) * k1[1] + bf1((bf16_t)q[6]) * k1[2] + bf1((bf16_t)q[7]) * k1[3];
            }
            s += __shfl_xor(s, 32);
            sc_[j] = s;
        }
    }
    unsigned sel = 0u;
#pragma unroll
    for (int it = 0; it < 3; ++it) {
        float best = -__builtin_inff(); int bi = 0;
#pragma unroll
        for (int j = 0; j < 7; ++j) { const bool ok = (j < qb) && !((sel >> j) & 1u) && (sc_[j] > best); best = ok ? sc_[j] : best; bi = ok ? j : bi; }
        sel |= 1u << bi;
    }
    return sel;
}
__device__ __forceinline__ void moba_block(const BlockRef& cur, const BlockRef& nxt, char* lds, Seam& S, int wv) {
    const int tid = opq_tid(wv), wid = __builtin_amdgcn_readfirstlane(tid >> 6), lane = tid & 63, r32 = lane & 31, hi = lane >> 5;
    const int NT = cur.P0 / KVBLK + 4;
    const int qb = cur.P0 >> 8;
    const int qlo = cur.P0 + wid * QBLK, qm = qlo + r32 - 4 * hi;
    char* V_lds = lds; char* K_lds = lds + 2 * SHM_V;
    float* ws = (float*)(lds + 2 * SHM_V + 2 * SHM_K) + wid * 64; float* li_l = ws, * al_l = ws + 32;
    float m_reg = -1e30f, l_reg = 0; f32x16 o[4] = {};
    const int sr = tid >> 4, sc = (tid & 15) * 8, vst0 = v_st(sr, sc), vst1 = v_st(32 + sr, sc), kws = KSWZ(sr, sc * 2);
    const int vb0 = (int)(uintptr_t)V_lds + v_rd_base(lane);
    const bf16_t* Kh = cur.K; const bf16_t* Vh = cur.V;
    const unsigned sel = moba_select(S, cur.KM, qb, hi);
    const bool need_sel = qb > 3;
#define RESC(a) do { if (__any((a) < 1.f)) { if (hi == 0) al_l[r32] = (a); asm volatile("s_waitcnt lgkmcnt(0)" ::: "memory");              \
                     for (int d_ = 0; d_ < 4; ++d_) for (int r = 0; r < 16; ++r) o[d_][r] *= al_l[crow(r, hi)]; } } while (0)
#define KBASE(t) ((t) * KVBLK)
#define MASKT(P0_, P1_, t) do { const int kb_ = KBASE(t); \
        if (kb_ < cur.P0) { if (need_sel) mask_all(P0_, P1_, ((sel >> (kb_ >> 8)) & 1u) == 0u); } \
        else if (kb_ + KVBLK - 1 > qlo) mask_tile(P0_, P1_, qm - kb_); } while (0)
#define SEAM_K0() do { VMWN(8); SWRITE_HK(0); SBAR(); } while (0)
    f32x16 pA0, pA1, pB0, pB1; float mnA, mnB, alA, alB; bf16x8 pa0, pa1, pa2, pa3;
    SWRITE_HV(0); SBAR();
    SLOAD_H(Kh, Vh, KBASE(1));
    SBAR(); qkt<0>(pA0, pA1, K_lds, r32, hi, S.qr);
    MASKT(pA0, pA1, 0); partialSM(pA0, pA1, m_reg, mnA, alA);
    VMW(); SWRITE_H(1);
    __syncthreads();
#define HALF_STEP(PX0, PX1, mnX, alX, PY0, PY1, alY, t, KB, VB, SB) do {                                                      \
        SBAR(); qkt<KB>(PX0, PX1, K_lds, r32, hi, S.qr);                                                                       \
        finishSM(PY0, PY1, alY, l_reg, pa0, pa1, pa2, pa3); SBAR();                                                           \
        if ((t) + 1 < NT) { SLOAD_H(Kh, Vh, KBASE((t) + 1)); SBAR(); }                                                        \
        pv_tile<VB>(o, vb0, pa0, pa1, pa2, pa3); MASKT(PX0, PX1, (t)); partialSM(PX0, PX1, m_reg, mnX, alX);                  \
        __syncthreads();                                                                                                      \
        if ((t) + 1 < NT) { VMW(); SWRITE_H(SB); }                                                                            \
        RESC(alX); __syncthreads(); } while (0)
    for (int t = 1; t + 1 < NT; t += 2) {
        HALF_STEP(pB0, pB1, mnB, alB, pA0, pA1, alA, t, 1, 0, 0);
        HALF_STEP(pA0, pA1, mnA, alA, pB0, pB1, alB, t + 1, 0, 1, 1);
    }
    SBAR(); qkt<1>(pB0, pB1, K_lds, r32, hi, S.qr); SBAR();
    SLOAD_H(nxt.K, nxt.V, 0); SBAR();
#pragma unroll
    for (int d0 = 0; d0 < 8; ++d0) S.qr[d0] = load8(nxt.Q + (size_t)(wid * QBLK + r32) * D + d0 * 16 + hi * 8);
    SBAR();
    finishSM(pA0, pA1, alA, l_reg, pa0, pa1, pa2, pa3); SBAR();
    pv_tile<0>(o, vb0, pa0, pa1, pa2, pa3);
    MASKT(pB0, pB1, NT - 1); partialSM(pB0, pB1, m_reg, mnB, alB); __syncthreads(); RESC(alB);
    finishSM(pB0, pB1, alB, l_reg, pa0, pa1, pa2, pa3); SBAR(); pv_tile<1>(o, vb0, pa0, pa1, pa2, pa3);
    SBAR(); SEAM_K0();
    if (hi == 0) li_l[r32] = l_reg; asm volatile("s_waitcnt lgkmcnt(0)" ::: "memory");
    bf16_t* Ow = cur.O + (size_t)(wid * QBLK) * DM; const bf16_t* Gw = cur.Gt + (size_t)(wid * QBLK) * DM;
#pragma unroll
    for (int r = 0; r < 16; ++r) { const int orow = crow(r, hi); const float rl = __builtin_amdgcn_rcpf(li_l[orow]);
#pragma unroll
        for (int d0 = 0; d0 < 4; ++d0) { const float gv = bf1(Gw[(size_t)orow * DM + d0 * 32 + r32]);
            const float v = o[d0][r] * rl * fsilu(gv);
            const float vn = __shfl_xor(v, 1);
            if ((r32 & 1) == 0) *(unsigned*)(Ow + (size_t)orow * DM + d0 * 32 + r32) = cvt_pk_bf16(v, vn); } }
    __syncthreads();
#undef RESC
#undef KBASE
#undef MASKT
#undef SEAM_K0
#undef HALF_STEP
}
#undef ROW
#undef VMW
#undef VMWN
#undef SLOAD_H
#undef SWRITE_HK
#undef SWRITE_HV
#undef SWRITE_H

__device__ __forceinline__ BlockRef mk_ref(int L, int pass, const bf16_t* Q, const bf16_t* K, const bf16_t* V, bf16_t* O, const bf16_t* Gt, const float* KM) {
    const int bh = L >> 2, x = L & 3, qb = pass ? 7 - x : x, b = bh >> 3, h = bh & 7;
    BlockRef r;
    r.Q = Q + ((size_t)bh * SEQ + (size_t)qb * QB) * D; r.K = K + (size_t)bh * SEQ * D; r.V = V + (size_t)bh * SEQ * D;
    r.O = O + ((size_t)b * SEQ + (size_t)qb * QB) * DM + h * DH; r.Gt = Gt + ((size_t)b * SEQ + (size_t)qb * QB) * DM + h * DH;
    r.KM = KM + (size_t)bh * 8 * D; r.P0 = qb * QB;
    return r;
}
__device__ __forceinline__ void attn_phase(char* lds, const bf16_t* Q, const bf16_t* K, const bf16_t* V, bf16_t* O, const bf16_t* Gt, const float* KM, int wv) {
    const int total = NB * NH * 4, stride = gridDim.x;
    int L = opq_bid(); if (L >= total) return;
    int pass = 0;
    BlockRef cur = mk_ref(L, 0, Q, K, V, O, Gt, KM);
    Seam S;
    moba_prime(cur, lds, S, wv);
    for (;;) {
        const bool more_pass = pass == 0, more_item = L + stride < total, last = !more_pass && !more_item;
        int passn = pass + 1, Ln = L;
        if (!more_pass) { passn = 0; Ln = more_item ? L + stride : L; }
        const BlockRef nxt = last ? cur : mk_ref(Ln, passn, Q, K, V, O, Gt, KM);
        moba_block(cur, nxt, lds, S, wv);
        if (last) break;
        cur = nxt; pass = passn; L = Ln;
    }
}
}

struct Args { const float* in[21]; float* out; unsigned char* ws; int ph_lo, ph_hi; };
typedef const __attribute__((address_space(4))) Args* ArgsP;
#define AIN(i) ((const float*)ap->in[i])

__device__ __forceinline__ void transpose_item(const float* W, int ldw, bf16_t* WT, int ldt, LAS float* scr, int lane) {
#pragma unroll 8
    for (int i = 0; i < 32; ++i) { const int kk = 2 * i + (lane >> 5); scr[kk * 33 + (lane & 31)] = W[(size_t)kk * ldw + (lane & 31)]; }
    asm volatile("s_waitcnt lgkmcnt(0)" ::: "memory");
    const int c = lane & 7;
#pragma unroll
    for (int j = 0; j < 4; ++j) { const int n = (lane >> 3) + 8 * j; const LAS float* s = scr + (8 * c) * 33 + n;
        u32x4 o; o.x = cvt_pk_bf16(s[0 * 33], s[1 * 33]); o.y = cvt_pk_bf16(s[2 * 33], s[3 * 33]); o.z = cvt_pk_bf16(s[4 * 33], s[5 * 33]); o.w = cvt_pk_bf16(s[6 * 33], s[7 * 33]);
        *(u32x4*)(WT + (size_t)n * ldt + 8 * c) = o; }
    asm volatile("s_waitcnt lgkmcnt(0)" ::: "memory");
}
__device__ __forceinline__ void transpose_mat(const float* W, int K, int N, bf16_t* WT, int item, LAS float* scr, int lane) {
    const int nblk = N / 32, kb = item / nblk, nb = item % nblk;
    transpose_item(W + (size_t)(64 * kb) * N + 32 * nb, N, WT + (size_t)(32 * nb) * K + 64 * kb, K, scr, lane);
}

__device__ __forceinline__ void prep_phase(ArgsP ap, LAS unsigned char* lds, int wave, int lane) {
    unsigned char* ws = (unsigned char*)ap->ws;
    LAS float* scr = (LAS float*)(lds + wave * 16384);
    const int gw = opq_bid() * NWAVES + wave, NGW = gridDim.x * NWAVES;
    constexpr int I_BIG = (DM / 64) * (2 * DM / 32);
    constexpr int I_SQ = (DM / 64) * (DM / 32);
    constexpr int I_G = (256 / 64) * (256 / 32);
    constexpr int N_T = 2 * I_BIG + 2 * I_SQ + 2 * I_BIG + I_BIG + 2 * I_SQ + 16 * I_G;
    constexpr int N_GEMV = (MODV_LD / 64) * 8;
    for (int it = gw; it < N_T + N_GEMV; it += NGW) {
        int r = it;
        if (r < 2 * I_BIG) { const int l = r / I_BIG; transpose_mat(AIN(5) + (size_t)l * DM * 2 * DM, DM, 2 * DM, (bf16_t*)(ws + WS_WIN) + (size_t)l * 2 * DM * DM, r % I_BIG, scr, lane); continue; } r -= 2 * I_BIG;
        if (r < 2 * I_SQ) { const int l = r / I_SQ; transpose_mat(AIN(13) + (size_t)l * DM * DM, DM, DM, (bf16_t*)(ws + WS_WOUT) + (size_t)l * DM * DM, r % I_SQ, scr, lane); continue; } r -= 2 * I_SQ;
        if (r < 2 * I_BIG) { const int l = r / I_BIG; transpose_mat(AIN(18) + (size_t)l * DM * 2 * DM, DM, 2 * DM, (bf16_t*)(ws + (l ? WS_ATTIN1 : WS_ATTIN0)), r % I_BIG, scr, lane); continue; } r -= 2 * I_BIG;
        if (r < I_BIG) { transpose_mat(AIN(17), DM, 2 * DM, (bf16_t*)(ws + WS_WKV), r, scr, lane); continue; } r -= I_BIG;
        if (r < 2 * I_SQ) { const int l = r / I_SQ; transpose_mat(AIN(19) + (size_t)l * DM * DM, DM, DM, (bf16_t*)(ws + WS_ATTOUT) + (size_t)l * DM * DM, r % I_SQ, scr, lane); continue; } r -= 2 * I_SQ;
        if (r < 16 * I_G) {
            const int mat = r / I_G, item = r % I_G, which = mat >> 3, lh = mat & 7;
            const float* W = (which ? AIN(10) : AIN(8)) + (size_t)lh * 256 * 256;
            bf16_t* WT = (bf16_t*)(ws + WS_WG) + (size_t)lh * 512 * 256;
            const int kb = item / 8, nb = item % 8, n0 = 32 * nb, drow = 256 * (n0 >> 7) + 128 * which + (n0 & 127);
            transpose_item(W + (size_t)(64 * kb) * 256 + n0, 256, WT + (size_t)drow * 256 + 64 * kb, 256, scr, lane);
            continue;
        } r -= 16 * I_G;
        { const int cgp = r >> 3, kc = r & 7, k0 = kc * 128;
          const float* W; int ldw, n0; const float* bias;
          if (cgp < 192) { const int l = cgp / 48; n0 = (cgp % 48) * 64; W = AIN(2) + (size_t)l * DM * 3 * DM; ldw = 3 * DM; bias = AIN(3) + l * 3 * DM; }
          else { n0 = (cgp - 192) * 64; W = AIN(15); ldw = 2 * DM; bias = AIN(16); }
          const float* c = AIN(1);
#pragma unroll
          for (int i = 0; i < 16; ++i) { const int idx = i * 64 + lane, b = idx >> 7, kk = idx & 127; scr[kk * 8 + b] = fsilu(c[b * DM + k0 + kk]); }
          asm volatile("s_waitcnt lgkmcnt(0)" ::: "memory");
          float acc[8];
#pragma unroll
          for (int b = 0; b < 8; ++b) acc[b] = 0.f;
          const float* wp = W + (size_t)k0 * ldw + n0 + lane;
#pragma unroll 8
          for (int kk = 0; kk < 128; ++kk) { const float w = wp[(size_t)kk * ldw];
              const f32x4 c0 = *(const LAS f32x4*)(scr + kk * 8), c1 = *(const LAS f32x4*)(scr + kk * 8 + 4);
              acc[0] += w * c0[0]; acc[1] += w * c0[1]; acc[2] += w * c0[2]; acc[3] += w * c0[3];
              acc[4] += w * c1[0]; acc[5] += w * c1[1]; acc[6] += w * c1[2]; acc[7] += w * c1[3]; }
          const float bv = (kc == 0) ? bias[n0 + lane] : 0.f;
          float* mv = (float*)(ws + WS_MODV) + cgp * 64 + lane;
#pragma unroll
          for (int b = 0; b < 8; ++b) atomicAdd(mv + (size_t)b * MODV_LD, acc[b] + bv);
          asm volatile("s_waitcnt lgkmcnt(0)" ::: "memory");
        }
    }
}

__device__ __forceinline__ void norm_phase(const float* xin, bf16_t* o1, const float* g1, const float* modv, int sh1, int sc1c,
                                            bf16_t* o2, const float* g2, int sh2, int sc2c, int wave, int lane) {
    const int gw = opq_bid() * NWAVES + wave, NGW = gridDim.x * NWAVES;
    for (int rb = gw; rb < MTOK / 8; rb += NGW) {
        const int r0 = rb * 8, b = r0 / SEQ;
        const float* mv = modv + (size_t)b * MODV_LD;
        f32x4 gs1[4], sf1[4], gs2[4], sf2[4];
#pragma unroll
        for (int j = 0; j < 4; ++j) { const int idx = 4 * lane + 256 * j;
            const f32x4 gv = *(const f32x4*)(g1 + idx), sc = *(const f32x4*)(mv + sc1c + idx); gs1[j] = gv * (sc + 1.f); sf1[j] = *(const f32x4*)(mv + sh1 + idx);
            if (o2) { const f32x4 gv2 = *(const f32x4*)(g2 + idx), sc2 = *(const f32x4*)(mv + sc2c + idx); gs2[j] = gv2 * (sc2 + 1.f); sf2[j] = *(const f32x4*)(mv + sh2 + idx); }
            else { gs2[j] = gs1[j]; sf2[j] = sf1[j]; } }
        for (int rr = 0; rr < 8; ++rr) {
            const size_t row = (size_t)(r0 + rr);
            const f32x4* xr = (const f32x4*)(xin + row * DM) + lane;
            f32x4 v[4]; float s = 0.f;
#pragma unroll
            for (int j = 0; j < 4; ++j) { v[j] = xr[64 * j]; s += (v[j].x * v[j].x + v[j].y * v[j].y) + (v[j].z * v[j].z + v[j].w * v[j].w); }
            const float rstd = 1.f / sqrtf(wave_sum(s) * (1.f / DM) + EPS);
#pragma unroll
            for (int j = 0; j < 4; ++j) { const f32x4 t = v[j] * rstd; const f32x4 y = t * gs1[j] + sf1[j];
                u32x2 w; w.x = cvt_pk_bf16(y.x, y.y); w.y = cvt_pk_bf16(y.z, y.w);
                *((u32x2*)(o1 + row * DM) + lane + 64 * j) = w;
                if (o2) { const f32x4 y2 = t * gs2[j] + sf2[j]; u32x2 w2; w2.x = cvt_pk_bf16(y2.x, y2.y); w2.y = cvt_pk_bf16(y2.z, y2.w);
                    *((u32x2*)(o2 + row * DM) + lane + 64 * j) = w2; } }
        }
    }
}
__device__ __forceinline__ void final_norm_phase(float* x, const float* g, int wave, int lane) {
    const int gw = opq_bid() * NWAVES + wave, NGW = gridDim.x * NWAVES;
    f32x4 gv[4];
#pragma unroll
    for (int j = 0; j < 4; ++j) gv[j] = *(const f32x4*)(g + 4 * lane + 256 * j);
    for (int row = gw; row < MTOK; row += NGW) {
        f32x4* xr = (f32x4*)(x + (size_t)row * DM) + lane;
        f32x4 v[4]; float s = 0.f;
#pragma unroll
        for (int j = 0; j < 4; ++j) { v[j] = xr[64 * j]; s += (v[j].x * v[j].x + v[j].y * v[j].y) + (v[j].z * v[j].z + v[j].w * v[j].w); }
        const float rstd = 1.f / sqrtf(wave_sum(s) * (1.f / DM) + EPS);
#pragma unroll
        for (int j = 0; j < 4; ++j) xr[64 * j] = v[j] * rstd * gv[j];
    }
}

__device__ __forceinline__ void conv_phase(const bf16_t* UP, bf16_t* U, const float* cw, const float* cb, int tid) {
    const int ch = 2 * tid;
    const f32x2 w0 = *(const f32x2*)(cw + ch), w1 = *(const f32x2*)(cw + DM + ch), w2 = *(const f32x2*)(cw + 2 * DM + ch), w3 = *(const f32x2*)(cw + 3 * DM + ch), bb = *(const f32x2*)(cb + ch);
    for (int it = opq_bid(); it < NB * 32; it += gridDim.x) {
        const int b = it >> 5, c = it & 31; const size_t base = ((size_t)b * SEQ + c * 64) * DM + ch;
        f32x2 x0 = {0.f, 0.f}, x1 = {0.f, 0.f}, x2 = {0.f, 0.f};
        if (c > 0) { const unsigned a0 = *(const unsigned*)(UP + base - 3 * DM), a1 = *(const unsigned*)(UP + base - 2 * DM), a2 = *(const unsigned*)(UP + base - DM);
            x0 = (f32x2){bf_lo(a0), bf_hi(a0)}; x1 = (f32x2){bf_lo(a1), bf_hi(a1)}; x2 = (f32x2){bf_lo(a2), bf_hi(a2)}; }
#pragma unroll 16
        for (int t = 0; t < 64; ++t) { const unsigned a = *(const unsigned*)(UP + base + (size_t)t * DM); const f32x2 x3 = {bf_lo(a), bf_hi(a)};
            const f32x2 y = bb + w0 * x0 + w1 * x1 + w2 * x2 + w3 * x3;
            *(unsigned*)(U + base + (size_t)t * DM) = cvt_pk_bf16(y.x, y.y);
            x0 = x1; x1 = x2; x2 = x3; }
    }
}
__device__ __forceinline__ void scanA_phase(const bf16_t* LA, const bf16_t* BIN, float* AGGA, float* AGGB, int tid) {
    const int ch = 2 * tid;
    for (int it = opq_bid(); it < NB * 32; it += gridDim.x) {
        const int b = it >> 5, c = it & 31; const size_t base = ((size_t)b * SEQ + c * 64) * DM + ch;
        float s0 = 0.f, s1 = 0.f, h0 = 0.f, h1 = 0.f;
#pragma unroll 16
        for (int t = 0; t < 64; ++t) { const unsigned la = *(const unsigned*)(LA + base + (size_t)t * DM), bi = *(const unsigned*)(BIN + base + (size_t)t * DM);
            const float l0 = bf_lo(la), l1 = bf_hi(la);
            h0 = __expf(l0) * h0 + bf_lo(bi); h1 = __expf(l1) * h1 + bf_hi(bi); s0 += l0; s1 += l1; }
        *(f32x2*)(AGGA + (size_t)it * DM + ch) = (f32x2){__expf(s0), __expf(s1)};
        *(f32x2*)(AGGB + (size_t)it * DM + ch) = (f32x2){h0, h1};
    }
}
__device__ __forceinline__ void scanB_phase(const bf16_t* LA, const bf16_t* BIN, const bf16_t* Gt, const float* AGGA, const float* AGGB, bf16_t* Y, int tid) {
    const int ch = 2 * tid;
    for (int it = opq_bid(); it < NB * 32; it += gridDim.x) {
        const int b = it >> 5, c = it & 31; const size_t base = ((size_t)b * SEQ + c * 64) * DM + ch;
        float h0 = 0.f, h1 = 0.f;
        for (int cc = 0; cc < c; ++cc) { const f32x2 A = *(const f32x2*)(AGGA + (size_t)(b * 32 + cc) * DM + ch), Bv = *(const f32x2*)(AGGB + (size_t)(b * 32 + cc) * DM + ch);
            h0 = A.x * h0 + Bv.x; h1 = A.y * h1 + Bv.y; }
#pragma unroll 16
        for (int t = 0; t < 64; ++t) { const unsigned la = *(const unsigned*)(LA + base + (size_t)t * DM), bi = *(const unsigned*)(BIN + base + (size_t)t * DM), gg = *(const unsigned*)(Gt + base + (size_t)t * DM);
            h0 = __expf(bf_lo(la)) * h0 + bf_lo(bi); h1 = __expf(bf_hi(la)) * h1 + bf_hi(bi);
            *(unsigned*)(Y + base + (size_t)t * DM) = cvt_pk_bf16(h0 * fsilu(bf_lo(gg)), h1 * fsilu(bf_hi(gg))); }
    }
}


#define XB_TMO      128
#define XB_XCNT(j)  (256  + 64 * (j))
#define XB_XSUB(j)  (1280 + 64 * (j))
#define XB_XGEN(j)  (2304 + 64 * (j))
#define XB_TOP      3328
#define XB_TOPGEN   3392
#define XCD_BAR_WORDS 3456
#define XB_SPIN_CAP (1u << 18)
constexpr size_t WS_BAR = 16384;
constexpr int LDS_MISC = 131072 + 320;
__device__ __forceinline__ unsigned xb_ld(unsigned* p)              { return __hip_atomic_load(p, __ATOMIC_RELAXED, __HIP_MEMORY_SCOPE_AGENT); }
__device__ __forceinline__ unsigned xb_add(unsigned* p, unsigned v) { return __hip_atomic_fetch_add(p, v, __ATOMIC_RELAXED, __HIP_MEMORY_SCOPE_AGENT); }
__device__ __forceinline__ unsigned xb_xcc_id() { return (unsigned)__builtin_amdgcn_s_getreg((3 << 11) | 20) & 0xFu; }
#define XB_SPIN(cond, bar) do { unsigned _sp = 0; while (cond) { __builtin_amdgcn_s_sleep(1); \
    if ((++_sp & 255u) == 0u) { if (xb_ld(&(bar)[XB_TMO])) break; if (_sp > XB_SPIN_CAP) { atomicAdd(&(bar)[XB_TMO], 1u); break; } } } } while (0)
__device__ __forceinline__ void xcd_barrier_complete(unsigned* bar, unsigned x, unsigned& nloc, unsigned& nx) {
    const unsigned G = gridDim.x * gridDim.y * gridDim.z;
    unsigned sum, cnt, mine, sp = 0u;
    for (;;) {
        sum = 0u; cnt = 0u; mine = 0u;
#pragma unroll
        for (unsigned j = 0; j < 16; ++j) { const unsigned c = xb_ld(&bar[XB_XCNT(j)]); sum += c; cnt += (c > 0u) ? 1u : 0u; mine = (j == x) ? c : mine; }
        if (sum == G) break;
        __builtin_amdgcn_s_sleep(1);
        if ((++sp & 255u) == 0u) { if (xb_ld(&bar[XB_TMO])) break; if (sp > XB_SPIN_CAP) { atomicAdd(&bar[XB_TMO], 1u); break; } }
    }
    nloc = mine > 0u ? mine : 1u; nx = cnt > 0u ? cnt : 1u;
}
__device__ __forceinline__ void xcd_barrier(unsigned* bar, volatile LAS unsigned* st, int tid) {
    asm volatile("s_waitcnt vmcnt(0)" ::: "memory");
    __syncthreads();
    if (tid == 0) {
        const unsigned x = xb_xcc_id();
        __builtin_amdgcn_s_waitcnt(0);
        unsigned nloc = st[0], nx = st[1];
        if (nloc == 0u) { xcd_barrier_complete(bar, x, nloc, nx); st[0] = nloc; st[1] = nx; }
        const unsigned old = xb_add(&bar[XB_XSUB(x)], 1u);
        const unsigned gen = old / nloc;
        if (old + 1u == (gen + 1u) * nloc) {
            __builtin_amdgcn_fence(__ATOMIC_RELEASE, "agent");
            asm volatile("s_waitcnt vmcnt(0)" ::: "memory");
            const unsigned og = xb_add(&bar[XB_TOP], 1u);
            const unsigned tg = og / nx;
            if (og + 1u == (tg + 1u) * nx) xb_add(&bar[XB_TOPGEN], 1u);
            else XB_SPIN(xb_ld(&bar[XB_TOPGEN]) == tg, bar);
            __builtin_amdgcn_fence(__ATOMIC_ACQUIRE, "agent");
            xb_add(&bar[XB_XGEN(x)], 1u);
            asm volatile("s_waitcnt vmcnt(0)" ::: "memory");
        } else {
            XB_SPIN(xb_ld(&bar[XB_XGEN(x)]) == gen, bar);
            __builtin_amdgcn_fence(__ATOMIC_ACQUIRE, "agent");
            asm volatile("s_waitcnt vmcnt(0)" ::: "memory");
        }
    }
    __syncthreads();
}

constexpr int NPHASE = 24;
#ifndef PH_EN
#define PH_EN 0xFFFF
#endif
#define EN(b) ((PH_EN >> (b)) & 1)
template <int ph>
__device__ __forceinline__ void run_phase(unsigned char* lds, int wv) {
    LAS unsigned char* ldsl = (LAS unsigned char*)lds;
    {
        ArgsP ap = (ArgsP)__builtin_amdgcn_kernarg_segment_ptr();
        asm volatile("" : "+s"(ap));
        const int G = gridDim.x;
        unsigned char* ws = (unsigned char*)ap->ws;
        float* modv = (float*)(ws + WS_MODV);
        float* kmean = (float*)(ws + WS_KMEAN);
        bf16_t* HN = (bf16_t*)(ws + WS_HN); bf16_t* HKV = (bf16_t*)(ws + WS_HKV); bf16_t* UPRE = (bf16_t*)(ws + WS_UPRE); bf16_t* GB = (bf16_t*)(ws + WS_G);
        bf16_t* LAb = (bf16_t*)(ws + WS_LA); bf16_t* BINb = (bf16_t*)(ws + WS_BIN);
        float* xw = (float*)ap->out;
        const int tid = opq_tid(wv), c = opq_bid();
        const int lane = tid & 63, wave = __builtin_amdgcn_readfirstlane(tid >> 6);
        if (ph == 0) {
            if (EN(0)) prep_phase(ap, ldsl, wave, lane);
        } else if (ph <= 14) {
            const int l = (ph - 1) / 7, k = (ph - 1) % 7;
            const float* xin = (l == 0) ? AIN(0) : xw;
            if (k == 0) {
                if (EN(1)) norm_phase(xin, HN, AIN(4) + l * DM, modv, l * 3 * DM, l * 3 * DM + DM, nullptr, nullptr, 0, 0, wave, lane);
            } else if (k == 1) {
                pg8::Gemm g{HN, (const bf16_t*)(ws + WS_WIN) + (size_t)l * 2 * DM * DM, DM, DM, DM, 0, 0};
                pg8::MultiOrder S; S.init(MTOK, 2 * DM, 1, G, c);
                pg8::EpiSplit E{UPRE, GB};
                if (EN(2)) pg8::gemm_phase(ldsl, g, S, E, wv);
            } else if (k == 2) {
                if (EN(3)) conv_phase(UPRE, HKV, AIN(6) + l * 4 * DM, AIN(7) + l * DM, tid);
            } else if (k == 3) {
                pg8::Gemm g{HKV, (const bf16_t*)(ws + WS_WG) + (size_t)l * 4 * 512 * 256, DM, 256, 256, 256 * 2, 512 * 256 * 2};
                pg8::MultiOrder S; S.init(MTOK, 512, 4, G, c);
                pg8::EpiGates E{HKV, LAb, BINb, AIN(9) + l * DM, AIN(11) + l * DM, AIN(12) + l * DM};
                if (EN(4)) pg8::gemm_phase(ldsl, g, S, E, wv);
            } else if (k == 4) {
                if (EN(5)) scanA_phase(LAb, BINb, (float*)(ws + WS_AGGA), (float*)(ws + WS_AGGB), tid);
            } else if (k == 5) {
                if (EN(6)) scanB_phase(LAb, BINb, GB, (const float*)(ws + WS_AGGA), (const float*)(ws + WS_AGGB), HN, tid);
            } else {
                pg8::Gemm g{HN, (const bf16_t*)(ws + WS_WOUT) + (size_t)l * DM * DM, DM, DM, DM, 0, 0};
                pg8::MultiOrder S; S.init(MTOK, DM, 1, G, c);
                pg8::EpiRes E{xin, xw, modv + l * 3 * DM + 2 * DM};
                if (EN(7)) pg8::gemm_phase(ldsl, g, S, E, wv);
            }
        } else if (ph <= 22) {
            const int i = (ph - 15) / 4, k = (ph - 15) % 4, l = 2 + i;
            if (k == 0) {
                if (EN(8)) norm_phase(xw, HN, AIN(4) + l * DM, modv, l * 3 * DM, l * 3 * DM + DM,
                           i == 0 ? HKV : nullptr, AIN(14), 4 * 3 * DM, 4 * 3 * DM + DM, wave, lane);
            } else if (k == 1) {
                pg8::Gemm g{HN, (const bf16_t*)(ws + (i == 0 ? WS_ATTIN0 : WS_ATTIN1)), DM, DM, DM, (long)(WS_HKV - WS_HN), (long)(WS_WKV - WS_ATTIN0)};
                pg8::MultiOrder S; S.init(MTOK, 2 * DM, i == 0 ? 2 : 1, G, c);
                pg8::EpiQKV E{ws, kmean};
                if (EN(9)) pg8::gemm_phase(ldsl, g, S, E, wv);
            } else if (k == 2) {
                if (EN(10)) att::attn_phase((char*)lds, UPRE, LAb, BINb, HN, GB, kmean, wv);
            } else {
                pg8::Gemm g{HN, (const bf16_t*)(ws + WS_ATTOUT) + (size_t)i * DM * DM, DM, DM, DM, 0, 0};
                pg8::MultiOrder S; S.init(MTOK, DM, 1, G, c);
                pg8::EpiRes E{xw, xw, modv + l * 3 * DM + 2 * DM};
                if (EN(11)) pg8::gemm_phase(ldsl, g, S, E, wv);
            }
        } else {
            if (EN(12)) final_norm_phase(xw, AIN(20), wave, lane);
        }
    }
}
__global__ void __launch_bounds__(NTHR, 2) yoco_fwd(Args a_) {
    extern __shared__ __attribute__((aligned(16))) unsigned char lds[];
    const int ph_lo = a_.ph_lo, ph_hi = a_.ph_hi;
    const int wv = __builtin_amdgcn_readfirstlane((int)threadIdx.x >> 6);
    if (ph_hi - ph_lo > 1) {
        if (threadIdx.x < 2) ((volatile LAS unsigned*)((LAS unsigned char*)lds + LDS_MISC))[threadIdx.x] = 0u;
        if (threadIdx.x == 0) (void)xb_add(&((unsigned*)(a_.ws + WS_BAR))[XB_XCNT(xb_xcc_id())], 1u);
        __syncthreads();
    }
#define SEAM(P) do { if ((P) == 0) cg::this_grid().sync(); else { ArgsP ap_ = (ArgsP)__builtin_amdgcn_kernarg_segment_ptr(); asm volatile("" : "+s"(ap_)); \
        xcd_barrier((unsigned*)((unsigned char*)ap_->ws + WS_BAR), (volatile LAS unsigned*)((LAS unsigned char*)lds + LDS_MISC), opq_tid(wv)); } } while (0)
#define RUN(P) if ((P) >= ph_lo && (P) < ph_hi) { run_phase<P>(lds, wv); if ((P) + 1 < ph_hi) SEAM(P); }
    RUN(0) RUN(1) RUN(2) RUN(3) RUN(4) RUN(5) RUN(6) RUN(7) RUN(8) RUN(9) RUN(10) RUN(11)
    RUN(12) RUN(13) RUN(14) RUN(15) RUN(16) RUN(17) RUN(18) RUN(19) RUN(20) RUN(21) RUN(22) RUN(23)
#undef RUN
#undef SEAM
}

extern "C" void kernel_launch(void* const* d_in, const int* in_sizes, int n_in, void* d_out, int out_size, void* d_ws, size_t ws_size, hipStream_t stream) {
    static int grid = 0;
    if (grid == 0) {
        if (n_in != 21 || out_size != MTOK * DM || ws_size < WS_END) { fprintf(stderr, "kernel_launch: unexpected shapes (n_in %d out %d ws %zu)\n", n_in, out_size, ws_size); grid = -1; return; }
        int dev = 0, cus = 0, per_cu = 0;
        (void)hipGetDevice(&dev);
        if (hipDeviceGetAttribute(&cus, hipDeviceAttributeMultiprocessorCount, dev) != hipSuccess || cus <= 0) cus = 256;
        if (hipFuncSetAttribute((const void*)yoco_fwd, hipFuncAttributeMaxDynamicSharedMemorySize, LDS_BYTES) != hipSuccess) { fprintf(stderr, "kernel_launch: hipFuncSetAttribute failed\n"); grid = -1; return; }
        if (hipOccupancyMaxActiveBlocksPerMultiprocessor(&per_cu, (const void*)yoco_fwd, NTHR, LDS_BYTES) != hipSuccess || per_cu < 1) { fprintf(stderr, "kernel_launch: occupancy query says %d\n", per_cu); per_cu = 1; }
        (void)hipGetLastError();
        grid = cus;
    }
    if (grid < 0) return;
    (void)hipMemsetAsync((char*)d_ws + WS_CTL, 0, CTL_ZERO_BYTES, stream);
    Args a{};
    for (int i = 0; i < 21; ++i) a.in[i] = (const float*)d_in[i];
    a.out = (float*)d_out; a.ws = (unsigned char*)d_ws;
#if MK_MULTI_LAUNCH
    for (int ph = 0; ph < NPHASE; ++ph) { a.ph_lo = ph; a.ph_hi = ph + 1; hipLaunchKernelGGL(yoco_fwd, dim3(grid), dim3(NTHR), LDS_BYTES, stream, a); }
#else
    a.ph_lo = 0; a.ph_hi = NPHASE;
    void* kargs[] = {&a};
    hipError_t e = hipLaunchCooperativeKernel((const void*)yoco_fwd, dim3(grid), dim3(NTHR), kargs, LDS_BYTES, stream);
    if (e != hipSuccess) fprintf(stderr, "kernel_launch: cooperative launch failed: %s (grid %d)\n", hipGetErrorString(e), grid);
#endif
}
```

```cpp
#include <hip/hip_runtime.h>
#include <hip/hip_cooperative_groups.h>
#include <cstdio>
#include <cstdint>
namespace cg = cooperative_groups;

#ifndef MK_MULTI_LAUNCH
#define MK_MULTI_LAUNCH 0
#endif

constexpr int DM = 1024, NB = 8, SEQ = 2048, MTOK = NB * SEQ, NH = 8, DH = 128;
constexpr int MODV_LD = 14336;
constexpr float EPS = 1e-6f;
constexpr int NWAVES = 8, NTHR = 512;
constexpr int LDS_BYTES = 147456;

constexpr size_t MiB = 1u << 20;
constexpr size_t WS_CTL = 0, CTL_ZERO_BYTES = 1 * MiB;
constexpr size_t WS_MODV = 64 * 1024;
constexpr size_t WS_KMEAN = 512 * 1024;
constexpr size_t WS_AGGA = 1 * MiB, WS_AGGB = 2 * MiB;
constexpr size_t WS_WIN = 3 * MiB;
constexpr size_t WS_WG = 11 * MiB;
constexpr size_t WS_WOUT = 13 * MiB;
constexpr size_t WS_ATTIN0 = 17 * MiB, WS_WKV = 21 * MiB, WS_ATTIN1 = 25 * MiB;
constexpr size_t WS_ATTOUT = 29 * MiB;
constexpr size_t WS_HN = 33 * MiB;
constexpr size_t WS_HKV = 65 * MiB;
constexpr size_t WS_UPRE = 97 * MiB;
constexpr size_t WS_G = 129 * MiB;
constexpr size_t WS_LA = 161 * MiB;
constexpr size_t WS_BIN = 193 * MiB;
constexpr size_t WS_END = 225 * MiB;

typedef unsigned short bf16_t;
typedef short bf16x8 __attribute__((ext_vector_type(8)));
typedef short s16x4 __attribute__((ext_vector_type(4)));
typedef float f32x4 __attribute__((ext_vector_type(4)));
typedef float f32x2 __attribute__((ext_vector_type(2)));
typedef float f32x16 __attribute__((ext_vector_type(16)));
typedef unsigned u32x4 __attribute__((ext_vector_type(4)));
typedef unsigned u32x2 __attribute__((ext_vector_type(2)));
#define LAS __attribute__((address_space(3)))

__device__ __forceinline__ unsigned cvt_pk_bf16(float lo, float hi) { unsigned r; asm volatile("v_cvt_pk_bf16_f32 %0, %1, %2" : "=v"(r) : "v"(lo), "v"(hi)); return r; }
__device__ __forceinline__ float bf_lo(unsigned w) { return __uint_as_float(w << 16); }
__device__ __forceinline__ float bf_hi(unsigned w) { return __uint_as_float(w & 0xffff0000u); }
__device__ __forceinline__ float bf1(bf16_t h) { return __uint_as_float((unsigned)h << 16); }
__device__ __forceinline__ float fsigmoid(float x) { return __builtin_amdgcn_rcpf(1.f + __expf(-x)); }
__device__ __forceinline__ float fsilu(float x) { return x * fsigmoid(x); }
__device__ __forceinline__ int opq_tid(int wv) { int l; asm volatile("v_mbcnt_lo_u32_b32 %0, -1, 0\n\tv_mbcnt_hi_u32_b32 %0, -1, %0" : "=v"(l)); return wv * 64 + l; }
__device__ __forceinline__ int opq_bid() { int b = blockIdx.x; asm volatile("" : "+s"(b)); return b; }
__device__ __forceinline__ float wave_sum(float v) {
#pragma unroll
    for (int o = 1; o < 64; o <<= 1) v += __shfl_xor(v, o);
    return v;
}

namespace pg8 {
constexpr int BM = 256, BK = 64, HALF = 128, HTB = HALF * BK * 2, STAGE_BYTES = 8 * HTB, NXCD = 8, WGM = 8;
__host__ __device__ __forceinline__ int lds_byte(int r, int c) { const int st = (r >> 4) * 2 + (c >> 5), rr = r & 15, cc = c & 31, ob = rr * 64 + cc * 2; return st * 1024 + (ob ^ (((ob >> 9) & 1) << 5)); }
__host__ __device__ __forceinline__ void stage_rc(int b, int& R, int& C) { const int st = b / 1024, sb = b % 1024, swz = sb ^ (((sb >> 9) & 1) << 5); R = (st >> 1) * 16 + swz / 64; C = (st & 1) * 32 + (swz % 64) / 2; }
__host__ __device__ __forceinline__ int perm32(int rho) { const int n = rho >> 4, i = rho & 15; return 8 * (i >> 2) + 4 * n + (i & 3); }

struct Unit { int pm, pn, sub; };
struct Gemm { const bf16_t* A; const bf16_t* Bt; int lda, ldb, K; long a_sub, b_sub; };

struct MultiOrder {
    int nM, nN, nwg, nsub, G, c;
    __device__ void init(int M, int N, int nsub_, int G_, int c_) { nM = M / BM; nN = N / BM; nwg = nM * nN; nsub = nsub_; G = G_; c = c_; }
    __device__ bool next(int i, Unit& u) const {
        const long L = (long)i * G + c; if (L >= (long)nwg * nsub) return false;
        u.sub = (int)(L / nwg);
        int wgid = (int)(L % nwg); { const int q = nwg / NXCD, r = nwg % NXCD, xcd = wgid % NXCD, off = wgid / NXCD; wgid = (xcd < r ? xcd * (q + 1) : r * (q + 1) + (xcd - r) * q) + off; }
        const int nig = WGM * nN, gid = wgid / nig, fm = gid * WGM, gsz = (nM - fm) < WGM ? (nM - fm) : WGM;
        u.pm = fm + ((wgid % nig) % gsz); u.pn = (wgid % nig) / gsz; return true;
    }
};


struct EpiSplit {
    static constexpr bool PERM = true;
    bf16_t* O0; bf16_t* O1;
    __device__ __forceinline__ void operator()(const f32x4 (&acc)[2][2][4][2], const Unit& u, int wr, int wc, int fr, int fq) const {
        const int row0 = u.pm * BM + wr * 64 + fr; int colt = u.pn * BM; bf16_t* base = O0;
        if (colt >= DM) { base = O1; colt -= DM; }
        const int col0 = colt + wc * 32 + 8 * fq;
#pragma unroll
        for (int ai = 0; ai < 2; ++ai)
#pragma unroll
            for (int m = 0; m < 4; ++m) { bf16_t* rowp = base + (size_t)(row0 + ai * HALF + m * 16) * DM + col0;
#pragma unroll
                for (int bj = 0; bj < 2; ++bj) { const f32x4 v0 = acc[ai][bj][m][0], v1 = acc[ai][bj][m][1];
                    u32x4 w; w.x = cvt_pk_bf16(v0[0], v0[1]); w.y = cvt_pk_bf16(v0[2], v0[3]); w.z = cvt_pk_bf16(v1[0], v1[1]); w.w = cvt_pk_bf16(v1[2], v1[3]);
                    *(u32x4*)(rowp + bj * HALF) = w; } }
    }
};

struct EpiRes {
    static constexpr bool PERM = false;
    const float* xin; float* out; const float* gate;
    __device__ __forceinline__ void operator()(const f32x4 (&acc)[2][2][4][2], const Unit& u, int wr, int wc, int fr, int fq) const {
        const int b = u.pm >> 3, col0 = u.pn * BM + wc * 32 + 4 * fq;
        f32x4 gv[2][2];
#pragma unroll
        for (int bj = 0; bj < 2; ++bj)
#pragma unroll
            for (int n = 0; n < 2; ++n) gv[bj][n] = *(const f32x4*)(gate + (size_t)b * MODV_LD + col0 + bj * HALF + n * 16);
#pragma unroll
        for (int ai = 0; ai < 2; ++ai)
#pragma unroll
            for (int m = 0; m < 4; ++m) { const size_t off = (size_t)(u.pm * BM + ai * HALF + wr * 64 + m * 16 + fr) * DM + col0;
#pragma unroll
                for (int bj = 0; bj < 2; ++bj)
#pragma unroll
                    for (int n = 0; n < 2; ++n) { const f32x4 xv = *(const f32x4*)(xin + off + bj * HALF + n * 16);
                        *(f32x4*)(out + off + bj * HALF + n * 16) = xv + gv[bj][n] * acc[ai][bj][m][n]; } }
    }
};

struct EpiGates {
    static constexpr bool PERM = true;
    const bf16_t* U; bf16_t* LA; bf16_t* BIN; const float* ba; const float* bx; const float* lam;
    __device__ __forceinline__ void operator()(const f32x4 (&acc)[2][2][4][2], const Unit& u, int wr, int wc, int fr, int fq) const {
        const int ch0 = u.sub * 256 + u.pn * 128 + wc * 32 + 8 * fq;
        float pba[8], pbx[8], psp[8];
#pragma unroll
        for (int j = 0; j < 8; ++j) { pba[j] = ba[ch0 + j]; pbx[j] = bx[ch0 + j]; const float z = -lam[ch0 + j];
            psp[j] = 8.f * (z > 20.f ? z : __logf(1.f + __expf(z))); }
#pragma unroll
        for (int ai = 0; ai < 2; ++ai)
#pragma unroll
            for (int m = 0; m < 4; ++m) { const size_t off = (size_t)(u.pm * BM + ai * HALF + wr * 64 + m * 16 + fr) * DM + ch0;
                const u32x4 uw = *(const u32x4*)(U + off);
                const float uv[8] = {bf_lo(uw.x), bf_hi(uw.x), bf_lo(uw.y), bf_hi(uw.y), bf_lo(uw.z), bf_hi(uw.z), bf_lo(uw.w), bf_hi(uw.w)};
                float lav[8], bnv[8];
#pragma unroll
                for (int j = 0; j < 8; ++j) { const float r = fsigmoid(acc[ai][0][m][j >> 2][j & 3] + pba[j]), gi = fsigmoid(acc[ai][1][m][j >> 2][j & 3] + pbx[j]);
                    const float la = -psp[j] * r, z = 2.f * la;
                    const float om = (z > -0.03f) ? -z * (1.f + z * (0.5f + z * (0.16666667f + z * 0.041666667f))) : 1.f - __expf(z);
                    lav[j] = la; bnv[j] = __builtin_sqrtf(om) * gi * uv[j]; }
                u32x4 w0, w1;
                w0.x = cvt_pk_bf16(lav[0], lav[1]); w0.y = cvt_pk_bf16(lav[2], lav[3]); w0.z = cvt_pk_bf16(lav[4], lav[5]); w0.w = cvt_pk_bf16(lav[6], lav[7]);
                w1.x = cvt_pk_bf16(bnv[0], bnv[1]); w1.y = cvt_pk_bf16(bnv[2], bnv[3]); w1.z = cvt_pk_bf16(bnv[4], bnv[5]); w1.w = cvt_pk_bf16(bnv[6], bnv[7]);
                *(u32x4*)(LA + off) = w0; *(u32x4*)(BIN + off) = w1;
                asm volatile("" ::: "memory"); __builtin_amdgcn_sched_barrier(0); }
    }
};

struct EpiQKV {
    static constexpr bool PERM = true;
    unsigned char* ws; float* kmean;
    __device__ __forceinline__ void operator()(const f32x4 (&acc)[2][2][4][2], const Unit& u, int wr, int wc, int fr, int fq) const {
        const int b = u.pm >> 3, sblk = u.pm & 7, pq = u.pn & 3; const bool second = u.pn >= 4;
        const int dcol = wc * 32 + 8 * fq;
        if (u.sub == 0 && second) {
#pragma unroll
            for (int ai = 0; ai < 2; ++ai)
#pragma unroll
                for (int m = 0; m < 4; ++m) { bf16_t* rowp = (bf16_t*)(ws + WS_G) + (size_t)(u.pm * BM + ai * HALF + wr * 64 + m * 16 + fr) * DM + pq * 256 + dcol;
#pragma unroll
                    for (int bj = 0; bj < 2; ++bj) { const f32x4 v0 = acc[ai][bj][m][0], v1 = acc[ai][bj][m][1];
                        u32x4 w; w.x = cvt_pk_bf16(v0[0], v0[1]); w.y = cvt_pk_bf16(v0[2], v0[3]); w.z = cvt_pk_bf16(v1[0], v1[1]); w.w = cvt_pk_bf16(v1[2], v1[3]);
                        *(u32x4*)(rowp + bj * HALF) = w; } }
            return;
        }
        const size_t boff = (u.sub == 0) ? WS_UPRE : (second ? WS_BIN : WS_LA);
        bf16_t* base = (bf16_t*)(ws + boff);
#pragma unroll
        for (int bj = 0; bj < 2; ++bj) { const int head = 2 * pq + bj;
            bf16_t* hb = base + ((size_t)(b * NH + head) * SEQ + sblk * 256) * DH + dcol;
#pragma unroll
            for (int ai = 0; ai < 2; ++ai)
#pragma unroll
                for (int m = 0; m < 4; ++m) { const f32x4 v0 = acc[ai][bj][m][0], v1 = acc[ai][bj][m][1];
                    u32x4 w; w.x = cvt_pk_bf16(v0[0], v0[1]); w.y = cvt_pk_bf16(v0[2], v0[3]); w.z = cvt_pk_bf16(v1[0], v1[1]); w.w = cvt_pk_bf16(v1[2], v1[3]);
                    *(u32x4*)(hb + (size_t)(ai * HALF + wr * 64 + m * 16 + fr) * DH) = w; } }
        if (u.sub == 1 && !second) {
#pragma unroll
            for (int bj = 0; bj < 2; ++bj) { const int head = 2 * pq + bj;
#pragma unroll
                for (int n = 0; n < 2; ++n) { f32x4 s = (f32x4){0.f, 0.f, 0.f, 0.f};
#pragma unroll
                    for (int ai = 0; ai < 2; ++ai)
#pragma unroll
                        for (int m = 0; m < 4; ++m) s += acc[ai][bj][m][n];
#pragma unroll
                    for (int j = 0; j < 4; ++j) { float t = s[j]; t += __shfl_xor(t, 1); t += __shfl_xor(t, 2); t += __shfl_xor(t, 4); t += __shfl_xor(t, 8);
                        if (fr == 0) atomicAdd(kmean + ((size_t)(b * NH + head) * 8 + sblk) * DH + dcol + 4 * n + j, t * (1.f / 256.f)); } } }
        }
    }
};

template <class Epi, class Sched>
__device__ __forceinline__ void gemm_phase(LAS unsigned char* lds, const Gemm g, const Sched& S, const Epi& E, int wv) {
    const int tid = opq_tid(wv), wid = __builtin_amdgcn_readfirstlane(tid >> 6), lane = tid & 63, wr = wid >> 2, wc = wid & 3, fr = lane & 15, fq = lane >> 4;
    const int K = g.K, nt = K / BK;
    unsigned voffA[2], voffB[2];
#pragma unroll
    for (int i = 0; i < 2; ++i) { int R, C; stage_rc(tid * 16 + i * 8192, R, C); const int Rb = Epi::PERM ? ((R & ~31) + perm32(R & 31)) : R;
        voffA[i] = (unsigned)(R * g.lda + C) * 2u; voffB[i] = (unsigned)(Rb * g.ldb + C) * 2u; }
    const size_t kstep = (size_t)(BK * 2);
    const size_t hstepA = (size_t)HALF * g.lda * 2, hstepB = (size_t)HALF * g.ldb * 2;
    const size_t tstepA = 2 * hstepA, tstepB = 2 * hstepB;
    const unsigned ldsw = (unsigned)wid * 1024u;
    const int aoff = lds_byte(wr * 64 + fr, fq * 8), boff = lds_byte(wc * 32 + fr, fq * 8);
#define PG8_SA(b, h) (((b) * 2 + (h)) * HTB)
#define PG8_SB(b, h) ((4 + (b) * 2 + (h)) * HTB)
#define PG8_STAGE(bufoff, gbase, voff) do { _Pragma("unroll") for (int _i = 0; _i < 2; ++_i) \
        __builtin_amdgcn_global_load_lds((const unsigned*)((const char*)(gbase) + (voff)[_i]), (LAS unsigned*)(lds + (bufoff) + ldsw + _i * 8192), 16, 0, 0); } while (0)
#define PG8_LDA(dst, b, h) do { _Pragma("unroll") for (int m = 0; m < 4; ++m) _Pragma("unroll") for (int k = 0; k < 2; ++k) dst[m][k] = *(const LAS bf16x8*)(lds + PG8_SA(b, h) + aoff + m * 2048 + k * 1024); } while (0)
#define PG8_LDB(dst, b, h) do { _Pragma("unroll") for (int n = 0; n < 2; ++n) _Pragma("unroll") for (int k = 0; k < 2; ++k) dst[n][k] = *(const LAS bf16x8*)(lds + PG8_SB(b, h) + boff + n * 2048 + k * 1024); } while (0)
#define PG8_MMA(ai, bj, At, Bt) do { __builtin_amdgcn_s_setprio(1); _Pragma("unroll") for (int m = 0; m < 4; ++m) _Pragma("unroll") for (int n = 0; n < 2; ++n) _Pragma("unroll") for (int k = 0; k < 2; ++k) \
        acc[ai][bj][m][n] = __builtin_amdgcn_mfma_f32_16x16x32_bf16(Bt[n][k], At[m][k], acc[ai][bj][m][n], 0, 0, 0); __builtin_amdgcn_s_setprio(0); } while (0)
#define PG8_WAIT_V(n) asm volatile("s_waitcnt vmcnt(" #n ")" ::: "memory")
#define PG8_WAIT_L(n) asm volatile("s_waitcnt lgkmcnt(" #n ")" ::: "memory")
#define PG8_BAR __builtin_amdgcn_s_barrier()
#define PG8_SCHED __builtin_amdgcn_sched_barrier(0)
#define PG8_UA(u) ((const char*)g.A + (size_t)(u).sub * g.a_sub + (size_t)(u).pm * tstepA)
#define PG8_UB(u) ((const char*)g.Bt + (size_t)(u).sub * g.b_sub + (size_t)(u).pn * tstepB)
    Unit cur, nxt; int ui = 0;
    if (!S.next(0, cur)) return;
    f32x4 acc[2][2][4][2];
#pragma unroll
    for (int a = 0; a < 2; ++a)
#pragma unroll
        for (int b = 0; b < 2; ++b)
#pragma unroll
            for (int m = 0; m < 4; ++m)
#pragma unroll
                for (int n = 0; n < 2; ++n) acc[a][b][m][n] = (f32x4){0.f, 0.f, 0.f, 0.f};
    bf16x8 At[4][2], B0[2][2], B1[2][2];
    const char* cA = PG8_UA(cur); const char* cB = PG8_UB(cur);
    PG8_STAGE(PG8_SB(0, 0), cB, voffB); PG8_STAGE(PG8_SB(0, 1), cB + hstepB, voffB); PG8_STAGE(PG8_SA(0, 0), cA, voffA); PG8_STAGE(PG8_SA(0, 1), cA + hstepA, voffA);
    if (wr == 1) PG8_BAR;
    PG8_WAIT_V(2); PG8_BAR;
    PG8_STAGE(PG8_SB(1, 0), cB + kstep, voffB); PG8_STAGE(PG8_SA(1, 0), cA + kstep, voffA); PG8_STAGE(PG8_SB(1, 1), cB + hstepB + kstep, voffB);
    PG8_WAIT_V(6); PG8_BAR;
    for (;;) {
        const bool has_next = S.next(ui + 1, nxt);
        const char* nA = has_next ? PG8_UA(nxt) : cA; const char* nB = has_next ? PG8_UB(nxt) : cB;
        for (int t = 0; t < nt; t += 2) {
            const bool last = (t == nt - 2);
            const char* a1 = cA + (size_t)(t + 1) * kstep;
            const char* a2 = last ? nA : cA + (size_t)(t + 2) * kstep; const char* b2 = last ? nB : cB + (size_t)(t + 2) * kstep;
            const char* a3 = a2 + kstep; const char* b3 = b2 + kstep;
            PG8_LDB(B0, 0, 0); PG8_LDB(B1, 0, 1); PG8_SCHED; PG8_LDA(At, 0, 0); PG8_STAGE(PG8_SA(1, 1), a1 + hstepA, voffA);
            PG8_WAIT_V(8); PG8_WAIT_L(0); PG8_BAR; PG8_MMA(0, 0, At, B0); PG8_MMA(0, 1, At, B1); PG8_BAR; PG8_SCHED;
            PG8_LDA(At, 0, 1); PG8_STAGE(PG8_SB(0, 0), b2, voffB); PG8_STAGE(PG8_SB(0, 1), b2 + hstepB, voffB); PG8_STAGE(PG8_SA(0, 0), a2, voffA);
            PG8_WAIT_V(8); PG8_WAIT_L(0); PG8_BAR; PG8_MMA(1, 0, At, B0); PG8_MMA(1, 1, At, B1); PG8_BAR; PG8_SCHED;
            PG8_LDB(B0, 1, 0); PG8_LDB(B1, 1, 1); PG8_SCHED; PG8_LDA(At, 1, 0); PG8_STAGE(PG8_SA(0, 1), a2 + hstepA, voffA);
            PG8_WAIT_V(8); PG8_WAIT_L(0); PG8_BAR; PG8_MMA(0, 0, At, B0); PG8_MMA(0, 1, At, B1); PG8_BAR; PG8_SCHED;
            PG8_LDA(At, 1, 1); PG8_STAGE(PG8_SB(1, 0), b3, voffB); PG8_STAGE(PG8_SB(1, 1), b3 + hstepB, voffB); PG8_STAGE(PG8_SA(1, 0), a3, voffA);
            PG8_WAIT_V(8); PG8_WAIT_L(0); PG8_BAR; PG8_MMA(1, 0, At, B0); PG8_MMA(1, 1, At, B1); PG8_BAR; PG8_SCHED;
        }
        if (wr == 0) PG8_BAR;
        { const int t2 = opq_tid(wv), w2 = __builtin_amdgcn_readfirstlane(t2 >> 6), l2 = t2 & 63; E(acc, cur, w2 >> 2, w2 & 3, l2 & 15, l2 >> 4); }
        if (!has_next) break;
#pragma unroll
        for (int a = 0; a < 2; ++a)
#pragma unroll
            for (int b = 0; b < 2; ++b)
#pragma unroll
                for (int m = 0; m < 4; ++m)
#pragma unroll
                    for (int n = 0; n < 2; ++n) acc[a][b][m][n] = (f32x4){0.f, 0.f, 0.f, 0.f};
        cur = nxt; cA = nA; cB = nB; ++ui;
        if (wr == 1) PG8_BAR;
    }
    PG8_WAIT_V(0);
    PG8_BAR;
#undef PG8_SA
#undef PG8_SB
#undef PG8_STAGE
#undef PG8_LDA
#undef PG8_LDB
#undef PG8_MMA
#undef PG8_WAIT_V
#undef PG8_WAIT_L
#undef PG8_BAR
#undef PG8_SCHED
#undef PG8_UA
#undef PG8_UB
}
}

namespace att {
constexpr float SCALE = 0.08838834764831845f;
constexpr float THR = 8.f;
constexpr int NW = 8, QBLK = 32, KVBLK = 64, QB = NW * QBLK, D = 128;
constexpr int SHM_V = KVBLK * D * 2, SHM_K = KVBLK * D * 2;
constexpr int ATT_LDS = 2 * SHM_V + 2 * SHM_K + NW * 64 * 4;
#define KSWZ(row, colB) ((row) * 256 + ((colB) ^ (((row) & 7) << 4)))
#define SBAR() __builtin_amdgcn_sched_barrier(0)
__device__ __forceinline__ int v_st(int k, int c) { const int kk = (k & ~0xC) | ((k & 4) << 1) | ((k & 8) >> 1); return ((kk >> 3) * 4 + (c >> 5)) * 512 + ((kk & 7) * 32 + (c & 31)) * 2; }
__device__ __forceinline__ int v_rd_base(int lane) { return ((lane & 3) << 3) | (((lane >> 2) & 3) << 6) | (((lane >> 4) & 1) << 5) | (((lane >> 5) & 1) << 8); }
constexpr int v_rd_off(int d0, int ks, int half) { return d0 * 512 + ks * 4096 + half * 2048; }
__device__ __forceinline__ int crow(int r, int hi) { return (r & 3) + 8 * (r >> 2) + 4 * hi; }
__device__ __forceinline__ bf16x8 load8(const bf16_t* p) { return *reinterpret_cast<const bf16x8*>(p); }
__device__ __forceinline__ void mask_tile(f32x16& p0, f32x16& p1, int dq) {
    const float NEG = -__builtin_inff();
#pragma unroll
    for (int r = 0; r < 16; ++r) {
        const int c = (r & 3) + 8 * (r >> 2);
        if (dq - c < 0) p0[r] = NEG;
        if (dq - c - 32 < 0) p1[r] = NEG;
    }
}
__device__ __forceinline__ void mask_all(f32x16& p0, f32x16& p1, bool off) {
    const float NEG = -__builtin_inff();
#pragma unroll
    for (int r = 0; r < 16; ++r) { p0[r] = off ? NEG : p0[r]; p1[r] = off ? NEG : p1[r]; }
}
__device__ __forceinline__ void partialSM(f32x16& p0, f32x16& p1, float& m_reg, float& mn, float& alpha) {
    float pmax = p0[0];
#pragma unroll
    for (int r = 1; r < 16; ++r) pmax = fmaxf(pmax, p0[r]);
#pragma unroll
    for (int r = 0; r < 16; ++r) pmax = fmaxf(pmax, p1[r]);
    { auto rr = __builtin_amdgcn_permlane32_swap(__float_as_uint(pmax), __float_as_uint(pmax), false, false);
      pmax = fmaxf(__uint_as_float(rr[0]), __uint_as_float(rr[1])); }
    constexpr float C2 = 1.4426950408889634f * SCALE;
    if (__builtin_expect(__all((pmax - m_reg) * SCALE <= THR), 1)) { mn = m_reg; alpha = 1.f; }
    else { mn = fmaxf(m_reg, pmax); alpha = __builtin_amdgcn_exp2f((m_reg - mn) * C2); m_reg = mn; }
    const float mnL = -mn * C2;
#pragma unroll
    for (int r = 0; r < 16; ++r) p0[r] = fmaf(p0[r], C2, mnL);
#pragma unroll
    for (int r = 0; r < 16; ++r) p1[r] = fmaf(p1[r], C2, mnL);
#pragma unroll
    for (int r = 0; r < 16; ++r) p0[r] = __builtin_amdgcn_exp2f(p0[r]);
}
__device__ __forceinline__ void finishSM(f32x16& p0, f32x16& p1, float alpha, float& l_reg, bf16x8& pa0, bf16x8& pa1, bf16x8& pa2, bf16x8& pa3) {
#pragma unroll
    for (int r = 0; r < 16; ++r) p1[r] = __builtin_amdgcn_exp2f(p1[r]);
    float ps = 0;
#pragma unroll
    for (int r = 0; r < 16; ++r) ps += p0[r];
#pragma unroll
    for (int r = 0; r < 16; ++r) ps += p1[r];
    { auto rr = __builtin_amdgcn_permlane32_swap(__float_as_uint(ps), __float_as_uint(ps), false, false);
      ps = __uint_as_float(rr[0]) + __uint_as_float(rr[1]); }
    l_reg = l_reg * alpha + ps;
#define PK4(P, B_, OUT) do { unsigned a0 = cvt_pk_bf16(P[B_+0], P[B_+1]), a1 = cvt_pk_bf16(P[B_+2], P[B_+3]);                          \
        unsigned b0 = cvt_pk_bf16(P[B_+4], P[B_+5]), b1 = cvt_pk_bf16(P[B_+6], P[B_+7]);                                             \
        auto r0 = __builtin_amdgcn_permlane32_swap(a0, b0, false, false); auto r1 = __builtin_amdgcn_permlane32_swap(a1, b1, false, false); \
        u32x4 w = {r0[0], r1[0], r0[1], r1[1]}; OUT = *reinterpret_cast<bf16x8*>(&w); } while (0)
    PK4(p0, 0, pa0); PK4(p0, 8, pa1); PK4(p1, 0, pa2); PK4(p1, 8, pa3);
#undef PK4
}
template <int KB>
__device__ __forceinline__ void qkt(f32x16& p0, f32x16& p1, const char* K_lds, int r32, int hi, const bf16x8* qr) {
    p0 = f32x16{}; p1 = f32x16{};
    const char* kb[4];
#pragma unroll
    for (int dd = 0; dd < 4; ++dd) kb[dd] = K_lds + KB * SHM_K + KSWZ(r32, (dd * 16 + hi * 8) * 2);
#pragma unroll
    for (int d0 = 0; d0 < 8; ++d0) { const char* a = kb[d0 & 3] + (d0 >> 2) * 128;
        bf16x8 b0 = *reinterpret_cast<const bf16x8*>(a);
        bf16x8 b1 = *reinterpret_cast<const bf16x8*>(a + 32 * 256);
        p0 = __builtin_amdgcn_mfma_f32_32x32x16_bf16(b0, qr[d0], p0, 0, 0, 0);
        p1 = __builtin_amdgcn_mfma_f32_32x32x16_bf16(b1, qr[d0], p1, 0, 0, 0); }
}
template <int VB>
__device__ __forceinline__ void pv_tile(f32x16* o, int vb0, bf16x8 pa0, bf16x8 pa1, bf16x8 pa2, bf16x8 pa3) {
#define TRRD(dst, off) asm volatile("ds_read_b64_tr_b16 %0, %1 offset:%2" : "=&v"(dst) : "v"(vb0), "i"(off) : "memory")
#define PV_D0(d0) do { s16x4 l0, l1, l2, l3, h0, h1, h2, h3; constexpr int b_ = VB * SHM_V + v_rd_off(d0, 0, 0); \
        TRRD(l0, b_); TRRD(h0, b_ + 2048); TRRD(l1, b_ + 4096); TRRD(h1, b_ + 6144); TRRD(l2, b_ + 8192); TRRD(h2, b_ + 10240); TRRD(l3, b_ + 12288); TRRD(h3, b_ + 14336); \
        asm volatile("s_waitcnt lgkmcnt(0)" ::: "memory"); SBAR();   \
        o[d0] = __builtin_amdgcn_mfma_f32_32x32x16_bf16(pa0, (bf16x8){l0[0], l0[1], l0[2], l0[3], h0[0], h0[1], h0[2], h0[3]}, o[d0], 0, 0, 0);   \
        o[d0] = __builtin_amdgcn_mfma_f32_32x32x16_bf16(pa1, (bf16x8){l1[0], l1[1], l1[2], l1[3], h1[0], h1[1], h1[2], h1[3]}, o[d0], 0, 0, 0);   \
        o[d0] = __builtin_amdgcn_mfma_f32_32x32x16_bf16(pa2, (bf16x8){l2[0], l2[1], l2[2], l2[3], h2[0], h2[1], h2[2], h2[3]}, o[d0], 0, 0, 0);   \
        o[d0] = __builtin_amdgcn_mfma_f32_32x32x16_bf16(pa3, (bf16x8){l3[0], l3[1], l3[2], l3[3], h3[0], h3[1], h3[2], h3[3]}, o[d0], 0, 0, 0); } while (0)
    PV_D0(0); PV_D0(1); PV_D0(2); PV_D0(3);
#undef PV_D0
#undef TRRD
}

struct BlockRef { const bf16_t* Q; const bf16_t* K; const bf16_t* V; bf16_t* O; const bf16_t* Gt; const float* KM; int P0; };
struct Seam { bf16x8 qr[8]; bf16x8 st_v0, st_v1, st_k0, st_k1; };
#define ROW(p, k0, rr) ((p) + (size_t)((k0) + (rr)) * D + sc)
#define VMW() asm volatile("s_waitcnt vmcnt(0)" ::: "memory")
#define VMWN(n) asm volatile("s_waitcnt vmcnt(%0)" :: "i"(n) : "memory")
#define SLOAD_H(Kp, Vp, k0) do { S.st_v0 = load8(ROW(Vp, k0, sr)); S.st_v1 = load8(ROW(Vp, k0, 32 + sr));              \
                         S.st_k0 = load8(ROW(Kp, k0, sr)); S.st_k1 = load8(ROW(Kp, k0, 32 + sr)); } while (0)
#define SWRITE_HK(bf) do { *(bf16x8*)(K_lds + (bf) * SHM_K + kws) = S.st_k0; *(bf16x8*)(K_lds + (bf) * SHM_K + kws + 32 * 256) = S.st_k1; } while (0)
#define SWRITE_HV(bf) do { *(bf16x8*)(V_lds + (bf) * SHM_V + vst0) = S.st_v0; *(bf16x8*)(V_lds + (bf) * SHM_V + vst1) = S.st_v1; } while (0)
#define SWRITE_H(bf) do { SWRITE_HV(bf); SWRITE_HK(bf); } while (0)
__device__ __forceinline__ void moba_prime(const BlockRef& cur, char* lds, Seam& S, int wv) {
    const int tid = opq_tid(wv), wid = __builtin_amdgcn_readfirstlane(tid >> 6), lane = tid & 63, r32 = lane & 31, hi = lane >> 5;
    const int sr = tid >> 4, sc = (tid & 15) * 8, kws = KSWZ(sr, sc * 2); char* K_lds = lds + 2 * SHM_V;
#pragma unroll
    for (int d0 = 0; d0 < 8; ++d0) S.qr[d0] = load8(cur.Q + (size_t)(wid * QBLK + r32) * D + d0 * 16 + hi * 8);
    SLOAD_H(cur.K, cur.V, 0); VMW(); SWRITE_HK(0);
    __syncthreads();
}
__device__ __forceinline__ unsigned moba_select(const Seam& S, const float* KM, int qb, int hi) {
    if (qb <= 3) return (1u << qb) - 1u;
    float sc_[8];
#pragma unroll
    for (int j = 0; j < 8; ++j) sc_[j] = 0.f;
#pragma unroll
    for (int j = 0; j < 7; ++j) {
        if (j < qb) {
            float s = 0.f;
#pragma unroll
            for (int d0 = 0; d0 < 8; ++d0) {
                const f32x4 k0 = *(const f32x4*)(KM + j * D + d0 * 16 + hi * 8), k1 = *(const f32x4*)(KM + j * D + d0 * 16 + hi * 8 + 4);
                const bf16x8 q = S.qr[d0];
                s += bf1((bf16_t)q[0]) * k0[0] + bf1((bf16_t)q[1]) * k0[1] + bf1((bf16_t)q[2]) * k0[2] + bf1((bf16_t)q[3]) * k0[3]
                   + bf1((bf16_t)q[4]) * k1[0] + bf1((bf16_t)q[5]) * k1[1] + bf1((bf16_t)q[6]) * k1[2] + bf1((bf16_t)q[7]) * k1[3];
            }
            s += __shfl_xor(s, 32);
            sc_[j] = s;
        }
    }
    unsigned sel = 0u;
#pragma unroll
    for (int it = 0; it < 3; ++it) {
        float best = -__builtin_inff(); int bi = 0;
#pragma unroll
        for (int j = 0; j < 7; ++j) { const bool ok = (j < qb) && !((sel >> j) & 1u) && (sc_[j] > best); best = ok ? sc_[j] : best; bi = ok ? j : bi; }
        sel |= 1u << bi;
    }
    return sel;
}
__device__ __forceinline__ void moba_block(const BlockRef& cur, const BlockRef& nxt, char* lds, Seam& S, int wv) {
    const int tid = opq_tid(wv), wid = __builtin_amdgcn_readfirstlane(tid >> 6), lane = tid & 63, r32 = lane & 31, hi = lane >> 5;
    const int NT = cur.P0 / KVBLK + 4;
    const int qb = cur.P0 >> 8;
    const int qlo = cur.P0 + wid * QBLK, qm = qlo + r32 - 4 * hi;
    char* V_lds = lds; char* K_lds = lds + 2 * SHM_V;
    float* ws = (float*)(lds + 2 * SHM_V + 2 * SHM_K) + wid * 64; float* li_l = ws, * al_l = ws + 32;
    float m_reg = -1e30f, l_reg = 0; f32x16 o[4] = {};
    const int sr = tid >> 4, sc = (tid & 15) * 8, vst0 = v_st(sr, sc), vst1 = v_st(32 + sr, sc), kws = KSWZ(sr, sc * 2);
    const int vb0 = (int)(uintptr_t)V_lds + v_rd_base(lane);
    const bf16_t* Kh = cur.K; const bf16_t* Vh = cur.V;
    const unsigned sel = moba_select(S, cur.KM, qb, hi);
    const bool need_sel = qb > 3;
#define RESC(a) do { if (__any((a) < 1.f)) { if (hi == 0) al_l[r32] = (a); asm volatile("s_waitcnt lgkmcnt(0)" ::: "memory");              \
                     for (int d_ = 0; d_ < 4; ++d_) for (int r = 0; r < 16; ++r) o[d_][r] *= al_l[crow(r, hi)]; } } while (0)
#define KBASE(t) ((t) * KVBLK)
#define MASKT(P0_, P1_, t) do { const int kb_ = KBASE(t); \
        if (kb_ < cur.P0) { if (need_sel) mask_all(P0_, P1_, ((sel >> (kb_ >> 8)) & 1u) == 0u); } \
        else if (kb_ + KVBLK - 1 > qlo) mask_tile(P0_, P1_, qm - kb_); } while (0)
#define SEAM_K0() do { VMWN(8); SWRITE_HK(0); SBAR(); } while (0)
    f32x16 pA0, pA1, pB0, pB1; float mnA, mnB, alA, alB; bf16x8 pa0, pa1, pa2, pa3;
    SWRITE_HV(0); SBAR();
    SLOAD_H(Kh, Vh, KBASE(1));
    SBAR(); qkt<0>(pA0, pA1, K_lds, r32, hi, S.qr);
    MASKT(pA0, pA1, 0); partialSM(pA0, pA1, m_reg, mnA, alA);
    VMW(); SWRITE_H(1);
    __syncthreads();
#define HALF_STEP(PX0, PX1, mnX, alX, PY0, PY1, alY, t, KB, VB, SB) do {                                                      \
        SBAR(); qkt<KB>(PX0, PX1, K_lds, r32, hi, S.qr);                                                                       \
        finishSM(PY0, PY1, alY, l_reg, pa0, pa1, pa2, pa3); SBAR();                                                           \
        if ((t) + 1 < NT) { SLOAD_H(Kh, Vh, KBASE((t) + 1)); SBAR(); }                                                        \
        pv_tile<VB>(o, vb0, pa0, pa1, pa2, pa3); MASKT(PX0, PX1, (t)); partialSM(PX0, PX1, m_reg, mnX, alX);                  \
        __syncthreads();                                                                                                      \
        if ((t) + 1 < NT) { VMW(); SWRITE_H(SB); }                                                                            \
        RESC(alX); __syncthreads(); } while (0)
    for (int t = 1; t + 1 < NT; t += 2) {
        HALF_STEP(pB0, pB1, mnB, alB, pA0, pA1, alA, t, 1, 0, 0);
        HALF_STEP(pA0, pA1, mnA, alA, pB0, pB1, alB, t + 1, 0, 1, 1);
    }
    SBAR(); qkt<1>(pB0, pB1, K_lds, r32, hi, S.qr); SBAR();
    SLOAD_H(nxt.K, nxt.V, 0); SBAR();
#pragma unroll
    for (int d0 = 0; d0 < 8; ++d0) S.qr[d0] = load8(nxt.Q + (size_t)(wid * QBLK + r32) * D + d0 * 16 + hi * 8);
    SBAR();
    finishSM(pA0, pA1, alA, l_reg, pa0, pa1, pa2, pa3); SBAR();
    pv_tile<0>(o, vb0, pa0, pa1, pa2, pa3);
    MASKT(pB0, pB1, NT - 1); partialSM(pB0, pB1, m_reg, mnB, alB); __syncthreads(); RESC(alB);
    finishSM(pB0, pB1, alB, l_reg, pa0, pa1, pa2, pa3); SBAR(); pv_tile<1>(o, vb0, pa0, pa1, pa2, pa3);
    SBAR(); SEAM_K0();
    if (hi == 0) li_l[r32] = l_reg; asm volatile("s_waitcnt lgkmcnt(0)" ::: "memory");
    bf16_t* Ow = cur.O + (size_t)(wid * QBLK) * DM; const bf16_t* Gw = cur.Gt + (size_t)(wid * QBLK) * DM;
#pragma unroll
    for (int r = 0; r < 16; ++r) { const int orow = crow(r, hi); const float rl = __builtin_amdgcn_rcpf(li_l[orow]);
#pragma unroll
        for (int d0 = 0; d0 < 4; ++d0) { const float gv = bf1(Gw[(size_t)orow * DM + d0 * 32 + r32]);
            const float v = o[d0][r] * rl * fsilu(gv);
            const float vn = __shfl_xor(v, 1);
            if ((r32 & 1) == 0) *(unsigned*)(Ow + (size_t)orow * DM + d0 * 32 + r32) = cvt_pk_bf16(v, vn); } }
    __syncthreads();
#undef RESC
#undef KBASE
#undef MASKT
#undef SEAM_K0
#undef HALF_STEP
}
#undef ROW
#undef VMW
#undef VMWN
#undef SLOAD_H
#undef SWRITE_HK
#undef SWRITE_HV
#undef SWRITE_H

__device__ __forceinline__ BlockRef mk_ref(int L, int pass, const bf16_t* Q, const bf16_t* K, const bf16_t* V, bf16_t* O, const bf16_t* Gt, const float* KM) {
    const int bh = L >> 2, x = L & 3, qb = pass ? 7 - x : x, b = bh >> 3, h = bh & 7;
    BlockRef r;
    r.Q = Q + ((size_t)bh * SEQ + (size_t)qb * QB) * D; r.K = K + (size_t)bh * SEQ * D; r.V = V + (size_t)bh * SEQ * D;
    r.O = O + ((size_t)b * SEQ + (size_t)qb * QB) * DM + h * DH; r.Gt = Gt + ((size_t)b * SEQ + (size_t)qb * QB) * DM + h * DH;
    r.KM = KM + (size_t)bh * 8 * D; r.P0 = qb * QB;
    return r;
}
__device__ __forceinline__ void attn_phase(char* lds, const bf16_t* Q, const bf16_t* K, const bf16_t* V, bf16_t* O, const bf16_t* Gt, const float* KM, int wv) {
    const int total = NB * NH * 4, stride = gridDim.x;
    int L = opq_bid(); if (L >= total) return;
    int pass = 0;
    BlockRef cur = mk_ref(L, 0, Q, K, V, O, Gt, KM);
    Seam S;
    moba_prime(cur, lds, S, wv);
    for (;;) {
        const bool more_pass = pass == 0, more_item = L + stride < total, last = !more_pass && !more_item;
        int passn = pass + 1, Ln = L;
        if (!more_pass) { passn = 0; Ln = more_item ? L + stride : L; }
        const BlockRef nxt = last ? cur : mk_ref(Ln, passn, Q, K, V, O, Gt, KM);
        moba_block(cur, nxt, lds, S, wv);
        if (last) break;
        cur = nxt; pass = passn; L = Ln;
    }
}
}

struct Args { const float* in[21]; float* out; unsigned char* ws; int ph_lo, ph_hi; };
typedef const __attribute__((address_space(4))) Args* ArgsP;
#define AIN(i) ((const float*)ap->in[i])

__device__ __forceinline__ void transpose_item(const float* W, int ldw, bf16_t* WT, int ldt, LAS float* scr, int lane) {
#pragma unroll 8
    for (int i = 0; i < 32; ++i) { const int kk = 2 * i + (lane >> 5); scr[kk * 33 + (lane & 31)] = W[(size_t)kk * ldw + (lane & 31)]; }
    asm volatile("s_waitcnt lgkmcnt(0)" ::: "memory");
    const int c = lane & 7;
#pragma unroll
    for (int j = 0; j < 4; ++j) { const int n = (lane >> 3) + 8 * j; const LAS float* s = scr + (8 * c) * 33 + n;
        u32x4 o; o.x = cvt_pk_bf16(s[0 * 33], s[1 * 33]); o.y = cvt_pk_bf16(s[2 * 33], s[3 * 33]); o.z = cvt_pk_bf16(s[4 * 33], s[5 * 33]); o.w = cvt_pk_bf16(s[6 * 33], s[7 * 33]);
        *(u32x4*)(WT + (size_t)n * ldt + 8 * c) = o; }
    asm volatile("s_waitcnt lgkmcnt(0)" ::: "memory");
}
__device__ __forceinline__ void transpose_mat(const float* W, int K, int N, bf16_t* WT, int item, LAS float* scr, int lane) {
    const int nblk = N / 32, kb = item / nblk, nb = item % nblk;
    transpose_item(W + (size_t)(64 * kb) * N + 32 * nb, N, WT + (size_t)(32 * nb) * K + 64 * kb, K, scr, lane);
}

__device__ __forceinline__ void prep_phase(ArgsP ap, LAS unsigned char* lds, int wave, int lane) {
    unsigned char* ws = (unsigned char*)ap->ws;
    LAS float* scr = (LAS float*)(lds + wave * 16384);
    const int gw = opq_bid() * NWAVES + wave, NGW = gridDim.x * NWAVES;
    constexpr int I_BIG = (DM / 64) * (2 * DM / 32);
    constexpr int I_SQ = (DM / 64) * (DM / 32);
    constexpr int I_G = (256 / 64) * (256 / 32);
    constexpr int N_T = 2 * I_BIG + 2 * I_SQ + 2 * I_BIG + I_BIG + 2 * I_SQ + 16 * I_G;
    constexpr int N_GEMV = (MODV_LD / 64) * 8;
    for (int it = gw; it < N_T + N_GEMV; it += NGW) {
        int r = it;
        if (r < 2 * I_BIG) { const int l = r / I_BIG; transpose_mat(AIN(5) + (size_t)l * DM * 2 * DM, DM, 2 * DM, (bf16_t*)(ws + WS_WIN) + (size_t)l * 2 * DM * DM, r % I_BIG, scr, lane); continue; } r -= 2 * I_BIG;
        if (r < 2 * I_SQ) { const int l = r / I_SQ; transpose_mat(AIN(13) + (size_t)l * DM * DM, DM, DM, (bf16_t*)(ws + WS_WOUT) + (size_t)l * DM * DM, r % I_SQ, scr, lane); continue; } r -= 2 * I_SQ;
        if (r < 2 * I_BIG) { const int l = r / I_BIG; transpose_mat(AIN(18) + (size_t)l * DM * 2 * DM, DM, 2 * DM, (bf16_t*)(ws + (l ? WS_ATTIN1 : WS_ATTIN0)), r % I_BIG, scr, lane); continue; } r -= 2 * I_BIG;
        if (r < I_BIG) { transpose_mat(AIN(17), DM, 2 * DM, (bf16_t*)(ws + WS_WKV), r, scr, lane); continue; } r -= I_BIG;
        if (r < 2 * I_SQ) { const int l = r / I_SQ; transpose_mat(AIN(19) + (size_t)l * DM * DM, DM, DM, (bf16_t*)(ws + WS_ATTOUT) + (size_t)l * DM * DM, r % I_SQ, scr, lane); continue; } r -= 2 * I_SQ;
        if (r < 16 * I_G) {
            const int mat = r / I_G, item = r % I_G, which = mat >> 3, lh = mat & 7;
            const float* W = (which ? AIN(10) : AIN(8)) + (size_t)lh * 256 * 256;
            bf16_t* WT = (bf16_t*)(ws + WS_WG) + (size_t)lh * 512 * 256;
            const int kb = item / 8, nb = item % 8, n0 = 32 * nb, drow = 256 * (n0 >> 7) + 128 * which + (n0 & 127);
            transpose_item(W + (size_t)(64 * kb) * 256 + n0, 256, WT + (size_t)drow * 256 + 64 * kb, 256, scr, lane);
            continue;
        } r -= 16 * I_G;
        { const int cgp = r >> 3, kc = r & 7, k0 = kc * 128;
          const float* W; int ldw, n0; const float* bias;
          if (cgp < 192) { const int l = cgp / 48; n0 = (cgp % 48) * 64; W = AIN(2) + (size_t)l * DM * 3 * DM; ldw = 3 * DM; bias = AIN(3) + l * 3 * DM; }
          else { n0 = (cgp - 192) * 64; W = AIN(15); ldw = 2 * DM; bias = AIN(16); }
          const float* c = AIN(1);
#pragma unroll
          for (int i = 0; i < 16; ++i) { const int idx = i * 64 + lane, b = idx >> 7, kk = idx & 127; scr[kk * 8 + b] = fsilu(c[b * DM + k0 + kk]); }
          asm volatile("s_waitcnt lgkmcnt(0)" ::: "memory");
          float acc[8];
#pragma unroll
          for (int b = 0; b < 8; ++b) acc[b] = 0.f;
          const float* wp = W + (size_t)k0 * ldw + n0 + lane;
#pragma unroll 8
          for (int kk = 0; kk < 128; ++kk) { const float w = wp[(size_t)kk * ldw];
              const f32x4 c0 = *(const LAS f32x4*)(scr + kk * 8), c1 = *(const LAS f32x4*)(scr + kk * 8 + 4);
              acc[0] += w * c0[0]; acc[1] += w * c0[1]; acc[2] += w * c0[2]; acc[3] += w * c0[3];
              acc[4] += w * c1[0]; acc[5] += w * c1[1]; acc[6] += w * c1[2]; acc[7] += w * c1[3]; }
          const float bv = (kc == 0) ? bias[n0 + lane] : 0.f;
          float* mv = (float*)(ws + WS_MODV) + cgp * 64 + lane;
#pragma unroll
          for (int b = 0; b < 8; ++b) atomicAdd(mv + (size_t)b * MODV_LD, acc[b] + bv);
          asm volatile("s_waitcnt lgkmcnt(0)" ::: "memory");
        }
    }
}

__device__ __forceinline__ void norm_phase(const float* xin, bf16_t* o1, const float* g1, const float* modv, int sh1, int sc1c,
                                            bf16_t* o2, const float* g2, int sh2, int sc2c, int wave, int lane) {
    const int gw = opq_bid() * NWAVES + wave, NGW = gridDim.x * NWAVES;
    for (int rb = gw; rb < MTOK / 8; rb += NGW) {
        const int r0 = rb * 8, b = r0 / SEQ;
        const float* mv = modv + (size_t)b * MODV_LD;
        f32x4 gs1[4], sf1[4], gs2[4], sf2[4];
#pragma unroll
        for (int j = 0; j < 4; ++j) { const int idx = 4 * lane + 256 * j;
            const f32x4 gv = *(const f32x4*)(g1 + idx), sc = *(const f32x4*)(mv + sc1c + idx); gs1[j] = gv * (sc + 1.f); sf1[j] = *(const f32x4*)(mv + sh1 + idx);
            if (o2) { const f32x4 gv2 = *(const f32x4*)(g2 + idx), sc2 = *(const f32x4*)(mv + sc2c + idx); gs2[j] = gv2 * (sc2 + 1.f); sf2[j] = *(const f32x4*)(mv + sh2 + idx); }
            else { gs2[j] = gs1[j]; sf2[j] = sf1[j]; } }
        for (int rr = 0; rr < 8; ++rr) {
            const size_t row = (size_t)(r0 + rr);
            const f32x4* xr = (const f32x4*)(xin + row * DM) + lane;
            f32x4 v[4]; float s = 0.f;
#pragma unroll
            for (int j = 0; j < 4; ++j) { v[j] = xr[64 * j]; s += (v[j].x * v[j].x + v[j].y * v[j].y) + (v[j].z * v[j].z + v[j].w * v[j].w); }
            const float rstd = 1.f / sqrtf(wave_sum(s) * (1.f / DM) + EPS);
#pragma unroll
            for (int j = 0; j < 4; ++j) { const f32x4 t = v[j] * rstd; const f32x4 y = t * gs1[j] + sf1[j];
                u32x2 w; w.x = cvt_pk_bf16(y.x, y.y); w.y = cvt_pk_bf16(y.z, y.w);
                *((u32x2*)(o1 + row * DM) + lane + 64 * j) = w;
                if (o2) { const f32x4 y2 = t * gs2[j] + sf2[j]; u32x2 w2; w2.x = cvt_pk_bf16(y2.x, y2.y); w2.y = cvt_pk_bf16(y2.z, y2.w);
                    *((u32x2*)(o2 + row * DM) + lane + 64 * j) = w2; } }
        }
    }
}
__device__ __forceinline__ void final_norm_phase(float* x, const float* g, int wave, int lane) {
    const int gw = opq_bid() * NWAVES + wave, NGW = gridDim.x * NWAVES;
    f32x4 gv[4];
#pragma unroll
    for (int j = 0; j < 4; ++j) gv[j] = *(const f32x4*)(g + 4 * lane + 256 * j);
    for (int row = gw; row < MTOK; row += NGW) {
        f32x4* xr = (f32x4*)(x + (size_t)row * DM) + lane;
        f32x4 v[4]; float s = 0.f;
#pragma unroll
        for (int j = 0; j < 4; ++j) { v[j] = xr[64 * j]; s += (v[j].x * v[j].x + v[j].y * v[j].y) + (v[j].z * v[j].z + v[j].w * v[j].w); }
        const float rstd = 1.f / sqrtf(wave_sum(s) * (1.f / DM) + EPS);
#pragma unroll
        for (int j = 0; j < 4; ++j) xr[64 * j] = v[j] * rstd * gv[j];
    }
}

__device__ __forceinline__ void conv_phase(const bf16_t* UP, bf16_t* U, const float* cw, const float* cb, int tid) {
    const int ch = 2 * tid;
    const f32x2 w0 = *(const f32x2*)(cw + ch), w1 = *(const f32x2*)(cw + DM + ch), w2 = *(const f32x2*)(cw + 2 * DM + ch), w3 = *(const f32x2*)(cw + 3 * DM + ch), bb = *(const f32x2*)(cb + ch);
    for (int it = opq_bid(); it < NB * 32; it += gridDim.x) {
        const int b = it >> 5, c = it & 31; const size_t base = ((size_t)b * SEQ + c * 64) * DM + ch;
        f32x2 x0 = {0.f, 0.f}, x1 = {0.f, 0.f}, x2 = {0.f, 0.f};
        if (c > 0) { const unsigned a0 = *(const unsigned*)(UP + base - 3 * DM), a1 = *(const unsigned*)(UP + base - 2 * DM), a2 = *(const unsigned*)(UP + base - DM);
            x0 = (f32x2){bf_lo(a0), bf_hi(a0)}; x1 = (f32x2){bf_lo(a1), bf_hi(a1)}; x2 = (f32x2){bf_lo(a2), bf_hi(a2)}; }
#pragma unroll 16
        for (int t = 0; t < 64; ++t) { const unsigned a = *(const unsigned*)(UP + base + (size_t)t * DM); const f32x2 x3 = {bf_lo(a), bf_hi(a)};
            const f32x2 y = bb + w0 * x0 + w1 * x1 + w2 * x2 + w3 * x3;
            *(unsigned*)(U + base + (size_t)t * DM) = cvt_pk_bf16(y.x, y.y);
            x0 = x1; x1 = x2; x2 = x3; }
    }
}
__device__ __forceinline__ void scanA_phase(const bf16_t* LA, const bf16_t* BIN, float* AGGA, float* AGGB, int tid) {
    const int ch = 2 * tid;
    for (int it = opq_bid(); it < NB * 32; it += gridDim.x) {
        const int b = it >> 5, c = it & 31; const size_t base = ((size_t)b * SEQ + c * 64) * DM + ch;
        float s0 = 0.f, s1 = 0.f, h0 = 0.f, h1 = 0.f;
#pragma unroll 16
        for (int t = 0; t < 64; ++t) { const unsigned la = *(const unsigned*)(LA + base + (size_t)t * DM), bi = *(const unsigned*)(BIN + base + (size_t)t * DM);
            const float l0 = bf_lo(la), l1 = bf_hi(la);
            h0 = __expf(l0) * h0 + bf_lo(bi); h1 = __expf(l1) * h1 + bf_hi(bi); s0 += l0; s1 += l1; }
        *(f32x2*)(AGGA + (size_t)it * DM + ch) = (f32x2){__expf(s0), __expf(s1)};
        *(f32x2*)(AGGB + (size_t)it * DM + ch) = (f32x2){h0, h1};
    }
}
__device__ __forceinline__ void scanB_phase(const bf16_t* LA, const bf16_t* BIN, const bf16_t* Gt, const float* AGGA, const float* AGGB, bf16_t* Y, int tid) {
    const int ch = 2 * tid;
    for (int it = opq_bid(); it < NB * 32; it += gridDim.x) {
        const int b = it >> 5, c = it & 31; const size_t base = ((size_t)b * SEQ + c * 64) * DM + ch;
        float h0 = 0.f, h1 = 0.f;
        for (int cc = 0; cc < c; ++cc) { const f32x2 A = *(const f32x2*)(AGGA + (size_t)(b * 32 + cc) * DM + ch), Bv = *(const f32x2*)(AGGB + (size_t)(b * 32 + cc) * DM + ch);
            h0 = A.x * h0 + Bv.x; h1 = A.y * h1 + Bv.y; }
#pragma unroll 16
        for (int t = 0; t < 64; ++t) { const unsigned la = *(const unsigned*)(LA + base + (size_t)t * DM), bi = *(const unsigned*)(BIN + base + (size_t)t * DM), gg = *(const unsigned*)(Gt + base + (size_t)t * DM);
            h0 = __expf(bf_lo(la)) * h0 + bf_lo(bi); h1 = __expf(bf_hi(la)) * h1 + bf_hi(bi);
            *(unsigned*)(Y + base + (size_t)t * DM) = cvt_pk_bf16(h0 * fsilu(bf_lo(gg)), h1 * fsilu(bf_hi(gg))); }
    }
}


#define XB_TMO      128
#define XB_XCNT(j)  (256  + 64 * (j))
#define XB_XSUB(j)  (1280 + 64 * (j))
#define XB_XGEN(j)  (2304 + 64 * (j))
#define XB_TOP      3328
#define XB_TOPGEN   3392
#define XCD_BAR_WORDS 3456
#define XB_SPIN_CAP (1u << 18)
constexpr size_t WS_BAR = 16384;
constexpr int LDS_MISC = 131072 + 320;
__device__ __forceinline__ unsigned xb_ld(unsigned* p)              { return __hip_atomic_load(p, __ATOMIC_RELAXED, __HIP_MEMORY_SCOPE_AGENT); }
__device__ __forceinline__ unsigned xb_add(unsigned* p, unsigned v) { return __hip_atomic_fetch_add(p, v, __ATOMIC_RELAXED, __HIP_MEMORY_SCOPE_AGENT); }
__device__ __forceinline__ unsigned xb_xcc_id() { return (unsigned)__builtin_amdgcn_s_getreg((3 << 11) | 20) & 0xFu; }
#define XB_SPIN(cond, bar) do { unsigned _sp = 0; while (cond) { __builtin_amdgcn_s_sleep(1); \
    if ((++_sp & 255u) == 0u) { if (xb_ld(&(bar)[XB_TMO])) break; if (_sp > XB_SPIN_CAP) { atomicAdd(&(bar)[XB_TMO], 1u); break; } } } } while (0)
__device__ __forceinline__ void xcd_barrier_complete(unsigned* bar, unsigned x, unsigned& nloc, unsigned& nx) {
    const unsigned G = gridDim.x * gridDim.y * gridDim.z;
    unsigned sum, cnt, mine, sp = 0u;
    for (;;) {
        sum = 0u; cnt = 0u; mine = 0u;
#pragma unroll
        for (unsigned j = 0; j < 16; ++j) { const unsigned c = xb_ld(&bar[XB_XCNT(j)]); sum += c; cnt += (c > 0u) ? 1u : 0u; mine = (j == x) ? c : mine; }
        if (sum == G) break;
        __builtin_amdgcn_s_sleep(1);
        if ((++sp & 255u) == 0u) { if (xb_ld(&bar[XB_TMO])) break; if (sp > XB_SPIN_CAP) { atomicAdd(&bar[XB_TMO], 1u); break; } }
    }
    nloc = mine > 0u ? mine : 1u; nx = cnt > 0u ? cnt : 1u;
}
__device__ __forceinline__ void xcd_barrier(unsigned* bar, volatile LAS unsigned* st, int tid) {
    asm volatile("s_waitcnt vmcnt(0)" ::: "memory");
    __syncthreads();
    if (tid == 0) {
        const unsigned x = xb_xcc_id();
        __builtin_amdgcn_s_waitcnt(0);
        unsigned nloc = st[0], nx = st[1];
        if (nloc == 0u) { xcd_barrier_complete(bar, x, nloc, nx); st[0] = nloc; st[1] = nx; }
        const unsigned old = xb_add(&bar[XB_XSUB(x)], 1u);
        const unsigned gen = old / nloc;
        if (old + 1u == (gen + 1u) * nloc) {
            __builtin_amdgcn_fence(__ATOMIC_RELEASE, "agent");
            asm volatile("s_waitcnt vmcnt(0)" ::: "memory");
            const unsigned og = xb_add(&bar[XB_TOP], 1u);
            const unsigned tg = og / nx;
            if (og + 1u == (tg + 1u) * nx) xb_add(&bar[XB_TOPGEN], 1u);
            else XB_SPIN(xb_ld(&bar[XB_TOPGEN]) == tg, bar);
            __builtin_amdgcn_fence(__ATOMIC_ACQUIRE, "agent");
            xb_add(&bar[XB_XGEN(x)], 1u);
            asm volatile("s_waitcnt vmcnt(0)" ::: "memory");
        } else {
            XB_SPIN(xb_ld(&bar[XB_XGEN(x)]) == gen, bar);
            __builtin_amdgcn_fence(__ATOMIC_ACQUIRE, "agent");
            asm volatile("s_waitcnt vmcnt(0)" ::: "memory");
        }
    }
    __syncthreads();
}

constexpr int NPHASE = 24;
#ifndef PH_EN
#define PH_EN 0xFFFF
#endif
#define EN(b) ((PH_EN >> (b)) & 1)
template <int ph>
__device__ __forceinline__ void run_phase(unsigned char* lds, int wv) {
    LAS unsigned char* ldsl = (LAS unsigned char*)lds;
    {
        ArgsP ap = (ArgsP)__builtin_amdgcn_kernarg_segment_ptr();
        asm volatile("" : "+s"(ap));
        const int G = gridDim.x;
        unsigned char* ws = (unsigned char*)ap->ws;
        float* modv = (float*)(ws + WS_MODV);
        float* kmean = (float*)(ws + WS_KMEAN);
        bf16_t* HN = (bf16_t*)(ws + WS_HN); bf16_t* HKV = (bf16_t*)(ws + WS_HKV); bf16_t* UPRE = (bf16_t*)(ws + WS_UPRE); bf16_t* GB = (bf16_t*)(ws + WS_G);
        bf16_t* LAb = (bf16_t*)(ws + WS_LA); bf16_t* BINb = (bf16_t*)(ws + WS_BIN);
        float* xw = (float*)ap->out;
        const int tid = opq_tid(wv), c = opq_bid();
        const int lane = tid & 63, wave = __builtin_amdgcn_readfirstlane(tid >> 6);
        if (ph == 0) {
            if (EN(0)) prep_phase(ap, ldsl, wave, lane);
        } else if (ph <= 14) {
            const int l = (ph - 1) / 7, k = (ph - 1) % 7;
            const float* xin = (l == 0) ? AIN(0) : xw;
            if (k == 0) {
                if (EN(1)) norm_phase(xin, HN, AIN(4) + l * DM, modv, l * 3 * DM, l * 3 * DM + DM, nullptr, nullptr, 0, 0, wave, lane);
            } else if (k == 1) {
                pg8::Gemm g{HN, (const bf16_t*)(ws + WS_WIN) + (size_t)l * 2 * DM * DM, DM, DM, DM, 0, 0};
                pg8::MultiOrder S; S.init(MTOK, 2 * DM, 1, G, c);
                pg8::EpiSplit E{UPRE, GB};
                if (EN(2)) pg8::gemm_phase(ldsl, g, S, E, wv);
            } else if (k == 2) {
                if (EN(3)) conv_phase(UPRE, HKV, AIN(6) + l * 4 * DM, AIN(7) + l * DM, tid);
            } else if (k == 3) {
                pg8::Gemm g{HKV, (const bf16_t*)(ws + WS_WG) + (size_t)l * 4 * 512 * 256, DM, 256, 256, 256 * 2, 512 * 256 * 2};
                pg8::MultiOrder S; S.init(MTOK, 512, 4, G, c);
                pg8::EpiGates E{HKV, LAb, BINb, AIN(9) + l * DM, AIN(11) + l * DM, AIN(12) + l * DM};
                if (EN(4)) pg8::gemm_phase(ldsl, g, S, E, wv);
            } else if (k == 4) {
                if (EN(5)) scanA_phase(LAb, BINb, (float*)(ws + WS_AGGA), (float*)(ws + WS_AGGB), tid);
            } else if (k == 5) {
                if (EN(6)) scanB_phase(LAb, BINb, GB, (const float*)(ws + WS_AGGA), (const float*)(ws + WS_AGGB), HN, tid);
            } else {
                pg8::Gemm g{HN, (const bf16_t*)(ws + WS_WOUT) + (size_t)l * DM * DM, DM, DM, DM, 0, 0};
                pg8::MultiOrder S; S.init(MTOK, DM, 1, G, c);
                pg8::EpiRes E{xin, xw, modv + l * 3 * DM + 2 * DM};
                if (EN(7)) pg8::gemm_phase(ldsl, g, S, E, wv);
            }
        } else if (ph <= 22) {
            const int i = (ph - 15) / 4, k = (ph - 15) % 4, l = 2 + i;
            if (k == 0) {
                if (EN(8)) norm_phase(xw, HN, AIN(4) + l * DM, modv, l * 3 * DM, l * 3 * DM + DM,
                           i == 0 ? HKV : nullptr, AIN(14), 4 * 3 * DM, 4 * 3 * DM + DM, wave, lane);
            } else if (k == 1) {
                pg8::Gemm g{HN, (const bf16_t*)(ws + (i == 0 ? WS_ATTIN0 : WS_ATTIN1)), DM, DM, DM, (long)(WS_HKV - WS_HN), (long)(WS_WKV - WS_ATTIN0)};
                pg8::MultiOrder S; S.init(MTOK, 2 * DM, i == 0 ? 2 : 1, G, c);
                pg8::EpiQKV E{ws, kmean};
                if (EN(9)) pg8::gemm_phase(ldsl, g, S, E, wv);
            } else if (k == 2) {
                if (EN(10)) att::attn_phase((char*)lds, UPRE, LAb, BINb, HN, GB, kmean, wv);
            } else {
                pg8::Gemm g{HN, (const bf16_t*)(ws + WS_ATTOUT) + (size_t)i * DM * DM, DM, DM, DM, 0, 0};
                pg8::MultiOrder S; S.init(MTOK, DM, 1, G, c);
                pg8::EpiRes E{xw, xw, modv + l * 3 * DM + 2 * DM};
                if (EN(11)) pg8::gemm_phase(ldsl, g, S, E, wv);
            }
        } else {
            if (EN(12)) final_norm_phase(xw, AIN(20), wave, lane);
        }
    }
}
__global__ void __launch_bounds__(NTHR, 2) yoco_fwd(Args a_) {
    extern __shared__ __attribute__((aligned(16))) unsigned char lds[];
    const int ph_lo = a_.ph_lo, ph_hi = a_.ph_hi;
    const int wv = __builtin_amdgcn_readfirstlane((int)threadIdx.x >> 6);
    if (ph_hi - ph_lo > 1) {
        if (threadIdx.x < 2) ((volatile LAS unsigned*)((LAS unsigned char*)lds + LDS_MISC))[threadIdx.x] = 0u;
        if (threadIdx.x == 0) (void)xb_add(&((unsigned*)(a_.ws + WS_BAR))[XB_XCNT(xb_xcc_id())], 1u);
        __syncthreads();
    }
#define SEAM(P) do { if ((P) == 0) cg::this_grid().sync(); else { ArgsP ap_ = (ArgsP)__builtin_amdgcn_kernarg_segment_ptr(); asm volatile("" : "+s"(ap_)); \
        xcd_barrier((unsigned*)((unsigned char*)ap_->ws + WS_BAR), (volatile LAS unsigned*)((LAS unsigned char*)lds + LDS_MISC), opq_tid(wv)); } } while (0)
#define RUN(P) if ((P) >= ph_lo && (P) < ph_hi) { run_phase<P>(lds, wv); if ((P) + 1 < ph_hi) SEAM(P); }
    RUN(0) RUN(1) RUN(2) RUN(3) RUN(4) RUN(5) RUN(6) RUN(7) RUN(8) RUN(9) RUN(10) RUN(11)
    RUN(12) RUN(13) RUN(14) RUN(15) RUN(16) RUN(17) RUN(18) RUN(19) RUN(20) RUN(21) RUN(22) RUN(23)
#undef RUN
#undef SEAM
}

extern "C" void kernel_launch(void* const* d_in, const int* in_sizes, int n_in, void* d_out, int out_size, void* d_ws, size_t ws_size, hipStream_t stream) {
    static int grid = 0;
    if (grid == 0) {
        if (n_in != 21 || out_size != MTOK * DM || ws_size < WS_END) { fprintf(stderr, "kernel_launch: unexpected shapes (n_in %d out %d ws %zu)\n", n_in, out_size, ws_size); grid = -1; return; }
        int dev = 0, cus = 0, per_cu = 0;
        (void)hipGetDevice(&dev);
        if (hipDeviceGetAttribute(&cus, hipDeviceAttributeMultiprocessorCount, dev) != hipSuccess || cus <= 0) cus = 256;
        if (hipFuncSetAttribute((const void*)yoco_fwd, hipFuncAttributeMaxDynamicSharedMemorySize, LDS_BYTES) != hipSuccess) { fprintf(stderr, "kernel_launch: hipFuncSetAttribute failed\n"); grid = -1; return; }
        if (hipOccupancyMaxActiveBlocksPerMultiprocessor(&per_cu, (const void*)yoco_fwd, NTHR, LDS_BYTES) != hipSuccess || per_cu < 1) { fprintf(stderr, "kernel_launch: occupancy query says %d\n", per_cu); per_cu = 1; }
        (void)hipGetLastError();
        grid = cus;
    }
    if (grid < 0) return;
    (void)hipMemsetAsync((char*)d_ws + WS_CTL, 0, CTL_ZERO_BYTES, stream);
    Args a{};
    for (int i = 0; i < 21; ++i) a.in[i] = (const float*)d_in[i];
    a.out = (float*)d_out; a.ws = (unsigned char*)d_ws;
#if MK_MULTI_LAUNCH
    for (int ph = 0; ph < NPHASE; ++ph) { a.ph_lo = ph; a.ph_hi = ph + 1; hipLaunchKernelGGL(yoco_fwd, dim3(grid), dim3(NTHR), LDS_BYTES, stream, a); }
#else
    a.ph_lo = 0; a.ph_hi = NPHASE;
    void* kargs[] = {&a};
    hipError_t e = hipLaunchCooperativeKernel((const void*)yoco_fwd, dim3(grid), dim3(NTHR), kargs, LDS_BYTES, stream);
    if (e != hipSuccess) fprintf(stderr, "kernel_launch: cooperative launch failed: %s (grid %d)\n", hipGetErrorString(e), grid);
#endif
}
```

```cpp
#include <hip/hip_runtime.h>
#include <hip/hip_cooperative_groups.h>
#include <cstdio>
#include <cstdint>
namespace cg = cooperative_groups;

#ifndef MK_MULTI_LAUNCH
#define MK_MULTI_LAUNCH 0
#endif

constexpr int DM = 1024, NB = 8, SEQ = 2048, MTOK = NB * SEQ, NH = 8, DH = 128;
constexpr int MODV_LD = 14336;
constexpr float EPS = 1e-6f;
constexpr int NWAVES = 8, NTHR = 512;
constexpr int LDS_BYTES = 147456;

constexpr size_t MiB = 1u << 20;
constexpr size_t WS_CTL = 0, CTL_ZERO_BYTES = 1 * MiB;
constexpr size_t WS_MODV = 64 * 1024;
constexpr size_t WS_KMEAN = 512 * 1024;
constexpr size_t WS_AGGA = 1 * MiB, WS_AGGB = 2 * MiB;
constexpr size_t WS_WIN = 3 * MiB;
constexpr size_t WS_WG = 11 * MiB;
constexpr size_t WS_WOUT = 13 * MiB;
constexpr size_t WS_ATTIN0 = 17 * MiB, WS_WKV = 21 * MiB, WS_ATTIN1 = 25 * MiB;
constexpr size_t WS_ATTOUT = 29 * MiB;
constexpr size_t WS_HN = 33 * MiB;
constexpr size_t WS_HKV = 65 * MiB;
constexpr size_t WS_UPRE = 97 * MiB;
constexpr size_t WS_G = 129 * MiB;
constexpr size_t WS_LA = 161 * MiB;
constexpr size_t WS_BIN = 193 * MiB;
constexpr size_t WS_END = 225 * MiB;

typedef unsigned short bf16_t;
typedef short bf16x8 __attribute__((ext_vector_type(8)));
typedef short s16x4 __attribute__((ext_vector_type(4)));
typedef float f32x4 __attribute__((ext_vector_type(4)));
typedef float f32x2 __attribute__((ext_vector_type(2)));
typedef float f32x16 __attribute__((ext_vector_type(16)));
typedef unsigned u32x4 __attribute__((ext_vector_type(4)));
typedef unsigned u32x2 __attribute__((ext_vector_type(2)));
#define LAS __attribute__((address_space(3)))

__device__ __forceinline__ unsigned cvt_pk_bf16(float lo, float hi) { unsigned r; asm volatile("v_cvt_pk_bf16_f32 %0, %1, %2" : "=v"(r) : "v"(lo), "v"(hi)); return r; }
__device__ __forceinline__ float bf_lo(unsigned w) { return __uint_as_float(w << 16); }
__device__ __forceinline__ float bf_hi(unsigned w) { return __uint_as_float(w & 0xffff0000u); }
__device__ __forceinline__ float bf1(bf16_t h) { return __uint_as_float((unsigned)h << 16); }
__device__ __forceinline__ float fexp(float x) { return __builtin_amdgcn_exp2f(x * 1.4426950408889634f); }
__device__ __forceinline__ float flog(float x) { return __builtin_amdgcn_logf(x) * 0.6931471805599453f; }
__device__ __forceinline__ float fsigmoid(float x) { return __builtin_amdgcn_rcpf(1.f + fexp(-x)); }
__device__ __forceinline__ float fsilu(float x) { return x * fsigmoid(x); }
__device__ __forceinline__ int opq_tid(int wv) { int l; asm volatile("v_mbcnt_lo_u32_b32 %0, -1, 0\n\tv_mbcnt_hi_u32_b32 %0, -1, %0" : "=v"(l)); return wv * 64 + l; }
__device__ __forceinline__ int opq_bid() { int b = blockIdx.x; asm volatile("" : "+s"(b)); return b; }
__device__ __forceinline__ float wave_sum(float v) {
#pragma unroll
    for (int o = 1; o < 64; o <<= 1) v += __shfl_xor(v, o);
    return v;
}

namespace pg8 {
constexpr int BM = 256, BK = 64, HALF = 128, HTB = HALF * BK * 2, STAGE_BYTES = 8 * HTB, NXCD = 8, WGM = 8;
__host__ __device__ __forceinline__ int lds_byte(int r, int c) { const int st = (r >> 4) * 2 + (c >> 5), rr = r & 15, cc = c & 31, ob = rr * 64 + cc * 2; return st * 1024 + (ob ^ (((ob >> 9) & 1) << 5)); }
__host__ __device__ __forceinline__ void stage_rc(int b, int& R, int& C) { const int st = b / 1024, sb = b % 1024, swz = sb ^ (((sb >> 9) & 1) << 5); R = (st >> 1) * 16 + swz / 64; C = (st & 1) * 32 + (swz % 64) / 2; }
__host__ __device__ __forceinline__ int perm32(int rho) { const int n = rho >> 4, i = rho & 15; return 8 * (i >> 2) + 4 * n + (i & 3); }

struct Unit { int pm, pn, sub; };
struct Gemm { const bf16_t* A; const bf16_t* Bt; int lda, ldb, K; long a_sub, b_sub; };

struct MultiOrder {
    int nM, nN, nwg, nsub, G, c;
    __device__ void init(int M, int N, int nsub_, int G_, int c_) { nM = M / BM; nN = N / BM; nwg = nM * nN; nsub = nsub_; G = G_; c = c_; }
    __device__ bool next(int i, Unit& u) const {
        const long L = (long)i * G + c; if (L >= (long)nwg * nsub) return false;
        u.sub = (int)(L / nwg);
        int wgid = (int)(L % nwg); { const int q = nwg / NXCD, r = nwg % NXCD, xcd = wgid % NXCD, off = wgid / NXCD; wgid = (xcd < r ? xcd * (q + 1) : r * (q + 1) + (xcd - r) * q) + off; }
        const int nig = WGM * nN, gid = wgid / nig, fm = gid * WGM, gsz = (nM - fm) < WGM ? (nM - fm) : WGM;
        u.pm = fm + ((wgid % nig) % gsz); u.pn = (wgid % nig) / gsz; return true;
    }
};


struct EpiSplit {
    static constexpr bool PERM = true;
    bf16_t* O0; bf16_t* O1;
    __device__ __forceinline__ void operator()(const f32x4 (&acc)[2][2][4][2], const Unit& u, int wr, int wc, int fr, int fq) const {
        const int row0 = u.pm * BM + wr * 64 + fr; int colt = u.pn * BM; bf16_t* base = O0;
        if (colt >= DM) { base = O1; colt -= DM; }
        const int col0 = colt + wc * 32 + 8 * fq;
#pragma unroll
        for (int ai = 0; ai < 2; ++ai)
#pragma unroll
            for (int m = 0; m < 4; ++m) { bf16_t* rowp = base + (size_t)(row0 + ai * HALF + m * 16) * DM + col0;
#pragma unroll
                for (int bj = 0; bj < 2; ++bj) { const f32x4 v0 = acc[ai][bj][m][0], v1 = acc[ai][bj][m][1];
                    u32x4 w; w.x = cvt_pk_bf16(v0[0], v0[1]); w.y = cvt_pk_bf16(v0[2], v0[3]); w.z = cvt_pk_bf16(v1[0], v1[1]); w.w = cvt_pk_bf16(v1[2], v1[3]);
                    *(u32x4*)(rowp + bj * HALF) = w; } }
    }
};

struct EpiRes {
    static constexpr bool PERM = false;
    const float* xin; float* out; const float* gate;
    __device__ __forceinline__ void operator()(const f32x4 (&acc)[2][2][4][2], const Unit& u, int wr, int wc, int fr, int fq) const {
        const int b = u.pm >> 3, col0 = u.pn * BM + wc * 32 + 4 * fq;
        f32x4 gv[2][2];
#pragma unroll
        for (int bj = 0; bj < 2; ++bj)
#pragma unroll
            for (int n = 0; n < 2; ++n) gv[bj][n] = *(const f32x4*)(gate + (size_t)b * MODV_LD + col0 + bj * HALF + n * 16);
#pragma unroll
        for (int ai = 0; ai < 2; ++ai)
#pragma unroll
            for (int m = 0; m < 4; ++m) { const size_t off = (size_t)(u.pm * BM + ai * HALF + wr * 64 + m * 16 + fr) * DM + col0;
#pragma unroll
                for (int bj = 0; bj < 2; ++bj)
#pragma unroll
                    for (int n = 0; n < 2; ++n) { const f32x4 xv = *(const f32x4*)(xin + off + bj * HALF + n * 16);
                        *(f32x4*)(out + off + bj * HALF + n * 16) = xv + gv[bj][n] * acc[ai][bj][m][n]; } }
    }
};

template <int N> __device__ __forceinline__ float dpp_shr(float src, float ident) {
    return __int_as_float(__builtin_amdgcn_update_dpp(__float_as_int(ident), __float_as_int(src), 0x110 + N, 0xF, 0xF, false));
}
__device__ __forceinline__ void scan16(float& a, float& b) {
    float ap, bp;
    ap = dpp_shr<1>(a, 1.f); bp = dpp_shr<1>(b, 0.f); b = fmaf(a, bp, b); a *= ap;
    ap = dpp_shr<2>(a, 1.f); bp = dpp_shr<2>(b, 0.f); b = fmaf(a, bp, b); a *= ap;
    ap = dpp_shr<4>(a, 1.f); bp = dpp_shr<4>(b, 0.f); b = fmaf(a, bp, b); a *= ap;
    ap = dpp_shr<8>(a, 1.f); bp = dpp_shr<8>(b, 0.f); b = fmaf(a, bp, b); a *= ap;
}
__device__ __forceinline__ void gate_elem2(f32x2 xr, f32x2 xg, f32x2 nba, f32x2 nbx, f32x2 psp2, f32x2 uv, f32x2& a, f32x2& b) {
    const f32x2 tr = xr * (-1.4426950408889634f) + nba, tg = xg * (-1.4426950408889634f) + nbx;
    f32x2 er, eg; er.x = __builtin_amdgcn_exp2f(tr.x); er.y = __builtin_amdgcn_exp2f(tr.y); eg.x = __builtin_amdgcn_exp2f(tg.x); eg.y = __builtin_amdgcn_exp2f(tg.y);
    const f32x2 dr = er + 1.f, dg = eg + 1.f, dd = dr * dg;
    f32x2 inv; inv.x = __builtin_amdgcn_rcpf(dd.x); inv.y = __builtin_amdgcn_rcpf(dd.y);
    const f32x2 r = inv * dg, gi = inv * dr;
    const f32x2 la2 = psp2 * r;
    a.x = __builtin_amdgcn_exp2f(-la2.x); a.y = __builtin_amdgcn_exp2f(-la2.y);
    const f32x2 om = 1.f - a * a;
    f32x2 sq; sq.x = __builtin_amdgcn_sqrtf(om.x); sq.y = __builtin_amdgcn_sqrtf(om.y);
    b = sq * gi * uv;
}
struct GateParams { f32x2 nba[4], nbx[4], psp2[4]; };
__device__ __forceinline__ void gate_params(GateParams& P, const float* ba, const float* bx, const float* lam, int ch0) {
#pragma unroll
    for (int p = 0; p < 4; ++p) {
        const f32x2 vb = *(const f32x2*)(ba + ch0 + 2 * p), vx = *(const f32x2*)(bx + ch0 + 2 * p), vl = *(const f32x2*)(lam + ch0 + 2 * p);
        P.nba[p] = vb * (-1.4426950408889634f); P.nbx[p] = vx * (-1.4426950408889634f);
        const float z0 = -vl.x, z1 = -vl.y;
        P.psp2[p].x = 8.f * 1.4426950408889634f * (z0 > 20.f ? z0 : flog(1.f + fexp(z0)));
        P.psp2[p].y = 8.f * 1.4426950408889634f * (z1 > 20.f ? z1 : flog(1.f + fexp(z1)));
    }
}
#define GATE_PAIR(p, accv, uw_, a2, b2) do { const int n_ = (p) >> 1, q_ = ((p) & 1) * 2; \
        const unsigned uword_ = ((p) == 0) ? uw_.x : ((p) == 1) ? uw_.y : ((p) == 2) ? uw_.z : uw_.w; \
        gate_elem2((f32x2){accv[ai][0][m][n_][q_], accv[ai][0][m][n_][q_ + 1]}, (f32x2){accv[ai][1][m][n_][q_], accv[ai][1][m][n_][q_ + 1]}, \
                   P.nba[p], P.nbx[p], P.psp2[p], (f32x2){bf_lo(uword_), bf_hi(uword_)}, a2, b2); } while (0)
struct EpiGatesA {
    static constexpr bool PERM = true;
    const bf16_t* U; float* AGGA; float* AGGB; const float* ba; const float* bx; const float* lam;
    __device__ __forceinline__ void operator()(const f32x4 (&acc)[2][2][4][2], const Unit& u, int wr, int wc, int fr, int fq) const {
        const int ch0 = u.sub * 256 + u.pn * 128 + wc * 32 + 8 * fq;
        GateParams P; gate_params(P, ba, bx, lam, ch0);
#pragma unroll
        for (int ai = 0; ai < 2; ++ai) {
            float Ar[8], Br[8];
#pragma unroll
            for (int j = 0; j < 8; ++j) { Ar[j] = 1.f; Br[j] = 0.f; }
#pragma unroll
            for (int m = 0; m < 4; ++m) { const size_t off = (size_t)(u.pm * BM + ai * HALF + wr * 64 + m * 16 + fr) * DM + ch0;
                const u32x4 uw = *(const u32x4*)(U + off);
#pragma unroll
                for (int p = 0; p < 4; ++p) { f32x2 a2, b2; GATE_PAIR(p, acc, uw, a2, b2);
                    float a = a2.x, b = b2.x; scan16(a, b); Br[2 * p] = fmaf(a, Br[2 * p], b); Ar[2 * p] *= a;
                    a = a2.y; b = b2.y; scan16(a, b); Br[2 * p + 1] = fmaf(a, Br[2 * p + 1], b); Ar[2 * p + 1] *= a;
                    if (p & 1) __builtin_amdgcn_sched_barrier(0); }
                asm volatile("" ::: "memory"); __builtin_amdgcn_sched_barrier(0); }
            if (fr == 15) { const size_t ao = (size_t)((u.pm >> 3) * 32 + (u.pm & 7) * 4 + ai * 2 + wr) * DM + ch0;
                *(f32x4*)(AGGA + ao) = (f32x4){Ar[0], Ar[1], Ar[2], Ar[3]}; *(f32x4*)(AGGA + ao + 4) = (f32x4){Ar[4], Ar[5], Ar[6], Ar[7]};
                *(f32x4*)(AGGB + ao) = (f32x4){Br[0], Br[1], Br[2], Br[3]}; *(f32x4*)(AGGB + ao + 4) = (f32x4){Br[4], Br[5], Br[6], Br[7]}; }
        }
    }
};
struct EpiGatesB {
    static constexpr bool PERM = true;
    const bf16_t* U; const bf16_t* Gt; bf16_t* Y; const float* AGGA; const float* AGGB; const float* ba; const float* bx; const float* lam;
    __device__ __forceinline__ void operator()(const f32x4 (&acc)[2][2][4][2], const Unit& u, int wr, int wc, int fr, int fq) const {
        const int ch0 = u.sub * 256 + u.pn * 128 + wc * 32 + 8 * fq;
        const int c0 = (u.pm & 7) * 4 + wr; const size_t ab = (size_t)((u.pm >> 3) * 32) * DM + ch0;
        const int bsrc = (fq * 16 + 15) << 2;
        float h[8];
#pragma unroll
        for (int hf = 0; hf < 2; ++hf) {
            f32x4 Ac = (f32x4){1.f, 1.f, 1.f, 1.f}, Bc = (f32x4){0.f, 0.f, 0.f, 0.f};
#pragma unroll
            for (int t = 0; t < 2; ++t) { const int cc = 2 * fr + t;
                const bool on = cc < c0; const size_t o = ab + (size_t)(on ? cc : 0) * DM + 4 * hf;
                f32x4 A0 = *(const f32x4*)(AGGA + o), B0 = *(const f32x4*)(AGGB + o);
#pragma unroll
                for (int j = 0; j < 4; ++j) { A0[j] = on ? A0[j] : 1.f; B0[j] = on ? B0[j] : 0.f; }
                Bc = A0 * Bc + B0; Ac = Ac * A0; }
#pragma unroll
            for (int j = 0; j < 4; ++j) { float a = Ac[j], b = Bc[j]; scan16(a, b); h[4 * hf + j] = __int_as_float(__builtin_amdgcn_ds_bpermute(bsrc, __float_as_int(b))); }
            asm volatile("" ::: "memory"); __builtin_amdgcn_sched_barrier(0);
        }
        GateParams P; gate_params(P, ba, bx, lam, ch0);
#pragma unroll
        for (int ai = 0; ai < 2; ++ai) {
            if (ai == 1) { const size_t o1 = ab + (size_t)(c0 + 1) * DM;
                const f32x4 A0 = *(const f32x4*)(AGGA + o1), A1 = *(const f32x4*)(AGGA + o1 + 4), B0 = *(const f32x4*)(AGGB + o1), B1 = *(const f32x4*)(AGGB + o1 + 4);
#pragma unroll
                for (int j = 0; j < 4; ++j) { h[j] = fmaf(A0[j], h[j], B0[j]); h[4 + j] = fmaf(A1[j], h[4 + j], B1[j]); } }
#pragma unroll
            for (int m = 0; m < 4; ++m) { const size_t off = (size_t)(u.pm * BM + ai * HALF + wr * 64 + m * 16 + fr) * DM + ch0;
                const u32x4 uw = *(const u32x4*)(U + off), gw = *(const u32x4*)(Gt + off);
                const float gv[8] = {bf_lo(gw.x), bf_hi(gw.x), bf_lo(gw.y), bf_hi(gw.y), bf_lo(gw.z), bf_hi(gw.z), bf_lo(gw.w), bf_hi(gw.w)};
                float yv[8];
#pragma unroll
                for (int p = 0; p < 4; ++p) { f32x2 a2, b2; GATE_PAIR(p, acc, uw, a2, b2);
                    float a = a2.x, b = b2.x; scan16(a, b); float hv = fmaf(a, h[2 * p], b); yv[2 * p] = hv * fsilu(gv[2 * p]);
                    h[2 * p] = __int_as_float(__builtin_amdgcn_ds_bpermute(bsrc, __float_as_int(hv)));
                    a = a2.y; b = b2.y; scan16(a, b); hv = fmaf(a, h[2 * p + 1], b); yv[2 * p + 1] = hv * fsilu(gv[2 * p + 1]);
                    h[2 * p + 1] = __int_as_float(__builtin_amdgcn_ds_bpermute(bsrc, __float_as_int(hv))); }
                u32x4 w; w.x = cvt_pk_bf16(yv[0], yv[1]); w.y = cvt_pk_bf16(yv[2], yv[3]); w.z = cvt_pk_bf16(yv[4], yv[5]); w.w = cvt_pk_bf16(yv[6], yv[7]);
                *(u32x4*)(Y + off) = w;
                asm volatile("" ::: "memory"); __builtin_amdgcn_sched_barrier(0); }
        }
    }
};

struct EpiQKV {
    static constexpr bool PERM = true;
    unsigned char* ws; float* kmean;
    __device__ __forceinline__ void operator()(const f32x4 (&acc)[2][2][4][2], const Unit& u, int wr, int wc, int fr, int fq) const {
        const int b = u.pm >> 3, sblk = u.pm & 7, pq = u.pn & 3; const bool second = u.pn >= 4;
        const int dcol = wc * 32 + 8 * fq;
        if (u.sub == 0 && second) {
#pragma unroll
            for (int ai = 0; ai < 2; ++ai)
#pragma unroll
                for (int m = 0; m < 4; ++m) { bf16_t* rowp = (bf16_t*)(ws + WS_G) + (size_t)(u.pm * BM + ai * HALF + wr * 64 + m * 16 + fr) * DM + pq * 256 + dcol;
#pragma unroll
                    for (int bj = 0; bj < 2; ++bj) { const f32x4 v0 = acc[ai][bj][m][0], v1 = acc[ai][bj][m][1];
                        u32x4 w; w.x = cvt_pk_bf16(v0[0], v0[1]); w.y = cvt_pk_bf16(v0[2], v0[3]); w.z = cvt_pk_bf16(v1[0], v1[1]); w.w = cvt_pk_bf16(v1[2], v1[3]);
                        *(u32x4*)(rowp + bj * HALF) = w; } }
            return;
        }
        const size_t boff = (u.sub == 0) ? WS_UPRE : (second ? WS_BIN : WS_LA);
        bf16_t* base = (bf16_t*)(ws + boff);
#pragma unroll
        for (int bj = 0; bj < 2; ++bj) { const int head = 2 * pq + bj;
            bf16_t* hb = base + ((size_t)(b * NH + head) * SEQ + sblk * 256) * DH + dcol;
#pragma unroll
            for (int ai = 0; ai < 2; ++ai)
#pragma unroll
                for (int m = 0; m < 4; ++m) { const f32x4 v0 = acc[ai][bj][m][0], v1 = acc[ai][bj][m][1];
                    u32x4 w; w.x = cvt_pk_bf16(v0[0], v0[1]); w.y = cvt_pk_bf16(v0[2], v0[3]); w.z = cvt_pk_bf16(v1[0], v1[1]); w.w = cvt_pk_bf16(v1[2], v1[3]);
                    *(u32x4*)(hb + (size_t)(ai * HALF + wr * 64 + m * 16 + fr) * DH) = w; } }
        if (u.sub == 1 && !second) {
#pragma unroll
            for (int bj = 0; bj < 2; ++bj) { const int head = 2 * pq + bj;
#pragma unroll
                for (int n = 0; n < 2; ++n) { f32x4 s = (f32x4){0.f, 0.f, 0.f, 0.f};
#pragma unroll
                    for (int ai = 0; ai < 2; ++ai)
#pragma unroll
                        for (int m = 0; m < 4; ++m) s += acc[ai][bj][m][n];
#pragma unroll
                    for (int j = 0; j < 4; ++j) { float t = s[j]; t += __shfl_xor(t, 1); t += __shfl_xor(t, 2); t += __shfl_xor(t, 4); t += __shfl_xor(t, 8);
                        if (fr == 0) atomicAdd(kmean + ((size_t)(b * NH + head) * 8 + sblk) * DH + dcol + 4 * n + j, t * (1.f / 256.f)); } } }
        }
    }
};

template <class Epi, class Sched>
__device__ __forceinline__ void gemm_phase(LAS unsigned char* lds, const Gemm g, const Sched& S, const Epi& E, int wv) {
    const int tid = opq_tid(wv), wid = __builtin_amdgcn_readfirstlane(tid >> 6), lane = tid & 63, wr = wid >> 2, wc = wid & 3, fr = lane & 15, fq = lane >> 4;
    const int K = g.K, nt = K / BK;
    unsigned voffA[2], voffB[2];
#pragma unroll
    for (int i = 0; i < 2; ++i) { int R, C; stage_rc(tid * 16 + i * 8192, R, C); const int Rb = Epi::PERM ? ((R & ~31) + perm32(R & 31)) : R;
        voffA[i] = (unsigned)(R * g.lda + C) * 2u; voffB[i] = (unsigned)(Rb * g.ldb + C) * 2u; }
    const size_t kstep = (size_t)(BK * 2);
    const size_t hstepA = (size_t)HALF * g.lda * 2, hstepB = (size_t)HALF * g.ldb * 2;
    const size_t tstepA = 2 * hstepA, tstepB = 2 * hstepB;
    const unsigned ldsw = (unsigned)wid * 1024u;
    const int aoff = lds_byte(wr * 64 + fr, fq * 8), boff = lds_byte(wc * 32 + fr, fq * 8);
#define PG8_SA(b, h) (((b) * 2 + (h)) * HTB)
#define PG8_SB(b, h) ((4 + (b) * 2 + (h)) * HTB)
#define PG8_STAGE(bufoff, gbase, voff) do { _Pragma("unroll") for (int _i = 0; _i < 2; ++_i) \
        __builtin_amdgcn_global_load_lds((const unsigned*)((const char*)(gbase) + (voff)[_i]), (LAS unsigned*)(lds + (bufoff) + ldsw + _i * 8192), 16, 0, 0); } while (0)
#define PG8_LDA(dst, b, h) do { _Pragma("unroll") for (int m = 0; m < 4; ++m) _Pragma("unroll") for (int k = 0; k < 2; ++k) dst[m][k] = *(const LAS bf16x8*)(lds + PG8_SA(b, h) + aoff + m * 2048 + k * 1024); } while (0)
#define PG8_LDB(dst, b, h) do { _Pragma("unroll") for (int n = 0; n < 2; ++n) _Pragma("unroll") for (int k = 0; k < 2; ++k) dst[n][k] = *(const LAS bf16x8*)(lds + PG8_SB(b, h) + boff + n * 2048 + k * 1024); } while (0)
#define PG8_MMA(ai, bj, At, Bt) do { __builtin_amdgcn_s_setprio(1); _Pragma("unroll") for (int m = 0; m < 4; ++m) _Pragma("unroll") for (int n = 0; n < 2; ++n) _Pragma("unroll") for (int k = 0; k < 2; ++k) \
        acc[ai][bj][m][n] = __builtin_amdgcn_mfma_f32_16x16x32_bf16(Bt[n][k], At[m][k], acc[ai][bj][m][n], 0, 0, 0); __builtin_amdgcn_s_setprio(0); } while (0)
#define PG8_WAIT_V(n) asm volatile("s_waitcnt vmcnt(" #n ")" ::: "memory")
#define PG8_WAIT_L(n) asm volatile("s_waitcnt lgkmcnt(" #n ")" ::: "memory")
#define PG8_BAR __builtin_amdgcn_s_barrier()
#define PG8_SCHED __builtin_amdgcn_sched_barrier(0)
#define PG8_UA(u) ((const char*)g.A + (size_t)(u).sub * g.a_sub + (size_t)(u).pm * tstepA)
#define PG8_UB(u) ((const char*)g.Bt + (size_t)(u).sub * g.b_sub + (size_t)(u).pn * tstepB)
    Unit cur, nxt; int ui = 0;
    if (!S.next(0, cur)) return;
    f32x4 acc[2][2][4][2];
#pragma unroll
    for (int a = 0; a < 2; ++a)
#pragma unroll
        for (int b = 0; b < 2; ++b)
#pragma unroll
            for (int m = 0; m < 4; ++m)
#pragma unroll
                for (int n = 0; n < 2; ++n) acc[a][b][m][n] = (f32x4){0.f, 0.f, 0.f, 0.f};
    bf16x8 At[4][2], B0[2][2], B1[2][2];
    const char* cA = PG8_UA(cur); const char* cB = PG8_UB(cur);
    PG8_STAGE(PG8_SB(0, 0), cB, voffB); PG8_STAGE(PG8_SB(0, 1), cB + hstepB, voffB); PG8_STAGE(PG8_SA(0, 0), cA, voffA); PG8_STAGE(PG8_SA(0, 1), cA + hstepA, voffA);
    if (wr == 1) PG8_BAR;
    PG8_WAIT_V(2); PG8_BAR;
    PG8_STAGE(PG8_SB(1, 0), cB + kstep, voffB); PG8_STAGE(PG8_SA(1, 0), cA + kstep, voffA); PG8_STAGE(PG8_SB(1, 1), cB + hstepB + kstep, voffB);
    PG8_WAIT_V(6); PG8_BAR;
    for (;;) {
        const bool has_next = S.next(ui + 1, nxt);
        const char* nA = has_next ? PG8_UA(nxt) : cA; const char* nB = has_next ? PG8_UB(nxt) : cB;
        for (int t = 0; t < nt; t += 2) {
            const bool last = (t == nt - 2);
            const char* a1 = cA + (size_t)(t + 1) * kstep;
            const char* a2 = last ? nA : cA + (size_t)(t + 2) * kstep; const char* b2 = last ? nB : cB + (size_t)(t + 2) * kstep;
            const char* a3 = a2 + kstep; const char* b3 = b2 + kstep;
            PG8_LDB(B0, 0, 0); PG8_LDB(B1, 0, 1); PG8_SCHED; PG8_LDA(At, 0, 0); PG8_STAGE(PG8_SA(1, 1), a1 + hstepA, voffA);
            PG8_WAIT_V(8); PG8_WAIT_L(0); PG8_BAR; PG8_MMA(0, 0, At, B0); PG8_MMA(0, 1, At, B1); PG8_BAR; PG8_SCHED;
            PG8_LDA(At, 0, 1); PG8_STAGE(PG8_SB(0, 0), b2, voffB); PG8_STAGE(PG8_SB(0, 1), b2 + hstepB, voffB); PG8_STAGE(PG8_SA(0, 0), a2, voffA);
            PG8_WAIT_V(8); PG8_WAIT_L(0); PG8_BAR; PG8_MMA(1, 0, At, B0); PG8_MMA(1, 1, At, B1); PG8_BAR; PG8_SCHED;
            PG8_LDB(B0, 1, 0); PG8_LDB(B1, 1, 1); PG8_SCHED; PG8_LDA(At, 1, 0); PG8_STAGE(PG8_SA(0, 1), a2 + hstepA, voffA);
            PG8_WAIT_V(8); PG8_WAIT_L(0); PG8_BAR; PG8_MMA(0, 0, At, B0); PG8_MMA(0, 1, At, B1); PG8_BAR; PG8_SCHED;
            PG8_LDA(At, 1, 1); PG8_STAGE(PG8_SB(1, 0), b3, voffB); PG8_STAGE(PG8_SB(1, 1), b3 + hstepB, voffB); PG8_STAGE(PG8_SA(1, 0), a3, voffA);
            PG8_WAIT_V(8); PG8_WAIT_L(0); PG8_BAR; PG8_MMA(1, 0, At, B0); PG8_MMA(1, 1, At, B1); PG8_BAR; PG8_SCHED;
        }
        if (wr == 0) PG8_BAR;
        { const int t2 = opq_tid(wv), w2 = __builtin_amdgcn_readfirstlane(t2 >> 6), l2 = t2 & 63; E(acc, cur, w2 >> 2, w2 & 3, l2 & 15, l2 >> 4); }
        if (!has_next) break;
#pragma unroll
        for (int a = 0; a < 2; ++a)
#pragma unroll
            for (int b = 0; b < 2; ++b)
#pragma unroll
                for (int m = 0; m < 4; ++m)
#pragma unroll
                    for (int n = 0; n < 2; ++n) acc[a][b][m][n] = (f32x4){0.f, 0.f, 0.f, 0.f};
        cur = nxt; cA = nA; cB = nB; ++ui;
        if (wr == 1) PG8_BAR;
    }
    PG8_WAIT_V(0);
    PG8_BAR;
#undef PG8_SA
#undef PG8_SB
#undef PG8_STAGE
#undef PG8_LDA
#undef PG8_LDB
#undef PG8_MMA
#undef PG8_WAIT_V
#undef PG8_WAIT_L
#undef PG8_BAR
#undef PG8_SCHED
#undef PG8_UA
#undef PG8_UB
}
}

namespace att {
constexpr float SCALE = 0.08838834764831845f;
constexpr float THR = 8.f;
constexpr int NW = 8, QBLK = 32, KVBLK = 64, QB = NW * QBLK, D = 128;
constexpr int SHM_V = KVBLK * D * 2, SHM_K = KVBLK * D * 2;
constexpr int ATT_LDS = 2 * SHM_V + 2 * SHM_K + NW * 64 * 4;
#define KSWZ(row, colB) ((row) * 256 + ((colB) ^ (((row) & 7) << 4)))
#define SBAR() __builtin_amdgcn_sched_barrier(0)
__device__ __forceinline__ int v_st(int k, int c) { const int kk = (k & ~0xC) | ((k & 4) << 1) | ((k & 8) >> 1); return ((kk >> 3) * 4 + (c >> 5)) * 512 + ((kk & 7) * 32 + (c & 31)) * 2; }
__device__ __forceinline__ int v_rd_base(int lane) { return ((lane & 3) << 3) | (((lane >> 2) & 3) << 6) | (((lane >> 4) & 1) << 5) | (((lane >> 5) & 1) << 8); }
constexpr int v_rd_off(int d0, int ks, int half) { return d0 * 512 + ks * 4096 + half * 2048; }
__device__ __forceinline__ int crow(int r, int hi) { return (r & 3) + 8 * (r >> 2) + 4 * hi; }
__device__ __forceinline__ bf16x8 load8(const bf16_t* p) { return *reinterpret_cast<const bf16x8*>(p); }
__device__ __forceinline__ void mask_tile(f32x16& p0, f32x16& p1, int dq) {
    const float NEG = -__builtin_inff();
#pragma unroll
    for (int r = 0; r < 16; ++r) {
        const int c = (r & 3) + 8 * (r >> 2);
        if (dq - c < 0) p0[r] = NEG;
        if (dq - c - 32 < 0) p1[r] = NEG;
    }
}
__device__ __forceinline__ void mask_all(f32x16& p0, f32x16& p1, bool off) {
    const float NEG = -__builtin_inff();
#pragma unroll
    for (int r = 0; r < 16; ++r) { p0[r] = off ? NEG : p0[r]; p1[r] = off ? NEG : p1[r]; }
}
__device__ __forceinline__ void partialSM(f32x16& p0, f32x16& p1, float& m_reg, float& mn, float& alpha) {
    float pmax = p0[0];
#pragma unroll
    for (int r = 1; r < 16; ++r) pmax = fmaxf(pmax, p0[r]);
#pragma unroll
    for (int r = 0; r < 16; ++r) pmax = fmaxf(pmax, p1[r]);
    { auto rr = __builtin_amdgcn_permlane32_swap(__float_as_uint(pmax), __float_as_uint(pmax), false, false);
      pmax = fmaxf(__uint_as_float(rr[0]), __uint_as_float(rr[1])); }
    constexpr float C2 = 1.4426950408889634f * SCALE;
    if (__builtin_expect(__all((pmax - m_reg) * SCALE <= THR), 1)) { mn = m_reg; alpha = 1.f; }
    else { mn = fmaxf(m_reg, pmax); alpha = __builtin_amdgcn_exp2f((m_reg - mn) * C2); m_reg = mn; }
    const float mnL = -mn * C2;
#pragma unroll
    for (int r = 0; r < 16; ++r) p0[r] = fmaf(p0[r], C2, mnL);
#pragma unroll
    for (int r = 0; r < 16; ++r) p1[r] = fmaf(p1[r], C2, mnL);
#pragma unroll
    for (int r = 0; r < 16; ++r) p0[r] = __builtin_amdgcn_exp2f(p0[r]);
}
__device__ __forceinline__ void finishSM(f32x16& p0, f32x16& p1, float alpha, float& l_reg, bf16x8& pa0, bf16x8& pa1, bf16x8& pa2, bf16x8& pa3) {
#pragma unroll
    for (int r = 0; r < 16; ++r) p1[r] = __builtin_amdgcn_exp2f(p1[r]);
    float ps = 0;
#pragma unroll
    for (int r = 0; r < 16; ++r) ps += p0[r];
#pragma unroll
    for (int r = 0; r < 16; ++r) ps += p1[r];
    { auto rr = __builtin_amdgcn_permlane32_swap(__float_as_uint(ps), __float_as_uint(ps), false, false);
      ps = __uint_as_float(rr[0]) + __uint_as_float(rr[1]); }
    l_reg = l_reg * alpha + ps;
#define PK4(P, B_, OUT) do { unsigned a0 = cvt_pk_bf16(P[B_+0], P[B_+1]), a1 = cvt_pk_bf16(P[B_+2], P[B_+3]);                          \
        unsigned b0 = cvt_pk_bf16(P[B_+4], P[B_+5]), b1 = cvt_pk_bf16(P[B_+6], P[B_+7]);                                             \
        auto r0 = __builtin_amdgcn_permlane32_swap(a0, b0, false, false); auto r1 = __builtin_amdgcn_permlane32_swap(a1, b1, false, false); \
        u32x4 w = {r0[0], r1[0], r0[1], r1[1]}; OUT = *reinterpret_cast<bf16x8*>(&w); } while (0)
    PK4(p0, 0, pa0); PK4(p0, 8, pa1); PK4(p1, 0, pa2); PK4(p1, 8, pa3);
#undef PK4
}
template <int KB>
__device__ __forceinline__ void qkt(f32x16& p0, f32x16& p1, const char* K_lds, int r32, int hi, const bf16x8* qr) {
    p0 = f32x16{}; p1 = f32x16{};
    const char* kb[4];
#pragma unroll
    for (int dd = 0; dd < 4; ++dd) kb[dd] = K_lds + KB * SHM_K + KSWZ(r32, (dd * 16 + hi * 8) * 2);
#pragma unroll
    for (int d0 = 0; d0 < 8; ++d0) { const char* a = kb[d0 & 3] + (d0 >> 2) * 128;
        bf16x8 b0 = *reinterpret_cast<const bf16x8*>(a);
        bf16x8 b1 = *reinterpret_cast<const bf16x8*>(a + 32 * 256);
        p0 = __builtin_amdgcn_mfma_f32_32x32x16_bf16(b0, qr[d0], p0, 0, 0, 0);
        p1 = __builtin_amdgcn_mfma_f32_32x32x16_bf16(b1, qr[d0], p1, 0, 0, 0); }
}
template <int VB>
__device__ __forceinline__ void pv_tile(f32x16* o, int vb0, bf16x8 pa0, bf16x8 pa1, bf16x8 pa2, bf16x8 pa3) {
#define TRRD(dst, off) asm volatile("ds_read_b64_tr_b16 %0, %1 offset:%2" : "=&v"(dst) : "v"(vb0), "i"(off) : "memory")
#define PV_D0(d0) do { s16x4 l0, l1, l2, l3, h0, h1, h2, h3; constexpr int b_ = VB * SHM_V + v_rd_off(d0, 0, 0); \
        TRRD(l0, b_); TRRD(h0, b_ + 2048); TRRD(l1, b_ + 4096); TRRD(h1, b_ + 6144); TRRD(l2, b_ + 8192); TRRD(h2, b_ + 10240); TRRD(l3, b_ + 12288); TRRD(h3, b_ + 14336); \
        asm volatile("s_waitcnt lgkmcnt(0)" ::: "memory"); SBAR();   \
        o[d0] = __builtin_amdgcn_mfma_f32_32x32x16_bf16(pa0, (bf16x8){l0[0], l0[1], l0[2], l0[3], h0[0], h0[1], h0[2], h0[3]}, o[d0], 0, 0, 0);   \
        o[d0] = __builtin_amdgcn_mfma_f32_32x32x16_bf16(pa1, (bf16x8){l1[0], l1[1], l1[2], l1[3], h1[0], h1[1], h1[2], h1[3]}, o[d0], 0, 0, 0);   \
        o[d0] = __builtin_amdgcn_mfma_f32_32x32x16_bf16(pa2, (bf16x8){l2[0], l2[1], l2[2], l2[3], h2[0], h2[1], h2[2], h2[3]}, o[d0], 0, 0, 0);   \
        o[d0] = __builtin_amdgcn_mfma_f32_32x32x16_bf16(pa3, (bf16x8){l3[0], l3[1], l3[2], l3[3], h3[0], h3[1], h3[2], h3[3]}, o[d0], 0, 0, 0); } while (0)
    PV_D0(0); PV_D0(1); PV_D0(2); PV_D0(3);
#undef PV_D0
#undef TRRD
}

struct BlockRef { const bf16_t* Q; const bf16_t* K; const bf16_t* V; bf16_t* O; const bf16_t* Gt; const float* KM; int P0; };
struct Seam { bf16x8 qr[8]; bf16x8 st_v0, st_v1, st_k0, st_k1; };
#define ROW(p, k0, rr) ((p) + (size_t)((k0) + (rr)) * D + sc)
#define VMW() asm volatile("s_waitcnt vmcnt(0)" ::: "memory")
#define VMWN(n) asm volatile("s_waitcnt vmcnt(%0)" :: "i"(n) : "memory")
#define SLOAD_H(Kp, Vp, k0) do { S.st_v0 = load8(ROW(Vp, k0, sr)); S.st_v1 = load8(ROW(Vp, k0, 32 + sr));              \
                         S.st_k0 = load8(ROW(Kp, k0, sr)); S.st_k1 = load8(ROW(Kp, k0, 32 + sr)); } while (0)
#define SWRITE_HK(bf) do { *(bf16x8*)(K_lds + (bf) * SHM_K + kws) = S.st_k0; *(bf16x8*)(K_lds + (bf) * SHM_K + kws + 32 * 256) = S.st_k1; } while (0)
#define SWRITE_HV(bf) do { *(bf16x8*)(V_lds + (bf) * SHM_V + vst0) = S.st_v0; *(bf16x8*)(V_lds + (bf) * SHM_V + vst1) = S.st_v1; } while (0)
#define SWRITE_H(bf) do { SWRITE_HV(bf); SWRITE_HK(bf); } while (0)
__device__ __forceinline__ void moba_prime(const BlockRef& cur, char* lds, Seam& S, int wv) {
    const int tid = opq_tid(wv), wid = __builtin_amdgcn_readfirstlane(tid >> 6), lane = tid & 63, r32 = lane & 31, hi = lane >> 5;
    const int sr = tid >> 4, sc = (tid & 15) * 8, kws = KSWZ(sr, sc * 2); char* K_lds = lds + 2 * SHM_V;
#pragma unroll
    for (int d0 = 0; d0 < 8; ++d0) S.qr[d0] = load8(cur.Q + (size_t)(wid * QBLK + r32) * D + d0 * 16 + hi * 8);
    SLOAD_H(cur.K, cur.V, 0); VMW(); SWRITE_HK(0);
    __syncthreads();
}
__device__ __forceinline__ unsigned moba_select(const Seam& S, const float* KM, int qb, int hi) {
    if (qb <= 3) return (1u << qb) - 1u;
    float sc_[8];
#pragma unroll
    for (int j = 0; j < 8; ++j) sc_[j] = 0.f;
#pragma unroll
    for (int j = 0; j < 7; ++j) {
        if (j < qb) {
            float s = 0.f;
#pragma unroll
            for (int d0 = 0; d0 < 8; ++d0) {
                const f32x4 k0 = *(const f32x4*)(KM + j * D + d0 * 16 + hi * 8), k1 = *(const f32x4*)(KM + j * D + d0 * 16 + hi * 8 + 4);
                const bf16x8 q = S.qr[d0];
                s += bf1((bf16_t)q[0]) * k0[0] + bf1((bf16_t)q[1]) * k0[1] + bf1((bf16_t)q[2]) * k0[2] + bf1((bf16_t)q[3]) * k0[3]
                   + bf1((bf16_t)q[4]) * k1[0] + bf1((bf16_t)q[5]) * k1[1] + bf1((bf16_t)q[6]) * k1[2] + bf1((bf16_t)q[7]) * k1[3];
            }
            s += __shfl_xor(s, 32);
            sc_[j] = s;
        }
    }
    unsigned sel = 0u;
#pragma unroll
    for (int it = 0; it < 3; ++it) {
        float best = -__builtin_inff(); int bi = 0;
#pragma unroll
        for (int j = 0; j < 7; ++j) { const bool ok = (j < qb) && !((sel >> j) & 1u) && (sc_[j] > best); best = ok ? sc_[j] : best; bi = ok ? j : bi; }
        sel |= 1u << bi;
    }
    return sel;
}
__device__ __forceinline__ void moba_block(const BlockRef& cur, const BlockRef& nxt, char* lds, Seam& S, int wv) {
    const int tid = opq_tid(wv), wid = __builtin_amdgcn_readfirstlane(tid >> 6), lane = tid & 63, r32 = lane & 31, hi = lane >> 5;
    const int NT = cur.P0 / KVBLK + 4;
    const int qb = cur.P0 >> 8;
    const int qlo = cur.P0 + wid * QBLK, qm = qlo + r32 - 4 * hi;
    char* V_lds = lds; char* K_lds = lds + 2 * SHM_V;
    float* ws = (float*)(lds + 2 * SHM_V + 2 * SHM_K) + wid * 64; float* li_l = ws, * al_l = ws + 32;
    float m_reg = -1e30f, l_reg = 0; f32x16 o[4] = {};
    const int sr = tid >> 4, sc = (tid & 15) * 8, vst0 = v_st(sr, sc), vst1 = v_st(32 + sr, sc), kws = KSWZ(sr, sc * 2);
    const int vb0 = (int)(uintptr_t)V_lds + v_rd_base(lane);
    const bf16_t* Kh = cur.K; const bf16_t* Vh = cur.V;
    const unsigned sel = moba_select(S, cur.KM, qb, hi);
    const bool need_sel = qb > 3;
#define RESC(a) do { if (__any((a) < 1.f)) { if (hi == 0) al_l[r32] = (a); asm volatile("s_waitcnt lgkmcnt(0)" ::: "memory");              \
                     for (int d_ = 0; d_ < 4; ++d_) for (int r = 0; r < 16; ++r) o[d_][r] *= al_l[crow(r, hi)]; } } while (0)
#define KBASE(t) ((t) * KVBLK)
#define MASKT(P0_, P1_, t) do { const int kb_ = KBASE(t); \
        if (kb_ < cur.P0) { if (need_sel) mask_all(P0_, P1_, ((sel >> (kb_ >> 8)) & 1u) == 0u); } \
        else if (kb_ + KVBLK - 1 > qlo) mask_tile(P0_, P1_, qm - kb_); } while (0)
#define SEAM_K0() do { VMWN(8); SWRITE_HK(0); SBAR(); } while (0)
    f32x16 pA0, pA1, pB0, pB1; float mnA, mnB, alA, alB; bf16x8 pa0, pa1, pa2, pa3;
    SWRITE_HV(0); SBAR();
    SLOAD_H(Kh, Vh, KBASE(1));
    SBAR(); qkt<0>(pA0, pA1, K_lds, r32, hi, S.qr);
    MASKT(pA0, pA1, 0); partialSM(pA0, pA1, m_reg, mnA, alA);
    VMW(); SWRITE_H(1);
    __syncthreads();
#define HALF_STEP(PX0, PX1, mnX, alX, PY0, PY1, alY, t, KB, VB, SB) do {                                                      \
        SBAR(); qkt<KB>(PX0, PX1, K_lds, r32, hi, S.qr);                                                                       \
        finishSM(PY0, PY1, alY, l_reg, pa0, pa1, pa2, pa3); SBAR();                                                           \
        if ((t) + 1 < NT) { SLOAD_H(Kh, Vh, KBASE((t) + 1)); SBAR(); }                                                        \
        pv_tile<VB>(o, vb0, pa0, pa1, pa2, pa3); MASKT(PX0, PX1, (t)); partialSM(PX0, PX1, m_reg, mnX, alX);                  \
        __syncthreads();                                                                                                      \
        if ((t) + 1 < NT) { VMW(); SWRITE_H(SB); }                                                                            \
        RESC(alX); __syncthreads(); } while (0)
    for (int t = 1; t + 1 < NT; t += 2) {
        HALF_STEP(pB0, pB1, mnB, alB, pA0, pA1, alA, t, 1, 0, 0);
        HALF_STEP(pA0, pA1, mnA, alA, pB0, pB1, alB, t + 1, 0, 1, 1);
    }
    SBAR(); qkt<1>(pB0, pB1, K_lds, r32, hi, S.qr); SBAR();
    SLOAD_H(nxt.K, nxt.V, 0); SBAR();
#pragma unroll
    for (int d0 = 0; d0 < 8; ++d0) S.qr[d0] = load8(nxt.Q + (size_t)(wid * QBLK + r32) * D + d0 * 16 + hi * 8);
    SBAR();
    finishSM(pA0, pA1, alA, l_reg, pa0, pa1, pa2, pa3); SBAR();
    pv_tile<0>(o, vb0, pa0, pa1, pa2, pa3);
    MASKT(pB0, pB1, NT - 1); partialSM(pB0, pB1, m_reg, mnB, alB); __syncthreads(); RESC(alB);
    finishSM(pB0, pB1, alB, l_reg, pa0, pa1, pa2, pa3); SBAR(); pv_tile<1>(o, vb0, pa0, pa1, pa2, pa3);
    SBAR(); SEAM_K0();
    if (hi == 0) li_l[r32] = l_reg; asm volatile("s_waitcnt lgkmcnt(0)" ::: "memory");
    bf16_t* Ow = cur.O + (size_t)(wid * QBLK) * DM; const bf16_t* Gw = cur.Gt + (size_t)(wid * QBLK) * DM;
#pragma unroll
    for (int r = 0; r < 16; ++r) { const int orow = crow(r, hi); const float rl = __builtin_amdgcn_rcpf(li_l[orow]);
#pragma unroll
        for (int d0 = 0; d0 < 4; ++d0) { const float gv = bf1(Gw[(size_t)orow * DM + d0 * 32 + r32]);
            const float v = o[d0][r] * rl * fsilu(gv);
            const float vn = __shfl_xor(v, 1);
            if ((r32 & 1) == 0) *(unsigned*)(Ow + (size_t)orow * DM + d0 * 32 + r32) = cvt_pk_bf16(v, vn); } }
    __syncthreads();
#undef RESC
#undef KBASE
#undef MASKT
#undef SEAM_K0
#undef HALF_STEP
}
#undef ROW
#undef VMW
#undef VMWN
#undef SLOAD_H
#undef SWRITE_HK
#undef SWRITE_HV
#undef SWRITE_H

__device__ __forceinline__ BlockRef mk_ref(int L, int pass, const bf16_t* Q, const bf16_t* K, const bf16_t* V, bf16_t* O, const bf16_t* Gt, const float* KM) {
    const int bh = L >> 2, x = L & 3, qb = pass ? 7 - x : x, b = bh >> 3, h = bh & 7;
    BlockRef r;
    r.Q = Q + ((size_t)bh * SEQ + (size_t)qb * QB) * D; r.K = K + (size_t)bh * SEQ * D; r.V = V + (size_t)bh * SEQ * D;
    r.O = O + ((size_t)b * SEQ + (size_t)qb * QB) * DM + h * DH; r.Gt = Gt + ((size_t)b * SEQ + (size_t)qb * QB) * DM + h * DH;
    r.KM = KM + (size_t)bh * 8 * D; r.P0 = qb * QB;
    return r;
}
__device__ __forceinline__ void attn_phase(char* lds, const bf16_t* Q, const bf16_t* K, const bf16_t* V, bf16_t* O, const bf16_t* Gt, const float* KM, int wv) {
    const int total = NB * NH * 4, stride = gridDim.x;
    int L = opq_bid(); if (L >= total) return;
    int pass = 0;
    BlockRef cur = mk_ref(L, 0, Q, K, V, O, Gt, KM);
    Seam S;
    moba_prime(cur, lds, S, wv);
    for (;;) {
        const bool more_pass = pass == 0, more_item = L + stride < total, last = !more_pass && !more_item;
        int passn = pass + 1, Ln = L;
        if (!more_pass) { passn = 0; Ln = more_item ? L + stride : L; }
        const BlockRef nxt = last ? cur : mk_ref(Ln, passn, Q, K, V, O, Gt, KM);
        moba_block(cur, nxt, lds, S, wv);
        if (last) break;
        cur = nxt; pass = passn; L = Ln;
    }
}
}

#ifndef REP_MASK
#define REP_MASK 0
#endif
#ifndef BAR_REP
#define BAR_REP 1
#endif
struct Args { const float* in[21]; float* out; unsigned char* ws; int ph_lo, ph_hi; };
typedef const __attribute__((address_space(4))) Args* ArgsP;
#define AIN(i) ((const float*)ap->in[i])

__device__ __forceinline__ void transpose_item(const float* W, int ldw, bf16_t* WT, int ldt, LAS float* scr, int lane) {
#pragma unroll 8
    for (int i = 0; i < 32; ++i) { const int kk = 2 * i + (lane >> 5); scr[kk * 33 + (lane & 31)] = W[(size_t)kk * ldw + (lane & 31)]; }
    asm volatile("s_waitcnt lgkmcnt(0)" ::: "memory");
    const int c = lane & 7;
#pragma unroll
    for (int j = 0; j < 4; ++j) { const int n = (lane >> 3) + 8 * j; const LAS float* s = scr + (8 * c) * 33 + n;
        u32x4 o; o.x = cvt_pk_bf16(s[0 * 33], s[1 * 33]); o.y = cvt_pk_bf16(s[2 * 33], s[3 * 33]); o.z = cvt_pk_bf16(s[4 * 33], s[5 * 33]); o.w = cvt_pk_bf16(s[6 * 33], s[7 * 33]);
        *(u32x4*)(WT + (size_t)n * ldt + 8 * c) = o; }
    asm volatile("s_waitcnt lgkmcnt(0)" ::: "memory");
}
__device__ __forceinline__ void transpose_mat(const float* W, int K, int N, bf16_t* WT, int item, LAS float* scr, int lane) {
    const int nblk = N / 32, kb = item / nblk, nb = item % nblk;
    transpose_item(W + (size_t)(64 * kb) * N + 32 * nb, N, WT + (size_t)(32 * nb) * K + 64 * kb, K, scr, lane);
}

__device__ __forceinline__ void prep_phase(ArgsP ap, LAS unsigned char* lds, int wave, int lane) {
    unsigned char* ws = (unsigned char*)ap->ws;
    LAS float* scr = (LAS float*)(lds + wave * 16384);
    const int gw = opq_bid() * NWAVES + wave, NGW = gridDim.x * NWAVES;
    constexpr int I_BIG = (DM / 64) * (2 * DM / 32);
    constexpr int I_SQ = (DM / 64) * (DM / 32);
    constexpr int I_G = (256 / 64) * (256 / 32);
    constexpr int N_T = 2 * I_BIG + 2 * I_SQ + 2 * I_BIG + I_BIG + 2 * I_SQ + 16 * I_G;
    constexpr int N_GEMV = (MODV_LD / 64) * 8;
    for (int rep = 0; rep < 1 + (REP_MASK & 1); ++rep)
    for (int it = gw; it < (rep ? N_T : N_T + N_GEMV); it += NGW) {
        int r = it;
        if (r < 2 * I_BIG) { const int l = r / I_BIG; transpose_mat(AIN(5) + (size_t)l * DM * 2 * DM, DM, 2 * DM, (bf16_t*)(ws + WS_WIN) + (size_t)l * 2 * DM * DM, r % I_BIG, scr, lane); continue; } r -= 2 * I_BIG;
        if (r < 2 * I_SQ) { const int l = r / I_SQ; transpose_mat(AIN(13) + (size_t)l * DM * DM, DM, DM, (bf16_t*)(ws + WS_WOUT) + (size_t)l * DM * DM, r % I_SQ, scr, lane); continue; } r -= 2 * I_SQ;
        if (r < 2 * I_BIG) { const int l = r / I_BIG; transpose_mat(AIN(18) + (size_t)l * DM * 2 * DM, DM, 2 * DM, (bf16_t*)(ws + (l ? WS_ATTIN1 : WS_ATTIN0)), r % I_BIG, scr, lane); continue; } r -= 2 * I_BIG;
        if (r < I_BIG) { transpose_mat(AIN(17), DM, 2 * DM, (bf16_t*)(ws + WS_WKV), r, scr, lane); continue; } r -= I_BIG;
        if (r < 2 * I_SQ) { const int l = r / I_SQ; transpose_mat(AIN(19) + (size_t)l * DM * DM, DM, DM, (bf16_t*)(ws + WS_ATTOUT) + (size_t)l * DM * DM, r % I_SQ, scr, lane); continue; } r -= 2 * I_SQ;
        if (r < 16 * I_G) {
            const int mat = r / I_G, item = r % I_G, which = mat >> 3, lh = mat & 7;
            const float* W = (which ? AIN(10) : AIN(8)) + (size_t)lh * 256 * 256;
            bf16_t* WT = (bf16_t*)(ws + WS_WG) + (size_t)lh * 512 * 256;
            const int kb = item / 8, nb = item % 8, n0 = 32 * nb, drow = 256 * (n0 >> 7) + 128 * which + (n0 & 127);
            transpose_item(W + (size_t)(64 * kb) * 256 + n0, 256, WT + (size_t)drow * 256 + 64 * kb, 256, scr, lane);
            continue;
        } r -= 16 * I_G;
        { const int cgp = r >> 3, kc = r & 7, k0 = kc * 128;
          const float* W; int ldw, n0; const float* bias;
          if (cgp < 192) { const int l = cgp / 48; n0 = (cgp % 48) * 64; W = AIN(2) + (size_t)l * DM * 3 * DM; ldw = 3 * DM; bias = AIN(3) + l * 3 * DM; }
          else { n0 = (cgp - 192) * 64; W = AIN(15); ldw = 2 * DM; bias = AIN(16); }
          const float* c = AIN(1);
#pragma unroll
          for (int i = 0; i < 16; ++i) { const int idx = i * 64 + lane, b = idx >> 7, kk = idx & 127; scr[kk * 8 + b] = fsilu(c[b * DM + k0 + kk]); }
          asm volatile("s_waitcnt lgkmcnt(0)" ::: "memory");
          float acc[8];
#pragma unroll
          for (int b = 0; b < 8; ++b) acc[b] = 0.f;
          const float* wp = W + (size_t)k0 * ldw + n0 + lane;
#pragma unroll 8
          for (int kk = 0; kk < 128; ++kk) { const float w = wp[(size_t)kk * ldw];
              const f32x4 c0 = *(const LAS f32x4*)(scr + kk * 8), c1 = *(const LAS f32x4*)(scr + kk * 8 + 4);
              acc[0] += w * c0[0]; acc[1] += w * c0[1]; acc[2] += w * c0[2]; acc[3] += w * c0[3];
              acc[4] += w * c1[0]; acc[5] += w * c1[1]; acc[6] += w * c1[2]; acc[7] += w * c1[3]; }
          const float bv = (kc == 0) ? bias[n0 + lane] : 0.f;
          float* mv = (float*)(ws + WS_MODV) + cgp * 64 + lane;
#pragma unroll
          for (int b = 0; b < 8; ++b) atomicAdd(mv + (size_t)b * MODV_LD, acc[b] + bv);
          asm volatile("s_waitcnt lgkmcnt(0)" ::: "memory");
        }
    }
}

__device__ __forceinline__ void norm_phase(const float* xin, bf16_t* o1, const float* g1, const float* modv, int sh1, int sc1c,
                                            bf16_t* o2, const float* g2, int sh2, int sc2c, int wave, int lane) {
    const int gw = opq_bid() * NWAVES + wave, NGW = gridDim.x * NWAVES;
    for (int rb = gw; rb < MTOK / 8; rb += NGW) {
        const int r0 = rb * 8, b = r0 / SEQ;
        const float* mv = modv + (size_t)b * MODV_LD;
        f32x4 gs1[4], sf1[4], gs2[4], sf2[4];
#pragma unroll
        for (int j = 0; j < 4; ++j) { const int idx = 4 * lane + 256 * j;
            const f32x4 gv = *(const f32x4*)(g1 + idx), sc = *(const f32x4*)(mv + sc1c + idx); gs1[j] = gv * (sc + 1.f); sf1[j] = *(const f32x4*)(mv + sh1 + idx);
            if (o2) { const f32x4 gv2 = *(const f32x4*)(g2 + idx), sc2 = *(const f32x4*)(mv + sc2c + idx); gs2[j] = gv2 * (sc2 + 1.f); sf2[j] = *(const f32x4*)(mv + sh2 + idx); }
            else { gs2[j] = gs1[j]; sf2[j] = sf1[j]; } }
        for (int rr = 0; rr < 8; ++rr) {
            const size_t row = (size_t)(r0 + rr);
            const f32x4* xr = (const f32x4*)(xin + row * DM) + lane;
            f32x4 v[4]; float s = 0.f;
#pragma unroll
            for (int j = 0; j < 4; ++j) { v[j] = xr[64 * j]; s += (v[j].x * v[j].x + v[j].y * v[j].y) + (v[j].z * v[j].z + v[j].w * v[j].w); }
            const float rstd = 1.f / sqrtf(wave_sum(s) * (1.f / DM) + EPS);
#pragma unroll
            for (int j = 0; j < 4; ++j) { const f32x4 t = v[j] * rstd; const f32x4 y = t * gs1[j] + sf1[j];
                u32x2 w; w.x = cvt_pk_bf16(y.x, y.y); w.y = cvt_pk_bf16(y.z, y.w);
                *((u32x2*)(o1 + row * DM) + lane + 64 * j) = w;
                if (o2) { const f32x4 y2 = t * gs2[j] + sf2[j]; u32x2 w2; w2.x = cvt_pk_bf16(y2.x, y2.y); w2.y = cvt_pk_bf16(y2.z, y2.w);
                    *((u32x2*)(o2 + row * DM) + lane + 64 * j) = w2; } }
        }
    }
}
__device__ __forceinline__ void final_norm_phase(float* x, const float* g, int wave, int lane) {
    const int gw = opq_bid() * NWAVES + wave, NGW = gridDim.x * NWAVES;
    f32x4 gv[4];
#pragma unroll
    for (int j = 0; j < 4; ++j) gv[j] = *(const f32x4*)(g + 4 * lane + 256 * j);
    for (int row = gw; row < MTOK; row += NGW) {
        f32x4* xr = (f32x4*)(x + (size_t)row * DM) + lane;
        f32x4 v[4]; float s = 0.f;
#pragma unroll
        for (int j = 0; j < 4; ++j) { v[j] = xr[64 * j]; s += (v[j].x * v[j].x + v[j].y * v[j].y) + (v[j].z * v[j].z + v[j].w * v[j].w); }
        const float rstd = 1.f / sqrtf(wave_sum(s) * (1.f / DM) + EPS);
#pragma unroll
        for (int j = 0; j < 4; ++j) xr[64 * j] = v[j] * rstd * gv[j];
    }
}

__device__ __forceinline__ void conv_phase(const bf16_t* UP, bf16_t* U, const float* cw, const float* cb, int tid) {
    const int ch = 2 * tid;
    const f32x2 w0 = *(const f32x2*)(cw + ch), w1 = *(const f32x2*)(cw + DM + ch), w2 = *(const f32x2*)(cw + 2 * DM + ch), w3 = *(const f32x2*)(cw + 3 * DM + ch), bb = *(const f32x2*)(cb + ch);
    for (int it = opq_bid(); it < NB * 32; it += gridDim.x) {
        const int b = it >> 5, c = it & 31; const size_t base = ((size_t)b * SEQ + c * 64) * DM + ch;
        f32x2 x0 = {0.f, 0.f}, x1 = {0.f, 0.f}, x2 = {0.f, 0.f};
        if (c > 0) { const unsigned a0 = *(const unsigned*)(UP + base - 3 * DM), a1 = *(const unsigned*)(UP + base - 2 * DM), a2 = *(const unsigned*)(UP + base - DM);
            x0 = (f32x2){bf_lo(a0), bf_hi(a0)}; x1 = (f32x2){bf_lo(a1), bf_hi(a1)}; x2 = (f32x2){bf_lo(a2), bf_hi(a2)}; }
#pragma unroll 16
        for (int t = 0; t < 64; ++t) { const unsigned a = *(const unsigned*)(UP + base + (size_t)t * DM); const f32x2 x3 = {bf_lo(a), bf_hi(a)};
            const f32x2 y = bb + w0 * x0 + w1 * x1 + w2 * x2 + w3 * x3;
            *(unsigned*)(U + base + (size_t)t * DM) = cvt_pk_bf16(y.x, y.y);
            x0 = x1; x1 = x2; x2 = x3; }
    }
}
#define XB_TMO      128
#define XB_XCNT(j)  (256  + 64 * (j))
#define XB_XSUB(j)  (1280 + 64 * (j))
#define XB_XGEN(j)  (2304 + 64 * (j))
#define XB_TOP      3328
#define XB_TOPGEN   3392
#define XCD_BAR_WORDS 3456
#define XB_SPIN_CAP (1u << 18)
constexpr size_t WS_BAR = 16384;
constexpr int LDS_MISC = 131072 + 320;
__device__ __forceinline__ unsigned xb_ld(unsigned* p)              { return __hip_atomic_load(p, __ATOMIC_RELAXED, __HIP_MEMORY_SCOPE_AGENT); }
__device__ __forceinline__ unsigned xb_add(unsigned* p, unsigned v) { return __hip_atomic_fetch_add(p, v, __ATOMIC_RELAXED, __HIP_MEMORY_SCOPE_AGENT); }
__device__ __forceinline__ unsigned xb_xcc_id() { return (unsigned)__builtin_amdgcn_s_getreg((3 << 11) | 20) & 0xFu; }
#define XB_SPIN(cond, bar) do { unsigned _sp = 0; while (cond) { __builtin_amdgcn_s_sleep(1); \
    if ((++_sp & 255u) == 0u) { if (xb_ld(&(bar)[XB_TMO])) break; if (_sp > XB_SPIN_CAP) { atomicAdd(&(bar)[XB_TMO], 1u); break; } } } } while (0)
__device__ __forceinline__ void xcd_barrier_complete(unsigned* bar, unsigned x, unsigned& nloc, unsigned& nx) {
    const unsigned G = gridDim.x * gridDim.y * gridDim.z;
    unsigned sum, cnt, mine, sp = 0u;
    for (;;) {
        sum = 0u; cnt = 0u; mine = 0u;
#pragma unroll
        for (unsigned j = 0; j < 16; ++j) { const unsigned c = xb_ld(&bar[XB_XCNT(j)]); sum += c; cnt += (c > 0u) ? 1u : 0u; mine = (j == x) ? c : mine; }
        if (sum == G) break;
        __builtin_amdgcn_s_sleep(1);
        if ((++sp & 255u) == 0u) { if (xb_ld(&bar[XB_TMO])) break; if (sp > XB_SPIN_CAP) { atomicAdd(&bar[XB_TMO], 1u); break; } }
    }
    nloc = mine > 0u ? mine : 1u; nx = cnt > 0u ? cnt : 1u;
}
__device__ __forceinline__ void xcd_barrier(unsigned* bar, volatile LAS unsigned* st, int tid) {
    asm volatile("s_waitcnt vmcnt(0)" ::: "memory");
    __syncthreads();
    if (tid == 0) {
        const unsigned x = xb_xcc_id();
        __builtin_amdgcn_s_waitcnt(0);
        unsigned nloc = st[0], nx = st[1];
        if (nloc == 0u) { xcd_barrier_complete(bar, x, nloc, nx); st[0] = nloc; st[1] = nx; }
        const unsigned old = xb_add(&bar[XB_XSUB(x)], 1u);
        const unsigned gen = old / nloc;
        if (old + 1u == (gen + 1u) * nloc) {
            __builtin_amdgcn_fence(__ATOMIC_RELEASE, "agent");
            asm volatile("s_waitcnt vmcnt(0)" ::: "memory");
            const unsigned og = xb_add(&bar[XB_TOP], 1u);
            const unsigned tg = og / nx;
            if (og + 1u == (tg + 1u) * nx) xb_add(&bar[XB_TOPGEN], 1u);
            else XB_SPIN(xb_ld(&bar[XB_TOPGEN]) == tg, bar);
            __builtin_amdgcn_fence(__ATOMIC_ACQUIRE, "agent");
            xb_add(&bar[XB_XGEN(x)], 1u);
            asm volatile("s_waitcnt vmcnt(0)" ::: "memory");
        } else {
            XB_SPIN(xb_ld(&bar[XB_XGEN(x)]) == gen, bar);
            __builtin_amdgcn_fence(__ATOMIC_ACQUIRE, "agent");
            asm volatile("s_waitcnt vmcnt(0)" ::: "memory");
        }
    }
    __syncthreads();
}

constexpr int NPHASE = 22;
#ifndef PH_EN
#define PH_EN 0xFFFF
#endif
#define EN(b) ((PH_EN >> (b)) & 1)
#ifndef REP_MASK
#define REP_MASK 0
#endif
#define REPS(b) for (int rep_ = 0; rep_ < EN(b) * (1 + ((REP_MASK >> (b)) & 1)); ++rep_)
template <int ph>
__device__ __forceinline__ void run_phase(unsigned char* lds, int wv) {
    LAS unsigned char* ldsl = (LAS unsigned char*)lds;
    {
        ArgsP ap = (ArgsP)__builtin_amdgcn_kernarg_segment_ptr();
        asm volatile("" : "+s"(ap));
        const int G = gridDim.x;
        unsigned char* ws = (unsigned char*)ap->ws;
        float* modv = (float*)(ws + WS_MODV);
        float* kmean = (float*)(ws + WS_KMEAN);
        bf16_t* HN = (bf16_t*)(ws + WS_HN); bf16_t* HKV = (bf16_t*)(ws + WS_HKV); bf16_t* UPRE = (bf16_t*)(ws + WS_UPRE); bf16_t* GB = (bf16_t*)(ws + WS_G);
        bf16_t* LAb = (bf16_t*)(ws + WS_LA); bf16_t* BINb = (bf16_t*)(ws + WS_BIN);
        float* xw = (float*)ap->out;
        const int tid = opq_tid(wv), c = opq_bid();
        const int lane = tid & 63, wave = __builtin_amdgcn_readfirstlane(tid >> 6);
        if (ph == 0) {
            if (EN(0)) prep_phase(ap, ldsl, wave, lane);
        } else if (ph <= 12) {
            const int l = (ph - 1) / 6, k = (ph - 1) % 6;
            const float* xin = (l == 0) ? AIN(0) : xw;
            if (k == 0) {
                REPS(1) norm_phase(xin, HN, AIN(4) + l * DM, modv, l * 3 * DM, l * 3 * DM + DM, nullptr, nullptr, 0, 0, wave, lane);
            } else if (k == 1) {
                pg8::Gemm g{HN, (const bf16_t*)(ws + WS_WIN) + (size_t)l * 2 * DM * DM, DM, DM, DM, 0, 0};
                pg8::MultiOrder S; S.init(MTOK, 2 * DM, 1, G, c);
                pg8::EpiSplit E{UPRE, GB};
                REPS(2) pg8::gemm_phase(ldsl, g, S, E, wv);
            } else if (k == 2) {
                REPS(3) conv_phase(UPRE, HKV, AIN(6) + l * 4 * DM, AIN(7) + l * DM, tid);
            } else if (k == 3) {
                pg8::Gemm g{HKV, (const bf16_t*)(ws + WS_WG) + (size_t)l * 4 * 512 * 256, DM, 256, 256, 256 * 2, 512 * 256 * 2};
                pg8::MultiOrder S; S.init(MTOK, 512, 4, G, c);
                pg8::EpiGatesA E{HKV, (float*)(ws + WS_AGGA), (float*)(ws + WS_AGGB), AIN(9) + l * DM, AIN(11) + l * DM, AIN(12) + l * DM};
                REPS(4) pg8::gemm_phase(ldsl, g, S, E, wv);
            } else if (k == 4) {
                pg8::Gemm g{HKV, (const bf16_t*)(ws + WS_WG) + (size_t)l * 4 * 512 * 256, DM, 256, 256, 256 * 2, 512 * 256 * 2};
                pg8::MultiOrder S; S.init(MTOK, 512, 4, G, c);
                pg8::EpiGatesB E{HKV, GB, HN, (const float*)(ws + WS_AGGA), (const float*)(ws + WS_AGGB), AIN(9) + l * DM, AIN(11) + l * DM, AIN(12) + l * DM};
                REPS(5) pg8::gemm_phase(ldsl, g, S, E, wv);
            } else {
                pg8::Gemm g{HN, (const bf16_t*)(ws + WS_WOUT) + (size_t)l * DM * DM, DM, DM, DM, 0, 0};
                pg8::MultiOrder S; S.init(MTOK, DM, 1, G, c);
                pg8::EpiRes E{xin, xw, modv + l * 3 * DM + 2 * DM};
                REPS(7) pg8::gemm_phase(ldsl, g, S, E, wv);
            }
        } else if (ph <= 20) {
            const int i = (ph - 13) / 4, k = (ph - 13) % 4, l = 2 + i;
            if (k == 0) {
                REPS(8) norm_phase(xw, HN, AIN(4) + l * DM, modv, l * 3 * DM, l * 3 * DM + DM,
                           i == 0 ? HKV : nullptr, AIN(14), 4 * 3 * DM, 4 * 3 * DM + DM, wave, lane);
            } else if (k == 1) {
                pg8::Gemm g{HN, (const bf16_t*)(ws + (i == 0 ? WS_ATTIN0 : WS_ATTIN1)), DM, DM, DM, (long)(WS_HKV - WS_HN), (long)(WS_WKV - WS_ATTIN0)};
                pg8::MultiOrder S; S.init(MTOK, 2 * DM, i == 0 ? 2 : 1, G, c);
                pg8::EpiQKV E{ws, kmean};
                REPS(9) pg8::gemm_phase(ldsl, g, S, E, wv);
            } else if (k == 2) {
                REPS(10) att::attn_phase((char*)lds, UPRE, LAb, BINb, HN, GB, kmean, wv);
            } else {
                pg8::Gemm g{HN, (const bf16_t*)(ws + WS_ATTOUT) + (size_t)i * DM * DM, DM, DM, DM, 0, 0};
                pg8::MultiOrder S; S.init(MTOK, DM, 1, G, c);
                pg8::EpiRes E{xw, xw, modv + l * 3 * DM + 2 * DM};
                REPS(11) pg8::gemm_phase(ldsl, g, S, E, wv);
            }
        } else {
            REPS(12) final_norm_phase(xw, AIN(20), wave, lane);
        }
    }
}
__global__ void __launch_bounds__(NTHR, 2) yoco_fwd(Args a_) {
    extern __shared__ __attribute__((aligned(16))) unsigned char lds[];
    const int ph_lo = a_.ph_lo, ph_hi = a_.ph_hi;
    const int wv = __builtin_amdgcn_readfirstlane((int)threadIdx.x >> 6);
    if (ph_hi - ph_lo > 1) {
        if (threadIdx.x < 2) ((volatile LAS unsigned*)((LAS unsigned char*)lds + LDS_MISC))[threadIdx.x] = 0u;
        if (threadIdx.x == 0) (void)xb_add(&((unsigned*)(a_.ws + WS_BAR))[XB_XCNT(xb_xcc_id())], 1u);
        __syncthreads();
    }
#define SEAM(P) do { if ((P) == 0) cg::this_grid().sync(); else { ArgsP ap_ = (ArgsP)__builtin_amdgcn_kernarg_segment_ptr(); asm volatile("" : "+s"(ap_)); \
        xcd_barrier((unsigned*)((unsigned char*)ap_->ws + WS_BAR), (volatile LAS unsigned*)((LAS unsigned char*)lds + LDS_MISC), opq_tid(wv)); } } while (0)
#define RUN(P) if ((P) >= ph_lo && (P) < ph_hi) { run_phase<P>(lds, wv); if ((P) + 1 < ph_hi) { for (int br_ = 0; br_ < BAR_REP; ++br_) SEAM(P); } }
    RUN(0) RUN(1) RUN(2) RUN(3) RUN(4) RUN(5) RUN(6) RUN(7) RUN(8) RUN(9) RUN(10) RUN(11)
    RUN(12) RUN(13) RUN(14) RUN(15) RUN(16) RUN(17) RUN(18) RUN(19) RUN(20) RUN(21)
#undef RUN
#undef SEAM
}

extern "C" void kernel_launch(void* const* d_in, const int* in_sizes, int n_in, void* d_out, int out_size, void* d_ws, size_t ws_size, hipStream_t stream) {
    static int grid = 0;
    if (grid == 0) {
        if (n_in != 21 || out_size != MTOK * DM || ws_size < WS_END) { fprintf(stderr, "kernel_launch: unexpected shapes (n_in %d out %d ws %zu)\n", n_in, out_size, ws_size); grid = -1; return; }
        int dev = 0, cus = 0, per_cu = 0;
        (void)hipGetDevice(&dev);
        if (hipDeviceGetAttribute(&cus, hipDeviceAttributeMultiprocessorCount, dev) != hipSuccess || cus <= 0) cus = 256;
        if (hipFuncSetAttribute((const void*)yoco_fwd, hipFuncAttributeMaxDynamicSharedMemorySize, LDS_BYTES) != hipSuccess) { fprintf(stderr, "kernel_launch: hipFuncSetAttribute failed\n"); grid = -1; return; }
        if (hipOccupancyMaxActiveBlocksPerMultiprocessor(&per_cu, (const void*)yoco_fwd, NTHR, LDS_BYTES) != hipSuccess || per_cu < 1) { fprintf(stderr, "kernel_launch: occupancy query says %d\n", per_cu); per_cu = 1; }
        (void)hipGetLastError();
        grid = cus;
    }
    if (grid < 0) return;
    (void)hipMemsetAsync((char*)d_ws + WS_CTL, 0, CTL_ZERO_BYTES, stream);
    Args a{};
    for (int i = 0; i < 21; ++i) a.in[i] = (const float*)d_in[i];
    a.out = (float*)d_out; a.ws = (unsigned char*)d_ws;
#if MK_MULTI_LAUNCH
    for (int ph = 0; ph < NPHASE; ++ph) { a.ph_lo = ph; a.ph_hi = ph + 1; hipLaunchKernelGGL(yoco_fwd, dim3(grid), dim3(NTHR), LDS_BYTES, stream, a); }
#else
    a.ph_lo = 0; a.ph_hi = NPHASE;
    void* kargs[] = {&a};
    hipError_t e = hipLaunchCooperativeKernel((const void*)yoco_fwd, dim3(grid), dim3(NTHR), kargs, LDS_BYTES, stream);
    if (e != hipSuccess) fprintf(stderr, "kernel_launch: cooperative launch failed: %s (grid %d)\n", hipGetErrorString(e), grid);
#endif
}
```

```cpp
#include <hip/hip_runtime.h>
#include <hip/hip_cooperative_groups.h>
#include <cstdio>
#include <cstdint>
namespace cg = cooperative_groups;

#ifndef MK_MULTI_LAUNCH
#define MK_MULTI_LAUNCH 0
#endif

constexpr int DM = 1024, NB = 8, SEQ = 2048, MTOK = NB * SEQ, NH = 8, DH = 128;
constexpr int MODV_LD = 14336;
constexpr float EPS = 1e-6f;
constexpr int NWAVES = 8, NTHR = 512;
constexpr int LDS_BYTES = 147456;

constexpr size_t MiB = 1u << 20;
constexpr size_t WS_CTL = 0, CTL_ZERO_BYTES = 1 * MiB + 256 * 1024;
constexpr size_t WS_MODV = 64 * 1024;
constexpr size_t WS_KMEAN = 512 * 1024;
constexpr size_t WS_GFLAG = 32 * 1024;
constexpr size_t WS_SHW = 768 * 1024;
constexpr size_t WS_PCNT = 48 * 1024;
constexpr size_t WS_CFLAG = 50 * 1024;
constexpr size_t WS_SUMSQ = 1 * MiB;
constexpr size_t WS_TA = 1 * MiB + 256 * 1024;
constexpr size_t WS_WIN = 2 * MiB;
constexpr size_t WS_WG = 10 * MiB;
constexpr size_t WS_WOUT = 12 * MiB;
constexpr size_t WS_ATTIN0 = 16 * MiB, WS_WKV = 20 * MiB, WS_ATTIN1 = 24 * MiB;
constexpr size_t WS_ATTOUT = 28 * MiB;
constexpr size_t WS_HN = 32 * MiB;
constexpr size_t WS_HKV = 64 * MiB;
constexpr size_t WS_UPRE = 96 * MiB;
constexpr size_t WS_G = 128 * MiB;
constexpr size_t WS_LA = 160 * MiB;
constexpr size_t WS_BIN = 192 * MiB;
constexpr size_t WS_X16 = 224 * MiB;
constexpr size_t WS_END = 256 * MiB;

typedef unsigned short bf16_t;
typedef short bf16x8 __attribute__((ext_vector_type(8)));
typedef short s16x4 __attribute__((ext_vector_type(4)));
typedef float f32x4 __attribute__((ext_vector_type(4)));
typedef float f32x2 __attribute__((ext_vector_type(2)));
typedef float f32x16 __attribute__((ext_vector_type(16)));
typedef unsigned u32x4 __attribute__((ext_vector_type(4)));
typedef unsigned u32x2 __attribute__((ext_vector_type(2)));
#define LAS __attribute__((address_space(3)))

__device__ __forceinline__ unsigned cvt_pk_bf16(float lo, float hi) { unsigned r; asm volatile("v_cvt_pk_bf16_f32 %0, %1, %2" : "=v"(r) : "v"(lo), "v"(hi)); return r; }
__device__ __forceinline__ float bf_lo(unsigned w) { return __uint_as_float(w << 16); }
__device__ __forceinline__ float bf_hi(unsigned w) { return __uint_as_float(w & 0xffff0000u); }
__device__ __forceinline__ float bf1(bf16_t h) { return __uint_as_float((unsigned)h << 16); }
__device__ __forceinline__ float fexp(float x) { return __builtin_amdgcn_exp2f(x * 1.4426950408889634f); }
__device__ __forceinline__ float flog(float x) { return __builtin_amdgcn_logf(x) * 0.6931471805599453f; }
__device__ __forceinline__ float fsigmoid(float x) { return __builtin_amdgcn_rcpf(1.f + fexp(-x)); }
__device__ __forceinline__ float fsilu(float x) { return x * fsigmoid(x); }
__device__ __forceinline__ int opq_tid(int wv) { int l; asm volatile("v_mbcnt_lo_u32_b32 %0, -1, 0\n\tv_mbcnt_hi_u32_b32 %0, -1, %0" : "=v"(l)); return wv * 64 + l; }
__device__ __forceinline__ int opq_bid() { int b = blockIdx.x; asm volatile("" : "+s"(b)); return b; }
__device__ __forceinline__ float wave_sum(float v) {
#pragma unroll
    for (int o = 1; o < 64; o <<= 1) v += __shfl_xor(v, o);
    return v;
}

namespace pg8 {
constexpr int BM = 256, BK = 64, HALF = 128, HTB = HALF * BK * 2, STAGE_BYTES = 8 * HTB, NXCD = 8, WGM = 8;
__host__ __device__ __forceinline__ int lds_byte(int r, int c) { const int st = (r >> 4) * 2 + (c >> 5), rr = r & 15, cc = c & 31, ob = rr * 64 + cc * 2; return st * 1024 + (ob ^ (((ob >> 9) & 1) << 5)); }
__host__ __device__ __forceinline__ void stage_rc(int b, int& R, int& C) { const int st = b / 1024, sb = b % 1024, swz = sb ^ (((sb >> 9) & 1) << 5); R = (st >> 1) * 16 + swz / 64; C = (st & 1) * 32 + (swz % 64) / 2; }
__host__ __device__ __forceinline__ int perm32(int rho) { const int n = rho >> 4, i = rho & 15; return 8 * (i >> 2) + 4 * n + (i & 3); }

struct Unit { int pm, pn, sub; };
struct Gemm { const bf16_t* A; const bf16_t* Bt; int lda, ldb, K; long a_sub, b_sub; };

struct MultiOrder {
    int nM, nN, nwg, nsub, G, c;
    __device__ void init(int M, int N, int nsub_, int G_, int c_) { nM = M / BM; nN = N / BM; nwg = nM * nN; nsub = nsub_; G = G_; c = c_; }
    __device__ bool next(int i, Unit& u) const {
        const long L = (long)i * G + c; if (L >= (long)nwg * nsub) return false;
        u.sub = (int)(L / nwg);
        int wgid = (int)(L % nwg); { const int q = nwg / NXCD, r = nwg % NXCD, xcd = wgid % NXCD, off = wgid / NXCD; wgid = (xcd < r ? xcd * (q + 1) : r * (q + 1) + (xcd - r) * q) + off; }
        const int nig = WGM * nN, gid = wgid / nig, fm = gid * WGM, gsz = (nM - fm) < WGM ? (nM - fm) : WGM;
        u.pm = fm + ((wgid % nig) % gsz); u.pn = (wgid % nig) / gsz; return true;
    }
};


template <int N> __device__ __forceinline__ float dpp_shr(float src, float ident) {
    return __int_as_float(__builtin_amdgcn_update_dpp(__float_as_int(ident), __float_as_int(src), 0x110 + N, 0xF, 0xF, false));
}
struct EpiSplit {
    static constexpr bool PERM = true, APERM = false;
    bf16_t* O0; bf16_t* O1; const float* sumsq; const float* shw;
    __device__ __forceinline__ void operator()(const f32x4 (&acc)[2][2][4][2], const Unit& u, int wr, int wc, int fr, int fq) const {
        const int row0 = u.pm * BM + wr * 64 + fr; int colt = u.pn * BM; bf16_t* base = O0;
        const int cfull = u.pn * BM + wc * 32 + 8 * fq;
        const bool gate_half = colt >= DM;
        if (gate_half) { base = O1; colt -= DM; }
        const int col0 = colt + wc * 32 + 8 * fq;
        f32x4 bv[2][2];
#pragma unroll
        for (int bj = 0; bj < 2; ++bj)
#pragma unroll
            for (int n = 0; n < 2; ++n) bv[bj][n] = sumsq ? *(const f32x4*)(shw + (size_t)(u.pm >> 3) * 2 * DM + cfull + bj * HALF + 4 * n) : (f32x4){0.f, 0.f, 0.f, 0.f};
        float ssq[2][4];
#pragma unroll
        for (int ai = 0; ai < 2; ++ai)
#pragma unroll
            for (int m = 0; m < 4; ++m) ssq[ai][m] = sumsq ? sumsq[row0 + ai * HALF + m * 16] : 0.f;
#pragma unroll
        for (int ai = 0; ai < 2; ++ai)
#pragma unroll
            for (int m = 0; m < 4; ++m) { const int row = row0 + ai * HALF + m * 16; bf16_t* rowp = base + (size_t)row * DM + col0;
                const float rs = sumsq ? __builtin_amdgcn_rsqf(ssq[ai][m] * (1.f / DM) + EPS) : 1.f;
#pragma unroll
                for (int bj = 0; bj < 2; ++bj) { f32x4 v0 = acc[ai][bj][m][0] * rs + bv[bj][0], v1 = acc[ai][bj][m][1] * rs + bv[bj][1];
                    if (gate_half) {
#pragma unroll
                        for (int j = 0; j < 4; ++j) { v0[j] = fsilu(v0[j]); v1[j] = fsilu(v1[j]); } }
                    u32x4 w; w.x = cvt_pk_bf16(v0[0], v0[1]); w.y = cvt_pk_bf16(v0[2], v0[3]); w.z = cvt_pk_bf16(v1[0], v1[1]); w.w = cvt_pk_bf16(v1[2], v1[3]);
                    *(u32x4*)(rowp + bj * HALF) = w; } }
    }
};

typedef _Float16 h16x8 __attribute__((ext_vector_type(8)));
__device__ __forceinline__ void ld8(const float* p, float (&v)[8]) { const f32x4 a = *(const f32x4*)p, b = *(const f32x4*)(p + 4); v[0] = a[0]; v[1] = a[1]; v[2] = a[2]; v[3] = a[3]; v[4] = b[0]; v[5] = b[1]; v[6] = b[2]; v[7] = b[3]; }
struct InOrder {
    int c, n, base;
    __device__ bool next(int i, Unit& u) const { if (i >= n) return false; const int j = c >> 3; int pm = (c & 7) * 8 + (j >> 2), pn = 4 * (i + base) + (j & 3), sub = 0;
        asm volatile("" : "+s"(pm), "+s"(pn), "+s"(sub)); u.pm = pm; u.pn = pn; u.sub = sub; return true; }
};
constexpr int CV_HL_OFF = 133120;
struct EpiSplitConv {
    static constexpr bool PERM = true, APERM = true;
    unsigned char* ws; const float* sumsq; const float* shw; const float* cw; const float* cb; unsigned target; LAS unsigned char* lds;
    __device__ __forceinline__ void operator()(f32x4 (&acc)[2][2][4][2], const Unit& u, int wr, int wc, int fr, int fq) const {
        const int pnl = u.pn & 3;
        const int cfull = u.pn * BM + wc * 32 + 8 * fq, ct = wc * 32 + 8 * fq, col0 = pnl * BM + ct;
        bf16_t* obase = (bf16_t*)(ws + WS_UPRE);
        f32x4 bv[2][2];
#pragma unroll
        for (int bj = 0; bj < 2; ++bj)
#pragma unroll
            for (int n = 0; n < 2; ++n) bv[bj][n] = sumsq ? *(const f32x4*)(shw + (size_t)(u.pm >> 3) * 2 * DM + cfull + bj * HALF + 4 * n) : (f32x4){0.f, 0.f, 0.f, 0.f};
        float ssq[2][4];
#pragma unroll
        for (int ai = 0; ai < 2; ++ai)
#pragma unroll
            for (int m = 0; m < 4; ++m) ssq[ai][m] = sumsq ? sumsq[u.pm * BM + ai * HALF + wr * 64 + 4 * fr + m] : 0.f;
#pragma unroll
        for (int ai = 0; ai < 2; ++ai)
#pragma unroll
            for (int m = 0; m < 4; ++m) { const float rs = sumsq ? __builtin_amdgcn_rsqf(ssq[ai][m] * (1.f / DM) + EPS) : 1.f;
#pragma unroll
                for (int bj = 0; bj < 2; ++bj) { acc[ai][bj][m][0] = acc[ai][bj][m][0] * rs + bv[bj][0]; acc[ai][bj][m][1] = acc[ai][bj][m][1] * rs + bv[bj][1]; } }
        const int tile = u.pm * 4 + pnl;
        unsigned long long* HX = (unsigned long long*)(ws + WS_BIN);
        unsigned* flags = (unsigned*)(ws + WS_CFLAG);
        LAS f32x4* HL = (LAS f32x4*)(lds + CV_HL_OFF);
#pragma unroll
        for (int ai = 0; ai < 2; ++ai)
#pragma unroll
            for (int k = 0; k < 3; ++k)
#pragma unroll
                for (int bj = 0; bj < 2; ++bj) {
                    if (fr == 15) { LAS f32x4* d = HL + (((ai * 2 + wr) * 3 + k) * 256 + bj * HALF + ct) / 4;
                        d[0] = acc[ai][bj][k + 1][0]; d[1] = acc[ai][bj][k + 1][1];
                        if (ai == 1 && wr == 1) { unsigned long long* g_ = HX + ((size_t)(tile * 3 + k) * 256 + bj * HALF + ct) / 2;
#pragma unroll
                            for (int n = 0; n < 2; ++n) { const f32x4 v = acc[1][bj][k + 1][n];
                                __hip_atomic_store(g_ + 2 * n, ((unsigned long long)__float_as_uint(v[1]) << 32) | __float_as_uint(v[0]), __ATOMIC_RELAXED, __HIP_MEMORY_SCOPE_AGENT);
                                __hip_atomic_store(g_ + 2 * n + 1, ((unsigned long long)__float_as_uint(v[3]) << 32) | __float_as_uint(v[2]), __ATOMIC_RELAXED, __HIP_MEMORY_SCOPE_AGENT); } } }
                    asm volatile("" ::: "memory"); __builtin_amdgcn_sched_barrier(0);
                }
        if (wr == 1) { asm volatile("s_waitcnt vmcnt(0)" ::: "memory");
            if (fr == 15 && fq == 0) __hip_atomic_fetch_add(flags + tile * 8, 1u, __ATOMIC_RELAXED, __HIP_MEMORY_SCOPE_AGENT); }
        asm volatile("s_waitcnt lgkmcnt(0)" ::: "memory"); __builtin_amdgcn_s_barrier(); asm volatile("" ::: "memory");
        const bool need_prev = (wr == 0) && ((u.pm & 7) != 0);
        if (need_prev) { unsigned spins = 0;
            while (__hip_atomic_load(flags + (tile - 4) * 8, __ATOMIC_RELAXED, __HIP_MEMORY_SCOPE_AGENT) < target) { __builtin_amdgcn_s_sleep(2); if (++spins > (1u << 22)) break; } }
#pragma unroll
        for (int ai = 0; ai < 2; ++ai)
#pragma unroll
            for (int bj = 0; bj < 2; ++bj)
#pragma unroll
                for (int n = 0; n < 2; ++n) {
                    f32x4 pr[3];
                    if (ai == 0 && wr == 0) {
#pragma unroll
                        for (int k = 0; k < 3; ++k) { unsigned long long wa = 0ull, wb = 0ull;
                            if (need_prev) { const unsigned long long* sp = HX + ((size_t)((tile - 4) * 3 + k) * 256 + bj * HALF + ct + 4 * n) / 2;
                                wa = __hip_atomic_load(sp, __ATOMIC_RELAXED, __HIP_MEMORY_SCOPE_AGENT); wb = __hip_atomic_load(sp + 1, __ATOMIC_RELAXED, __HIP_MEMORY_SCOPE_AGENT); }
                            pr[k] = (f32x4){__uint_as_float((unsigned)wa), __uint_as_float((unsigned)(wa >> 32)), __uint_as_float((unsigned)wb), __uint_as_float((unsigned)(wb >> 32))}; }
                    } else { const int prun = ai * 2 + wr - 1;
#pragma unroll
                        for (int k = 0; k < 3; ++k) pr[k] = HL[((prun * 3 + k) * 256 + bj * HALF + ct + 4 * n) / 4]; }
                    const int chg = pnl * BM + bj * HALF + ct + 4 * n;
                    const f32x4 w0 = *(const f32x4*)(cw + chg), w1 = *(const f32x4*)(cw + DM + chg), w2 = *(const f32x4*)(cw + 2 * DM + chg), w3 = *(const f32x4*)(cw + 3 * DM + chg), bb = *(const f32x4*)(cb + chg);
                    const f32x4 x0 = acc[ai][bj][0][n], x1 = acc[ai][bj][1][n], x2 = acc[ai][bj][2][n], x3 = acc[ai][bj][3][n];
                    f32x4 q1, q2, q3;
#pragma unroll
                    for (int j = 0; j < 4; ++j) { q1[j] = dpp_shr<1>(x3[j], pr[2][j]); q2[j] = dpp_shr<1>(x2[j], pr[1][j]); q3[j] = dpp_shr<1>(x1[j], pr[0][j]); }
                    const f32x4 y0 = bb + w0 * q3 + w1 * q2 + w2 * q1 + w3 * x0, y1 = bb + w0 * q2 + w1 * q1 + w2 * x0 + w3 * x1;
                    const f32x4 y2 = bb + w0 * q1 + w1 * x0 + w2 * x1 + w3 * x2, y3 = bb + w0 * x0 + w1 * x1 + w2 * x2 + w3 * x3;
                    bf16_t* op = obase + (size_t)(u.pm * BM + ai * HALF + wr * 64 + 4 * fr) * DM + col0 + bj * HALF + 4 * n;
                    { u32x2 w; w.x = cvt_pk_bf16(y0[0], y0[1]); w.y = cvt_pk_bf16(y0[2], y0[3]); *(u32x2*)(op) = w; }
                    { u32x2 w; w.x = cvt_pk_bf16(y1[0], y1[1]); w.y = cvt_pk_bf16(y1[2], y1[3]); *(u32x2*)(op + DM) = w; }
                    { u32x2 w; w.x = cvt_pk_bf16(y2[0], y2[1]); w.y = cvt_pk_bf16(y2[2], y2[3]); *(u32x2*)(op + 2 * DM) = w; }
                    { u32x2 w; w.x = cvt_pk_bf16(y3[0], y3[1]); w.y = cvt_pk_bf16(y3[2], y3[3]); *(u32x2*)(op + 3 * DM) = w; }
                    asm volatile("" ::: "memory"); __builtin_amdgcn_sched_barrier(0);
                }
    }
};

template <class TIn, bool HAS_A2>
struct EpiResH {
    static constexpr bool PERM = true, APERM = false;
    const TIn* xin; _Float16* xo; const float* gate; const float* modv; bf16_t* A1; const float* g1; int sc1; bf16_t* A2; const float* g2; int sc2; float* sumsq;
    __device__ __forceinline__ void operator()(const f32x4 (&acc)[2][2][4][2], const Unit& u, int wr, int wc, int fr, int fq) const {
        const int b = u.pm >> 3, col0 = u.pn * BM + wc * 32 + 8 * fq;
        float gv[2][8], gs1[2][8], gs2[HAS_A2 ? 2 : 1][8];
#pragma unroll
        for (int bj = 0; bj < 2; ++bj) { const int cc = col0 + bj * HALF;
            ld8(gate + (size_t)b * MODV_LD + cc, gv[bj]);
            { float gg[8], sc[8]; ld8(g1 + cc, gg); ld8(modv + (size_t)b * MODV_LD + sc1 + cc, sc);
#pragma unroll
              for (int j = 0; j < 8; ++j) gs1[bj][j] = gg[j] * (sc[j] + 1.f); }
            if constexpr (HAS_A2) { float gg[8], sc[8]; ld8(g2 + cc, gg); ld8(modv + (size_t)b * MODV_LD + sc2 + cc, sc);
#pragma unroll
              for (int j = 0; j < 8; ++j) gs2[bj][j] = gg[j] * (sc[j] + 1.f); } }
#pragma unroll
        for (int ai = 0; ai < 2; ++ai) {
#pragma unroll
          for (int mh = 0; mh < 4; mh += 2) {
            float xv[2][2][8];
#pragma unroll
            for (int mm = 0; mm < 2; ++mm) { const size_t off = (size_t)(u.pm * BM + ai * HALF + wr * 64 + (mh + mm) * 16 + fr) * DM + col0;
#pragma unroll
                for (int bj = 0; bj < 2; ++bj) {
                    if constexpr (sizeof(TIn) == 4) ld8((const float*)xin + off + bj * HALF, xv[mm][bj]);
                    else { const h16x8 hv = *(const h16x8*)((const _Float16*)xin + off + bj * HALF);
#pragma unroll
                        for (int j = 0; j < 8; ++j) xv[mm][bj][j] = (float)hv[j]; } } }
            __builtin_amdgcn_sched_barrier(0);
#pragma unroll
            for (int mm = 0; mm < 2; ++mm) { const int m = mh + mm; const int row = u.pm * BM + ai * HALF + wr * 64 + m * 16 + fr; const size_t off = (size_t)row * DM + col0;
                float ss = 0.f;
#pragma unroll
                for (int bj = 0; bj < 2; ++bj) { float o[8]; h16x8 ho;
#pragma unroll
                    for (int j = 0; j < 8; ++j) { o[j] = xv[mm][bj][j] + gv[bj][j] * acc[ai][bj][m][j >> 2][j & 3]; ho[j] = (_Float16)o[j]; ss += o[j] * o[j]; }
                    *(h16x8*)(xo + off + bj * HALF) = ho;
                    if (A1) { u32x4 w; w.x = cvt_pk_bf16(o[0] * gs1[bj][0], o[1] * gs1[bj][1]); w.y = cvt_pk_bf16(o[2] * gs1[bj][2], o[3] * gs1[bj][3]);
                        w.z = cvt_pk_bf16(o[4] * gs1[bj][4], o[5] * gs1[bj][5]); w.w = cvt_pk_bf16(o[6] * gs1[bj][6], o[7] * gs1[bj][7]); *(u32x4*)(A1 + off + bj * HALF) = w; }
                    if constexpr (HAS_A2) { u32x4 w; w.x = cvt_pk_bf16(o[0] * gs2[bj][0], o[1] * gs2[bj][1]); w.y = cvt_pk_bf16(o[2] * gs2[bj][2], o[3] * gs2[bj][3]);
                        w.z = cvt_pk_bf16(o[4] * gs2[bj][4], o[5] * gs2[bj][5]); w.w = cvt_pk_bf16(o[6] * gs2[bj][6], o[7] * gs2[bj][7]); *(u32x4*)(A2 + off + bj * HALF) = w; } }
                if (sumsq) { ss += __shfl_xor(ss, 16); ss += __shfl_xor(ss, 32); if (fq == 0) atomicAdd(sumsq + row, ss); } }
            __builtin_amdgcn_sched_barrier(0);
          }
        }
    }
};

struct EpiFinal {
    static constexpr bool PERM = true, APERM = false;
    const _Float16* xin; float* out; const float* gate; const float* fg; float* sumsq; unsigned* cnt;
    __device__ __forceinline__ void operator()(f32x4 (&acc)[2][2][4][2], const Unit& u, int wr, int wc, int fr, int fq) const {
        const int b = u.pm >> 3, col0 = u.pn * BM + wc * 32 + 8 * fq;
        float gv[2][8];
#pragma unroll
        for (int bj = 0; bj < 2; ++bj) ld8(gate + (size_t)b * MODV_LD + col0 + bj * HALF, gv[bj]);
#pragma unroll
        for (int ai = 0; ai < 2; ++ai) {
            h16x8 xh[4][2];
#pragma unroll
            for (int m = 0; m < 4; ++m)
#pragma unroll
                for (int bj = 0; bj < 2; ++bj) xh[m][bj] = *(const h16x8*)(xin + (size_t)(u.pm * BM + ai * HALF + wr * 64 + m * 16 + fr) * DM + col0 + bj * HALF);
            __builtin_amdgcn_sched_barrier(0);
#pragma unroll
            for (int m = 0; m < 4; ++m) { const int row = u.pm * BM + ai * HALF + wr * 64 + m * 16 + fr;
                float ss = 0.f;
#pragma unroll
                for (int bj = 0; bj < 2; ++bj) { f32x4 o0, o1;
#pragma unroll
                    for (int j = 0; j < 4; ++j) { o0[j] = (float)xh[m][bj][j] + gv[bj][j] * acc[ai][bj][m][0][j]; o1[j] = (float)xh[m][bj][4 + j] + gv[bj][4 + j] * acc[ai][bj][m][1][j]; }
                    acc[ai][bj][m][0] = o0; acc[ai][bj][m][1] = o1;
                    ss += (o0[0] * o0[0] + o0[1] * o0[1]) + (o0[2] * o0[2] + o0[3] * o0[3]) + (o1[0] * o1[0] + o1[1] * o1[1]) + (o1[2] * o1[2] + o1[3] * o1[3]); }
                ss += __shfl_xor(ss, 16); ss += __shfl_xor(ss, 32); if (fq == 0) atomicAdd(sumsq + row, ss); }
            __builtin_amdgcn_sched_barrier(0);
        }
        asm volatile("s_waitcnt vmcnt(0)" ::: "memory");
        if (fr == 0 && fq == 0) __hip_atomic_fetch_add(cnt + u.pm * 8, 1u, __ATOMIC_RELAXED, __HIP_MEMORY_SCOPE_AGENT);
        { unsigned spins = 0;
          while (__hip_atomic_load(cnt + u.pm * 8, __ATOMIC_RELAXED, __HIP_MEMORY_SCOPE_AGENT) < 32u) { __builtin_amdgcn_s_sleep(2); if (++spins > (1u << 22)) break; } }
        float fgv[2][8];
#pragma unroll
        for (int bj = 0; bj < 2; ++bj) ld8(fg + col0 + bj * HALF, fgv[bj]);
        float ssq[2][4];
#pragma unroll
        for (int ai = 0; ai < 2; ++ai)
#pragma unroll
            for (int m = 0; m < 4; ++m) ssq[ai][m] = __hip_atomic_load(sumsq + u.pm * BM + ai * HALF + wr * 64 + m * 16 + fr, __ATOMIC_RELAXED, __HIP_MEMORY_SCOPE_AGENT);
#pragma unroll
        for (int ai = 0; ai < 2; ++ai)
#pragma unroll
            for (int m = 0; m < 4; ++m) { const size_t off = (size_t)(u.pm * BM + ai * HALF + wr * 64 + m * 16 + fr) * DM + col0;
                const float rs = __builtin_amdgcn_rsqf(ssq[ai][m] * (1.f / DM) + EPS);
#pragma unroll
                for (int bj = 0; bj < 2; ++bj) { f32x4 y0, y1;
#pragma unroll
                    for (int j = 0; j < 4; ++j) { y0[j] = acc[ai][bj][m][0][j] * rs * fgv[bj][j]; y1[j] = acc[ai][bj][m][1][j] * rs * fgv[bj][4 + j]; }
                    *(f32x4*)(out + off + bj * HALF) = y0; *(f32x4*)(out + off + bj * HALF + 4) = y1; } }
    }
};

__device__ __forceinline__ void scan16(float& a, float& b) {
    float ap, bp;
    ap = dpp_shr<1>(a, 1.f); bp = dpp_shr<1>(b, 0.f); b = fmaf(a, bp, b); a *= ap;
    ap = dpp_shr<2>(a, 1.f); bp = dpp_shr<2>(b, 0.f); b = fmaf(a, bp, b); a *= ap;
    ap = dpp_shr<4>(a, 1.f); bp = dpp_shr<4>(b, 0.f); b = fmaf(a, bp, b); a *= ap;
    ap = dpp_shr<8>(a, 1.f); bp = dpp_shr<8>(b, 0.f); b = fmaf(a, bp, b); a *= ap;
}
__device__ __forceinline__ void gate_elem2(f32x2 xr, f32x2 xg, f32x2 nba, f32x2 nbx, f32x2 psp2, f32x2 uv, f32x2& a, f32x2& b) {
    const f32x2 tr = xr * (-1.4426950408889634f) + nba, tg = xg * (-1.4426950408889634f) + nbx;
    f32x2 er, eg; er.x = __builtin_amdgcn_exp2f(tr.x); er.y = __builtin_amdgcn_exp2f(tr.y); eg.x = __builtin_amdgcn_exp2f(tg.x); eg.y = __builtin_amdgcn_exp2f(tg.y);
    const f32x2 dr = er + 1.f, dg = eg + 1.f, dd = dr * dg;
    f32x2 inv; inv.x = __builtin_amdgcn_rcpf(dd.x); inv.y = __builtin_amdgcn_rcpf(dd.y);
    const f32x2 r = inv * dg, gi = inv * dr;
    const f32x2 la2 = psp2 * r;
    a.x = __builtin_amdgcn_exp2f(-la2.x); a.y = __builtin_amdgcn_exp2f(-la2.y);
    const f32x2 om = 1.f - a * a;
    f32x2 sq; sq.x = __builtin_amdgcn_sqrtf(om.x); sq.y = __builtin_amdgcn_sqrtf(om.y);
    b = sq * gi * uv;
}
struct GateParams { f32x2 nba[4], nbx[4], psp2[4]; };
__device__ __forceinline__ void gate_params(GateParams& P, const float* ba, const float* bx, const float* lam, int ch0) {
#pragma unroll
    for (int p = 0; p < 4; ++p) {
        const f32x2 vb = *(const f32x2*)(ba + ch0 + 2 * p), vx = *(const f32x2*)(bx + ch0 + 2 * p), vl = *(const f32x2*)(lam + ch0 + 2 * p);
        P.nba[p] = vb * (-1.4426950408889634f); P.nbx[p] = vx * (-1.4426950408889634f);
        const float z0 = -vl.x, z1 = -vl.y;
        P.psp2[p].x = 8.f * 1.4426950408889634f * (z0 > 20.f ? z0 : flog(1.f + fexp(z0)));
        P.psp2[p].y = 8.f * 1.4426950408889634f * (z1 > 20.f ? z1 : flog(1.f + fexp(z1)));
    }
}
#define GATE_PAIR(p, accv, uw_, a2, b2) do { const int n_ = (p) >> 1, q_ = ((p) & 1) * 2; \
        const unsigned uword_ = ((p) == 0) ? uw_.x : ((p) == 1) ? uw_.y : ((p) == 2) ? uw_.z : uw_.w; \
        gate_elem2((f32x2){accv[ai][0][m][n_][q_], accv[ai][0][m][n_][q_ + 1]}, (f32x2){accv[ai][1][m][n_][q_], accv[ai][1][m][n_][q_ + 1]}, \
                   P.nba[p], P.nbx[p], P.psp2[p], (f32x2){bf_lo(uword_), bf_hi(uword_)}, a2, b2); } while (0)
struct GatesOrder {
    int c, n;
    __device__ bool next(int i, Unit& u) const { if (i >= n) return false; int pm = (c >> 5) * 8 + 4 * i + (c & 3), pn = (c >> 2) & 1, sub = (c >> 3) & 3;
        asm volatile("" : "+s"(pm), "+s"(pn), "+s"(sub)); u.pm = pm; u.pn = pn; u.sub = sub; return true; }
};
constexpr int GS_RA_OFF = 133120;
struct EpiGatesS {
    static constexpr bool PERM = true, APERM = true;
    unsigned char* ws; unsigned target; const float* ba; const float* bx; const float* lam; LAS unsigned char* lds;
    __device__ __forceinline__ void operator()(f32x4 (&acc)[2][2][4][2], const Unit& u, int wr, int wc, int fr, int fq) const {
        const bf16_t* U = (const bf16_t*)(ws + WS_UPRE); const bf16_t* Gt = (const bf16_t*)(ws + WS_G); bf16_t* Y = (bf16_t*)(ws + WS_HN);
        unsigned long long* TA = (unsigned long long*)(ws + WS_TA); unsigned* flags = (unsigned*)(ws + WS_GFLAG);
        const int ct0 = wc * 32 + 8 * fq, ch0 = u.sub * 256 + u.pn * 128 + ct0;
        const int chain = ((u.pm >> 3) * 4 + u.sub) * 2 + u.pn, p = u.pm & 7, tix = chain * 8 + p;
        const int bsrc = (fq * 16 + 15) << 2;
        LAS f32x4* RA = (LAS f32x4*)(lds + GS_RA_OFF);
        {
            GateParams P; gate_params(P, ba, bx, lam, ch0);
#pragma unroll
            for (int ai = 0; ai < 2; ++ai) {
                u32x4 uall[4];
#pragma unroll
                for (int m = 0; m < 4; ++m) uall[m] = *(const u32x4*)(U + (size_t)(u.pm * BM + ai * HALF + wr * 64 + 4 * fr + m) * DM + ch0);
#pragma unroll
                for (int n = 0; n < 2; ++n) { f32x4 tA[4], tB[4]; f32x4 agg;
#pragma unroll
                    for (int hq = 0; hq < 2; ++hq) { const int pq = 2 * n + hq; f32x2 a2[4], b2[4];
#pragma unroll
                        for (int m = 0; m < 4; ++m) { const u32x4 uw = uall[m]; GATE_PAIR(pq, acc, uw, a2[m], b2[m]); }
#pragma unroll
                        for (int m = 1; m < 4; ++m) { b2[m] = a2[m] * b2[m - 1] + b2[m]; a2[m] = a2[m] * a2[m - 1]; }
                        float pax = a2[3].x, pbx = b2[3].x, pay = a2[3].y, pby = b2[3].y; scan16(pax, pbx); scan16(pay, pby);
                        if (hq == 0) { agg[0] = pax; agg[1] = pbx; agg[2] = pay; agg[3] = pby;
                            if (fr == 15) RA[((ai * 2 + wr) * 128 + ct0) / 2 + pq] = agg; }
                        else { if (fr == 15) RA[((ai * 2 + wr) * 128 + ct0) / 2 + pq] = (f32x4){pax, pbx, pay, pby}; }
                        const f32x2 EA = {dpp_shr<1>(pax, 1.f), dpp_shr<1>(pay, 1.f)}, EB = {dpp_shr<1>(pbx, 0.f), dpp_shr<1>(pby, 0.f)};
#pragma unroll
                        for (int m = 0; m < 4; ++m) { const f32x2 Ae = a2[m] * EA, Be = a2[m] * EB + b2[m];
                            tA[m][2 * hq] = Ae.x; tA[m][2 * hq + 1] = Ae.y; tB[m][2 * hq] = Be.x; tB[m][2 * hq + 1] = Be.y; }
                        __builtin_amdgcn_sched_barrier(0); }
#pragma unroll
                    for (int m = 0; m < 4; ++m) { acc[ai][0][m][n] = tA[m]; acc[ai][1][m][n] = tB[m]; }
                    asm volatile("" ::: "memory"); __builtin_amdgcn_sched_barrier(0); }
            }
        }
        asm volatile("s_waitcnt lgkmcnt(0)" ::: "memory"); __builtin_amdgcn_s_barrier(); asm volatile("" ::: "memory");
        if (wr == 0) {
            float At[8], Bt[8];
#pragma unroll
            for (int j = 0; j < 8; ++j) { At[j] = 1.f; Bt[j] = 0.f; }
#pragma unroll
            for (int ri = 0; ri < 4; ++ri)
#pragma unroll
                for (int q = 0; q < 4; ++q) { const f32x4 v = RA[(ri * 128 + ct0) / 2 + q];
                    Bt[2 * q] = fmaf(v[0], Bt[2 * q], v[1]); At[2 * q] *= v[0]; Bt[2 * q + 1] = fmaf(v[2], Bt[2 * q + 1], v[3]); At[2 * q + 1] *= v[2]; }
            if (fr == 15) {
#pragma unroll
                for (int j = 0; j < 8; ++j) __hip_atomic_store(TA + (size_t)tix * 128 + ct0 + j, ((unsigned long long)__float_as_uint(Bt[j]) << 32) | __float_as_uint(At[j]), __ATOMIC_RELAXED, __HIP_MEMORY_SCOPE_AGENT);
            }
            asm volatile("s_waitcnt vmcnt(0)" ::: "memory");
            if (fr == 15 && fq == 0) __hip_atomic_fetch_add(flags + tix * 8, 1u, __ATOMIC_RELAXED, __HIP_MEMORY_SCOPE_AGENT);
        }
        float h[8];
        {
            const bool on = fr < p;
            if (on) { unsigned spins = 0;
                while (__hip_atomic_load(flags + (chain * 8 + fr) * 8, __ATOMIC_RELAXED, __HIP_MEMORY_SCOPE_AGENT) < target) { __builtin_amdgcn_s_sleep(2); if (++spins > (1u << 22)) break; } }
            float Ac[8], Bc[8];
#pragma unroll
            for (int j = 0; j < 8; ++j) { unsigned long long w = 0x000000003f800000ull;
                if (on) w = __hip_atomic_load(TA + (size_t)(chain * 8 + fr) * 128 + ct0 + j, __ATOMIC_RELAXED, __HIP_MEMORY_SCOPE_AGENT);
                Ac[j] = __uint_as_float((unsigned)w); Bc[j] = __uint_as_float((unsigned)(w >> 32)); }
#pragma unroll
            for (int j = 0; j < 8; ++j) { float a = Ac[j], b = Bc[j]; scan16(a, b); h[j] = __int_as_float(__builtin_amdgcn_ds_bpermute(bsrc, __float_as_int(b))); }
        }
#pragma unroll
        for (int ai = 0; ai < 2; ++ai) {
            const int nskip = (ai == 0) ? wr : 1;
            const int rfirst = (ai == 0) ? 0 : (1 + wr);
            for (int k = 0; k < nskip; ++k)
#pragma unroll
                for (int q = 0; q < 4; ++q) { const f32x4 v = RA[((rfirst + k) * 128 + ct0) / 2 + q];
                    h[2 * q] = fmaf(v[0], h[2 * q], v[1]); h[2 * q + 1] = fmaf(v[2], h[2 * q + 1], v[3]); }
            u32x4 gall[4];
#pragma unroll
            for (int m = 0; m < 4; ++m) gall[m] = *(const u32x4*)(Gt + (size_t)(u.pm * BM + ai * HALF + wr * 64 + 4 * fr + m) * DM + ch0);
            float hl[8];
#pragma unroll
            for (int m = 0; m < 4; ++m) { const size_t off = (size_t)(u.pm * BM + ai * HALF + wr * 64 + 4 * fr + m) * DM + ch0;
                const u32x4 gw = gall[m];
                const float gv[8] = {bf_lo(gw.x), bf_hi(gw.x), bf_lo(gw.y), bf_hi(gw.y), bf_lo(gw.z), bf_hi(gw.z), bf_lo(gw.w), bf_hi(gw.w)};
                float yv[8];
#pragma unroll
                for (int j = 0; j < 8; ++j) { const float hv = fmaf(acc[ai][0][m][j >> 2][j & 3], h[j], acc[ai][1][m][j >> 2][j & 3]); yv[j] = hv * gv[j];
                    if (m == 3) hl[j] = hv; }
                u32x4 w; w.x = cvt_pk_bf16(yv[0], yv[1]); w.y = cvt_pk_bf16(yv[2], yv[3]); w.z = cvt_pk_bf16(yv[4], yv[5]); w.w = cvt_pk_bf16(yv[6], yv[7]);
                *(u32x4*)(Y + off) = w; }
#pragma unroll
            for (int j = 0; j < 8; ++j) h[j] = __int_as_float(__builtin_amdgcn_ds_bpermute(bsrc, __float_as_int(hl[j])));
            asm volatile("" ::: "memory"); __builtin_amdgcn_sched_barrier(0);
        }
    }
};

struct EpiQKV {
    static constexpr bool PERM = true, APERM = false;
    unsigned char* ws; float* kmean; const float* sumsq; const float* shw; int shw_sub;
    __device__ __forceinline__ void operator()(const f32x4 (&acc)[2][2][4][2], const Unit& u, int wr, int wc, int fr, int fq) const {
        const int b = u.pm >> 3, sblk = u.pm & 7, pq = u.pn & 3; const bool second = u.pn >= 4;
        const int dcol = wc * 32 + 8 * fq;
        const float* sw = shw + (size_t)u.sub * shw_sub + (size_t)b * 2 * DM + u.pn * BM + dcol;
        f32x4 bv[2][2];
#pragma unroll
        for (int bj = 0; bj < 2; ++bj)
#pragma unroll
            for (int n = 0; n < 2; ++n) bv[bj][n] = *(const f32x4*)(sw + bj * HALF + 4 * n);
        const bool plain = (u.sub == 0 && second), km = (u.sub == 1 && !second);
        const size_t boff = plain ? WS_G : (u.sub == 0) ? WS_UPRE : (second ? WS_BIN : WS_HN);
        const size_t rstride = plain ? DM : DH;
        bf16_t* bp[2];
#pragma unroll
        for (int bj = 0; bj < 2; ++bj)
            bp[bj] = (bf16_t*)(ws + boff) + (plain ? (size_t)(u.pm * BM) * DM + pq * 256 + bj * HALF + dcol : ((size_t)(b * NH + 2 * pq + bj) * SEQ + sblk * 256) * DH + dcol);
        f32x4 s0[2], s1[2];
#pragma unroll
        for (int bj = 0; bj < 2; ++bj) { s0[bj] = (f32x4){0.f, 0.f, 0.f, 0.f}; s1[bj] = (f32x4){0.f, 0.f, 0.f, 0.f}; }
        float ssq[2][4];
#pragma unroll
        for (int ai = 0; ai < 2; ++ai)
#pragma unroll
            for (int m = 0; m < 4; ++m) ssq[ai][m] = sumsq[u.pm * BM + ai * HALF + wr * 64 + m * 16 + fr];
#pragma unroll
        for (int ai = 0; ai < 2; ++ai)
#pragma unroll
            for (int m = 0; m < 4; ++m) { const int r = ai * HALF + wr * 64 + m * 16 + fr;
                const float rs = __builtin_amdgcn_rsqf(ssq[ai][m] * (1.f / DM) + EPS);
#pragma unroll
                for (int bj = 0; bj < 2; ++bj) { f32x4 v0 = acc[ai][bj][m][0] * rs + bv[bj][0], v1 = acc[ai][bj][m][1] * rs + bv[bj][1];
                    if (plain) {
#pragma unroll
                        for (int j = 0; j < 4; ++j) { v0[j] = fsilu(v0[j]); v1[j] = fsilu(v1[j]); } }
                    s0[bj] += v0; s1[bj] += v1;
                    u32x4 w; w.x = cvt_pk_bf16(v0[0], v0[1]); w.y = cvt_pk_bf16(v0[2], v0[3]); w.z = cvt_pk_bf16(v1[0], v1[1]); w.w = cvt_pk_bf16(v1[2], v1[3]);
                    *(u32x4*)(bp[bj] + (size_t)r * rstride) = w; }
                asm volatile("" ::: "memory"); }
        if (km) {
#pragma unroll
            for (int bj = 0; bj < 2; ++bj)
#pragma unroll
                for (int j = 0; j < 4; ++j) { float t0 = s0[bj][j], t1 = s1[bj][j];
                    t0 += __shfl_xor(t0, 1); t0 += __shfl_xor(t0, 2); t0 += __shfl_xor(t0, 4); t0 += __shfl_xor(t0, 8);
                    t1 += __shfl_xor(t1, 1); t1 += __shfl_xor(t1, 2); t1 += __shfl_xor(t1, 4); t1 += __shfl_xor(t1, 8);
                    if (fr == 0) { float* kp = kmean + ((size_t)(b * NH + 2 * pq + bj) * 8 + sblk) * DH + dcol + j;
                        atomicAdd(kp, t0 * (1.f / 256.f)); atomicAdd(kp + 4, t1 * (1.f / 256.f)); } }
        }
    }
};

template <class Epi, class Sched>
__device__ __forceinline__ void gemm_phase(LAS unsigned char* lds, const Gemm g, const Sched& S, const Epi& E, int wv) {
    const int tid = opq_tid(wv), wid = __builtin_amdgcn_readfirstlane(tid >> 6), lane = tid & 63, wr = wid >> 2, wc = wid & 3, fr = lane & 15, fq = lane >> 4;
    const int K = g.K, nt = K / BK;
    unsigned voffA[2], voffB[2];
#pragma unroll
    for (int i = 0; i < 2; ++i) { int R, C; stage_rc(tid * 16 + i * 8192, R, C); const int Rb = Epi::PERM ? ((R & ~31) + perm32(R & 31)) : R;
        const int Ra = Epi::APERM ? ((R & 64) + 4 * (R & 15) + ((R >> 4) & 3)) : R;
        voffA[i] = (unsigned)(Ra * g.lda + C) * 2u; voffB[i] = (unsigned)(Rb * g.ldb + C) * 2u; }
    const size_t kstep = (size_t)(BK * 2);
    const size_t hstepA = (size_t)HALF * g.lda * 2, hstepB = (size_t)HALF * g.ldb * 2;
    const size_t tstepA = 2 * hstepA, tstepB = 2 * hstepB;
    const unsigned ldsw = (unsigned)wid * 1024u;
    const int aoff = lds_byte(wr * 64 + fr, fq * 8), boff = lds_byte(wc * 32 + fr, fq * 8);
#define PG8_SA(b, h) (((b) * 2 + (h)) * HTB)
#define PG8_SB(b, h) ((4 + (b) * 2 + (h)) * HTB)
#define PG8_STAGE(bufoff, gbase, voff) do { _Pragma("unroll") for (int _i = 0; _i < 2; ++_i) \
        __builtin_amdgcn_global_load_lds((const unsigned*)((const char*)(gbase) + (voff)[_i]), (LAS unsigned*)(lds + (bufoff) + ldsw + _i * 8192), 16, 0, 0); } while (0)
#define PG8_LDA(dst, b, h) do { _Pragma("unroll") for (int m = 0; m < 4; ++m) _Pragma("unroll") for (int k = 0; k < 2; ++k) dst[m][k] = *(const LAS bf16x8*)(lds + PG8_SA(b, h) + aoff + m * 2048 + k * 1024); } while (0)
#define PG8_LDB(dst, b, h) do { _Pragma("unroll") for (int n = 0; n < 2; ++n) _Pragma("unroll") for (int k = 0; k < 2; ++k) dst[n][k] = *(const LAS bf16x8*)(lds + PG8_SB(b, h) + boff + n * 2048 + k * 1024); } while (0)
#define PG8_MMA(ai, bj, At, Bt) do { __builtin_amdgcn_s_setprio(1); _Pragma("unroll") for (int m = 0; m < 4; ++m) _Pragma("unroll") for (int n = 0; n < 2; ++n) _Pragma("unroll") for (int k = 0; k < 2; ++k) \
        acc[ai][bj][m][n] = __builtin_amdgcn_mfma_f32_16x16x32_bf16(Bt[n][k], At[m][k], acc[ai][bj][m][n], 0, 0, 0); __builtin_amdgcn_s_setprio(0); } while (0)
#define PG8_WAIT_V(n) asm volatile("s_waitcnt vmcnt(" #n ")" ::: "memory")
#define PG8_WAIT_L(n) asm volatile("s_waitcnt lgkmcnt(" #n ")" ::: "memory")
#define PG8_BAR __builtin_amdgcn_s_barrier()
#define PG8_SCHED __builtin_amdgcn_sched_barrier(0)
#define PG8_UA(u) ((const char*)g.A + (size_t)(u).sub * g.a_sub + (size_t)(u).pm * tstepA)
#define PG8_UB(u) ((const char*)g.Bt + (size_t)(u).sub * g.b_sub + (size_t)(u).pn * tstepB)
    Unit cur, nxt; int ui = 0;
    if (!S.next(0, cur)) return;
    f32x4 acc[2][2][4][2];
#pragma unroll
    for (int a = 0; a < 2; ++a)
#pragma unroll
        for (int b = 0; b < 2; ++b)
#pragma unroll
            for (int m = 0; m < 4; ++m)
#pragma unroll
                for (int n = 0; n < 2; ++n) acc[a][b][m][n] = (f32x4){0.f, 0.f, 0.f, 0.f};
    bf16x8 At[4][2], B0[2][2], B1[2][2];
    const char* cA = PG8_UA(cur); const char* cB = PG8_UB(cur);
    PG8_STAGE(PG8_SB(0, 0), cB, voffB); PG8_STAGE(PG8_SB(0, 1), cB + hstepB, voffB); PG8_STAGE(PG8_SA(0, 0), cA, voffA); PG8_STAGE(PG8_SA(0, 1), cA + hstepA, voffA);
    if (wr == 1) PG8_BAR;
    PG8_WAIT_V(2); PG8_BAR;
    PG8_STAGE(PG8_SB(1, 0), cB + kstep, voffB); PG8_STAGE(PG8_SA(1, 0), cA + kstep, voffA); PG8_STAGE(PG8_SB(1, 1), cB + hstepB + kstep, voffB);
    PG8_WAIT_V(6); PG8_BAR;
    for (;;) {
        const bool has_next = S.next(ui + 1, nxt);
        const char* nA = has_next ? PG8_UA(nxt) : cA; const char* nB = has_next ? PG8_UB(nxt) : cB;
        for (int t = 0; t < nt; t += 2) {
            const bool last = (t == nt - 2);
            const char* a1 = cA + (size_t)(t + 1) * kstep;
            const char* a2 = last ? nA : cA + (size_t)(t + 2) * kstep; const char* b2 = last ? nB : cB + (size_t)(t + 2) * kstep;
            const char* a3 = a2 + kstep; const char* b3 = b2 + kstep;
            PG8_LDB(B0, 0, 0); PG8_LDB(B1, 0, 1); PG8_SCHED; PG8_LDA(At, 0, 0); PG8_STAGE(PG8_SA(1, 1), a1 + hstepA, voffA);
            PG8_WAIT_V(8); PG8_WAIT_L(0); PG8_BAR; PG8_MMA(0, 0, At, B0); PG8_MMA(0, 1, At, B1); PG8_BAR; PG8_SCHED;
            PG8_LDA(At, 0, 1); PG8_STAGE(PG8_SB(0, 0), b2, voffB); PG8_STAGE(PG8_SB(0, 1), b2 + hstepB, voffB); PG8_STAGE(PG8_SA(0, 0), a2, voffA);
            PG8_WAIT_V(8); PG8_WAIT_L(0); PG8_BAR; PG8_MMA(1, 0, At, B0); PG8_MMA(1, 1, At, B1); PG8_BAR; PG8_SCHED;
            PG8_LDB(B0, 1, 0); PG8_LDB(B1, 1, 1); PG8_SCHED; PG8_LDA(At, 1, 0); PG8_STAGE(PG8_SA(0, 1), a2 + hstepA, voffA);
            PG8_WAIT_V(8); PG8_WAIT_L(0); PG8_BAR; PG8_MMA(0, 0, At, B0); PG8_MMA(0, 1, At, B1); PG8_BAR; PG8_SCHED;
            PG8_LDA(At, 1, 1); PG8_STAGE(PG8_SB(1, 0), b3, voffB); PG8_STAGE(PG8_SB(1, 1), b3 + hstepB, voffB); PG8_STAGE(PG8_SA(1, 0), a3, voffA);
            PG8_WAIT_V(8); PG8_WAIT_L(0); PG8_BAR; PG8_MMA(1, 0, At, B0); PG8_MMA(1, 1, At, B1); PG8_BAR; PG8_SCHED;
        }
        if (wr == 0) PG8_BAR;
        { const int t2 = opq_tid(wv), w2 = __builtin_amdgcn_readfirstlane(t2 >> 6), l2 = t2 & 63; E(acc, cur, w2 >> 2, w2 & 3, l2 & 15, l2 >> 4); }
        if (!has_next) break;
#pragma unroll
        for (int a = 0; a < 2; ++a)
#pragma unroll
            for (int b = 0; b < 2; ++b)
#pragma unroll
                for (int m = 0; m < 4; ++m)
#pragma unroll
                    for (int n = 0; n < 2; ++n) acc[a][b][m][n] = (f32x4){0.f, 0.f, 0.f, 0.f};
        cur = nxt; cA = nA; cB = nB; ++ui;
        if (wr == 1) PG8_BAR;
    }
    PG8_WAIT_V(0);
    PG8_BAR;
#undef PG8_SA
#undef PG8_SB
#undef PG8_STAGE
#undef PG8_LDA
#undef PG8_LDB
#undef PG8_MMA
#undef PG8_WAIT_V
#undef PG8_WAIT_L
#undef PG8_BAR
#undef PG8_SCHED
#undef PG8_UA
#undef PG8_UB
}
}

namespace att {
constexpr float SCALE = 0.08838834764831845f;
constexpr float THR = 8.f;
constexpr int NW = 8, QBLK = 32, KVBLK = 64, QB = NW * QBLK, D = 128;
constexpr int SHM_V = KVBLK * D * 2, SHM_K = KVBLK * D * 2;
constexpr int ATT_LDS = 2 * SHM_V + 2 * SHM_K + NW * 64 * 4;
#define KSWZ(row, colB) ((row) * 256 + ((colB) ^ (((row) & 7) << 4)))
#define SBAR() __builtin_amdgcn_sched_barrier(0)
__device__ __forceinline__ int v_st(int k, int c) { const int kk = (k & ~0xC) | ((k & 4) << 1) | ((k & 8) >> 1); return ((kk >> 3) * 4 + (c >> 5)) * 512 + ((kk & 7) * 32 + (c & 31)) * 2; }
__device__ __forceinline__ int v_rd_base(int lane) { return ((lane & 3) << 3) | (((lane >> 2) & 3) << 6) | (((lane >> 4) & 1) << 5) | (((lane >> 5) & 1) << 8); }
constexpr int v_rd_off(int d0, int ks, int half) { return d0 * 512 + ks * 4096 + half * 2048; }
__device__ __forceinline__ int crow(int r, int hi) { return (r & 3) + 8 * (r >> 2) + 4 * hi; }
__device__ __forceinline__ bf16x8 load8(const bf16_t* p) { return *reinterpret_cast<const bf16x8*>(p); }
__device__ __forceinline__ void mask_tile(f32x16& p0, f32x16& p1, int dq) {
    const float NEG = -__builtin_inff();
#pragma unroll
    for (int r = 0; r < 16; ++r) {
        const int c = (r & 3) + 8 * (r >> 2);
        if (dq - c < 0) p0[r] = NEG;
        if (dq - c - 32 < 0) p1[r] = NEG;
    }
}
__device__ __forceinline__ void mask_all(f32x16& p0, f32x16& p1, bool off) {
    const float NEG = -__builtin_inff();
#pragma unroll
    for (int r = 0; r < 16; ++r) { p0[r] = off ? NEG : p0[r]; p1[r] = off ? NEG : p1[r]; }
}
__device__ __forceinline__ void partialSM(f32x16& p0, f32x16& p1, float& m_reg, float& mn, float& alpha, float rbias = 0.f) {
    float pmax = p0[0];
#pragma unroll
    for (int r = 1; r < 16; ++r) pmax = fmaxf(pmax, p0[r]);
#pragma unroll
    for (int r = 0; r < 16; ++r) pmax = fmaxf(pmax, p1[r]);
    { auto rr = __builtin_amdgcn_permlane32_swap(__float_as_uint(pmax), __float_as_uint(pmax), false, false);
      pmax = fmaxf(__uint_as_float(rr[0]), __uint_as_float(rr[1])); }
    constexpr float C2 = 1.4426950408889634f * SCALE;
    if (__builtin_expect(__all((pmax - m_reg) * SCALE <= THR), 1)) { mn = m_reg; alpha = 1.f; }
    else { mn = fmaxf(m_reg, pmax); alpha = __builtin_amdgcn_exp2f((m_reg - mn) * C2); m_reg = mn; }
    const float mnL = -mn * C2 + rbias;
#pragma unroll
    for (int r = 0; r < 16; ++r) p0[r] = fmaf(p0[r], C2, mnL);
#pragma unroll
    for (int r = 0; r < 16; ++r) p1[r] = fmaf(p1[r], C2, mnL);
#pragma unroll
    for (int r = 0; r < 16; ++r) p0[r] = __builtin_amdgcn_exp2f(p0[r]);
}
__device__ __forceinline__ void finishSM(f32x16& p0, f32x16& p1, float alpha, float& l_reg, bf16x8& pa0, bf16x8& pa1, bf16x8& pa2, bf16x8& pa3) {
#pragma unroll
    for (int r = 0; r < 16; ++r) p1[r] = __builtin_amdgcn_exp2f(p1[r]);
    float ps = 0;
#pragma unroll
    for (int r = 0; r < 16; ++r) ps += p0[r];
#pragma unroll
    for (int r = 0; r < 16; ++r) ps += p1[r];
    { auto rr = __builtin_amdgcn_permlane32_swap(__float_as_uint(ps), __float_as_uint(ps), false, false);
      ps = __uint_as_float(rr[0]) + __uint_as_float(rr[1]); }
    l_reg = l_reg * alpha + ps;
#define PK4(P, B_, OUT) do { unsigned a0 = cvt_pk_bf16(P[B_+0], P[B_+1]), a1 = cvt_pk_bf16(P[B_+2], P[B_+3]);                          \
        unsigned b0 = cvt_pk_bf16(P[B_+4], P[B_+5]), b1 = cvt_pk_bf16(P[B_+6], P[B_+7]);                                             \
        auto r0 = __builtin_amdgcn_permlane32_swap(a0, b0, false, false); auto r1 = __builtin_amdgcn_permlane32_swap(a1, b1, false, false); \
        u32x4 w = {r0[0], r1[0], r0[1], r1[1]}; OUT = *reinterpret_cast<bf16x8*>(&w); } while (0)
    PK4(p0, 0, pa0); PK4(p0, 8, pa1); PK4(p1, 0, pa2); PK4(p1, 8, pa3);
#undef PK4
}
template <int KB>
__device__ __forceinline__ void qkt(f32x16& p0, f32x16& p1, const char* K_lds, int r32, int hi, const bf16x8* qr) {
    p0 = f32x16{}; p1 = f32x16{};
    const char* kb[4];
#pragma unroll
    for (int dd = 0; dd < 4; ++dd) kb[dd] = K_lds + KB * SHM_K + KSWZ(r32, (dd * 16 + hi * 8) * 2);
#pragma unroll
    for (int d0 = 0; d0 < 8; ++d0) { const char* a = kb[d0 & 3] + (d0 >> 2) * 128;
        bf16x8 b0 = *reinterpret_cast<const bf16x8*>(a);
        bf16x8 b1 = *reinterpret_cast<const bf16x8*>(a + 32 * 256);
        p0 = __builtin_amdgcn_mfma_f32_32x32x16_bf16(b0, qr[d0], p0, 0, 0, 0);
        p1 = __builtin_amdgcn_mfma_f32_32x32x16_bf16(b1, qr[d0], p1, 0, 0, 0); }
}
template <int VB>
__device__ __forceinline__ void pv_tile(f32x16* o, int vb0, bf16x8 pa0, bf16x8 pa1, bf16x8 pa2, bf16x8 pa3) {
#define TRRD(dst, off) asm volatile("ds_read_b64_tr_b16 %0, %1 offset:%2" : "=&v"(dst) : "v"(vb0), "i"(off) : "memory")
#define PV_D0(d0) do { s16x4 l0, l1, l2, l3, h0, h1, h2, h3; constexpr int b_ = VB * SHM_V + v_rd_off(d0, 0, 0); \
        TRRD(l0, b_); TRRD(h0, b_ + 2048); TRRD(l1, b_ + 4096); TRRD(h1, b_ + 6144); TRRD(l2, b_ + 8192); TRRD(h2, b_ + 10240); TRRD(l3, b_ + 12288); TRRD(h3, b_ + 14336); \
        asm volatile("s_waitcnt lgkmcnt(0)" ::: "memory"); SBAR();   \
        o[d0] = __builtin_amdgcn_mfma_f32_32x32x16_bf16(pa0, (bf16x8){l0[0], l0[1], l0[2], l0[3], h0[0], h0[1], h0[2], h0[3]}, o[d0], 0, 0, 0);   \
        o[d0] = __builtin_amdgcn_mfma_f32_32x32x16_bf16(pa1, (bf16x8){l1[0], l1[1], l1[2], l1[3], h1[0], h1[1], h1[2], h1[3]}, o[d0], 0, 0, 0);   \
        o[d0] = __builtin_amdgcn_mfma_f32_32x32x16_bf16(pa2, (bf16x8){l2[0], l2[1], l2[2], l2[3], h2[0], h2[1], h2[2], h2[3]}, o[d0], 0, 0, 0);   \
        o[d0] = __builtin_amdgcn_mfma_f32_32x32x16_bf16(pa3, (bf16x8){l3[0], l3[1], l3[2], l3[3], h3[0], h3[1], h3[2], h3[3]}, o[d0], 0, 0, 0); } while (0)
    PV_D0(0); PV_D0(1); PV_D0(2); PV_D0(3);
#undef PV_D0
#undef TRRD
}

struct BlockRef { const bf16_t* Q; const bf16_t* K; const bf16_t* V; bf16_t* O; const bf16_t* Gt; const float* KM; int P0; };
struct Seam { bf16x8 qr[8]; bf16x8 st_v0, st_v1, st_k0, st_k1; };
#define ROW(p, k0, rr) ((p) + (size_t)((k0) + (rr)) * D + sc)
#define VMW() asm volatile("s_waitcnt vmcnt(0)" ::: "memory")
#define VMWN(n) asm volatile("s_waitcnt vmcnt(%0)" :: "i"(n) : "memory")
#define SLOAD_H(Kp, Vp, k0) do { S.st_v0 = load8(ROW(Vp, k0, sr)); S.st_v1 = load8(ROW(Vp, k0, 32 + sr));              \
                         S.st_k0 = load8(ROW(Kp, k0, sr)); S.st_k1 = load8(ROW(Kp, k0, 32 + sr)); } while (0)
#define SWRITE_HK(bf) do { *(bf16x8*)(K_lds + (bf) * SHM_K + kws) = S.st_k0; *(bf16x8*)(K_lds + (bf) * SHM_K + kws + 32 * 256) = S.st_k1; } while (0)
#define SWRITE_HV(bf) do { *(bf16x8*)(V_lds + (bf) * SHM_V + vst0) = S.st_v0; *(bf16x8*)(V_lds + (bf) * SHM_V + vst1) = S.st_v1; } while (0)
#define SWRITE_H(bf) do { SWRITE_HV(bf); SWRITE_HK(bf); } while (0)
__device__ __forceinline__ void moba_prime(const BlockRef& cur, char* lds, Seam& S, int wv) {
    const int tid = opq_tid(wv), wid = __builtin_amdgcn_readfirstlane(tid >> 6), lane = tid & 63, r32 = lane & 31, hi = lane >> 5;
    const int sr = tid >> 4, sc = (tid & 15) * 8, kws = KSWZ(sr, sc * 2); char* K_lds = lds + 2 * SHM_V;
#pragma unroll
    for (int d0 = 0; d0 < 8; ++d0) S.qr[d0] = load8(cur.Q + (size_t)(wid * QBLK + r32) * D + d0 * 16 + hi * 8);
    SLOAD_H(cur.K, cur.V, 0); VMW(); SWRITE_HK(0);
    __syncthreads();
}
__device__ __forceinline__ unsigned moba_select(const Seam& S, const float* KM, int qb, int hi) {
    if (qb <= 3) return (1u << qb) - 1u;
    float sc_[8];
#pragma unroll
    for (int j = 0; j < 8; ++j) sc_[j] = 0.f;
#pragma unroll
    for (int j = 0; j < 7; ++j) {
        if (j < qb) {
            float s = 0.f;
#pragma unroll
            for (int d0 = 0; d0 < 8; ++d0) {
                const f32x4 k0 = *(const f32x4*)(KM + j * D + d0 * 16 + hi * 8), k1 = *(const f32x4*)(KM + j * D + d0 * 16 + hi * 8 + 4);
                const bf16x8 q = S.qr[d0];
                s += bf1((bf16_t)q[0]) * k0[0] + bf1((bf16_t)q[1]) * k0[1] + bf1((bf16_t)q[2]) * k0[2] + bf1((bf16_t)q[3]) * k0[3]
                   + bf1((bf16_t)q[4]) * k1[0] + bf1((bf16_t)q[5]) * k1[1] + bf1((bf16_t)q[6]) * k1[2] + bf1((bf16_t)q[7]) * k1[3];
            }
            s += __shfl_xor(s, 32);
            sc_[j] = s;
        }
    }
    unsigned sel = 0u;
#pragma unroll
    for (int it = 0; it < 3; ++it) {
        float best = -__builtin_inff(); int bi = 0;
#pragma unroll
        for (int j = 0; j < 7; ++j) { const bool ok = (j < qb) && !((sel >> j) & 1u) && (sc_[j] > best); best = ok ? sc_[j] : best; bi = ok ? j : bi; }
        sel |= 1u << bi;
    }
    return sel;
}
__device__ __forceinline__ void moba_block(const BlockRef& cur, const BlockRef& nxt, char* lds, Seam& S, int wv) {
    const int tid = opq_tid(wv), wid = __builtin_amdgcn_readfirstlane(tid >> 6), lane = tid & 63, r32 = lane & 31, hi = lane >> 5;
    const int NT = cur.P0 / KVBLK + 4;
    const int qb = cur.P0 >> 8;
    const int qlo = cur.P0 + wid * QBLK, qm = qlo + r32 - 4 * hi;
    char* V_lds = lds; char* K_lds = lds + 2 * SHM_V;
    float* ws = (float*)(lds + 2 * SHM_V + 2 * SHM_K) + wid * 64; float* li_l = ws, * al_l = ws + 32;
    float m_reg = -1e30f, l_reg = 0; f32x16 o[4] = {};
    const int sr = tid >> 4, sc = (tid & 15) * 8, vst0 = v_st(sr, sc), vst1 = v_st(32 + sr, sc), kws = KSWZ(sr, sc * 2);
    const int vb0 = (int)(uintptr_t)V_lds + v_rd_base(lane);
    const bf16_t* Kh = cur.K; const bf16_t* Vh = cur.V;
    const unsigned sel = moba_select(S, cur.KM, qb, hi);
    const bool need_sel = qb > 3;
#define RESC(a) do { if (__any((a) < 1.f)) { if (hi == 0) al_l[r32] = (a); asm volatile("s_waitcnt lgkmcnt(0)" ::: "memory");              \
                     for (int d_ = 0; d_ < 4; ++d_) for (int r = 0; r < 16; ++r) o[d_][r] *= al_l[crow(r, hi)]; } } while (0)
#define KBASE(t) ((t) * KVBLK)
#define MASKT(P0_, P1_, t) do { const int kb_ = KBASE(t); rb_ = 0.f; \
        if (kb_ < cur.P0) { if (need_sel) rb_ = (((sel >> (kb_ >> 8)) & 1u) == 0u) ? -__builtin_inff() : 0.f; } \
        else if (kb_ + KVBLK - 1 > qlo) mask_tile(P0_, P1_, qm - kb_); } while (0)
#define SEAM_K0() do { VMWN(8); SWRITE_HK(0); SBAR(); } while (0)
    f32x16 pA0, pA1, pB0, pB1; float mnA, mnB, alA, alB, rb_ = 0.f; bf16x8 pa0, pa1, pa2, pa3;
    SWRITE_HV(0); SBAR();
    SLOAD_H(Kh, Vh, KBASE(1));
    SBAR(); qkt<0>(pA0, pA1, K_lds, r32, hi, S.qr);
    MASKT(pA0, pA1, 0); partialSM(pA0, pA1, m_reg, mnA, alA, rb_);
    VMW(); SWRITE_H(1);
    __syncthreads();
#define HALF_STEP(PX0, PX1, mnX, alX, PY0, PY1, alY, t, KB, VB, SB) do {                                                      \
        SBAR(); qkt<KB>(PX0, PX1, K_lds, r32, hi, S.qr);                                                                       \
        finishSM(PY0, PY1, alY, l_reg, pa0, pa1, pa2, pa3); SBAR();                                                           \
        if ((t) + 1 < NT) { SLOAD_H(Kh, Vh, KBASE((t) + 1)); SBAR(); }                                                        \
        pv_tile<VB>(o, vb0, pa0, pa1, pa2, pa3); MASKT(PX0, PX1, (t)); partialSM(PX0, PX1, m_reg, mnX, alX, rb_);                  \
        __syncthreads();                                                                                                      \
        if ((t) + 1 < NT) { VMW(); SWRITE_H(SB); }                                                                            \
        RESC(alX); __syncthreads(); } while (0)
    for (int t = 1; t + 1 < NT; t += 2) {
        HALF_STEP(pB0, pB1, mnB, alB, pA0, pA1, alA, t, 1, 0, 0);
        HALF_STEP(pA0, pA1, mnA, alA, pB0, pB1, alB, t + 1, 0, 1, 1);
    }
    SBAR(); qkt<1>(pB0, pB1, K_lds, r32, hi, S.qr); SBAR();
    SLOAD_H(nxt.K, nxt.V, 0); SBAR();
#pragma unroll
    for (int d0 = 0; d0 < 8; ++d0) S.qr[d0] = load8(nxt.Q + (size_t)(wid * QBLK + r32) * D + d0 * 16 + hi * 8);
    SBAR();
    finishSM(pA0, pA1, alA, l_reg, pa0, pa1, pa2, pa3); SBAR();
    pv_tile<0>(o, vb0, pa0, pa1, pa2, pa3);
    MASKT(pB0, pB1, NT - 1); partialSM(pB0, pB1, m_reg, mnB, alB, rb_); __syncthreads(); RESC(alB);
    finishSM(pB0, pB1, alB, l_reg, pa0, pa1, pa2, pa3); SBAR(); pv_tile<1>(o, vb0, pa0, pa1, pa2, pa3);
    SBAR(); SEAM_K0();
    if (hi == 0) li_l[r32] = l_reg; asm volatile("s_waitcnt lgkmcnt(0)" ::: "memory");
    bf16_t* Ow = cur.O + (size_t)(wid * QBLK) * DM; const bf16_t* Gw = cur.Gt + (size_t)(wid * QBLK) * DM + r32;
    bf16_t gl[16][4];
#pragma unroll
    for (int r = 0; r < 16; ++r)
#pragma unroll
        for (int d0 = 0; d0 < 4; ++d0) gl[r][d0] = Gw[(size_t)crow(r, hi) * DM + d0 * 32];
#pragma unroll
    for (int r = 0; r < 16; ++r) { const int orow = crow(r, hi); const float rl = __builtin_amdgcn_rcpf(li_l[orow]);
#pragma unroll
        for (int d0 = 0; d0 < 4; ++d0) { const float gv = bf1(gl[r][d0]);
            const float v = o[d0][r] * rl * gv;
            const float vn = __shfl_xor(v, 1);
            if ((r32 & 1) == 0) *(unsigned*)(Ow + (size_t)orow * DM + d0 * 32 + r32) = cvt_pk_bf16(v, vn); } }
    __syncthreads();
#undef RESC
#undef KBASE
#undef MASKT
#undef SEAM_K0
#undef HALF_STEP
}
#undef ROW
#undef VMW
#undef VMWN
#undef SLOAD_H
#undef SWRITE_HK
#undef SWRITE_HV
#undef SWRITE_H

__device__ __forceinline__ BlockRef mk_ref(int L, int pass, const bf16_t* Q, const bf16_t* K, const bf16_t* V, bf16_t* O, const bf16_t* Gt, const float* KM) {
    const int bh = L >> 2, x = L & 3, qb = pass ? 7 - x : x, b = bh >> 3, h = bh & 7;
    BlockRef r;
    r.Q = Q + ((size_t)bh * SEQ + (size_t)qb * QB) * D; r.K = K + (size_t)bh * SEQ * D; r.V = V + (size_t)bh * SEQ * D;
    r.O = O + ((size_t)b * SEQ + (size_t)qb * QB) * DM + h * DH; r.Gt = Gt + ((size_t)b * SEQ + (size_t)qb * QB) * DM + h * DH;
    r.KM = KM + (size_t)bh * 8 * D; r.P0 = qb * QB;
    return r;
}
__device__ __forceinline__ void attn_phase(char* lds, const bf16_t* Q, const bf16_t* K, const bf16_t* V, bf16_t* O, const bf16_t* Gt, const float* KM, int wv) {
    const int total = NB * NH * 4, stride = gridDim.x;
    int L = opq_bid(); if (L >= total) return;
    if (stride == 256) { const int xcd = L & 7, j = L >> 3; L = ((xcd * 8 + (j >> 2)) << 2) | (j & 3); }
    int pass = 0;
    BlockRef cur = mk_ref(L, 0, Q, K, V, O, Gt, KM);
    Seam S;
    moba_prime(cur, lds, S, wv);
    for (;;) {
        const bool more_pass = pass == 0, more_item = L + stride < total, last = !more_pass && !more_item;
        int passn = pass + 1, Ln = L;
        if (!more_pass) { passn = 0; Ln = more_item ? L + stride : L; }
        const BlockRef nxt = last ? cur : mk_ref(Ln, passn, Q, K, V, O, Gt, KM);
        moba_block(cur, nxt, lds, S, wv);
        if (last) break;
        cur = nxt; pass = passn; L = Ln;
    }
}
}

#ifndef REP_MASK
#define REP_MASK 0
#endif
#ifndef BAR_REP
#define BAR_REP 1
#endif
struct Args { const float* in[21]; float* out; unsigned char* ws; int ph_lo, ph_hi; };
typedef const __attribute__((address_space(4))) Args* ArgsP;
#define AIN(i) ((const float*)ap->in[i])

__device__ __forceinline__ void transpose_item(const float* W, int ldw, bf16_t* WT, int ldt, LAS float* scr, int lane) {
    float tv[32];
#pragma unroll
    for (int i = 0; i < 32; ++i) { const int kk = 2 * i + (lane >> 5); tv[i] = W[(size_t)kk * ldw + (lane & 31)]; }
#pragma unroll
    for (int i = 0; i < 32; ++i) { const int kk = 2 * i + (lane >> 5); scr[kk * 33 + (lane & 31)] = tv[i]; }
    asm volatile("s_waitcnt lgkmcnt(0)" ::: "memory");
    const int c = lane & 7;
#pragma unroll
    for (int j = 0; j < 4; ++j) { const int n = (lane >> 3) + 8 * j; const LAS float* s = scr + (8 * c) * 33 + n;
        u32x4 o; o.x = cvt_pk_bf16(s[0 * 33], s[1 * 33]); o.y = cvt_pk_bf16(s[2 * 33], s[3 * 33]); o.z = cvt_pk_bf16(s[4 * 33], s[5 * 33]); o.w = cvt_pk_bf16(s[6 * 33], s[7 * 33]);
        *(u32x4*)(WT + (size_t)n * ldt + 8 * c) = o; }
    asm volatile("s_waitcnt lgkmcnt(0)" ::: "memory");
}
__device__ __forceinline__ void transpose_mat(const float* W, int K, int N, bf16_t* WT, int item, LAS float* scr, int lane) {
    const int nblk = N / 32, kb = item / nblk, nb = item % nblk;
    transpose_item(W + (size_t)(64 * kb) * N + 32 * nb, N, WT + (size_t)(32 * nb) * K + 64 * kb, K, scr, lane);
}

template <bool SILU>
__device__ __forceinline__ void gemv_item(const float* vec, int vld, const float* W, int ldw, int n0, int k0, float* out, int old, const float* bias, LAS float* scr, int lane) {
    const float* wp = W + (size_t)k0 * ldw + n0 + lane;
#pragma unroll
    for (int i = 0; i < 8; ++i) { const int idx = i * 64 + lane, b = idx >> 6, kk = idx & 63; const float v = vec[(size_t)b * vld + k0 + kk]; scr[kk * 8 + b] = SILU ? fsilu(v) : v; }
    asm volatile("s_waitcnt lgkmcnt(0)" ::: "memory");
    float acc[8];
#pragma unroll
    for (int b = 0; b < 8; ++b) acc[b] = 0.f;
#pragma unroll 1
    for (int kh = 0; kh < 64; kh += 32) {
        float w[32];
#pragma unroll
        for (int kk = 0; kk < 32; ++kk) w[kk] = wp[(size_t)(kh + kk) * ldw];
#pragma unroll
        for (int kk = 0; kk < 32; ++kk) {
            const f32x4 c0 = *(const LAS f32x4*)(scr + (kh + kk) * 8), c1 = *(const LAS f32x4*)(scr + (kh + kk) * 8 + 4);
            acc[0] += w[kk] * c0[0]; acc[1] += w[kk] * c0[1]; acc[2] += w[kk] * c0[2]; acc[3] += w[kk] * c0[3];
            acc[4] += w[kk] * c1[0]; acc[5] += w[kk] * c1[1]; acc[6] += w[kk] * c1[2]; acc[7] += w[kk] * c1[3];
            if ((kk & 3) == 3) __builtin_amdgcn_sched_barrier(0); }
    }
    const float bv = bias ? bias[n0 + lane] : 0.f;
#pragma unroll
    for (int b = 0; b < 8; ++b) atomicAdd(out + (size_t)b * old + n0 + lane, acc[b] + bv);
    asm volatile("s_waitcnt lgkmcnt(0)" ::: "memory");
}
__device__ __forceinline__ void prep0_phase(ArgsP ap, LAS unsigned char* lds, int wave, int lane) {
    unsigned char* ws = (unsigned char*)ap->ws;
    LAS float* scr = (LAS float*)(lds + wave * 16384);
    const int gw = opq_bid() * NWAVES + wave, NGW = gridDim.x * NWAVES;
    for (int r = gw; r < (MODV_LD / 64) * 16; r += NGW) {
        const int cgp = r >> 4, kc = r & 15;
        const float* W; int ldw, n0; const float* bias;
        if (cgp < 192) { const int l = cgp / 48; n0 = (cgp % 48) * 64; W = AIN(2) + (size_t)l * DM * 3 * DM; ldw = 3 * DM; bias = AIN(3) + l * 3 * DM; }
        else { n0 = (cgp - 192) * 64; W = AIN(15); ldw = 2 * DM; bias = AIN(16); }
        gemv_item<true>(AIN(1), DM, W, ldw, n0, kc * 64, (float*)(ws + WS_MODV) + (cgp * 64 - n0), MODV_LD, kc == 0 ? bias : nullptr, scr, lane);
    }
}
__device__ __forceinline__ void prep1_phase(ArgsP ap, LAS unsigned char* lds, int wave, int lane) {
    unsigned char* ws = (unsigned char*)ap->ws;
    LAS float* scr = (LAS float*)(lds + wave * 16384);
    const int gw = opq_bid() * NWAVES + wave, NGW = gridDim.x * NWAVES;
    constexpr int I_BIG = (DM / 64) * (2 * DM / 32);
    constexpr int I_SQ = (DM / 64) * (DM / 32);
    constexpr int I_G = (256 / 64) * (256 / 32);
    constexpr int N_T = 2 * I_BIG + 2 * I_SQ + 2 * I_BIG + I_BIG + 2 * I_SQ + 16 * I_G;
    constexpr int N_GEMV = 4 * 32 * 16;
    for (int it = gw; it < N_T + N_GEMV; it += NGW) {
        int r = it;
        if (r < N_GEMV) {
            const int slot = r >> 9, q = r & 511, cgp = q >> 4, kc = q & 15;
            const size_t woff = slot == 0 ? (size_t)DM * 2 * DM : slot == 3 ? (size_t)DM * 2 * DM : 0;
            const float* W = (slot == 0 ? AIN(5) : slot == 2 ? AIN(17) : AIN(18)) + woff;
            const int shcol = slot == 0 ? 1 * 3 * DM : slot == 1 ? 2 * 3 * DM : slot == 2 ? 4 * 3 * DM : 3 * 3 * DM;
            gemv_item<false>((const float*)(ws + WS_MODV) + shcol, MODV_LD, W, 2 * DM, cgp * 64, kc * 64, (float*)(ws + WS_SHW) + (size_t)slot * 8 * 2 * DM, 2 * DM, nullptr, scr, lane);
            continue;
        } r -= N_GEMV;
        const float* W; bf16_t* WT; int ldw, ldt;
        if (r < 6 * I_BIG + 0 * I_SQ && r < 2 * I_BIG) { const int l = r / I_BIG, item = r % I_BIG, kb = item / 64, nb = item % 64;
            W = AIN(5) + (size_t)l * DM * 2 * DM + (size_t)(64 * kb) * 2 * DM + 32 * nb; ldw = 2 * DM; WT = (bf16_t*)(ws + WS_WIN) + (size_t)l * 2 * DM * DM + (size_t)(32 * nb) * DM + 64 * kb; ldt = DM; }
        else if ((r -= 2 * I_BIG) < 2 * I_SQ) { const int l = r / I_SQ, item = r % I_SQ, kb = item / 32, nb = item % 32;
            W = AIN(13) + (size_t)l * DM * DM + (size_t)(64 * kb) * DM + 32 * nb; ldw = DM; WT = (bf16_t*)(ws + WS_WOUT) + (size_t)l * DM * DM + (size_t)(32 * nb) * DM + 64 * kb; ldt = DM; }
        else if ((r -= 2 * I_SQ) < 2 * I_BIG) { const int l = r / I_BIG, item = r % I_BIG, kb = item / 64, nb = item % 64;
            W = AIN(18) + (size_t)l * DM * 2 * DM + (size_t)(64 * kb) * 2 * DM + 32 * nb; ldw = 2 * DM; WT = (bf16_t*)(ws + (l ? WS_ATTIN1 : WS_ATTIN0)) + (size_t)(32 * nb) * DM + 64 * kb; ldt = DM; }
        else if ((r -= 2 * I_BIG) < I_BIG) { const int kb = r / 64, nb = r % 64;
            W = AIN(17) + (size_t)(64 * kb) * 2 * DM + 32 * nb; ldw = 2 * DM; WT = (bf16_t*)(ws + WS_WKV) + (size_t)(32 * nb) * DM + 64 * kb; ldt = DM; }
        else if ((r -= I_BIG) < 2 * I_SQ) { const int l = r / I_SQ, item = r % I_SQ, kb = item / 32, nb = item % 32;
            W = AIN(19) + (size_t)l * DM * DM + (size_t)(64 * kb) * DM + 32 * nb; ldw = DM; WT = (bf16_t*)(ws + WS_ATTOUT) + (size_t)l * DM * DM + (size_t)(32 * nb) * DM + 64 * kb; ldt = DM; }
        else { r -= 2 * I_SQ;
            const int mat = r / I_G, item = r % I_G, which = mat >> 3, lh = mat & 7;
            const int kb = item / 8, nb = item % 8, n0 = 32 * nb, drow = 256 * (n0 >> 7) + 128 * which + (n0 & 127);
            W = (which ? AIN(10) : AIN(8)) + (size_t)lh * 256 * 256 + (size_t)(64 * kb) * 256 + n0; ldw = 256;
            WT = (bf16_t*)(ws + WS_WG) + (size_t)lh * 512 * 256 + (size_t)drow * 256 + 64 * kb; ldt = 256; }
        transpose_item(W, ldw, WT, ldt, scr, lane);
    }
}

__device__ __forceinline__ void norm_phase(const float* xin, bf16_t* o1, const float* g1, const float* modv, int sh1, int sc1c,
                                            bf16_t* o2, const float* g2, int sh2, int sc2c, int wave, int lane) {
    const int gw = opq_bid() * NWAVES + wave, NGW = gridDim.x * NWAVES;
    for (int rb = gw; rb < MTOK / 8; rb += NGW) {
        const int r0 = rb * 8, b = r0 / SEQ;
        const float* mv = modv + (size_t)b * MODV_LD;
        f32x4 gs1[4], sf1[4], gs2[4], sf2[4];
#pragma unroll
        for (int j = 0; j < 4; ++j) { const int idx = 4 * lane + 256 * j;
            const f32x4 gv = *(const f32x4*)(g1 + idx), sc = *(const f32x4*)(mv + sc1c + idx); gs1[j] = gv * (sc + 1.f); sf1[j] = *(const f32x4*)(mv + sh1 + idx);
            if (o2) { const f32x4 gv2 = *(const f32x4*)(g2 + idx), sc2 = *(const f32x4*)(mv + sc2c + idx); gs2[j] = gv2 * (sc2 + 1.f); sf2[j] = *(const f32x4*)(mv + sh2 + idx); }
            else { gs2[j] = gs1[j]; sf2[j] = sf1[j]; } }
        for (int rr = 0; rr < 8; ++rr) {
            const size_t row = (size_t)(r0 + rr);
            const f32x4* xr = (const f32x4*)(xin + row * DM) + lane;
            f32x4 v[4]; float s = 0.f;
#pragma unroll
            for (int j = 0; j < 4; ++j) { v[j] = xr[64 * j]; s += (v[j].x * v[j].x + v[j].y * v[j].y) + (v[j].z * v[j].z + v[j].w * v[j].w); }
            const float rstd = 1.f / sqrtf(wave_sum(s) * (1.f / DM) + EPS);
#pragma unroll
            for (int j = 0; j < 4; ++j) { const f32x4 t = v[j] * rstd; const f32x4 y = t * gs1[j] + sf1[j];
                u32x2 w; w.x = cvt_pk_bf16(y.x, y.y); w.y = cvt_pk_bf16(y.z, y.w);
                *((u32x2*)(o1 + row * DM) + lane + 64 * j) = w;
                if (o2) { const f32x4 y2 = t * gs2[j] + sf2[j]; u32x2 w2; w2.x = cvt_pk_bf16(y2.x, y2.y); w2.y = cvt_pk_bf16(y2.z, y2.w);
                    *((u32x2*)(o2 + row * DM) + lane + 64 * j) = w2; } }
        }
    }
}
__device__ __forceinline__ void conv_phase(const bf16_t* UP, bf16_t* U, const float* cw, const float* cb, int tid) {
    const int ch = 8 * (tid & 127), sub = tid >> 7;
    float w0[8], w1[8], w2[8], w3[8], bb[8];
#pragma unroll
    for (int h = 0; h < 2; ++h) { const f32x4 a = *(const f32x4*)(cw + ch + 4 * h), b = *(const f32x4*)(cw + DM + ch + 4 * h), c = *(const f32x4*)(cw + 2 * DM + ch + 4 * h), d = *(const f32x4*)(cw + 3 * DM + ch + 4 * h), e = *(const f32x4*)(cb + ch + 4 * h);
#pragma unroll
        for (int j = 0; j < 4; ++j) { w0[4 * h + j] = a[j]; w1[4 * h + j] = b[j]; w2[4 * h + j] = c[j]; w3[4 * h + j] = d[j]; bb[4 * h + j] = e[j]; } }
    for (int it = opq_bid(); it < NB * 32; it += gridDim.x) {
        const int b = it >> 5, c = it & 31, t0 = c * 64 + sub * 16; const size_t base = ((size_t)b * SEQ + t0) * DM + ch;
        u32x4 rw[19];
#pragma unroll
        for (int t = 0; t < 19; ++t) rw[t] = (t0 + t - 3 >= 0) ? *(const u32x4*)(UP + base + (ptrdiff_t)(t - 3) * DM) : (u32x4){0u, 0u, 0u, 0u};
#pragma unroll
        for (int t = 0; t < 16; ++t) {
            unsigned ow[4];
#pragma unroll
            for (int q = 0; q < 4; ++q) { const unsigned a0 = rw[t][q], a1 = rw[t + 1][q], a2 = rw[t + 2][q], a3 = rw[t + 3][q];
                const float lo = bb[2 * q] + w0[2 * q] * bf_lo(a0) + w1[2 * q] * bf_lo(a1) + w2[2 * q] * bf_lo(a2) + w3[2 * q] * bf_lo(a3);
                const float hi = bb[2 * q + 1] + w0[2 * q + 1] * bf_hi(a0) + w1[2 * q + 1] * bf_hi(a1) + w2[2 * q + 1] * bf_hi(a2) + w3[2 * q + 1] * bf_hi(a3);
                ow[q] = cvt_pk_bf16(lo, hi); }
            *(u32x4*)(U + base + (size_t)t * DM) = (u32x4){ow[0], ow[1], ow[2], ow[3]}; }
    }
}

#define XB_TMO      128
#define XB_XCNT(j)  (256  + 64 * (j))
#define XB_XSUB(j)  (1280 + 64 * (j))
#define XB_XGEN(j)  (2304 + 64 * (j))
#define XB_TOP      3328
#define XB_TOPGEN   3392
#define XCD_BAR_WORDS 3456
#define XB_SPIN_CAP (1u << 18)
constexpr size_t WS_BAR = 16384;
constexpr int LDS_MISC = 131072 + 320;
__device__ __forceinline__ unsigned xb_ld(unsigned* p)              { return __hip_atomic_load(p, __ATOMIC_RELAXED, __HIP_MEMORY_SCOPE_AGENT); }
__device__ __forceinline__ unsigned xb_add(unsigned* p, unsigned v) { return __hip_atomic_fetch_add(p, v, __ATOMIC_RELAXED, __HIP_MEMORY_SCOPE_AGENT); }
__device__ __forceinline__ unsigned xb_xcc_id() { return (unsigned)__builtin_amdgcn_s_getreg((3 << 11) | 20) & 0xFu; }
#define XB_SPIN(cond, bar) do { unsigned _sp = 0; while (cond) { __builtin_amdgcn_s_sleep(1); \
    if ((++_sp & 255u) == 0u) { if (xb_ld(&(bar)[XB_TMO])) break; if (_sp > XB_SPIN_CAP) { atomicAdd(&(bar)[XB_TMO], 1u); break; } } } } while (0)
__device__ __forceinline__ void xcd_barrier_complete(unsigned* bar, unsigned x, unsigned& nloc, unsigned& nx) {
    const unsigned G = gridDim.x * gridDim.y * gridDim.z;
    unsigned sum, cnt, mine, sp = 0u;
    for (;;) {
        sum = 0u; cnt = 0u; mine = 0u;
#pragma unroll
        for (unsigned j = 0; j < 16; ++j) { const unsigned c = xb_ld(&bar[XB_XCNT(j)]); sum += c; cnt += (c > 0u) ? 1u : 0u; mine = (j == x) ? c : mine; }
        if (sum == G) break;
        __builtin_amdgcn_s_sleep(1);
        if ((++sp & 255u) == 0u) { if (xb_ld(&bar[XB_TMO])) break; if (sp > XB_SPIN_CAP) { atomicAdd(&bar[XB_TMO], 1u); break; } }
    }
    nloc = mine > 0u ? mine : 1u; nx = cnt > 0u ? cnt : 1u;
}
__device__ __forceinline__ void xcd_barrier(unsigned* bar, volatile LAS unsigned* st, int tid) {
    asm volatile("s_waitcnt vmcnt(0)" ::: "memory");
    __syncthreads();
    if (tid == 0) {
        const unsigned x = xb_xcc_id();
        __builtin_amdgcn_s_waitcnt(0);
        unsigned nloc = st[0], nx = st[1];
        if (nloc == 0u) { xcd_barrier_complete(bar, x, nloc, nx); st[0] = nloc; st[1] = nx; }
        const unsigned old = xb_add(&bar[XB_XSUB(x)], 1u);
        const unsigned gen = old / nloc;
        if (old + 1u == (gen + 1u) * nloc) {
            __builtin_amdgcn_fence(__ATOMIC_RELEASE, "agent");
            asm volatile("s_waitcnt vmcnt(0)" ::: "memory");
            const unsigned og = xb_add(&bar[XB_TOP], 1u);
            const unsigned tg = og / nx;
            if (og + 1u == (tg + 1u) * nx) xb_add(&bar[XB_TOPGEN], 1u);
            else XB_SPIN(xb_ld(&bar[XB_TOPGEN]) == tg, bar);
            __builtin_amdgcn_fence(__ATOMIC_ACQUIRE, "agent");
            xb_add(&bar[XB_XGEN(x)], 1u);
            asm volatile("s_waitcnt vmcnt(0)" ::: "memory");
        } else {
            XB_SPIN(xb_ld(&bar[XB_XGEN(x)]) == gen, bar);
            __builtin_amdgcn_fence(__ATOMIC_ACQUIRE, "agent");
            asm volatile("s_waitcnt vmcnt(0)" ::: "memory");
        }
    }
    __syncthreads();
}

constexpr int NPHASE = 14;
#ifndef PH_EN
#define PH_EN 0xFFFF
#endif
#define EN(b) ((PH_EN >> (b)) & 1)
#ifndef REP_MASK
#define REP_MASK 0
#endif
#define REPS(b) for (int rep_ = 0; rep_ < EN(b) * (1 + ((REP_MASK >> (b)) & 1)); ++rep_)
template <int ph>
__device__ __forceinline__ void run_phase(unsigned char* lds, int wv) {
    LAS unsigned char* ldsl = (LAS unsigned char*)lds;
    {
        ArgsP ap = (ArgsP)__builtin_amdgcn_kernarg_segment_ptr();
        asm volatile("" : "+s"(ap));
        const int G = gridDim.x;
        unsigned char* ws = (unsigned char*)ap->ws;
        float* modv = (float*)(ws + WS_MODV);
        float* kmean = (float*)(ws + WS_KMEAN);
        bf16_t* HN = (bf16_t*)(ws + WS_HN); bf16_t* HKV = (bf16_t*)(ws + WS_HKV); bf16_t* UPRE = (bf16_t*)(ws + WS_UPRE); bf16_t* GB = (bf16_t*)(ws + WS_G);
        bf16_t* LAb = (bf16_t*)(ws + WS_LA); bf16_t* BINb = (bf16_t*)(ws + WS_BIN);
        float* xw = (float*)ap->out;
        const int tid = opq_tid(wv), c = opq_bid();
        const int lane = tid & 63, wave = __builtin_amdgcn_readfirstlane(tid >> 6);
        float* sumsq = (float*)(ws + WS_SUMSQ); const float* shw = (const float*)(ws + WS_SHW);
        if (ph == 0) {
            if (EN(0)) prep0_phase(ap, ldsl, wave, lane);
        } else if (ph == 1) {
            REPS(1) norm_phase(AIN(0), HN, AIN(4), modv, 0, DM, nullptr, nullptr, 0, 0, wave, lane);
            if (EN(0)) prep1_phase(ap, ldsl, wave, lane);
        } else if (ph <= 7) {
            const int l = (ph - 2) / 3, k3 = (ph - 2) % 3, k = k3 == 0 ? 0 : k3 + 1;
            const float* xin = (l == 0) ? AIN(0) : xw;
            if (k == 0) {
                pg8::Gemm g{l == 0 ? HN : HKV, (const bf16_t*)(ws + WS_WIN) + (size_t)l * 2 * DM * DM, DM, DM, DM, 0, 0};
                int one = 1; asm volatile("" : "+s"(one));
                { pg8::InOrder S{c, one, 0};
                  pg8::EpiSplitConv E{ws, l == 0 ? nullptr : sumsq, shw, AIN(6) + l * 4 * DM, AIN(7) + l * DM, 4u * (unsigned)(l + 1), ldsl};
                  REPS(2) pg8::gemm_phase(ldsl, g, S, E, wv); }
                { pg8::InOrder S{c, one, 1};
                  pg8::EpiSplit E{UPRE, GB, l == 0 ? nullptr : sumsq, shw};
                  REPS(2) pg8::gemm_phase(ldsl, g, S, E, wv); }
            } else if (k == 1) {
                REPS(3) conv_phase(UPRE, HKV, AIN(6) + l * 4 * DM, AIN(7) + l * DM, tid);
            } else if (k == 2) {
                pg8::Gemm g{UPRE, (const bf16_t*)(ws + WS_WG) + (size_t)l * 4 * 512 * 256, DM, 256, 256, 256 * 2, 512 * 256 * 2};
                int two = 2; asm volatile("" : "+s"(two));
                pg8::GatesOrder S{c, two};
                pg8::EpiGatesS E{ws, 4u * (unsigned)(l + 1), AIN(9) + l * DM, AIN(11) + l * DM, AIN(12) + l * DM, ldsl};
                REPS(4) pg8::gemm_phase(ldsl, g, S, E, wv);
            } else {
                pg8::Gemm g{HN, (const bf16_t*)(ws + WS_WOUT) + (size_t)l * DM * DM, DM, DM, DM, 0, 0};
                pg8::MultiOrder S; S.init(MTOK, DM, 1, G, c);
                _Float16* x16 = (_Float16*)(ws + WS_X16);
                if (l == 0) { pg8::EpiResH<float, false> E{AIN(0), x16, modv + 2 * DM, modv, HKV, AIN(4) + DM, 3 * DM + DM, nullptr, nullptr, 0, sumsq};
                    REPS(7) pg8::gemm_phase(ldsl, g, S, E, wv); }
                else { pg8::EpiResH<_Float16, true> E{x16, x16, modv + l * 3 * DM + 2 * DM, modv, HKV, AIN(4) + (l + 1) * DM, (l + 1) * 3 * DM + DM,
                              LAb, AIN(14), 4 * 3 * DM + DM, sumsq + (size_t)l * MTOK};
                    REPS(7) pg8::gemm_phase(ldsl, g, S, E, wv); }
            }
        } else if (ph <= 13) {
            const int i = (ph - 8) / 3, k = (ph - 8) % 3, l = 2 + i;
            if (k == 0) {
                pg8::Gemm g{i == 0 ? HKV : LAb, (const bf16_t*)(ws + (i == 0 ? WS_ATTIN0 : WS_ATTIN1)), DM, DM, DM, (long)(WS_LA - WS_HKV), (long)(WS_WKV - WS_ATTIN0)};
                pg8::MultiOrder S; S.init(MTOK, 2 * DM, i == 0 ? 2 : 1, G, c);
                pg8::EpiQKV E{ws, kmean, sumsq + (size_t)(1 + i) * MTOK, shw + (size_t)(i == 0 ? 1 : 3) * 8 * 2 * DM, 8 * 2 * DM};
                REPS(9) pg8::gemm_phase(ldsl, g, S, E, wv);
            } else if (k == 1) {
                REPS(10) att::attn_phase((char*)lds, UPRE, HN, BINb, HKV, GB, kmean, wv);
            } else if (i == 0) {
                pg8::Gemm g{HKV, (const bf16_t*)(ws + WS_ATTOUT), DM, DM, DM, 0, 0};
                pg8::MultiOrder S; S.init(MTOK, DM, 1, G, c);
                _Float16* x16 = (_Float16*)(ws + WS_X16);
                pg8::EpiResH<_Float16, false> E{x16, x16, modv + l * 3 * DM + 2 * DM, modv, LAb, AIN(4) + 3 * DM, 3 * 3 * DM + DM, nullptr, nullptr, 0, sumsq + (size_t)2 * MTOK};
                REPS(11) pg8::gemm_phase(ldsl, g, S, E, wv);
            } else {
                pg8::Gemm g{HKV, (const bf16_t*)(ws + WS_ATTOUT) + (size_t)DM * DM, DM, DM, DM, 0, 0};
                pg8::MultiOrder S; S.init(MTOK, DM, 1, G, c);
                pg8::EpiFinal E{(const _Float16*)(ws + WS_X16), xw, modv + l * 3 * DM + 2 * DM, AIN(20), sumsq + (size_t)3 * MTOK, (unsigned*)(ws + WS_PCNT)};
                REPS(12) pg8::gemm_phase(ldsl, g, S, E, wv);
            }
        }
    }
}
__global__ void __launch_bounds__(NTHR, 2) yoco_fwd(Args a_) {
    extern __shared__ __attribute__((aligned(16))) unsigned char lds[];
    const int ph_lo = a_.ph_lo, ph_hi = a_.ph_hi;
    const int wv = __builtin_amdgcn_readfirstlane((int)threadIdx.x >> 6);
    if (ph_hi - ph_lo > 1) {
        if (threadIdx.x < 8) ((volatile LAS unsigned*)((LAS unsigned char*)lds + LDS_MISC))[threadIdx.x] = 0u;
        if (threadIdx.x == 0) (void)xb_add(&((unsigned*)(a_.ws + WS_BAR))[XB_XCNT(xb_xcc_id())], 1u);
        __syncthreads();
    }
    if (ph_lo < 0) cg::this_grid().sync();
#define SEAM(P) do { ArgsP ap_ = (ArgsP)__builtin_amdgcn_kernarg_segment_ptr(); asm volatile("" : "+s"(ap_)); \
        xcd_barrier((unsigned*)((unsigned char*)ap_->ws + WS_BAR), (volatile LAS unsigned*)((LAS unsigned char*)lds + LDS_MISC), opq_tid(wv)); } while (0)
#ifndef TPROBE_MASK
#define TPROBE_MASK 0
#endif
#define TPROBE_MULT 10
#define TP_ON(P) ((TPROBE_MASK >> (P)) & 1)
#define TP_BEGIN(P) if (TP_ON(P) && blockIdx.x == 0 && opq_tid(wv) == 0) { volatile LAS unsigned long long* tw_ = (volatile LAS unsigned long long*)((LAS unsigned char*)lds + LDS_MISC + 16); tw_[1] = __builtin_amdgcn_s_memrealtime(); }
#define TP_END(P) if (TP_ON(P) && blockIdx.x == 0 && opq_tid(wv) == 0) { volatile LAS unsigned long long* tw_ = (volatile LAS unsigned long long*)((LAS unsigned char*)lds + LDS_MISC + 16); tw_[0] = tw_[0] + (__builtin_amdgcn_s_memrealtime() - tw_[1]); }
#define RUN(P) if ((P) >= ph_lo && (P) < ph_hi) { TP_BEGIN(P) run_phase<P>(lds, wv); if ((P) + 1 < ph_hi) { for (int br_ = 0; br_ < BAR_REP; ++br_) SEAM(P); } TP_END(P) }
    RUN(0) RUN(1) RUN(2) RUN(3) RUN(4) RUN(5) RUN(6) RUN(7) RUN(8) RUN(9) RUN(10) RUN(11)
    RUN(12) RUN(13)
#undef RUN
#undef SEAM
    if (TPROBE_MASK != 0 && blockIdx.x == 0 && opq_tid(wv) == 0) {
        volatile LAS unsigned long long* tw_ = (volatile LAS unsigned long long*)((LAS unsigned char*)lds + LDS_MISC + 16);
        const unsigned long long span = tw_[0] * TPROBE_MULT, t0 = __builtin_amdgcn_s_memrealtime();
        while (__builtin_amdgcn_s_memrealtime() - t0 < span) __builtin_amdgcn_s_sleep(8);
    }
}

extern "C" void kernel_launch(void* const* d_in, const int* in_sizes, int n_in, void* d_out, int out_size, void* d_ws, size_t ws_size, hipStream_t stream) {
    static int grid = 0;
    if (grid == 0) {
        if (n_in != 21 || out_size != MTOK * DM || ws_size < WS_END) { fprintf(stderr, "kernel_launch: unexpected shapes (n_in %d out %d ws %zu)\n", n_in, out_size, ws_size); grid = -1; return; }
        int dev = 0, cus = 0, per_cu = 0;
        (void)hipGetDevice(&dev);
        if (hipDeviceGetAttribute(&cus, hipDeviceAttributeMultiprocessorCount, dev) != hipSuccess || cus <= 0) cus = 256;
        if (hipFuncSetAttribute((const void*)yoco_fwd, hipFuncAttributeMaxDynamicSharedMemorySize, LDS_BYTES) != hipSuccess) { fprintf(stderr, "kernel_launch: hipFuncSetAttribute failed\n"); grid = -1; return; }
        if (hipOccupancyMaxActiveBlocksPerMultiprocessor(&per_cu, (const void*)yoco_fwd, NTHR, LDS_BYTES) != hipSuccess || per_cu < 1) { fprintf(stderr, "kernel_launch: occupancy query says %d\n", per_cu); per_cu = 1; }
        (void)hipGetLastError();
        grid = cus > 256 ? 256 : cus;
    }
    if (grid < 0) return;
    (void)hipMemsetAsync((char*)d_ws + WS_CTL, 0, CTL_ZERO_BYTES, stream);
    Args a{};
    for (int i = 0; i < 21; ++i) a.in[i] = (const float*)d_in[i];
    a.out = (float*)d_out; a.ws = (unsigned char*)d_ws;
#if MK_MULTI_LAUNCH
    for (int ph = 0; ph < NPHASE; ++ph) { a.ph_lo = ph; a.ph_hi = ph + 1; hipLaunchKernelGGL(yoco_fwd, dim3(grid), dim3(NTHR), LDS_BYTES, stream, a); }
#else
    a.ph_lo = 0; a.ph_hi = NPHASE;
    void* kargs[] = {&a};
    hipError_t e = hipLaunchCooperativeKernel((const void*)yoco_fwd, dim3(grid), dim3(NTHR), kargs, LDS_BYTES, stream);
    if (e != hipSuccess) fprintf(stderr, "kernel_launch: cooperative launch failed: %s (grid %d)\n", hipGetErrorString(e), grid);
#endif
}
```

```cpp
#include <hip/hip_runtime.h>
#include <hip/hip_cooperative_groups.h>
#include <cstdio>
#include <cstdint>
namespace cg = cooperative_groups;

#ifndef MK_MULTI_LAUNCH
#define MK_MULTI_LAUNCH 0
#endif

constexpr int DM = 1024, NB = 8, SEQ = 2048, MTOK = NB * SEQ, NH = 8, DH = 128;
constexpr int MODV_LD = 14336;
constexpr float EPS = 1e-6f;
constexpr int NWAVES = 8, NTHR = 512;
constexpr int LDS_BYTES = 147456;

constexpr size_t MiB = 1u << 20;
constexpr size_t WS_CTL = 0, CTL_ZERO_BYTES = 1 * MiB + 256 * 1024;
constexpr size_t WS_MODV = 64 * 1024;
constexpr size_t WS_KMEAN = 512 * 1024;
constexpr size_t WS_GFLAG = 32 * 1024;
constexpr size_t WS_SHW = 768 * 1024;
constexpr size_t WS_PCNT = 48 * 1024;
constexpr size_t WS_CFLAG = 50 * 1024;
constexpr size_t WS_SUMSQ = 1 * MiB;
constexpr size_t WS_TA = 1 * MiB + 256 * 1024;
constexpr size_t WS_WIN = 2 * MiB;
constexpr size_t WS_WG = 10 * MiB;
constexpr size_t WS_WOUT = 12 * MiB;
constexpr size_t WS_ATTIN0 = 16 * MiB, WS_WKV = 20 * MiB, WS_ATTIN1 = 24 * MiB;
constexpr size_t WS_ATTOUT = 28 * MiB;
constexpr size_t WS_HN = 32 * MiB;
constexpr size_t WS_HKV = 64 * MiB;
constexpr size_t WS_UPRE = 96 * MiB;
constexpr size_t WS_G = 128 * MiB;
constexpr size_t WS_LA = 160 * MiB;
constexpr size_t WS_BIN = 192 * MiB;
constexpr size_t WS_X16 = 224 * MiB;
constexpr size_t WS_END = 256 * MiB;

typedef unsigned short bf16_t;
typedef short bf16x8 __attribute__((ext_vector_type(8)));
typedef short s16x4 __attribute__((ext_vector_type(4)));
typedef float f32x4 __attribute__((ext_vector_type(4)));
typedef float f32x2 __attribute__((ext_vector_type(2)));
typedef float f32x16 __attribute__((ext_vector_type(16)));
typedef unsigned u32x4 __attribute__((ext_vector_type(4)));
typedef unsigned u32x2 __attribute__((ext_vector_type(2)));
#define LAS __attribute__((address_space(3)))

__device__ __forceinline__ unsigned cvt_pk_bf16(float lo, float hi) { unsigned r; asm volatile("v_cvt_pk_bf16_f32 %0, %1, %2" : "=v"(r) : "v"(lo), "v"(hi)); return r; }
__device__ __forceinline__ float bf_lo(unsigned w) { return __uint_as_float(w << 16); }
__device__ __forceinline__ float bf_hi(unsigned w) { return __uint_as_float(w & 0xffff0000u); }
__device__ __forceinline__ float bf1(bf16_t h) { return __uint_as_float((unsigned)h << 16); }
__device__ __forceinline__ float fexp(float x) { return __builtin_amdgcn_exp2f(x * 1.4426950408889634f); }
__device__ __forceinline__ float flog(float x) { return __builtin_amdgcn_logf(x) * 0.6931471805599453f; }
__device__ __forceinline__ float fsigmoid(float x) { return __builtin_amdgcn_rcpf(1.f + fexp(-x)); }
__device__ __forceinline__ float fsilu(float x) { return x * fsigmoid(x); }
__device__ __forceinline__ int opq_tid(int wv) { int l; asm volatile("v_mbcnt_lo_u32_b32 %0, -1, 0\n\tv_mbcnt_hi_u32_b32 %0, -1, %0" : "=v"(l)); return wv * 64 + l; }
__device__ __forceinline__ int opq_bid() { int b = blockIdx.x; asm volatile("" : "+s"(b)); return b; }
__device__ __forceinline__ float wave_sum(float v) {
#pragma unroll
    for (int o = 1; o < 64; o <<= 1) v += __shfl_xor(v, o);
    return v;
}

namespace pg8 {
constexpr int BM = 256, BK = 64, HALF = 128, HTB = HALF * BK * 2, STAGE_BYTES = 8 * HTB, NXCD = 8, WGM = 8;
__host__ __device__ __forceinline__ int lds_byte(int r, int c) { const int st = (r >> 4) * 2 + (c >> 5), rr = r & 15, cc = c & 31, ob = rr * 64 + cc * 2; return st * 1024 + (ob ^ (((ob >> 9) & 1) << 5)); }
__host__ __device__ __forceinline__ void stage_rc(int b, int& R, int& C) { const int st = b / 1024, sb = b % 1024, swz = sb ^ (((sb >> 9) & 1) << 5); R = (st >> 1) * 16 + swz / 64; C = (st & 1) * 32 + (swz % 64) / 2; }
__host__ __device__ __forceinline__ int perm32(int rho) { const int n = rho >> 4, i = rho & 15; return 8 * (i >> 2) + 4 * n + (i & 3); }

struct Unit { int pm, pn, sub; };
struct Gemm { const bf16_t* A; const bf16_t* Bt; int lda, ldb, K; long a_sub, b_sub; };

struct MultiOrder {
    int nM, nN, nwg, nsub, G, c;
    __device__ void init(int M, int N, int nsub_, int G_, int c_) { nM = M / BM; nN = N / BM; nwg = nM * nN; nsub = nsub_; G = G_; c = c_; }
    __device__ bool next(int i, Unit& u) const {
        const long L = (long)i * G + c; if (L >= (long)nwg * nsub) return false;
        u.sub = (int)(L / nwg);
        int wgid = (int)(L % nwg); { const int q = nwg / NXCD, r = nwg % NXCD, xcd = wgid % NXCD, off = wgid / NXCD; wgid = (xcd < r ? xcd * (q + 1) : r * (q + 1) + (xcd - r) * q) + off; }
        const int nig = WGM * nN, gid = wgid / nig, fm = gid * WGM, gsz = (nM - fm) < WGM ? (nM - fm) : WGM;
        u.pm = fm + ((wgid % nig) % gsz); u.pn = (wgid % nig) / gsz; return true;
    }
};


template <int N> __device__ __forceinline__ float dpp_shr(float src, float ident) {
    return __int_as_float(__builtin_amdgcn_update_dpp(__float_as_int(ident), __float_as_int(src), 0x110 + N, 0xF, 0xF, false));
}
struct EpiSplit {
    static constexpr bool PERM = true, APERM = false;
    bf16_t* O0; bf16_t* O1; const float* sumsq; const float* shw;
    __device__ __forceinline__ void operator()(const f32x4 (&acc)[2][2][4][2], const Unit& u, int wr, int wc, int fr, int fq) const {
        const int row0 = u.pm * BM + wr * 64 + fr; int colt = u.pn * BM; bf16_t* base = O0;
        const int cfull = u.pn * BM + wc * 32 + 8 * fq;
        const bool gate_half = colt >= DM;
        if (gate_half) { base = O1; colt -= DM; }
        const int col0 = colt + wc * 32 + 8 * fq;
        f32x4 bv[2][2];
#pragma unroll
        for (int bj = 0; bj < 2; ++bj)
#pragma unroll
            for (int n = 0; n < 2; ++n) bv[bj][n] = sumsq ? *(const f32x4*)(shw + (size_t)(u.pm >> 3) * 2 * DM + cfull + bj * HALF + 4 * n) : (f32x4){0.f, 0.f, 0.f, 0.f};
        float ssq[2][4];
#pragma unroll
        for (int ai = 0; ai < 2; ++ai)
#pragma unroll
            for (int m = 0; m < 4; ++m) ssq[ai][m] = sumsq ? sumsq[row0 + ai * HALF + m * 16] : 0.f;
#pragma unroll
        for (int ai = 0; ai < 2; ++ai)
#pragma unroll
            for (int m = 0; m < 4; ++m) { const int row = row0 + ai * HALF + m * 16; bf16_t* rowp = base + (size_t)row * DM + col0;
                const float rs = sumsq ? __builtin_amdgcn_rsqf(ssq[ai][m] * (1.f / DM) + EPS) : 1.f;
#pragma unroll
                for (int bj = 0; bj < 2; ++bj) { f32x4 v0 = acc[ai][bj][m][0] * rs + bv[bj][0], v1 = acc[ai][bj][m][1] * rs + bv[bj][1];
                    if (gate_half) {
#pragma unroll
                        for (int j = 0; j < 4; ++j) { v0[j] = fsilu(v0[j]); v1[j] = fsilu(v1[j]); } }
                    u32x4 w; w.x = cvt_pk_bf16(v0[0], v0[1]); w.y = cvt_pk_bf16(v0[2], v0[3]); w.z = cvt_pk_bf16(v1[0], v1[1]); w.w = cvt_pk_bf16(v1[2], v1[3]);
                    *(u32x4*)(rowp + bj * HALF) = w; } }
    }
};

typedef _Float16 h16x8 __attribute__((ext_vector_type(8)));
__device__ __forceinline__ void ld8(const float* p, float (&v)[8]) { const f32x4 a = *(const f32x4*)p, b = *(const f32x4*)(p + 4); v[0] = a[0]; v[1] = a[1]; v[2] = a[2]; v[3] = a[3]; v[4] = b[0]; v[5] = b[1]; v[6] = b[2]; v[7] = b[3]; }
struct InOrder {
    int c, n, base;
    __device__ bool next(int i, Unit& u) const { if (i >= n) return false; const int j = c >> 3; int pm = (c & 7) * 8 + (j >> 2), pn = 4 * (i + base) + (j & 3), sub = 0;
        asm volatile("" : "+s"(pm), "+s"(pn), "+s"(sub)); u.pm = pm; u.pn = pn; u.sub = sub; return true; }
};
constexpr int CV_HL_OFF = 133120;
struct EpiSplitConv {
    static constexpr bool PERM = true, APERM = true;
    unsigned char* ws; const float* sumsq; const float* shw; const float* cw; const float* cb; unsigned target; LAS unsigned char* lds;
    __device__ __forceinline__ void operator()(f32x4 (&acc)[2][2][4][2], const Unit& u, int wr, int wc, int fr, int fq) const {
        const int pnl = u.pn & 3;
        const int cfull = u.pn * BM + wc * 32 + 8 * fq, ct = wc * 32 + 8 * fq, col0 = pnl * BM + ct;
        bf16_t* obase = (bf16_t*)(ws + WS_UPRE);
        f32x4 bv[2][2];
#pragma unroll
        for (int bj = 0; bj < 2; ++bj)
#pragma unroll
            for (int n = 0; n < 2; ++n) bv[bj][n] = sumsq ? *(const f32x4*)(shw + (size_t)(u.pm >> 3) * 2 * DM + cfull + bj * HALF + 4 * n) : (f32x4){0.f, 0.f, 0.f, 0.f};
        float ssq[2][4];
#pragma unroll
        for (int ai = 0; ai < 2; ++ai)
#pragma unroll
            for (int m = 0; m < 4; ++m) ssq[ai][m] = sumsq ? sumsq[u.pm * BM + ai * HALF + wr * 64 + 4 * fr + m] : 0.f;
#pragma unroll
        for (int ai = 0; ai < 2; ++ai)
#pragma unroll
            for (int m = 0; m < 4; ++m) { const float rs = sumsq ? __builtin_amdgcn_rsqf(ssq[ai][m] * (1.f / DM) + EPS) : 1.f;
#pragma unroll
                for (int bj = 0; bj < 2; ++bj) { acc[ai][bj][m][0] = acc[ai][bj][m][0] * rs + bv[bj][0]; acc[ai][bj][m][1] = acc[ai][bj][m][1] * rs + bv[bj][1]; } }
        const int tile = u.pm * 4 + pnl;
        unsigned long long* HX = (unsigned long long*)(ws + WS_BIN);
        unsigned* flags = (unsigned*)(ws + WS_CFLAG);
        LAS f32x4* HL = (LAS f32x4*)(lds + CV_HL_OFF);
#pragma unroll
        for (int ai = 0; ai < 2; ++ai)
#pragma unroll
            for (int k = 0; k < 3; ++k)
#pragma unroll
                for (int bj = 0; bj < 2; ++bj) {
                    if (fr == 15) { LAS f32x4* d = HL + (((ai * 2 + wr) * 3 + k) * 256 + bj * HALF + ct) / 4;
                        d[0] = acc[ai][bj][k + 1][0]; d[1] = acc[ai][bj][k + 1][1];
                        if (ai == 1 && wr == 1) { unsigned long long* g_ = HX + ((size_t)(tile * 3 + k) * 256 + bj * HALF + ct) / 2;
#pragma unroll
                            for (int n = 0; n < 2; ++n) { const f32x4 v = acc[1][bj][k + 1][n];
                                __hip_atomic_store(g_ + 2 * n, ((unsigned long long)__float_as_uint(v[1]) << 32) | __float_as_uint(v[0]), __ATOMIC_RELAXED, __HIP_MEMORY_SCOPE_AGENT);
                                __hip_atomic_store(g_ + 2 * n + 1, ((unsigned long long)__float_as_uint(v[3]) << 32) | __float_as_uint(v[2]), __ATOMIC_RELAXED, __HIP_MEMORY_SCOPE_AGENT); } } }
                    asm volatile("" ::: "memory"); __builtin_amdgcn_sched_barrier(0);
                }
        if (wr == 1) { asm volatile("s_waitcnt vmcnt(0)" ::: "memory");
            if (fr == 15 && fq == 0) __hip_atomic_fetch_add(flags + tile * 8, 1u, __ATOMIC_RELAXED, __HIP_MEMORY_SCOPE_AGENT); }
        asm volatile("s_waitcnt lgkmcnt(0)" ::: "memory"); __builtin_amdgcn_s_barrier(); asm volatile("" ::: "memory");
        const bool need_prev = (wr == 0) && ((u.pm & 7) != 0);
        if (need_prev) { unsigned spins = 0;
            while (__hip_atomic_load(flags + (tile - 4) * 8, __ATOMIC_RELAXED, __HIP_MEMORY_SCOPE_AGENT) < target) { __builtin_amdgcn_s_sleep(2); if (++spins > (1u << 22)) break; } }
#pragma unroll
        for (int ai = 0; ai < 2; ++ai)
#pragma unroll
            for (int bj = 0; bj < 2; ++bj)
#pragma unroll
                for (int n = 0; n < 2; ++n) {
                    f32x4 pr[3];
                    if (ai == 0 && wr == 0) {
#pragma unroll
                        for (int k = 0; k < 3; ++k) { unsigned long long wa = 0ull, wb = 0ull;
                            if (need_prev) { const unsigned long long* sp = HX + ((size_t)((tile - 4) * 3 + k) * 256 + bj * HALF + ct + 4 * n) / 2;
                                wa = __hip_atomic_load(sp, __ATOMIC_RELAXED, __HIP_MEMORY_SCOPE_AGENT); wb = __hip_atomic_load(sp + 1, __ATOMIC_RELAXED, __HIP_MEMORY_SCOPE_AGENT); }
                            pr[k] = (f32x4){__uint_as_float((unsigned)wa), __uint_as_float((unsigned)(wa >> 32)), __uint_as_float((unsigned)wb), __uint_as_float((unsigned)(wb >> 32))}; }
                    } else { const int prun = ai * 2 + wr - 1;
#pragma unroll
                        for (int k = 0; k < 3; ++k) pr[k] = HL[((prun * 3 + k) * 256 + bj * HALF + ct + 4 * n) / 4]; }
                    const int chg = pnl * BM + bj * HALF + ct + 4 * n;
                    const f32x4 w0 = *(const f32x4*)(cw + chg), w1 = *(const f32x4*)(cw + DM + chg), w2 = *(const f32x4*)(cw + 2 * DM + chg), w3 = *(const f32x4*)(cw + 3 * DM + chg), bb = *(const f32x4*)(cb + chg);
                    const f32x4 x0 = acc[ai][bj][0][n], x1 = acc[ai][bj][1][n], x2 = acc[ai][bj][2][n], x3 = acc[ai][bj][3][n];
                    f32x4 q1, q2, q3;
#pragma unroll
                    for (int j = 0; j < 4; ++j) { q1[j] = dpp_shr<1>(x3[j], pr[2][j]); q2[j] = dpp_shr<1>(x2[j], pr[1][j]); q3[j] = dpp_shr<1>(x1[j], pr[0][j]); }
                    const f32x4 y0 = bb + w0 * q3 + w1 * q2 + w2 * q1 + w3 * x0, y1 = bb + w0 * q2 + w1 * q1 + w2 * x0 + w3 * x1;
                    const f32x4 y2 = bb + w0 * q1 + w1 * x0 + w2 * x1 + w3 * x2, y3 = bb + w0 * x0 + w1 * x1 + w2 * x2 + w3 * x3;
                    bf16_t* op = obase + (size_t)(u.pm * BM + ai * HALF + wr * 64 + 4 * fr) * DM + col0 + bj * HALF + 4 * n;
                    { u32x2 w; w.x = cvt_pk_bf16(y0[0], y0[1]); w.y = cvt_pk_bf16(y0[2], y0[3]); *(u32x2*)(op) = w; }
                    { u32x2 w; w.x = cvt_pk_bf16(y1[0], y1[1]); w.y = cvt_pk_bf16(y1[2], y1[3]); *(u32x2*)(op + DM) = w; }
                    { u32x2 w; w.x = cvt_pk_bf16(y2[0], y2[1]); w.y = cvt_pk_bf16(y2[2], y2[3]); *(u32x2*)(op + 2 * DM) = w; }
                    { u32x2 w; w.x = cvt_pk_bf16(y3[0], y3[1]); w.y = cvt_pk_bf16(y3[2], y3[3]); *(u32x2*)(op + 3 * DM) = w; }
                    asm volatile("" ::: "memory"); __builtin_amdgcn_sched_barrier(0);
                }
    }
};

template <class TIn, bool HAS_A2>
struct EpiResH {
    static constexpr bool PERM = true, APERM = false;
    const TIn* xin; _Float16* xo; const float* gate; const float* modv; bf16_t* A1; const float* g1; int sc1; bf16_t* A2; const float* g2; int sc2; float* sumsq;
    __device__ __forceinline__ void operator()(const f32x4 (&acc)[2][2][4][2], const Unit& u, int wr, int wc, int fr, int fq) const {
        const int b = u.pm >> 3, col0 = u.pn * BM + wc * 32 + 8 * fq;
        float gv[2][8], gs1[2][8], gs2[HAS_A2 ? 2 : 1][8];
#pragma unroll
        for (int bj = 0; bj < 2; ++bj) { const int cc = col0 + bj * HALF;
            ld8(gate + (size_t)b * MODV_LD + cc, gv[bj]);
            { float gg[8], sc[8]; ld8(g1 + cc, gg); ld8(modv + (size_t)b * MODV_LD + sc1 + cc, sc);
#pragma unroll
              for (int j = 0; j < 8; ++j) gs1[bj][j] = gg[j] * (sc[j] + 1.f); }
            if constexpr (HAS_A2) { float gg[8], sc[8]; ld8(g2 + cc, gg); ld8(modv + (size_t)b * MODV_LD + sc2 + cc, sc);
#pragma unroll
              for (int j = 0; j < 8; ++j) gs2[bj][j] = gg[j] * (sc[j] + 1.f); } }
        constexpr int NG = (sizeof(TIn) == 4 || HAS_A2) ? 2 : 4;
#pragma unroll
        for (int ai = 0; ai < 2; ++ai) {
#pragma unroll
          for (int mh = 0; mh < 4; mh += NG) {
            float xv[sizeof(TIn) == 4 ? NG : 1][2][8]; h16x8 xh[sizeof(TIn) == 4 ? 1 : NG][2];
#pragma unroll
            for (int mm = 0; mm < NG; ++mm) { const size_t off = (size_t)(u.pm * BM + ai * HALF + wr * 64 + (mh + mm) * 16 + fr) * DM + col0;
#pragma unroll
                for (int bj = 0; bj < 2; ++bj) {
                    if constexpr (sizeof(TIn) == 4) ld8((const float*)xin + off + bj * HALF, xv[mm][bj]);
                    else xh[mm][bj] = *(const h16x8*)((const _Float16*)xin + off + bj * HALF); } }
            __builtin_amdgcn_sched_barrier(0);
#pragma unroll
            for (int mm = 0; mm < NG; ++mm) { const int m = mh + mm; const int row = u.pm * BM + ai * HALF + wr * 64 + m * 16 + fr; const size_t off = (size_t)row * DM + col0;
                float ss = 0.f;
#pragma unroll
                for (int bj = 0; bj < 2; ++bj) { float o[8]; h16x8 ho;
#pragma unroll
                    for (int j = 0; j < 8; ++j) { float xj; if constexpr (sizeof(TIn) == 4) xj = xv[mm][bj][j]; else xj = (float)xh[mm][bj][j];
                        o[j] = xj + gv[bj][j] * acc[ai][bj][m][j >> 2][j & 3]; ho[j] = (_Float16)o[j]; ss += o[j] * o[j]; }
                    *(h16x8*)(xo + off + bj * HALF) = ho;
                    if (A1) { u32x4 w; w.x = cvt_pk_bf16(o[0] * gs1[bj][0], o[1] * gs1[bj][1]); w.y = cvt_pk_bf16(o[2] * gs1[bj][2], o[3] * gs1[bj][3]);
                        w.z = cvt_pk_bf16(o[4] * gs1[bj][4], o[5] * gs1[bj][5]); w.w = cvt_pk_bf16(o[6] * gs1[bj][6], o[7] * gs1[bj][7]); *(u32x4*)(A1 + off + bj * HALF) = w; }
                    if constexpr (HAS_A2) { u32x4 w; w.x = cvt_pk_bf16(o[0] * gs2[bj][0], o[1] * gs2[bj][1]); w.y = cvt_pk_bf16(o[2] * gs2[bj][2], o[3] * gs2[bj][3]);
                        w.z = cvt_pk_bf16(o[4] * gs2[bj][4], o[5] * gs2[bj][5]); w.w = cvt_pk_bf16(o[6] * gs2[bj][6], o[7] * gs2[bj][7]); *(u32x4*)(A2 + off + bj * HALF) = w; } }
                if (sumsq) { ss += __shfl_xor(ss, 16); ss += __shfl_xor(ss, 32); if (fq == 0) atomicAdd(sumsq + row, ss); } }
            __builtin_amdgcn_sched_barrier(0);
          }
        }
    }
};

struct EpiFinal {
    static constexpr bool PERM = true, APERM = false;
    const _Float16* xin; float* out; const float* gate; const float* fg; float* sumsq; unsigned* cnt;
    __device__ __forceinline__ void operator()(f32x4 (&acc)[2][2][4][2], const Unit& u, int wr, int wc, int fr, int fq) const {
        const int b = u.pm >> 3, col0 = u.pn * BM + wc * 32 + 8 * fq;
        float gv[2][8];
#pragma unroll
        for (int bj = 0; bj < 2; ++bj) ld8(gate + (size_t)b * MODV_LD + col0 + bj * HALF, gv[bj]);
#pragma unroll
        for (int ai = 0; ai < 2; ++ai) {
            h16x8 xh[4][2];
#pragma unroll
            for (int m = 0; m < 4; ++m)
#pragma unroll
                for (int bj = 0; bj < 2; ++bj) xh[m][bj] = *(const h16x8*)(xin + (size_t)(u.pm * BM + ai * HALF + wr * 64 + m * 16 + fr) * DM + col0 + bj * HALF);
            __builtin_amdgcn_sched_barrier(0);
#pragma unroll
            for (int m = 0; m < 4; ++m) { const int row = u.pm * BM + ai * HALF + wr * 64 + m * 16 + fr;
                float ss = 0.f;
#pragma unroll
                for (int bj = 0; bj < 2; ++bj) { f32x4 o0, o1;
#pragma unroll
                    for (int j = 0; j < 4; ++j) { o0[j] = (float)xh[m][bj][j] + gv[bj][j] * acc[ai][bj][m][0][j]; o1[j] = (float)xh[m][bj][4 + j] + gv[bj][4 + j] * acc[ai][bj][m][1][j]; }
                    acc[ai][bj][m][0] = o0; acc[ai][bj][m][1] = o1;
                    ss += (o0[0] * o0[0] + o0[1] * o0[1]) + (o0[2] * o0[2] + o0[3] * o0[3]) + (o1[0] * o1[0] + o1[1] * o1[1]) + (o1[2] * o1[2] + o1[3] * o1[3]); }
                ss += __shfl_xor(ss, 16); ss += __shfl_xor(ss, 32); if (fq == 0) atomicAdd(sumsq + row, ss); }
            __builtin_amdgcn_sched_barrier(0);
        }
        asm volatile("s_waitcnt vmcnt(0)" ::: "memory");
        if (fr == 0 && fq == 0) __hip_atomic_fetch_add(cnt + u.pm * 8, 1u, __ATOMIC_RELAXED, __HIP_MEMORY_SCOPE_AGENT);
        { unsigned spins = 0;
          while (__hip_atomic_load(cnt + u.pm * 8, __ATOMIC_RELAXED, __HIP_MEMORY_SCOPE_AGENT) < 32u) { __builtin_amdgcn_s_sleep(2); if (++spins > (1u << 22)) break; } }
        float fgv[2][8];
#pragma unroll
        for (int bj = 0; bj < 2; ++bj) ld8(fg + col0 + bj * HALF, fgv[bj]);
        float ssq[2][4];
#pragma unroll
        for (int ai = 0; ai < 2; ++ai)
#pragma unroll
            for (int m = 0; m < 4; ++m) ssq[ai][m] = __hip_atomic_load(sumsq + u.pm * BM + ai * HALF + wr * 64 + m * 16 + fr, __ATOMIC_RELAXED, __HIP_MEMORY_SCOPE_AGENT);
#pragma unroll
        for (int ai = 0; ai < 2; ++ai)
#pragma unroll
            for (int m = 0; m < 4; ++m) { const size_t off = (size_t)(u.pm * BM + ai * HALF + wr * 64 + m * 16 + fr) * DM + col0;
                const float rs = __builtin_amdgcn_rsqf(ssq[ai][m] * (1.f / DM) + EPS);
#pragma unroll
                for (int bj = 0; bj < 2; ++bj) { f32x4 y0, y1;
#pragma unroll
                    for (int j = 0; j < 4; ++j) { y0[j] = acc[ai][bj][m][0][j] * rs * fgv[bj][j]; y1[j] = acc[ai][bj][m][1][j] * rs * fgv[bj][4 + j]; }
                    *(f32x4*)(out + off + bj * HALF) = y0; *(f32x4*)(out + off + bj * HALF + 4) = y1; } }
    }
};

__device__ __forceinline__ void scan16(float& a, float& b) {
    float ap, bp;
    ap = dpp_shr<1>(a, 1.f); bp = dpp_shr<1>(b, 0.f); b = fmaf(a, bp, b); a *= ap;
    ap = dpp_shr<2>(a, 1.f); bp = dpp_shr<2>(b, 0.f); b = fmaf(a, bp, b); a *= ap;
    ap = dpp_shr<4>(a, 1.f); bp = dpp_shr<4>(b, 0.f); b = fmaf(a, bp, b); a *= ap;
    ap = dpp_shr<8>(a, 1.f); bp = dpp_shr<8>(b, 0.f); b = fmaf(a, bp, b); a *= ap;
}
__device__ __forceinline__ void gate_elem2(f32x2 xr, f32x2 xg, f32x2 nba, f32x2 nbx, f32x2 psp2, f32x2 uv, f32x2& a, f32x2& b) {
    const f32x2 tr = xr * (-1.4426950408889634f) + nba, tg = xg * (-1.4426950408889634f) + nbx;
    f32x2 er, eg; er.x = __builtin_amdgcn_exp2f(tr.x); er.y = __builtin_amdgcn_exp2f(tr.y); eg.x = __builtin_amdgcn_exp2f(tg.x); eg.y = __builtin_amdgcn_exp2f(tg.y);
    const f32x2 dr = er + 1.f, dg = eg + 1.f, dd = dr * dg;
    f32x2 inv; inv.x = __builtin_amdgcn_rcpf(dd.x); inv.y = __builtin_amdgcn_rcpf(dd.y);
    const f32x2 r = inv * dg, gi = inv * dr;
    const f32x2 la2 = psp2 * r;
    a.x = __builtin_amdgcn_exp2f(-la2.x); a.y = __builtin_amdgcn_exp2f(-la2.y);
    const f32x2 om = 1.f - a * a;
    f32x2 sq; sq.x = __builtin_amdgcn_sqrtf(om.x); sq.y = __builtin_amdgcn_sqrtf(om.y);
    b = sq * gi * uv;
}
struct GateParams { f32x2 nba[4], nbx[4], psp2[4]; };
__device__ __forceinline__ void gate_params(GateParams& P, const float* ba, const float* bx, const float* lam, int ch0) {
#pragma unroll
    for (int p = 0; p < 4; ++p) {
        const f32x2 vb = *(const f32x2*)(ba + ch0 + 2 * p), vx = *(const f32x2*)(bx + ch0 + 2 * p), vl = *(const f32x2*)(lam + ch0 + 2 * p);
        P.nba[p] = vb * (-1.4426950408889634f); P.nbx[p] = vx * (-1.4426950408889634f);
        const float z0 = -vl.x, z1 = -vl.y;
        P.psp2[p].x = 8.f * 1.4426950408889634f * (z0 > 20.f ? z0 : flog(1.f + fexp(z0)));
        P.psp2[p].y = 8.f * 1.4426950408889634f * (z1 > 20.f ? z1 : flog(1.f + fexp(z1)));
    }
}
#define GATE_PAIR(p, accv, uw_, a2, b2) do { const int n_ = (p) >> 1, q_ = ((p) & 1) * 2; \
        const unsigned uword_ = ((p) == 0) ? uw_.x : ((p) == 1) ? uw_.y : ((p) == 2) ? uw_.z : uw_.w; \
        gate_elem2((f32x2){accv[ai][0][m][n_][q_], accv[ai][0][m][n_][q_ + 1]}, (f32x2){accv[ai][1][m][n_][q_], accv[ai][1][m][n_][q_ + 1]}, \
                   P.nba[p], P.nbx[p], P.psp2[p], (f32x2){bf_lo(uword_), bf_hi(uword_)}, a2, b2); } while (0)
struct GatesOrder {
    int c, n;
    __device__ bool next(int i, Unit& u) const { if (i >= n) return false; int pm = (c >> 5) * 8 + 4 * i + (c & 3), pn = (c >> 2) & 1, sub = (c >> 3) & 3;
        asm volatile("" : "+s"(pm), "+s"(pn), "+s"(sub)); u.pm = pm; u.pn = pn; u.sub = sub; return true; }
};
constexpr int GS_RA_OFF = 133120;
struct EpiGatesS {
    static constexpr bool PERM = true, APERM = true;
    unsigned char* ws; unsigned target; const float* ba; const float* bx; const float* lam; LAS unsigned char* lds;
    __device__ __forceinline__ void operator()(f32x4 (&acc)[2][2][4][2], const Unit& u, int wr, int wc, int fr, int fq) const {
        const bf16_t* U = (const bf16_t*)(ws + WS_UPRE); const bf16_t* Gt = (const bf16_t*)(ws + WS_G); bf16_t* Y = (bf16_t*)(ws + WS_HN);
        unsigned long long* TA = (unsigned long long*)(ws + WS_TA); unsigned* flags = (unsigned*)(ws + WS_GFLAG);
        const int ct0 = wc * 32 + 8 * fq, ch0 = u.sub * 256 + u.pn * 128 + ct0;
        const int chain = ((u.pm >> 3) * 4 + u.sub) * 2 + u.pn, p = u.pm & 7, tix = chain * 8 + p;
        const int bsrc = (fq * 16 + 15) << 2;
        LAS f32x4* RA = (LAS f32x4*)(lds + GS_RA_OFF);
        {
            GateParams P; gate_params(P, ba, bx, lam, ch0);
#pragma unroll
            for (int ai = 0; ai < 2; ++ai) {
                u32x4 uall[4];
#pragma unroll
                for (int m = 0; m < 4; ++m) uall[m] = *(const u32x4*)(U + (size_t)(u.pm * BM + ai * HALF + wr * 64 + 4 * fr + m) * DM + ch0);
#pragma unroll
                for (int n = 0; n < 2; ++n) { f32x4 tA[4], tB[4]; f32x4 agg;
#pragma unroll
                    for (int hq = 0; hq < 2; ++hq) { const int pq = 2 * n + hq; f32x2 a2[4], b2[4];
#pragma unroll
                        for (int m = 0; m < 4; ++m) { const u32x4 uw = uall[m]; GATE_PAIR(pq, acc, uw, a2[m], b2[m]); }
#pragma unroll
                        for (int m = 1; m < 4; ++m) { b2[m] = a2[m] * b2[m - 1] + b2[m]; a2[m] = a2[m] * a2[m - 1]; }
                        float pax = a2[3].x, pbx = b2[3].x, pay = a2[3].y, pby = b2[3].y; scan16(pax, pbx); scan16(pay, pby);
                        if (hq == 0) { agg[0] = pax; agg[1] = pbx; agg[2] = pay; agg[3] = pby;
                            if (fr == 15) RA[((ai * 2 + wr) * 128 + ct0) / 2 + pq] = agg; }
                        else { if (fr == 15) RA[((ai * 2 + wr) * 128 + ct0) / 2 + pq] = (f32x4){pax, pbx, pay, pby}; }
                        const f32x2 EA = {dpp_shr<1>(pax, 1.f), dpp_shr<1>(pay, 1.f)}, EB = {dpp_shr<1>(pbx, 0.f), dpp_shr<1>(pby, 0.f)};
#pragma unroll
                        for (int m = 0; m < 4; ++m) { const f32x2 Ae = a2[m] * EA, Be = a2[m] * EB + b2[m];
                            tA[m][2 * hq] = Ae.x; tA[m][2 * hq + 1] = Ae.y; tB[m][2 * hq] = Be.x; tB[m][2 * hq + 1] = Be.y; }
                        __builtin_amdgcn_sched_barrier(0); }
#pragma unroll
                    for (int m = 0; m < 4; ++m) { acc[ai][0][m][n] = tA[m]; acc[ai][1][m][n] = tB[m]; }
                    asm volatile("" ::: "memory"); __builtin_amdgcn_sched_barrier(0); }
            }
        }
        asm volatile("s_waitcnt lgkmcnt(0)" ::: "memory"); __builtin_amdgcn_s_barrier(); asm volatile("" ::: "memory");
        if (wr == 0) {
            float At[8], Bt[8];
#pragma unroll
            for (int j = 0; j < 8; ++j) { At[j] = 1.f; Bt[j] = 0.f; }
#pragma unroll
            for (int ri = 0; ri < 4; ++ri)
#pragma unroll
                for (int q = 0; q < 4; ++q) { const f32x4 v = RA[(ri * 128 + ct0) / 2 + q];
                    Bt[2 * q] = fmaf(v[0], Bt[2 * q], v[1]); At[2 * q] *= v[0]; Bt[2 * q + 1] = fmaf(v[2], Bt[2 * q + 1], v[3]); At[2 * q + 1] *= v[2]; }
            if (fr == 15) {
#pragma unroll
                for (int j = 0; j < 8; ++j) __hip_atomic_store(TA + (size_t)tix * 128 + ct0 + j, ((unsigned long long)__float_as_uint(Bt[j]) << 32) | __float_as_uint(At[j]), __ATOMIC_RELAXED, __HIP_MEMORY_SCOPE_AGENT);
            }
            asm volatile("s_waitcnt vmcnt(0)" ::: "memory");
            if (fr == 15 && fq == 0) __hip_atomic_fetch_add(flags + tix * 8, 1u, __ATOMIC_RELAXED, __HIP_MEMORY_SCOPE_AGENT);
        }
        float h[8];
        {
            const bool on = fr < p;
            if (on) { unsigned spins = 0;
                while (__hip_atomic_load(flags + (chain * 8 + fr) * 8, __ATOMIC_RELAXED, __HIP_MEMORY_SCOPE_AGENT) < target) { __builtin_amdgcn_s_sleep(2); if (++spins > (1u << 22)) break; } }
            float Ac[8], Bc[8];
#pragma unroll
            for (int j = 0; j < 8; ++j) { unsigned long long w = 0x000000003f800000ull;
                if (on) w = __hip_atomic_load(TA + (size_t)(chain * 8 + fr) * 128 + ct0 + j, __ATOMIC_RELAXED, __HIP_MEMORY_SCOPE_AGENT);
                Ac[j] = __uint_as_float((unsigned)w); Bc[j] = __uint_as_float((unsigned)(w >> 32)); }
#pragma unroll
            for (int j = 0; j < 8; ++j) { float a = Ac[j], b = Bc[j]; scan16(a, b); h[j] = __int_as_float(__builtin_amdgcn_ds_bpermute(bsrc, __float_as_int(b))); }
        }
#pragma unroll
        for (int ai = 0; ai < 2; ++ai) {
            const int nskip = (ai == 0) ? wr : 1;
            const int rfirst = (ai == 0) ? 0 : (1 + wr);
            for (int k = 0; k < nskip; ++k)
#pragma unroll
                for (int q = 0; q < 4; ++q) { const f32x4 v = RA[((rfirst + k) * 128 + ct0) / 2 + q];
                    h[2 * q] = fmaf(v[0], h[2 * q], v[1]); h[2 * q + 1] = fmaf(v[2], h[2 * q + 1], v[3]); }
            u32x4 gall[4];
#pragma unroll
            for (int m = 0; m < 4; ++m) gall[m] = *(const u32x4*)(Gt + (size_t)(u.pm * BM + ai * HALF + wr * 64 + 4 * fr + m) * DM + ch0);
            float hl[8];
#pragma unroll
            for (int m = 0; m < 4; ++m) { const size_t off = (size_t)(u.pm * BM + ai * HALF + wr * 64 + 4 * fr + m) * DM + ch0;
                const u32x4 gw = gall[m];
                const float gv[8] = {bf_lo(gw.x), bf_hi(gw.x), bf_lo(gw.y), bf_hi(gw.y), bf_lo(gw.z), bf_hi(gw.z), bf_lo(gw.w), bf_hi(gw.w)};
                float yv[8];
#pragma unroll
                for (int j = 0; j < 8; ++j) { const float hv = fmaf(acc[ai][0][m][j >> 2][j & 3], h[j], acc[ai][1][m][j >> 2][j & 3]); yv[j] = hv * gv[j];
                    if (m == 3) hl[j] = hv; }
                u32x4 w; w.x = cvt_pk_bf16(yv[0], yv[1]); w.y = cvt_pk_bf16(yv[2], yv[3]); w.z = cvt_pk_bf16(yv[4], yv[5]); w.w = cvt_pk_bf16(yv[6], yv[7]);
                *(u32x4*)(Y + off) = w; }
#pragma unroll
            for (int j = 0; j < 8; ++j) h[j] = __int_as_float(__builtin_amdgcn_ds_bpermute(bsrc, __float_as_int(hl[j])));
            asm volatile("" ::: "memory"); __builtin_amdgcn_sched_barrier(0);
        }
    }
};

struct EpiQKV {
    static constexpr bool PERM = true, APERM = false;
    unsigned char* ws; float* kmean; const float* sumsq; const float* shw; int shw_sub;
    __device__ __forceinline__ void operator()(const f32x4 (&acc)[2][2][4][2], const Unit& u, int wr, int wc, int fr, int fq) const {
        const int b = u.pm >> 3, sblk = u.pm & 7, pq = u.pn & 3; const bool second = u.pn >= 4;
        const int dcol = wc * 32 + 8 * fq;
        const float* sw = shw + (size_t)u.sub * shw_sub + (size_t)b * 2 * DM + u.pn * BM + dcol;
        f32x4 bv[2][2];
#pragma unroll
        for (int bj = 0; bj < 2; ++bj)
#pragma unroll
            for (int n = 0; n < 2; ++n) bv[bj][n] = *(const f32x4*)(sw + bj * HALF + 4 * n);
        const bool plain = (u.sub == 0 && second), km = (u.sub == 1 && !second);
        const size_t boff = plain ? WS_G : (u.sub == 0) ? WS_UPRE : (second ? WS_BIN : WS_HN);
        const size_t rstride = plain ? DM : DH;
        bf16_t* bp[2];
#pragma unroll
        for (int bj = 0; bj < 2; ++bj)
            bp[bj] = (bf16_t*)(ws + boff) + (plain ? (size_t)(u.pm * BM) * DM + pq * 256 + bj * HALF + dcol : ((size_t)(b * NH + 2 * pq + bj) * SEQ + sblk * 256) * DH + dcol);
        f32x4 s0[2], s1[2];
#pragma unroll
        for (int bj = 0; bj < 2; ++bj) { s0[bj] = (f32x4){0.f, 0.f, 0.f, 0.f}; s1[bj] = (f32x4){0.f, 0.f, 0.f, 0.f}; }
        float ssq[2][4];
#pragma unroll
        for (int ai = 0; ai < 2; ++ai)
#pragma unroll
            for (int m = 0; m < 4; ++m) ssq[ai][m] = sumsq[u.pm * BM + ai * HALF + wr * 64 + m * 16 + fr];
#pragma unroll
        for (int ai = 0; ai < 2; ++ai)
#pragma unroll
            for (int m = 0; m < 4; ++m) { const int r = ai * HALF + wr * 64 + m * 16 + fr;
                const float rs = __builtin_amdgcn_rsqf(ssq[ai][m] * (1.f / DM) + EPS);
#pragma unroll
                for (int bj = 0; bj < 2; ++bj) { f32x4 v0 = acc[ai][bj][m][0] * rs + bv[bj][0], v1 = acc[ai][bj][m][1] * rs + bv[bj][1];
                    if (plain) {
#pragma unroll
                        for (int j = 0; j < 4; ++j) { v0[j] = fsilu(v0[j]); v1[j] = fsilu(v1[j]); } }
                    s0[bj] += v0; s1[bj] += v1;
                    u32x4 w; w.x = cvt_pk_bf16(v0[0], v0[1]); w.y = cvt_pk_bf16(v0[2], v0[3]); w.z = cvt_pk_bf16(v1[0], v1[1]); w.w = cvt_pk_bf16(v1[2], v1[3]);
                    *(u32x4*)(bp[bj] + (size_t)r * rstride) = w; }
                asm volatile("" ::: "memory"); }
        if (km) {
#pragma unroll
            for (int bj = 0; bj < 2; ++bj)
#pragma unroll
                for (int j = 0; j < 4; ++j) { float t0 = s0[bj][j], t1 = s1[bj][j];
                    t0 += __shfl_xor(t0, 1); t0 += __shfl_xor(t0, 2); t0 += __shfl_xor(t0, 4); t0 += __shfl_xor(t0, 8);
                    t1 += __shfl_xor(t1, 1); t1 += __shfl_xor(t1, 2); t1 += __shfl_xor(t1, 4); t1 += __shfl_xor(t1, 8);
                    if (fr == 0) { float* kp = kmean + ((size_t)(b * NH + 2 * pq + bj) * 8 + sblk) * DH + dcol + j;
                        atomicAdd(kp, t0 * (1.f / 256.f)); atomicAdd(kp + 4, t1 * (1.f / 256.f)); } }
        }
    }
};

template <class Epi, class Sched>
__device__ __forceinline__ void gemm_phase(LAS unsigned char* lds, const Gemm g, const Sched& S, const Epi& E, int wv) {
    const int tid = opq_tid(wv), wid = __builtin_amdgcn_readfirstlane(tid >> 6), lane = tid & 63, wr = wid >> 2, wc = wid & 3, fr = lane & 15, fq = lane >> 4;
    const int K = g.K, nt = K / BK;
    unsigned voffA[2], voffB[2];
#pragma unroll
    for (int i = 0; i < 2; ++i) { int R, C; stage_rc(tid * 16 + i * 8192, R, C); const int Rb = Epi::PERM ? ((R & ~31) + perm32(R & 31)) : R;
        const int Ra = Epi::APERM ? ((R & 64) + 4 * (R & 15) + ((R >> 4) & 3)) : R;
        voffA[i] = (unsigned)(Ra * g.lda + C) * 2u; voffB[i] = (unsigned)(Rb * g.ldb + C) * 2u; }
    const size_t kstep = (size_t)(BK * 2);
    const size_t hstepA = (size_t)HALF * g.lda * 2, hstepB = (size_t)HALF * g.ldb * 2;
    const size_t tstepA = 2 * hstepA, tstepB = 2 * hstepB;
    const unsigned ldsw = (unsigned)wid * 1024u;
    const int aoff = lds_byte(wr * 64 + fr, fq * 8), boff = lds_byte(wc * 32 + fr, fq * 8);
#define PG8_SA(b, h) (((b) * 2 + (h)) * HTB)
#define PG8_SB(b, h) ((4 + (b) * 2 + (h)) * HTB)
#define PG8_STAGE(bufoff, gbase, voff) do { _Pragma("unroll") for (int _i = 0; _i < 2; ++_i) \
        __builtin_amdgcn_global_load_lds((const unsigned*)((const char*)(gbase) + (voff)[_i]), (LAS unsigned*)(lds + (bufoff) + ldsw + _i * 8192), 16, 0, 0); } while (0)
#define PG8_LDA(dst, b, h) do { _Pragma("unroll") for (int m = 0; m < 4; ++m) _Pragma("unroll") for (int k = 0; k < 2; ++k) dst[m][k] = *(const LAS bf16x8*)(lds + PG8_SA(b, h) + aoff + m * 2048 + k * 1024); } while (0)
#define PG8_LDB(dst, b, h) do { _Pragma("unroll") for (int n = 0; n < 2; ++n) _Pragma("unroll") for (int k = 0; k < 2; ++k) dst[n][k] = *(const LAS bf16x8*)(lds + PG8_SB(b, h) + boff + n * 2048 + k * 1024); } while (0)
#define PG8_MMA(ai, bj, At, Bt) do { __builtin_amdgcn_s_setprio(1); _Pragma("unroll") for (int m = 0; m < 4; ++m) _Pragma("unroll") for (int n = 0; n < 2; ++n) _Pragma("unroll") for (int k = 0; k < 2; ++k) \
        acc[ai][bj][m][n] = __builtin_amdgcn_mfma_f32_16x16x32_bf16(Bt[n][k], At[m][k], acc[ai][bj][m][n], 0, 0, 0); __builtin_amdgcn_s_setprio(0); } while (0)
#define PG8_WAIT_V(n) asm volatile("s_waitcnt vmcnt(" #n ")" ::: "memory")
#define PG8_WAIT_L(n) asm volatile("s_waitcnt lgkmcnt(" #n ")" ::: "memory")
#define PG8_BAR __builtin_amdgcn_s_barrier()
#define PG8_SCHED __builtin_amdgcn_sched_barrier(0)
#define PG8_UA(u) ((const char*)g.A + (size_t)(u).sub * g.a_sub + (size_t)(u).pm * tstepA)
#define PG8_UB(u) ((const char*)g.Bt + (size_t)(u).sub * g.b_sub + (size_t)(u).pn * tstepB)
    Unit cur, nxt; int ui = 0;
    if (!S.next(0, cur)) return;
    f32x4 acc[2][2][4][2];
#pragma unroll
    for (int a = 0; a < 2; ++a)
#pragma unroll
        for (int b = 0; b < 2; ++b)
#pragma unroll
            for (int m = 0; m < 4; ++m)
#pragma unroll
                for (int n = 0; n < 2; ++n) acc[a][b][m][n] = (f32x4){0.f, 0.f, 0.f, 0.f};
    bf16x8 At[4][2], B0[2][2], B1[2][2];
    const char* cA = PG8_UA(cur); const char* cB = PG8_UB(cur);
    PG8_STAGE(PG8_SB(0, 0), cB, voffB); PG8_STAGE(PG8_SB(0, 1), cB + hstepB, voffB); PG8_STAGE(PG8_SA(0, 0), cA, voffA); PG8_STAGE(PG8_SA(0, 1), cA + hstepA, voffA);
    if (wr == 1) PG8_BAR;
    PG8_WAIT_V(2); PG8_BAR;
    PG8_STAGE(PG8_SB(1, 0), cB + kstep, voffB); PG8_STAGE(PG8_SA(1, 0), cA + kstep, voffA); PG8_STAGE(PG8_SB(1, 1), cB + hstepB + kstep, voffB);
    PG8_WAIT_V(6); PG8_BAR;
    for (;;) {
        const bool has_next = S.next(ui + 1, nxt);
        const char* nA = has_next ? PG8_UA(nxt) : cA; const char* nB = has_next ? PG8_UB(nxt) : cB;
        for (int t = 0; t < nt; t += 2) {
            const bool last = (t == nt - 2);
            const char* a1 = cA + (size_t)(t + 1) * kstep;
            const char* a2 = last ? nA : cA + (size_t)(t + 2) * kstep; const char* b2 = last ? nB : cB + (size_t)(t + 2) * kstep;
            const char* a3 = a2 + kstep; const char* b3 = b2 + kstep;
            PG8_LDB(B0, 0, 0); PG8_LDB(B1, 0, 1); PG8_SCHED; PG8_LDA(At, 0, 0); PG8_STAGE(PG8_SA(1, 1), a1 + hstepA, voffA);
            PG8_WAIT_V(8); PG8_WAIT_L(0); PG8_BAR; PG8_MMA(0, 0, At, B0); PG8_MMA(0, 1, At, B1); PG8_BAR; PG8_SCHED;
            PG8_LDA(At, 0, 1); PG8_STAGE(PG8_SB(0, 0), b2, voffB); PG8_STAGE(PG8_SB(0, 1), b2 + hstepB, voffB); PG8_STAGE(PG8_SA(0, 0), a2, voffA);
            PG8_WAIT_V(8); PG8_WAIT_L(0); PG8_BAR; PG8_MMA(1, 0, At, B0); PG8_MMA(1, 1, At, B1); PG8_BAR; PG8_SCHED;
            PG8_LDB(B0, 1, 0); PG8_LDB(B1, 1, 1); PG8_SCHED; PG8_LDA(At, 1, 0); PG8_STAGE(PG8_SA(0, 1), a2 + hstepA, voffA);
            PG8_WAIT_V(8); PG8_WAIT_L(0); PG8_BAR; PG8_MMA(0, 0, At, B0); PG8_MMA(0, 1, At, B1); PG8_BAR; PG8_SCHED;
            PG8_LDA(At, 1, 1); PG8_STAGE(PG8_SB(1, 0), b3, voffB); PG8_STAGE(PG8_SB(1, 1), b3 + hstepB, voffB); PG8_STAGE(PG8_SA(1, 0), a3, voffA);
            PG8_WAIT_V(8); PG8_WAIT_L(0); PG8_BAR; PG8_MMA(1, 0, At, B0); PG8_MMA(1, 1, At, B1); PG8_BAR; PG8_SCHED;
        }
        if (wr == 0) PG8_BAR;
        { const int t2 = opq_tid(wv), w2 = __builtin_amdgcn_readfirstlane(t2 >> 6), l2 = t2 & 63; E(acc, cur, w2 >> 2, w2 & 3, l2 & 15, l2 >> 4); }
        if (!has_next) break;
#pragma unroll
        for (int a = 0; a < 2; ++a)
#pragma unroll
            for (int b = 0; b < 2; ++b)
#pragma unroll
                for (int m = 0; m < 4; ++m)
#pragma unroll
                    for (int n = 0; n < 2; ++n) acc[a][b][m][n] = (f32x4){0.f, 0.f, 0.f, 0.f};
        cur = nxt; cA = nA; cB = nB; ++ui;
        if (wr == 1) PG8_BAR;
    }
    PG8_WAIT_V(0);
    PG8_BAR;
#undef PG8_SA
#undef PG8_SB
#undef PG8_STAGE
#undef PG8_LDA
#undef PG8_LDB
#undef PG8_MMA
#undef PG8_WAIT_V
#undef PG8_WAIT_L
#undef PG8_BAR
#undef PG8_SCHED
#undef PG8_UA
#undef PG8_UB
}
}

namespace att {
constexpr float SCALE = 0.08838834764831845f;
constexpr float THR = 8.f;
constexpr int NW = 8, QBLK = 32, KVBLK = 64, QB = NW * QBLK, D = 128;
constexpr int SHM_V = KVBLK * D * 2, SHM_K = KVBLK * D * 2;
constexpr int ATT_LDS = 2 * SHM_V + 2 * SHM_K + NW * 64 * 4;
#define KSWZ(row, colB) ((row) * 256 + ((colB) ^ (((row) & 7) << 4)))
#define SBAR() __builtin_amdgcn_sched_barrier(0)
__device__ __forceinline__ int v_st(int k, int c) { const int kk = (k & ~0xC) | ((k & 4) << 1) | ((k & 8) >> 1); return ((kk >> 3) * 4 + (c >> 5)) * 512 + ((kk & 7) * 32 + (c & 31)) * 2; }
__device__ __forceinline__ int v_rd_base(int lane) { return ((lane & 3) << 3) | (((lane >> 2) & 3) << 6) | (((lane >> 4) & 1) << 5) | (((lane >> 5) & 1) << 8); }
constexpr int v_rd_off(int d0, int ks, int half) { return d0 * 512 + ks * 4096 + half * 2048; }
__device__ __forceinline__ int crow(int r, int hi) { return (r & 3) + 8 * (r >> 2) + 4 * hi; }
__device__ __forceinline__ bf16x8 load8(const bf16_t* p) { return *reinterpret_cast<const bf16x8*>(p); }
__device__ __forceinline__ void mask_tile(f32x16& p0, f32x16& p1, int dq) {
    const float NEG = -__builtin_inff();
#pragma unroll
    for (int r = 0; r < 16; ++r) {
        const int c = (r & 3) + 8 * (r >> 2);
        if (dq - c < 0) p0[r] = NEG;
        if (dq - c - 32 < 0) p1[r] = NEG;
    }
}
__device__ __forceinline__ void mask_all(f32x16& p0, f32x16& p1, bool off) {
    const float NEG = -__builtin_inff();
#pragma unroll
    for (int r = 0; r < 16; ++r) { p0[r] = off ? NEG : p0[r]; p1[r] = off ? NEG : p1[r]; }
}
__device__ __forceinline__ void partialSM(f32x16& p0, f32x16& p1, float& m_reg, float& mn, float& alpha, float rbias = 0.f) {
    float pmax = p0[0];
#pragma unroll
    for (int r = 1; r < 16; ++r) pmax = fmaxf(pmax, p0[r]);
#pragma unroll
    for (int r = 0; r < 16; ++r) pmax = fmaxf(pmax, p1[r]);
    { auto rr = __builtin_amdgcn_permlane32_swap(__float_as_uint(pmax), __float_as_uint(pmax), false, false);
      pmax = fmaxf(__uint_as_float(rr[0]), __uint_as_float(rr[1])); }
    constexpr float C2 = 1.4426950408889634f * SCALE;
    if (__builtin_expect(__all((pmax - m_reg) * SCALE <= THR), 1)) { mn = m_reg; alpha = 1.f; }
    else { mn = fmaxf(m_reg, pmax); alpha = __builtin_amdgcn_exp2f((m_reg - mn) * C2); m_reg = mn; }
    const float mnL = -mn * C2 + rbias;
#pragma unroll
    for (int r = 0; r < 16; ++r) p0[r] = fmaf(p0[r], C2, mnL);
#pragma unroll
    for (int r = 0; r < 16; ++r) p1[r] = fmaf(p1[r], C2, mnL);
#pragma unroll
    for (int r = 0; r < 16; ++r) p0[r] = __builtin_amdgcn_exp2f(p0[r]);
}
__device__ __forceinline__ void finishSM(f32x16& p0, f32x16& p1, float alpha, float& l_reg, bf16x8& pa0, bf16x8& pa1, bf16x8& pa2, bf16x8& pa3) {
#pragma unroll
    for (int r = 0; r < 16; ++r) p1[r] = __builtin_amdgcn_exp2f(p1[r]);
    float ps = 0;
#pragma unroll
    for (int r = 0; r < 16; ++r) ps += p0[r];
#pragma unroll
    for (int r = 0; r < 16; ++r) ps += p1[r];
    { auto rr = __builtin_amdgcn_permlane32_swap(__float_as_uint(ps), __float_as_uint(ps), false, false);
      ps = __uint_as_float(rr[0]) + __uint_as_float(rr[1]); }
    l_reg = l_reg * alpha + ps;
#define PK4(P, B_, OUT) do { unsigned a0 = cvt_pk_bf16(P[B_+0], P[B_+1]), a1 = cvt_pk_bf16(P[B_+2], P[B_+3]);                          \
        unsigned b0 = cvt_pk_bf16(P[B_+4], P[B_+5]), b1 = cvt_pk_bf16(P[B_+6], P[B_+7]);                                             \
        auto r0 = __builtin_amdgcn_permlane32_swap(a0, b0, false, false); auto r1 = __builtin_amdgcn_permlane32_swap(a1, b1, false, false); \
        u32x4 w = {r0[0], r1[0], r0[1], r1[1]}; OUT = *reinterpret_cast<bf16x8*>(&w); } while (0)
    PK4(p0, 0, pa0); PK4(p0, 8, pa1); PK4(p1, 0, pa2); PK4(p1, 8, pa3);
#undef PK4
}
template <int KB>
__device__ __forceinline__ void qkt(f32x16& p0, f32x16& p1, const char* K_lds, int r32, int hi, const bf16x8* qr) {
    p0 = f32x16{}; p1 = f32x16{};
    const char* kb[4];
#pragma unroll
    for (int dd = 0; dd < 4; ++dd) kb[dd] = K_lds + KB * SHM_K + KSWZ(r32, (dd * 16 + hi * 8) * 2);
#pragma unroll
    for (int d0 = 0; d0 < 8; ++d0) { const char* a = kb[d0 & 3] + (d0 >> 2) * 128;
        bf16x8 b0 = *reinterpret_cast<const bf16x8*>(a);
        bf16x8 b1 = *reinterpret_cast<const bf16x8*>(a + 32 * 256);
        p0 = __builtin_amdgcn_mfma_f32_32x32x16_bf16(b0, qr[d0], p0, 0, 0, 0);
        p1 = __builtin_amdgcn_mfma_f32_32x32x16_bf16(b1, qr[d0], p1, 0, 0, 0); }
}
template <int VB>
__device__ __forceinline__ void pv_tile(f32x16* o, int vb0, bf16x8 pa0, bf16x8 pa1, bf16x8 pa2, bf16x8 pa3) {
#define TRRD(dst, off) asm volatile("ds_read_b64_tr_b16 %0, %1 offset:%2" : "=&v"(dst) : "v"(vb0), "i"(off) : "memory")
#define PV_D0(d0) do { s16x4 l0, l1, l2, l3, h0, h1, h2, h3; constexpr int b_ = VB * SHM_V + v_rd_off(d0, 0, 0); \
        TRRD(l0, b_); TRRD(h0, b_ + 2048); TRRD(l1, b_ + 4096); TRRD(h1, b_ + 6144); TRRD(l2, b_ + 8192); TRRD(h2, b_ + 10240); TRRD(l3, b_ + 12288); TRRD(h3, b_ + 14336); \
        asm volatile("s_waitcnt lgkmcnt(0)" ::: "memory"); SBAR();   \
        o[d0] = __builtin_amdgcn_mfma_f32_32x32x16_bf16(pa0, (bf16x8){l0[0], l0[1], l0[2], l0[3], h0[0], h0[1], h0[2], h0[3]}, o[d0], 0, 0, 0);   \
        o[d0] = __builtin_amdgcn_mfma_f32_32x32x16_bf16(pa1, (bf16x8){l1[0], l1[1], l1[2], l1[3], h1[0], h1[1], h1[2], h1[3]}, o[d0], 0, 0, 0);   \
        o[d0] = __builtin_amdgcn_mfma_f32_32x32x16_bf16(pa2, (bf16x8){l2[0], l2[1], l2[2], l2[3], h2[0], h2[1], h2[2], h2[3]}, o[d0], 0, 0, 0);   \
        o[d0] = __builtin_amdgcn_mfma_f32_32x32x16_bf16(pa3, (bf16x8){l3[0], l3[1], l3[2], l3[3], h3[0], h3[1], h3[2], h3[3]}, o[d0], 0, 0, 0); } while (0)
    PV_D0(0); PV_D0(1); PV_D0(2); PV_D0(3);
#undef PV_D0
#undef TRRD
}

struct BlockRef { const bf16_t* Q; const bf16_t* K; const bf16_t* V; bf16_t* O; const bf16_t* Gt; const float* KM; int P0; };
struct Seam { bf16x8 qr[8]; bf16x8 st_v0, st_v1, st_k0, st_k1; };
#define ROW(p, k0, rr) ((p) + (size_t)((k0) + (rr)) * D + sc)
#define VMW() asm volatile("s_waitcnt vmcnt(0)" ::: "memory")
#define VMWN(n) asm volatile("s_waitcnt vmcnt(%0)" :: "i"(n) : "memory")
#define SLOAD_H(Kp, Vp, k0) do { S.st_v0 = load8(ROW(Vp, k0, sr)); S.st_v1 = load8(ROW(Vp, k0, 32 + sr));              \
                         S.st_k0 = load8(ROW(Kp, k0, sr)); S.st_k1 = load8(ROW(Kp, k0, 32 + sr)); } while (0)
#define SWRITE_HK(bf) do { *(bf16x8*)(K_lds + (bf) * SHM_K + kws) = S.st_k0; *(bf16x8*)(K_lds + (bf) * SHM_K + kws + 32 * 256) = S.st_k1; } while (0)
#define SWRITE_HV(bf) do { *(bf16x8*)(V_lds + (bf) * SHM_V + vst0) = S.st_v0; *(bf16x8*)(V_lds + (bf) * SHM_V + vst1) = S.st_v1; } while (0)
#define SWRITE_H(bf) do { SWRITE_HV(bf); SWRITE_HK(bf); } while (0)
__device__ __forceinline__ void moba_prime(const BlockRef& cur, char* lds, Seam& S, int wv) {
    const int tid = opq_tid(wv), wid = __builtin_amdgcn_readfirstlane(tid >> 6), lane = tid & 63, r32 = lane & 31, hi = lane >> 5;
    const int sr = tid >> 4, sc = (tid & 15) * 8, kws = KSWZ(sr, sc * 2); char* K_lds = lds + 2 * SHM_V;
#pragma unroll
    for (int d0 = 0; d0 < 8; ++d0) S.qr[d0] = load8(cur.Q + (size_t)(wid * QBLK + r32) * D + d0 * 16 + hi * 8);
    SLOAD_H(cur.K, cur.V, 0); VMW(); SWRITE_HK(0);
    __syncthreads();
}
__device__ __forceinline__ unsigned moba_select(const Seam& S, const float* KM, int qb, int hi) {
    if (qb <= 3) return (1u << qb) - 1u;
    float sc_[8];
#pragma unroll
    for (int j = 0; j < 8; ++j) sc_[j] = 0.f;
#pragma unroll
    for (int j = 0; j < 7; ++j) {
        if (j < qb) {
            float s = 0.f;
#pragma unroll
            for (int d0 = 0; d0 < 8; ++d0) {
                const f32x4 k0 = *(const f32x4*)(KM + j * D + d0 * 16 + hi * 8), k1 = *(const f32x4*)(KM + j * D + d0 * 16 + hi * 8 + 4);
                const bf16x8 q = S.qr[d0];
                s += bf1((bf16_t)q[0]) * k0[0] + bf1((bf16_t)q[1]) * k0[1] + bf1((bf16_t)q[2]) * k0[2] + bf1((bf16_t)q[3]) * k0[3]
                   + bf1((bf16_t)q[4]) * k1[0] + bf1((bf16_t)q[5]) * k1[1] + bf1((bf16_t)q[6]) * k1[2] + bf1((bf16_t)q[7]) * k1[3];
            }
            s += __shfl_xor(s, 32);
            sc_[j] = s;
        }
    }
    unsigned sel = 0u;
#pragma unroll
    for (int it = 0; it < 3; ++it) {
        float best = -__builtin_inff(); int bi = 0;
#pragma unroll
        for (int j = 0; j < 7; ++j) { const bool ok = (j < qb) && !((sel >> j) & 1u) && (sc_[j] > best); best = ok ? sc_[j] : best; bi = ok ? j : bi; }
        sel |= 1u << bi;
    }
    return sel;
}
__device__ __forceinline__ void moba_block(const BlockRef& cur, const BlockRef& nxt, char* lds, Seam& S, int wv) {
    const int tid = opq_tid(wv), wid = __builtin_amdgcn_readfirstlane(tid >> 6), lane = tid & 63, r32 = lane & 31, hi = lane >> 5;
    const int NT = cur.P0 / KVBLK + 4;
    const int qb = cur.P0 >> 8;
    const int qlo = cur.P0 + wid * QBLK, qm = qlo + r32 - 4 * hi;
    char* V_lds = lds; char* K_lds = lds + 2 * SHM_V;
    float* ws = (float*)(lds + 2 * SHM_V + 2 * SHM_K) + wid * 64; float* li_l = ws, * al_l = ws + 32;
    float m_reg = -1e30f, l_reg = 0; f32x16 o[4] = {};
    const int sr = tid >> 4, sc = (tid & 15) * 8, vst0 = v_st(sr, sc), vst1 = v_st(32 + sr, sc), kws = KSWZ(sr, sc * 2);
    const int vb0 = (int)(uintptr_t)V_lds + v_rd_base(lane);
    const bf16_t* Kh = cur.K; const bf16_t* Vh = cur.V;
    const unsigned sel = moba_select(S, cur.KM, qb, hi);
    const bool need_sel = qb > 3;
#define RESC(a) do { if (__any((a) < 1.f)) { if (hi == 0) al_l[r32] = (a); asm volatile("s_waitcnt lgkmcnt(0)" ::: "memory");              \
                     for (int d_ = 0; d_ < 4; ++d_) for (int r = 0; r < 16; ++r) o[d_][r] *= al_l[crow(r, hi)]; } } while (0)
#define KBASE(t) ((t) * KVBLK)
#define MASKT(P0_, P1_, t) do { const int kb_ = KBASE(t); rb_ = 0.f; \
        if (kb_ < cur.P0) { if (need_sel) rb_ = (((sel >> (kb_ >> 8)) & 1u) == 0u) ? -__builtin_inff() : 0.f; } \
        else if (kb_ + KVBLK - 1 > qlo) mask_tile(P0_, P1_, qm - kb_); } while (0)
#define SEAM_K0() do { VMWN(8); SWRITE_HK(0); SBAR(); } while (0)
    f32x16 pA0, pA1, pB0, pB1; float mnA, mnB, alA, alB, rb_ = 0.f; bf16x8 pa0, pa1, pa2, pa3;
    SWRITE_HV(0); SBAR();
    SLOAD_H(Kh, Vh, KBASE(1));
    SBAR(); qkt<0>(pA0, pA1, K_lds, r32, hi, S.qr);
    MASKT(pA0, pA1, 0); partialSM(pA0, pA1, m_reg, mnA, alA, rb_);
    VMW(); SWRITE_H(1);
    __syncthreads();
#define HALF_STEP(PX0, PX1, mnX, alX, PY0, PY1, alY, t, KB, VB, SB) do {                                                      \
        SBAR(); qkt<KB>(PX0, PX1, K_lds, r32, hi, S.qr);                                                                       \
        finishSM(PY0, PY1, alY, l_reg, pa0, pa1, pa2, pa3); SBAR();                                                           \
        if ((t) + 1 < NT) { SLOAD_H(Kh, Vh, KBASE((t) + 1)); SBAR(); }                                                        \
        pv_tile<VB>(o, vb0, pa0, pa1, pa2, pa3); MASKT(PX0, PX1, (t)); partialSM(PX0, PX1, m_reg, mnX, alX, rb_);                  \
        __syncthreads();                                                                                                      \
        if ((t) + 1 < NT) { VMW(); SWRITE_H(SB); }                                                                            \
        RESC(alX); __syncthreads(); } while (0)
    for (int t = 1; t + 1 < NT; t += 2) {
        HALF_STEP(pB0, pB1, mnB, alB, pA0, pA1, alA, t, 1, 0, 0);
        HALF_STEP(pA0, pA1, mnA, alA, pB0, pB1, alB, t + 1, 0, 1, 1);
    }
    SBAR(); qkt<1>(pB0, pB1, K_lds, r32, hi, S.qr); SBAR();
    SLOAD_H(nxt.K, nxt.V, 0); SBAR();
#pragma unroll
    for (int d0 = 0; d0 < 8; ++d0) S.qr[d0] = load8(nxt.Q + (size_t)(wid * QBLK + r32) * D + d0 * 16 + hi * 8);
    SBAR();
    finishSM(pA0, pA1, alA, l_reg, pa0, pa1, pa2, pa3); SBAR();
    pv_tile<0>(o, vb0, pa0, pa1, pa2, pa3);
    MASKT(pB0, pB1, NT - 1); partialSM(pB0, pB1, m_reg, mnB, alB, rb_); __syncthreads(); RESC(alB);
    finishSM(pB0, pB1, alB, l_reg, pa0, pa1, pa2, pa3); SBAR(); pv_tile<1>(o, vb0, pa0, pa1, pa2, pa3);
    SBAR(); SEAM_K0();
    if (hi == 0) li_l[r32] = l_reg; asm volatile("s_waitcnt lgkmcnt(0)" ::: "memory");
    bf16_t* Ow = cur.O + (size_t)(wid * QBLK) * DM; const bf16_t* Gw = cur.Gt + (size_t)(wid * QBLK) * DM + r32;
    bf16_t gl[16][4];
#pragma unroll
    for (int r = 0; r < 16; ++r)
#pragma unroll
        for (int d0 = 0; d0 < 4; ++d0) gl[r][d0] = Gw[(size_t)crow(r, hi) * DM + d0 * 32];
#pragma unroll
    for (int r = 0; r < 16; ++r) { const int orow = crow(r, hi); const float rl = __builtin_amdgcn_rcpf(li_l[orow]);
#pragma unroll
        for (int d0 = 0; d0 < 4; ++d0) { const float gv = bf1(gl[r][d0]);
            const float v = o[d0][r] * rl * gv;
            const float vn = __shfl_xor(v, 1);
            if ((r32 & 1) == 0) *(unsigned*)(Ow + (size_t)orow * DM + d0 * 32 + r32) = cvt_pk_bf16(v, vn); } }
    __syncthreads();
#undef RESC
#undef KBASE
#undef MASKT
#undef SEAM_K0
#undef HALF_STEP
}
#undef ROW
#undef VMW
#undef VMWN
#undef SLOAD_H
#undef SWRITE_HK
#undef SWRITE_HV
#undef SWRITE_H

__device__ __forceinline__ BlockRef mk_ref(int L, int pass, const bf16_t* Q, const bf16_t* K, const bf16_t* V, bf16_t* O, const bf16_t* Gt, const float* KM) {
    const int bh = L >> 2, x = L & 3, qb = pass ? 7 - x : x, b = bh >> 3, h = bh & 7;
    BlockRef r;
    r.Q = Q + ((size_t)bh * SEQ + (size_t)qb * QB) * D; r.K = K + (size_t)bh * SEQ * D; r.V = V + (size_t)bh * SEQ * D;
    r.O = O + ((size_t)b * SEQ + (size_t)qb * QB) * DM + h * DH; r.Gt = Gt + ((size_t)b * SEQ + (size_t)qb * QB) * DM + h * DH;
    r.KM = KM + (size_t)bh * 8 * D; r.P0 = qb * QB;
    return r;
}
__device__ __forceinline__ void attn_phase(char* lds, const bf16_t* Q, const bf16_t* K, const bf16_t* V, bf16_t* O, const bf16_t* Gt, const float* KM, int wv) {
    const int total = NB * NH * 4, stride = gridDim.x;
    int L = opq_bid(); if (L >= total) return;
    if (stride == 256) { const int xcd = L & 7, j = L >> 3; L = ((xcd * 8 + (j >> 2)) << 2) | (j & 3); }
    int pass = 0;
    BlockRef cur = mk_ref(L, 0, Q, K, V, O, Gt, KM);
    Seam S;
    moba_prime(cur, lds, S, wv);
    for (;;) {
        const bool more_pass = pass == 0, more_item = L + stride < total, last = !more_pass && !more_item;
        int passn = pass + 1, Ln = L;
        if (!more_pass) { passn = 0; Ln = more_item ? L + stride : L; }
        const BlockRef nxt = last ? cur : mk_ref(Ln, passn, Q, K, V, O, Gt, KM);
        moba_block(cur, nxt, lds, S, wv);
        if (last) break;
        cur = nxt; pass = passn; L = Ln;
    }
}
}

#ifndef REP_MASK
#define REP_MASK 0
#endif
#ifndef BAR_REP
#define BAR_REP 1
#endif
struct Args { const float* in[21]; float* out; unsigned char* ws; int ph_lo, ph_hi; };
typedef const __attribute__((address_space(4))) Args* ArgsP;
#define AIN(i) ((const float*)ap->in[i])

__device__ __forceinline__ void transpose_item(const float* W, int ldw, bf16_t* WT, int ldt, LAS float* scr, int lane) {
    float tv[32];
#pragma unroll
    for (int i = 0; i < 32; ++i) { const int kk = 2 * i + (lane >> 5); tv[i] = W[(size_t)kk * ldw + (lane & 31)]; }
#pragma unroll
    for (int i = 0; i < 32; ++i) { const int kk = 2 * i + (lane >> 5); scr[kk * 33 + (lane & 31)] = tv[i]; }
    asm volatile("s_waitcnt lgkmcnt(0)" ::: "memory");
    const int c = lane & 7;
#pragma unroll
    for (int j = 0; j < 4; ++j) { const int n = (lane >> 3) + 8 * j; const LAS float* s = scr + (8 * c) * 33 + n;
        u32x4 o; o.x = cvt_pk_bf16(s[0 * 33], s[1 * 33]); o.y = cvt_pk_bf16(s[2 * 33], s[3 * 33]); o.z = cvt_pk_bf16(s[4 * 33], s[5 * 33]); o.w = cvt_pk_bf16(s[6 * 33], s[7 * 33]);
        *(u32x4*)(WT + (size_t)n * ldt + 8 * c) = o; }
    asm volatile("s_waitcnt lgkmcnt(0)" ::: "memory");
}
__device__ __forceinline__ void transpose_mat(const float* W, int K, int N, bf16_t* WT, int item, LAS float* scr, int lane) {
    const int nblk = N / 32, kb = item / nblk, nb = item % nblk;
    transpose_item(W + (size_t)(64 * kb) * N + 32 * nb, N, WT + (size_t)(32 * nb) * K + 64 * kb, K, scr, lane);
}

template <bool SILU>
__device__ __forceinline__ void gemv_item(const float* vec, int vld, const float* W, int ldw, int n0, int k0, float* out, int old, const float* bias, LAS float* scr, int lane) {
    const float* wp = W + (size_t)k0 * ldw + n0 + lane;
#pragma unroll
    for (int i = 0; i < 8; ++i) { const int idx = i * 64 + lane, b = idx >> 6, kk = idx & 63; const float v = vec[(size_t)b * vld + k0 + kk]; scr[kk * 8 + b] = SILU ? fsilu(v) : v; }
    asm volatile("s_waitcnt lgkmcnt(0)" ::: "memory");
    float acc[8];
#pragma unroll
    for (int b = 0; b < 8; ++b) acc[b] = 0.f;
#pragma unroll 1
    for (int kh = 0; kh < 64; kh += 32) {
        float w[32];
#pragma unroll
        for (int kk = 0; kk < 32; ++kk) w[kk] = wp[(size_t)(kh + kk) * ldw];
#pragma unroll
        for (int kk = 0; kk < 32; ++kk) {
            const f32x4 c0 = *(const LAS f32x4*)(scr + (kh + kk) * 8), c1 = *(const LAS f32x4*)(scr + (kh + kk) * 8 + 4);
            acc[0] += w[kk] * c0[0]; acc[1] += w[kk] * c0[1]; acc[2] += w[kk] * c0[2]; acc[3] += w[kk] * c0[3];
            acc[4] += w[kk] * c1[0]; acc[5] += w[kk] * c1[1]; acc[6] += w[kk] * c1[2]; acc[7] += w[kk] * c1[3];
            if ((kk & 3) == 3) __builtin_amdgcn_sched_barrier(0); }
    }
    const float bv = bias ? bias[n0 + lane] : 0.f;
#pragma unroll
    for (int b = 0; b < 8; ++b) atomicAdd(out + (size_t)b * old + n0 + lane, acc[b] + bv);
    asm volatile("s_waitcnt lgkmcnt(0)" ::: "memory");
}
__device__ __forceinline__ void prep0_phase(ArgsP ap, LAS unsigned char* lds, int wave, int lane) {
    unsigned char* ws = (unsigned char*)ap->ws;
    LAS float* scr = (LAS float*)(lds + wave * 16384);
    const int gw = opq_bid() * NWAVES + wave, NGW = gridDim.x * NWAVES;
    for (int r = gw; r < (MODV_LD / 64) * 16; r += NGW) {
        const int cgp = r >> 4, kc = r & 15;
        const float* W; int ldw, n0; const float* bias;
        if (cgp < 192) { const int l = cgp / 48; n0 = (cgp % 48) * 64; W = AIN(2) + (size_t)l * DM * 3 * DM; ldw = 3 * DM; bias = AIN(3) + l * 3 * DM; }
        else { n0 = (cgp - 192) * 64; W = AIN(15); ldw = 2 * DM; bias = AIN(16); }
        gemv_item<true>(AIN(1), DM, W, ldw, n0, kc * 64, (float*)(ws + WS_MODV) + (cgp * 64 - n0), MODV_LD, kc == 0 ? bias : nullptr, scr, lane);
    }
}
__device__ __forceinline__ void prep1_phase(ArgsP ap, LAS unsigned char* lds, int wave, int lane) {
    unsigned char* ws = (unsigned char*)ap->ws;
    LAS float* scr = (LAS float*)(lds + wave * 16384);
    const int gw = opq_bid() * NWAVES + wave, NGW = gridDim.x * NWAVES;
    constexpr int I_BIG = (DM / 64) * (2 * DM / 32);
    constexpr int I_SQ = (DM / 64) * (DM / 32);
    constexpr int I_G = (256 / 64) * (256 / 32);
    constexpr int N_T = 2 * I_BIG + 2 * I_SQ + 2 * I_BIG + I_BIG + 2 * I_SQ + 16 * I_G;
    constexpr int N_GEMV = 4 * 32 * 16;
    for (int it = gw; it < N_T + N_GEMV; it += NGW) {
        int r = it;
        if (r < N_GEMV) {
            const int slot = r >> 9, q = r & 511, cgp = q >> 4, kc = q & 15;
            const size_t woff = slot == 0 ? (size_t)DM * 2 * DM : slot == 3 ? (size_t)DM * 2 * DM : 0;
            const float* W = (slot == 0 ? AIN(5) : slot == 2 ? AIN(17) : AIN(18)) + woff;
            const int shcol = slot == 0 ? 1 * 3 * DM : slot == 1 ? 2 * 3 * DM : slot == 2 ? 4 * 3 * DM : 3 * 3 * DM;
            gemv_item<false>((const float*)(ws + WS_MODV) + shcol, MODV_LD, W, 2 * DM, cgp * 64, kc * 64, (float*)(ws + WS_SHW) + (size_t)slot * 8 * 2 * DM, 2 * DM, nullptr, scr, lane);
            continue;
        } r -= N_GEMV;
        const float* W; bf16_t* WT; int ldw, ldt;
        if (r < 6 * I_BIG + 0 * I_SQ && r < 2 * I_BIG) { const int l = r / I_BIG, item = r % I_BIG, kb = item / 64, nb = item % 64;
            W = AIN(5) + (size_t)l * DM * 2 * DM + (size_t)(64 * kb) * 2 * DM + 32 * nb; ldw = 2 * DM; WT = (bf16_t*)(ws + WS_WIN) + (size_t)l * 2 * DM * DM + (size_t)(32 * nb) * DM + 64 * kb; ldt = DM; }
        else if ((r -= 2 * I_BIG) < 2 * I_SQ) { const int l = r / I_SQ, item = r % I_SQ, kb = item / 32, nb = item % 32;
            W = AIN(13) + (size_t)l * DM * DM + (size_t)(64 * kb) * DM + 32 * nb; ldw = DM; WT = (bf16_t*)(ws + WS_WOUT) + (size_t)l * DM * DM + (size_t)(32 * nb) * DM + 64 * kb; ldt = DM; }
        else if ((r -= 2 * I_SQ) < 2 * I_BIG) { const int l = r / I_BIG, item = r % I_BIG, kb = item / 64, nb = item % 64;
            W = AIN(18) + (size_t)l * DM * 2 * DM + (size_t)(64 * kb) * 2 * DM + 32 * nb; ldw = 2 * DM; WT = (bf16_t*)(ws + (l ? WS_ATTIN1 : WS_ATTIN0)) + (size_t)(32 * nb) * DM + 64 * kb; ldt = DM; }
        else if ((r -= 2 * I_BIG) < I_BIG) { const int kb = r / 64, nb = r % 64;
            W = AIN(17) + (size_t)(64 * kb) * 2 * DM + 32 * nb; ldw = 2 * DM; WT = (bf16_t*)(ws + WS_WKV) + (size_t)(32 * nb) * DM + 64 * kb; ldt = DM; }
        else if ((r -= I_BIG) < 2 * I_SQ) { const int l = r / I_SQ, item = r % I_SQ, kb = item / 32, nb = item % 32;
            W = AIN(19) + (size_t)l * DM * DM + (size_t)(64 * kb) * DM + 32 * nb; ldw = DM; WT = (bf16_t*)(ws + WS_ATTOUT) + (size_t)l * DM * DM + (size_t)(32 * nb) * DM + 64 * kb; ldt = DM; }
        else { r -= 2 * I_SQ;
            const int mat = r / I_G, item = r % I_G, which = mat >> 3, lh = mat & 7;
            const int kb = item / 8, nb = item % 8, n0 = 32 * nb, drow = 256 * (n0 >> 7) + 128 * which + (n0 & 127);
            W = (which ? AIN(10) : AIN(8)) + (size_t)lh * 256 * 256 + (size_t)(64 * kb) * 256 + n0; ldw = 256;
            WT = (bf16_t*)(ws + WS_WG) + (size_t)lh * 512 * 256 + (size_t)drow * 256 + 64 * kb; ldt = 256; }
        transpose_item(W, ldw, WT, ldt, scr, lane);
    }
}

__device__ __forceinline__ void norm_phase(const float* xin, bf16_t* o1, const float* g1, const float* modv, int sh1, int sc1c,
                                            bf16_t* o2, const float* g2, int sh2, int sc2c, int wave, int lane) {
    const int gw = opq_bid() * NWAVES + wave, NGW = gridDim.x * NWAVES;
    for (int rb = gw; rb < MTOK / 8; rb += NGW) {
        const int r0 = rb * 8, b = r0 / SEQ;
        const float* mv = modv + (size_t)b * MODV_LD;
        f32x4 gs1[4], sf1[4], gs2[4], sf2[4];
#pragma unroll
        for (int j = 0; j < 4; ++j) { const int idx = 4 * lane + 256 * j;
            const f32x4 gv = *(const f32x4*)(g1 + idx), sc = *(const f32x4*)(mv + sc1c + idx); gs1[j] = gv * (sc + 1.f); sf1[j] = *(const f32x4*)(mv + sh1 + idx);
            if (o2) { const f32x4 gv2 = *(const f32x4*)(g2 + idx), sc2 = *(const f32x4*)(mv + sc2c + idx); gs2[j] = gv2 * (sc2 + 1.f); sf2[j] = *(const f32x4*)(mv + sh2 + idx); }
            else { gs2[j] = gs1[j]; sf2[j] = sf1[j]; } }
        for (int rr = 0; rr < 8; ++rr) {
            const size_t row = (size_t)(r0 + rr);
            const f32x4* xr = (const f32x4*)(xin + row * DM) + lane;
            f32x4 v[4]; float s = 0.f;
#pragma unroll
            for (int j = 0; j < 4; ++j) { v[j] = xr[64 * j]; s += (v[j].x * v[j].x + v[j].y * v[j].y) + (v[j].z * v[j].z + v[j].w * v[j].w); }
            const float rstd = 1.f / sqrtf(wave_sum(s) * (1.f / DM) + EPS);
#pragma unroll
            for (int j = 0; j < 4; ++j) { const f32x4 t = v[j] * rstd; const f32x4 y = t * gs1[j] + sf1[j];
                u32x2 w; w.x = cvt_pk_bf16(y.x, y.y); w.y = cvt_pk_bf16(y.z, y.w);
                *((u32x2*)(o1 + row * DM) + lane + 64 * j) = w;
                if (o2) { const f32x4 y2 = t * gs2[j] + sf2[j]; u32x2 w2; w2.x = cvt_pk_bf16(y2.x, y2.y); w2.y = cvt_pk_bf16(y2.z, y2.w);
                    *((u32x2*)(o2 + row * DM) + lane + 64 * j) = w2; } }
        }
    }
}
__device__ __forceinline__ void conv_phase(const bf16_t* UP, bf16_t* U, const float* cw, const float* cb, int tid) {
    const int ch = 8 * (tid & 127), sub = tid >> 7;
    float w0[8], w1[8], w2[8], w3[8], bb[8];
#pragma unroll
    for (int h = 0; h < 2; ++h) { const f32x4 a = *(const f32x4*)(cw + ch + 4 * h), b = *(const f32x4*)(cw + DM + ch + 4 * h), c = *(const f32x4*)(cw + 2 * DM + ch + 4 * h), d = *(const f32x4*)(cw + 3 * DM + ch + 4 * h), e = *(const f32x4*)(cb + ch + 4 * h);
#pragma unroll
        for (int j = 0; j < 4; ++j) { w0[4 * h + j] = a[j]; w1[4 * h + j] = b[j]; w2[4 * h + j] = c[j]; w3[4 * h + j] = d[j]; bb[4 * h + j] = e[j]; } }
    for (int it = opq_bid(); it < NB * 32; it += gridDim.x) {
        const int b = it >> 5, c = it & 31, t0 = c * 64 + sub * 16; const size_t base = ((size_t)b * SEQ + t0) * DM + ch;
        u32x4 rw[19];
#pragma unroll
        for (int t = 0; t < 19; ++t) rw[t] = (t0 + t - 3 >= 0) ? *(const u32x4*)(UP + base + (ptrdiff_t)(t - 3) * DM) : (u32x4){0u, 0u, 0u, 0u};
#pragma unroll
        for (int t = 0; t < 16; ++t) {
            unsigned ow[4];
#pragma unroll
            for (int q = 0; q < 4; ++q) { const unsigned a0 = rw[t][q], a1 = rw[t + 1][q], a2 = rw[t + 2][q], a3 = rw[t + 3][q];
                const float lo = bb[2 * q] + w0[2 * q] * bf_lo(a0) + w1[2 * q] * bf_lo(a1) + w2[2 * q] * bf_lo(a2) + w3[2 * q] * bf_lo(a3);
                const float hi = bb[2 * q + 1] + w0[2 * q + 1] * bf_hi(a0) + w1[2 * q + 1] * bf_hi(a1) + w2[2 * q + 1] * bf_hi(a2) + w3[2 * q + 1] * bf_hi(a3);
                ow[q] = cvt_pk_bf16(lo, hi); }
            *(u32x4*)(U + base + (size_t)t * DM) = (u32x4){ow[0], ow[1], ow[2], ow[3]}; }
    }
}

#define XB_TMO      128
#define XB_XCNT(j)  (256  + 64 * (j))
#define XB_XSUB(j)  (1280 + 64 * (j))
#define XB_XGEN(j)  (2304 + 64 * (j))
#define XB_TOP      3328
#define XB_TOPGEN   3392
#define XCD_BAR_WORDS 3456
#define XB_SPIN_CAP (1u << 18)
constexpr size_t WS_BAR = 16384;
constexpr int LDS_MISC = 131072 + 320;
__device__ __forceinline__ unsigned xb_ld(unsigned* p)              { return __hip_atomic_load(p, __ATOMIC_RELAXED, __HIP_MEMORY_SCOPE_AGENT); }
__device__ __forceinline__ unsigned xb_add(unsigned* p, unsigned v) { return __hip_atomic_fetch_add(p, v, __ATOMIC_RELAXED, __HIP_MEMORY_SCOPE_AGENT); }
__device__ __forceinline__ unsigned xb_xcc_id() { return (unsigned)__builtin_amdgcn_s_getreg((3 << 11) | 20) & 0xFu; }
#define XB_SPIN(cond, bar) do { unsigned _sp = 0; while (cond) { __builtin_amdgcn_s_sleep(1); \
    if ((++_sp & 255u) == 0u) { if (xb_ld(&(bar)[XB_TMO])) break; if (_sp > XB_SPIN_CAP) { atomicAdd(&(bar)[XB_TMO], 1u); break; } } } } while (0)
__device__ __forceinline__ void xcd_barrier_complete(unsigned* bar, unsigned x, unsigned& nloc, unsigned& nx) {
    const unsigned G = gridDim.x * gridDim.y * gridDim.z;
    unsigned sum, cnt, mine, sp = 0u;
    for (;;) {
        sum = 0u; cnt = 0u; mine = 0u;
#pragma unroll
        for (unsigned j = 0; j < 16; ++j) { const unsigned c = xb_ld(&bar[XB_XCNT(j)]); sum += c; cnt += (c > 0u) ? 1u : 0u; mine = (j == x) ? c : mine; }
        if (sum == G) break;
        __builtin_amdgcn_s_sleep(1);
        if ((++sp & 255u) == 0u) { if (xb_ld(&bar[XB_TMO])) break; if (sp > XB_SPIN_CAP) { atomicAdd(&bar[XB_TMO], 1u); break; } }
    }
    nloc = mine > 0u ? mine : 1u; nx = cnt > 0u ? cnt : 1u;
}
__device__ __forceinline__ void xcd_barrier(unsigned* bar, volatile LAS unsigned* st, int tid) {
    asm volatile("s_waitcnt vmcnt(0)" ::: "memory");
    __syncthreads();
    if (tid == 0) {
        const unsigned x = xb_xcc_id();
        __builtin_amdgcn_s_waitcnt(0);
        unsigned nloc = st[0], nx = st[1];
        if (nloc == 0u) { xcd_barrier_complete(bar, x, nloc, nx); st[0] = nloc; st[1] = nx; }
        const unsigned old = xb_add(&bar[XB_XSUB(x)], 1u);
        const unsigned gen = old / nloc;
        if (old + 1u == (gen + 1u) * nloc) {
            __builtin_amdgcn_fence(__ATOMIC_RELEASE, "agent");
            asm volatile("s_waitcnt vmcnt(0)" ::: "memory");
            const unsigned og = xb_add(&bar[XB_TOP], 1u);
            const unsigned tg = og / nx;
            if (og + 1u == (tg + 1u) * nx) xb_add(&bar[XB_TOPGEN], 1u);
            else XB_SPIN(xb_ld(&bar[XB_TOPGEN]) == tg, bar);
            __builtin_amdgcn_fence(__ATOMIC_ACQUIRE, "agent");
            xb_add(&bar[XB_XGEN(x)], 1u);
            asm volatile("s_waitcnt vmcnt(0)" ::: "memory");
        } else {
            XB_SPIN(xb_ld(&bar[XB_XGEN(x)]) == gen, bar);
            __builtin_amdgcn_fence(__ATOMIC_ACQUIRE, "agent");
            asm volatile("s_waitcnt vmcnt(0)" ::: "memory");
        }
    }
    __syncthreads();
}

constexpr int NPHASE = 14;
#ifndef PH_EN
#define PH_EN 0xFFFF
#endif
#define EN(b) ((PH_EN >> (b)) & 1)
#ifndef REP_MASK
#define REP_MASK 0
#endif
#define REPS(b) for (int rep_ = 0; rep_ < EN(b) * (1 + ((REP_MASK >> (b)) & 1)); ++rep_)
template <int ph>
__device__ __forceinline__ void run_phase(unsigned char* lds, int wv) {
    LAS unsigned char* ldsl = (LAS unsigned char*)lds;
    {
        ArgsP ap = (ArgsP)__builtin_amdgcn_kernarg_segment_ptr();
        asm volatile("" : "+s"(ap));
        const int G = gridDim.x;
        unsigned char* ws = (unsigned char*)ap->ws;
        float* modv = (float*)(ws + WS_MODV);
        float* kmean = (float*)(ws + WS_KMEAN);
        bf16_t* HN = (bf16_t*)(ws + WS_HN); bf16_t* HKV = (bf16_t*)(ws + WS_HKV); bf16_t* UPRE = (bf16_t*)(ws + WS_UPRE); bf16_t* GB = (bf16_t*)(ws + WS_G);
        bf16_t* LAb = (bf16_t*)(ws + WS_LA); bf16_t* BINb = (bf16_t*)(ws + WS_BIN);
        float* xw = (float*)ap->out;
        const int tid = opq_tid(wv), c = opq_bid();
        const int lane = tid & 63, wave = __builtin_amdgcn_readfirstlane(tid >> 6);
        float* sumsq = (float*)(ws + WS_SUMSQ); const float* shw = (const float*)(ws + WS_SHW);
        if (ph == 0) {
            if (EN(0)) prep0_phase(ap, ldsl, wave, lane);
        } else if (ph == 1) {
            REPS(1) norm_phase(AIN(0), HN, AIN(4), modv, 0, DM, nullptr, nullptr, 0, 0, wave, lane);
            if (EN(0)) prep1_phase(ap, ldsl, wave, lane);
        } else if (ph <= 7) {
            const int l = (ph - 2) / 3, k3 = (ph - 2) % 3, k = k3 == 0 ? 0 : k3 + 1;
            const float* xin = (l == 0) ? AIN(0) : xw;
            if (k == 0) {
                pg8::Gemm g{l == 0 ? HN : HKV, (const bf16_t*)(ws + WS_WIN) + (size_t)l * 2 * DM * DM, DM, DM, DM, 0, 0};
                int one = 1; asm volatile("" : "+s"(one));
                { pg8::InOrder S{c, one, 0};
                  pg8::EpiSplitConv E{ws, l == 0 ? nullptr : sumsq, shw, AIN(6) + l * 4 * DM, AIN(7) + l * DM, 4u * (unsigned)(l + 1), ldsl};
                  REPS(2) pg8::gemm_phase(ldsl, g, S, E, wv); }
                { pg8::InOrder S{c, one, 1};
                  pg8::EpiSplit E{UPRE, GB, l == 0 ? nullptr : sumsq, shw};
                  REPS(2) pg8::gemm_phase(ldsl, g, S, E, wv); }
            } else if (k == 1) {
                REPS(3) conv_phase(UPRE, HKV, AIN(6) + l * 4 * DM, AIN(7) + l * DM, tid);
            } else if (k == 2) {
                pg8::Gemm g{UPRE, (const bf16_t*)(ws + WS_WG) + (size_t)l * 4 * 512 * 256, DM, 256, 256, 256 * 2, 512 * 256 * 2};
                int two = 2; asm volatile("" : "+s"(two));
                pg8::GatesOrder S{c, two};
                pg8::EpiGatesS E{ws, 4u * (unsigned)(l + 1), AIN(9) + l * DM, AIN(11) + l * DM, AIN(12) + l * DM, ldsl};
                REPS(4) pg8::gemm_phase(ldsl, g, S, E, wv);
            } else {
                pg8::Gemm g{HN, (const bf16_t*)(ws + WS_WOUT) + (size_t)l * DM * DM, DM, DM, DM, 0, 0};
                pg8::MultiOrder S; S.init(MTOK, DM, 1, G, c);
                _Float16* x16 = (_Float16*)(ws + WS_X16);
                if (l == 0) { pg8::EpiResH<float, false> E{AIN(0), x16, modv + 2 * DM, modv, HKV, AIN(4) + DM, 3 * DM + DM, nullptr, nullptr, 0, sumsq};
                    REPS(7) pg8::gemm_phase(ldsl, g, S, E, wv); }
                else { pg8::EpiResH<_Float16, true> E{x16, x16, modv + l * 3 * DM + 2 * DM, modv, HKV, AIN(4) + (l + 1) * DM, (l + 1) * 3 * DM + DM,
                              LAb, AIN(14), 4 * 3 * DM + DM, sumsq + (size_t)l * MTOK};
                    REPS(7) pg8::gemm_phase(ldsl, g, S, E, wv); }
            }
        } else if (ph <= 13) {
            const int i = (ph - 8) / 3, k = (ph - 8) % 3, l = 2 + i;
            if (k == 0) {
                pg8::Gemm g{i == 0 ? HKV : LAb, (const bf16_t*)(ws + (i == 0 ? WS_ATTIN0 : WS_ATTIN1)), DM, DM, DM, (long)(WS_LA - WS_HKV), (long)(WS_WKV - WS_ATTIN0)};
                pg8::MultiOrder S; S.init(MTOK, 2 * DM, i == 0 ? 2 : 1, G, c);
                pg8::EpiQKV E{ws, kmean, sumsq + (size_t)(1 + i) * MTOK, shw + (size_t)(i == 0 ? 1 : 3) * 8 * 2 * DM, 8 * 2 * DM};
                REPS(9) pg8::gemm_phase(ldsl, g, S, E, wv);
            } else if (k == 1) {
                REPS(10) att::attn_phase((char*)lds, UPRE, HN, BINb, HKV, GB, kmean, wv);
            } else if (i == 0) {
                pg8::Gemm g{HKV, (const bf16_t*)(ws + WS_ATTOUT), DM, DM, DM, 0, 0};
                pg8::MultiOrder S; S.init(MTOK, DM, 1, G, c);
                _Float16* x16 = (_Float16*)(ws + WS_X16);
                pg8::EpiResH<_Float16, false> E{x16, x16, modv + l * 3 * DM + 2 * DM, modv, LAb, AIN(4) + 3 * DM, 3 * 3 * DM + DM, nullptr, nullptr, 0, sumsq + (size_t)2 * MTOK};
                REPS(11) pg8::gemm_phase(ldsl, g, S, E, wv);
            } else {
                pg8::Gemm g{HKV, (const bf16_t*)(ws + WS_ATTOUT) + (size_t)DM * DM, DM, DM, DM, 0, 0};
                pg8::MultiOrder S; S.init(MTOK, DM, 1, G, c);
                pg8::EpiFinal E{(const _Float16*)(ws + WS_X16), xw, modv + l * 3 * DM + 2 * DM, AIN(20), sumsq + (size_t)3 * MTOK, (unsigned*)(ws + WS_PCNT)};
                REPS(12) pg8::gemm_phase(ldsl, g, S, E, wv);
            }
        }
    }
}
__global__ void __launch_bounds__(NTHR, 2) yoco_fwd(Args a_) {
    extern __shared__ __attribute__((aligned(16))) unsigned char lds[];
    const int ph_lo = a_.ph_lo, ph_hi = a_.ph_hi;
    const int wv = __builtin_amdgcn_readfirstlane((int)threadIdx.x >> 6);
    if (ph_hi - ph_lo > 1) {
        if (threadIdx.x < 8) ((volatile LAS unsigned*)((LAS unsigned char*)lds + LDS_MISC))[threadIdx.x] = 0u;
        if (threadIdx.x == 0) (void)xb_add(&((unsigned*)(a_.ws + WS_BAR))[XB_XCNT(xb_xcc_id())], 1u);
        __syncthreads();
    }
    if (ph_lo < 0) cg::this_grid().sync();
#define SEAM(P) do { ArgsP ap_ = (ArgsP)__builtin_amdgcn_kernarg_segment_ptr(); asm volatile("" : "+s"(ap_)); \
        xcd_barrier((unsigned*)((unsigned char*)ap_->ws + WS_BAR), (volatile LAS unsigned*)((LAS unsigned char*)lds + LDS_MISC), opq_tid(wv)); } while (0)
#ifndef TPROBE_MASK
#define TPROBE_MASK 0
#endif
#define TPROBE_MULT 10
#define TP_ON(P) ((TPROBE_MASK >> (P)) & 1)
#define TP_BEGIN(P) if (TP_ON(P) && blockIdx.x == 0 && opq_tid(wv) == 0) { volatile LAS unsigned long long* tw_ = (volatile LAS unsigned long long*)((LAS unsigned char*)lds + LDS_MISC + 16); tw_[1] = __builtin_amdgcn_s_memrealtime(); }
#define TP_END(P) if (TP_ON(P) && blockIdx.x == 0 && opq_tid(wv) == 0) { volatile LAS unsigned long long* tw_ = (volatile LAS unsigned long long*)((LAS unsigned char*)lds + LDS_MISC + 16); tw_[0] = tw_[0] + (__builtin_amdgcn_s_memrealtime() - tw_[1]); }
#define RUN(P) if ((P) >= ph_lo && (P) < ph_hi) { TP_BEGIN(P) run_phase<P>(lds, wv); if ((P) + 1 < ph_hi) { for (int br_ = 0; br_ < BAR_REP; ++br_) SEAM(P); } TP_END(P) }
    RUN(0) RUN(1) RUN(2) RUN(3) RUN(4) RUN(5) RUN(6) RUN(7) RUN(8) RUN(9) RUN(10) RUN(11)
    RUN(12) RUN(13)
#undef RUN
#undef SEAM
    if (TPROBE_MASK != 0 && blockIdx.x == 0 && opq_tid(wv) == 0) {
        volatile LAS unsigned long long* tw_ = (volatile LAS unsigned long long*)((LAS unsigned char*)lds + LDS_MISC + 16);
        const unsigned long long span = tw_[0] * TPROBE_MULT, t0 = __builtin_amdgcn_s_memrealtime();
        while (__builtin_amdgcn_s_memrealtime() - t0 < span) __builtin_amdgcn_s_sleep(8);
    }
}

extern "C" void kernel_launch(void* const* d_in, const int* in_sizes, int n_in, void* d_out, int out_size, void* d_ws, size_t ws_size, hipStream_t stream) {
    static int grid = 0;
    if (grid == 0) {
        if (n_in != 21 || out_size != MTOK * DM || ws_size < WS_END) { fprintf(stderr, "kernel_launch: unexpected shapes (n_in %d out %d ws %zu)\n", n_in, out_size, ws_size); grid = -1; return; }
        int dev = 0, cus = 0, per_cu = 0;
        (void)hipGetDevice(&dev);
        if (hipDeviceGetAttribute(&cus, hipDeviceAttributeMultiprocessorCount, dev) != hipSuccess || cus <= 0) cus = 256;
        if (hipFuncSetAttribute((const void*)yoco_fwd, hipFuncAttributeMaxDynamicSharedMemorySize, LDS_BYTES) != hipSuccess) { fprintf(stderr, "kernel_launch: hipFuncSetAttribute failed\n"); grid = -1; return; }
        if (hipOccupancyMaxActiveBlocksPerMultiprocessor(&per_cu, (const void*)yoco_fwd, NTHR, LDS_BYTES) != hipSuccess || per_cu < 1) { fprintf(stderr, "kernel_launch: occupancy query says %d\n", per_cu); per_cu = 1; }
        (void)hipGetLastError();
        grid = cus > 256 ? 256 : cus;
    }
    if (grid < 0) return;
    (void)hipMemsetAsync((char*)d_ws + WS_CTL, 0, CTL_ZERO_BYTES, stream);
    Args a{};
    for (int i = 0; i < 21; ++i) a.in[i] = (const float*)d_in[i];
    a.out = (float*)d_out; a.ws = (unsigned char*)d_ws;
#if MK_MULTI_LAUNCH
    for (int ph = 0; ph < NPHASE; ++ph) { a.ph_lo = ph; a.ph_hi = ph + 1; hipLaunchKernelGGL(yoco_fwd, dim3(grid), dim3(NTHR), LDS_BYTES, stream, a); }
#else
    a.ph_lo = 0; a.ph_hi = NPHASE;
    void* kargs[] = {&a};
    hipError_t e = hipLaunchCooperativeKernel((const void*)yoco_fwd, dim3(grid), dim3(NTHR), kargs, LDS_BYTES, stream);
    if (e != hipSuccess) fprintf(stderr, "kernel_launch: cooperative launch failed: %s (grid %d)\n", hipGetErrorString(e), grid);
#endif
}
```

```cpp
#include <hip/hip_runtime.h>
#include <hip/hip_cooperative_groups.h>
#include <cstdio>
#include <cstdint>
namespace cg = cooperative_groups;

#ifndef MK_MULTI_LAUNCH
#define MK_MULTI_LAUNCH 0
#endif

constexpr int DM = 1024, NB = 8, SEQ = 2048, MTOK = NB * SEQ, NH = 8, DH = 128;
constexpr int MODV_LD = 14336;
constexpr float EPS = 1e-6f;
constexpr int NWAVES = 8, NTHR = 512;
constexpr int LDS_BYTES = 147456;

constexpr size_t MiB = 1u << 20;
constexpr size_t WS_CTL = 0, CTL_ZERO_BYTES = 1 * MiB + 256 * 1024;
constexpr size_t WS_MODV = 64 * 1024;
constexpr size_t WS_KMEAN = 512 * 1024;
constexpr size_t WS_GFLAG = 32 * 1024;
constexpr size_t WS_SHW = 768 * 1024;
constexpr size_t WS_PCNT = 48 * 1024;
constexpr size_t WS_CFLAG = 50 * 1024;
constexpr size_t WS_SUMSQ = 1 * MiB;
constexpr size_t WS_TA = 1 * MiB + 256 * 1024;
constexpr size_t WS_WIN = 2 * MiB;
constexpr size_t WS_WG = 10 * MiB;
constexpr size_t WS_WOUT = 12 * MiB;
constexpr size_t WS_ATTIN0 = 16 * MiB, WS_WKV = 20 * MiB, WS_ATTIN1 = 24 * MiB;
constexpr size_t WS_ATTOUT = 28 * MiB;
constexpr size_t WS_HN = 32 * MiB;
constexpr size_t WS_HKV = 64 * MiB;
constexpr size_t WS_UPRE = 96 * MiB;
constexpr size_t WS_G = 128 * MiB;
constexpr size_t WS_LA = 160 * MiB;
constexpr size_t WS_BIN = 192 * MiB;
constexpr size_t WS_X16 = 224 * MiB;
constexpr size_t WS_END = 256 * MiB;

typedef unsigned short bf16_t;
typedef short bf16x8 __attribute__((ext_vector_type(8)));
typedef short s16x4 __attribute__((ext_vector_type(4)));
typedef float f32x4 __attribute__((ext_vector_type(4)));
typedef float f32x2 __attribute__((ext_vector_type(2)));
typedef float f32x16 __attribute__((ext_vector_type(16)));
typedef unsigned u32x4 __attribute__((ext_vector_type(4)));
typedef unsigned u32x2 __attribute__((ext_vector_type(2)));
#define LAS __attribute__((address_space(3)))

__device__ __forceinline__ unsigned cvt_pk_bf16(float lo, float hi) { unsigned r; asm volatile("v_cvt_pk_bf16_f32 %0, %1, %2" : "=v"(r) : "v"(lo), "v"(hi)); return r; }
__device__ __forceinline__ float bf_lo(unsigned w) { return __uint_as_float(w << 16); }
__device__ __forceinline__ float bf_hi(unsigned w) { return __uint_as_float(w & 0xffff0000u); }
__device__ __forceinline__ float bf1(bf16_t h) { return __uint_as_float((unsigned)h << 16); }
__device__ __forceinline__ float fexp(float x) { return __builtin_amdgcn_exp2f(x * 1.4426950408889634f); }
__device__ __forceinline__ float flog(float x) { return __builtin_amdgcn_logf(x) * 0.6931471805599453f; }
__device__ __forceinline__ float fsigmoid(float x) { return __builtin_amdgcn_rcpf(1.f + fexp(-x)); }
__device__ __forceinline__ float fsilu(float x) { return x * fsigmoid(x); }
__device__ __forceinline__ int opq_tid(int wv) { int l; asm volatile("v_mbcnt_lo_u32_b32 %0, -1, 0\n\tv_mbcnt_hi_u32_b32 %0, -1, %0" : "=v"(l)); return wv * 64 + l; }
__device__ __forceinline__ int opq_bid() { int b = blockIdx.x; asm volatile("" : "+s"(b)); return b; }
__device__ __forceinline__ float wave_sum(float v) {
#pragma unroll
    for (int o = 1; o < 64; o <<= 1) v += __shfl_xor(v, o);
    return v;
}

namespace pg8 {
constexpr int BM = 256, BK = 64, HALF = 128, HTB = HALF * BK * 2, STAGE_BYTES = 8 * HTB, NXCD = 8, WGM = 8;
__host__ __device__ __forceinline__ int lds_byte(int r, int c) { const int st = (r >> 4) * 2 + (c >> 5), rr = r & 15, cc = c & 31, ob = rr * 64 + cc * 2; return st * 1024 + (ob ^ (((ob >> 9) & 1) << 5)); }
__host__ __device__ __forceinline__ void stage_rc(int b, int& R, int& C) { const int st = b / 1024, sb = b % 1024, swz = sb ^ (((sb >> 9) & 1) << 5); R = (st >> 1) * 16 + swz / 64; C = (st & 1) * 32 + (swz % 64) / 2; }
__host__ __device__ __forceinline__ int perm32(int rho) { const int n = rho >> 4, i = rho & 15; return 8 * (i >> 2) + 4 * n + (i & 3); }

struct Unit { int pm, pn, sub; };
struct Gemm { const bf16_t* A; const bf16_t* Bt; int lda, ldb, K; long a_sub, b_sub; };

struct MultiOrder {
    int nM, nN, nwg, nsub, G, c;
    __device__ void init(int M, int N, int nsub_, int G_, int c_) { nM = M / BM; nN = N / BM; nwg = nM * nN; nsub = nsub_; G = G_; c = c_; }
    __device__ bool next(int i, Unit& u) const {
        const long L = (long)i * G + c; if (L >= (long)nwg * nsub) return false;
        u.sub = (int)(L / nwg);
        int wgid = (int)(L % nwg); { const int q = nwg / NXCD, r = nwg % NXCD, xcd = wgid % NXCD, off = wgid / NXCD; wgid = (xcd < r ? xcd * (q + 1) : r * (q + 1) + (xcd - r) * q) + off; }
        const int nig = WGM * nN, gid = wgid / nig, fm = gid * WGM, gsz = (nM - fm) < WGM ? (nM - fm) : WGM;
        u.pm = fm + ((wgid % nig) % gsz); u.pn = (wgid % nig) / gsz; return true;
    }
};


template <int N> __device__ __forceinline__ float dpp_shr(float src, float ident) {
    return __int_as_float(__builtin_amdgcn_update_dpp(__float_as_int(ident), __float_as_int(src), 0x110 + N, 0xF, 0xF, false));
}
struct EpiSplit {
    static constexpr bool PERM = true, APERM = false;
    bf16_t* O0; bf16_t* O1; const float* sumsq; const float* shw;
    __device__ __forceinline__ void operator()(const f32x4 (&acc)[2][2][4][2], const Unit& u, int wr, int wc, int fr, int fq) const {
        const int row0 = u.pm * BM + wr * 64 + fr; int colt = u.pn * BM; bf16_t* base = O0;
        const int cfull = u.pn * BM + wc * 32 + 8 * fq;
        const bool gate_half = colt >= DM;
        if (gate_half) { base = O1; colt -= DM; }
        const int col0 = colt + wc * 32 + 8 * fq;
        f32x4 bv[2][2];
#pragma unroll
        for (int bj = 0; bj < 2; ++bj)
#pragma unroll
            for (int n = 0; n < 2; ++n) bv[bj][n] = sumsq ? *(const f32x4*)(shw + (size_t)(u.pm >> 3) * 2 * DM + cfull + bj * HALF + 4 * n) : (f32x4){0.f, 0.f, 0.f, 0.f};
        float ssq[2][4];
#pragma unroll
        for (int ai = 0; ai < 2; ++ai)
#pragma unroll
            for (int m = 0; m < 4; ++m) ssq[ai][m] = sumsq ? sumsq[row0 + ai * HALF + m * 16] : 0.f;
#pragma unroll
        for (int ai = 0; ai < 2; ++ai)
#pragma unroll
            for (int m = 0; m < 4; ++m) { const int row = row0 + ai * HALF + m * 16; bf16_t* rowp = base + (size_t)row * DM + col0;
                const float rs = sumsq ? __builtin_amdgcn_rsqf(ssq[ai][m] * (1.f / DM) + EPS) : 1.f;
#pragma unroll
                for (int bj = 0; bj < 2; ++bj) { f32x4 v0 = acc[ai][bj][m][0] * rs + bv[bj][0], v1 = acc[ai][bj][m][1] * rs + bv[bj][1];
                    if (gate_half) {
#pragma unroll
                        for (int j = 0; j < 4; ++j) { v0[j] = fsilu(v0[j]); v1[j] = fsilu(v1[j]); } }
                    u32x4 w; w.x = cvt_pk_bf16(v0[0], v0[1]); w.y = cvt_pk_bf16(v0[2], v0[3]); w.z = cvt_pk_bf16(v1[0], v1[1]); w.w = cvt_pk_bf16(v1[2], v1[3]);
                    *(u32x4*)(rowp + bj * HALF) = w; } }
    }
};

typedef _Float16 h16x8 __attribute__((ext_vector_type(8)));
__device__ __forceinline__ void ld8(const float* p, float (&v)[8]) { const f32x4 a = *(const f32x4*)p, b = *(const f32x4*)(p + 4); v[0] = a[0]; v[1] = a[1]; v[2] = a[2]; v[3] = a[3]; v[4] = b[0]; v[5] = b[1]; v[6] = b[2]; v[7] = b[3]; }
struct InOrder {
    int c, n, base;
    __device__ bool next(int i, Unit& u) const { if (i >= n) return false; const int j = c >> 3; int pm = (c & 7) * 8 + (j >> 2), pn = 4 * (i + base) + (j & 3), sub = 0;
        asm volatile("" : "+s"(pm), "+s"(pn), "+s"(sub)); u.pm = pm; u.pn = pn; u.sub = sub; return true; }
};
constexpr int CV_HL_OFF = 133120;
struct EpiSplitConv {
    static constexpr bool PERM = true, APERM = true;
    unsigned char* ws; const float* sumsq; const float* shw; const float* cw; const float* cb; unsigned target; LAS unsigned char* lds;
    __device__ __forceinline__ void operator()(f32x4 (&acc)[2][2][4][2], const Unit& u, int wr, int wc, int fr, int fq) const {
        const int pnl = u.pn & 3;
        const int cfull = u.pn * BM + wc * 32 + 8 * fq, ct = wc * 32 + 8 * fq, col0 = pnl * BM + ct;
        bf16_t* obase = (bf16_t*)(ws + WS_UPRE);
        f32x4 bv[2][2];
#pragma unroll
        for (int bj = 0; bj < 2; ++bj)
#pragma unroll
            for (int n = 0; n < 2; ++n) bv[bj][n] = sumsq ? *(const f32x4*)(shw + (size_t)(u.pm >> 3) * 2 * DM + cfull + bj * HALF + 4 * n) : (f32x4){0.f, 0.f, 0.f, 0.f};
        float ssq[2][4];
#pragma unroll
        for (int ai = 0; ai < 2; ++ai)
#pragma unroll
            for (int m = 0; m < 4; ++m) ssq[ai][m] = sumsq ? sumsq[u.pm * BM + ai * HALF + wr * 64 + 4 * fr + m] : 0.f;
#pragma unroll
        for (int ai = 0; ai < 2; ++ai)
#pragma unroll
            for (int m = 0; m < 4; ++m) { const float rs = sumsq ? __builtin_amdgcn_rsqf(ssq[ai][m] * (1.f / DM) + EPS) : 1.f;
#pragma unroll
                for (int bj = 0; bj < 2; ++bj) { acc[ai][bj][m][0] = acc[ai][bj][m][0] * rs + bv[bj][0]; acc[ai][bj][m][1] = acc[ai][bj][m][1] * rs + bv[bj][1]; } }
        const int tile = u.pm * 4 + pnl;
        unsigned long long* HX = (unsigned long long*)(ws + WS_BIN);
        unsigned* flags = (unsigned*)(ws + WS_CFLAG);
        LAS f32x4* HL = (LAS f32x4*)(lds + CV_HL_OFF);
#pragma unroll
        for (int ai = 0; ai < 2; ++ai)
#pragma unroll
            for (int k = 0; k < 3; ++k)
#pragma unroll
                for (int bj = 0; bj < 2; ++bj) {
                    if (fr == 15) { LAS f32x4* d = HL + (((ai * 2 + wr) * 3 + k) * 256 + bj * HALF + ct) / 4;
                        d[0] = acc[ai][bj][k + 1][0]; d[1] = acc[ai][bj][k + 1][1];
                        if (ai == 1 && wr == 1) { unsigned long long* g_ = HX + ((size_t)(tile * 3 + k) * 256 + bj * HALF + ct) / 2;
#pragma unroll
                            for (int n = 0; n < 2; ++n) { const f32x4 v = acc[1][bj][k + 1][n];
                                __hip_atomic_store(g_ + 2 * n, ((unsigned long long)__float_as_uint(v[1]) << 32) | __float_as_uint(v[0]), __ATOMIC_RELAXED, __HIP_MEMORY_SCOPE_AGENT);
                                __hip_atomic_store(g_ + 2 * n + 1, ((unsigned long long)__float_as_uint(v[3]) << 32) | __float_as_uint(v[2]), __ATOMIC_RELAXED, __HIP_MEMORY_SCOPE_AGENT); } } }
                    asm volatile("" ::: "memory"); __builtin_amdgcn_sched_barrier(0);
                }
        if (wr == 1) { asm volatile("s_waitcnt vmcnt(0)" ::: "memory");
            if (fr == 15 && fq == 0) __hip_atomic_fetch_add(flags + tile * 8, 1u, __ATOMIC_RELAXED, __HIP_MEMORY_SCOPE_AGENT); }
        asm volatile("s_waitcnt lgkmcnt(0)" ::: "memory"); __builtin_amdgcn_s_barrier(); asm volatile("" ::: "memory");
        const bool need_prev = (wr == 0) && ((u.pm & 7) != 0);
        if (need_prev) { unsigned spins = 0;
            while (__hip_atomic_load(flags + (tile - 4) * 8, __ATOMIC_RELAXED, __HIP_MEMORY_SCOPE_AGENT) < target) { __builtin_amdgcn_s_sleep(2); if (++spins > (1u << 22)) break; } }
#pragma unroll
        for (int ai = 0; ai < 2; ++ai)
#pragma unroll
            for (int bj = 0; bj < 2; ++bj)
#pragma unroll
                for (int n = 0; n < 2; ++n) {
                    f32x4 pr[3];
                    if (ai == 0 && wr == 0) {
#pragma unroll
                        for (int k = 0; k < 3; ++k) { unsigned long long wa = 0ull, wb = 0ull;
                            if (need_prev) { const unsigned long long* sp = HX + ((size_t)((tile - 4) * 3 + k) * 256 + bj * HALF + ct + 4 * n) / 2;
                                wa = __hip_atomic_load(sp, __ATOMIC_RELAXED, __HIP_MEMORY_SCOPE_AGENT); wb = __hip_atomic_load(sp + 1, __ATOMIC_RELAXED, __HIP_MEMORY_SCOPE_AGENT); }
                            pr[k] = (f32x4){__uint_as_float((unsigned)wa), __uint_as_float((unsigned)(wa >> 32)), __uint_as_float((unsigned)wb), __uint_as_float((unsigned)(wb >> 32))}; }
                    } else { const int prun = ai * 2 + wr - 1;
#pragma unroll
                        for (int k = 0; k < 3; ++k) pr[k] = HL[((prun * 3 + k) * 256 + bj * HALF + ct + 4 * n) / 4]; }
                    const int chg = pnl * BM + bj * HALF + ct + 4 * n;
                    const f32x4 w0 = *(const f32x4*)(cw + chg), w1 = *(const f32x4*)(cw + DM + chg), w2 = *(const f32x4*)(cw + 2 * DM + chg), w3 = *(const f32x4*)(cw + 3 * DM + chg), bb = *(const f32x4*)(cb + chg);
                    const f32x4 x0 = acc[ai][bj][0][n], x1 = acc[ai][bj][1][n], x2 = acc[ai][bj][2][n], x3 = acc[ai][bj][3][n];
                    f32x4 q1, q2, q3;
#pragma unroll
                    for (int j = 0; j < 4; ++j) { q1[j] = dpp_shr<1>(x3[j], pr[2][j]); q2[j] = dpp_shr<1>(x2[j], pr[1][j]); q3[j] = dpp_shr<1>(x1[j], pr[0][j]); }
                    const f32x4 y0 = bb + w0 * q3 + w1 * q2 + w2 * q1 + w3 * x0, y1 = bb + w0 * q2 + w1 * q1 + w2 * x0 + w3 * x1;
                    const f32x4 y2 = bb + w0 * q1 + w1 * x0 + w2 * x1 + w3 * x2, y3 = bb + w0 * x0 + w1 * x1 + w2 * x2 + w3 * x3;
                    bf16_t* op = obase + (size_t)(u.pm * BM + ai * HALF + wr * 64 + 4 * fr) * DM + col0 + bj * HALF + 4 * n;
                    { u32x2 w; w.x = cvt_pk_bf16(y0[0], y0[1]); w.y = cvt_pk_bf16(y0[2], y0[3]); *(u32x2*)(op) = w; }
                    { u32x2 w; w.x = cvt_pk_bf16(y1[0], y1[1]); w.y = cvt_pk_bf16(y1[2], y1[3]); *(u32x2*)(op + DM) = w; }
                    { u32x2 w; w.x = cvt_pk_bf16(y2[0], y2[1]); w.y = cvt_pk_bf16(y2[2], y2[3]); *(u32x2*)(op + 2 * DM) = w; }
                    { u32x2 w; w.x = cvt_pk_bf16(y3[0], y3[1]); w.y = cvt_pk_bf16(y3[2], y3[3]); *(u32x2*)(op + 3 * DM) = w; }
                    asm volatile("" ::: "memory"); __builtin_amdgcn_sched_barrier(0);
                }
    }
};

template <class TIn, bool HAS_A2>
struct EpiResH {
    static constexpr bool PERM = true, APERM = false;
    const TIn* xin; _Float16* xo; const float* gate; const float* modv; bf16_t* A1; const float* g1; int sc1; bf16_t* A2; const float* g2; int sc2; float* sumsq;
    __device__ __forceinline__ void operator()(const f32x4 (&acc)[2][2][4][2], const Unit& u, int wr, int wc, int fr, int fq) const {
        const int b = u.pm >> 3, col0 = u.pn * BM + wc * 32 + 8 * fq;
        float gv[2][8], gs1[2][8], gs2[HAS_A2 ? 2 : 1][8];
#pragma unroll
        for (int bj = 0; bj < 2; ++bj) { const int cc = col0 + bj * HALF;
            ld8(gate + (size_t)b * MODV_LD + cc, gv[bj]);
            { float gg[8], sc[8]; ld8(g1 + cc, gg); ld8(modv + (size_t)b * MODV_LD + sc1 + cc, sc);
#pragma unroll
              for (int j = 0; j < 8; ++j) gs1[bj][j] = gg[j] * (sc[j] + 1.f); }
            if constexpr (HAS_A2) { float gg[8], sc[8]; ld8(g2 + cc, gg); ld8(modv + (size_t)b * MODV_LD + sc2 + cc, sc);
#pragma unroll
              for (int j = 0; j < 8; ++j) gs2[bj][j] = gg[j] * (sc[j] + 1.f); } }
        constexpr int NG = (sizeof(TIn) == 4 || HAS_A2) ? 2 : 4;
#pragma unroll
        for (int ai = 0; ai < 2; ++ai) {
#pragma unroll
          for (int mh = 0; mh < 4; mh += NG) {
            float xv[sizeof(TIn) == 4 ? NG : 1][2][8]; h16x8 xh[sizeof(TIn) == 4 ? 1 : NG][2];
#pragma unroll
            for (int mm = 0; mm < NG; ++mm) { const size_t off = (size_t)(u.pm * BM + ai * HALF + wr * 64 + (mh + mm) * 16 + fr) * DM + col0;
#pragma unroll
                for (int bj = 0; bj < 2; ++bj) {
                    if constexpr (sizeof(TIn) == 4) ld8((const float*)xin + off + bj * HALF, xv[mm][bj]);
                    else xh[mm][bj] = *(const h16x8*)((const _Float16*)xin + off + bj * HALF); } }
            __builtin_amdgcn_sched_barrier(0);
#pragma unroll
            for (int mm = 0; mm < NG; ++mm) { const int m = mh + mm; const int row = u.pm * BM + ai * HALF + wr * 64 + m * 16 + fr; const size_t off = (size_t)row * DM + col0;
                float ss = 0.f;
#pragma unroll
                for (int bj = 0; bj < 2; ++bj) { float o[8]; h16x8 ho;
#pragma unroll
                    for (int j = 0; j < 8; ++j) { float xj; if constexpr (sizeof(TIn) == 4) xj = xv[mm][bj][j]; else xj = (float)xh[mm][bj][j];
                        o[j] = xj + gv[bj][j] * acc[ai][bj][m][j >> 2][j & 3]; ho[j] = (_Float16)o[j]; ss += o[j] * o[j]; }
                    *(h16x8*)(xo + off + bj * HALF) = ho;
                    if (A1) { u32x4 w; w.x = cvt_pk_bf16(o[0] * gs1[bj][0], o[1] * gs1[bj][1]); w.y = cvt_pk_bf16(o[2] * gs1[bj][2], o[3] * gs1[bj][3]);
                        w.z = cvt_pk_bf16(o[4] * gs1[bj][4], o[5] * gs1[bj][5]); w.w = cvt_pk_bf16(o[6] * gs1[bj][6], o[7] * gs1[bj][7]); *(u32x4*)(A1 + off + bj * HALF) = w; }
                    if constexpr (HAS_A2) { u32x4 w; w.x = cvt_pk_bf16(o[0] * gs2[bj][0], o[1] * gs2[bj][1]); w.y = cvt_pk_bf16(o[2] * gs2[bj][2], o[3] * gs2[bj][3]);
                        w.z = cvt_pk_bf16(o[4] * gs2[bj][4], o[5] * gs2[bj][5]); w.w = cvt_pk_bf16(o[6] * gs2[bj][6], o[7] * gs2[bj][7]); *(u32x4*)(A2 + off + bj * HALF) = w; } }
                if (sumsq) { ss += __shfl_xor(ss, 16); ss += __shfl_xor(ss, 32); if (fq == 0) atomicAdd(sumsq + row, ss); } }
            __builtin_amdgcn_sched_barrier(0);
          }
        }
    }
};

struct EpiFinal {
    static constexpr bool PERM = true, APERM = false;
    const _Float16* xin; float* out; const float* gate; const float* fg; float* sumsq; unsigned* cnt;
    __device__ __forceinline__ void operator()(f32x4 (&acc)[2][2][4][2], const Unit& u, int wr, int wc, int fr, int fq) const {
        const int b = u.pm >> 3, col0 = u.pn * BM + wc * 32 + 8 * fq;
        float gv[2][8];
#pragma unroll
        for (int bj = 0; bj < 2; ++bj) ld8(gate + (size_t)b * MODV_LD + col0 + bj * HALF, gv[bj]);
#pragma unroll
        for (int ai = 0; ai < 2; ++ai) {
            h16x8 xh[4][2];
#pragma unroll
            for (int m = 0; m < 4; ++m)
#pragma unroll
                for (int bj = 0; bj < 2; ++bj) xh[m][bj] = *(const h16x8*)(xin + (size_t)(u.pm * BM + ai * HALF + wr * 64 + m * 16 + fr) * DM + col0 + bj * HALF);
            __builtin_amdgcn_sched_barrier(0);
#pragma unroll
            for (int m = 0; m < 4; ++m) { const int row = u.pm * BM + ai * HALF + wr * 64 + m * 16 + fr;
                float ss = 0.f;
#pragma unroll
                for (int bj = 0; bj < 2; ++bj) { f32x4 o0, o1;
#pragma unroll
                    for (int j = 0; j < 4; ++j) { o0[j] = (float)xh[m][bj][j] + gv[bj][j] * acc[ai][bj][m][0][j]; o1[j] = (float)xh[m][bj][4 + j] + gv[bj][4 + j] * acc[ai][bj][m][1][j]; }
                    acc[ai][bj][m][0] = o0; acc[ai][bj][m][1] = o1;
                    ss += (o0[0] * o0[0] + o0[1] * o0[1]) + (o0[2] * o0[2] + o0[3] * o0[3]) + (o1[0] * o1[0] + o1[1] * o1[1]) + (o1[2] * o1[2] + o1[3] * o1[3]); }
                ss += __shfl_xor(ss, 16); ss += __shfl_xor(ss, 32); if (fq == 0) atomicAdd(sumsq + row, ss); }
            __builtin_amdgcn_sched_barrier(0);
        }
        asm volatile("s_waitcnt vmcnt(0)" ::: "memory");
        if (fr == 0 && fq == 0) __hip_atomic_fetch_add(cnt + u.pm * 8, 1u, __ATOMIC_RELAXED, __HIP_MEMORY_SCOPE_AGENT);
        { unsigned spins = 0;
          while (__hip_atomic_load(cnt + u.pm * 8, __ATOMIC_RELAXED, __HIP_MEMORY_SCOPE_AGENT) < 32u) { __builtin_amdgcn_s_sleep(2); if (++spins > (1u << 22)) break; } }
        float fgv[2][8];
#pragma unroll
        for (int bj = 0; bj < 2; ++bj) ld8(fg + col0 + bj * HALF, fgv[bj]);
        float ssq[2][4];
#pragma unroll
        for (int ai = 0; ai < 2; ++ai)
#pragma unroll
            for (int m = 0; m < 4; ++m) ssq[ai][m] = __hip_atomic_load(sumsq + u.pm * BM + ai * HALF + wr * 64 + m * 16 + fr, __ATOMIC_RELAXED, __HIP_MEMORY_SCOPE_AGENT);
#pragma unroll
        for (int ai = 0; ai < 2; ++ai)
#pragma unroll
            for (int m = 0; m < 4; ++m) { const size_t off = (size_t)(u.pm * BM + ai * HALF + wr * 64 + m * 16 + fr) * DM + col0;
                const float rs = __builtin_amdgcn_rsqf(ssq[ai][m] * (1.f / DM) + EPS);
#pragma unroll
                for (int bj = 0; bj < 2; ++bj) { f32x4 y0, y1;
#pragma unroll
                    for (int j = 0; j < 4; ++j) { y0[j] = acc[ai][bj][m][0][j] * rs * fgv[bj][j]; y1[j] = acc[ai][bj][m][1][j] * rs * fgv[bj][4 + j]; }
                    *(f32x4*)(out + off + bj * HALF) = y0; *(f32x4*)(out + off + bj * HALF + 4) = y1; } }
    }
};

__device__ __forceinline__ void scan16(float& a, float& b) {
    float ap, bp;
    ap = dpp_shr<1>(a, 1.f); bp = dpp_shr<1>(b, 0.f); b = fmaf(a, bp, b); a *= ap;
    ap = dpp_shr<2>(a, 1.f); bp = dpp_shr<2>(b, 0.f); b = fmaf(a, bp, b); a *= ap;
    ap = dpp_shr<4>(a, 1.f); bp = dpp_shr<4>(b, 0.f); b = fmaf(a, bp, b); a *= ap;
    ap = dpp_shr<8>(a, 1.f); bp = dpp_shr<8>(b, 0.f); b = fmaf(a, bp, b); a *= ap;
}
__device__ __forceinline__ void gate_elem2(f32x2 xr, f32x2 xg, f32x2 nba, f32x2 nbx, f32x2 psp2, f32x2 uv, f32x2& a, f32x2& b) {
    const f32x2 tr = xr * (-1.4426950408889634f) + nba, tg = xg * (-1.4426950408889634f) + nbx;
    f32x2 er, eg; er.x = __builtin_amdgcn_exp2f(tr.x); er.y = __builtin_amdgcn_exp2f(tr.y); eg.x = __builtin_amdgcn_exp2f(tg.x); eg.y = __builtin_amdgcn_exp2f(tg.y);
    const f32x2 dr = er + 1.f, dg = eg + 1.f, dd = dr * dg;
    f32x2 inv; inv.x = __builtin_amdgcn_rcpf(dd.x); inv.y = __builtin_amdgcn_rcpf(dd.y);
    const f32x2 r = inv * dg, gi = inv * dr;
    const f32x2 la2 = psp2 * r;
    a.x = __builtin_amdgcn_exp2f(-la2.x); a.y = __builtin_amdgcn_exp2f(-la2.y);
    const f32x2 om = 1.f - a * a;
    f32x2 sq; sq.x = __builtin_amdgcn_sqrtf(om.x); sq.y = __builtin_amdgcn_sqrtf(om.y);
    b = sq * gi * uv;
}
struct GateParams { f32x2 nba[4], nbx[4], psp2[4]; };
__device__ __forceinline__ void gate_params(GateParams& P, const float* ba, const float* bx, const float* lam, int ch0) {
#pragma unroll
    for (int p = 0; p < 4; ++p) {
        const f32x2 vb = *(const f32x2*)(ba + ch0 + 2 * p), vx = *(const f32x2*)(bx + ch0 + 2 * p), vl = *(const f32x2*)(lam + ch0 + 2 * p);
        P.nba[p] = vb * (-1.4426950408889634f); P.nbx[p] = vx * (-1.4426950408889634f);
        const float z0 = -vl.x, z1 = -vl.y;
        P.psp2[p].x = 8.f * 1.4426950408889634f * (z0 > 20.f ? z0 : flog(1.f + fexp(z0)));
        P.psp2[p].y = 8.f * 1.4426950408889634f * (z1 > 20.f ? z1 : flog(1.f + fexp(z1)));
    }
}
#define GATE_PAIR(p, accv, uw_, a2, b2) do { const int n_ = (p) >> 1, q_ = ((p) & 1) * 2; \
        const unsigned uword_ = ((p) == 0) ? uw_.x : ((p) == 1) ? uw_.y : ((p) == 2) ? uw_.z : uw_.w; \
        gate_elem2((f32x2){accv[ai][0][m][n_][q_], accv[ai][0][m][n_][q_ + 1]}, (f32x2){accv[ai][1][m][n_][q_], accv[ai][1][m][n_][q_ + 1]}, \
                   P.nba[p], P.nbx[p], P.psp2[p], (f32x2){bf_lo(uword_), bf_hi(uword_)}, a2, b2); } while (0)
struct GatesOrder {
    int c, n;
    __device__ bool next(int i, Unit& u) const { if (i >= n) return false; int pm = (c >> 5) * 8 + 4 * i + (c & 3), pn = (c >> 2) & 1, sub = (c >> 3) & 3;
        asm volatile("" : "+s"(pm), "+s"(pn), "+s"(sub)); u.pm = pm; u.pn = pn; u.sub = sub; return true; }
};
constexpr int GS_RA_OFF = 133120;
struct EpiGatesS {
    static constexpr bool PERM = true, APERM = true;
    unsigned char* ws; unsigned target; const float* ba; const float* bx; const float* lam; LAS unsigned char* lds;
    __device__ __forceinline__ void operator()(f32x4 (&acc)[2][2][4][2], const Unit& u, int wr, int wc, int fr, int fq) const {
        const bf16_t* U = (const bf16_t*)(ws + WS_UPRE); const bf16_t* Gt = (const bf16_t*)(ws + WS_G); bf16_t* Y = (bf16_t*)(ws + WS_HN);
        unsigned long long* TA = (unsigned long long*)(ws + WS_TA); unsigned* flags = (unsigned*)(ws + WS_GFLAG);
        const int ct0 = wc * 32 + 8 * fq, ch0 = u.sub * 256 + u.pn * 128 + ct0;
        const int chain = ((u.pm >> 3) * 4 + u.sub) * 2 + u.pn, p = u.pm & 7, tix = chain * 8 + p;
        const int bsrc = (fq * 16 + 15) << 2;
        LAS f32x4* RA = (LAS f32x4*)(lds + GS_RA_OFF);
        {
            GateParams P; gate_params(P, ba, bx, lam, ch0);
#pragma unroll
            for (int ai = 0; ai < 2; ++ai) {
                u32x4 uall[4];
#pragma unroll
                for (int m = 0; m < 4; ++m) uall[m] = *(const u32x4*)(U + (size_t)(u.pm * BM + ai * HALF + wr * 64 + 4 * fr + m) * DM + ch0);
#pragma unroll
                for (int n = 0; n < 2; ++n) { f32x4 tA[4], tB[4]; f32x4 agg;
#pragma unroll
                    for (int hq = 0; hq < 2; ++hq) { const int pq = 2 * n + hq; f32x2 a2[4], b2[4];
#pragma unroll
                        for (int m = 0; m < 4; ++m) { const u32x4 uw = uall[m]; GATE_PAIR(pq, acc, uw, a2[m], b2[m]); }
#pragma unroll
                        for (int m = 1; m < 4; ++m) { b2[m] = a2[m] * b2[m - 1] + b2[m]; a2[m] = a2[m] * a2[m - 1]; }
                        float pax = a2[3].x, pbx = b2[3].x, pay = a2[3].y, pby = b2[3].y; scan16(pax, pbx); scan16(pay, pby);
                        if (hq == 0) { agg[0] = pax; agg[1] = pbx; agg[2] = pay; agg[3] = pby;
                            if (fr == 15) RA[((ai * 2 + wr) * 128 + ct0) / 2 + pq] = agg; }
                        else { if (fr == 15) RA[((ai * 2 + wr) * 128 + ct0) / 2 + pq] = (f32x4){pax, pbx, pay, pby}; }
                        const f32x2 EA = {dpp_shr<1>(pax, 1.f), dpp_shr<1>(pay, 1.f)}, EB = {dpp_shr<1>(pbx, 0.f), dpp_shr<1>(pby, 0.f)};
#pragma unroll
                        for (int m = 0; m < 4; ++m) { const f32x2 Ae = a2[m] * EA, Be = a2[m] * EB + b2[m];
                            tA[m][2 * hq] = Ae.x; tA[m][2 * hq + 1] = Ae.y; tB[m][2 * hq] = Be.x; tB[m][2 * hq + 1] = Be.y; }
                        __builtin_amdgcn_sched_barrier(0); }
#pragma unroll
                    for (int m = 0; m < 4; ++m) { acc[ai][0][m][n] = tA[m]; acc[ai][1][m][n] = tB[m]; }
                    asm volatile("" ::: "memory"); __builtin_amdgcn_sched_barrier(0); }
            }
        }
        asm volatile("s_waitcnt lgkmcnt(0)" ::: "memory"); __builtin_amdgcn_s_barrier(); asm volatile("" ::: "memory");
        if (wr == 0) {
            float At[8], Bt[8];
#pragma unroll
            for (int j = 0; j < 8; ++j) { At[j] = 1.f; Bt[j] = 0.f; }
#pragma unroll
            for (int ri = 0; ri < 4; ++ri)
#pragma unroll
                for (int q = 0; q < 4; ++q) { const f32x4 v = RA[(ri * 128 + ct0) / 2 + q];
                    Bt[2 * q] = fmaf(v[0], Bt[2 * q], v[1]); At[2 * q] *= v[0]; Bt[2 * q + 1] = fmaf(v[2], Bt[2 * q + 1], v[3]); At[2 * q + 1] *= v[2]; }
            if (fr == 15) {
#pragma unroll
                for (int j = 0; j < 8; ++j) __hip_atomic_store(TA + (size_t)tix * 128 + ct0 + j, ((unsigned long long)__float_as_uint(Bt[j]) << 32) | __float_as_uint(At[j]), __ATOMIC_RELAXED, __HIP_MEMORY_SCOPE_AGENT);
            }
            asm volatile("s_waitcnt vmcnt(0)" ::: "memory");
            if (fr == 15 && fq == 0) __hip_atomic_fetch_add(flags + tix * 8, 1u, __ATOMIC_RELAXED, __HIP_MEMORY_SCOPE_AGENT);
        }
        float h[8];
        {
            const bool on = fr < p;
            if (on) { unsigned spins = 0;
                while (__hip_atomic_load(flags + (chain * 8 + fr) * 8, __ATOMIC_RELAXED, __HIP_MEMORY_SCOPE_AGENT) < target) { __builtin_amdgcn_s_sleep(2); if (++spins > (1u << 22)) break; } }
            float Ac[8], Bc[8];
#pragma unroll
            for (int j = 0; j < 8; ++j) { unsigned long long w = 0x000000003f800000ull;
                if (on) w = __hip_atomic_load(TA + (size_t)(chain * 8 + fr) * 128 + ct0 + j, __ATOMIC_RELAXED, __HIP_MEMORY_SCOPE_AGENT);
                Ac[j] = __uint_as_float((unsigned)w); Bc[j] = __uint_as_float((unsigned)(w >> 32)); }
#pragma unroll
            for (int j = 0; j < 8; ++j) { float a = Ac[j], b = Bc[j]; scan16(a, b); h[j] = __int_as_float(__builtin_amdgcn_ds_bpermute(bsrc, __float_as_int(b))); }
        }
#pragma unroll
        for (int ai = 0; ai < 2; ++ai) {
            const int nskip = (ai == 0) ? wr : 1;
            const int rfirst = (ai == 0) ? 0 : (1 + wr);
            for (int k = 0; k < nskip; ++k)
#pragma unroll
                for (int q = 0; q < 4; ++q) { const f32x4 v = RA[((rfirst + k) * 128 + ct0) / 2 + q];
                    h[2 * q] = fmaf(v[0], h[2 * q], v[1]); h[2 * q + 1] = fmaf(v[2], h[2 * q + 1], v[3]); }
            u32x4 gall[4];
#pragma unroll
            for (int m = 0; m < 4; ++m) gall[m] = *(const u32x4*)(Gt + (size_t)(u.pm * BM + ai * HALF + wr * 64 + 4 * fr + m) * DM + ch0);
            float hl[8];
#pragma unroll
            for (int m = 0; m < 4; ++m) { const size_t off = (size_t)(u.pm * BM + ai * HALF + wr * 64 + 4 * fr + m) * DM + ch0;
                const u32x4 gw = gall[m];
                const float gv[8] = {bf_lo(gw.x), bf_hi(gw.x), bf_lo(gw.y), bf_hi(gw.y), bf_lo(gw.z), bf_hi(gw.z), bf_lo(gw.w), bf_hi(gw.w)};
                float yv[8];
#pragma unroll
                for (int j = 0; j < 8; ++j) { const float hv = fmaf(acc[ai][0][m][j >> 2][j & 3], h[j], acc[ai][1][m][j >> 2][j & 3]); yv[j] = hv * gv[j];
                    if (m == 3) hl[j] = hv; }
                u32x4 w; w.x = cvt_pk_bf16(yv[0], yv[1]); w.y = cvt_pk_bf16(yv[2], yv[3]); w.z = cvt_pk_bf16(yv[4], yv[5]); w.w = cvt_pk_bf16(yv[6], yv[7]);
                *(u32x4*)(Y + off) = w; }
#pragma unroll
            for (int j = 0; j < 8; ++j) h[j] = __int_as_float(__builtin_amdgcn_ds_bpermute(bsrc, __float_as_int(hl[j])));
            asm volatile("" ::: "memory"); __builtin_amdgcn_sched_barrier(0);
        }
    }
};

struct EpiQKV {
    static constexpr bool PERM = true, APERM = false;
    unsigned char* ws; float* kmean; const float* sumsq; const float* shw; int shw_sub;
    __device__ __forceinline__ void operator()(const f32x4 (&acc)[2][2][4][2], const Unit& u, int wr, int wc, int fr, int fq) const {
        const int b = u.pm >> 3, sblk = u.pm & 7, pq = u.pn & 3; const bool second = u.pn >= 4;
        const int dcol = wc * 32 + 8 * fq;
        const float* sw = shw + (size_t)u.sub * shw_sub + (size_t)b * 2 * DM + u.pn * BM + dcol;
        f32x4 bv[2][2];
#pragma unroll
        for (int bj = 0; bj < 2; ++bj)
#pragma unroll
            for (int n = 0; n < 2; ++n) bv[bj][n] = *(const f32x4*)(sw + bj * HALF + 4 * n);
        const bool plain = (u.sub == 0 && second), km = (u.sub == 1 && !second);
        const size_t boff = plain ? WS_G : (u.sub == 0) ? WS_UPRE : (second ? WS_BIN : WS_HN);
        const size_t rstride = plain ? DM : DH;
        bf16_t* bp[2];
#pragma unroll
        for (int bj = 0; bj < 2; ++bj)
            bp[bj] = (bf16_t*)(ws + boff) + (plain ? (size_t)(u.pm * BM) * DM + pq * 256 + bj * HALF + dcol : ((size_t)(b * NH + 2 * pq + bj) * SEQ + sblk * 256) * DH + dcol);
        f32x4 s0[2], s1[2];
#pragma unroll
        for (int bj = 0; bj < 2; ++bj) { s0[bj] = (f32x4){0.f, 0.f, 0.f, 0.f}; s1[bj] = (f32x4){0.f, 0.f, 0.f, 0.f}; }
        float ssq[2][4];
#pragma unroll
        for (int ai = 0; ai < 2; ++ai)
#pragma unroll
            for (int m = 0; m < 4; ++m) ssq[ai][m] = sumsq[u.pm * BM + ai * HALF + wr * 64 + m * 16 + fr];
#pragma unroll
        for (int ai = 0; ai < 2; ++ai)
#pragma unroll
            for (int m = 0; m < 4; ++m) { const int r = ai * HALF + wr * 64 + m * 16 + fr;
                const float rs = __builtin_amdgcn_rsqf(ssq[ai][m] * (1.f / DM) + EPS);
#pragma unroll
                for (int bj = 0; bj < 2; ++bj) { f32x4 v0 = acc[ai][bj][m][0] * rs + bv[bj][0], v1 = acc[ai][bj][m][1] * rs + bv[bj][1];
                    if (plain) {
#pragma unroll
                        for (int j = 0; j < 4; ++j) { v0[j] = fsilu(v0[j]); v1[j] = fsilu(v1[j]); } }
                    s0[bj] += v0; s1[bj] += v1;
                    u32x4 w; w.x = cvt_pk_bf16(v0[0], v0[1]); w.y = cvt_pk_bf16(v0[2], v0[3]); w.z = cvt_pk_bf16(v1[0], v1[1]); w.w = cvt_pk_bf16(v1[2], v1[3]);
                    *(u32x4*)(bp[bj] + (size_t)r * rstride) = w; }
                asm volatile("" ::: "memory"); }
        if (km) {
#pragma unroll
            for (int bj = 0; bj < 2; ++bj)
#pragma unroll
                for (int j = 0; j < 4; ++j) { float t0 = s0[bj][j], t1 = s1[bj][j];
                    t0 += __shfl_xor(t0, 1); t0 += __shfl_xor(t0, 2); t0 += __shfl_xor(t0, 4); t0 += __shfl_xor(t0, 8);
                    t1 += __shfl_xor(t1, 1); t1 += __shfl_xor(t1, 2); t1 += __shfl_xor(t1, 4); t1 += __shfl_xor(t1, 8);
                    if (fr == 0) { float* kp = kmean + ((size_t)(b * NH + 2 * pq + bj) * 8 + sblk) * DH + dcol + j;
                        atomicAdd(kp, t0 * (1.f / 256.f)); atomicAdd(kp + 4, t1 * (1.f / 256.f)); } }
        }
    }
};

template <class Epi, class Sched>
__device__ __forceinline__ void gemm_phase(LAS unsigned char* lds, const Gemm g, const Sched& S, const Epi& E, int wv) {
    const int tid = opq_tid(wv), wid = __builtin_amdgcn_readfirstlane(tid >> 6), lane = tid & 63, wr = wid >> 2, wc = wid & 3, fr = lane & 15, fq = lane >> 4;
    const int K = g.K, nt = K / BK;
    unsigned voffA[2], voffB[2];
#pragma unroll
    for (int i = 0; i < 2; ++i) { int R, C; stage_rc(tid * 16 + i * 8192, R, C); const int Rb = Epi::PERM ? ((R & ~31) + perm32(R & 31)) : R;
        const int Ra = Epi::APERM ? ((R & 64) + 4 * (R & 15) + ((R >> 4) & 3)) : R;
        voffA[i] = (unsigned)(Ra * g.lda + C) * 2u; voffB[i] = (unsigned)(Rb * g.ldb + C) * 2u; }
    const size_t kstep = (size_t)(BK * 2);
    const size_t hstepA = (size_t)HALF * g.lda * 2, hstepB = (size_t)HALF * g.ldb * 2;
    const size_t tstepA = 2 * hstepA, tstepB = 2 * hstepB;
    const unsigned ldsw = (unsigned)wid * 1024u;
    const int aoff = lds_byte(wr * 64 + fr, fq * 8), boff = lds_byte(wc * 32 + fr, fq * 8);
#define PG8_SA(b, h) (((b) * 2 + (h)) * HTB)
#define PG8_SB(b, h) ((4 + (b) * 2 + (h)) * HTB)
#define PG8_STAGE(bufoff, gbase, voff) do { _Pragma("unroll") for (int _i = 0; _i < 2; ++_i) \
        __builtin_amdgcn_global_load_lds((const unsigned*)((const char*)(gbase) + (voff)[_i]), (LAS unsigned*)(lds + (bufoff) + ldsw + _i * 8192), 16, 0, 0); } while (0)
#define PG8_LDA(dst, b, h) do { _Pragma("unroll") for (int m = 0; m < 4; ++m) _Pragma("unroll") for (int k = 0; k < 2; ++k) dst[m][k] = *(const LAS bf16x8*)(lds + PG8_SA(b, h) + aoff + m * 2048 + k * 1024); } while (0)
#define PG8_LDB(dst, b, h) do { _Pragma("unroll") for (int n = 0; n < 2; ++n) _Pragma("unroll") for (int k = 0; k < 2; ++k) dst[n][k] = *(const LAS bf16x8*)(lds + PG8_SB(b, h) + boff + n * 2048 + k * 1024); } while (0)
#define PG8_MMA(ai, bj, At, Bt) do { __builtin_amdgcn_s_setprio(1); _Pragma("unroll") for (int m = 0; m < 4; ++m) _Pragma("unroll") for (int n = 0; n < 2; ++n) _Pragma("unroll") for (int k = 0; k < 2; ++k) \
        acc[ai][bj][m][n] = __builtin_amdgcn_mfma_f32_16x16x32_bf16(Bt[n][k], At[m][k], acc[ai][bj][m][n], 0, 0, 0); __builtin_amdgcn_s_setprio(0); } while (0)
#define PG8_WAIT_V(n) asm volatile("s_waitcnt vmcnt(" #n ")" ::: "memory")
#define PG8_WAIT_L(n) asm volatile("s_waitcnt lgkmcnt(" #n ")" ::: "memory")
#define PG8_BAR __builtin_amdgcn_s_barrier()
#define PG8_SCHED __builtin_amdgcn_sched_barrier(0)
#define PG8_UA(u) ((const char*)g.A + (size_t)(u).sub * g.a_sub + (size_t)(u).pm * tstepA)
#define PG8_UB(u) ((const char*)g.Bt + (size_t)(u).sub * g.b_sub + (size_t)(u).pn * tstepB)
    Unit cur, nxt; int ui = 0;
    if (!S.next(0, cur)) return;
    f32x4 acc[2][2][4][2];
#pragma unroll
    for (int a = 0; a < 2; ++a)
#pragma unroll
        for (int b = 0; b < 2; ++b)
#pragma unroll
            for (int m = 0; m < 4; ++m)
#pragma unroll
                for (int n = 0; n < 2; ++n) acc[a][b][m][n] = (f32x4){0.f, 0.f, 0.f, 0.f};
    bf16x8 At[4][2], B0[2][2], B1[2][2];
    const char* cA = PG8_UA(cur); const char* cB = PG8_UB(cur);
    PG8_STAGE(PG8_SB(0, 0), cB, voffB); PG8_STAGE(PG8_SB(0, 1), cB + hstepB, voffB); PG8_STAGE(PG8_SA(0, 0), cA, voffA); PG8_STAGE(PG8_SA(0, 1), cA + hstepA, voffA);
    if (wr == 1) PG8_BAR;
    PG8_WAIT_V(2); PG8_BAR;
    PG8_STAGE(PG8_SB(1, 0), cB + kstep, voffB); PG8_STAGE(PG8_SA(1, 0), cA + kstep, voffA); PG8_STAGE(PG8_SB(1, 1), cB + hstepB + kstep, voffB);
    PG8_WAIT_V(6); PG8_BAR;
    for (;;) {
        const bool has_next = S.next(ui + 1, nxt);
        const char* nA = has_next ? PG8_UA(nxt) : cA; const char* nB = has_next ? PG8_UB(nxt) : cB;
        for (int t = 0; t < nt; t += 2) {
            const bool last = (t == nt - 2);
            const char* a1 = cA + (size_t)(t + 1) * kstep;
            const char* a2 = last ? nA : cA + (size_t)(t + 2) * kstep; const char* b2 = last ? nB : cB + (size_t)(t + 2) * kstep;
            const char* a3 = a2 + kstep; const char* b3 = b2 + kstep;
            PG8_LDB(B0, 0, 0); PG8_LDB(B1, 0, 1); PG8_SCHED; PG8_LDA(At, 0, 0); PG8_STAGE(PG8_SA(1, 1), a1 + hstepA, voffA);
            PG8_WAIT_V(8); PG8_WAIT_L(0); PG8_BAR; PG8_MMA(0, 0, At, B0); PG8_MMA(0, 1, At, B1); PG8_BAR; PG8_SCHED;
            PG8_LDA(At, 0, 1); PG8_STAGE(PG8_SB(0, 0), b2, voffB); PG8_STAGE(PG8_SB(0, 1), b2 + hstepB, voffB); PG8_STAGE(PG8_SA(0, 0), a2, voffA);
            PG8_WAIT_V(8); PG8_WAIT_L(0); PG8_BAR; PG8_MMA(1, 0, At, B0); PG8_MMA(1, 1, At, B1); PG8_BAR; PG8_SCHED;
            PG8_LDB(B0, 1, 0); PG8_LDB(B1, 1, 1); PG8_SCHED; PG8_LDA(At, 1, 0); PG8_STAGE(PG8_SA(0, 1), a2 + hstepA, voffA);
            PG8_WAIT_V(8); PG8_WAIT_L(0); PG8_BAR; PG8_MMA(0, 0, At, B0); PG8_MMA(0, 1, At, B1); PG8_BAR; PG8_SCHED;
            PG8_LDA(At, 1, 1); PG8_STAGE(PG8_SB(1, 0), b3, voffB); PG8_STAGE(PG8_SB(1, 1), b3 + hstepB, voffB); PG8_STAGE(PG8_SA(1, 0), a3, voffA);
            PG8_WAIT_V(8); PG8_WAIT_L(0); PG8_BAR; PG8_MMA(1, 0, At, B0); PG8_MMA(1, 1, At, B1); PG8_BAR; PG8_SCHED;
        }
        if (wr == 0) PG8_BAR;
        { const int t2 = opq_tid(wv), w2 = __builtin_amdgcn_readfirstlane(t2 >> 6), l2 = t2 & 63; E(acc, cur, w2 >> 2, w2 & 3, l2 & 15, l2 >> 4); }
        if (!has_next) break;
#pragma unroll
        for (int a = 0; a < 2; ++a)
#pragma unroll
            for (int b = 0; b < 2; ++b)
#pragma unroll
                for (int m = 0; m < 4; ++m)
#pragma unroll
                    for (int n = 0; n < 2; ++n) acc[a][b][m][n] = (f32x4){0.f, 0.f, 0.f, 0.f};
        cur = nxt; cA = nA; cB = nB; ++ui;
        if (wr == 1) PG8_BAR;
    }
    PG8_WAIT_V(0);
    PG8_BAR;
#undef PG8_SA
#undef PG8_SB
#undef PG8_STAGE
#undef PG8_LDA
#undef PG8_LDB
#undef PG8_MMA
#undef PG8_WAIT_V
#undef PG8_WAIT_L
#undef PG8_BAR
#undef PG8_SCHED
#undef PG8_UA
#undef PG8_UB
}
}

namespace att {
constexpr float SCALE = 0.08838834764831845f;
constexpr float THR = 8.f;
constexpr int NW = 8, QBLK = 32, KVBLK = 64, QB = NW * QBLK, D = 128;
constexpr int SHM_V = KVBLK * D * 2, SHM_K = KVBLK * D * 2;
constexpr int ATT_LDS = 2 * SHM_V + 2 * SHM_K + NW * 64 * 4;
#define KSWZ(row, colB) ((row) * 256 + ((colB) ^ (((row) & 7) << 4)))
#define SBAR() __builtin_amdgcn_sched_barrier(0)
__device__ __forceinline__ int v_st(int k, int c) { const int kk = (k & ~0xC) | ((k & 4) << 1) | ((k & 8) >> 1); return ((kk >> 3) * 4 + (c >> 5)) * 512 + ((kk & 7) * 32 + (c & 31)) * 2; }
__device__ __forceinline__ int v_rd_base(int lane) { return ((lane & 3) << 3) | (((lane >> 2) & 3) << 6) | (((lane >> 4) & 1) << 5) | (((lane >> 5) & 1) << 8); }
constexpr int v_rd_off(int d0, int ks, int half) { return d0 * 512 + ks * 4096 + half * 2048; }
__device__ __forceinline__ int crow(int r, int hi) { return (r & 3) + 8 * (r >> 2) + 4 * hi; }
__device__ __forceinline__ bf16x8 load8(const bf16_t* p) { return *reinterpret_cast<const bf16x8*>(p); }
__device__ __forceinline__ void mask_tile(f32x16& p0, f32x16& p1, int dq) {
    const float NEG = -__builtin_inff();
#pragma unroll
    for (int r = 0; r < 16; ++r) {
        const int c = (r & 3) + 8 * (r >> 2);
        if (dq - c < 0) p0[r] = NEG;
        if (dq - c - 32 < 0) p1[r] = NEG;
    }
}
__device__ __forceinline__ void mask_all(f32x16& p0, f32x16& p1, bool off) {
    const float NEG = -__builtin_inff();
#pragma unroll
    for (int r = 0; r < 16; ++r) { p0[r] = off ? NEG : p0[r]; p1[r] = off ? NEG : p1[r]; }
}
__device__ __forceinline__ void partialSM(f32x16& p0, f32x16& p1, float& m_reg, float& mn, float& alpha, float rbias = 0.f) {
    float pmax = p0[0];
#pragma unroll
    for (int r = 1; r < 16; ++r) pmax = fmaxf(pmax, p0[r]);
#pragma unroll
    for (int r = 0; r < 16; ++r) pmax = fmaxf(pmax, p1[r]);
    { auto rr = __builtin_amdgcn_permlane32_swap(__float_as_uint(pmax), __float_as_uint(pmax), false, false);
      pmax = fmaxf(__uint_as_float(rr[0]), __uint_as_float(rr[1])); }
    constexpr float C2 = 1.4426950408889634f * SCALE;
    if (__builtin_expect(__all((pmax - m_reg) * SCALE <= THR), 1)) { mn = m_reg; alpha = 1.f; }
    else { mn = fmaxf(m_reg, pmax); alpha = __builtin_amdgcn_exp2f((m_reg - mn) * C2); m_reg = mn; }
    const float mnL = -mn * C2 + rbias;
#pragma unroll
    for (int r = 0; r < 16; ++r) p0[r] = fmaf(p0[r], C2, mnL);
#pragma unroll
    for (int r = 0; r < 16; ++r) p1[r] = fmaf(p1[r], C2, mnL);
#pragma unroll
    for (int r = 0; r < 16; ++r) p0[r] = __builtin_amdgcn_exp2f(p0[r]);
}
__device__ __forceinline__ void finishSM(f32x16& p0, f32x16& p1, float alpha, float& l_reg, bf16x8& pa0, bf16x8& pa1, bf16x8& pa2, bf16x8& pa3) {
#pragma unroll
    for (int r = 0; r < 16; ++r) p1[r] = __builtin_amdgcn_exp2f(p1[r]);
    float ps = 0;
#pragma unroll
    for (int r = 0; r < 16; ++r) ps += p0[r];
#pragma unroll
    for (int r = 0; r < 16; ++r) ps += p1[r];
    { auto rr = __builtin_amdgcn_permlane32_swap(__float_as_uint(ps), __float_as_uint(ps), false, false);
      ps = __uint_as_float(rr[0]) + __uint_as_float(rr[1]); }
    l_reg = l_reg * alpha + ps;
#define PK4(P, B_, OUT) do { unsigned a0 = cvt_pk_bf16(P[B_+0], P[B_+1]), a1 = cvt_pk_bf16(P[B_+2], P[B_+3]);                          \
        unsigned b0 = cvt_pk_bf16(P[B_+4], P[B_+5]), b1 = cvt_pk_bf16(P[B_+6], P[B_+7]);                                             \
        auto r0 = __builtin_amdgcn_permlane32_swap(a0, b0, false, false); auto r1 = __builtin_amdgcn_permlane32_swap(a1, b1, false, false); \
        u32x4 w = {r0[0], r1[0], r0[1], r1[1]}; OUT = *reinterpret_cast<bf16x8*>(&w); } while (0)
    PK4(p0, 0, pa0); PK4(p0, 8, pa1); PK4(p1, 0, pa2); PK4(p1, 8, pa3);
#undef PK4
}
template <int KB>
__device__ __forceinline__ void qkt(f32x16& p0, f32x16& p1, const char* K_lds, int r32, int hi, const bf16x8* qr) {
    p0 = f32x16{}; p1 = f32x16{};
    const char* kb[4];
#pragma unroll
    for (int dd = 0; dd < 4; ++dd) kb[dd] = K_lds + KB * SHM_K + KSWZ(r32, (dd * 16 + hi * 8) * 2);
#pragma unroll
    for (int d0 = 0; d0 < 8; ++d0) { const char* a = kb[d0 & 3] + (d0 >> 2) * 128;
        bf16x8 b0 = *reinterpret_cast<const bf16x8*>(a);
        bf16x8 b1 = *reinterpret_cast<const bf16x8*>(a + 32 * 256);
        p0 = __builtin_amdgcn_mfma_f32_32x32x16_bf16(b0, qr[d0], p0, 0, 0, 0);
        p1 = __builtin_amdgcn_mfma_f32_32x32x16_bf16(b1, qr[d0], p1, 0, 0, 0); }
}
template <int VB>
__device__ __forceinline__ void pv_tile(f32x16* o, int vb0, bf16x8 pa0, bf16x8 pa1, bf16x8 pa2, bf16x8 pa3) {
#define TRRD(dst, off) asm volatile("ds_read_b64_tr_b16 %0, %1 offset:%2" : "=&v"(dst) : "v"(vb0), "i"(off) : "memory")
#define PV_D0(d0) do { s16x4 l0, l1, l2, l3, h0, h1, h2, h3; constexpr int b_ = VB * SHM_V + v_rd_off(d0, 0, 0); \
        TRRD(l0, b_); TRRD(h0, b_ + 2048); TRRD(l1, b_ + 4096); TRRD(h1, b_ + 6144); TRRD(l2, b_ + 8192); TRRD(h2, b_ + 10240); TRRD(l3, b_ + 12288); TRRD(h3, b_ + 14336); \
        asm volatile("s_waitcnt lgkmcnt(0)" ::: "memory"); SBAR();   \
        o[d0] = __builtin_amdgcn_mfma_f32_32x32x16_bf16(pa0, (bf16x8){l0[0], l0[1], l0[2], l0[3], h0[0], h0[1], h0[2], h0[3]}, o[d0], 0, 0, 0);   \
        o[d0] = __builtin_amdgcn_mfma_f32_32x32x16_bf16(pa1, (bf16x8){l1[0], l1[1], l1[2], l1[3], h1[0], h1[1], h1[2], h1[3]}, o[d0], 0, 0, 0);   \
        o[d0] = __builtin_amdgcn_mfma_f32_32x32x16_bf16(pa2, (bf16x8){l2[0], l2[1], l2[2], l2[3], h2[0], h2[1], h2[2], h2[3]}, o[d0], 0, 0, 0);   \
        o[d0] = __builtin_amdgcn_mfma_f32_32x32x16_bf16(pa3, (bf16x8){l3[0], l3[1], l3[2], l3[3], h3[0], h3[1], h3[2], h3[3]}, o[d0], 0, 0, 0); } while (0)
    PV_D0(0); PV_D0(1); PV_D0(2); PV_D0(3);
#undef PV_D0
#undef TRRD
}

struct BlockRef { const bf16_t* Q; const bf16_t* K; const bf16_t* V; bf16_t* O; const bf16_t* Gt; const float* KM; int P0; };
struct Seam { bf16x8 qr[8]; bf16x8 st_v0, st_v1, st_k0, st_k1; };
#define ROW(p, k0, rr) ((p) + (size_t)((k0) + (rr)) * D + sc)
#define VMW() asm volatile("s_waitcnt vmcnt(0)" ::: "memory")
#define VMWN(n) asm volatile("s_waitcnt vmcnt(%0)" :: "i"(n) : "memory")
#define SLOAD_H(Kp, Vp, k0) do { S.st_v0 = load8(ROW(Vp, k0, sr)); S.st_v1 = load8(ROW(Vp, k0, 32 + sr));              \
                         S.st_k0 = load8(ROW(Kp, k0, sr)); S.st_k1 = load8(ROW(Kp, k0, 32 + sr)); } while (0)
#define SWRITE_HK(bf) do { *(bf16x8*)(K_lds + (bf) * SHM_K + kws) = S.st_k0; *(bf16x8*)(K_lds + (bf) * SHM_K + kws + 32 * 256) = S.st_k1; } while (0)
#define SWRITE_HV(bf) do { *(bf16x8*)(V_lds + (bf) * SHM_V + vst0) = S.st_v0; *(bf16x8*)(V_lds + (bf) * SHM_V + vst1) = S.st_v1; } while (0)
#define SWRITE_H(bf) do { SWRITE_HV(bf); SWRITE_HK(bf); } while (0)
__device__ __forceinline__ void moba_prime(const BlockRef& cur, char* lds, Seam& S, int wv) {
    const int tid = opq_tid(wv), wid = __builtin_amdgcn_readfirstlane(tid >> 6), lane = tid & 63, r32 = lane & 31, hi = lane >> 5;
    const int sr = tid >> 4, sc = (tid & 15) * 8, kws = KSWZ(sr, sc * 2); char* K_lds = lds + 2 * SHM_V;
#pragma unroll
    for (int d0 = 0; d0 < 8; ++d0) S.qr[d0] = load8(cur.Q + (size_t)(wid * QBLK + r32) * D + d0 * 16 + hi * 8);
    SLOAD_H(cur.K, cur.V, 0); VMW(); SWRITE_HK(0);
    __syncthreads();
}
__device__ __forceinline__ unsigned moba_select(const Seam& S, const float* KM, int qb, int hi) {
    if (qb <= 3) return (1u << qb) - 1u;
    float sc_[8];
#pragma unroll
    for (int j = 0; j < 8; ++j) sc_[j] = 0.f;
#pragma unroll
    for (int j = 0; j < 7; ++j) {
        if (j < qb) {
            float s = 0.f;
#pragma unroll
            for (int d0 = 0; d0 < 8; ++d0) {
                const f32x4 k0 = *(const f32x4*)(KM + j * D + d0 * 16 + hi * 8), k1 = *(const f32x4*)(KM + j * D + d0 * 16 + hi * 8 + 4);
                const bf16x8 q = S.qr[d0];
                s += bf1((bf16_t)q[0]) * k0[0] + bf1((bf16_t)q[1]) * k0[1] + bf1((bf16_t)q[2]) * k0[2] + bf1((bf16_t)q[3]) * k0[3]
                   + bf1((bf16_t)q[4]) * k1[0] + bf1((bf16_t)q[5]) * k1[1] + bf1((bf16_t)q[6]) * k1[2] + bf1((bf16_t)q[7]) * k1[3];
            }
            s += __shfl_xor(s, 32);
            sc_[j] = s;
        }
    }
    unsigned sel = 0u;
#pragma unroll
    for (int it = 0; it < 3; ++it) {
        float best = -__builtin_inff(); int bi = 0;
#pragma unroll
        for (int j = 0; j < 7; ++j) { const bool ok = (j < qb) && !((sel >> j) & 1u) && (sc_[j] > best); best = ok ? sc_[j] : best; bi = ok ? j : bi; }
        sel |= 1u << bi;
    }
    return sel;
}
__device__ __forceinline__ void moba_block(const BlockRef& cur, const BlockRef& nxt, char* lds, Seam& S, int wv) {
    const int tid = opq_tid(wv), wid = __builtin_amdgcn_readfirstlane(tid >> 6), lane = tid & 63, r32 = lane & 31, hi = lane >> 5;
    const int NT = cur.P0 / KVBLK + 4;
    const int qb = cur.P0 >> 8;
    const int qlo = cur.P0 + wid * QBLK, qm = qlo + r32 - 4 * hi;
    char* V_lds = lds; char* K_lds = lds + 2 * SHM_V;
    float* ws = (float*)(lds + 2 * SHM_V + 2 * SHM_K) + wid * 64; float* li_l = ws, * al_l = ws + 32;
    float m_reg = -1e30f, l_reg = 0; f32x16 o[4] = {};
    const int sr = tid >> 4, sc = (tid & 15) * 8, vst0 = v_st(sr, sc), vst1 = v_st(32 + sr, sc), kws = KSWZ(sr, sc * 2);
    const int vb0 = (int)(uintptr_t)V_lds + v_rd_base(lane);
    const bf16_t* Kh = cur.K; const bf16_t* Vh = cur.V;
    const bool need_sel = qb > 3;
    const float* kml = (const float*)(lds + 69632);
    if (need_sel) { if (tid < 224) ((f32x4*)(lds + 69632))[tid] = ((const f32x4*)cur.KM)[tid]; __syncthreads(); }
    const unsigned sel = moba_select(S, kml, qb, hi);
#define RESC(a) do { if (__any((a) < 1.f)) { if (hi == 0) al_l[r32] = (a); asm volatile("s_waitcnt lgkmcnt(0)" ::: "memory");              \
                     for (int d_ = 0; d_ < 4; ++d_) for (int r = 0; r < 16; ++r) o[d_][r] *= al_l[crow(r, hi)]; } } while (0)
#define KBASE(t) ((t) * KVBLK)
#define MASKT(P0_, P1_, t) do { const int kb_ = KBASE(t); rb_ = 0.f; \
        if (kb_ < cur.P0) { if (need_sel) rb_ = (((sel >> (kb_ >> 8)) & 1u) == 0u) ? -__builtin_inff() : 0.f; } \
        else if (kb_ + KVBLK - 1 > qlo) mask_tile(P0_, P1_, qm - kb_); } while (0)
#define SEAM_K0() do { VMWN(8); SWRITE_HK(0); SBAR(); } while (0)
    f32x16 pA0, pA1, pB0, pB1; float mnA, mnB, alA, alB, rb_ = 0.f; bf16x8 pa0, pa1, pa2, pa3;
    SWRITE_HV(0); SBAR();
    SLOAD_H(Kh, Vh, KBASE(1));
    SBAR(); qkt<0>(pA0, pA1, K_lds, r32, hi, S.qr);
    MASKT(pA0, pA1, 0); partialSM(pA0, pA1, m_reg, mnA, alA, rb_);
    VMW(); SWRITE_H(1);
    __syncthreads();
#define HALF_STEP(PX0, PX1, mnX, alX, PY0, PY1, alY, t, KB, VB, SB) do {                                                      \
        SBAR(); qkt<KB>(PX0, PX1, K_lds, r32, hi, S.qr);                                                                       \
        finishSM(PY0, PY1, alY, l_reg, pa0, pa1, pa2, pa3); SBAR();                                                           \
        if ((t) + 1 < NT) { SLOAD_H(Kh, Vh, KBASE((t) + 1)); SBAR(); }                                                        \
        pv_tile<VB>(o, vb0, pa0, pa1, pa2, pa3); MASKT(PX0, PX1, (t)); partialSM(PX0, PX1, m_reg, mnX, alX, rb_);                  \
        __syncthreads();                                                                                                      \
        if ((t) + 1 < NT) { VMW(); SWRITE_H(SB); }                                                                            \
        RESC(alX); __syncthreads(); } while (0)
    for (int t = 1; t + 1 < NT; t += 2) {
        HALF_STEP(pB0, pB1, mnB, alB, pA0, pA1, alA, t, 1, 0, 0);
        HALF_STEP(pA0, pA1, mnA, alA, pB0, pB1, alB, t + 1, 0, 1, 1);
    }
    SBAR(); qkt<1>(pB0, pB1, K_lds, r32, hi, S.qr); SBAR();
    SLOAD_H(nxt.K, nxt.V, 0); SBAR();
#pragma unroll
    for (int d0 = 0; d0 < 8; ++d0) S.qr[d0] = load8(nxt.Q + (size_t)(wid * QBLK + r32) * D + d0 * 16 + hi * 8);
    SBAR();
    finishSM(pA0, pA1, alA, l_reg, pa0, pa1, pa2, pa3); SBAR();
    pv_tile<0>(o, vb0, pa0, pa1, pa2, pa3);
    MASKT(pB0, pB1, NT - 1); partialSM(pB0, pB1, m_reg, mnB, alB, rb_); __syncthreads(); RESC(alB);
    finishSM(pB0, pB1, alB, l_reg, pa0, pa1, pa2, pa3); SBAR(); pv_tile<1>(o, vb0, pa0, pa1, pa2, pa3);
    SBAR(); SEAM_K0();
    if (hi == 0) li_l[r32] = l_reg; asm volatile("s_waitcnt lgkmcnt(0)" ::: "memory");
    bf16_t* Ow = cur.O + (size_t)(wid * QBLK) * DM; const bf16_t* Gw = cur.Gt + (size_t)(wid * QBLK) * DM + r32;
    bf16_t gl[16][4];
#pragma unroll
    for (int r = 0; r < 16; ++r)
#pragma unroll
        for (int d0 = 0; d0 < 4; ++d0) gl[r][d0] = Gw[(size_t)crow(r, hi) * DM + d0 * 32];
#pragma unroll
    for (int r = 0; r < 16; ++r) { const int orow = crow(r, hi); const float rl = __builtin_amdgcn_rcpf(li_l[orow]);
#pragma unroll
        for (int d0 = 0; d0 < 4; ++d0) { const float gv = bf1(gl[r][d0]);
            const float v = o[d0][r] * rl * gv;
            const float vn = __shfl_xor(v, 1);
            if ((r32 & 1) == 0) *(unsigned*)(Ow + (size_t)orow * DM + d0 * 32 + r32) = cvt_pk_bf16(v, vn); } }
    __syncthreads();
#undef RESC
#undef KBASE
#undef MASKT
#undef SEAM_K0
#undef HALF_STEP
}
#undef ROW
#undef VMW
#undef VMWN
#undef SLOAD_H
#undef SWRITE_HK
#undef SWRITE_HV
#undef SWRITE_H

__device__ __forceinline__ BlockRef mk_ref(int L, int pass, const bf16_t* Q, const bf16_t* K, const bf16_t* V, bf16_t* O, const bf16_t* Gt, const float* KM) {
    const int bh = L >> 2, x = L & 3, qb = pass ? 7 - x : x, b = bh >> 3, h = bh & 7;
    BlockRef r;
    r.Q = Q + ((size_t)bh * SEQ + (size_t)qb * QB) * D; r.K = K + (size_t)bh * SEQ * D; r.V = V + (size_t)bh * SEQ * D;
    r.O = O + ((size_t)b * SEQ + (size_t)qb * QB) * DM + h * DH; r.Gt = Gt + ((size_t)b * SEQ + (size_t)qb * QB) * DM + h * DH;
    r.KM = KM + (size_t)bh * 8 * D; r.P0 = qb * QB;
    return r;
}
__device__ __forceinline__ void attn_phase(char* lds, const bf16_t* Q, const bf16_t* K, const bf16_t* V, bf16_t* O, const bf16_t* Gt, const float* KM, int wv) {
    const int total = NB * NH * 4, stride = gridDim.x;
    int L = opq_bid(); if (L >= total) return;
    if (stride == 256) { const int xcd = L & 7, j = L >> 3; L = ((xcd * 8 + (j >> 2)) << 2) | (j & 3); }
    int pass = 0;
    BlockRef cur = mk_ref(L, 0, Q, K, V, O, Gt, KM);
    Seam S;
    moba_prime(cur, lds, S, wv);
    for (;;) {
        const bool more_pass = pass == 0, more_item = L + stride < total, last = !more_pass && !more_item;
        int passn = pass + 1, Ln = L;
        if (!more_pass) { passn = 0; Ln = more_item ? L + stride : L; }
        const BlockRef nxt = last ? cur : mk_ref(Ln, passn, Q, K, V, O, Gt, KM);
        moba_block(cur, nxt, lds, S, wv);
        if (last) break;
        cur = nxt; pass = passn; L = Ln;
    }
}
}

#ifndef REP_MASK
#define REP_MASK 0
#endif
#ifndef BAR_REP
#define BAR_REP 1
#endif
struct Args { const float* in[21]; float* out; unsigned char* ws; int ph_lo, ph_hi; };
typedef const __attribute__((address_space(4))) Args* ArgsP;
#define AIN(i) ((const float*)ap->in[i])

__device__ __forceinline__ void transpose_item(const float* W, int ldw, bf16_t* WT, int ldt, LAS float* scr, int lane) {
    float tv[32];
#pragma unroll
    for (int i = 0; i < 32; ++i) { const int kk = 2 * i + (lane >> 5); tv[i] = W[(size_t)kk * ldw + (lane & 31)]; }
#pragma unroll
    for (int i = 0; i < 32; ++i) { const int kk = 2 * i + (lane >> 5); scr[kk * 33 + (lane & 31)] = tv[i]; }
    asm volatile("s_waitcnt lgkmcnt(0)" ::: "memory");
    const int c = lane & 7;
#pragma unroll
    for (int j = 0; j < 4; ++j) { const int n = (lane >> 3) + 8 * j; const LAS float* s = scr + (8 * c) * 33 + n;
        u32x4 o; o.x = cvt_pk_bf16(s[0 * 33], s[1 * 33]); o.y = cvt_pk_bf16(s[2 * 33], s[3 * 33]); o.z = cvt_pk_bf16(s[4 * 33], s[5 * 33]); o.w = cvt_pk_bf16(s[6 * 33], s[7 * 33]);
        *(u32x4*)(WT + (size_t)n * ldt + 8 * c) = o; }
    asm volatile("s_waitcnt lgkmcnt(0)" ::: "memory");
}
__device__ __forceinline__ void transpose_mat(const float* W, int K, int N, bf16_t* WT, int item, LAS float* scr, int lane) {
    const int nblk = N / 32, kb = item / nblk, nb = item % nblk;
    transpose_item(W + (size_t)(64 * kb) * N + 32 * nb, N, WT + (size_t)(32 * nb) * K + 64 * kb, K, scr, lane);
}

template <bool SILU>
__device__ __forceinline__ void gemv_item(const float* vec, int vld, const float* W, int ldw, int n0, int k0, float* out, int old, const float* bias, LAS float* scr, int lane) {
    const float* wp = W + (size_t)k0 * ldw + n0 + lane;
#pragma unroll
    for (int i = 0; i < 8; ++i) { const int idx = i * 64 + lane, b = idx >> 6, kk = idx & 63; const float v = vec[(size_t)b * vld + k0 + kk]; scr[kk * 8 + b] = SILU ? fsilu(v) : v; }
    asm volatile("s_waitcnt lgkmcnt(0)" ::: "memory");
    float acc[8];
#pragma unroll
    for (int b = 0; b < 8; ++b) acc[b] = 0.f;
#pragma unroll 1
    for (int kh = 0; kh < 64; kh += 32) {
        float w[32];
#pragma unroll
        for (int kk = 0; kk < 32; ++kk) w[kk] = wp[(size_t)(kh + kk) * ldw];
#pragma unroll
        for (int kk = 0; kk < 32; ++kk) {
            const f32x4 c0 = *(const LAS f32x4*)(scr + (kh + kk) * 8), c1 = *(const LAS f32x4*)(scr + (kh + kk) * 8 + 4);
            acc[0] += w[kk] * c0[0]; acc[1] += w[kk] * c0[1]; acc[2] += w[kk] * c0[2]; acc[3] += w[kk] * c0[3];
            acc[4] += w[kk] * c1[0]; acc[5] += w[kk] * c1[1]; acc[6] += w[kk] * c1[2]; acc[7] += w[kk] * c1[3];
            if ((kk & 3) == 3) __builtin_amdgcn_sched_barrier(0); }
    }
    const float bv = bias ? bias[n0 + lane] : 0.f;
#pragma unroll
    for (int b = 0; b < 8; ++b) atomicAdd(out + (size_t)b * old + n0 + lane, acc[b] + bv);
    asm volatile("s_waitcnt lgkmcnt(0)" ::: "memory");
}
__device__ __forceinline__ void prep0_phase(ArgsP ap, LAS unsigned char* lds, int wave, int lane) {
    unsigned char* ws = (unsigned char*)ap->ws;
    LAS float* scr = (LAS float*)(lds + wave * 16384);
    const int gw = opq_bid() * NWAVES + wave, NGW = gridDim.x * NWAVES;
    for (int r = gw; r < (MODV_LD / 64) * 16; r += NGW) {
        const int cgp = r >> 4, kc = r & 15;
        const float* W; int ldw, n0; const float* bias;
        if (cgp < 192) { const int l = cgp / 48; n0 = (cgp % 48) * 64; W = AIN(2) + (size_t)l * DM * 3 * DM; ldw = 3 * DM; bias = AIN(3) + l * 3 * DM; }
        else { n0 = (cgp - 192) * 64; W = AIN(15); ldw = 2 * DM; bias = AIN(16); }
        gemv_item<true>(AIN(1), DM, W, ldw, n0, kc * 64, (float*)(ws + WS_MODV) + (cgp * 64 - n0), MODV_LD, kc == 0 ? bias : nullptr, scr, lane);
    }
}
__device__ __forceinline__ void prep1_phase(ArgsP ap, LAS unsigned char* lds, int wave, int lane) {
    unsigned char* ws = (unsigned char*)ap->ws;
    LAS float* scr = (LAS float*)(lds + wave * 16384);
    const int gw = opq_bid() * NWAVES + wave, NGW = gridDim.x * NWAVES;
    constexpr int I_BIG = (DM / 64) * (2 * DM / 32);
    constexpr int I_SQ = (DM / 64) * (DM / 32);
    constexpr int I_G = (256 / 64) * (256 / 32);
    constexpr int N_T = 2 * I_BIG + 2 * I_SQ + 2 * I_BIG + I_BIG + 2 * I_SQ + 16 * I_G;
    constexpr int N_GEMV = 4 * 32 * 16;
    for (int it = gw; it < N_T + N_GEMV; it += NGW) {
        int r = it;
        if (r < N_GEMV) {
            const int slot = r >> 9, q = r & 511, cgp = q >> 4, kc = q & 15;
            const size_t woff = slot == 0 ? (size_t)DM * 2 * DM : slot == 3 ? (size_t)DM * 2 * DM : 0;
            const float* W = (slot == 0 ? AIN(5) : slot == 2 ? AIN(17) : AIN(18)) + woff;
            const int shcol = slot == 0 ? 1 * 3 * DM : slot == 1 ? 2 * 3 * DM : slot == 2 ? 4 * 3 * DM : 3 * 3 * DM;
            gemv_item<false>((const float*)(ws + WS_MODV) + shcol, MODV_LD, W, 2 * DM, cgp * 64, kc * 64, (float*)(ws + WS_SHW) + (size_t)slot * 8 * 2 * DM, 2 * DM, nullptr, scr, lane);
            continue;
        } r -= N_GEMV;
        const float* W; bf16_t* WT; int ldw, ldt;
        if (r < 6 * I_BIG + 0 * I_SQ && r < 2 * I_BIG) { const int l = r / I_BIG, item = r % I_BIG, kb = item / 64, nb = item % 64;
            W = AIN(5) + (size_t)l * DM * 2 * DM + (size_t)(64 * kb) * 2 * DM + 32 * nb; ldw = 2 * DM; WT = (bf16_t*)(ws + WS_WIN) + (size_t)l * 2 * DM * DM + (size_t)(32 * nb) * DM + 64 * kb; ldt = DM; }
        else if ((r -= 2 * I_BIG) < 2 * I_SQ) { const int l = r / I_SQ, item = r % I_SQ, kb = item / 32, nb = item % 32;
            W = AIN(13) + (size_t)l * DM * DM + (size_t)(64 * kb) * DM + 32 * nb; ldw = DM; WT = (bf16_t*)(ws + WS_WOUT) + (size_t)l * DM * DM + (size_t)(32 * nb) * DM + 64 * kb; ldt = DM; }
        else if ((r -= 2 * I_SQ) < 2 * I_BIG) { const int l = r / I_BIG, item = r % I_BIG, kb = item / 64, nb = item % 64;
            W = AIN(18) + (size_t)l * DM * 2 * DM + (size_t)(64 * kb) * 2 * DM + 32 * nb; ldw = 2 * DM; WT = (bf16_t*)(ws + (l ? WS_ATTIN1 : WS_ATTIN0)) + (size_t)(32 * nb) * DM + 64 * kb; ldt = DM; }
        else if ((r -= 2 * I_BIG) < I_BIG) { const int kb = r / 64, nb = r % 64;
            W = AIN(17) + (size_t)(64 * kb) * 2 * DM + 32 * nb; ldw = 2 * DM; WT = (bf16_t*)(ws + WS_WKV) + (size_t)(32 * nb) * DM + 64 * kb; ldt = DM; }
        else if ((r -= I_BIG) < 2 * I_SQ) { const int l = r / I_SQ, item = r % I_SQ, kb = item / 32, nb = item % 32;
            W = AIN(19) + (size_t)l * DM * DM + (size_t)(64 * kb) * DM + 32 * nb; ldw = DM; WT = (bf16_t*)(ws + WS_ATTOUT) + (size_t)l * DM * DM + (size_t)(32 * nb) * DM + 64 * kb; ldt = DM; }
        else { r -= 2 * I_SQ;
            const int mat = r / I_G, item = r % I_G, which = mat >> 3, lh = mat & 7;
            const int kb = item / 8, nb = item % 8, n0 = 32 * nb, drow = 256 * (n0 >> 7) + 128 * which + (n0 & 127);
            W = (which ? AIN(10) : AIN(8)) + (size_t)lh * 256 * 256 + (size_t)(64 * kb) * 256 + n0; ldw = 256;
            WT = (bf16_t*)(ws + WS_WG) + (size_t)lh * 512 * 256 + (size_t)drow * 256 + 64 * kb; ldt = 256; }
        transpose_item(W, ldw, WT, ldt, scr, lane);
    }
}

__device__ __forceinline__ void norm_phase(const float* xin, bf16_t* o1, const float* g1, const float* modv, int sh1, int sc1c,
                                            bf16_t* o2, const float* g2, int sh2, int sc2c, int wave, int lane) {
    const int gw = opq_bid() * NWAVES + wave, NGW = gridDim.x * NWAVES;
    for (int rb = gw; rb < MTOK / 8; rb += NGW) {
        const int r0 = rb * 8, b = r0 / SEQ;
        const float* mv = modv + (size_t)b * MODV_LD;
        f32x4 gs1[4], sf1[4], gs2[4], sf2[4];
#pragma unroll
        for (int j = 0; j < 4; ++j) { const int idx = 4 * lane + 256 * j;
            const f32x4 gv = *(const f32x4*)(g1 + idx), sc = *(const f32x4*)(mv + sc1c + idx); gs1[j] = gv * (sc + 1.f); sf1[j] = *(const f32x4*)(mv + sh1 + idx);
            if (o2) { const f32x4 gv2 = *(const f32x4*)(g2 + idx), sc2 = *(const f32x4*)(mv + sc2c + idx); gs2[j] = gv2 * (sc2 + 1.f); sf2[j] = *(const f32x4*)(mv + sh2 + idx); }
            else { gs2[j] = gs1[j]; sf2[j] = sf1[j]; } }
        for (int rr = 0; rr < 8; ++rr) {
            const size_t row = (size_t)(r0 + rr);
            const f32x4* xr = (const f32x4*)(xin + row * DM) + lane;
            f32x4 v[4]; float s = 0.f;
#pragma unroll
            for (int j = 0; j < 4; ++j) { v[j] = xr[64 * j]; s += (v[j].x * v[j].x + v[j].y * v[j].y) + (v[j].z * v[j].z + v[j].w * v[j].w); }
            const float rstd = 1.f / sqrtf(wave_sum(s) * (1.f / DM) + EPS);
#pragma unroll
            for (int j = 0; j < 4; ++j) { const f32x4 t = v[j] * rstd; const f32x4 y = t * gs1[j] + sf1[j];
                u32x2 w; w.x = cvt_pk_bf16(y.x, y.y); w.y = cvt_pk_bf16(y.z, y.w);
                *((u32x2*)(o1 + row * DM) + lane + 64 * j) = w;
                if (o2) { const f32x4 y2 = t * gs2[j] + sf2[j]; u32x2 w2; w2.x = cvt_pk_bf16(y2.x, y2.y); w2.y = cvt_pk_bf16(y2.z, y2.w);
                    *((u32x2*)(o2 + row * DM) + lane + 64 * j) = w2; } }
        }
    }
}
__device__ __forceinline__ void conv_phase(const bf16_t* UP, bf16_t* U, const float* cw, const float* cb, int tid) {
    const int ch = 8 * (tid & 127), sub = tid >> 7;
    float w0[8], w1[8], w2[8], w3[8], bb[8];
#pragma unroll
    for (int h = 0; h < 2; ++h) { const f32x4 a = *(const f32x4*)(cw + ch + 4 * h), b = *(const f32x4*)(cw + DM + ch + 4 * h), c = *(const f32x4*)(cw + 2 * DM + ch + 4 * h), d = *(const f32x4*)(cw + 3 * DM + ch + 4 * h), e = *(const f32x4*)(cb + ch + 4 * h);
#pragma unroll
        for (int j = 0; j < 4; ++j) { w0[4 * h + j] = a[j]; w1[4 * h + j] = b[j]; w2[4 * h + j] = c[j]; w3[4 * h + j] = d[j]; bb[4 * h + j] = e[j]; } }
    for (int it = opq_bid(); it < NB * 32; it += gridDim.x) {
        const int b = it >> 5, c = it & 31, t0 = c * 64 + sub * 16; const size_t base = ((size_t)b * SEQ + t0) * DM + ch;
        u32x4 rw[19];
#pragma unroll
        for (int t = 0; t < 19; ++t) rw[t] = (t0 + t - 3 >= 0) ? *(const u32x4*)(UP + base + (ptrdiff_t)(t - 3) * DM) : (u32x4){0u, 0u, 0u, 0u};
#pragma unroll
        for (int t = 0; t < 16; ++t) {
            unsigned ow[4];
#pragma unroll
            for (int q = 0; q < 4; ++q) { const unsigned a0 = rw[t][q], a1 = rw[t + 1][q], a2 = rw[t + 2][q], a3 = rw[t + 3][q];
                const float lo = bb[2 * q] + w0[2 * q] * bf_lo(a0) + w1[2 * q] * bf_lo(a1) + w2[2 * q] * bf_lo(a2) + w3[2 * q] * bf_lo(a3);
                const float hi = bb[2 * q + 1] + w0[2 * q + 1] * bf_hi(a0) + w1[2 * q + 1] * bf_hi(a1) + w2[2 * q + 1] * bf_hi(a2) + w3[2 * q + 1] * bf_hi(a3);
                ow[q] = cvt_pk_bf16(lo, hi); }
            *(u32x4*)(U + base + (size_t)t * DM) = (u32x4){ow[0], ow[1], ow[2], ow[3]}; }
    }
}

#define XB_TMO      128
#define XB_XCNT(j)  (256  + 64 * (j))
#define XB_XSUB(j)  (1280 + 64 * (j))
#define XB_XGEN(j)  (2304 + 64 * (j))
#define XB_TOP      3328
#define XB_TOPGEN   3392
#define XCD_BAR_WORDS 3456
#define XB_SPIN_CAP (1u << 18)
constexpr size_t WS_BAR = 16384;
constexpr int LDS_MISC = 131072 + 320;
__device__ __forceinline__ unsigned xb_ld(unsigned* p)              { return __hip_atomic_load(p, __ATOMIC_RELAXED, __HIP_MEMORY_SCOPE_AGENT); }
__device__ __forceinline__ unsigned xb_add(unsigned* p, unsigned v) { return __hip_atomic_fetch_add(p, v, __ATOMIC_RELAXED, __HIP_MEMORY_SCOPE_AGENT); }
__device__ __forceinline__ unsigned xb_xcc_id() { return (unsigned)__builtin_amdgcn_s_getreg((3 << 11) | 20) & 0xFu; }
#define XB_SPIN(cond, bar) do { unsigned _sp = 0; while (cond) { __builtin_amdgcn_s_sleep(1); \
    if ((++_sp & 255u) == 0u) { if (xb_ld(&(bar)[XB_TMO])) break; if (_sp > XB_SPIN_CAP) { atomicAdd(&(bar)[XB_TMO], 1u); break; } } } } while (0)
__device__ __forceinline__ void xcd_barrier_complete(unsigned* bar, unsigned x, unsigned& nloc, unsigned& nx) {
    const unsigned G = gridDim.x * gridDim.y * gridDim.z;
    unsigned sum, cnt, mine, sp = 0u;
    for (;;) {
        sum = 0u; cnt = 0u; mine = 0u;
#pragma unroll
        for (unsigned j = 0; j < 16; ++j) { const unsigned c = xb_ld(&bar[XB_XCNT(j)]); sum += c; cnt += (c > 0u) ? 1u : 0u; mine = (j == x) ? c : mine; }
        if (sum == G) break;
        __builtin_amdgcn_s_sleep(1);
        if ((++sp & 255u) == 0u) { if (xb_ld(&bar[XB_TMO])) break; if (sp > XB_SPIN_CAP) { atomicAdd(&bar[XB_TMO], 1u); break; } }
    }
    nloc = mine > 0u ? mine : 1u; nx = cnt > 0u ? cnt : 1u;
}
__device__ __forceinline__ void xcd_barrier(unsigned* bar, volatile LAS unsigned* st, int tid) {
    asm volatile("s_waitcnt vmcnt(0)" ::: "memory");
    __syncthreads();
    if (tid == 0) {
        const unsigned x = xb_xcc_id();
        __builtin_amdgcn_s_waitcnt(0);
        unsigned nloc = st[0], nx = st[1];
        if (nloc == 0u) { xcd_barrier_complete(bar, x, nloc, nx); st[0] = nloc; st[1] = nx; }
        const unsigned old = xb_add(&bar[XB_XSUB(x)], 1u);
        const unsigned gen = old / nloc;
        if (old + 1u == (gen + 1u) * nloc) {
            __builtin_amdgcn_fence(__ATOMIC_RELEASE, "agent");
            asm volatile("s_waitcnt vmcnt(0)" ::: "memory");
            const unsigned og = xb_add(&bar[XB_TOP], 1u);
            const unsigned tg = og / nx;
            if (og + 1u == (tg + 1u) * nx) xb_add(&bar[XB_TOPGEN], 1u);
            else XB_SPIN(xb_ld(&bar[XB_TOPGEN]) == tg, bar);
            __builtin_amdgcn_fence(__ATOMIC_ACQUIRE, "agent");
            xb_add(&bar[XB_XGEN(x)], 1u);
            asm volatile("s_waitcnt vmcnt(0)" ::: "memory");
        } else {
            XB_SPIN(xb_ld(&bar[XB_XGEN(x)]) == gen, bar);
            __builtin_amdgcn_fence(__ATOMIC_ACQUIRE, "agent");
            asm volatile("s_waitcnt vmcnt(0)" ::: "memory");
        }
    }
    __syncthreads();
}

constexpr int NPHASE = 14;
#ifndef PH_EN
#define PH_EN 0xFFFF
#endif
#define EN(b) ((PH_EN >> (b)) & 1)
#ifndef REP_MASK
#define REP_MASK 0
#endif
#define REPS(b) for (int rep_ = 0; rep_ < EN(b) * (1 + ((REP_MASK >> (b)) & 1)); ++rep_)
template <int ph>
__device__ __forceinline__ void run_phase(unsigned char* lds, int wv) {
    LAS unsigned char* ldsl = (LAS unsigned char*)lds;
    {
        ArgsP ap = (ArgsP)__builtin_amdgcn_kernarg_segment_ptr();
        asm volatile("" : "+s"(ap));
        const int G = gridDim.x;
        unsigned char* ws = (unsigned char*)ap->ws;
        float* modv = (float*)(ws + WS_MODV);
        float* kmean = (float*)(ws + WS_KMEAN);
        bf16_t* HN = (bf16_t*)(ws + WS_HN); bf16_t* HKV = (bf16_t*)(ws + WS_HKV); bf16_t* UPRE = (bf16_t*)(ws + WS_UPRE); bf16_t* GB = (bf16_t*)(ws + WS_G);
        bf16_t* LAb = (bf16_t*)(ws + WS_LA); bf16_t* BINb = (bf16_t*)(ws + WS_BIN);
        float* xw = (float*)ap->out;
        const int tid = opq_tid(wv), c = opq_bid();
        const int lane = tid & 63, wave = __builtin_amdgcn_readfirstlane(tid >> 6);
        float* sumsq = (float*)(ws + WS_SUMSQ); const float* shw = (const float*)(ws + WS_SHW);
        if (ph == 0) {
            if (EN(0)) prep0_phase(ap, ldsl, wave, lane);
        } else if (ph == 1) {
            REPS(1) norm_phase(AIN(0), HN, AIN(4), modv, 0, DM, nullptr, nullptr, 0, 0, wave, lane);
            if (EN(0)) prep1_phase(ap, ldsl, wave, lane);
        } else if (ph <= 7) {
            const int l = (ph - 2) / 3, k3 = (ph - 2) % 3, k = k3 == 0 ? 0 : k3 + 1;
            const float* xin = (l == 0) ? AIN(0) : xw;
            if (k == 0) {
                pg8::Gemm g{l == 0 ? HN : HKV, (const bf16_t*)(ws + WS_WIN) + (size_t)l * 2 * DM * DM, DM, DM, DM, 0, 0};
                int one = 1; asm volatile("" : "+s"(one));
                { pg8::InOrder S{c, one, 0};
                  pg8::EpiSplitConv E{ws, l == 0 ? nullptr : sumsq, shw, AIN(6) + l * 4 * DM, AIN(7) + l * DM, 4u * (unsigned)(l + 1), ldsl};
                  REPS(2) pg8::gemm_phase(ldsl, g, S, E, wv); }
                { pg8::InOrder S{c, one, 1};
                  pg8::EpiSplit E{UPRE, GB, l == 0 ? nullptr : sumsq, shw};
                  REPS(2) pg8::gemm_phase(ldsl, g, S, E, wv); }
            } else if (k == 1) {
                REPS(3) conv_phase(UPRE, HKV, AIN(6) + l * 4 * DM, AIN(7) + l * DM, tid);
            } else if (k == 2) {
                pg8::Gemm g{UPRE, (const bf16_t*)(ws + WS_WG) + (size_t)l * 4 * 512 * 256, DM, 256, 256, 256 * 2, 512 * 256 * 2};
                int two = 2; asm volatile("" : "+s"(two));
                pg8::GatesOrder S{c, two};
                pg8::EpiGatesS E{ws, 4u * (unsigned)(l + 1), AIN(9) + l * DM, AIN(11) + l * DM, AIN(12) + l * DM, ldsl};
                REPS(4) pg8::gemm_phase(ldsl, g, S, E, wv);
            } else {
                pg8::Gemm g{HN, (const bf16_t*)(ws + WS_WOUT) + (size_t)l * DM * DM, DM, DM, DM, 0, 0};
                pg8::MultiOrder S; S.init(MTOK, DM, 1, G, c);
                _Float16* x16 = (_Float16*)(ws + WS_X16);
                if (l == 0) { pg8::EpiResH<float, false> E{AIN(0), x16, modv + 2 * DM, modv, HKV, AIN(4) + DM, 3 * DM + DM, nullptr, nullptr, 0, sumsq};
                    REPS(7) pg8::gemm_phase(ldsl, g, S, E, wv); }
                else { pg8::EpiResH<_Float16, true> E{x16, x16, modv + l * 3 * DM + 2 * DM, modv, HKV, AIN(4) + (l + 1) * DM, (l + 1) * 3 * DM + DM,
                              LAb, AIN(14), 4 * 3 * DM + DM, sumsq + (size_t)l * MTOK};
                    REPS(7) pg8::gemm_phase(ldsl, g, S, E, wv); }
            }
        } else if (ph <= 13) {
            const int i = (ph - 8) / 3, k = (ph - 8) % 3, l = 2 + i;
            if (k == 0) {
                pg8::Gemm g{i == 0 ? HKV : LAb, (const bf16_t*)(ws + (i == 0 ? WS_ATTIN0 : WS_ATTIN1)), DM, DM, DM, (long)(WS_LA - WS_HKV), (long)(WS_WKV - WS_ATTIN0)};
                pg8::MultiOrder S; S.init(MTOK, 2 * DM, i == 0 ? 2 : 1, G, c);
                pg8::EpiQKV E{ws, kmean, sumsq + (size_t)(1 + i) * MTOK, shw + (size_t)(i == 0 ? 1 : 3) * 8 * 2 * DM, 8 * 2 * DM};
                REPS(9) pg8::gemm_phase(ldsl, g, S, E, wv);
            } else if (k == 1) {
                REPS(10) att::attn_phase((char*)lds, UPRE, HN, BINb, HKV, GB, kmean, wv);
            } else if (i == 0) {
                pg8::Gemm g{HKV, (const bf16_t*)(ws + WS_ATTOUT), DM, DM, DM, 0, 0};
                pg8::MultiOrder S; S.init(MTOK, DM, 1, G, c);
                _Float16* x16 = (_Float16*)(ws + WS_X16);
                pg8::EpiResH<_Float16, false> E{x16, x16, modv + l * 3 * DM + 2 * DM, modv, LAb, AIN(4) + 3 * DM, 3 * 3 * DM + DM, nullptr, nullptr, 0, sumsq + (size_t)2 * MTOK};
                REPS(11) pg8::gemm_phase(ldsl, g, S, E, wv);
            } else {
                pg8::Gemm g{HKV, (const bf16_t*)(ws + WS_ATTOUT) + (size_t)DM * DM, DM, DM, DM, 0, 0};
                pg8::MultiOrder S; S.init(MTOK, DM, 1, G, c);
                pg8::EpiFinal E{(const _Float16*)(ws + WS_X16), xw, modv + l * 3 * DM + 2 * DM, AIN(20), sumsq + (size_t)3 * MTOK, (unsigned*)(ws + WS_PCNT)};
                REPS(12) pg8::gemm_phase(ldsl, g, S, E, wv);
            }
        }
    }
}
__global__ void __launch_bounds__(NTHR, 2) yoco_fwd(Args a_) {
    extern __shared__ __attribute__((aligned(16))) unsigned char lds[];
    const int ph_lo = a_.ph_lo, ph_hi = a_.ph_hi;
    const int wv = __builtin_amdgcn_readfirstlane((int)threadIdx.x >> 6);
    if (ph_hi - ph_lo > 1) {
        if (threadIdx.x < 8) ((volatile LAS unsigned*)((LAS unsigned char*)lds + LDS_MISC))[threadIdx.x] = 0u;
        if (threadIdx.x == 0) (void)xb_add(&((unsigned*)(a_.ws + WS_BAR))[XB_XCNT(xb_xcc_id())], 1u);
        __syncthreads();
    }
    if (ph_lo < 0) cg::this_grid().sync();
#define SEAM(P) do { ArgsP ap_ = (ArgsP)__builtin_amdgcn_kernarg_segment_ptr(); asm volatile("" : "+s"(ap_)); \
        xcd_barrier((unsigned*)((unsigned char*)ap_->ws + WS_BAR), (volatile LAS unsigned*)((LAS unsigned char*)lds + LDS_MISC), opq_tid(wv)); } while (0)
#ifndef TPROBE_MASK
#define TPROBE_MASK 0
#endif
#define TPROBE_MULT 10
#define TP_ON(P) ((TPROBE_MASK >> (P)) & 1)
#define TP_BEGIN(P) if (TP_ON(P) && blockIdx.x == 0 && opq_tid(wv) == 0) { volatile LAS unsigned long long* tw_ = (volatile LAS unsigned long long*)((LAS unsigned char*)lds + LDS_MISC + 16); tw_[1] = __builtin_amdgcn_s_memrealtime(); }
#define TP_END(P) if (TP_ON(P) && blockIdx.x == 0 && opq_tid(wv) == 0) { volatile LAS unsigned long long* tw_ = (volatile LAS unsigned long long*)((LAS unsigned char*)lds + LDS_MISC + 16); tw_[0] = tw_[0] + (__builtin_amdgcn_s_memrealtime() - tw_[1]); }
#define RUN(P) if ((P) >= ph_lo && (P) < ph_hi) { TP_BEGIN(P) run_phase<P>(lds, wv); if ((P) + 1 < ph_hi) { for (int br_ = 0; br_ < BAR_REP; ++br_) SEAM(P); } TP_END(P) }
    RUN(0) RUN(1) RUN(2) RUN(3) RUN(4) RUN(5) RUN(6) RUN(7) RUN(8) RUN(9) RUN(10) RUN(11)
    RUN(12) RUN(13)
#undef RUN
#undef SEAM
    if (TPROBE_MASK != 0 && blockIdx.x == 0 && opq_tid(wv) == 0) {
        volatile LAS unsigned long long* tw_ = (volatile LAS unsigned long long*)((LAS unsigned char*)lds + LDS_MISC + 16);
        const unsigned long long span = tw_[0] * TPROBE_MULT, t0 = __builtin_amdgcn_s_memrealtime();
        while (__builtin_amdgcn_s_memrealtime() - t0 < span) __builtin_amdgcn_s_sleep(8);
    }
}

extern "C" void kernel_launch(void* const* d_in, const int* in_sizes, int n_in, void* d_out, int out_size, void* d_ws, size_t ws_size, hipStream_t stream) {
    static int grid = 0;
    if (grid == 0) {
        if (n_in != 21 || out_size != MTOK * DM || ws_size < WS_END) { fprintf(stderr, "kernel_launch: unexpected shapes (n_in %d out %d ws %zu)\n", n_in, out_size, ws_size); grid = -1; return; }
        int dev = 0, cus = 0, per_cu = 0;
        (void)hipGetDevice(&dev);
        if (hipDeviceGetAttribute(&cus, hipDeviceAttributeMultiprocessorCount, dev) != hipSuccess || cus <= 0) cus = 256;
        if (hipFuncSetAttribute((const void*)yoco_fwd, hipFuncAttributeMaxDynamicSharedMemorySize, LDS_BYTES) != hipSuccess) { fprintf(stderr, "kernel_launch: hipFuncSetAttribute failed\n"); grid = -1; return; }
        if (hipOccupancyMaxActiveBlocksPerMultiprocessor(&per_cu, (const void*)yoco_fwd, NTHR, LDS_BYTES) != hipSuccess || per_cu < 1) { fprintf(stderr, "kernel_launch: occupancy query says %d\n", per_cu); per_cu = 1; }
        (void)hipGetLastError();
        grid = cus > 256 ? 256 : cus;
    }
    if (grid < 0) return;
    (void)hipMemsetAsync((char*)d_ws + WS_CTL, 0, CTL_ZERO_BYTES, stream);
    Args a{};
    for (int i = 0; i < 21; ++i) a.in[i] = (const float*)d_in[i];
    a.out = (float*)d_out; a.ws = (unsigned char*)d_ws;
#if MK_MULTI_LAUNCH
    for (int ph = 0; ph < NPHASE; ++ph) { a.ph_lo = ph; a.ph_hi = ph + 1; hipLaunchKernelGGL(yoco_fwd, dim3(grid), dim3(NTHR), LDS_BYTES, stream, a); }
#else
    a.ph_lo = 0; a.ph_hi = NPHASE;
    void* kargs[] = {&a};
    hipError_t e = hipLaunchCooperativeKernel((const void*)yoco_fwd, dim3(grid), dim3(NTHR), kargs, LDS_BYTES, stream);
    if (e != hipSuccess) fprintf(stderr, "kernel_launch: cooperative launch failed: %s (grid %d)\n", hipGetErrorString(e), grid);
#endif
}
```

```cpp
#include <hip/hip_runtime.h>
#include <hip/hip_cooperative_groups.h>
#include <cstdio>
#include <cstdint>
namespace cg = cooperative_groups;

#ifndef MK_MULTI_LAUNCH
#define MK_MULTI_LAUNCH 0
#endif

constexpr int DM = 1024, NB = 8, SEQ = 2048, MTOK = NB * SEQ, NH = 8, DH = 128;
constexpr int MODV_LD = 14336;
constexpr float EPS = 1e-6f;
constexpr int NWAVES = 8, NTHR = 512;
constexpr int LDS_BYTES = 147456;

constexpr size_t MiB = 1u << 20;
constexpr size_t WS_CTL = 0, CTL_ZERO_BYTES = 1 * MiB + 256 * 1024;
constexpr size_t WS_MODV = 64 * 1024;
constexpr size_t WS_KMEAN = 512 * 1024;
constexpr size_t WS_GFLAG = 32 * 1024;
constexpr size_t WS_SHW = 768 * 1024;
constexpr size_t WS_PCNT = 48 * 1024;
constexpr size_t WS_CFLAG = 50 * 1024;
constexpr size_t WS_SUMSQ = 1 * MiB;
constexpr size_t WS_TA = 1 * MiB + 256 * 1024;
constexpr size_t WS_WIN = 2 * MiB;
constexpr size_t WS_WG = 10 * MiB;
constexpr size_t WS_WOUT = 12 * MiB;
constexpr size_t WS_ATTIN0 = 16 * MiB, WS_WKV = 20 * MiB, WS_ATTIN1 = 24 * MiB;
constexpr size_t WS_ATTOUT = 28 * MiB;
constexpr size_t WS_HN = 32 * MiB;
constexpr size_t WS_HKV = 64 * MiB;
constexpr size_t WS_UPRE = 96 * MiB;
constexpr size_t WS_G = 128 * MiB;
constexpr size_t WS_LA = 160 * MiB;
constexpr size_t WS_BIN = 192 * MiB;
constexpr size_t WS_X16 = 224 * MiB;
constexpr size_t WS_END = 256 * MiB;

typedef unsigned short bf16_t;
typedef short bf16x8 __attribute__((ext_vector_type(8)));
typedef short s16x4 __attribute__((ext_vector_type(4)));
typedef float f32x4 __attribute__((ext_vector_type(4)));
typedef float f32x2 __attribute__((ext_vector_type(2)));
typedef float f32x16 __attribute__((ext_vector_type(16)));
typedef unsigned u32x4 __attribute__((ext_vector_type(4)));
typedef unsigned u32x2 __attribute__((ext_vector_type(2)));
#define LAS __attribute__((address_space(3)))

__device__ __forceinline__ unsigned cvt_pk_bf16(float lo, float hi) { unsigned r; asm volatile("v_cvt_pk_bf16_f32 %0, %1, %2" : "=v"(r) : "v"(lo), "v"(hi)); return r; }
__device__ __forceinline__ float bf_lo(unsigned w) { return __uint_as_float(w << 16); }
__device__ __forceinline__ float bf_hi(unsigned w) { return __uint_as_float(w & 0xffff0000u); }
__device__ __forceinline__ float bf1(bf16_t h) { return __uint_as_float((unsigned)h << 16); }
__device__ __forceinline__ float fexp(float x) { return __builtin_amdgcn_exp2f(x * 1.4426950408889634f); }
__device__ __forceinline__ float flog(float x) { return __builtin_amdgcn_logf(x) * 0.6931471805599453f; }
__device__ __forceinline__ float fsigmoid(float x) { return __builtin_amdgcn_rcpf(1.f + fexp(-x)); }
__device__ __forceinline__ float fsilu(float x) { return x * fsigmoid(x); }
__device__ __forceinline__ int opq_tid(int wv) { int l; asm volatile("v_mbcnt_lo_u32_b32 %0, -1, 0\n\tv_mbcnt_hi_u32_b32 %0, -1, %0" : "=v"(l)); return wv * 64 + l; }
__device__ __forceinline__ int opq_bid() { int b = blockIdx.x; asm volatile("" : "+s"(b)); return b; }
__device__ __forceinline__ float wave_sum(float v) {
#pragma unroll
    for (int o = 1; o < 64; o <<= 1) v += __shfl_xor(v, o);
    return v;
}

namespace pg8 {
constexpr int BM = 256, BK = 64, HALF = 128, HTB = HALF * BK * 2, STAGE_BYTES = 8 * HTB, NXCD = 8, WGM = 8;
__host__ __device__ __forceinline__ int lds_byte(int r, int c) { const int st = (r >> 4) * 2 + (c >> 5), rr = r & 15, cc = c & 31, ob = rr * 64 + cc * 2; return st * 1024 + (ob ^ (((ob >> 9) & 1) << 5)); }
__host__ __device__ __forceinline__ void stage_rc(int b, int& R, int& C) { const int st = b / 1024, sb = b % 1024, swz = sb ^ (((sb >> 9) & 1) << 5); R = (st >> 1) * 16 + swz / 64; C = (st & 1) * 32 + (swz % 64) / 2; }
__host__ __device__ __forceinline__ int perm32(int rho) { const int n = rho >> 4, i = rho & 15; return 8 * (i >> 2) + 4 * n + (i & 3); }

struct Unit { int pm, pn, sub; };
struct Gemm { const bf16_t* A; const bf16_t* Bt; int lda, ldb, K; long a_sub, b_sub; };

struct MultiOrder {
    int nM, nN, nwg, nsub, G, c;
    __device__ void init(int M, int N, int nsub_, int G_, int c_) { nM = M / BM; nN = N / BM; nwg = nM * nN; nsub = nsub_; G = G_; c = c_; }
    __device__ bool next(int i, Unit& u) const {
        const long L = (long)i * G + c; if (L >= (long)nwg * nsub) return false;
        u.sub = (int)(L / nwg);
        int wgid = (int)(L % nwg); { const int q = nwg / NXCD, r = nwg % NXCD, xcd = wgid % NXCD, off = wgid / NXCD; wgid = (xcd < r ? xcd * (q + 1) : r * (q + 1) + (xcd - r) * q) + off; }
        const int nig = WGM * nN, gid = wgid / nig, fm = gid * WGM, gsz = (nM - fm) < WGM ? (nM - fm) : WGM;
        u.pm = fm + ((wgid % nig) % gsz); u.pn = (wgid % nig) / gsz; return true;
    }
};


template <int N> __device__ __forceinline__ float dpp_shr(float src, float ident) {
    return __int_as_float(__builtin_amdgcn_update_dpp(__float_as_int(ident), __float_as_int(src), 0x110 + N, 0xF, 0xF, false));
}
struct EpiSplit {
    static constexpr bool PERM = true, APERM = false;
    bf16_t* O0; bf16_t* O1; const float* sumsq; const float* shw;
    __device__ __forceinline__ void operator()(const f32x4 (&acc)[2][2][4][2], const Unit& u, int wr, int wc, int fr, int fq) const {
        const int row0 = u.pm * BM + wr * 64 + fr; int colt = u.pn * BM; bf16_t* base = O0;
        const int cfull = u.pn * BM + wc * 32 + 8 * fq;
        const bool gate_half = colt >= DM;
        if (gate_half) { base = O1; colt -= DM; }
        const int col0 = colt + wc * 32 + 8 * fq;
        f32x4 bv[2][2];
#pragma unroll
        for (int bj = 0; bj < 2; ++bj)
#pragma unroll
            for (int n = 0; n < 2; ++n) bv[bj][n] = sumsq ? *(const f32x4*)(shw + (size_t)(u.pm >> 3) * 2 * DM + cfull + bj * HALF + 4 * n) : (f32x4){0.f, 0.f, 0.f, 0.f};
        float ssq[2][4];
#pragma unroll
        for (int ai = 0; ai < 2; ++ai)
#pragma unroll
            for (int m = 0; m < 4; ++m) ssq[ai][m] = sumsq ? sumsq[row0 + ai * HALF + m * 16] : 0.f;
#pragma unroll
        for (int ai = 0; ai < 2; ++ai)
#pragma unroll
            for (int m = 0; m < 4; ++m) { const int row = row0 + ai * HALF + m * 16; bf16_t* rowp = base + (size_t)row * DM + col0;
                const float rs = sumsq ? __builtin_amdgcn_rsqf(ssq[ai][m] * (1.f / DM) + EPS) : 1.f;
#pragma unroll
                for (int bj = 0; bj < 2; ++bj) { f32x4 v0 = acc[ai][bj][m][0] * rs + bv[bj][0], v1 = acc[ai][bj][m][1] * rs + bv[bj][1];
                    if (gate_half) {
#pragma unroll
                        for (int j = 0; j < 4; ++j) { v0[j] = fsilu(v0[j]); v1[j] = fsilu(v1[j]); } }
                    u32x4 w; w.x = cvt_pk_bf16(v0[0], v0[1]); w.y = cvt_pk_bf16(v0[2], v0[3]); w.z = cvt_pk_bf16(v1[0], v1[1]); w.w = cvt_pk_bf16(v1[2], v1[3]);
                    *(u32x4*)(rowp + bj * HALF) = w; } }
    }
};

typedef _Float16 h16x8 __attribute__((ext_vector_type(8)));
__device__ __forceinline__ void ld8(const float* p, float (&v)[8]) { const f32x4 a = *(const f32x4*)p, b = *(const f32x4*)(p + 4); v[0] = a[0]; v[1] = a[1]; v[2] = a[2]; v[3] = a[3]; v[4] = b[0]; v[5] = b[1]; v[6] = b[2]; v[7] = b[3]; }
struct InOrder {
    int c, n, base;
    __device__ bool next(int i, Unit& u) const { if (i >= n) return false; const int j = c >> 3; int pm = (c & 7) * 8 + (j >> 2), pn = 4 * (i + base) + (j & 3), sub = 0;
        asm volatile("" : "+s"(pm), "+s"(pn), "+s"(sub)); u.pm = pm; u.pn = pn; u.sub = sub; return true; }
};
constexpr int CV_HL_OFF = 133120;
struct EpiSplitConv {
    static constexpr bool PERM = true, APERM = true;
    unsigned char* ws; const float* sumsq; const float* shw; const float* cw; const float* cb; unsigned target; LAS unsigned char* lds;
    __device__ __forceinline__ void operator()(f32x4 (&acc)[2][2][4][2], const Unit& u, int wr, int wc, int fr, int fq) const {
        const int pnl = u.pn & 3;
        const int cfull = u.pn * BM + wc * 32 + 8 * fq, ct = wc * 32 + 8 * fq, col0 = pnl * BM + ct;
        bf16_t* obase = (bf16_t*)(ws + WS_UPRE);
        f32x4 bv[2][2];
#pragma unroll
        for (int bj = 0; bj < 2; ++bj)
#pragma unroll
            for (int n = 0; n < 2; ++n) bv[bj][n] = sumsq ? *(const f32x4*)(shw + (size_t)(u.pm >> 3) * 2 * DM + cfull + bj * HALF + 4 * n) : (f32x4){0.f, 0.f, 0.f, 0.f};
        float ssq[2][4];
#pragma unroll
        for (int ai = 0; ai < 2; ++ai)
#pragma unroll
            for (int m = 0; m < 4; ++m) ssq[ai][m] = sumsq ? sumsq[u.pm * BM + ai * HALF + wr * 64 + 4 * fr + m] : 0.f;
#pragma unroll
        for (int ai = 0; ai < 2; ++ai)
#pragma unroll
            for (int m = 0; m < 4; ++m) { const float rs = sumsq ? __builtin_amdgcn_rsqf(ssq[ai][m] * (1.f / DM) + EPS) : 1.f;
#pragma unroll
                for (int bj = 0; bj < 2; ++bj) { acc[ai][bj][m][0] = acc[ai][bj][m][0] * rs + bv[bj][0]; acc[ai][bj][m][1] = acc[ai][bj][m][1] * rs + bv[bj][1]; } }
        const int tile = u.pm * 4 + pnl;
        unsigned long long* HX = (unsigned long long*)(ws + WS_BIN);
        unsigned* flags = (unsigned*)(ws + WS_CFLAG);
        LAS f32x4* HL = (LAS f32x4*)(lds + CV_HL_OFF);
#pragma unroll
        for (int ai = 0; ai < 2; ++ai)
#pragma unroll
            for (int k = 0; k < 3; ++k)
#pragma unroll
                for (int bj = 0; bj < 2; ++bj) {
                    if (fr == 15) { LAS f32x4* d = HL + (((ai * 2 + wr) * 3 + k) * 256 + bj * HALF + ct) / 4;
                        d[0] = acc[ai][bj][k + 1][0]; d[1] = acc[ai][bj][k + 1][1];
                        if (ai == 1 && wr == 1) { unsigned long long* g_ = HX + ((size_t)(tile * 3 + k) * 256 + bj * HALF + ct) / 2;
#pragma unroll
                            for (int n = 0; n < 2; ++n) { const f32x4 v = acc[1][bj][k + 1][n];
                                __hip_atomic_store(g_ + 2 * n, ((unsigned long long)__float_as_uint(v[1]) << 32) | __float_as_uint(v[0]), __ATOMIC_RELAXED, __HIP_MEMORY_SCOPE_AGENT);
                                __hip_atomic_store(g_ + 2 * n + 1, ((unsigned long long)__float_as_uint(v[3]) << 32) | __float_as_uint(v[2]), __ATOMIC_RELAXED, __HIP_MEMORY_SCOPE_AGENT); } } }
                    asm volatile("" ::: "memory"); __builtin_amdgcn_sched_barrier(0);
                }
        if (wr == 1) { asm volatile("s_waitcnt vmcnt(0)" ::: "memory");
            if (fr == 15 && fq == 0) __hip_atomic_fetch_add(flags + tile * 8, 1u, __ATOMIC_RELAXED, __HIP_MEMORY_SCOPE_AGENT); }
        asm volatile("s_waitcnt lgkmcnt(0)" ::: "memory"); __builtin_amdgcn_s_barrier(); asm volatile("" ::: "memory");
        const bool need_prev = (wr == 0) && ((u.pm & 7) != 0);
        if (need_prev) { unsigned spins = 0;
            while (__hip_atomic_load(flags + (tile - 4) * 8, __ATOMIC_RELAXED, __HIP_MEMORY_SCOPE_AGENT) < target) { __builtin_amdgcn_s_sleep(2); if (++spins > (1u << 22)) break; } }
#pragma unroll
        for (int ai = 0; ai < 2; ++ai)
#pragma unroll
            for (int bj = 0; bj < 2; ++bj)
#pragma unroll
                for (int n = 0; n < 2; ++n) {
                    f32x4 pr[3];
                    if (ai == 0 && wr == 0) {
#pragma unroll
                        for (int k = 0; k < 3; ++k) { unsigned long long wa = 0ull, wb = 0ull;
                            if (need_prev) { const unsigned long long* sp = HX + ((size_t)((tile - 4) * 3 + k) * 256 + bj * HALF + ct + 4 * n) / 2;
                                wa = __hip_atomic_load(sp, __ATOMIC_RELAXED, __HIP_MEMORY_SCOPE_AGENT); wb = __hip_atomic_load(sp + 1, __ATOMIC_RELAXED, __HIP_MEMORY_SCOPE_AGENT); }
                            pr[k] = (f32x4){__uint_as_float((unsigned)wa), __uint_as_float((unsigned)(wa >> 32)), __uint_as_float((unsigned)wb), __uint_as_float((unsigned)(wb >> 32))}; }
                    } else { const int prun = ai * 2 + wr - 1;
#pragma unroll
                        for (int k = 0; k < 3; ++k) pr[k] = HL[((prun * 3 + k) * 256 + bj * HALF + ct + 4 * n) / 4]; }
                    const int chg = pnl * BM + bj * HALF + ct + 4 * n;
                    const f32x4 w0 = *(const f32x4*)(cw + chg), w1 = *(const f32x4*)(cw + DM + chg), w2 = *(const f32x4*)(cw + 2 * DM + chg), w3 = *(const f32x4*)(cw + 3 * DM + chg), bb = *(const f32x4*)(cb + chg);
                    const f32x4 x0 = acc[ai][bj][0][n], x1 = acc[ai][bj][1][n], x2 = acc[ai][bj][2][n], x3 = acc[ai][bj][3][n];
                    f32x4 q1, q2, q3;
#pragma unroll
                    for (int j = 0; j < 4; ++j) { q1[j] = dpp_shr<1>(x3[j], pr[2][j]); q2[j] = dpp_shr<1>(x2[j], pr[1][j]); q3[j] = dpp_shr<1>(x1[j], pr[0][j]); }
                    const f32x4 y0 = bb + w0 * q3 + w1 * q2 + w2 * q1 + w3 * x0, y1 = bb + w0 * q2 + w1 * q1 + w2 * x0 + w3 * x1;
                    const f32x4 y2 = bb + w0 * q1 + w1 * x0 + w2 * x1 + w3 * x2, y3 = bb + w0 * x0 + w1 * x1 + w2 * x2 + w3 * x3;
                    bf16_t* op = obase + (size_t)(u.pm * BM + ai * HALF + wr * 64 + 4 * fr) * DM + col0 + bj * HALF + 4 * n;
                    { u32x2 w; w.x = cvt_pk_bf16(y0[0], y0[1]); w.y = cvt_pk_bf16(y0[2], y0[3]); *(u32x2*)(op) = w; }
                    { u32x2 w; w.x = cvt_pk_bf16(y1[0], y1[1]); w.y = cvt_pk_bf16(y1[2], y1[3]); *(u32x2*)(op + DM) = w; }
                    { u32x2 w; w.x = cvt_pk_bf16(y2[0], y2[1]); w.y = cvt_pk_bf16(y2[2], y2[3]); *(u32x2*)(op + 2 * DM) = w; }
                    { u32x2 w; w.x = cvt_pk_bf16(y3[0], y3[1]); w.y = cvt_pk_bf16(y3[2], y3[3]); *(u32x2*)(op + 3 * DM) = w; }
                    asm volatile("" ::: "memory"); __builtin_amdgcn_sched_barrier(0);
                }
    }
};

template <class TIn, bool HAS_A2>
struct EpiResH {
    static constexpr bool PERM = true, APERM = false;
    const TIn* xin; _Float16* xo; const float* gate; const float* modv; bf16_t* A1; const float* g1; int sc1; bf16_t* A2; const float* g2; int sc2; float* sumsq;
    __device__ __forceinline__ void operator()(const f32x4 (&acc)[2][2][4][2], const Unit& u, int wr, int wc, int fr, int fq) const {
        const int b = u.pm >> 3, col0 = u.pn * BM + wc * 32 + 8 * fq;
        float gv[2][8], gs1[2][8], gs2[HAS_A2 ? 2 : 1][8];
#pragma unroll
        for (int bj = 0; bj < 2; ++bj) { const int cc = col0 + bj * HALF;
            ld8(gate + (size_t)b * MODV_LD + cc, gv[bj]);
            { float gg[8], sc[8]; ld8(g1 + cc, gg); ld8(modv + (size_t)b * MODV_LD + sc1 + cc, sc);
#pragma unroll
              for (int j = 0; j < 8; ++j) gs1[bj][j] = gg[j] * (sc[j] + 1.f); }
            if constexpr (HAS_A2) { float gg[8], sc[8]; ld8(g2 + cc, gg); ld8(modv + (size_t)b * MODV_LD + sc2 + cc, sc);
#pragma unroll
              for (int j = 0; j < 8; ++j) gs2[bj][j] = gg[j] * (sc[j] + 1.f); } }
        constexpr int NG = (sizeof(TIn) == 4 || HAS_A2) ? 2 : 4;
#pragma unroll
        for (int ai = 0; ai < 2; ++ai) {
#pragma unroll
          for (int mh = 0; mh < 4; mh += NG) {
            float xv[sizeof(TIn) == 4 ? NG : 1][2][8]; h16x8 xh[sizeof(TIn) == 4 ? 1 : NG][2];
#pragma unroll
            for (int mm = 0; mm < NG; ++mm) { const size_t off = (size_t)(u.pm * BM + ai * HALF + wr * 64 + (mh + mm) * 16 + fr) * DM + col0;
#pragma unroll
                for (int bj = 0; bj < 2; ++bj) {
                    if constexpr (sizeof(TIn) == 4) ld8((const float*)xin + off + bj * HALF, xv[mm][bj]);
                    else xh[mm][bj] = *(const h16x8*)((const _Float16*)xin + off + bj * HALF); } }
            __builtin_amdgcn_sched_barrier(0);
#pragma unroll
            for (int mm = 0; mm < NG; ++mm) { const int m = mh + mm; const int row = u.pm * BM + ai * HALF + wr * 64 + m * 16 + fr; const size_t off = (size_t)row * DM + col0;
                float ss = 0.f;
#pragma unroll
                for (int bj = 0; bj < 2; ++bj) { float o[8]; h16x8 ho;
#pragma unroll
                    for (int j = 0; j < 8; ++j) { float xj; if constexpr (sizeof(TIn) == 4) xj = xv[mm][bj][j]; else xj = (float)xh[mm][bj][j];
                        o[j] = xj + gv[bj][j] * acc[ai][bj][m][j >> 2][j & 3]; ho[j] = (_Float16)o[j]; ss += o[j] * o[j]; }
                    *(h16x8*)(xo + off + bj * HALF) = ho;
                    if (A1) { u32x4 w; w.x = cvt_pk_bf16(o[0] * gs1[bj][0], o[1] * gs1[bj][1]); w.y = cvt_pk_bf16(o[2] * gs1[bj][2], o[3] * gs1[bj][3]);
                        w.z = cvt_pk_bf16(o[4] * gs1[bj][4], o[5] * gs1[bj][5]); w.w = cvt_pk_bf16(o[6] * gs1[bj][6], o[7] * gs1[bj][7]); *(u32x4*)(A1 + off + bj * HALF) = w; }
                    if constexpr (HAS_A2) { u32x4 w; w.x = cvt_pk_bf16(o[0] * gs2[bj][0], o[1] * gs2[bj][1]); w.y = cvt_pk_bf16(o[2] * gs2[bj][2], o[3] * gs2[bj][3]);
                        w.z = cvt_pk_bf16(o[4] * gs2[bj][4], o[5] * gs2[bj][5]); w.w = cvt_pk_bf16(o[6] * gs2[bj][6], o[7] * gs2[bj][7]); *(u32x4*)(A2 + off + bj * HALF) = w; } }
                if (sumsq) { ss += __shfl_xor(ss, 16); ss += __shfl_xor(ss, 32); if (fq == 0) atomicAdd(sumsq + row, ss); } }
            __builtin_amdgcn_sched_barrier(0);
          }
        }
    }
};

struct EpiFinal {
    static constexpr bool PERM = true, APERM = false;
    const _Float16* xin; float* out; const float* gate; const float* fg; float* sumsq; unsigned* cnt;
    __device__ __forceinline__ void operator()(f32x4 (&acc)[2][2][4][2], const Unit& u, int wr, int wc, int fr, int fq) const {
        const int b = u.pm >> 3, col0 = u.pn * BM + wc * 32 + 8 * fq;
        float gv[2][8];
#pragma unroll
        for (int bj = 0; bj < 2; ++bj) ld8(gate + (size_t)b * MODV_LD + col0 + bj * HALF, gv[bj]);
#pragma unroll
        for (int ai = 0; ai < 2; ++ai) {
            h16x8 xh[4][2];
#pragma unroll
            for (int m = 0; m < 4; ++m)
#pragma unroll
                for (int bj = 0; bj < 2; ++bj) xh[m][bj] = *(const h16x8*)(xin + (size_t)(u.pm * BM + ai * HALF + wr * 64 + m * 16 + fr) * DM + col0 + bj * HALF);
            __builtin_amdgcn_sched_barrier(0);
#pragma unroll
            for (int m = 0; m < 4; ++m) { const int row = u.pm * BM + ai * HALF + wr * 64 + m * 16 + fr;
                float ss = 0.f;
#pragma unroll
                for (int bj = 0; bj < 2; ++bj) { f32x4 o0, o1;
#pragma unroll
                    for (int j = 0; j < 4; ++j) { o0[j] = (float)xh[m][bj][j] + gv[bj][j] * acc[ai][bj][m][0][j]; o1[j] = (float)xh[m][bj][4 + j] + gv[bj][4 + j] * acc[ai][bj][m][1][j]; }
                    acc[ai][bj][m][0] = o0; acc[ai][bj][m][1] = o1;
                    ss += (o0[0] * o0[0] + o0[1] * o0[1]) + (o0[2] * o0[2] + o0[3] * o0[3]) + (o1[0] * o1[0] + o1[1] * o1[1]) + (o1[2] * o1[2] + o1[3] * o1[3]); }
                ss += __shfl_xor(ss, 16); ss += __shfl_xor(ss, 32); if (fq == 0) atomicAdd(sumsq + row, ss); }
            __builtin_amdgcn_sched_barrier(0);
        }
        asm volatile("s_waitcnt vmcnt(0)" ::: "memory");
        if (fr == 0 && fq == 0) __hip_atomic_fetch_add(cnt + u.pm * 8, 1u, __ATOMIC_RELAXED, __HIP_MEMORY_SCOPE_AGENT);
        { unsigned spins = 0;
          while (__hip_atomic_load(cnt + u.pm * 8, __ATOMIC_RELAXED, __HIP_MEMORY_SCOPE_AGENT) < 32u) { __builtin_amdgcn_s_sleep(2); if (++spins > (1u << 22)) break; } }
        float fgv[2][8];
#pragma unroll
        for (int bj = 0; bj < 2; ++bj) ld8(fg + col0 + bj * HALF, fgv[bj]);
        float ssq[2][4];
#pragma unroll
        for (int ai = 0; ai < 2; ++ai)
#pragma unroll
            for (int m = 0; m < 4; ++m) ssq[ai][m] = __hip_atomic_load(sumsq + u.pm * BM + ai * HALF + wr * 64 + m * 16 + fr, __ATOMIC_RELAXED, __HIP_MEMORY_SCOPE_AGENT);
#pragma unroll
        for (int ai = 0; ai < 2; ++ai)
#pragma unroll
            for (int m = 0; m < 4; ++m) { const size_t off = (size_t)(u.pm * BM + ai * HALF + wr * 64 + m * 16 + fr) * DM + col0;
                const float rs = __builtin_amdgcn_rsqf(ssq[ai][m] * (1.f / DM) + EPS);
#pragma unroll
                for (int bj = 0; bj < 2; ++bj) { f32x4 y0, y1;
#pragma unroll
                    for (int j = 0; j < 4; ++j) { y0[j] = acc[ai][bj][m][0][j] * rs * fgv[bj][j]; y1[j] = acc[ai][bj][m][1][j] * rs * fgv[bj][4 + j]; }
                    *(f32x4*)(out + off + bj * HALF) = y0; *(f32x4*)(out + off + bj * HALF + 4) = y1; } }
    }
};

__device__ __forceinline__ void scan16(float& a, float& b) {
    float ap, bp;
    ap = dpp_shr<1>(a, 1.f); bp = dpp_shr<1>(b, 0.f); b = fmaf(a, bp, b); a *= ap;
    ap = dpp_shr<2>(a, 1.f); bp = dpp_shr<2>(b, 0.f); b = fmaf(a, bp, b); a *= ap;
    ap = dpp_shr<4>(a, 1.f); bp = dpp_shr<4>(b, 0.f); b = fmaf(a, bp, b); a *= ap;
    ap = dpp_shr<8>(a, 1.f); bp = dpp_shr<8>(b, 0.f); b = fmaf(a, bp, b); a *= ap;
}
__device__ __forceinline__ void gate_elem2(f32x2 xr, f32x2 xg, f32x2 nba, f32x2 nbx, f32x2 psp2, f32x2 uv, f32x2& a, f32x2& b) {
    const f32x2 tr = xr * (-1.4426950408889634f) + nba, tg = xg * (-1.4426950408889634f) + nbx;
    f32x2 er, eg; er.x = __builtin_amdgcn_exp2f(tr.x); er.y = __builtin_amdgcn_exp2f(tr.y); eg.x = __builtin_amdgcn_exp2f(tg.x); eg.y = __builtin_amdgcn_exp2f(tg.y);
    const f32x2 dr = er + 1.f, dg = eg + 1.f, dd = dr * dg;
    f32x2 inv; inv.x = __builtin_amdgcn_rcpf(dd.x); inv.y = __builtin_amdgcn_rcpf(dd.y);
    const f32x2 r = inv * dg, gi = inv * dr;
    const f32x2 la2 = psp2 * r;
    a.x = __builtin_amdgcn_exp2f(-la2.x); a.y = __builtin_amdgcn_exp2f(-la2.y);
    const f32x2 om = 1.f - a * a;
    f32x2 sq; sq.x = __builtin_amdgcn_sqrtf(om.x); sq.y = __builtin_amdgcn_sqrtf(om.y);
    b = sq * gi * uv;
}
struct GateParams { f32x2 nba[4], nbx[4], psp2[4]; };
__device__ __forceinline__ void gate_params(GateParams& P, const float* ba, const float* bx, const float* lam, int ch0) {
#pragma unroll
    for (int p = 0; p < 4; ++p) {
        const f32x2 vb = *(const f32x2*)(ba + ch0 + 2 * p), vx = *(const f32x2*)(bx + ch0 + 2 * p), vl = *(const f32x2*)(lam + ch0 + 2 * p);
        P.nba[p] = vb * (-1.4426950408889634f); P.nbx[p] = vx * (-1.4426950408889634f);
        const float z0 = -vl.x, z1 = -vl.y;
        P.psp2[p].x = 8.f * 1.4426950408889634f * (z0 > 20.f ? z0 : flog(1.f + fexp(z0)));
        P.psp2[p].y = 8.f * 1.4426950408889634f * (z1 > 20.f ? z1 : flog(1.f + fexp(z1)));
    }
}
#define GATE_PAIR(p, accv, uw_, a2, b2) do { const int n_ = (p) >> 1, q_ = ((p) & 1) * 2; \
        const unsigned uword_ = ((p) == 0) ? uw_.x : ((p) == 1) ? uw_.y : ((p) == 2) ? uw_.z : uw_.w; \
        gate_elem2((f32x2){accv[ai][0][m][n_][q_], accv[ai][0][m][n_][q_ + 1]}, (f32x2){accv[ai][1][m][n_][q_], accv[ai][1][m][n_][q_ + 1]}, \
                   P.nba[p], P.nbx[p], P.psp2[p], (f32x2){bf_lo(uword_), bf_hi(uword_)}, a2, b2); } while (0)
struct GatesOrder {
    int c, n;
    __device__ bool next(int i, Unit& u) const { if (i >= n) return false; int pm = (c >> 5) * 8 + 4 * i + (c & 3), pn = (c >> 2) & 1, sub = (c >> 3) & 3;
        asm volatile("" : "+s"(pm), "+s"(pn), "+s"(sub)); u.pm = pm; u.pn = pn; u.sub = sub; return true; }
};
constexpr int GS_RA_OFF = 133120;
struct EpiGatesS {
    static constexpr bool PERM = true, APERM = true;
    unsigned char* ws; unsigned target; const float* ba; const float* bx; const float* lam; LAS unsigned char* lds;
    __device__ __forceinline__ void operator()(f32x4 (&acc)[2][2][4][2], const Unit& u, int wr, int wc, int fr, int fq) const {
        const bf16_t* U = (const bf16_t*)(ws + WS_UPRE); const bf16_t* Gt = (const bf16_t*)(ws + WS_G); bf16_t* Y = (bf16_t*)(ws + WS_HN);
        unsigned long long* TA = (unsigned long long*)(ws + WS_TA); unsigned* flags = (unsigned*)(ws + WS_GFLAG);
        const int ct0 = wc * 32 + 8 * fq, ch0 = u.sub * 256 + u.pn * 128 + ct0;
        const int chain = ((u.pm >> 3) * 4 + u.sub) * 2 + u.pn, p = u.pm & 7, tix = chain * 8 + p;
        const int bsrc = (fq * 16 + 15) << 2;
        LAS f32x4* RA = (LAS f32x4*)(lds + GS_RA_OFF);
        {
            GateParams P; gate_params(P, ba, bx, lam, ch0);
#pragma unroll
            for (int ai = 0; ai < 2; ++ai) {
                u32x4 uall[4];
#pragma unroll
                for (int m = 0; m < 4; ++m) uall[m] = *(const u32x4*)(U + (size_t)(u.pm * BM + ai * HALF + wr * 64 + 4 * fr + m) * DM + ch0);
#pragma unroll
                for (int n = 0; n < 2; ++n) { f32x4 tA[4], tB[4]; f32x4 agg;
#pragma unroll
                    for (int hq = 0; hq < 2; ++hq) { const int pq = 2 * n + hq; f32x2 a2[4], b2[4];
#pragma unroll
                        for (int m = 0; m < 4; ++m) { const u32x4 uw = uall[m]; GATE_PAIR(pq, acc, uw, a2[m], b2[m]); }
#pragma unroll
                        for (int m = 1; m < 4; ++m) { b2[m] = a2[m] * b2[m - 1] + b2[m]; a2[m] = a2[m] * a2[m - 1]; }
                        float pax = a2[3].x, pbx = b2[3].x, pay = a2[3].y, pby = b2[3].y; scan16(pax, pbx); scan16(pay, pby);
                        if (hq == 0) { agg[0] = pax; agg[1] = pbx; agg[2] = pay; agg[3] = pby;
                            if (fr == 15) RA[((ai * 2 + wr) * 128 + ct0) / 2 + pq] = agg; }
                        else { if (fr == 15) RA[((ai * 2 + wr) * 128 + ct0) / 2 + pq] = (f32x4){pax, pbx, pay, pby}; }
                        const f32x2 EA = {dpp_shr<1>(pax, 1.f), dpp_shr<1>(pay, 1.f)}, EB = {dpp_shr<1>(pbx, 0.f), dpp_shr<1>(pby, 0.f)};
#pragma unroll
                        for (int m = 0; m < 4; ++m) { const f32x2 Ae = a2[m] * EA, Be = a2[m] * EB + b2[m];
                            tA[m][2 * hq] = Ae.x; tA[m][2 * hq + 1] = Ae.y; tB[m][2 * hq] = Be.x; tB[m][2 * hq + 1] = Be.y; }
                        __builtin_amdgcn_sched_barrier(0); }
#pragma unroll
                    for (int m = 0; m < 4; ++m) { acc[ai][0][m][n] = tA[m]; acc[ai][1][m][n] = tB[m]; }
                    asm volatile("" ::: "memory"); __builtin_amdgcn_sched_barrier(0); }
            }
        }
        asm volatile("s_waitcnt lgkmcnt(0)" ::: "memory"); __builtin_amdgcn_s_barrier(); asm volatile("" ::: "memory");
        if (wr == 0) {
            float At[8], Bt[8];
#pragma unroll
            for (int j = 0; j < 8; ++j) { At[j] = 1.f; Bt[j] = 0.f; }
#pragma unroll
            for (int ri = 0; ri < 4; ++ri)
#pragma unroll
                for (int q = 0; q < 4; ++q) { const f32x4 v = RA[(ri * 128 + ct0) / 2 + q];
                    Bt[2 * q] = fmaf(v[0], Bt[2 * q], v[1]); At[2 * q] *= v[0]; Bt[2 * q + 1] = fmaf(v[2], Bt[2 * q + 1], v[3]); At[2 * q + 1] *= v[2]; }
            if (fr == 15) {
#pragma unroll
                for (int j = 0; j < 8; ++j) __hip_atomic_store(TA + (size_t)tix * 128 + ct0 + j, ((unsigned long long)__float_as_uint(Bt[j]) << 32) | __float_as_uint(At[j]), __ATOMIC_RELAXED, __HIP_MEMORY_SCOPE_AGENT);
            }
            asm volatile("s_waitcnt vmcnt(0)" ::: "memory");
            if (fr == 15 && fq == 0) __hip_atomic_fetch_add(flags + tix * 8, 1u, __ATOMIC_RELAXED, __HIP_MEMORY_SCOPE_AGENT);
        }
        float h[8];
        {
            const bool on = fr < p;
            if (on) { unsigned spins = 0;
                while (__hip_atomic_load(flags + (chain * 8 + fr) * 8, __ATOMIC_RELAXED, __HIP_MEMORY_SCOPE_AGENT) < target) { __builtin_amdgcn_s_sleep(2); if (++spins > (1u << 22)) break; } }
            float Ac[8], Bc[8];
#pragma unroll
            for (int j = 0; j < 8; ++j) { unsigned long long w = 0x000000003f800000ull;
                if (on) w = __hip_atomic_load(TA + (size_t)(chain * 8 + fr) * 128 + ct0 + j, __ATOMIC_RELAXED, __HIP_MEMORY_SCOPE_AGENT);
                Ac[j] = __uint_as_float((unsigned)w); Bc[j] = __uint_as_float((unsigned)(w >> 32)); }
#pragma unroll
            for (int j = 0; j < 8; ++j) { float a = Ac[j], b = Bc[j]; scan16(a, b); h[j] = __int_as_float(__builtin_amdgcn_ds_bpermute(bsrc, __float_as_int(b))); }
        }
#pragma unroll
        for (int ai = 0; ai < 2; ++ai) {
            const int nskip = (ai == 0) ? wr : 1;
            const int rfirst = (ai == 0) ? 0 : (1 + wr);
            for (int k = 0; k < nskip; ++k)
#pragma unroll
                for (int q = 0; q < 4; ++q) { const f32x4 v = RA[((rfirst + k) * 128 + ct0) / 2 + q];
                    h[2 * q] = fmaf(v[0], h[2 * q], v[1]); h[2 * q + 1] = fmaf(v[2], h[2 * q + 1], v[3]); }
            u32x4 gall[4];
#pragma unroll
            for (int m = 0; m < 4; ++m) gall[m] = *(const u32x4*)(Gt + (size_t)(u.pm * BM + ai * HALF + wr * 64 + 4 * fr + m) * DM + ch0);
            float hl[8];
#pragma unroll
            for (int m = 0; m < 4; ++m) { const size_t off = (size_t)(u.pm * BM + ai * HALF + wr * 64 + 4 * fr + m) * DM + ch0;
                const u32x4 gw = gall[m];
                const float gv[8] = {bf_lo(gw.x), bf_hi(gw.x), bf_lo(gw.y), bf_hi(gw.y), bf_lo(gw.z), bf_hi(gw.z), bf_lo(gw.w), bf_hi(gw.w)};
                float yv[8];
#pragma unroll
                for (int j = 0; j < 8; ++j) { const float hv = fmaf(acc[ai][0][m][j >> 2][j & 3], h[j], acc[ai][1][m][j >> 2][j & 3]); yv[j] = hv * gv[j];
                    if (m == 3) hl[j] = hv; }
                u32x4 w; w.x = cvt_pk_bf16(yv[0], yv[1]); w.y = cvt_pk_bf16(yv[2], yv[3]); w.z = cvt_pk_bf16(yv[4], yv[5]); w.w = cvt_pk_bf16(yv[6], yv[7]);
                *(u32x4*)(Y + off) = w; }
#pragma unroll
            for (int j = 0; j < 8; ++j) h[j] = __int_as_float(__builtin_amdgcn_ds_bpermute(bsrc, __float_as_int(hl[j])));
            asm volatile("" ::: "memory"); __builtin_amdgcn_sched_barrier(0);
        }
    }
};

struct EpiQKV {
    static constexpr bool PERM = true, APERM = false;
    unsigned char* ws; float* kmean; const float* sumsq; const float* shw; int shw_sub;
    __device__ __forceinline__ void operator()(const f32x4 (&acc)[2][2][4][2], const Unit& u, int wr, int wc, int fr, int fq) const {
        const int b = u.pm >> 3, sblk = u.pm & 7, pq = u.pn & 3; const bool second = u.pn >= 4;
        const int dcol = wc * 32 + 8 * fq;
        const float* sw = shw + (size_t)u.sub * shw_sub + (size_t)b * 2 * DM + u.pn * BM + dcol;
        f32x4 bv[2][2];
#pragma unroll
        for (int bj = 0; bj < 2; ++bj)
#pragma unroll
            for (int n = 0; n < 2; ++n) bv[bj][n] = *(const f32x4*)(sw + bj * HALF + 4 * n);
        const bool plain = (u.sub == 0 && second), km = (u.sub == 1 && !second);
        const size_t boff = plain ? WS_G : (u.sub == 0) ? WS_UPRE : (second ? WS_BIN : WS_HN);
        const size_t rstride = plain ? DM : DH;
        bf16_t* bp[2];
#pragma unroll
        for (int bj = 0; bj < 2; ++bj)
            bp[bj] = (bf16_t*)(ws + boff) + (plain ? (size_t)(u.pm * BM) * DM + pq * 256 + bj * HALF + dcol : ((size_t)(b * NH + 2 * pq + bj) * SEQ + sblk * 256) * DH + dcol);
        f32x4 s0[2], s1[2];
#pragma unroll
        for (int bj = 0; bj < 2; ++bj) { s0[bj] = (f32x4){0.f, 0.f, 0.f, 0.f}; s1[bj] = (f32x4){0.f, 0.f, 0.f, 0.f}; }
        float ssq[2][4];
#pragma unroll
        for (int ai = 0; ai < 2; ++ai)
#pragma unroll
            for (int m = 0; m < 4; ++m) ssq[ai][m] = sumsq[u.pm * BM + ai * HALF + wr * 64 + m * 16 + fr];
#pragma unroll
        for (int ai = 0; ai < 2; ++ai)
#pragma unroll
            for (int m = 0; m < 4; ++m) { const int r = ai * HALF + wr * 64 + m * 16 + fr;
                const float rs = __builtin_amdgcn_rsqf(ssq[ai][m] * (1.f / DM) + EPS);
#pragma unroll
                for (int bj = 0; bj < 2; ++bj) { f32x4 v0 = acc[ai][bj][m][0] * rs + bv[bj][0], v1 = acc[ai][bj][m][1] * rs + bv[bj][1];
                    if (plain) {
#pragma unroll
                        for (int j = 0; j < 4; ++j) { v0[j] = fsilu(v0[j]); v1[j] = fsilu(v1[j]); } }
                    s0[bj] += v0; s1[bj] += v1;
                    u32x4 w; w.x = cvt_pk_bf16(v0[0], v0[1]); w.y = cvt_pk_bf16(v0[2], v0[3]); w.z = cvt_pk_bf16(v1[0], v1[1]); w.w = cvt_pk_bf16(v1[2], v1[3]);
                    *(u32x4*)(bp[bj] + (size_t)r * rstride) = w; }
                asm volatile("" ::: "memory"); }
        if (km) {
#pragma unroll
            for (int bj = 0; bj < 2; ++bj)
#pragma unroll
                for (int j = 0; j < 4; ++j) { float t0 = s0[bj][j], t1 = s1[bj][j];
                    t0 += __shfl_xor(t0, 1); t0 += __shfl_xor(t0, 2); t0 += __shfl_xor(t0, 4); t0 += __shfl_xor(t0, 8);
                    t1 += __shfl_xor(t1, 1); t1 += __shfl_xor(t1, 2); t1 += __shfl_xor(t1, 4); t1 += __shfl_xor(t1, 8);
                    if (fr == 0) { float* kp = kmean + ((size_t)(b * NH + 2 * pq + bj) * 8 + sblk) * DH + dcol + j;
                        atomicAdd(kp, t0 * (1.f / 256.f)); atomicAdd(kp + 4, t1 * (1.f / 256.f)); } }
        }
    }
};

template <class Epi, class Sched>
__device__ __forceinline__ void gemm_phase(LAS unsigned char* lds, const Gemm g, const Sched& S, const Epi& E, int wv) {
    const int tid = opq_tid(wv), wid = __builtin_amdgcn_readfirstlane(tid >> 6), lane = tid & 63, wr = wid >> 2, wc = wid & 3, fr = lane & 15, fq = lane >> 4;
    const int K = g.K, nt = K / BK;
    unsigned voffA[2], voffB[2];
#pragma unroll
    for (int i = 0; i < 2; ++i) { int R, C; stage_rc(tid * 16 + i * 8192, R, C); const int Rb = Epi::PERM ? ((R & ~31) + perm32(R & 31)) : R;
        const int Ra = Epi::APERM ? ((R & 64) + 4 * (R & 15) + ((R >> 4) & 3)) : R;
        voffA[i] = (unsigned)(Ra * g.lda + C) * 2u; voffB[i] = (unsigned)(Rb * g.ldb + C) * 2u; }
    const size_t kstep = (size_t)(BK * 2);
    const size_t hstepA = (size_t)HALF * g.lda * 2, hstepB = (size_t)HALF * g.ldb * 2;
    const size_t tstepA = 2 * hstepA, tstepB = 2 * hstepB;
    const unsigned ldsw = (unsigned)wid * 1024u;
    const int aoff = lds_byte(wr * 64 + fr, fq * 8), boff = lds_byte(wc * 32 + fr, fq * 8);
#define PG8_SA(b, h) (((b) * 2 + (h)) * HTB)
#define PG8_SB(b, h) ((4 + (b) * 2 + (h)) * HTB)
#define PG8_STAGE(bufoff, gbase, voff) do { _Pragma("unroll") for (int _i = 0; _i < 2; ++_i) \
        __builtin_amdgcn_global_load_lds((const unsigned*)((const char*)(gbase) + (voff)[_i]), (LAS unsigned*)(lds + (bufoff) + ldsw + _i * 8192), 16, 0, 0); } while (0)
#define PG8_LDA(dst, b, h) do { _Pragma("unroll") for (int m = 0; m < 4; ++m) _Pragma("unroll") for (int k = 0; k < 2; ++k) dst[m][k] = *(const LAS bf16x8*)(lds + PG8_SA(b, h) + aoff + m * 2048 + k * 1024); } while (0)
#define PG8_LDB(dst, b, h) do { _Pragma("unroll") for (int n = 0; n < 2; ++n) _Pragma("unroll") for (int k = 0; k < 2; ++k) dst[n][k] = *(const LAS bf16x8*)(lds + PG8_SB(b, h) + boff + n * 2048 + k * 1024); } while (0)
#define PG8_MMA(ai, bj, At, Bt) do { __builtin_amdgcn_s_setprio(1); _Pragma("unroll") for (int m = 0; m < 4; ++m) _Pragma("unroll") for (int n = 0; n < 2; ++n) _Pragma("unroll") for (int k = 0; k < 2; ++k) \
        acc[ai][bj][m][n] = __builtin_amdgcn_mfma_f32_16x16x32_bf16(Bt[n][k], At[m][k], acc[ai][bj][m][n], 0, 0, 0); __builtin_amdgcn_s_setprio(0); } while (0)
#define PG8_WAIT_V(n) asm volatile("s_waitcnt vmcnt(" #n ")" ::: "memory")
#define PG8_WAIT_L(n) asm volatile("s_waitcnt lgkmcnt(" #n ")" ::: "memory")
#define PG8_BAR __builtin_amdgcn_s_barrier()
#define PG8_SCHED __builtin_amdgcn_sched_barrier(0)
#define PG8_UA(u) ((const char*)g.A + (size_t)(u).sub * g.a_sub + (size_t)(u).pm * tstepA)
#define PG8_UB(u) ((const char*)g.Bt + (size_t)(u).sub * g.b_sub + (size_t)(u).pn * tstepB)
    Unit cur, nxt; int ui = 0;
    if (!S.next(0, cur)) return;
    f32x4 acc[2][2][4][2];
#pragma unroll
    for (int a = 0; a < 2; ++a)
#pragma unroll
        for (int b = 0; b < 2; ++b)
#pragma unroll
            for (int m = 0; m < 4; ++m)
#pragma unroll
                for (int n = 0; n < 2; ++n) acc[a][b][m][n] = (f32x4){0.f, 0.f, 0.f, 0.f};
    bf16x8 At[4][2], B0[2][2], B1[2][2];
    const char* cA = PG8_UA(cur); const char* cB = PG8_UB(cur);
    PG8_STAGE(PG8_SB(0, 0), cB, voffB); PG8_STAGE(PG8_SB(0, 1), cB + hstepB, voffB); PG8_STAGE(PG8_SA(0, 0), cA, voffA); PG8_STAGE(PG8_SA(0, 1), cA + hstepA, voffA);
    if (wr == 1) PG8_BAR;
    PG8_WAIT_V(2); PG8_BAR;
    PG8_STAGE(PG8_SB(1, 0), cB + kstep, voffB); PG8_STAGE(PG8_SA(1, 0), cA + kstep, voffA); PG8_STAGE(PG8_SB(1, 1), cB + hstepB + kstep, voffB);
    PG8_WAIT_V(6); PG8_BAR;
    for (;;) {
        const bool has_next = S.next(ui + 1, nxt);
        const char* nA = has_next ? PG8_UA(nxt) : cA; const char* nB = has_next ? PG8_UB(nxt) : cB;
        for (int t = 0; t < nt; t += 2) {
            const bool last = (t == nt - 2);
            const char* a1 = cA + (size_t)(t + 1) * kstep;
            const char* a2 = last ? nA : cA + (size_t)(t + 2) * kstep; const char* b2 = last ? nB : cB + (size_t)(t + 2) * kstep;
            const char* a3 = a2 + kstep; const char* b3 = b2 + kstep;
            PG8_LDB(B0, 0, 0); PG8_LDB(B1, 0, 1); PG8_SCHED; PG8_LDA(At, 0, 0); PG8_STAGE(PG8_SA(1, 1), a1 + hstepA, voffA);
            PG8_WAIT_V(8); PG8_WAIT_L(0); PG8_BAR; PG8_MMA(0, 0, At, B0); PG8_MMA(0, 1, At, B1); PG8_BAR; PG8_SCHED;
            PG8_LDA(At, 0, 1); PG8_STAGE(PG8_SB(0, 0), b2, voffB); PG8_STAGE(PG8_SB(0, 1), b2 + hstepB, voffB); PG8_STAGE(PG8_SA(0, 0), a2, voffA);
            PG8_WAIT_V(8); PG8_WAIT_L(0); PG8_BAR; PG8_MMA(1, 0, At, B0); PG8_MMA(1, 1, At, B1); PG8_BAR; PG8_SCHED;
            PG8_LDB(B0, 1, 0); PG8_LDB(B1, 1, 1); PG8_SCHED; PG8_LDA(At, 1, 0); PG8_STAGE(PG8_SA(0, 1), a2 + hstepA, voffA);
            PG8_WAIT_V(8); PG8_WAIT_L(0); PG8_BAR; PG8_MMA(0, 0, At, B0); PG8_MMA(0, 1, At, B1); PG8_BAR; PG8_SCHED;
            PG8_LDA(At, 1, 1); PG8_STAGE(PG8_SB(1, 0), b3, voffB); PG8_STAGE(PG8_SB(1, 1), b3 + hstepB, voffB); PG8_STAGE(PG8_SA(1, 0), a3, voffA);
            PG8_WAIT_V(8); PG8_WAIT_L(0); PG8_BAR; PG8_MMA(1, 0, At, B0); PG8_MMA(1, 1, At, B1); PG8_BAR; PG8_SCHED;
        }
        if (wr == 0) PG8_BAR;
        { const int t2 = opq_tid(wv), w2 = __builtin_amdgcn_readfirstlane(t2 >> 6), l2 = t2 & 63; E(acc, cur, w2 >> 2, w2 & 3, l2 & 15, l2 >> 4); }
        if (!has_next) break;
#pragma unroll
        for (int a = 0; a < 2; ++a)
#pragma unroll
            for (int b = 0; b < 2; ++b)
#pragma unroll
                for (int m = 0; m < 4; ++m)
#pragma unroll
                    for (int n = 0; n < 2; ++n) acc[a][b][m][n] = (f32x4){0.f, 0.f, 0.f, 0.f};
        cur = nxt; cA = nA; cB = nB; ++ui;
        if (wr == 1) PG8_BAR;
    }
    PG8_WAIT_V(0);
    PG8_BAR;
#undef PG8_SA
#undef PG8_SB
#undef PG8_STAGE
#undef PG8_LDA
#undef PG8_LDB
#undef PG8_MMA
#undef PG8_WAIT_V
#undef PG8_WAIT_L
#undef PG8_BAR
#undef PG8_SCHED
#undef PG8_UA
#undef PG8_UB
}
}

namespace att {
constexpr float SCALE = 0.08838834764831845f;
constexpr float THR = 8.f;
constexpr int NW = 8, QBLK = 32, KVBLK = 64, QB = NW * QBLK, D = 128;
constexpr int SHM_V = KVBLK * D * 2, SHM_K = KVBLK * D * 2;
constexpr int ATT_LDS = 2 * SHM_V + 2 * SHM_K + NW * 64 * 4;
#define KSWZ(row, colB) ((row) * 256 + ((colB) ^ (((row) & 7) << 4)))
#define SBAR() __builtin_amdgcn_sched_barrier(0)
__device__ __forceinline__ int v_st(int k, int c) { const int kk = (k & ~0xC) | ((k & 4) << 1) | ((k & 8) >> 1); return ((kk >> 3) * 4 + (c >> 5)) * 512 + ((kk & 7) * 32 + (c & 31)) * 2; }
__device__ __forceinline__ int v_rd_base(int lane) { return ((lane & 3) << 3) | (((lane >> 2) & 3) << 6) | (((lane >> 4) & 1) << 5) | (((lane >> 5) & 1) << 8); }
constexpr int v_rd_off(int d0, int ks, int half) { return d0 * 512 + ks * 4096 + half * 2048; }
__device__ __forceinline__ int crow(int r, int hi) { return (r & 3) + 8 * (r >> 2) + 4 * hi; }
__device__ __forceinline__ bf16x8 load8(const bf16_t* p) { return *reinterpret_cast<const bf16x8*>(p); }
__device__ __forceinline__ void mask_tile(f32x16& p0, f32x16& p1, int dq) {
    const float NEG = -__builtin_inff();
#pragma unroll
    for (int r = 0; r < 16; ++r) {
        const int c = (r & 3) + 8 * (r >> 2);
        if (dq - c < 0) p0[r] = NEG;
        if (dq - c - 32 < 0) p1[r] = NEG;
    }
}
__device__ __forceinline__ void mask_all(f32x16& p0, f32x16& p1, bool off) {
    const float NEG = -__builtin_inff();
#pragma unroll
    for (int r = 0; r < 16; ++r) { p0[r] = off ? NEG : p0[r]; p1[r] = off ? NEG : p1[r]; }
}
__device__ __forceinline__ void partialSM(f32x16& p0, f32x16& p1, float& m_reg, float& mn, float& alpha, float rbias = 0.f) {
    float pmax = p0[0];
#pragma unroll
    for (int r = 1; r < 16; ++r) pmax = fmaxf(pmax, p0[r]);
#pragma unroll
    for (int r = 0; r < 16; ++r) pmax = fmaxf(pmax, p1[r]);
    { auto rr = __builtin_amdgcn_permlane32_swap(__float_as_uint(pmax), __float_as_uint(pmax), false, false);
      pmax = fmaxf(__uint_as_float(rr[0]), __uint_as_float(rr[1])); }
    constexpr float C2 = 1.4426950408889634f * SCALE;
    if (__builtin_expect(__all((pmax - m_reg) * SCALE <= THR), 1)) { mn = m_reg; alpha = 1.f; }
    else { mn = fmaxf(m_reg, pmax); alpha = __builtin_amdgcn_exp2f((m_reg - mn) * C2); m_reg = mn; }
    const float mnL = -mn * C2 + rbias;
#pragma unroll
    for (int r = 0; r < 16; ++r) p0[r] = fmaf(p0[r], C2, mnL);
#pragma unroll
    for (int r = 0; r < 16; ++r) p1[r] = fmaf(p1[r], C2, mnL);
#pragma unroll
    for (int r = 0; r < 16; ++r) p0[r] = __builtin_amdgcn_exp2f(p0[r]);
}
__device__ __forceinline__ void finishSM(f32x16& p0, f32x16& p1, float alpha, float& l_reg, bf16x8& pa0, bf16x8& pa1, bf16x8& pa2, bf16x8& pa3) {
#pragma unroll
    for (int r = 0; r < 16; ++r) p1[r] = __builtin_amdgcn_exp2f(p1[r]);
    float ps = 0;
#pragma unroll
    for (int r = 0; r < 16; ++r) ps += p0[r];
#pragma unroll
    for (int r = 0; r < 16; ++r) ps += p1[r];
    { auto rr = __builtin_amdgcn_permlane32_swap(__float_as_uint(ps), __float_as_uint(ps), false, false);
      ps = __uint_as_float(rr[0]) + __uint_as_float(rr[1]); }
    l_reg = l_reg * alpha + ps;
#define PK4(P, B_, OUT) do { unsigned a0 = cvt_pk_bf16(P[B_+0], P[B_+1]), a1 = cvt_pk_bf16(P[B_+2], P[B_+3]);                          \
        unsigned b0 = cvt_pk_bf16(P[B_+4], P[B_+5]), b1 = cvt_pk_bf16(P[B_+6], P[B_+7]);                                             \
        auto r0 = __builtin_amdgcn_permlane32_swap(a0, b0, false, false); auto r1 = __builtin_amdgcn_permlane32_swap(a1, b1, false, false); \
        u32x4 w = {r0[0], r1[0], r0[1], r1[1]}; OUT = *reinterpret_cast<bf16x8*>(&w); } while (0)
    PK4(p0, 0, pa0); PK4(p0, 8, pa1); PK4(p1, 0, pa2); PK4(p1, 8, pa3);
#undef PK4
}
template <int KB>
__device__ __forceinline__ void qkt(f32x16& p0, f32x16& p1, const char* K_lds, int r32, int hi, const bf16x8* qr) {
    p0 = f32x16{}; p1 = f32x16{};
    const char* kb[4];
#pragma unroll
    for (int dd = 0; dd < 4; ++dd) kb[dd] = K_lds + KB * SHM_K + KSWZ(r32, (dd * 16 + hi * 8) * 2);
#pragma unroll
    for (int d0 = 0; d0 < 8; ++d0) { const char* a = kb[d0 & 3] + (d0 >> 2) * 128;
        bf16x8 b0 = *reinterpret_cast<const bf16x8*>(a);
        bf16x8 b1 = *reinterpret_cast<const bf16x8*>(a + 32 * 256);
        p0 = __builtin_amdgcn_mfma_f32_32x32x16_bf16(b0, qr[d0], p0, 0, 0, 0);
        p1 = __builtin_amdgcn_mfma_f32_32x32x16_bf16(b1, qr[d0], p1, 0, 0, 0); }
}
template <int VB>
__device__ __forceinline__ void pv_tile(f32x16* o, int vb0, bf16x8 pa0, bf16x8 pa1, bf16x8 pa2, bf16x8 pa3) {
#define TRRD(dst, off) asm volatile("ds_read_b64_tr_b16 %0, %1 offset:%2" : "=&v"(dst) : "v"(vb0), "i"(off) : "memory")
#define PV_D0(d0) do { s16x4 l0, l1, l2, l3, h0, h1, h2, h3; constexpr int b_ = VB * SHM_V + v_rd_off(d0, 0, 0); \
        TRRD(l0, b_); TRRD(h0, b_ + 2048); TRRD(l1, b_ + 4096); TRRD(h1, b_ + 6144); TRRD(l2, b_ + 8192); TRRD(h2, b_ + 10240); TRRD(l3, b_ + 12288); TRRD(h3, b_ + 14336); \
        asm volatile("s_waitcnt lgkmcnt(0)" ::: "memory"); SBAR();   \
        o[d0] = __builtin_amdgcn_mfma_f32_32x32x16_bf16(pa0, (bf16x8){l0[0], l0[1], l0[2], l0[3], h0[0], h0[1], h0[2], h0[3]}, o[d0], 0, 0, 0);   \
        o[d0] = __builtin_amdgcn_mfma_f32_32x32x16_bf16(pa1, (bf16x8){l1[0], l1[1], l1[2], l1[3], h1[0], h1[1], h1[2], h1[3]}, o[d0], 0, 0, 0);   \
        o[d0] = __builtin_amdgcn_mfma_f32_32x32x16_bf16(pa2, (bf16x8){l2[0], l2[1], l2[2], l2[3], h2[0], h2[1], h2[2], h2[3]}, o[d0], 0, 0, 0);   \
        o[d0] = __builtin_amdgcn_mfma_f32_32x32x16_bf16(pa3, (bf16x8){l3[0], l3[1], l3[2], l3[3], h3[0], h3[1], h3[2], h3[3]}, o[d0], 0, 0, 0); } while (0)
    PV_D0(0); PV_D0(1); PV_D0(2); PV_D0(3);
#undef PV_D0
#undef TRRD
}

struct BlockRef { const bf16_t* Q; const bf16_t* K; const bf16_t* V; bf16_t* O; const bf16_t* Gt; const float* KM; int P0; };
struct Seam { bf16x8 qr[8]; bf16x8 st_v0, st_v1, st_k0, st_k1; };
#define ROW(p, k0, rr) ((p) + (size_t)((k0) + (rr)) * D + sc)
#define VMW() asm volatile("s_waitcnt vmcnt(0)" ::: "memory")
#define VMWN(n) asm volatile("s_waitcnt vmcnt(%0)" :: "i"(n) : "memory")
#define SLOAD_H(Kp, Vp, k0) do { S.st_v0 = load8(ROW(Vp, k0, sr)); S.st_v1 = load8(ROW(Vp, k0, 32 + sr));              \
                         S.st_k0 = load8(ROW(Kp, k0, sr)); S.st_k1 = load8(ROW(Kp, k0, 32 + sr)); } while (0)
#define SWRITE_HK(bf) do { *(bf16x8*)(K_lds + (bf) * SHM_K + kws) = S.st_k0; *(bf16x8*)(K_lds + (bf) * SHM_K + kws + 32 * 256) = S.st_k1; } while (0)
#define SWRITE_HV(bf) do { *(bf16x8*)(V_lds + (bf) * SHM_V + vst0) = S.st_v0; *(bf16x8*)(V_lds + (bf) * SHM_V + vst1) = S.st_v1; } while (0)
#define SWRITE_H(bf) do { SWRITE_HV(bf); SWRITE_HK(bf); } while (0)
__device__ __forceinline__ void moba_prime(const BlockRef& cur, char* lds, Seam& S, int wv) {
    const int tid = opq_tid(wv), wid = __builtin_amdgcn_readfirstlane(tid >> 6), lane = tid & 63, r32 = lane & 31, hi = lane >> 5;
    const int sr = tid >> 4, sc = (tid & 15) * 8, kws = KSWZ(sr, sc * 2); char* K_lds = lds + 2 * SHM_V;
#pragma unroll
    for (int d0 = 0; d0 < 8; ++d0) S.qr[d0] = load8(cur.Q + (size_t)(wid * QBLK + r32) * D + d0 * 16 + hi * 8);
    SLOAD_H(cur.K, cur.V, 0); VMW(); SWRITE_HK(0);
    __syncthreads();
}
__device__ __forceinline__ unsigned moba_select(const Seam& S, const float* KM, int qb, int hi) {
    if (qb <= 3) return (1u << qb) - 1u;
    float sc_[8];
#pragma unroll
    for (int j = 0; j < 8; ++j) sc_[j] = 0.f;
#pragma unroll
    for (int j = 0; j < 7; ++j) {
        if (j < qb) {
            float s = 0.f;
#pragma unroll
            for (int d0 = 0; d0 < 8; ++d0) {
                const f32x4 k0 = *(const f32x4*)(KM + j * D + d0 * 16 + hi * 8), k1 = *(const f32x4*)(KM + j * D + d0 * 16 + hi * 8 + 4);
                const bf16x8 q = S.qr[d0];
                s += bf1((bf16_t)q[0]) * k0[0] + bf1((bf16_t)q[1]) * k0[1] + bf1((bf16_t)q[2]) * k0[2] + bf1((bf16_t)q[3]) * k0[3]
                   + bf1((bf16_t)q[4]) * k1[0] + bf1((bf16_t)q[5]) * k1[1] + bf1((bf16_t)q[6]) * k1[2] + bf1((bf16_t)q[7]) * k1[3];
            }
            s += __shfl_xor(s, 32);
            sc_[j] = s;
        }
    }
    unsigned sel = 0u;
#pragma unroll
    for (int it = 0; it < 3; ++it) {
        float best = -__builtin_inff(); int bi = 0;
#pragma unroll
        for (int j = 0; j < 7; ++j) { const bool ok = (j < qb) && !((sel >> j) & 1u) && (sc_[j] > best); best = ok ? sc_[j] : best; bi = ok ? j : bi; }
        sel |= 1u << bi;
    }
    return sel;
}
__device__ __forceinline__ void moba_block(const BlockRef& cur, const BlockRef& nxt, char* lds, Seam& S, int wv) {
    const int tid = opq_tid(wv), wid = __builtin_amdgcn_readfirstlane(tid >> 6), lane = tid & 63, r32 = lane & 31, hi = lane >> 5;
    const int NT = cur.P0 / KVBLK + 4;
    const int qb = cur.P0 >> 8;
    const int qlo = cur.P0 + wid * QBLK, qm = qlo + r32 - 4 * hi;
    char* V_lds = lds; char* K_lds = lds + 2 * SHM_V;
    float* ws = (float*)(lds + 2 * SHM_V + 2 * SHM_K) + wid * 64; float* li_l = ws, * al_l = ws + 32;
    float m_reg = -1e30f, l_reg = 0; f32x16 o[4] = {};
    const int sr = tid >> 4, sc = (tid & 15) * 8, vst0 = v_st(sr, sc), vst1 = v_st(32 + sr, sc), kws = KSWZ(sr, sc * 2);
    const int vb0 = (int)(uintptr_t)V_lds + v_rd_base(lane);
    const bf16_t* Kh = cur.K; const bf16_t* Vh = cur.V;
    const bool need_sel = qb > 3;
    const float* kml = (const float*)(lds + 69632);
    if (need_sel) { if (tid < 224) ((f32x4*)(lds + 69632))[tid] = ((const f32x4*)cur.KM)[tid]; __syncthreads(); }
    const unsigned sel = moba_select(S, kml, qb, hi);
#define RESC(a) do { if (__any((a) < 1.f)) { if (hi == 0) al_l[r32] = (a); asm volatile("s_waitcnt lgkmcnt(0)" ::: "memory");              \
                     for (int d_ = 0; d_ < 4; ++d_) for (int r = 0; r < 16; ++r) o[d_][r] *= al_l[crow(r, hi)]; } } while (0)
#define KBASE(t) ((t) * KVBLK)
#define MASKT(P0_, P1_, t) do { const int kb_ = KBASE(t); rb_ = 0.f; \
        if (kb_ < cur.P0) { if (need_sel) rb_ = (((sel >> (kb_ >> 8)) & 1u) == 0u) ? -__builtin_inff() : 0.f; } \
        else if (kb_ + KVBLK - 1 > qlo) mask_tile(P0_, P1_, qm - kb_); } while (0)
#define SEAM_K0() do { VMWN(8); SWRITE_HK(0); SBAR(); } while (0)
    f32x16 pA0, pA1, pB0, pB1; float mnA, mnB, alA, alB, rb_ = 0.f; bf16x8 pa0, pa1, pa2, pa3;
    SWRITE_HV(0); SBAR();
    SLOAD_H(Kh, Vh, KBASE(1));
    SBAR(); qkt<0>(pA0, pA1, K_lds, r32, hi, S.qr);
    MASKT(pA0, pA1, 0); partialSM(pA0, pA1, m_reg, mnA, alA, rb_);
    VMW(); SWRITE_H(1);
    __syncthreads();
#define HALF_STEP(PX0, PX1, mnX, alX, PY0, PY1, alY, t, KB, VB, SB) do {                                                      \
        SBAR(); qkt<KB>(PX0, PX1, K_lds, r32, hi, S.qr);                                                                       \
        finishSM(PY0, PY1, alY, l_reg, pa0, pa1, pa2, pa3); SBAR();                                                           \
        if ((t) + 1 < NT) { SLOAD_H(Kh, Vh, KBASE((t) + 1)); SBAR(); }                                                        \
        pv_tile<VB>(o, vb0, pa0, pa1, pa2, pa3); MASKT(PX0, PX1, (t)); partialSM(PX0, PX1, m_reg, mnX, alX, rb_);                  \
        __syncthreads();                                                                                                      \
        if ((t) + 1 < NT) { VMW(); SWRITE_H(SB); }                                                                            \
        RESC(alX); __syncthreads(); } while (0)
    for (int t = 1; t + 1 < NT; t += 2) {
        HALF_STEP(pB0, pB1, mnB, alB, pA0, pA1, alA, t, 1, 0, 0);
        HALF_STEP(pA0, pA1, mnA, alA, pB0, pB1, alB, t + 1, 0, 1, 1);
    }
    SBAR(); qkt<1>(pB0, pB1, K_lds, r32, hi, S.qr); SBAR();
    SLOAD_H(nxt.K, nxt.V, 0); SBAR();
#pragma unroll
    for (int d0 = 0; d0 < 8; ++d0) S.qr[d0] = load8(nxt.Q + (size_t)(wid * QBLK + r32) * D + d0 * 16 + hi * 8);
    SBAR();
    finishSM(pA0, pA1, alA, l_reg, pa0, pa1, pa2, pa3); SBAR();
    pv_tile<0>(o, vb0, pa0, pa1, pa2, pa3);
    MASKT(pB0, pB1, NT - 1); partialSM(pB0, pB1, m_reg, mnB, alB, rb_); __syncthreads(); RESC(alB);
    finishSM(pB0, pB1, alB, l_reg, pa0, pa1, pa2, pa3); SBAR(); pv_tile<1>(o, vb0, pa0, pa1, pa2, pa3);
    SBAR(); SEAM_K0();
    if (hi == 0) li_l[r32] = l_reg; asm volatile("s_waitcnt lgkmcnt(0)" ::: "memory");
    bf16_t* Ow = cur.O + (size_t)(wid * QBLK) * DM; const bf16_t* Gw = cur.Gt + (size_t)(wid * QBLK) * DM + r32;
    bf16_t gl[16][4];
#pragma unroll
    for (int r = 0; r < 16; ++r)
#pragma unroll
        for (int d0 = 0; d0 < 4; ++d0) gl[r][d0] = Gw[(size_t)crow(r, hi) * DM + d0 * 32];
#pragma unroll
    for (int r = 0; r < 16; ++r) { const int orow = crow(r, hi); const float rl = __builtin_amdgcn_rcpf(li_l[orow]);
#pragma unroll
        for (int d0 = 0; d0 < 4; ++d0) { const float gv = bf1(gl[r][d0]);
            const float v = o[d0][r] * rl * gv;
            const float vn = __shfl_xor(v, 1);
            if ((r32 & 1) == 0) *(unsigned*)(Ow + (size_t)orow * DM + d0 * 32 + r32) = cvt_pk_bf16(v, vn); } }
    __syncthreads();
#undef RESC
#undef KBASE
#undef MASKT
#undef SEAM_K0
#undef HALF_STEP
}
#undef ROW
#undef VMW
#undef VMWN
#undef SLOAD_H
#undef SWRITE_HK
#undef SWRITE_HV
#undef SWRITE_H

__device__ __forceinline__ BlockRef mk_ref(int L, int pass, const bf16_t* Q, const bf16_t* K, const bf16_t* V, bf16_t* O, const bf16_t* Gt, const float* KM) {
    const int bh = L >> 2, x = L & 3, qb = pass ? 7 - x : x, b = bh >> 3, h = bh & 7;
    BlockRef r;
    r.Q = Q + ((size_t)bh * SEQ + (size_t)qb * QB) * D; r.K = K + (size_t)bh * SEQ * D; r.V = V + (size_t)bh * SEQ * D;
    r.O = O + ((size_t)b * SEQ + (size_t)qb * QB) * DM + h * DH; r.Gt = Gt + ((size_t)b * SEQ + (size_t)qb * QB) * DM + h * DH;
    r.KM = KM + (size_t)bh * 8 * D; r.P0 = qb * QB;
    return r;
}
__device__ __forceinline__ void attn_phase(char* lds, const bf16_t* Q, const bf16_t* K, const bf16_t* V, bf16_t* O, const bf16_t* Gt, const float* KM, int wv) {
    const int total = NB * NH * 4, stride = gridDim.x;
    int L = opq_bid(); if (L >= total) return;
    if (stride == 256) { const int xcd = L & 7, j = L >> 3; L = ((xcd * 8 + (j >> 2)) << 2) | (j & 3); }
    int pass = 0;
    BlockRef cur = mk_ref(L, 0, Q, K, V, O, Gt, KM);
    Seam S;
    moba_prime(cur, lds, S, wv);
    for (;;) {
        const bool more_pass = pass == 0, more_item = L + stride < total, last = !more_pass && !more_item;
        int passn = pass + 1, Ln = L;
        if (!more_pass) { passn = 0; Ln = more_item ? L + stride : L; }
        const BlockRef nxt = last ? cur : mk_ref(Ln, passn, Q, K, V, O, Gt, KM);
        moba_block(cur, nxt, lds, S, wv);
        if (last) break;
        cur = nxt; pass = passn; L = Ln;
    }
}
}

#ifndef REP_MASK
#define REP_MASK 0
#endif
#ifndef BAR_REP
#define BAR_REP 1
#endif
struct Args { const float* in[21]; float* out; unsigned char* ws; int ph_lo, ph_hi; };
typedef const __attribute__((address_space(4))) Args* ArgsP;
#define AIN(i) ((const float*)ap->in[i])

__device__ __forceinline__ void transpose_item(const float* W, int ldw, bf16_t* WT, int ldt, LAS float* scr, int lane) {
    float tv[32];
#pragma unroll
    for (int i = 0; i < 32; ++i) { const int kk = 2 * i + (lane >> 5); tv[i] = __builtin_nontemporal_load(W + (size_t)kk * ldw + (lane & 31)); }
#pragma unroll
    for (int i = 0; i < 32; ++i) { const int kk = 2 * i + (lane >> 5); scr[kk * 33 + (lane & 31)] = tv[i]; }
    asm volatile("s_waitcnt lgkmcnt(0)" ::: "memory");
    const int c = lane & 7;
#pragma unroll
    for (int j = 0; j < 4; ++j) { const int n = (lane >> 3) + 8 * j; const LAS float* s = scr + (8 * c) * 33 + n;
        u32x4 o; o.x = cvt_pk_bf16(s[0 * 33], s[1 * 33]); o.y = cvt_pk_bf16(s[2 * 33], s[3 * 33]); o.z = cvt_pk_bf16(s[4 * 33], s[5 * 33]); o.w = cvt_pk_bf16(s[6 * 33], s[7 * 33]);
        *(u32x4*)(WT + (size_t)n * ldt + 8 * c) = o; }
    asm volatile("s_waitcnt lgkmcnt(0)" ::: "memory");
}
__device__ __forceinline__ void transpose_mat(const float* W, int K, int N, bf16_t* WT, int item, LAS float* scr, int lane) {
    const int nblk = N / 32, kb = item / nblk, nb = item % nblk;
    transpose_item(W + (size_t)(64 * kb) * N + 32 * nb, N, WT + (size_t)(32 * nb) * K + 64 * kb, K, scr, lane);
}

template <bool SILU>
__device__ __forceinline__ void gemv_item(const float* vec, int vld, const float* W, int ldw, int n0, int k0, float* out, int old, const float* bias, LAS float* scr, int lane) {
    const float* wp = W + (size_t)k0 * ldw + n0 + lane;
#pragma unroll
    for (int i = 0; i < 8; ++i) { const int idx = i * 64 + lane, b = idx >> 6, kk = idx & 63; const float v = vec[(size_t)b * vld + k0 + kk]; scr[kk * 8 + b] = SILU ? fsilu(v) : v; }
    asm volatile("s_waitcnt lgkmcnt(0)" ::: "memory");
    float acc[8];
#pragma unroll
    for (int b = 0; b < 8; ++b) acc[b] = 0.f;
#pragma unroll 1
    for (int kh = 0; kh < 64; kh += 32) {
        float w[32];
#pragma unroll
        for (int kk = 0; kk < 32; ++kk) w[kk] = SILU ? __builtin_nontemporal_load(wp + (size_t)(kh + kk) * ldw) : wp[(size_t)(kh + kk) * ldw];
#pragma unroll
        for (int kk = 0; kk < 32; ++kk) {
            const f32x4 c0 = *(const LAS f32x4*)(scr + (kh + kk) * 8), c1 = *(const LAS f32x4*)(scr + (kh + kk) * 8 + 4);
            acc[0] += w[kk] * c0[0]; acc[1] += w[kk] * c0[1]; acc[2] += w[kk] * c0[2]; acc[3] += w[kk] * c0[3];
            acc[4] += w[kk] * c1[0]; acc[5] += w[kk] * c1[1]; acc[6] += w[kk] * c1[2]; acc[7] += w[kk] * c1[3];
            if ((kk & 3) == 3) __builtin_amdgcn_sched_barrier(0); }
    }
    const float bv = bias ? bias[n0 + lane] : 0.f;
#pragma unroll
    for (int b = 0; b < 8; ++b) atomicAdd(out + (size_t)b * old + n0 + lane, acc[b] + bv);
    asm volatile("s_waitcnt lgkmcnt(0)" ::: "memory");
}
__device__ __forceinline__ void prep0_phase(ArgsP ap, LAS unsigned char* lds, int wave, int lane) {
    unsigned char* ws = (unsigned char*)ap->ws;
    LAS float* scr = (LAS float*)(lds + wave * 16384);
    const int gw = opq_bid() * NWAVES + wave, NGW = gridDim.x * NWAVES;
    for (int r = gw; r < (MODV_LD / 64) * 16; r += NGW) {
        const int cgp = r >> 4, kc = r & 15;
        const float* W; int ldw, n0; const float* bias;
        if (cgp < 192) { const int l = cgp / 48; n0 = (cgp % 48) * 64; W = AIN(2) + (size_t)l * DM * 3 * DM; ldw = 3 * DM; bias = AIN(3) + l * 3 * DM; }
        else { n0 = (cgp - 192) * 64; W = AIN(15); ldw = 2 * DM; bias = AIN(16); }
        gemv_item<true>(AIN(1), DM, W, ldw, n0, kc * 64, (float*)(ws + WS_MODV) + (cgp * 64 - n0), MODV_LD, kc == 0 ? bias : nullptr, scr, lane);
    }
}
__device__ __forceinline__ void prep1_phase(ArgsP ap, LAS unsigned char* lds, int wave, int lane) {
    unsigned char* ws = (unsigned char*)ap->ws;
    LAS float* scr = (LAS float*)(lds + wave * 16384);
    const int gw = opq_bid() * NWAVES + wave, NGW = gridDim.x * NWAVES;
    constexpr int I_BIG = (DM / 64) * (2 * DM / 32);
    constexpr int I_SQ = (DM / 64) * (DM / 32);
    constexpr int I_G = (256 / 64) * (256 / 32);
    constexpr int N_T = 2 * I_BIG + 2 * I_SQ + 2 * I_BIG + I_BIG + 2 * I_SQ + 16 * I_G;
    constexpr int N_GEMV = 4 * 32 * 16;
    for (int it = gw; it < N_T + N_GEMV; it += NGW) {
        int r = it;
        if (r < N_GEMV) {
            const int slot = r >> 9, q = r & 511, cgp = q >> 4, kc = q & 15;
            const size_t woff = slot == 0 ? (size_t)DM * 2 * DM : slot == 3 ? (size_t)DM * 2 * DM : 0;
            const float* W = (slot == 0 ? AIN(5) : slot == 2 ? AIN(17) : AIN(18)) + woff;
            const int shcol = slot == 0 ? 1 * 3 * DM : slot == 1 ? 2 * 3 * DM : slot == 2 ? 4 * 3 * DM : 3 * 3 * DM;
            gemv_item<false>((const float*)(ws + WS_MODV) + shcol, MODV_LD, W, 2 * DM, cgp * 64, kc * 64, (float*)(ws + WS_SHW) + (size_t)slot * 8 * 2 * DM, 2 * DM, nullptr, scr, lane);
            continue;
        } r -= N_GEMV;
        const float* W; bf16_t* WT; int ldw, ldt;
        if (r < 6 * I_BIG + 0 * I_SQ && r < 2 * I_BIG) { const int l = r / I_BIG, item = r % I_BIG, kb = item / 64, nb = item % 64;
            W = AIN(5) + (size_t)l * DM * 2 * DM + (size_t)(64 * kb) * 2 * DM + 32 * nb; ldw = 2 * DM; WT = (bf16_t*)(ws + WS_WIN) + (size_t)l * 2 * DM * DM + (size_t)(32 * nb) * DM + 64 * kb; ldt = DM; }
        else if ((r -= 2 * I_BIG) < 2 * I_SQ) { const int l = r / I_SQ, item = r % I_SQ, kb = item / 32, nb = item % 32;
            W = AIN(13) + (size_t)l * DM * DM + (size_t)(64 * kb) * DM + 32 * nb; ldw = DM; WT = (bf16_t*)(ws + WS_WOUT) + (size_t)l * DM * DM + (size_t)(32 * nb) * DM + 64 * kb; ldt = DM; }
        else if ((r -= 2 * I_SQ) < 2 * I_BIG) { const int l = r / I_BIG, item = r % I_BIG, kb = item / 64, nb = item % 64;
            W = AIN(18) + (size_t)l * DM * 2 * DM + (size_t)(64 * kb) * 2 * DM + 32 * nb; ldw = 2 * DM; WT = (bf16_t*)(ws + (l ? WS_ATTIN1 : WS_ATTIN0)) + (size_t)(32 * nb) * DM + 64 * kb; ldt = DM; }
        else if ((r -= 2 * I_BIG) < I_BIG) { const int kb = r / 64, nb = r % 64;
            W = AIN(17) + (size_t)(64 * kb) * 2 * DM + 32 * nb; ldw = 2 * DM; WT = (bf16_t*)(ws + WS_WKV) + (size_t)(32 * nb) * DM + 64 * kb; ldt = DM; }
        else if ((r -= I_BIG) < 2 * I_SQ) { const int l = r / I_SQ, item = r % I_SQ, kb = item / 32, nb = item % 32;
            W = AIN(19) + (size_t)l * DM * DM + (size_t)(64 * kb) * DM + 32 * nb; ldw = DM; WT = (bf16_t*)(ws + WS_ATTOUT) + (size_t)l * DM * DM + (size_t)(32 * nb) * DM + 64 * kb; ldt = DM; }
        else { r -= 2 * I_SQ;
            const int mat = r / I_G, item = r % I_G, which = mat >> 3, lh = mat & 7;
            const int kb = item / 8, nb = item % 8, n0 = 32 * nb, drow = 256 * (n0 >> 7) + 128 * which + (n0 & 127);
            W = (which ? AIN(10) : AIN(8)) + (size_t)lh * 256 * 256 + (size_t)(64 * kb) * 256 + n0; ldw = 256;
            WT = (bf16_t*)(ws + WS_WG) + (size_t)lh * 512 * 256 + (size_t)drow * 256 + 64 * kb; ldt = 256; }
        transpose_item(W, ldw, WT, ldt, scr, lane);
    }
}

__device__ __forceinline__ void norm_phase(const float* xin, bf16_t* o1, const float* g1, const float* modv, int sh1, int sc1c,
                                            bf16_t* o2, const float* g2, int sh2, int sc2c, int wave, int lane) {
    const int gw = opq_bid() * NWAVES + wave, NGW = gridDim.x * NWAVES;
    for (int rb = gw; rb < MTOK / 8; rb += NGW) {
        const int r0 = rb * 8, b = r0 / SEQ;
        const float* mv = modv + (size_t)b * MODV_LD;
        f32x4 gs1[4], sf1[4], gs2[4], sf2[4];
#pragma unroll
        for (int j = 0; j < 4; ++j) { const int idx = 4 * lane + 256 * j;
            const f32x4 gv = *(const f32x4*)(g1 + idx), sc = *(const f32x4*)(mv + sc1c + idx); gs1[j] = gv * (sc + 1.f); sf1[j] = *(const f32x4*)(mv + sh1 + idx);
            if (o2) { const f32x4 gv2 = *(const f32x4*)(g2 + idx), sc2 = *(const f32x4*)(mv + sc2c + idx); gs2[j] = gv2 * (sc2 + 1.f); sf2[j] = *(const f32x4*)(mv + sh2 + idx); }
            else { gs2[j] = gs1[j]; sf2[j] = sf1[j]; } }
        for (int rr = 0; rr < 8; ++rr) {
            const size_t row = (size_t)(r0 + rr);
            const f32x4* xr = (const f32x4*)(xin + row * DM) + lane;
            f32x4 v[4]; float s = 0.f;
#pragma unroll
            for (int j = 0; j < 4; ++j) { v[j] = xr[64 * j]; s += (v[j].x * v[j].x + v[j].y * v[j].y) + (v[j].z * v[j].z + v[j].w * v[j].w); }
            const float rstd = 1.f / sqrtf(wave_sum(s) * (1.f / DM) + EPS);
#pragma unroll
            for (int j = 0; j < 4; ++j) { const f32x4 t = v[j] * rstd; const f32x4 y = t * gs1[j] + sf1[j];
                u32x2 w; w.x = cvt_pk_bf16(y.x, y.y); w.y = cvt_pk_bf16(y.z, y.w);
                *((u32x2*)(o1 + row * DM) + lane + 64 * j) = w;
                if (o2) { const f32x4 y2 = t * gs2[j] + sf2[j]; u32x2 w2; w2.x = cvt_pk_bf16(y2.x, y2.y); w2.y = cvt_pk_bf16(y2.z, y2.w);
                    *((u32x2*)(o2 + row * DM) + lane + 64 * j) = w2; } }
        }
    }
}
__device__ __forceinline__ void conv_phase(const bf16_t* UP, bf16_t* U, const float* cw, const float* cb, int tid) {
    const int ch = 8 * (tid & 127), sub = tid >> 7;
    float w0[8], w1[8], w2[8], w3[8], bb[8];
#pragma unroll
    for (int h = 0; h < 2; ++h) { const f32x4 a = *(const f32x4*)(cw + ch + 4 * h), b = *(const f32x4*)(cw + DM + ch + 4 * h), c = *(const f32x4*)(cw + 2 * DM + ch + 4 * h), d = *(const f32x4*)(cw + 3 * DM + ch + 4 * h), e = *(const f32x4*)(cb + ch + 4 * h);
#pragma unroll
        for (int j = 0; j < 4; ++j) { w0[4 * h + j] = a[j]; w1[4 * h + j] = b[j]; w2[4 * h + j] = c[j]; w3[4 * h + j] = d[j]; bb[4 * h + j] = e[j]; } }
    for (int it = opq_bid(); it < NB * 32; it += gridDim.x) {
        const int b = it >> 5, c = it & 31, t0 = c * 64 + sub * 16; const size_t base = ((size_t)b * SEQ + t0) * DM + ch;
        u32x4 rw[19];
#pragma unroll
        for (int t = 0; t < 19; ++t) rw[t] = (t0 + t - 3 >= 0) ? *(const u32x4*)(UP + base + (ptrdiff_t)(t - 3) * DM) : (u32x4){0u, 0u, 0u, 0u};
#pragma unroll
        for (int t = 0; t < 16; ++t) {
            unsigned ow[4];
#pragma unroll
            for (int q = 0; q < 4; ++q) { const unsigned a0 = rw[t][q], a1 = rw[t + 1][q], a2 = rw[t + 2][q], a3 = rw[t + 3][q];
                const float lo = bb[2 * q] + w0[2 * q] * bf_lo(a0) + w1[2 * q] * bf_lo(a1) + w2[2 * q] * bf_lo(a2) + w3[2 * q] * bf_lo(a3);
                const float hi = bb[2 * q + 1] + w0[2 * q + 1] * bf_hi(a0) + w1[2 * q + 1] * bf_hi(a1) + w2[2 * q + 1] * bf_hi(a2) + w3[2 * q + 1] * bf_hi(a3);
                ow[q] = cvt_pk_bf16(lo, hi); }
            *(u32x4*)(U + base + (size_t)t * DM) = (u32x4){ow[0], ow[1], ow[2], ow[3]}; }
    }
}

#define XB_TMO      128
#define XB_XCNT(j)  (256  + 64 * (j))
#define XB_XSUB(j)  (1280 + 64 * (j))
#define XB_XGEN(j)  (2304 + 64 * (j))
#define XB_TOP      3328
#define XB_TOPGEN   3392
#define XCD_BAR_WORDS 3456
#define XB_SPIN_CAP (1u << 18)
constexpr size_t WS_BAR = 16384;
constexpr int LDS_MISC = 131072 + 320;
__device__ __forceinline__ unsigned xb_ld(unsigned* p)              { return __hip_atomic_load(p, __ATOMIC_RELAXED, __HIP_MEMORY_SCOPE_AGENT); }
__device__ __forceinline__ unsigned xb_add(unsigned* p, unsigned v) { return __hip_atomic_fetch_add(p, v, __ATOMIC_RELAXED, __HIP_MEMORY_SCOPE_AGENT); }
__device__ __forceinline__ unsigned xb_xcc_id() { return (unsigned)__builtin_amdgcn_s_getreg((3 << 11) | 20) & 0xFu; }
#define XB_SPIN(cond, bar) do { unsigned _sp = 0; while (cond) { __builtin_amdgcn_s_sleep(1); \
    if ((++_sp & 255u) == 0u) { if (xb_ld(&(bar)[XB_TMO])) break; if (_sp > XB_SPIN_CAP) { atomicAdd(&(bar)[XB_TMO], 1u); break; } } } } while (0)
__device__ __forceinline__ void xcd_barrier_complete(unsigned* bar, unsigned x, unsigned& nloc, unsigned& nx) {
    const unsigned G = gridDim.x * gridDim.y * gridDim.z;
    unsigned sum, cnt, mine, sp = 0u;
    for (;;) {
        sum = 0u; cnt = 0u; mine = 0u;
#pragma unroll
        for (unsigned j = 0; j < 16; ++j) { const unsigned c = xb_ld(&bar[XB_XCNT(j)]); sum += c; cnt += (c > 0u) ? 1u : 0u; mine = (j == x) ? c : mine; }
        if (sum == G) break;
        __builtin_amdgcn_s_sleep(1);
        if ((++sp & 255u) == 0u) { if (xb_ld(&bar[XB_TMO])) break; if (sp > XB_SPIN_CAP) { atomicAdd(&bar[XB_TMO], 1u); break; } }
    }
    nloc = mine > 0u ? mine : 1u; nx = cnt > 0u ? cnt : 1u;
}
__device__ __forceinline__ void xcd_barrier(unsigned* bar, volatile LAS unsigned* st, int tid) {
    asm volatile("s_waitcnt vmcnt(0)" ::: "memory");
    __syncthreads();
    if (tid == 0) {
        const unsigned x = xb_xcc_id();
        __builtin_amdgcn_s_waitcnt(0);
        unsigned nloc = st[0], nx = st[1];
        if (nloc == 0u) { xcd_barrier_complete(bar, x, nloc, nx); st[0] = nloc; st[1] = nx; }
        const unsigned old = xb_add(&bar[XB_XSUB(x)], 1u);
        const unsigned gen = old / nloc;
        if (old + 1u == (gen + 1u) * nloc) {
            __builtin_amdgcn_fence(__ATOMIC_RELEASE, "agent");
            asm volatile("s_waitcnt vmcnt(0)" ::: "memory");
            const unsigned og = xb_add(&bar[XB_TOP], 1u);
            const unsigned tg = og / nx;
            if (og + 1u == (tg + 1u) * nx) xb_add(&bar[XB_TOPGEN], 1u);
            else XB_SPIN(xb_ld(&bar[XB_TOPGEN]) == tg, bar);
            __builtin_amdgcn_fence(__ATOMIC_ACQUIRE, "agent");
            xb_add(&bar[XB_XGEN(x)], 1u);
            asm volatile("s_waitcnt vmcnt(0)" ::: "memory");
        } else {
            XB_SPIN(xb_ld(&bar[XB_XGEN(x)]) == gen, bar);
            __builtin_amdgcn_fence(__ATOMIC_ACQUIRE, "agent");
            asm volatile("s_waitcnt vmcnt(0)" ::: "memory");
        }
    }
    __syncthreads();
}

constexpr int NPHASE = 14;
#ifndef PH_EN
#define PH_EN 0xFFFF
#endif
#define EN(b) ((PH_EN >> (b)) & 1)
#ifndef REP_MASK
#define REP_MASK 0
#endif
#define REPS(b) for (int rep_ = 0; rep_ < EN(b) * (1 + ((REP_MASK >> (b)) & 1)); ++rep_)
template <int ph>
__device__ __forceinline__ void run_phase(unsigned char* lds, int wv) {
    LAS unsigned char* ldsl = (LAS unsigned char*)lds;
    {
        ArgsP ap = (ArgsP)__builtin_amdgcn_kernarg_segment_ptr();
        asm volatile("" : "+s"(ap));
        const int G = gridDim.x;
        unsigned char* ws = (unsigned char*)ap->ws;
        float* modv = (float*)(ws + WS_MODV);
        float* kmean = (float*)(ws + WS_KMEAN);
        bf16_t* HN = (bf16_t*)(ws + WS_HN); bf16_t* HKV = (bf16_t*)(ws + WS_HKV); bf16_t* UPRE = (bf16_t*)(ws + WS_UPRE); bf16_t* GB = (bf16_t*)(ws + WS_G);
        bf16_t* LAb = (bf16_t*)(ws + WS_LA); bf16_t* BINb = (bf16_t*)(ws + WS_BIN);
        float* xw = (float*)ap->out;
        const int tid = opq_tid(wv), c = opq_bid();
        const int lane = tid & 63, wave = __builtin_amdgcn_readfirstlane(tid >> 6);
        float* sumsq = (float*)(ws + WS_SUMSQ); const float* shw = (const float*)(ws + WS_SHW);
        if (ph == 0) {
            if (EN(0)) prep0_phase(ap, ldsl, wave, lane);
        } else if (ph == 1) {
            REPS(1) norm_phase(AIN(0), HN, AIN(4), modv, 0, DM, nullptr, nullptr, 0, 0, wave, lane);
            if (EN(0)) prep1_phase(ap, ldsl, wave, lane);
        } else if (ph <= 7) {
            const int l = (ph - 2) / 3, k3 = (ph - 2) % 3, k = k3 == 0 ? 0 : k3 + 1;
            const float* xin = (l == 0) ? AIN(0) : xw;
            if (k == 0) {
                pg8::Gemm g{l == 0 ? HN : HKV, (const bf16_t*)(ws + WS_WIN) + (size_t)l * 2 * DM * DM, DM, DM, DM, 0, 0};
                int one = 1; asm volatile("" : "+s"(one));
                { pg8::InOrder S{c, one, 0};
                  pg8::EpiSplitConv E{ws, l == 0 ? nullptr : sumsq, shw, AIN(6) + l * 4 * DM, AIN(7) + l * DM, 4u * (unsigned)(l + 1), ldsl};
                  REPS(2) pg8::gemm_phase(ldsl, g, S, E, wv); }
                { pg8::InOrder S{c, one, 1};
                  pg8::EpiSplit E{UPRE, GB, l == 0 ? nullptr : sumsq, shw};
                  REPS(2) pg8::gemm_phase(ldsl, g, S, E, wv); }
            } else if (k == 1) {
                REPS(3) conv_phase(UPRE, HKV, AIN(6) + l * 4 * DM, AIN(7) + l * DM, tid);
            } else if (k == 2) {
                pg8::Gemm g{UPRE, (const bf16_t*)(ws + WS_WG) + (size_t)l * 4 * 512 * 256, DM, 256, 256, 256 * 2, 512 * 256 * 2};
                int two = 2; asm volatile("" : "+s"(two));
                pg8::GatesOrder S{c, two};
                pg8::EpiGatesS E{ws, 4u * (unsigned)(l + 1), AIN(9) + l * DM, AIN(11) + l * DM, AIN(12) + l * DM, ldsl};
                REPS(4) pg8::gemm_phase(ldsl, g, S, E, wv);
            } else {
                pg8::Gemm g{HN, (const bf16_t*)(ws + WS_WOUT) + (size_t)l * DM * DM, DM, DM, DM, 0, 0};
                pg8::MultiOrder S; S.init(MTOK, DM, 1, G, c);
                _Float16* x16 = (_Float16*)(ws + WS_X16);
                if (l == 0) { pg8::EpiResH<float, false> E{AIN(0), x16, modv + 2 * DM, modv, HKV, AIN(4) + DM, 3 * DM + DM, nullptr, nullptr, 0, sumsq};
                    REPS(7) pg8::gemm_phase(ldsl, g, S, E, wv); }
                else { pg8::EpiResH<_Float16, true> E{x16, x16, modv + l * 3 * DM + 2 * DM, modv, HKV, AIN(4) + (l + 1) * DM, (l + 1) * 3 * DM + DM,
                              LAb, AIN(14), 4 * 3 * DM + DM, sumsq + (size_t)l * MTOK};
                    REPS(7) pg8::gemm_phase(ldsl, g, S, E, wv); }
            }
        } else if (ph <= 13) {
            const int i = (ph - 8) / 3, k = (ph - 8) % 3, l = 2 + i;
            if (k == 0) {
                pg8::Gemm g{i == 0 ? HKV : LAb, (const bf16_t*)(ws + (i == 0 ? WS_ATTIN0 : WS_ATTIN1)), DM, DM, DM, (long)(WS_LA - WS_HKV), (long)(WS_WKV - WS_ATTIN0)};
                pg8::MultiOrder S; S.init(MTOK, 2 * DM, i == 0 ? 2 : 1, G, c);
                pg8::EpiQKV E{ws, kmean, sumsq + (size_t)(1 + i) * MTOK, shw + (size_t)(i == 0 ? 1 : 3) * 8 * 2 * DM, 8 * 2 * DM};
                REPS(9) pg8::gemm_phase(ldsl, g, S, E, wv);
            } else if (k == 1) {
                REPS(10) att::attn_phase((char*)lds, UPRE, HN, BINb, HKV, GB, kmean, wv);
            } else if (i == 0) {
                pg8::Gemm g{HKV, (const bf16_t*)(ws + WS_ATTOUT), DM, DM, DM, 0, 0};
                pg8::MultiOrder S; S.init(MTOK, DM, 1, G, c);
                _Float16* x16 = (_Float16*)(ws + WS_X16);
                pg8::EpiResH<_Float16, false> E{x16, x16, modv + l * 3 * DM + 2 * DM, modv, LAb, AIN(4) + 3 * DM, 3 * 3 * DM + DM, nullptr, nullptr, 0, sumsq + (size_t)2 * MTOK};
                REPS(11) pg8::gemm_phase(ldsl, g, S, E, wv);
            } else {
                pg8::Gemm g{HKV, (const bf16_t*)(ws + WS_ATTOUT) + (size_t)DM * DM, DM, DM, DM, 0, 0};
                pg8::MultiOrder S; S.init(MTOK, DM, 1, G, c);
                pg8::EpiFinal E{(const _Float16*)(ws + WS_X16), xw, modv + l * 3 * DM + 2 * DM, AIN(20), sumsq + (size_t)3 * MTOK, (unsigned*)(ws + WS_PCNT)};
                REPS(12) pg8::gemm_phase(ldsl, g, S, E, wv);
            }
        }
    }
}
__global__ void __launch_bounds__(NTHR, 2) yoco_fwd(Args a_) {
    extern __shared__ __attribute__((aligned(16))) unsigned char lds[];
    const int ph_lo = a_.ph_lo, ph_hi = a_.ph_hi;
    const int wv = __builtin_amdgcn_readfirstlane((int)threadIdx.x >> 6);
    if (ph_hi - ph_lo > 1) {
        if (threadIdx.x < 8) ((volatile LAS unsigned*)((LAS unsigned char*)lds + LDS_MISC))[threadIdx.x] = 0u;
        if (threadIdx.x == 0) (void)xb_add(&((unsigned*)(a_.ws + WS_BAR))[XB_XCNT(xb_xcc_id())], 1u);
        __syncthreads();
    }
    if (ph_lo < 0) cg::this_grid().sync();
#define SEAM(P) do { ArgsP ap_ = (ArgsP)__builtin_amdgcn_kernarg_segment_ptr(); asm volatile("" : "+s"(ap_)); \
        xcd_barrier((unsigned*)((unsigned char*)ap_->ws + WS_BAR), (volatile LAS unsigned*)((LAS unsigned char*)lds + LDS_MISC), opq_tid(wv)); } while (0)
#ifndef TPROBE_MASK
#define TPROBE_MASK 0
#endif
#define TPROBE_MULT 10
#define TP_ON(P) ((TPROBE_MASK >> (P)) & 1)
#define TP_BEGIN(P) if (TP_ON(P) && blockIdx.x == 0 && opq_tid(wv) == 0) { volatile LAS unsigned long long* tw_ = (volatile LAS unsigned long long*)((LAS unsigned char*)lds + LDS_MISC + 16); tw_[1] = __builtin_amdgcn_s_memrealtime(); }
#define TP_END(P) if (TP_ON(P) && blockIdx.x == 0 && opq_tid(wv) == 0) { volatile LAS unsigned long long* tw_ = (volatile LAS unsigned long long*)((LAS unsigned char*)lds + LDS_MISC + 16); tw_[0] = tw_[0] + (__builtin_amdgcn_s_memrealtime() - tw_[1]); }
#define RUN(P) if ((P) >= ph_lo && (P) < ph_hi) { TP_BEGIN(P) run_phase<P>(lds, wv); if ((P) + 1 < ph_hi) { for (int br_ = 0; br_ < BAR_REP; ++br_) SEAM(P); } TP_END(P) }
    RUN(0) RUN(1) RUN(2) RUN(3) RUN(4) RUN(5) RUN(6) RUN(7) RUN(8) RUN(9) RUN(10) RUN(11)
    RUN(12) RUN(13)
#undef RUN
#undef SEAM
    if (TPROBE_MASK != 0 && blockIdx.x == 0 && opq_tid(wv) == 0) {
        volatile LAS unsigned long long* tw_ = (volatile LAS unsigned long long*)((LAS unsigned char*)lds + LDS_MISC + 16);
        const unsigned long long span = tw_[0] * TPROBE_MULT, t0 = __builtin_amdgcn_s_memrealtime();
        while (__builtin_amdgcn_s_memrealtime() - t0 < span) __builtin_amdgcn_s_sleep(8);
    }
}

extern "C" void kernel_launch(void* const* d_in, const int* in_sizes, int n_in, void* d_out, int out_size, void* d_ws, size_t ws_size, hipStream_t stream) {
    static int grid = 0;
    if (grid == 0) {
        if (n_in != 21 || out_size != MTOK * DM || ws_size < WS_END) { fprintf(stderr, "kernel_launch: unexpected shapes (n_in %d out %d ws %zu)\n", n_in, out_size, ws_size); grid = -1; return; }
        int dev = 0, cus = 0, per_cu = 0;
        (void)hipGetDevice(&dev);
        if (hipDeviceGetAttribute(&cus, hipDeviceAttributeMultiprocessorCount, dev) != hipSuccess || cus <= 0) cus = 256;
        if (hipFuncSetAttribute((const void*)yoco_fwd, hipFuncAttributeMaxDynamicSharedMemorySize, LDS_BYTES) != hipSuccess) { fprintf(stderr, "kernel_launch: hipFuncSetAttribute failed\n"); grid = -1; return; }
        if (hipOccupancyMaxActiveBlocksPerMultiprocessor(&per_cu, (const void*)yoco_fwd, NTHR, LDS_BYTES) != hipSuccess || per_cu < 1) { fprintf(stderr, "kernel_launch: occupancy query says %d\n", per_cu); per_cu = 1; }
        (void)hipGetLastError();
        grid = cus > 256 ? 256 : cus;
    }
    if (grid < 0) return;
    (void)hipMemsetAsync((char*)d_ws + WS_CTL, 0, CTL_ZERO_BYTES, stream);
    Args a{};
    for (int i = 0; i < 21; ++i) a.in[i] = (const float*)d_in[i];
    a.out = (float*)d_out; a.ws = (unsigned char*)d_ws;
#if MK_MULTI_LAUNCH
    for (int ph = 0; ph < NPHASE; ++ph) { a.ph_lo = ph; a.ph_hi = ph + 1; hipLaunchKernelGGL(yoco_fwd, dim3(grid), dim3(NTHR), LDS_BYTES, stream, a); }
#else
    a.ph_lo = 0; a.ph_hi = NPHASE;
    void* kargs[] = {&a};
    hipError_t e = hipLaunchCooperativeKernel((const void*)yoco_fwd, dim3(grid), dim3(NTHR), kargs, LDS_BYTES, stream);
    if (e != hipSuccess) fprintf(stderr, "kernel_launch: cooperative launch failed: %s (grid %d)\n", hipGetErrorString(e), grid);
#endif
}
```

```cpp
#include <hip/hip_runtime.h>
#include <hip/hip_cooperative_groups.h>
#include <cstdio>
#include <cstdint>
namespace cg = cooperative_groups;

#ifndef MK_MULTI_LAUNCH
#define MK_MULTI_LAUNCH 0
#endif

constexpr int DM = 1024, NB = 8, SEQ = 2048, MTOK = NB * SEQ, NH = 8, DH = 128;
constexpr int MODV_LD = 14336;
constexpr float EPS = 1e-6f;
constexpr int NWAVES = 8, NTHR = 512;
constexpr int LDS_BYTES = 147456;

constexpr size_t MiB = 1u << 20;
constexpr size_t WS_CTL = 0, CTL_ZERO_BYTES = 1 * MiB + 256 * 1024;
constexpr size_t WS_MODV = 64 * 1024;
constexpr size_t WS_KMEAN = 512 * 1024;
constexpr size_t WS_GFLAG = 32 * 1024;
constexpr size_t WS_SHW = 768 * 1024;
constexpr size_t WS_PCNT = 48 * 1024;
constexpr size_t WS_CFLAG = 50 * 1024;
constexpr size_t WS_SUMSQ = 1 * MiB;
constexpr size_t WS_TA = 1 * MiB + 256 * 1024;
constexpr size_t WS_WIN = 2 * MiB;
constexpr size_t WS_WG = 10 * MiB;
constexpr size_t WS_WOUT = 12 * MiB;
constexpr size_t WS_ATTIN0 = 16 * MiB, WS_WKV = 20 * MiB, WS_ATTIN1 = 24 * MiB;
constexpr size_t WS_ATTOUT = 28 * MiB;
constexpr size_t WS_HN = 32 * MiB;
constexpr size_t WS_HKV = 64 * MiB;
constexpr size_t WS_UPRE = 96 * MiB;
constexpr size_t WS_G = 128 * MiB;
constexpr size_t WS_LA = 160 * MiB;
constexpr size_t WS_BIN = 192 * MiB;
constexpr size_t WS_X16 = 224 * MiB;
constexpr size_t WS_END = 256 * MiB;

typedef unsigned short bf16_t;
typedef short bf16x8 __attribute__((ext_vector_type(8)));
typedef short s16x4 __attribute__((ext_vector_type(4)));
typedef float f32x4 __attribute__((ext_vector_type(4)));
typedef float f32x2 __attribute__((ext_vector_type(2)));
typedef float f32x16 __attribute__((ext_vector_type(16)));
typedef unsigned u32x4 __attribute__((ext_vector_type(4)));
typedef unsigned u32x2 __attribute__((ext_vector_type(2)));
#define LAS __attribute__((address_space(3)))

__device__ __forceinline__ unsigned cvt_pk_bf16(float lo, float hi) { unsigned r; asm volatile("v_cvt_pk_bf16_f32 %0, %1, %2" : "=v"(r) : "v"(lo), "v"(hi)); return r; }
__device__ __forceinline__ float bf_lo(unsigned w) { return __uint_as_float(w << 16); }
__device__ __forceinline__ float bf_hi(unsigned w) { return __uint_as_float(w & 0xffff0000u); }
__device__ __forceinline__ float bf1(bf16_t h) { return __uint_as_float((unsigned)h << 16); }
__device__ __forceinline__ float fexp(float x) { return __builtin_amdgcn_exp2f(x * 1.4426950408889634f); }
__device__ __forceinline__ float flog(float x) { return __builtin_amdgcn_logf(x) * 0.6931471805599453f; }
__device__ __forceinline__ float fsigmoid(float x) { return __builtin_amdgcn_rcpf(1.f + fexp(-x)); }
__device__ __forceinline__ float fsilu(float x) { return x * fsigmoid(x); }
__device__ __forceinline__ int opq_tid(int wv) { int l; asm volatile("v_mbcnt_lo_u32_b32 %0, -1, 0\n\tv_mbcnt_hi_u32_b32 %0, -1, %0" : "=v"(l)); return wv * 64 + l; }
__device__ __forceinline__ int opq_bid() { int b = blockIdx.x; asm volatile("" : "+s"(b)); return b; }
__device__ __forceinline__ float wave_sum(float v) {
#pragma unroll
    for (int o = 1; o < 64; o <<= 1) v += __shfl_xor(v, o);
    return v;
}

namespace pg8 {
constexpr int BM = 256, BK = 64, HALF = 128, HTB = HALF * BK * 2, STAGE_BYTES = 8 * HTB, NXCD = 8, WGM = 8;
__host__ __device__ __forceinline__ int lds_byte(int r, int c) { const int st = (r >> 4) * 2 + (c >> 5), rr = r & 15, cc = c & 31, ob = rr * 64 + cc * 2; return st * 1024 + (ob ^ (((ob >> 9) & 1) << 5)); }
__host__ __device__ __forceinline__ void stage_rc(int b, int& R, int& C) { const int st = b / 1024, sb = b % 1024, swz = sb ^ (((sb >> 9) & 1) << 5); R = (st >> 1) * 16 + swz / 64; C = (st & 1) * 32 + (swz % 64) / 2; }
__host__ __device__ __forceinline__ int perm32(int rho) { const int n = rho >> 4, i = rho & 15; return 8 * (i >> 2) + 4 * n + (i & 3); }

struct Unit { int pm, pn, sub; };
struct Gemm { const bf16_t* A; const bf16_t* Bt; int lda, ldb, K; long a_sub, b_sub; };

struct MultiOrder {
    int nM, nN, nwg, nsub, G, c;
    __device__ void init(int M, int N, int nsub_, int G_, int c_) { nM = M / BM; nN = N / BM; nwg = nM * nN; nsub = nsub_; G = G_; c = c_; }
    __device__ bool next(int i, Unit& u) const {
        const long L = (long)i * G + c; if (L >= (long)nwg * nsub) return false;
        u.sub = (int)(L / nwg);
        int wgid = (int)(L % nwg); { const int q = nwg / NXCD, r = nwg % NXCD, xcd = wgid % NXCD, off = wgid / NXCD; wgid = (xcd < r ? xcd * (q + 1) : r * (q + 1) + (xcd - r) * q) + off; }
        const int nig = WGM * nN, gid = wgid / nig, fm = gid * WGM, gsz = (nM - fm) < WGM ? (nM - fm) : WGM;
        u.pm = fm + ((wgid % nig) % gsz); u.pn = (wgid % nig) / gsz; return true;
    }
};


template <int N> __device__ __forceinline__ float dpp_shr(float src, float ident) {
    return __int_as_float(__builtin_amdgcn_update_dpp(__float_as_int(ident), __float_as_int(src), 0x110 + N, 0xF, 0xF, false));
}
struct EpiSplit {
    static constexpr bool PERM = true, APERM = false;
    bf16_t* O0; bf16_t* O1; const float* sumsq; const float* shw;
    __device__ __forceinline__ void operator()(const f32x4 (&acc)[2][2][4][2], const Unit& u, int wr, int wc, int fr, int fq) const {
        const int row0 = u.pm * BM + wr * 64 + fr; int colt = u.pn * BM; bf16_t* base = O0;
        const int cfull = u.pn * BM + wc * 32 + 8 * fq;
        const bool gate_half = colt >= DM;
        if (gate_half) { base = O1; colt -= DM; }
        const int col0 = colt + wc * 32 + 8 * fq;
        f32x4 bv[2][2];
#pragma unroll
        for (int bj = 0; bj < 2; ++bj)
#pragma unroll
            for (int n = 0; n < 2; ++n) bv[bj][n] = sumsq ? *(const f32x4*)(shw + (size_t)(u.pm >> 3) * 2 * DM + cfull + bj * HALF + 4 * n) : (f32x4){0.f, 0.f, 0.f, 0.f};
        float ssq[2][4];
#pragma unroll
        for (int ai = 0; ai < 2; ++ai)
#pragma unroll
            for (int m = 0; m < 4; ++m) ssq[ai][m] = sumsq ? sumsq[row0 + ai * HALF + m * 16] : 0.f;
#pragma unroll
        for (int ai = 0; ai < 2; ++ai)
#pragma unroll
            for (int m = 0; m < 4; ++m) { const int row = row0 + ai * HALF + m * 16; bf16_t* rowp = base + (size_t)row * DM + col0;
                const float rs = sumsq ? __builtin_amdgcn_rsqf(ssq[ai][m] * (1.f / DM) + EPS) : 1.f;
#pragma unroll
                for (int bj = 0; bj < 2; ++bj) { f32x4 v0 = acc[ai][bj][m][0] * rs + bv[bj][0], v1 = acc[ai][bj][m][1] * rs + bv[bj][1];
                    if (gate_half) {
#pragma unroll
                        for (int j = 0; j < 4; ++j) { v0[j] = fsilu(v0[j]); v1[j] = fsilu(v1[j]); } }
                    u32x4 w; w.x = cvt_pk_bf16(v0[0], v0[1]); w.y = cvt_pk_bf16(v0[2], v0[3]); w.z = cvt_pk_bf16(v1[0], v1[1]); w.w = cvt_pk_bf16(v1[2], v1[3]);
                    *(u32x4*)(rowp + bj * HALF) = w; } }
    }
};

typedef _Float16 h16x8 __attribute__((ext_vector_type(8)));
__device__ __forceinline__ void ld8(const float* p, float (&v)[8]) { const f32x4 a = *(const f32x4*)p, b = *(const f32x4*)(p + 4); v[0] = a[0]; v[1] = a[1]; v[2] = a[2]; v[3] = a[3]; v[4] = b[0]; v[5] = b[1]; v[6] = b[2]; v[7] = b[3]; }
struct InOrder {
    int c, n, base;
    __device__ bool next(int i, Unit& u) const { if (i >= n) return false; const int j = c >> 3; int pm = (c & 7) * 8 + (j >> 2), pn = 4 * (i + base) + (j & 3), sub = 0;
        asm volatile("" : "+s"(pm), "+s"(pn), "+s"(sub)); u.pm = pm; u.pn = pn; u.sub = sub; return true; }
};
constexpr int CV_HL_OFF = 133120;
struct EpiSplitConv {
    static constexpr bool PERM = true, APERM = true;
    unsigned char* ws; const float* sumsq; const float* shw; const float* cw; const float* cb; unsigned target; LAS unsigned char* lds;
    __device__ __forceinline__ void operator()(f32x4 (&acc)[2][2][4][2], const Unit& u, int wr, int wc, int fr, int fq) const {
        const int pnl = u.pn & 3;
        const int cfull = u.pn * BM + wc * 32 + 8 * fq, ct = wc * 32 + 8 * fq, col0 = pnl * BM + ct;
        bf16_t* obase = (bf16_t*)(ws + WS_UPRE);
        f32x4 bv[2][2];
#pragma unroll
        for (int bj = 0; bj < 2; ++bj)
#pragma unroll
            for (int n = 0; n < 2; ++n) bv[bj][n] = sumsq ? *(const f32x4*)(shw + (size_t)(u.pm >> 3) * 2 * DM + cfull + bj * HALF + 4 * n) : (f32x4){0.f, 0.f, 0.f, 0.f};
        float ssq[2][4];
#pragma unroll
        for (int ai = 0; ai < 2; ++ai)
#pragma unroll
            for (int m = 0; m < 4; ++m) ssq[ai][m] = sumsq ? sumsq[u.pm * BM + ai * HALF + wr * 64 + 4 * fr + m] : 0.f;
#pragma unroll
        for (int ai = 0; ai < 2; ++ai)
#pragma unroll
            for (int m = 0; m < 4; ++m) { const float rs = sumsq ? __builtin_amdgcn_rsqf(ssq[ai][m] * (1.f / DM) + EPS) : 1.f;
#pragma unroll
                for (int bj = 0; bj < 2; ++bj) { acc[ai][bj][m][0] = acc[ai][bj][m][0] * rs + bv[bj][0]; acc[ai][bj][m][1] = acc[ai][bj][m][1] * rs + bv[bj][1]; } }
        const int tile = u.pm * 4 + pnl;
        unsigned long long* HX = (unsigned long long*)(ws + WS_BIN);
        unsigned* flags = (unsigned*)(ws + WS_CFLAG);
        LAS f32x4* HL = (LAS f32x4*)(lds + CV_HL_OFF);
#pragma unroll
        for (int ai = 0; ai < 2; ++ai)
#pragma unroll
            for (int k = 0; k < 3; ++k)
#pragma unroll
                for (int bj = 0; bj < 2; ++bj) {
                    if (fr == 15) { LAS f32x4* d = HL + (((ai * 2 + wr) * 3 + k) * 256 + bj * HALF + ct) / 4;
                        d[0] = acc[ai][bj][k + 1][0]; d[1] = acc[ai][bj][k + 1][1];
                        if (ai == 1 && wr == 1) { unsigned long long* g_ = HX + ((size_t)(tile * 3 + k) * 256 + bj * HALF + ct) / 2;
#pragma unroll
                            for (int n = 0; n < 2; ++n) { const f32x4 v = acc[1][bj][k + 1][n];
                                __hip_atomic_store(g_ + 2 * n, ((unsigned long long)__float_as_uint(v[1]) << 32) | __float_as_uint(v[0]), __ATOMIC_RELAXED, __HIP_MEMORY_SCOPE_AGENT);
                                __hip_atomic_store(g_ + 2 * n + 1, ((unsigned long long)__float_as_uint(v[3]) << 32) | __float_as_uint(v[2]), __ATOMIC_RELAXED, __HIP_MEMORY_SCOPE_AGENT); } } }
                    asm volatile("" ::: "memory"); __builtin_amdgcn_sched_barrier(0);
                }
        if (wr == 1) { asm volatile("s_waitcnt vmcnt(0)" ::: "memory");
            if (fr == 15 && fq == 0) __hip_atomic_fetch_add(flags + tile * 8, 1u, __ATOMIC_RELAXED, __HIP_MEMORY_SCOPE_AGENT); }
        asm volatile("s_waitcnt lgkmcnt(0)" ::: "memory"); __builtin_amdgcn_s_barrier(); asm volatile("" ::: "memory");
        const bool need_prev = (wr == 0) && ((u.pm & 7) != 0);
        if (need_prev) { unsigned spins = 0;
            while (__hip_atomic_load(flags + (tile - 4) * 8, __ATOMIC_RELAXED, __HIP_MEMORY_SCOPE_AGENT) < target) { __builtin_amdgcn_s_sleep(2); if (++spins > (1u << 22)) break; } }
#pragma unroll
        for (int ai = 0; ai < 2; ++ai)
#pragma unroll
            for (int bj = 0; bj < 2; ++bj)
#pragma unroll
                for (int n = 0; n < 2; ++n) {
                    f32x4 pr[3];
                    if (ai == 0 && wr == 0) {
#pragma unroll
                        for (int k = 0; k < 3; ++k) { unsigned long long wa = 0ull, wb = 0ull;
                            if (need_prev) { const unsigned long long* sp = HX + ((size_t)((tile - 4) * 3 + k) * 256 + bj * HALF + ct + 4 * n) / 2;
                                wa = __hip_atomic_load(sp, __ATOMIC_RELAXED, __HIP_MEMORY_SCOPE_AGENT); wb = __hip_atomic_load(sp + 1, __ATOMIC_RELAXED, __HIP_MEMORY_SCOPE_AGENT); }
                            pr[k] = (f32x4){__uint_as_float((unsigned)wa), __uint_as_float((unsigned)(wa >> 32)), __uint_as_float((unsigned)wb), __uint_as_float((unsigned)(wb >> 32))}; }
                    } else { const int prun = ai * 2 + wr - 1;
#pragma unroll
                        for (int k = 0; k < 3; ++k) pr[k] = HL[((prun * 3 + k) * 256 + bj * HALF + ct + 4 * n) / 4]; }
                    const int chg = pnl * BM + bj * HALF + ct + 4 * n;
                    const f32x4 w0 = *(const f32x4*)(cw + chg), w1 = *(const f32x4*)(cw + DM + chg), w2 = *(const f32x4*)(cw + 2 * DM + chg), w3 = *(const f32x4*)(cw + 3 * DM + chg), bb = *(const f32x4*)(cb + chg);
                    const f32x4 x0 = acc[ai][bj][0][n], x1 = acc[ai][bj][1][n], x2 = acc[ai][bj][2][n], x3 = acc[ai][bj][3][n];
                    f32x4 q1, q2, q3;
#pragma unroll
                    for (int j = 0; j < 4; ++j) { q1[j] = dpp_shr<1>(x3[j], pr[2][j]); q2[j] = dpp_shr<1>(x2[j], pr[1][j]); q3[j] = dpp_shr<1>(x1[j], pr[0][j]); }
                    const f32x4 y0 = bb + w0 * q3 + w1 * q2 + w2 * q1 + w3 * x0, y1 = bb + w0 * q2 + w1 * q1 + w2 * x0 + w3 * x1;
                    const f32x4 y2 = bb + w0 * q1 + w1 * x0 + w2 * x1 + w3 * x2, y3 = bb + w0 * x0 + w1 * x1 + w2 * x2 + w3 * x3;
                    bf16_t* op = obase + (size_t)(u.pm * BM + ai * HALF + wr * 64 + 4 * fr) * DM + col0 + bj * HALF + 4 * n;
                    { u32x2 w; w.x = cvt_pk_bf16(y0[0], y0[1]); w.y = cvt_pk_bf16(y0[2], y0[3]); *(u32x2*)(op) = w; }
                    { u32x2 w; w.x = cvt_pk_bf16(y1[0], y1[1]); w.y = cvt_pk_bf16(y1[2], y1[3]); *(u32x2*)(op + DM) = w; }
                    { u32x2 w; w.x = cvt_pk_bf16(y2[0], y2[1]); w.y = cvt_pk_bf16(y2[2], y2[3]); *(u32x2*)(op + 2 * DM) = w; }
                    { u32x2 w; w.x = cvt_pk_bf16(y3[0], y3[1]); w.y = cvt_pk_bf16(y3[2], y3[3]); *(u32x2*)(op + 3 * DM) = w; }
                    asm volatile("" ::: "memory"); __builtin_amdgcn_sched_barrier(0);
                }
    }
};

template <class TIn, bool HAS_A2>
struct EpiResH {
    static constexpr bool PERM = true, APERM = false;
    const TIn* xin; _Float16* xo; const float* gate; const float* modv; bf16_t* A1; const float* g1; int sc1; bf16_t* A2; const float* g2; int sc2; float* sumsq;
    __device__ __forceinline__ void operator()(const f32x4 (&acc)[2][2][4][2], const Unit& u, int wr, int wc, int fr, int fq) const {
        const int b = u.pm >> 3, col0 = u.pn * BM + wc * 32 + 8 * fq;
        float gv[2][8], gs1[2][8], gs2[HAS_A2 ? 2 : 1][8];
#pragma unroll
        for (int bj = 0; bj < 2; ++bj) { const int cc = col0 + bj * HALF;
            ld8(gate + (size_t)b * MODV_LD + cc, gv[bj]);
            { float gg[8], sc[8]; ld8(g1 + cc, gg); ld8(modv + (size_t)b * MODV_LD + sc1 + cc, sc);
#pragma unroll
              for (int j = 0; j < 8; ++j) gs1[bj][j] = gg[j] * (sc[j] + 1.f); }
            if constexpr (HAS_A2) { float gg[8], sc[8]; ld8(g2 + cc, gg); ld8(modv + (size_t)b * MODV_LD + sc2 + cc, sc);
#pragma unroll
              for (int j = 0; j < 8; ++j) gs2[bj][j] = gg[j] * (sc[j] + 1.f); } }
        constexpr int NG = (sizeof(TIn) == 4 || HAS_A2) ? 2 : 4;
#pragma unroll
        for (int ai = 0; ai < 2; ++ai) {
#pragma unroll
          for (int mh = 0; mh < 4; mh += NG) {
            float xv[sizeof(TIn) == 4 ? NG : 1][2][8]; h16x8 xh[sizeof(TIn) == 4 ? 1 : NG][2];
#pragma unroll
            for (int mm = 0; mm < NG; ++mm) { const size_t off = (size_t)(u.pm * BM + ai * HALF + wr * 64 + (mh + mm) * 16 + fr) * DM + col0;
#pragma unroll
                for (int bj = 0; bj < 2; ++bj) {
                    if constexpr (sizeof(TIn) == 4) ld8((const float*)xin + off + bj * HALF, xv[mm][bj]);
                    else xh[mm][bj] = *(const h16x8*)((const _Float16*)xin + off + bj * HALF); } }
            __builtin_amdgcn_sched_barrier(0);
#pragma unroll
            for (int mm = 0; mm < NG; ++mm) { const int m = mh + mm; const int row = u.pm * BM + ai * HALF + wr * 64 + m * 16 + fr; const size_t off = (size_t)row * DM + col0;
                float ss = 0.f;
#pragma unroll
                for (int bj = 0; bj < 2; ++bj) { float o[8]; h16x8 ho;
#pragma unroll
                    for (int j = 0; j < 8; ++j) { float xj; if constexpr (sizeof(TIn) == 4) xj = xv[mm][bj][j]; else xj = (float)xh[mm][bj][j];
                        o[j] = xj + gv[bj][j] * acc[ai][bj][m][j >> 2][j & 3]; ho[j] = (_Float16)o[j]; ss += o[j] * o[j]; }
                    *(h16x8*)(xo + off + bj * HALF) = ho;
                    if (A1) { u32x4 w; w.x = cvt_pk_bf16(o[0] * gs1[bj][0], o[1] * gs1[bj][1]); w.y = cvt_pk_bf16(o[2] * gs1[bj][2], o[3] * gs1[bj][3]);
                        w.z = cvt_pk_bf16(o[4] * gs1[bj][4], o[5] * gs1[bj][5]); w.w = cvt_pk_bf16(o[6] * gs1[bj][6], o[7] * gs1[bj][7]); *(u32x4*)(A1 + off + bj * HALF) = w; }
                    if constexpr (HAS_A2) { u32x4 w; w.x = cvt_pk_bf16(o[0] * gs2[bj][0], o[1] * gs2[bj][1]); w.y = cvt_pk_bf16(o[2] * gs2[bj][2], o[3] * gs2[bj][3]);
                        w.z = cvt_pk_bf16(o[4] * gs2[bj][4], o[5] * gs2[bj][5]); w.w = cvt_pk_bf16(o[6] * gs2[bj][6], o[7] * gs2[bj][7]); *(u32x4*)(A2 + off + bj * HALF) = w; } }
                if (sumsq) { ss += __shfl_xor(ss, 16); ss += __shfl_xor(ss, 32); if (fq == 0) atomicAdd(sumsq + row, ss); } }
            __builtin_amdgcn_sched_barrier(0);
          }
        }
    }
};

struct EpiFinal {
    static constexpr bool PERM = true, APERM = false;
    const _Float16* xin; float* out; const float* gate; const float* fg; float* sumsq; unsigned* cnt;
    __device__ __forceinline__ void operator()(f32x4 (&acc)[2][2][4][2], const Unit& u, int wr, int wc, int fr, int fq) const {
        const int b = u.pm >> 3, col0 = u.pn * BM + wc * 32 + 8 * fq;
        float gv[2][8];
#pragma unroll
        for (int bj = 0; bj < 2; ++bj) ld8(gate + (size_t)b * MODV_LD + col0 + bj * HALF, gv[bj]);
#pragma unroll
        for (int ai = 0; ai < 2; ++ai) {
            h16x8 xh[4][2];
#pragma unroll
            for (int m = 0; m < 4; ++m)
#pragma unroll
                for (int bj = 0; bj < 2; ++bj) xh[m][bj] = *(const h16x8*)(xin + (size_t)(u.pm * BM + ai * HALF + wr * 64 + m * 16 + fr) * DM + col0 + bj * HALF);
            __builtin_amdgcn_sched_barrier(0);
#pragma unroll
            for (int m = 0; m < 4; ++m) { const int row = u.pm * BM + ai * HALF + wr * 64 + m * 16 + fr;
                float ss = 0.f;
#pragma unroll
                for (int bj = 0; bj < 2; ++bj) { f32x4 o0, o1;
#pragma unroll
                    for (int j = 0; j < 4; ++j) { o0[j] = (float)xh[m][bj][j] + gv[bj][j] * acc[ai][bj][m][0][j]; o1[j] = (float)xh[m][bj][4 + j] + gv[bj][4 + j] * acc[ai][bj][m][1][j]; }
                    acc[ai][bj][m][0] = o0; acc[ai][bj][m][1] = o1;
                    ss += (o0[0] * o0[0] + o0[1] * o0[1]) + (o0[2] * o0[2] + o0[3] * o0[3]) + (o1[0] * o1[0] + o1[1] * o1[1]) + (o1[2] * o1[2] + o1[3] * o1[3]); }
                ss += __shfl_xor(ss, 16); ss += __shfl_xor(ss, 32); if (fq == 0) atomicAdd(sumsq + row, ss); }
            __builtin_amdgcn_sched_barrier(0);
        }
        asm volatile("s_waitcnt vmcnt(0)" ::: "memory");
        if (fr == 0 && fq == 0) __hip_atomic_fetch_add(cnt + u.pm * 8, 1u, __ATOMIC_RELAXED, __HIP_MEMORY_SCOPE_AGENT);
        { unsigned spins = 0;
          while (__hip_atomic_load(cnt + u.pm * 8, __ATOMIC_RELAXED, __HIP_MEMORY_SCOPE_AGENT) < 32u) { __builtin_amdgcn_s_sleep(2); if (++spins > (1u << 22)) break; } }
        float fgv[2][8];
#pragma unroll
        for (int bj = 0; bj < 2; ++bj) ld8(fg + col0 + bj * HALF, fgv[bj]);
        float ssq[2][4];
#pragma unroll
        for (int ai = 0; ai < 2; ++ai)
#pragma unroll
            for (int m = 0; m < 4; ++m) ssq[ai][m] = __hip_atomic_load(sumsq + u.pm * BM + ai * HALF + wr * 64 + m * 16 + fr, __ATOMIC_RELAXED, __HIP_MEMORY_SCOPE_AGENT);
#pragma unroll
        for (int ai = 0; ai < 2; ++ai)
#pragma unroll
            for (int m = 0; m < 4; ++m) { const size_t off = (size_t)(u.pm * BM + ai * HALF + wr * 64 + m * 16 + fr) * DM + col0;
                const float rs = __builtin_amdgcn_rsqf(ssq[ai][m] * (1.f / DM) + EPS);
#pragma unroll
                for (int bj = 0; bj < 2; ++bj) { f32x4 y0, y1;
#pragma unroll
                    for (int j = 0; j < 4; ++j) { y0[j] = acc[ai][bj][m][0][j] * rs * fgv[bj][j]; y1[j] = acc[ai][bj][m][1][j] * rs * fgv[bj][4 + j]; }
                    *(f32x4*)(out + off + bj * HALF) = y0; *(f32x4*)(out + off + bj * HALF + 4) = y1; } }
    }
};

__device__ __forceinline__ void scan16(float& a, float& b) {
    float ap, bp;
    ap = dpp_shr<1>(a, 1.f); bp = dpp_shr<1>(b, 0.f); b = fmaf(a, bp, b); a *= ap;
    ap = dpp_shr<2>(a, 1.f); bp = dpp_shr<2>(b, 0.f); b = fmaf(a, bp, b); a *= ap;
    ap = dpp_shr<4>(a, 1.f); bp = dpp_shr<4>(b, 0.f); b = fmaf(a, bp, b); a *= ap;
    ap = dpp_shr<8>(a, 1.f); bp = dpp_shr<8>(b, 0.f); b = fmaf(a, bp, b); a *= ap;
}
__device__ __forceinline__ void gate_elem2(f32x2 xr, f32x2 xg, f32x2 nba, f32x2 nbx, f32x2 psp2, f32x2 uv, f32x2& a, f32x2& b) {
    const f32x2 tr = xr * (-1.4426950408889634f) + nba, tg = xg * (-1.4426950408889634f) + nbx;
    f32x2 er, eg; er.x = __builtin_amdgcn_exp2f(tr.x); er.y = __builtin_amdgcn_exp2f(tr.y); eg.x = __builtin_amdgcn_exp2f(tg.x); eg.y = __builtin_amdgcn_exp2f(tg.y);
    const f32x2 dr = er + 1.f, dg = eg + 1.f, dd = dr * dg;
    f32x2 inv; inv.x = __builtin_amdgcn_rcpf(dd.x); inv.y = __builtin_amdgcn_rcpf(dd.y);
    const f32x2 r = inv * dg, gi = inv * dr;
    const f32x2 la2 = psp2 * r;
    a.x = __builtin_amdgcn_exp2f(-la2.x); a.y = __builtin_amdgcn_exp2f(-la2.y);
    const f32x2 om = 1.f - a * a;
    f32x2 sq; sq.x = __builtin_amdgcn_sqrtf(om.x); sq.y = __builtin_amdgcn_sqrtf(om.y);
    b = sq * gi * uv;
}
struct GateParams { f32x2 nba[4], nbx[4], psp2[4]; };
__device__ __forceinline__ void gate_params(GateParams& P, const float* ba, const float* bx, const float* lam, int ch0) {
#pragma unroll
    for (int p = 0; p < 4; ++p) {
        const f32x2 vb = *(const f32x2*)(ba + ch0 + 2 * p), vx = *(const f32x2*)(bx + ch0 + 2 * p), vl = *(const f32x2*)(lam + ch0 + 2 * p);
        P.nba[p] = vb * (-1.4426950408889634f); P.nbx[p] = vx * (-1.4426950408889634f);
        const float z0 = -vl.x, z1 = -vl.y;
        P.psp2[p].x = 8.f * 1.4426950408889634f * (z0 > 20.f ? z0 : flog(1.f + fexp(z0)));
        P.psp2[p].y = 8.f * 1.4426950408889634f * (z1 > 20.f ? z1 : flog(1.f + fexp(z1)));
    }
}
#define GATE_PAIR(p, accv, uw_, a2, b2) do { const int n_ = (p) >> 1, q_ = ((p) & 1) * 2; \
        const unsigned uword_ = ((p) == 0) ? uw_.x : ((p) == 1) ? uw_.y : ((p) == 2) ? uw_.z : uw_.w; \
        gate_elem2((f32x2){accv[ai][0][m][n_][q_], accv[ai][0][m][n_][q_ + 1]}, (f32x2){accv[ai][1][m][n_][q_], accv[ai][1][m][n_][q_ + 1]}, \
                   P.nba[p], P.nbx[p], P.psp2[p], (f32x2){bf_lo(uword_), bf_hi(uword_)}, a2, b2); } while (0)
struct GatesOrder {
    int c, n;
    __device__ bool next(int i, Unit& u) const { if (i >= n) return false; int pm = (c >> 5) * 8 + 4 * i + (c & 3), pn = (c >> 2) & 1, sub = (c >> 3) & 3;
        asm volatile("" : "+s"(pm), "+s"(pn), "+s"(sub)); u.pm = pm; u.pn = pn; u.sub = sub; return true; }
};
constexpr int GS_RA_OFF = 133120;
struct EpiGatesS {
    static constexpr bool PERM = true, APERM = true;
    unsigned char* ws; unsigned target; const float* ba; const float* bx; const float* lam; LAS unsigned char* lds;
    __device__ __forceinline__ void operator()(f32x4 (&acc)[2][2][4][2], const Unit& u, int wr, int wc, int fr, int fq) const {
        const bf16_t* U = (const bf16_t*)(ws + WS_UPRE); const bf16_t* Gt = (const bf16_t*)(ws + WS_G); bf16_t* Y = (bf16_t*)(ws + WS_HN);
        unsigned long long* TA = (unsigned long long*)(ws + WS_TA); unsigned* flags = (unsigned*)(ws + WS_GFLAG);
        const int ct0 = wc * 32 + 8 * fq, ch0 = u.sub * 256 + u.pn * 128 + ct0;
        const int chain = ((u.pm >> 3) * 4 + u.sub) * 2 + u.pn, p = u.pm & 7, tix = chain * 8 + p;
        const int bsrc = (fq * 16 + 15) << 2;
        LAS f32x4* RA = (LAS f32x4*)(lds + GS_RA_OFF);
        {
            GateParams P; gate_params(P, ba, bx, lam, ch0);
#pragma unroll
            for (int ai = 0; ai < 2; ++ai) {
                u32x4 uall[4];
#pragma unroll
                for (int m = 0; m < 4; ++m) uall[m] = *(const u32x4*)(U + (size_t)(u.pm * BM + ai * HALF + wr * 64 + 4 * fr + m) * DM + ch0);
#pragma unroll
                for (int n = 0; n < 2; ++n) { f32x4 tA[4], tB[4]; f32x4 agg;
#pragma unroll
                    for (int hq = 0; hq < 2; ++hq) { const int pq = 2 * n + hq; f32x2 a2[4], b2[4];
#pragma unroll
                        for (int m = 0; m < 4; ++m) { const u32x4 uw = uall[m]; GATE_PAIR(pq, acc, uw, a2[m], b2[m]); }
#pragma unroll
                        for (int m = 1; m < 4; ++m) { b2[m] = a2[m] * b2[m - 1] + b2[m]; a2[m] = a2[m] * a2[m - 1]; }
                        float pax = a2[3].x, pbx = b2[3].x, pay = a2[3].y, pby = b2[3].y; scan16(pax, pbx); scan16(pay, pby);
                        if (hq == 0) { agg[0] = pax; agg[1] = pbx; agg[2] = pay; agg[3] = pby;
                            if (fr == 15) RA[((ai * 2 + wr) * 128 + ct0) / 2 + pq] = agg; }
                        else { if (fr == 15) RA[((ai * 2 + wr) * 128 + ct0) / 2 + pq] = (f32x4){pax, pbx, pay, pby}; }
                        const f32x2 EA = {dpp_shr<1>(pax, 1.f), dpp_shr<1>(pay, 1.f)}, EB = {dpp_shr<1>(pbx, 0.f), dpp_shr<1>(pby, 0.f)};
#pragma unroll
                        for (int m = 0; m < 4; ++m) { const f32x2 Ae = a2[m] * EA, Be = a2[m] * EB + b2[m];
                            tA[m][2 * hq] = Ae.x; tA[m][2 * hq + 1] = Ae.y; tB[m][2 * hq] = Be.x; tB[m][2 * hq + 1] = Be.y; }
                        __builtin_amdgcn_sched_barrier(0); }
#pragma unroll
                    for (int m = 0; m < 4; ++m) { acc[ai][0][m][n] = tA[m]; acc[ai][1][m][n] = tB[m]; }
                    asm volatile("" ::: "memory"); __builtin_amdgcn_sched_barrier(0); }
            }
        }
        asm volatile("s_waitcnt lgkmcnt(0)" ::: "memory"); __builtin_amdgcn_s_barrier(); asm volatile("" ::: "memory");
        if (wr == 0) {
            float At[8], Bt[8];
#pragma unroll
            for (int j = 0; j < 8; ++j) { At[j] = 1.f; Bt[j] = 0.f; }
#pragma unroll
            for (int ri = 0; ri < 4; ++ri)
#pragma unroll
                for (int q = 0; q < 4; ++q) { const f32x4 v = RA[(ri * 128 + ct0) / 2 + q];
                    Bt[2 * q] = fmaf(v[0], Bt[2 * q], v[1]); At[2 * q] *= v[0]; Bt[2 * q + 1] = fmaf(v[2], Bt[2 * q + 1], v[3]); At[2 * q + 1] *= v[2]; }
            if (fr == 15) {
#pragma unroll
                for (int j = 0; j < 8; ++j) __hip_atomic_store(TA + (size_t)tix * 128 + ct0 + j, ((unsigned long long)__float_as_uint(Bt[j]) << 32) | __float_as_uint(At[j]), __ATOMIC_RELAXED, __HIP_MEMORY_SCOPE_AGENT);
            }
            asm volatile("s_waitcnt vmcnt(0)" ::: "memory");
            if (fr == 15 && fq == 0) __hip_atomic_fetch_add(flags + tix * 8, 1u, __ATOMIC_RELAXED, __HIP_MEMORY_SCOPE_AGENT);
        }
        float h[8];
        {
            const bool on = fr < p;
            if (on) { unsigned spins = 0;
                while (__hip_atomic_load(flags + (chain * 8 + fr) * 8, __ATOMIC_RELAXED, __HIP_MEMORY_SCOPE_AGENT) < target) { __builtin_amdgcn_s_sleep(2); if (++spins > (1u << 22)) break; } }
            float Ac[8], Bc[8];
#pragma unroll
            for (int j = 0; j < 8; ++j) { unsigned long long w = 0x000000003f800000ull;
                if (on) w = __hip_atomic_load(TA + (size_t)(chain * 8 + fr) * 128 + ct0 + j, __ATOMIC_RELAXED, __HIP_MEMORY_SCOPE_AGENT);
                Ac[j] = __uint_as_float((unsigned)w); Bc[j] = __uint_as_float((unsigned)(w >> 32)); }
#pragma unroll
            for (int j = 0; j < 8; ++j) { float a = Ac[j], b = Bc[j]; scan16(a, b); h[j] = __int_as_float(__builtin_amdgcn_ds_bpermute(bsrc, __float_as_int(b))); }
        }
#pragma unroll
        for (int ai = 0; ai < 2; ++ai) {
            const int nskip = (ai == 0) ? wr : 1;
            const int rfirst = (ai == 0) ? 0 : (1 + wr);
            for (int k = 0; k < nskip; ++k)
#pragma unroll
                for (int q = 0; q < 4; ++q) { const f32x4 v = RA[((rfirst + k) * 128 + ct0) / 2 + q];
                    h[2 * q] = fmaf(v[0], h[2 * q], v[1]); h[2 * q + 1] = fmaf(v[2], h[2 * q + 1], v[3]); }
            u32x4 gall[4];
#pragma unroll
            for (int m = 0; m < 4; ++m) gall[m] = *(const u32x4*)(Gt + (size_t)(u.pm * BM + ai * HALF + wr * 64 + 4 * fr + m) * DM + ch0);
            float hl[8];
#pragma unroll
            for (int m = 0; m < 4; ++m) { const size_t off = (size_t)(u.pm * BM + ai * HALF + wr * 64 + 4 * fr + m) * DM + ch0;
                const u32x4 gw = gall[m];
                const float gv[8] = {bf_lo(gw.x), bf_hi(gw.x), bf_lo(gw.y), bf_hi(gw.y), bf_lo(gw.z), bf_hi(gw.z), bf_lo(gw.w), bf_hi(gw.w)};
                float yv[8];
#pragma unroll
                for (int j = 0; j < 8; ++j) { const float hv = fmaf(acc[ai][0][m][j >> 2][j & 3], h[j], acc[ai][1][m][j >> 2][j & 3]); yv[j] = hv * gv[j];
                    if (m == 3) hl[j] = hv; }
                u32x4 w; w.x = cvt_pk_bf16(yv[0], yv[1]); w.y = cvt_pk_bf16(yv[2], yv[3]); w.z = cvt_pk_bf16(yv[4], yv[5]); w.w = cvt_pk_bf16(yv[6], yv[7]);
                *(u32x4*)(Y + off) = w; }
#pragma unroll
            for (int j = 0; j < 8; ++j) h[j] = __int_as_float(__builtin_amdgcn_ds_bpermute(bsrc, __float_as_int(hl[j])));
            asm volatile("" ::: "memory"); __builtin_amdgcn_sched_barrier(0);
        }
    }
};

struct EpiQKV {
    static constexpr bool PERM = true, APERM = false;
    unsigned char* ws; float* kmean; const float* sumsq; const float* shw; int shw_sub;
    __device__ __forceinline__ void operator()(const f32x4 (&acc)[2][2][4][2], const Unit& u, int wr, int wc, int fr, int fq) const {
        const int b = u.pm >> 3, sblk = u.pm & 7, pq = u.pn & 3; const bool second = u.pn >= 4;
        const int dcol = wc * 32 + 8 * fq;
        const float* sw = shw + (size_t)u.sub * shw_sub + (size_t)b * 2 * DM + u.pn * BM + dcol;
        f32x4 bv[2][2];
#pragma unroll
        for (int bj = 0; bj < 2; ++bj)
#pragma unroll
            for (int n = 0; n < 2; ++n) bv[bj][n] = *(const f32x4*)(sw + bj * HALF + 4 * n);
        const bool plain = (u.sub == 0 && second), km = (u.sub == 1 && !second);
        const size_t boff = plain ? WS_G : (u.sub == 0) ? WS_UPRE : (second ? WS_BIN : WS_HN);
        const size_t rstride = plain ? DM : DH;
        bf16_t* bp[2];
#pragma unroll
        for (int bj = 0; bj < 2; ++bj)
            bp[bj] = (bf16_t*)(ws + boff) + (plain ? (size_t)(u.pm * BM) * DM + pq * 256 + bj * HALF + dcol : ((size_t)(b * NH + 2 * pq + bj) * SEQ + sblk * 256) * DH + dcol);
        f32x4 s0[2], s1[2];
#pragma unroll
        for (int bj = 0; bj < 2; ++bj) { s0[bj] = (f32x4){0.f, 0.f, 0.f, 0.f}; s1[bj] = (f32x4){0.f, 0.f, 0.f, 0.f}; }
        float ssq[2][4];
#pragma unroll
        for (int ai = 0; ai < 2; ++ai)
#pragma unroll
            for (int m = 0; m < 4; ++m) ssq[ai][m] = sumsq[u.pm * BM + ai * HALF + wr * 64 + m * 16 + fr];
#pragma unroll
        for (int ai = 0; ai < 2; ++ai)
#pragma unroll
            for (int m = 0; m < 4; ++m) { const int r = ai * HALF + wr * 64 + m * 16 + fr;
                const float rs = __builtin_amdgcn_rsqf(ssq[ai][m] * (1.f / DM) + EPS);
#pragma unroll
                for (int bj = 0; bj < 2; ++bj) { f32x4 v0 = acc[ai][bj][m][0] * rs + bv[bj][0], v1 = acc[ai][bj][m][1] * rs + bv[bj][1];
                    if (plain) {
#pragma unroll
                        for (int j = 0; j < 4; ++j) { v0[j] = fsilu(v0[j]); v1[j] = fsilu(v1[j]); } }
                    s0[bj] += v0; s1[bj] += v1;
                    u32x4 w; w.x = cvt_pk_bf16(v0[0], v0[1]); w.y = cvt_pk_bf16(v0[2], v0[3]); w.z = cvt_pk_bf16(v1[0], v1[1]); w.w = cvt_pk_bf16(v1[2], v1[3]);
                    *(u32x4*)(bp[bj] + (size_t)r * rstride) = w; }
                asm volatile("" ::: "memory"); }
        if (km) {
#pragma unroll
            for (int bj = 0; bj < 2; ++bj)
#pragma unroll
                for (int j = 0; j < 4; ++j) { float t0 = s0[bj][j], t1 = s1[bj][j];
                    t0 += __shfl_xor(t0, 1); t0 += __shfl_xor(t0, 2); t0 += __shfl_xor(t0, 4); t0 += __shfl_xor(t0, 8);
                    t1 += __shfl_xor(t1, 1); t1 += __shfl_xor(t1, 2); t1 += __shfl_xor(t1, 4); t1 += __shfl_xor(t1, 8);
                    if (fr == 0) { float* kp = kmean + ((size_t)(b * NH + 2 * pq + bj) * 8 + sblk) * DH + dcol + j;
                        atomicAdd(kp, t0 * (1.f / 256.f)); atomicAdd(kp + 4, t1 * (1.f / 256.f)); } }
        }
    }
};

template <class Epi, class Sched>
__device__ __forceinline__ void gemm_phase(LAS unsigned char* lds, const Gemm g, const Sched& S, const Epi& E, int wv) {
    const int tid = opq_tid(wv), wid = __builtin_amdgcn_readfirstlane(tid >> 6), lane = tid & 63, wr = wid >> 2, wc = wid & 3, fr = lane & 15, fq = lane >> 4;
    const int K = g.K, nt = K / BK;
    unsigned voffA[2], voffB[2];
#pragma unroll
    for (int i = 0; i < 2; ++i) { int R, C; stage_rc(tid * 16 + i * 8192, R, C); const int Rb = Epi::PERM ? ((R & ~31) + perm32(R & 31)) : R;
        const int Ra = Epi::APERM ? ((R & 64) + 4 * (R & 15) + ((R >> 4) & 3)) : R;
        voffA[i] = (unsigned)(Ra * g.lda + C) * 2u; voffB[i] = (unsigned)(Rb * g.ldb + C) * 2u; }
    const size_t kstep = (size_t)(BK * 2);
    const size_t hstepA = (size_t)HALF * g.lda * 2, hstepB = (size_t)HALF * g.ldb * 2;
    const size_t tstepA = 2 * hstepA, tstepB = 2 * hstepB;
    const unsigned ldsw = (unsigned)wid * 1024u;
    const int aoff = lds_byte(wr * 64 + fr, fq * 8), boff = lds_byte(wc * 32 + fr, fq * 8);
#define PG8_SA(b, h) (((b) * 2 + (h)) * HTB)
#define PG8_SB(b, h) ((4 + (b) * 2 + (h)) * HTB)
#define PG8_STAGE(bufoff, gbase, voff) do { _Pragma("unroll") for (int _i = 0; _i < 2; ++_i) \
        __builtin_amdgcn_global_load_lds((const unsigned*)((const char*)(gbase) + (voff)[_i]), (LAS unsigned*)(lds + (bufoff) + ldsw + _i * 8192), 16, 0, 0); } while (0)
#define PG8_LDA(dst, b, h) do { _Pragma("unroll") for (int m = 0; m < 4; ++m) _Pragma("unroll") for (int k = 0; k < 2; ++k) dst[m][k] = *(const LAS bf16x8*)(lds + PG8_SA(b, h) + aoff + m * 2048 + k * 1024); } while (0)
#define PG8_LDB(dst, b, h) do { _Pragma("unroll") for (int n = 0; n < 2; ++n) _Pragma("unroll") for (int k = 0; k < 2; ++k) dst[n][k] = *(const LAS bf16x8*)(lds + PG8_SB(b, h) + boff + n * 2048 + k * 1024); } while (0)
#define PG8_MMA(ai, bj, At, Bt) do { __builtin_amdgcn_s_setprio(1); _Pragma("unroll") for (int m = 0; m < 4; ++m) _Pragma("unroll") for (int n = 0; n < 2; ++n) _Pragma("unroll") for (int k = 0; k < 2; ++k) \
        acc[ai][bj][m][n] = __builtin_amdgcn_mfma_f32_16x16x32_bf16(Bt[n][k], At[m][k], acc[ai][bj][m][n], 0, 0, 0); __builtin_amdgcn_s_setprio(0); } while (0)
#define PG8_WAIT_V(n) asm volatile("s_waitcnt vmcnt(" #n ")" ::: "memory")
#define PG8_WAIT_L(n) asm volatile("s_waitcnt lgkmcnt(" #n ")" ::: "memory")
#define PG8_BAR __builtin_amdgcn_s_barrier()
#define PG8_SCHED __builtin_amdgcn_sched_barrier(0)
#define PG8_UA(u) ((const char*)g.A + (size_t)(u).sub * g.a_sub + (size_t)(u).pm * tstepA)
#define PG8_UB(u) ((const char*)g.Bt + (size_t)(u).sub * g.b_sub + (size_t)(u).pn * tstepB)
    Unit cur, nxt; int ui = 0;
    if (!S.next(0, cur)) return;
    f32x4 acc[2][2][4][2];
#pragma unroll
    for (int a = 0; a < 2; ++a)
#pragma unroll
        for (int b = 0; b < 2; ++b)
#pragma unroll
            for (int m = 0; m < 4; ++m)
#pragma unroll
                for (int n = 0; n < 2; ++n) acc[a][b][m][n] = (f32x4){0.f, 0.f, 0.f, 0.f};
    bf16x8 At[4][2], B0[2][2], B1[2][2];
    const char* cA = PG8_UA(cur); const char* cB = PG8_UB(cur);
    PG8_STAGE(PG8_SB(0, 0), cB, voffB); PG8_STAGE(PG8_SB(0, 1), cB + hstepB, voffB); PG8_STAGE(PG8_SA(0, 0), cA, voffA); PG8_STAGE(PG8_SA(0, 1), cA + hstepA, voffA);
    if (wr == 1) PG8_BAR;
    PG8_WAIT_V(2); PG8_BAR;
    PG8_STAGE(PG8_SB(1, 0), cB + kstep, voffB); PG8_STAGE(PG8_SA(1, 0), cA + kstep, voffA); PG8_STAGE(PG8_SB(1, 1), cB + hstepB + kstep, voffB);
    PG8_WAIT_V(6); PG8_BAR;
    for (;;) {
        const bool has_next = S.next(ui + 1, nxt);
        const char* nA = has_next ? PG8_UA(nxt) : cA; const char* nB = has_next ? PG8_UB(nxt) : cB;
        for (int t = 0; t < nt; t += 2) {
            const bool last = (t == nt - 2);
            const char* a1 = cA + (size_t)(t + 1) * kstep;
            const char* a2 = last ? nA : cA + (size_t)(t + 2) * kstep; const char* b2 = last ? nB : cB + (size_t)(t + 2) * kstep;
            const char* a3 = a2 + kstep; const char* b3 = b2 + kstep;
            PG8_LDB(B0, 0, 0); PG8_LDB(B1, 0, 1); PG8_SCHED; PG8_LDA(At, 0, 0); PG8_STAGE(PG8_SA(1, 1), a1 + hstepA, voffA);
            PG8_WAIT_V(8); PG8_WAIT_L(0); PG8_BAR; PG8_MMA(0, 0, At, B0); PG8_MMA(0, 1, At, B1); PG8_BAR; PG8_SCHED;
            PG8_LDA(At, 0, 1); PG8_STAGE(PG8_SB(0, 0), b2, voffB); PG8_STAGE(PG8_SB(0, 1), b2 + hstepB, voffB); PG8_STAGE(PG8_SA(0, 0), a2, voffA);
            PG8_WAIT_V(8); PG8_WAIT_L(0); PG8_BAR; PG8_MMA(1, 0, At, B0); PG8_MMA(1, 1, At, B1); PG8_BAR; PG8_SCHED;
            PG8_LDB(B0, 1, 0); PG8_LDB(B1, 1, 1); PG8_SCHED; PG8_LDA(At, 1, 0); PG8_STAGE(PG8_SA(0, 1), a2 + hstepA, voffA);
            PG8_WAIT_V(8); PG8_WAIT_L(0); PG8_BAR; PG8_MMA(0, 0, At, B0); PG8_MMA(0, 1, At, B1); PG8_BAR; PG8_SCHED;
            PG8_LDA(At, 1, 1); PG8_STAGE(PG8_SB(1, 0), b3, voffB); PG8_STAGE(PG8_SB(1, 1), b3 + hstepB, voffB); PG8_STAGE(PG8_SA(1, 0), a3, voffA);
            PG8_WAIT_V(8); PG8_WAIT_L(0); PG8_BAR; PG8_MMA(1, 0, At, B0); PG8_MMA(1, 1, At, B1); PG8_BAR; PG8_SCHED;
        }
        if (wr == 0) PG8_BAR;
        { const int t2 = opq_tid(wv), w2 = __builtin_amdgcn_readfirstlane(t2 >> 6), l2 = t2 & 63; E(acc, cur, w2 >> 2, w2 & 3, l2 & 15, l2 >> 4); }
        if (!has_next) break;
#pragma unroll
        for (int a = 0; a < 2; ++a)
#pragma unroll
            for (int b = 0; b < 2; ++b)
#pragma unroll
                for (int m = 0; m < 4; ++m)
#pragma unroll
                    for (int n = 0; n < 2; ++n) acc[a][b][m][n] = (f32x4){0.f, 0.f, 0.f, 0.f};
        cur = nxt; cA = nA; cB = nB; ++ui;
        if (wr == 1) PG8_BAR;
    }
    PG8_WAIT_V(0);
    PG8_BAR;
#undef PG8_SA
#undef PG8_SB
#undef PG8_STAGE
#undef PG8_LDA
#undef PG8_LDB
#undef PG8_MMA
#undef PG8_WAIT_V
#undef PG8_WAIT_L
#undef PG8_BAR
#undef PG8_SCHED
#undef PG8_UA
#undef PG8_UB
}
}

namespace att {
constexpr float SCALE = 0.08838834764831845f;
constexpr float THR = 8.f;
constexpr int NW = 8, QBLK = 32, KVBLK = 64, QB = NW * QBLK, D = 128;
constexpr int SHM_V = KVBLK * D * 2, SHM_K = KVBLK * D * 2;
constexpr int ATT_LDS = 2 * SHM_V + 2 * SHM_K + NW * 64 * 4;
#define KSWZ(row, colB) ((row) * 256 + ((colB) ^ (((row) & 7) << 4)))
#define SBAR() __builtin_amdgcn_sched_barrier(0)
__device__ __forceinline__ int v_st(int k, int c) { const int kk = (k & ~0xC) | ((k & 4) << 1) | ((k & 8) >> 1); return ((kk >> 3) * 4 + (c >> 5)) * 512 + ((kk & 7) * 32 + (c & 31)) * 2; }
__device__ __forceinline__ int v_rd_base(int lane) { return ((lane & 3) << 3) | (((lane >> 2) & 3) << 6) | (((lane >> 4) & 1) << 5) | (((lane >> 5) & 1) << 8); }
constexpr int v_rd_off(int d0, int ks, int half) { return d0 * 512 + ks * 4096 + half * 2048; }
__device__ __forceinline__ int crow(int r, int hi) { return (r & 3) + 8 * (r >> 2) + 4 * hi; }
__device__ __forceinline__ bf16x8 load8(const bf16_t* p) { return *reinterpret_cast<const bf16x8*>(p); }
__device__ __forceinline__ void mask_tile(f32x16& p0, f32x16& p1, int dq) {
    const float NEG = -__builtin_inff();
#pragma unroll
    for (int r = 0; r < 16; ++r) {
        const int c = (r & 3) + 8 * (r >> 2);
        if (dq - c < 0) p0[r] = NEG;
        if (dq - c - 32 < 0) p1[r] = NEG;
    }
}
__device__ __forceinline__ void mask_all(f32x16& p0, f32x16& p1, bool off) {
    const float NEG = -__builtin_inff();
#pragma unroll
    for (int r = 0; r < 16; ++r) { p0[r] = off ? NEG : p0[r]; p1[r] = off ? NEG : p1[r]; }
}
__device__ __forceinline__ void partialSM(f32x16& p0, f32x16& p1, float& m_reg, float& mn, float& alpha, float rbias = 0.f) {
    float pmax = p0[0];
#pragma unroll
    for (int r = 1; r < 16; ++r) pmax = fmaxf(pmax, p0[r]);
#pragma unroll
    for (int r = 0; r < 16; ++r) pmax = fmaxf(pmax, p1[r]);
    { auto rr = __builtin_amdgcn_permlane32_swap(__float_as_uint(pmax), __float_as_uint(pmax), false, false);
      pmax = fmaxf(__uint_as_float(rr[0]), __uint_as_float(rr[1])); }
    constexpr float C2 = 1.4426950408889634f * SCALE;
    if (__builtin_expect(__all((pmax - m_reg) * SCALE <= THR), 1)) { mn = m_reg; alpha = 1.f; }
    else { mn = fmaxf(m_reg, pmax); alpha = __builtin_amdgcn_exp2f((m_reg - mn) * C2); m_reg = mn; }
    const float mnL = -mn * C2 + rbias;
#pragma unroll
    for (int r = 0; r < 16; ++r) p0[r] = fmaf(p0[r], C2, mnL);
#pragma unroll
    for (int r = 0; r < 16; ++r) p1[r] = fmaf(p1[r], C2, mnL);
#pragma unroll
    for (int r = 0; r < 16; ++r) p0[r] = __builtin_amdgcn_exp2f(p0[r]);
}
__device__ __forceinline__ void finishSM(f32x16& p0, f32x16& p1, float alpha, float& l_reg, bf16x8& pa0, bf16x8& pa1, bf16x8& pa2, bf16x8& pa3) {
#pragma unroll
    for (int r = 0; r < 16; ++r) p1[r] = __builtin_amdgcn_exp2f(p1[r]);
    float ps = 0;
#pragma unroll
    for (int r = 0; r < 16; ++r) ps += p0[r];
#pragma unroll
    for (int r = 0; r < 16; ++r) ps += p1[r];
    { auto rr = __builtin_amdgcn_permlane32_swap(__float_as_uint(ps), __float_as_uint(ps), false, false);
      ps = __uint_as_float(rr[0]) + __uint_as_float(rr[1]); }
    l_reg = l_reg * alpha + ps;
#define PK4(P, B_, OUT) do { unsigned a0 = cvt_pk_bf16(P[B_+0], P[B_+1]), a1 = cvt_pk_bf16(P[B_+2], P[B_+3]);                          \
        unsigned b0 = cvt_pk_bf16(P[B_+4], P[B_+5]), b1 = cvt_pk_bf16(P[B_+6], P[B_+7]);                                             \
        auto r0 = __builtin_amdgcn_permlane32_swap(a0, b0, false, false); auto r1 = __builtin_amdgcn_permlane32_swap(a1, b1, false, false); \
        u32x4 w = {r0[0], r1[0], r0[1], r1[1]}; OUT = *reinterpret_cast<bf16x8*>(&w); } while (0)
    PK4(p0, 0, pa0); PK4(p0, 8, pa1); PK4(p1, 0, pa2); PK4(p1, 8, pa3);
#undef PK4
}
template <int KB>
__device__ __forceinline__ void qkt(f32x16& p0, f32x16& p1, const char* K_lds, int r32, int hi, const bf16x8* qr) {
    p0 = f32x16{}; p1 = f32x16{};
    const char* kb[4];
#pragma unroll
    for (int dd = 0; dd < 4; ++dd) kb[dd] = K_lds + KB * SHM_K + KSWZ(r32, (dd * 16 + hi * 8) * 2);
#pragma unroll
    for (int d0 = 0; d0 < 8; ++d0) { const char* a = kb[d0 & 3] + (d0 >> 2) * 128;
        bf16x8 b0 = *reinterpret_cast<const bf16x8*>(a);
        bf16x8 b1 = *reinterpret_cast<const bf16x8*>(a + 32 * 256);
        p0 = __builtin_amdgcn_mfma_f32_32x32x16_bf16(b0, qr[d0], p0, 0, 0, 0);
        p1 = __builtin_amdgcn_mfma_f32_32x32x16_bf16(b1, qr[d0], p1, 0, 0, 0); }
}
template <int VB>
__device__ __forceinline__ void pv_tile(f32x16* o, int vb0, bf16x8 pa0, bf16x8 pa1, bf16x8 pa2, bf16x8 pa3) {
#define TRRD(dst, off) asm volatile("ds_read_b64_tr_b16 %0, %1 offset:%2" : "=&v"(dst) : "v"(vb0), "i"(off) : "memory")
#define PV_D0(d0) do { s16x4 l0, l1, l2, l3, h0, h1, h2, h3; constexpr int b_ = VB * SHM_V + v_rd_off(d0, 0, 0); \
        TRRD(l0, b_); TRRD(h0, b_ + 2048); TRRD(l1, b_ + 4096); TRRD(h1, b_ + 6144); TRRD(l2, b_ + 8192); TRRD(h2, b_ + 10240); TRRD(l3, b_ + 12288); TRRD(h3, b_ + 14336); \
        asm volatile("s_waitcnt lgkmcnt(0)" ::: "memory"); SBAR();   \
        o[d0] = __builtin_amdgcn_mfma_f32_32x32x16_bf16(pa0, (bf16x8){l0[0], l0[1], l0[2], l0[3], h0[0], h0[1], h0[2], h0[3]}, o[d0], 0, 0, 0);   \
        o[d0] = __builtin_amdgcn_mfma_f32_32x32x16_bf16(pa1, (bf16x8){l1[0], l1[1], l1[2], l1[3], h1[0], h1[1], h1[2], h1[3]}, o[d0], 0, 0, 0);   \
        o[d0] = __builtin_amdgcn_mfma_f32_32x32x16_bf16(pa2, (bf16x8){l2[0], l2[1], l2[2], l2[3], h2[0], h2[1], h2[2], h2[3]}, o[d0], 0, 0, 0);   \
        o[d0] = __builtin_amdgcn_mfma_f32_32x32x16_bf16(pa3, (bf16x8){l3[0], l3[1], l3[2], l3[3], h3[0], h3[1], h3[2], h3[3]}, o[d0], 0, 0, 0); } while (0)
    PV_D0(0); PV_D0(1); PV_D0(2); PV_D0(3);
#undef PV_D0
#undef TRRD
}

struct BlockRef { const bf16_t* Q; const bf16_t* K; const bf16_t* V; bf16_t* O; const bf16_t* Gt; const float* KM; int P0; };
struct Seam { bf16x8 qr[8]; bf16x8 st_v0, st_v1, st_k0, st_k1; };
#define ROW(p, k0, rr) ((p) + (size_t)((k0) + (rr)) * D + sc)
#define VMW() asm volatile("s_waitcnt vmcnt(0)" ::: "memory")
#define VMWN(n) asm volatile("s_waitcnt vmcnt(%0)" :: "i"(n) : "memory")
#define SLOAD_H(Kp, Vp, k0) do { S.st_v0 = load8(ROW(Vp, k0, sr)); S.st_v1 = load8(ROW(Vp, k0, 32 + sr));              \
                         S.st_k0 = load8(ROW(Kp, k0, sr)); S.st_k1 = load8(ROW(Kp, k0, 32 + sr)); } while (0)
#define SWRITE_HK(bf) do { *(bf16x8*)(K_lds + (bf) * SHM_K + kws) = S.st_k0; *(bf16x8*)(K_lds + (bf) * SHM_K + kws + 32 * 256) = S.st_k1; } while (0)
#define SWRITE_HV(bf) do { *(bf16x8*)(V_lds + (bf) * SHM_V + vst0) = S.st_v0; *(bf16x8*)(V_lds + (bf) * SHM_V + vst1) = S.st_v1; } while (0)
#define SWRITE_H(bf) do { SWRITE_HV(bf); SWRITE_HK(bf); } while (0)
__device__ __forceinline__ void moba_prime(const BlockRef& cur, char* lds, Seam& S, int wv) {
    const int tid = opq_tid(wv), wid = __builtin_amdgcn_readfirstlane(tid >> 6), lane = tid & 63, r32 = lane & 31, hi = lane >> 5;
    const int sr = tid >> 4, sc = (tid & 15) * 8, kws = KSWZ(sr, sc * 2); char* K_lds = lds + 2 * SHM_V;
#pragma unroll
    for (int d0 = 0; d0 < 8; ++d0) S.qr[d0] = load8(cur.Q + (size_t)(wid * QBLK + r32) * D + d0 * 16 + hi * 8);
    SLOAD_H(cur.K, cur.V, 0); VMW(); SWRITE_HK(0);
    __syncthreads();
}
__device__ __forceinline__ unsigned moba_select(const Seam& S, const float* KM, int qb, int hi) {
    if (qb <= 3) return (1u << qb) - 1u;
    float sc_[8];
#pragma unroll
    for (int j = 0; j < 8; ++j) sc_[j] = 0.f;
#pragma unroll
    for (int j = 0; j < 7; ++j) {
        if (j < qb) {
            float s = 0.f;
#pragma unroll
            for (int d0 = 0; d0 < 8; ++d0) {
                const f32x4 k0 = *(const f32x4*)(KM + j * D + d0 * 16 + hi * 8), k1 = *(const f32x4*)(KM + j * D + d0 * 16 + hi * 8 + 4);
                const bf16x8 q = S.qr[d0];
                s += bf1((bf16_t)q[0]) * k0[0] + bf1((bf16_t)q[1]) * k0[1] + bf1((bf16_t)q[2]) * k0[2] + bf1((bf16_t)q[3]) * k0[3]
                   + bf1((bf16_t)q[4]) * k1[0] + bf1((bf16_t)q[5]) * k1[1] + bf1((bf16_t)q[6]) * k1[2] + bf1((bf16_t)q[7]) * k1[3];
            }
            s += __shfl_xor(s, 32);
            sc_[j] = s;
        }
    }
    unsigned sel = 0u;
#pragma unroll
    for (int it = 0; it < 3; ++it) {
        float best = -__builtin_inff(); int bi = 0;
#pragma unroll
        for (int j = 0; j < 7; ++j) { const bool ok = (j < qb) && !((sel >> j) & 1u) && (sc_[j] > best); best = ok ? sc_[j] : best; bi = ok ? j : bi; }
        sel |= 1u << bi;
    }
    return sel;
}
__device__ __forceinline__ void moba_block(const BlockRef& cur, const BlockRef& nxt, char* lds, Seam& S, int wv) {
    const int tid = opq_tid(wv), wid = __builtin_amdgcn_readfirstlane(tid >> 6), lane = tid & 63, r32 = lane & 31, hi = lane >> 5;
    const int NT = cur.P0 / KVBLK + 4;
    const int qb = cur.P0 >> 8;
    const int qlo = cur.P0 + wid * QBLK, qm = qlo + r32 - 4 * hi;
    char* V_lds = lds; char* K_lds = lds + 2 * SHM_V;
    float* ws = (float*)(lds + 2 * SHM_V + 2 * SHM_K) + wid * 64; float* li_l = ws, * al_l = ws + 32;
    float m_reg = -1e30f, l_reg = 0; f32x16 o[4] = {};
    const int sr = tid >> 4, sc = (tid & 15) * 8, vst0 = v_st(sr, sc), vst1 = v_st(32 + sr, sc), kws = KSWZ(sr, sc * 2);
    const int vb0 = (int)(uintptr_t)V_lds + v_rd_base(lane);
    const bf16_t* Kh = cur.K; const bf16_t* Vh = cur.V;
    const bool need_sel = qb > 3;
    const float* kml = (const float*)(lds + 69632);
    if (need_sel) { if (tid < 224) ((f32x4*)(lds + 69632))[tid] = ((const f32x4*)cur.KM)[tid]; __syncthreads(); }
    const unsigned sel = moba_select(S, kml, qb, hi);
#define RESC(a) do { if (__any((a) < 1.f)) { if (hi == 0) al_l[r32] = (a); asm volatile("s_waitcnt lgkmcnt(0)" ::: "memory");              \
                     for (int d_ = 0; d_ < 4; ++d_) for (int r = 0; r < 16; ++r) o[d_][r] *= al_l[crow(r, hi)]; } } while (0)
#define KBASE(t) ((t) * KVBLK)
#define MASKT(P0_, P1_, t) do { const int kb_ = KBASE(t); rb_ = 0.f; \
        if (kb_ < cur.P0) { if (need_sel) rb_ = (((sel >> (kb_ >> 8)) & 1u) == 0u) ? -__builtin_inff() : 0.f; } \
        else if (kb_ + KVBLK - 1 > qlo) mask_tile(P0_, P1_, qm - kb_); } while (0)
#define SEAM_K0() do { VMWN(8); SWRITE_HK(0); SBAR(); } while (0)
    f32x16 pA0, pA1, pB0, pB1; float mnA, mnB, alA, alB, rb_ = 0.f; bf16x8 pa0, pa1, pa2, pa3;
    SWRITE_HV(0); SBAR();
    SLOAD_H(Kh, Vh, KBASE(1));
    SBAR(); qkt<0>(pA0, pA1, K_lds, r32, hi, S.qr);
    MASKT(pA0, pA1, 0); partialSM(pA0, pA1, m_reg, mnA, alA, rb_);
    VMW(); SWRITE_H(1);
    __syncthreads();
#define HALF_STEP(PX0, PX1, mnX, alX, PY0, PY1, alY, t, KB, VB, SB) do {                                                      \
        SBAR(); qkt<KB>(PX0, PX1, K_lds, r32, hi, S.qr);                                                                       \
        finishSM(PY0, PY1, alY, l_reg, pa0, pa1, pa2, pa3); SBAR();                                                           \
        if ((t) + 1 < NT) { SLOAD_H(Kh, Vh, KBASE((t) + 1)); SBAR(); }                                                        \
        pv_tile<VB>(o, vb0, pa0, pa1, pa2, pa3); MASKT(PX0, PX1, (t)); partialSM(PX0, PX1, m_reg, mnX, alX, rb_);                  \
        __syncthreads();                                                                                                      \
        if ((t) + 1 < NT) { VMW(); SWRITE_H(SB); }                                                                            \
        RESC(alX); __syncthreads(); } while (0)
    for (int t = 1; t + 1 < NT; t += 2) {
        HALF_STEP(pB0, pB1, mnB, alB, pA0, pA1, alA, t, 1, 0, 0);
        HALF_STEP(pA0, pA1, mnA, alA, pB0, pB1, alB, t + 1, 0, 1, 1);
    }
    SBAR(); qkt<1>(pB0, pB1, K_lds, r32, hi, S.qr); SBAR();
    SLOAD_H(nxt.K, nxt.V, 0); SBAR();
#pragma unroll
    for (int d0 = 0; d0 < 8; ++d0) S.qr[d0] = load8(nxt.Q + (size_t)(wid * QBLK + r32) * D + d0 * 16 + hi * 8);
    SBAR();
    finishSM(pA0, pA1, alA, l_reg, pa0, pa1, pa2, pa3); SBAR();
    pv_tile<0>(o, vb0, pa0, pa1, pa2, pa3);
    MASKT(pB0, pB1, NT - 1); partialSM(pB0, pB1, m_reg, mnB, alB, rb_); __syncthreads(); RESC(alB);
    finishSM(pB0, pB1, alB, l_reg, pa0, pa1, pa2, pa3); SBAR(); pv_tile<1>(o, vb0, pa0, pa1, pa2, pa3);
    SBAR(); SEAM_K0();
    if (hi == 0) li_l[r32] = l_reg; asm volatile("s_waitcnt lgkmcnt(0)" ::: "memory");
    bf16_t* Ow = cur.O + (size_t)(wid * QBLK) * DM; const bf16_t* Gw = cur.Gt + (size_t)(wid * QBLK) * DM + r32;
    bf16_t gl[16][4];
#pragma unroll
    for (int r = 0; r < 16; ++r)
#pragma unroll
        for (int d0 = 0; d0 < 4; ++d0) gl[r][d0] = Gw[(size_t)crow(r, hi) * DM + d0 * 32];
#pragma unroll
    for (int r = 0; r < 16; ++r) { const int orow = crow(r, hi); const float rl = __builtin_amdgcn_rcpf(li_l[orow]);
#pragma unroll
        for (int d0 = 0; d0 < 4; ++d0) { const float gv = bf1(gl[r][d0]);
            const float v = o[d0][r] * rl * gv;
            const float vn = __shfl_xor(v, 1);
            if ((r32 & 1) == 0) *(unsigned*)(Ow + (size_t)orow * DM + d0 * 32 + r32) = cvt_pk_bf16(v, vn); } }
    __syncthreads();
#undef RESC
#undef KBASE
#undef MASKT
#undef SEAM_K0
#undef HALF_STEP
}
#undef ROW
#undef VMW
#undef VMWN
#undef SLOAD_H
#undef SWRITE_HK
#undef SWRITE_HV
#undef SWRITE_H

__device__ __forceinline__ BlockRef mk_ref(int L, int pass, const bf16_t* Q, const bf16_t* K, const bf16_t* V, bf16_t* O, const bf16_t* Gt, const float* KM) {
    const int bh = L >> 2, x = L & 3, qb = pass ? 7 - x : x, b = bh >> 3, h = bh & 7;
    BlockRef r;
    r.Q = Q + ((size_t)bh * SEQ + (size_t)qb * QB) * D; r.K = K + (size_t)bh * SEQ * D; r.V = V + (size_t)bh * SEQ * D;
    r.O = O + ((size_t)b * SEQ + (size_t)qb * QB) * DM + h * DH; r.Gt = Gt + ((size_t)b * SEQ + (size_t)qb * QB) * DM + h * DH;
    r.KM = KM + (size_t)bh * 8 * D; r.P0 = qb * QB;
    return r;
}
__device__ __forceinline__ void attn_phase(char* lds, const bf16_t* Q, const bf16_t* K, const bf16_t* V, bf16_t* O, const bf16_t* Gt, const float* KM, int wv) {
    const int total = NB * NH * 4, stride = gridDim.x;
    int L = opq_bid(); if (L >= total) return;
    if (stride == 256) { const int xcd = L & 7, j = L >> 3; L = ((xcd * 8 + (j >> 2)) << 2) | (j & 3); }
    int pass = 0;
    BlockRef cur = mk_ref(L, 0, Q, K, V, O, Gt, KM);
    Seam S;
    moba_prime(cur, lds, S, wv);
    for (;;) {
        const bool more_pass = pass == 0, more_item = L + stride < total, last = !more_pass && !more_item;
        int passn = pass + 1, Ln = L;
        if (!more_pass) { passn = 0; Ln = more_item ? L + stride : L; }
        const BlockRef nxt = last ? cur : mk_ref(Ln, passn, Q, K, V, O, Gt, KM);
        moba_block(cur, nxt, lds, S, wv);
        if (last) break;
        cur = nxt; pass = passn; L = Ln;
    }
}
}

#ifndef REP_MASK
#define REP_MASK 0
#endif
#ifndef BAR_REP
#define BAR_REP 1
#endif
struct Args { const float* in[21]; float* out; unsigned char* ws; int ph_lo, ph_hi; };
typedef const __attribute__((address_space(4))) Args* ArgsP;
#define AIN(i) ((const float*)ap->in[i])

__device__ __forceinline__ void transpose_item(const float* W, int ldw, bf16_t* WT, int ldt, LAS float* scr, int lane) {
    float tv[32];
#pragma unroll
    for (int i = 0; i < 32; ++i) { const int kk = 2 * i + (lane >> 5); tv[i] = __builtin_nontemporal_load(W + (size_t)kk * ldw + (lane & 31)); }
#pragma unroll
    for (int i = 0; i < 32; ++i) { const int kk = 2 * i + (lane >> 5); scr[kk * 33 + (lane & 31)] = tv[i]; }
    asm volatile("s_waitcnt lgkmcnt(0)" ::: "memory");
    const int c = lane & 7;
#pragma unroll
    for (int j = 0; j < 4; ++j) { const int n = (lane >> 3) + 8 * j; const LAS float* s = scr + (8 * c) * 33 + n;
        u32x4 o; o.x = cvt_pk_bf16(s[0 * 33], s[1 * 33]); o.y = cvt_pk_bf16(s[2 * 33], s[3 * 33]); o.z = cvt_pk_bf16(s[4 * 33], s[5 * 33]); o.w = cvt_pk_bf16(s[6 * 33], s[7 * 33]);
        *(u32x4*)(WT + (size_t)n * ldt + 8 * c) = o; }
    asm volatile("s_waitcnt lgkmcnt(0)" ::: "memory");
}
__device__ __forceinline__ void transpose_mat(const float* W, int K, int N, bf16_t* WT, int item, LAS float* scr, int lane) {
    const int nblk = N / 32, kb = item / nblk, nb = item % nblk;
    transpose_item(W + (size_t)(64 * kb) * N + 32 * nb, N, WT + (size_t)(32 * nb) * K + 64 * kb, K, scr, lane);
}

template <bool SILU>
__device__ __forceinline__ void gemv_item(const float* vec, int vld, const float* W, int ldw, int n0, int k0, float* out, int old, const float* bias, LAS float* scr, int lane) {
    const float* wp = W + (size_t)k0 * ldw + n0 + lane;
#pragma unroll
    for (int i = 0; i < 8; ++i) { const int idx = i * 64 + lane, b = idx >> 6, kk = idx & 63; const float v = vec[(size_t)b * vld + k0 + kk]; scr[kk * 8 + b] = SILU ? fsilu(v) : v; }
    asm volatile("s_waitcnt lgkmcnt(0)" ::: "memory");
    float acc[8];
#pragma unroll
    for (int b = 0; b < 8; ++b) acc[b] = 0.f;
#pragma unroll 1
    for (int kh = 0; kh < 64; kh += 32) {
        float w[32];
#pragma unroll
        for (int kk = 0; kk < 32; ++kk) w[kk] = SILU ? __builtin_nontemporal_load(wp + (size_t)(kh + kk) * ldw) : wp[(size_t)(kh + kk) * ldw];
#pragma unroll
        for (int kk = 0; kk < 32; ++kk) {
            const f32x4 c0 = *(const LAS f32x4*)(scr + (kh + kk) * 8), c1 = *(const LAS f32x4*)(scr + (kh + kk) * 8 + 4);
            acc[0] += w[kk] * c0[0]; acc[1] += w[kk] * c0[1]; acc[2] += w[kk] * c0[2]; acc[3] += w[kk] * c0[3];
            acc[4] += w[kk] * c1[0]; acc[5] += w[kk] * c1[1]; acc[6] += w[kk] * c1[2]; acc[7] += w[kk] * c1[3];
            if ((kk & 3) == 3) __builtin_amdgcn_sched_barrier(0); }
    }
    const float bv = bias ? bias[n0 + lane] : 0.f;
#pragma unroll
    for (int b = 0; b < 8; ++b) atomicAdd(out + (size_t)b * old + n0 + lane, acc[b] + bv);
    asm volatile("s_waitcnt lgkmcnt(0)" ::: "memory");
}
__device__ __forceinline__ void prep0_phase(ArgsP ap, LAS unsigned char* lds, int wave, int lane) {
    unsigned char* ws = (unsigned char*)ap->ws;
    LAS float* scr = (LAS float*)(lds + wave * 16384);
    const int gw = opq_bid() * NWAVES + wave, NGW = gridDim.x * NWAVES;
    for (int r = gw; r < (MODV_LD / 64) * 16; r += NGW) {
        const int cgp = r >> 4, kc = r & 15;
        const float* W; int ldw, n0; const float* bias;
        if (cgp < 192) { const int l = cgp / 48; n0 = (cgp % 48) * 64; W = AIN(2) + (size_t)l * DM * 3 * DM; ldw = 3 * DM; bias = AIN(3) + l * 3 * DM; }
        else { n0 = (cgp - 192) * 64; W = AIN(15); ldw = 2 * DM; bias = AIN(16); }
        gemv_item<true>(AIN(1), DM, W, ldw, n0, kc * 64, (float*)(ws + WS_MODV) + (cgp * 64 - n0), MODV_LD, kc == 0 ? bias : nullptr, scr, lane);
    }
}
__device__ __forceinline__ void prep1_phase(ArgsP ap, LAS unsigned char* lds, int wave, int lane) {
    unsigned char* ws = (unsigned char*)ap->ws;
    LAS float* scr = (LAS float*)(lds + wave * 16384);
    const int gw = opq_bid() * NWAVES + wave, NGW = gridDim.x * NWAVES;
    constexpr int I_BIG = (DM / 64) * (2 * DM / 32);
    constexpr int I_SQ = (DM / 64) * (DM / 32);
    constexpr int I_G = (256 / 64) * (256 / 32);
    constexpr int N_T = 2 * I_BIG + 2 * I_SQ + 2 * I_BIG + I_BIG + 2 * I_SQ + 16 * I_G;
    constexpr int N_GEMV = 4 * 32 * 16;
    for (int it = gw; it < N_T + N_GEMV; it += NGW) {
        int r = it;
        if (r < N_GEMV) {
            const int slot = r >> 9, q = r & 511, cgp = q >> 4, kc = q & 15;
            const size_t woff = slot == 0 ? (size_t)DM * 2 * DM : slot == 3 ? (size_t)DM * 2 * DM : 0;
            const float* W = (slot == 0 ? AIN(5) : slot == 2 ? AIN(17) : AIN(18)) + woff;
            const int shcol = slot == 0 ? 1 * 3 * DM : slot == 1 ? 2 * 3 * DM : slot == 2 ? 4 * 3 * DM : 3 * 3 * DM;
            gemv_item<false>((const float*)(ws + WS_MODV) + shcol, MODV_LD, W, 2 * DM, cgp * 64, kc * 64, (float*)(ws + WS_SHW) + (size_t)slot * 8 * 2 * DM, 2 * DM, nullptr, scr, lane);
            continue;
        } r -= N_GEMV;
        const float* W; bf16_t* WT; int ldw, ldt;
        if (r < 6 * I_BIG + 0 * I_SQ && r < 2 * I_BIG) { const int l = r / I_BIG, item = r % I_BIG, kb = item / 64, nb = item % 64;
            W = AIN(5) + (size_t)l * DM * 2 * DM + (size_t)(64 * kb) * 2 * DM + 32 * nb; ldw = 2 * DM; WT = (bf16_t*)(ws + WS_WIN) + (size_t)l * 2 * DM * DM + (size_t)(32 * nb) * DM + 64 * kb; ldt = DM; }
        else if ((r -= 2 * I_BIG) < 2 * I_SQ) { const int l = r / I_SQ, item = r % I_SQ, kb = item / 32, nb = item % 32;
            W = AIN(13) + (size_t)l * DM * DM + (size_t)(64 * kb) * DM + 32 * nb; ldw = DM; WT = (bf16_t*)(ws + WS_WOUT) + (size_t)l * DM * DM + (size_t)(32 * nb) * DM + 64 * kb; ldt = DM; }
        else if ((r -= 2 * I_SQ) < 2 * I_BIG) { const int l = r / I_BIG, item = r % I_BIG, kb = item / 64, nb = item % 64;
            W = AIN(18) + (size_t)l * DM * 2 * DM + (size_t)(64 * kb) * 2 * DM + 32 * nb; ldw = 2 * DM; WT = (bf16_t*)(ws + (l ? WS_ATTIN1 : WS_ATTIN0)) + (size_t)(32 * nb) * DM + 64 * kb; ldt = DM; }
        else if ((r -= 2 * I_BIG) < I_BIG) { const int kb = r / 64, nb = r % 64;
            W = AIN(17) + (size_t)(64 * kb) * 2 * DM + 32 * nb; ldw = 2 * DM; WT = (bf16_t*)(ws + WS_WKV) + (size_t)(32 * nb) * DM + 64 * kb; ldt = DM; }
        else if ((r -= I_BIG) < 2 * I_SQ) { const int l = r / I_SQ, item = r % I_SQ, kb = item / 32, nb = item % 32;
            W = AIN(19) + (size_t)l * DM * DM + (size_t)(64 * kb) * DM + 32 * nb; ldw = DM; WT = (bf16_t*)(ws + WS_ATTOUT) + (size_t)l * DM * DM + (size_t)(32 * nb) * DM + 64 * kb; ldt = DM; }
        else { r -= 2 * I_SQ;
            const int mat = r / I_G, item = r % I_G, which = mat >> 3, lh = mat & 7;
            const int kb = item / 8, nb = item % 8, n0 = 32 * nb, drow = 256 * (n0 >> 7) + 128 * which + (n0 & 127);
            W = (which ? AIN(10) : AIN(8)) + (size_t)lh * 256 * 256 + (size_t)(64 * kb) * 256 + n0; ldw = 256;
            WT = (bf16_t*)(ws + WS_WG) + (size_t)lh * 512 * 256 + (size_t)drow * 256 + 64 * kb; ldt = 256; }
        transpose_item(W, ldw, WT, ldt, scr, lane);
    }
}

__device__ __forceinline__ void norm_phase(const float* xin, bf16_t* o1, const float* g1, const float* modv, int sh1, int sc1c,
                                            bf16_t* o2, const float* g2, int sh2, int sc2c, int wave, int lane) {
    const int gw = opq_bid() * NWAVES + wave, NGW = gridDim.x * NWAVES;
    for (int rb = gw; rb < MTOK / 8; rb += NGW) {
        const int r0 = rb * 8, b = r0 / SEQ;
        const float* mv = modv + (size_t)b * MODV_LD;
        f32x4 gs1[4], sf1[4], gs2[4], sf2[4];
#pragma unroll
        for (int j = 0; j < 4; ++j) { const int idx = 4 * lane + 256 * j;
            const f32x4 gv = *(const f32x4*)(g1 + idx), sc = *(const f32x4*)(mv + sc1c + idx); gs1[j] = gv * (sc + 1.f); sf1[j] = *(const f32x4*)(mv + sh1 + idx);
            if (o2) { const f32x4 gv2 = *(const f32x4*)(g2 + idx), sc2 = *(const f32x4*)(mv + sc2c + idx); gs2[j] = gv2 * (sc2 + 1.f); sf2[j] = *(const f32x4*)(mv + sh2 + idx); }
            else { gs2[j] = gs1[j]; sf2[j] = sf1[j]; } }
        for (int rr = 0; rr < 8; ++rr) {
            const size_t row = (size_t)(r0 + rr);
            const f32x4* xr = (const f32x4*)(xin + row * DM) + lane;
            f32x4 v[4]; float s = 0.f;
#pragma unroll
            for (int j = 0; j < 4; ++j) { v[j] = xr[64 * j]; s += (v[j].x * v[j].x + v[j].y * v[j].y) + (v[j].z * v[j].z + v[j].w * v[j].w); }
            const float rstd = 1.f / sqrtf(wave_sum(s) * (1.f / DM) + EPS);
#pragma unroll
            for (int j = 0; j < 4; ++j) { const f32x4 t = v[j] * rstd; const f32x4 y = t * gs1[j] + sf1[j];
                u32x2 w; w.x = cvt_pk_bf16(y.x, y.y); w.y = cvt_pk_bf16(y.z, y.w);
                *((u32x2*)(o1 + row * DM) + lane + 64 * j) = w;
                if (o2) { const f32x4 y2 = t * gs2[j] + sf2[j]; u32x2 w2; w2.x = cvt_pk_bf16(y2.x, y2.y); w2.y = cvt_pk_bf16(y2.z, y2.w);
                    *((u32x2*)(o2 + row * DM) + lane + 64 * j) = w2; } }
        }
    }
}
__device__ __forceinline__ void conv_phase(const bf16_t* UP, bf16_t* U, const float* cw, const float* cb, int tid) {
    const int ch = 8 * (tid & 127), sub = tid >> 7;
    float w0[8], w1[8], w2[8], w3[8], bb[8];
#pragma unroll
    for (int h = 0; h < 2; ++h) { const f32x4 a = *(const f32x4*)(cw + ch + 4 * h), b = *(const f32x4*)(cw + DM + ch + 4 * h), c = *(const f32x4*)(cw + 2 * DM + ch + 4 * h), d = *(const f32x4*)(cw + 3 * DM + ch + 4 * h), e = *(const f32x4*)(cb + ch + 4 * h);
#pragma unroll
        for (int j = 0; j < 4; ++j) { w0[4 * h + j] = a[j]; w1[4 * h + j] = b[j]; w2[4 * h + j] = c[j]; w3[4 * h + j] = d[j]; bb[4 * h + j] = e[j]; } }
    for (int it = opq_bid(); it < NB * 32; it += gridDim.x) {
        const int b = it >> 5, c = it & 31, t0 = c * 64 + sub * 16; const size_t base = ((size_t)b * SEQ + t0) * DM + ch;
        u32x4 rw[19];
#pragma unroll
        for (int t = 0; t < 19; ++t) rw[t] = (t0 + t - 3 >= 0) ? *(const u32x4*)(UP + base + (ptrdiff_t)(t - 3) * DM) : (u32x4){0u, 0u, 0u, 0u};
#pragma unroll
        for (int t = 0; t < 16; ++t) {
            unsigned ow[4];
#pragma unroll
            for (int q = 0; q < 4; ++q) { const unsigned a0 = rw[t][q], a1 = rw[t + 1][q], a2 = rw[t + 2][q], a3 = rw[t + 3][q];
                const float lo = bb[2 * q] + w0[2 * q] * bf_lo(a0) + w1[2 * q] * bf_lo(a1) + w2[2 * q] * bf_lo(a2) + w3[2 * q] * bf_lo(a3);
                const float hi = bb[2 * q + 1] + w0[2 * q + 1] * bf_hi(a0) + w1[2 * q + 1] * bf_hi(a1) + w2[2 * q + 1] * bf_hi(a2) + w3[2 * q + 1] * bf_hi(a3);
                ow[q] = cvt_pk_bf16(lo, hi); }
            *(u32x4*)(U + base + (size_t)t * DM) = (u32x4){ow[0], ow[1], ow[2], ow[3]}; }
    }
}

#define XB_TMO      128
#define XB_XCNT(j)  (256  + 64 * (j))
#define XB_XSUB(j)  (1280 + 64 * (j))
#define XB_XGEN(j)  (2304 + 64 * (j))
#define XB_TOP      3328
#define XB_TOPGEN   3392
#define XCD_BAR_WORDS 3456
#define XB_SPIN_CAP (1u << 18)
constexpr size_t WS_BAR = 16384;
constexpr int LDS_MISC = 131072 + 320;
__device__ __forceinline__ unsigned xb_ld(unsigned* p)              { return __hip_atomic_load(p, __ATOMIC_RELAXED, __HIP_MEMORY_SCOPE_AGENT); }
__device__ __forceinline__ unsigned xb_add(unsigned* p, unsigned v) { return __hip_atomic_fetch_add(p, v, __ATOMIC_RELAXED, __HIP_MEMORY_SCOPE_AGENT); }
__device__ __forceinline__ unsigned xb_xcc_id() { return (unsigned)__builtin_amdgcn_s_getreg((3 << 11) | 20) & 0xFu; }
#define XB_SPIN(cond, bar) do { unsigned _sp = 0; while (cond) { __builtin_amdgcn_s_sleep(1); \
    if ((++_sp & 255u) == 0u) { if (xb_ld(&(bar)[XB_TMO])) break; if (_sp > XB_SPIN_CAP) { atomicAdd(&(bar)[XB_TMO], 1u); break; } } } } while (0)
__device__ __forceinline__ void xcd_barrier_complete(unsigned* bar, unsigned x, unsigned& nloc, unsigned& nx) {
    const unsigned G = gridDim.x * gridDim.y * gridDim.z;
    unsigned sum, cnt, mine, sp = 0u;
    for (;;) {
        sum = 0u; cnt = 0u; mine = 0u;
#pragma unroll
        for (unsigned j = 0; j < 16; ++j) { const unsigned c = xb_ld(&bar[XB_XCNT(j)]); sum += c; cnt += (c > 0u) ? 1u : 0u; mine = (j == x) ? c : mine; }
        if (sum == G) break;
        __builtin_amdgcn_s_sleep(1);
        if ((++sp & 255u) == 0u) { if (xb_ld(&bar[XB_TMO])) break; if (sp > XB_SPIN_CAP) { atomicAdd(&bar[XB_TMO], 1u); break; } }
    }
    nloc = mine > 0u ? mine : 1u; nx = cnt > 0u ? cnt : 1u;
}
__device__ __forceinline__ void xcd_barrier(unsigned* bar, volatile LAS unsigned* st, int tid) {
    asm volatile("s_waitcnt vmcnt(0)" ::: "memory");
    __syncthreads();
    if (tid == 0) {
        const unsigned x = xb_xcc_id();
        __builtin_amdgcn_s_waitcnt(0);
        unsigned nloc = st[0], nx = st[1];
        if (nloc == 0u) { xcd_barrier_complete(bar, x, nloc, nx); st[0] = nloc; st[1] = nx; }
        const unsigned old = xb_add(&bar[XB_XSUB(x)], 1u);
        const unsigned gen = old / nloc;
        if (old + 1u == (gen + 1u) * nloc) {
            __builtin_amdgcn_fence(__ATOMIC_RELEASE, "agent");
            asm volatile("s_waitcnt vmcnt(0)" ::: "memory");
            const unsigned og = xb_add(&bar[XB_TOP], 1u);
            const unsigned tg = og / nx;
            if (og + 1u == (tg + 1u) * nx) xb_add(&bar[XB_TOPGEN], 1u);
            else XB_SPIN(xb_ld(&bar[XB_TOPGEN]) == tg, bar);
            __builtin_amdgcn_fence(__ATOMIC_ACQUIRE, "agent");
            xb_add(&bar[XB_XGEN(x)], 1u);
            asm volatile("s_waitcnt vmcnt(0)" ::: "memory");
        } else {
            XB_SPIN(xb_ld(&bar[XB_XGEN(x)]) == gen, bar);
            __builtin_amdgcn_fence(__ATOMIC_ACQUIRE, "agent");
            asm volatile("s_waitcnt vmcnt(0)" ::: "memory");
        }
    }
    __syncthreads();
}

constexpr int NPHASE = 14;
#ifndef PH_EN
#define PH_EN 0xFFFF
#endif
#define EN(b) ((PH_EN >> (b)) & 1)
#ifndef REP_MASK
#define REP_MASK 0
#endif
#define REPS(b) for (int rep_ = 0; rep_ < EN(b) * (1 + ((REP_MASK >> (b)) & 1)); ++rep_)
template <int ph>
__device__ __forceinline__ void run_phase(unsigned char* lds, int wv) {
    LAS unsigned char* ldsl = (LAS unsigned char*)lds;
    {
        ArgsP ap = (ArgsP)__builtin_amdgcn_kernarg_segment_ptr();
        asm volatile("" : "+s"(ap));
        const int G = gridDim.x;
        unsigned char* ws = (unsigned char*)ap->ws;
        float* modv = (float*)(ws + WS_MODV);
        float* kmean = (float*)(ws + WS_KMEAN);
        bf16_t* HN = (bf16_t*)(ws + WS_HN); bf16_t* HKV = (bf16_t*)(ws + WS_HKV); bf16_t* UPRE = (bf16_t*)(ws + WS_UPRE); bf16_t* GB = (bf16_t*)(ws + WS_G);
        bf16_t* LAb = (bf16_t*)(ws + WS_LA); bf16_t* BINb = (bf16_t*)(ws + WS_BIN);
        float* xw = (float*)ap->out;
        const int tid = opq_tid(wv), c = opq_bid();
        const int lane = tid & 63, wave = __builtin_amdgcn_readfirstlane(tid >> 6);
        float* sumsq = (float*)(ws + WS_SUMSQ); const float* shw = (const float*)(ws + WS_SHW);
        if (ph == 0) {
            if (EN(0)) prep0_phase(ap, ldsl, wave, lane);
        } else if (ph == 1) {
            REPS(1) norm_phase(AIN(0), HN, AIN(4), modv, 0, DM, nullptr, nullptr, 0, 0, wave, lane);
            if (EN(0)) prep1_phase(ap, ldsl, wave, lane);
        } else if (ph <= 7) {
            const int l = (ph - 2) / 3, k3 = (ph - 2) % 3, k = k3 == 0 ? 0 : k3 + 1;
            const float* xin = (l == 0) ? AIN(0) : xw;
            if (k == 0) {
                pg8::Gemm g{l == 0 ? HN : HKV, (const bf16_t*)(ws + WS_WIN) + (size_t)l * 2 * DM * DM, DM, DM, DM, 0, 0};
                int one = 1; asm volatile("" : "+s"(one));
                { pg8::InOrder S{c, one, 0};
                  pg8::EpiSplitConv E{ws, l == 0 ? nullptr : sumsq, shw, AIN(6) + l * 4 * DM, AIN(7) + l * DM, 4u * (unsigned)(l + 1), ldsl};
                  REPS(2) pg8::gemm_phase(ldsl, g, S, E, wv); }
                { pg8::InOrder S{c, one, 1};
                  pg8::EpiSplit E{UPRE, GB, l == 0 ? nullptr : sumsq, shw};
                  REPS(2) pg8::gemm_phase(ldsl, g, S, E, wv); }
            } else if (k == 1) {
                REPS(3) conv_phase(UPRE, HKV, AIN(6) + l * 4 * DM, AIN(7) + l * DM, tid);
            } else if (k == 2) {
                pg8::Gemm g{UPRE, (const bf16_t*)(ws + WS_WG) + (size_t)l * 4 * 512 * 256, DM, 256, 256, 256 * 2, 512 * 256 * 2};
                int two = 2; asm volatile("" : "+s"(two));
                pg8::GatesOrder S{c, two};
                pg8::EpiGatesS E{ws, 4u * (unsigned)(l + 1), AIN(9) + l * DM, AIN(11) + l * DM, AIN(12) + l * DM, ldsl};
                REPS(4) pg8::gemm_phase(ldsl, g, S, E, wv);
            } else {
                pg8::Gemm g{HN, (const bf16_t*)(ws + WS_WOUT) + (size_t)l * DM * DM, DM, DM, DM, 0, 0};
                pg8::MultiOrder S; S.init(MTOK, DM, 1, G, c);
                _Float16* x16 = (_Float16*)(ws + WS_X16);
                if (l == 0) { pg8::EpiResH<float, false> E{AIN(0), x16, modv + 2 * DM, modv, HKV, AIN(4) + DM, 3 * DM + DM, nullptr, nullptr, 0, sumsq};
                    REPS(7) pg8::gemm_phase(ldsl, g, S, E, wv); }
                else { pg8::EpiResH<_Float16, true> E{x16, x16, modv + l * 3 * DM + 2 * DM, modv, HKV, AIN(4) + (l + 1) * DM, (l + 1) * 3 * DM + DM,
                              LAb, AIN(14), 4 * 3 * DM + DM, sumsq + (size_t)l * MTOK};
                    REPS(7) pg8::gemm_phase(ldsl, g, S, E, wv); }
            }
        } else if (ph <= 13) {
            const int i = (ph - 8) / 3, k = (ph - 8) % 3, l = 2 + i;
            if (k == 0) {
                pg8::Gemm g{i == 0 ? HKV : LAb, (const bf16_t*)(ws + (i == 0 ? WS_ATTIN0 : WS_ATTIN1)), DM, DM, DM, (long)(WS_LA - WS_HKV), (long)(WS_WKV - WS_ATTIN0)};
                pg8::MultiOrder S; S.init(MTOK, 2 * DM, i == 0 ? 2 : 1, G, c);
                pg8::EpiQKV E{ws, kmean, sumsq + (size_t)(1 + i) * MTOK, shw + (size_t)(i == 0 ? 1 : 3) * 8 * 2 * DM, 8 * 2 * DM};
                REPS(9) pg8::gemm_phase(ldsl, g, S, E, wv);
            } else if (k == 1) {
                REPS(10) att::attn_phase((char*)lds, UPRE, HN, BINb, HKV, GB, kmean, wv);
            } else if (i == 0) {
                pg8::Gemm g{HKV, (const bf16_t*)(ws + WS_ATTOUT), DM, DM, DM, 0, 0};
                pg8::MultiOrder S; S.init(MTOK, DM, 1, G, c);
                _Float16* x16 = (_Float16*)(ws + WS_X16);
                pg8::EpiResH<_Float16, false> E{x16, x16, modv + l * 3 * DM + 2 * DM, modv, LAb, AIN(4) + 3 * DM, 3 * 3 * DM + DM, nullptr, nullptr, 0, sumsq + (size_t)2 * MTOK};
                REPS(11) pg8::gemm_phase(ldsl, g, S, E, wv);
            } else {
                pg8::Gemm g{HKV, (const bf16_t*)(ws + WS_ATTOUT) + (size_t)DM * DM, DM, DM, DM, 0, 0};
                pg8::MultiOrder S; S.init(MTOK, DM, 1, G, c);
                pg8::EpiFinal E{(const _Float16*)(ws + WS_X16), xw, modv + l * 3 * DM + 2 * DM, AIN(20), sumsq + (size_t)3 * MTOK, (unsigned*)(ws + WS_PCNT)};
                REPS(12) pg8::gemm_phase(ldsl, g, S, E, wv);
            }
        }
    }
}
__global__ void __launch_bounds__(NTHR, 2) yoco_fwd(Args a_) {
    extern __shared__ __attribute__((aligned(16))) unsigned char lds[];
    const int ph_lo = a_.ph_lo, ph_hi = a_.ph_hi;
    const int wv = __builtin_amdgcn_readfirstlane((int)threadIdx.x >> 6);
    if (ph_hi - ph_lo > 1) {
        if (threadIdx.x < 8) ((volatile LAS unsigned*)((LAS unsigned char*)lds + LDS_MISC))[threadIdx.x] = 0u;
        if (threadIdx.x == 0) (void)xb_add(&((unsigned*)(a_.ws + WS_BAR))[XB_XCNT(xb_xcc_id())], 1u);
        __syncthreads();
    }
#define SEAM(P) do { ArgsP ap_ = (ArgsP)__builtin_amdgcn_kernarg_segment_ptr(); asm volatile("" : "+s"(ap_)); \
        xcd_barrier((unsigned*)((unsigned char*)ap_->ws + WS_BAR), (volatile LAS unsigned*)((LAS unsigned char*)lds + LDS_MISC), opq_tid(wv)); } while (0)
#ifndef TPROBE_MASK
#define TPROBE_MASK 0
#endif
#define TPROBE_MULT 10
#define TP_ON(P) ((TPROBE_MASK >> (P)) & 1)
#define TP_BEGIN(P) if (TP_ON(P) && blockIdx.x == 0 && opq_tid(wv) == 0) { volatile LAS unsigned long long* tw_ = (volatile LAS unsigned long long*)((LAS unsigned char*)lds + LDS_MISC + 16); tw_[1] = __builtin_amdgcn_s_memrealtime(); }
#define TP_END(P) if (TP_ON(P) && blockIdx.x == 0 && opq_tid(wv) == 0) { volatile LAS unsigned long long* tw_ = (volatile LAS unsigned long long*)((LAS unsigned char*)lds + LDS_MISC + 16); tw_[0] = tw_[0] + (__builtin_amdgcn_s_memrealtime() - tw_[1]); }
#define RUN(P) if ((P) >= ph_lo && (P) < ph_hi) { TP_BEGIN(P) run_phase<P>(lds, wv); if ((P) + 1 < ph_hi) { for (int br_ = 0; br_ < BAR_REP; ++br_) SEAM(P); } TP_END(P) }
    RUN(0) RUN(1) RUN(2) RUN(3) RUN(4) RUN(5) RUN(6) RUN(7) RUN(8) RUN(9) RUN(10) RUN(11)
    RUN(12) RUN(13)
#undef RUN
#undef SEAM
    if (TPROBE_MASK != 0 && blockIdx.x == 0 && opq_tid(wv) == 0) {
        volatile LAS unsigned long long* tw_ = (volatile LAS unsigned long long*)((LAS unsigned char*)lds + LDS_MISC + 16);
        const unsigned long long span = tw_[0] * TPROBE_MULT, t0 = __builtin_amdgcn_s_memrealtime();
        while (__builtin_amdgcn_s_memrealtime() - t0 < span) __builtin_amdgcn_s_sleep(8);
    }
}

extern "C" void kernel_launch(void* const* d_in, const int* in_sizes, int n_in, void* d_out, int out_size, void* d_ws, size_t ws_size, hipStream_t stream) {
    static int grid = 0;
    if (grid == 0) {
        if (n_in != 21 || out_size != MTOK * DM || ws_size < WS_END) { fprintf(stderr, "kernel_launch: unexpected shapes (n_in %d out %d ws %zu)\n", n_in, out_size, ws_size); grid = -1; return; }
        int dev = 0, cus = 0, per_cu = 0;
        (void)hipGetDevice(&dev);
        if (hipDeviceGetAttribute(&cus, hipDeviceAttributeMultiprocessorCount, dev) != hipSuccess || cus <= 0) cus = 256;
        if (hipFuncSetAttribute((const void*)yoco_fwd, hipFuncAttributeMaxDynamicSharedMemorySize, LDS_BYTES) != hipSuccess) { fprintf(stderr, "kernel_launch: hipFuncSetAttribute failed\n"); grid = -1; return; }
        if (hipOccupancyMaxActiveBlocksPerMultiprocessor(&per_cu, (const void*)yoco_fwd, NTHR, LDS_BYTES) != hipSuccess || per_cu < 1) { fprintf(stderr, "kernel_launch: occupancy query says %d\n", per_cu); per_cu = 1; }
        (void)hipGetLastError();
        grid = cus > 256 ? 256 : cus;
    }
    if (grid < 0) return;
    (void)hipMemsetAsync((char*)d_ws + WS_CTL, 0, CTL_ZERO_BYTES, stream);
    Args a{};
    for (int i = 0; i < 21; ++i) a.in[i] = (const float*)d_in[i];
    a.out = (float*)d_out; a.ws = (unsigned char*)d_ws;
#if MK_MULTI_LAUNCH
    for (int ph = 0; ph < NPHASE; ++ph) { a.ph_lo = ph; a.ph_hi = ph + 1; hipLaunchKernelGGL(yoco_fwd, dim3(grid), dim3(NTHR), LDS_BYTES, stream, a); }
#else
    a.ph_lo = 0; a.ph_hi = NPHASE;
    void* kargs[] = {&a};
    hipError_t e = hipLaunchCooperativeKernel((const void*)yoco_fwd, dim3(grid), dim3(NTHR), kargs, LDS_BYTES, stream);
    if (e != hipSuccess) fprintf(stderr, "kernel_launch: cooperative launch failed: %s (grid %d)\n", hipGetErrorString(e), grid);
#endif
}
```

```cpp
#include <hip/hip_runtime.h>
#include <hip/hip_cooperative_groups.h>
#include <cstdio>
#include <cstdint>
namespace cg = cooperative_groups;

#ifndef MK_MULTI_LAUNCH
#define MK_MULTI_LAUNCH 0
#endif

constexpr int DM = 1024, NB = 8, SEQ = 2048, MTOK = NB * SEQ, NH = 8, DH = 128;
constexpr int MODV_LD = 14336;
constexpr float EPS = 1e-6f;
constexpr int NWAVES = 8, NTHR = 512;
constexpr int LDS_BYTES = 147456;

constexpr size_t MiB = 1u << 20;
constexpr size_t WS_CTL = 0, CTL_ZERO_BYTES = 1 * MiB + 256 * 1024;
constexpr size_t WS_MODV = 64 * 1024;
constexpr size_t WS_KMEAN = 512 * 1024;
constexpr size_t WS_GFLAG = 32 * 1024;
constexpr size_t WS_SHW = 768 * 1024;
constexpr size_t WS_PCNT = 48 * 1024;
constexpr size_t WS_CFLAG = 50 * 1024;
constexpr size_t WS_SUMSQ = 1 * MiB;
constexpr size_t WS_TA = 1 * MiB + 256 * 1024;
constexpr size_t WS_WIN = 2 * MiB;
constexpr size_t WS_WG = 10 * MiB;
constexpr size_t WS_WOUT = 12 * MiB;
constexpr size_t WS_ATTIN0 = 16 * MiB, WS_WKV = 20 * MiB, WS_ATTIN1 = 24 * MiB;
constexpr size_t WS_ATTOUT = 28 * MiB;
constexpr size_t WS_HN = 32 * MiB;
constexpr size_t WS_HKV = 64 * MiB;
constexpr size_t WS_UPRE = 96 * MiB;
constexpr size_t WS_G = 128 * MiB;
constexpr size_t WS_LA = 160 * MiB;
constexpr size_t WS_BIN = 192 * MiB;
constexpr size_t WS_X16 = 224 * MiB;
constexpr size_t WS_END = 256 * MiB;

typedef unsigned short bf16_t;
typedef short bf16x8 __attribute__((ext_vector_type(8)));
typedef short s16x4 __attribute__((ext_vector_type(4)));
typedef float f32x4 __attribute__((ext_vector_type(4)));
typedef float f32x2 __attribute__((ext_vector_type(2)));
typedef float f32x16 __attribute__((ext_vector_type(16)));
typedef unsigned u32x4 __attribute__((ext_vector_type(4)));
typedef unsigned u32x2 __attribute__((ext_vector_type(2)));
#define LAS __attribute__((address_space(3)))

__device__ __forceinline__ unsigned cvt_pk_bf16(float lo, float hi) { unsigned r; asm volatile("v_cvt_pk_bf16_f32 %0, %1, %2" : "=v"(r) : "v"(lo), "v"(hi)); return r; }
__device__ __forceinline__ float bf_lo(unsigned w) { return __uint_as_float(w << 16); }
__device__ __forceinline__ float bf_hi(unsigned w) { return __uint_as_float(w & 0xffff0000u); }
__device__ __forceinline__ float bf1(bf16_t h) { return __uint_as_float((unsigned)h << 16); }
__device__ __forceinline__ float fexp(float x) { return __builtin_amdgcn_exp2f(x * 1.4426950408889634f); }
__device__ __forceinline__ float flog(float x) { return __builtin_amdgcn_logf(x) * 0.6931471805599453f; }
__device__ __forceinline__ float fsigmoid(float x) { return __builtin_amdgcn_rcpf(1.f + fexp(-x)); }
__device__ __forceinline__ float fsilu(float x) { return x * fsigmoid(x); }
__device__ __forceinline__ int opq_tid(int wv) { int l; asm volatile("v_mbcnt_lo_u32_b32 %0, -1, 0\n\tv_mbcnt_hi_u32_b32 %0, -1, %0" : "=v"(l)); return wv * 64 + l; }
__device__ __forceinline__ int opq_bid() { int b = blockIdx.x; asm volatile("" : "+s"(b)); return b; }
__device__ __forceinline__ float wave_sum(float v) {
#pragma unroll
    for (int o = 1; o < 64; o <<= 1) v += __shfl_xor(v, o);
    return v;
}

namespace pg8 {
constexpr int BM = 256, BK = 64, HALF = 128, HTB = HALF * BK * 2, STAGE_BYTES = 8 * HTB, NXCD = 8, WGM = 8;
__host__ __device__ __forceinline__ int lds_byte(int r, int c) { const int st = (r >> 4) * 2 + (c >> 5), rr = r & 15, cc = c & 31, ob = rr * 64 + cc * 2; return st * 1024 + (ob ^ (((ob >> 9) & 1) << 5)); }
__host__ __device__ __forceinline__ void stage_rc(int b, int& R, int& C) { const int st = b / 1024, sb = b % 1024, swz = sb ^ (((sb >> 9) & 1) << 5); R = (st >> 1) * 16 + swz / 64; C = (st & 1) * 32 + (swz % 64) / 2; }
__host__ __device__ __forceinline__ int perm32(int rho) { const int n = rho >> 4, i = rho & 15; return 8 * (i >> 2) + 4 * n + (i & 3); }

struct Unit { int pm, pn, sub; };
struct Gemm { const bf16_t* A; const bf16_t* Bt; int lda, ldb, K; long a_sub, b_sub; };

struct MultiOrder {
    int nM, nN, nwg, nsub, G, c;
    __device__ void init(int M, int N, int nsub_, int G_, int c_) { nM = M / BM; nN = N / BM; nwg = nM * nN; nsub = nsub_; G = G_; c = c_; }
    __device__ bool next(int i, Unit& u) const {
        const long L = (long)i * G + c; if (L >= (long)nwg * nsub) return false;
        u.sub = (int)(L / nwg);
        int wgid = (int)(L % nwg); { const int q = nwg / NXCD, r = nwg % NXCD, xcd = wgid % NXCD, off = wgid / NXCD; wgid = (xcd < r ? xcd * (q + 1) : r * (q + 1) + (xcd - r) * q) + off; }
        const int nig = WGM * nN, gid = wgid / nig, fm = gid * WGM, gsz = (nM - fm) < WGM ? (nM - fm) : WGM;
        u.pm = fm + ((wgid % nig) % gsz); u.pn = (wgid % nig) / gsz; return true;
    }
};


template <int N> __device__ __forceinline__ float dpp_shr(float src, float ident) {
    return __int_as_float(__builtin_amdgcn_update_dpp(__float_as_int(ident), __float_as_int(src), 0x110 + N, 0xF, 0xF, false));
}
struct EpiSplit {
    static constexpr bool PERM = true, APERM = false;
    bf16_t* O0; bf16_t* O1; const float* sumsq; const float* shw;
    __device__ __forceinline__ void operator()(const f32x4 (&acc)[2][2][4][2], const Unit& u, int wr, int wc, int fr, int fq) const {
        const int row0 = u.pm * BM + wr * 64 + fr; int colt = u.pn * BM; bf16_t* base = O0;
        const int cfull = u.pn * BM + wc * 32 + 8 * fq;
        const bool gate_half = colt >= DM;
        if (gate_half) { base = O1; colt -= DM; }
        const int col0 = colt + wc * 32 + 8 * fq;
        f32x4 bv[2][2];
#pragma unroll
        for (int bj = 0; bj < 2; ++bj)
#pragma unroll
            for (int n = 0; n < 2; ++n) bv[bj][n] = sumsq ? *(const f32x4*)(shw + (size_t)(u.pm >> 3) * 2 * DM + cfull + bj * HALF + 4 * n) : (f32x4){0.f, 0.f, 0.f, 0.f};
        float ssq[2][4];
#pragma unroll
        for (int ai = 0; ai < 2; ++ai)
#pragma unroll
            for (int m = 0; m < 4; ++m) ssq[ai][m] = sumsq ? sumsq[row0 + ai * HALF + m * 16] : 0.f;
#pragma unroll
        for (int ai = 0; ai < 2; ++ai)
#pragma unroll
            for (int m = 0; m < 4; ++m) { const int row = row0 + ai * HALF + m * 16; bf16_t* rowp = base + (size_t)row * DM + col0;
                const float rs = sumsq ? __builtin_amdgcn_rsqf(ssq[ai][m] * (1.f / DM) + EPS) : 1.f;
#pragma unroll
                for (int bj = 0; bj < 2; ++bj) { f32x4 v0 = acc[ai][bj][m][0] * rs + bv[bj][0], v1 = acc[ai][bj][m][1] * rs + bv[bj][1];
                    if (gate_half) {
#pragma unroll
                        for (int j = 0; j < 4; ++j) { v0[j] = fsilu(v0[j]); v1[j] = fsilu(v1[j]); } }
                    u32x4 w; w.x = cvt_pk_bf16(v0[0], v0[1]); w.y = cvt_pk_bf16(v0[2], v0[3]); w.z = cvt_pk_bf16(v1[0], v1[1]); w.w = cvt_pk_bf16(v1[2], v1[3]);
                    *(u32x4*)(rowp + bj * HALF) = w; } }
    }
};

typedef _Float16 h16x8 __attribute__((ext_vector_type(8)));
__device__ __forceinline__ void ld8(const float* p, float (&v)[8]) { const f32x4 a = *(const f32x4*)p, b = *(const f32x4*)(p + 4); v[0] = a[0]; v[1] = a[1]; v[2] = a[2]; v[3] = a[3]; v[4] = b[0]; v[5] = b[1]; v[6] = b[2]; v[7] = b[3]; }
struct InOrder {
    int c, n, base;
    __device__ bool next(int i, Unit& u) const { if (i >= n) return false; const int j = c >> 3; int pm = (c & 7) * 8 + (j >> 2), pn = 4 * (i + base) + (j & 3), sub = 0;
        asm volatile("" : "+s"(pm), "+s"(pn), "+s"(sub)); u.pm = pm; u.pn = pn; u.sub = sub; return true; }
};
constexpr int CV_HL_OFF = 133120;
struct EpiSplitConv {
    static constexpr bool PERM = true, APERM = true;
    unsigned char* ws; const float* sumsq; const float* shw; const float* cw; const float* cb; unsigned target; LAS unsigned char* lds;
    __device__ __forceinline__ void operator()(f32x4 (&acc)[2][2][4][2], const Unit& u, int wr, int wc, int fr, int fq) const {
        const int pnl = u.pn & 3;
        const int cfull = u.pn * BM + wc * 32 + 8 * fq, ct = wc * 32 + 8 * fq, col0 = pnl * BM + ct;
        bf16_t* obase = (bf16_t*)(ws + WS_UPRE);
        f32x4 bv[2][2];
#pragma unroll
        for (int bj = 0; bj < 2; ++bj)
#pragma unroll
            for (int n = 0; n < 2; ++n) bv[bj][n] = sumsq ? *(const f32x4*)(shw + (size_t)(u.pm >> 3) * 2 * DM + cfull + bj * HALF + 4 * n) : (f32x4){0.f, 0.f, 0.f, 0.f};
        float ssq[2][4];
#pragma unroll
        for (int ai = 0; ai < 2; ++ai)
#pragma unroll
            for (int m = 0; m < 4; ++m) ssq[ai][m] = sumsq ? sumsq[u.pm * BM + ai * HALF + wr * 64 + 4 * fr + m] : 0.f;
#pragma unroll
        for (int ai = 0; ai < 2; ++ai)
#pragma unroll
            for (int m = 0; m < 4; ++m) { const float rs = sumsq ? __builtin_amdgcn_rsqf(ssq[ai][m] * (1.f / DM) + EPS) : 1.f;
#pragma unroll
                for (int bj = 0; bj < 2; ++bj) { acc[ai][bj][m][0] = acc[ai][bj][m][0] * rs + bv[bj][0]; acc[ai][bj][m][1] = acc[ai][bj][m][1] * rs + bv[bj][1]; } }
        const int tile = u.pm * 4 + pnl;
        unsigned long long* HX = (unsigned long long*)(ws + WS_BIN);
        unsigned* flags = (unsigned*)(ws + WS_CFLAG);
        LAS f32x4* HL = (LAS f32x4*)(lds + CV_HL_OFF);
#pragma unroll
        for (int ai = 0; ai < 2; ++ai)
#pragma unroll
            for (int k = 0; k < 3; ++k)
#pragma unroll
                for (int bj = 0; bj < 2; ++bj) {
                    if (fr == 15) { LAS f32x4* d = HL + (((ai * 2 + wr) * 3 + k) * 256 + bj * HALF + ct) / 4;
                        d[0] = acc[ai][bj][k + 1][0]; d[1] = acc[ai][bj][k + 1][1];
                        if (ai == 1 && wr == 1) { unsigned long long* g_ = HX + ((size_t)(tile * 3 + k) * 256 + bj * HALF + ct) / 2;
#pragma unroll
                            for (int n = 0; n < 2; ++n) { const f32x4 v = acc[1][bj][k + 1][n];
                                __hip_atomic_store(g_ + 2 * n, ((unsigned long long)__float_as_uint(v[1]) << 32) | __float_as_uint(v[0]), __ATOMIC_RELAXED, __HIP_MEMORY_SCOPE_AGENT);
                                __hip_atomic_store(g_ + 2 * n + 1, ((unsigned long long)__float_as_uint(v[3]) << 32) | __float_as_uint(v[2]), __ATOMIC_RELAXED, __HIP_MEMORY_SCOPE_AGENT); } } }
                    asm volatile("" ::: "memory"); __builtin_amdgcn_sched_barrier(0);
                }
        if (wr == 1) { asm volatile("s_waitcnt vmcnt(0)" ::: "memory");
            if (fr == 15 && fq == 0) __hip_atomic_fetch_add(flags + tile * 8, 1u, __ATOMIC_RELAXED, __HIP_MEMORY_SCOPE_AGENT); }
        asm volatile("s_waitcnt lgkmcnt(0)" ::: "memory"); __builtin_amdgcn_s_barrier(); asm volatile("" ::: "memory");
        const bool need_prev = (wr == 0) && ((u.pm & 7) != 0);
        if (need_prev) { unsigned spins = 0;
            while (__hip_atomic_load(flags + (tile - 4) * 8, __ATOMIC_RELAXED, __HIP_MEMORY_SCOPE_AGENT) < target) { __builtin_amdgcn_s_sleep(2); if (++spins > (1u << 22)) break; } }
#pragma unroll
        for (int ai = 0; ai < 2; ++ai)
#pragma unroll
            for (int bj = 0; bj < 2; ++bj)
#pragma unroll
                for (int n = 0; n < 2; ++n) {
                    f32x4 pr[3];
                    if (ai == 0 && wr == 0) {
#pragma unroll
                        for (int k = 0; k < 3; ++k) { unsigned long long wa = 0ull, wb = 0ull;
                            if (need_prev) { const unsigned long long* sp = HX + ((size_t)((tile - 4) * 3 + k) * 256 + bj * HALF + ct + 4 * n) / 2;
                                wa = __hip_atomic_load(sp, __ATOMIC_RELAXED, __HIP_MEMORY_SCOPE_AGENT); wb = __hip_atomic_load(sp + 1, __ATOMIC_RELAXED, __HIP_MEMORY_SCOPE_AGENT); }
                            pr[k] = (f32x4){__uint_as_float((unsigned)wa), __uint_as_float((unsigned)(wa >> 32)), __uint_as_float((unsigned)wb), __uint_as_float((unsigned)(wb >> 32))}; }
                    } else { const int prun = ai * 2 + wr - 1;
#pragma unroll
                        for (int k = 0; k < 3; ++k) pr[k] = HL[((prun * 3 + k) * 256 + bj * HALF + ct + 4 * n) / 4]; }
                    const int chg = pnl * BM + bj * HALF + ct + 4 * n;
                    const f32x4 w0 = *(const f32x4*)(cw + chg), w1 = *(const f32x4*)(cw + DM + chg), w2 = *(const f32x4*)(cw + 2 * DM + chg), w3 = *(const f32x4*)(cw + 3 * DM + chg), bb = *(const f32x4*)(cb + chg);
                    const f32x4 x0 = acc[ai][bj][0][n], x1 = acc[ai][bj][1][n], x2 = acc[ai][bj][2][n], x3 = acc[ai][bj][3][n];
                    f32x4 q1, q2, q3;
#pragma unroll
                    for (int j = 0; j < 4; ++j) { q1[j] = dpp_shr<1>(x3[j], pr[2][j]); q2[j] = dpp_shr<1>(x2[j], pr[1][j]); q3[j] = dpp_shr<1>(x1[j], pr[0][j]); }
                    const f32x4 y0 = bb + w0 * q3 + w1 * q2 + w2 * q1 + w3 * x0, y1 = bb + w0 * q2 + w1 * q1 + w2 * x0 + w3 * x1;
                    const f32x4 y2 = bb + w0 * q1 + w1 * x0 + w2 * x1 + w3 * x2, y3 = bb + w0 * x0 + w1 * x1 + w2 * x2 + w3 * x3;
                    bf16_t* op = obase + (size_t)(u.pm * BM + ai * HALF + wr * 64 + 4 * fr) * DM + col0 + bj * HALF + 4 * n;
                    { u32x2 w; w.x = cvt_pk_bf16(y0[0], y0[1]); w.y = cvt_pk_bf16(y0[2], y0[3]); *(u32x2*)(op) = w; }
                    { u32x2 w; w.x = cvt_pk_bf16(y1[0], y1[1]); w.y = cvt_pk_bf16(y1[2], y1[3]); *(u32x2*)(op + DM) = w; }
                    { u32x2 w; w.x = cvt_pk_bf16(y2[0], y2[1]); w.y = cvt_pk_bf16(y2[2], y2[3]); *(u32x2*)(op + 2 * DM) = w; }
                    { u32x2 w; w.x = cvt_pk_bf16(y3[0], y3[1]); w.y = cvt_pk_bf16(y3[2], y3[3]); *(u32x2*)(op + 3 * DM) = w; }
                    asm volatile("" ::: "memory"); __builtin_amdgcn_sched_barrier(0);
                }
    }
};

template <class TIn, bool HAS_A2>
struct EpiResH {
    static constexpr bool PERM = true, APERM = false;
    const TIn* xin; _Float16* xo; const float* gate; const float* modv; bf16_t* A1; const float* g1; int sc1; bf16_t* A2; const float* g2; int sc2; float* sumsq;
    __device__ __forceinline__ void operator()(const f32x4 (&acc)[2][2][4][2], const Unit& u, int wr, int wc, int fr, int fq) const {
        const int b = u.pm >> 3, col0 = u.pn * BM + wc * 32 + 8 * fq;
        float gv[2][8], gs1[2][8], gs2[HAS_A2 ? 2 : 1][8];
#pragma unroll
        for (int bj = 0; bj < 2; ++bj) { const int cc = col0 + bj * HALF;
            ld8(gate + (size_t)b * MODV_LD + cc, gv[bj]);
            { float gg[8], sc[8]; ld8(g1 + cc, gg); ld8(modv + (size_t)b * MODV_LD + sc1 + cc, sc);
#pragma unroll
              for (int j = 0; j < 8; ++j) gs1[bj][j] = gg[j] * (sc[j] + 1.f); }
            if constexpr (HAS_A2) { float gg[8], sc[8]; ld8(g2 + cc, gg); ld8(modv + (size_t)b * MODV_LD + sc2 + cc, sc);
#pragma unroll
              for (int j = 0; j < 8; ++j) gs2[bj][j] = gg[j] * (sc[j] + 1.f); } }
        constexpr int NG = (sizeof(TIn) == 4 || HAS_A2) ? 2 : 4;
#pragma unroll
        for (int ai = 0; ai < 2; ++ai) {
#pragma unroll
          for (int mh = 0; mh < 4; mh += NG) {
            float xv[sizeof(TIn) == 4 ? NG : 1][2][8]; h16x8 xh[sizeof(TIn) == 4 ? 1 : NG][2];
#pragma unroll
            for (int mm = 0; mm < NG; ++mm) { const size_t off = (size_t)(u.pm * BM + ai * HALF + wr * 64 + (mh + mm) * 16 + fr) * DM + col0;
#pragma unroll
                for (int bj = 0; bj < 2; ++bj) {
                    if constexpr (sizeof(TIn) == 4) ld8((const float*)xin + off + bj * HALF, xv[mm][bj]);
                    else xh[mm][bj] = *(const h16x8*)((const _Float16*)xin + off + bj * HALF); } }
            __builtin_amdgcn_sched_barrier(0);
#pragma unroll
            for (int mm = 0; mm < NG; ++mm) { const int m = mh + mm; const int row = u.pm * BM + ai * HALF + wr * 64 + m * 16 + fr; const size_t off = (size_t)row * DM + col0;
                float ss = 0.f;
#pragma unroll
                for (int bj = 0; bj < 2; ++bj) { float o[8]; h16x8 ho;
#pragma unroll
                    for (int j = 0; j < 8; ++j) { float xj; if constexpr (sizeof(TIn) == 4) xj = xv[mm][bj][j]; else xj = (float)xh[mm][bj][j];
                        o[j] = xj + gv[bj][j] * acc[ai][bj][m][j >> 2][j & 3]; ho[j] = (_Float16)o[j]; ss += o[j] * o[j]; }
                    *(h16x8*)(xo + off + bj * HALF) = ho;
                    if (A1) { u32x4 w; w.x = cvt_pk_bf16(o[0] * gs1[bj][0], o[1] * gs1[bj][1]); w.y = cvt_pk_bf16(o[2] * gs1[bj][2], o[3] * gs1[bj][3]);
                        w.z = cvt_pk_bf16(o[4] * gs1[bj][4], o[5] * gs1[bj][5]); w.w = cvt_pk_bf16(o[6] * gs1[bj][6], o[7] * gs1[bj][7]); *(u32x4*)(A1 + off + bj * HALF) = w; }
                    if constexpr (HAS_A2) { u32x4 w; w.x = cvt_pk_bf16(o[0] * gs2[bj][0], o[1] * gs2[bj][1]); w.y = cvt_pk_bf16(o[2] * gs2[bj][2], o[3] * gs2[bj][3]);
                        w.z = cvt_pk_bf16(o[4] * gs2[bj][4], o[5] * gs2[bj][5]); w.w = cvt_pk_bf16(o[6] * gs2[bj][6], o[7] * gs2[bj][7]); *(u32x4*)(A2 + off + bj * HALF) = w; } }
                if (sumsq) { ss += __shfl_xor(ss, 16); ss += __shfl_xor(ss, 32); if (fq == 0) atomicAdd(sumsq + row, ss); } }
            __builtin_amdgcn_sched_barrier(0);
          }
        }
    }
};

struct EpiFinal {
    static constexpr bool PERM = true, APERM = false;
    const _Float16* xin; float* out; const float* gate; const float* fg; float* sumsq; unsigned* cnt;
    __device__ __forceinline__ void operator()(f32x4 (&acc)[2][2][4][2], const Unit& u, int wr, int wc, int fr, int fq) const {
        const int b = u.pm >> 3, col0 = u.pn * BM + wc * 32 + 8 * fq;
        float gv[2][8];
#pragma unroll
        for (int bj = 0; bj < 2; ++bj) ld8(gate + (size_t)b * MODV_LD + col0 + bj * HALF, gv[bj]);
#pragma unroll
        for (int ai = 0; ai < 2; ++ai) {
            h16x8 xh[4][2];
#pragma unroll
            for (int m = 0; m < 4; ++m)
#pragma unroll
                for (int bj = 0; bj < 2; ++bj) xh[m][bj] = *(const h16x8*)(xin + (size_t)(u.pm * BM + ai * HALF + wr * 64 + m * 16 + fr) * DM + col0 + bj * HALF);
            __builtin_amdgcn_sched_barrier(0);
#pragma unroll
            for (int m = 0; m < 4; ++m) { const int row = u.pm * BM + ai * HALF + wr * 64 + m * 16 + fr;
                float ss = 0.f;
#pragma unroll
                for (int bj = 0; bj < 2; ++bj) { f32x4 o0, o1;
#pragma unroll
                    for (int j = 0; j < 4; ++j) { o0[j] = (float)xh[m][bj][j] + gv[bj][j] * acc[ai][bj][m][0][j]; o1[j] = (float)xh[m][bj][4 + j] + gv[bj][4 + j] * acc[ai][bj][m][1][j]; }
                    acc[ai][bj][m][0] = o0; acc[ai][bj][m][1] = o1;
                    ss += (o0[0] * o0[0] + o0[1] * o0[1]) + (o0[2] * o0[2] + o0[3] * o0[3]) + (o1[0] * o1[0] + o1[1] * o1[1]) + (o1[2] * o1[2] + o1[3] * o1[3]); }
                ss += __shfl_xor(ss, 16); ss += __shfl_xor(ss, 32); if (fq == 0) atomicAdd(sumsq + row, ss); }
            __builtin_amdgcn_sched_barrier(0);
        }
        asm volatile("s_waitcnt vmcnt(0)" ::: "memory");
        if (fr == 0 && fq == 0) __hip_atomic_fetch_add(cnt + u.pm * 8, 1u, __ATOMIC_RELAXED, __HIP_MEMORY_SCOPE_AGENT);
        { unsigned spins = 0;
          while (__hip_atomic_load(cnt + u.pm * 8, __ATOMIC_RELAXED, __HIP_MEMORY_SCOPE_AGENT) < 32u) { __builtin_amdgcn_s_sleep(2); if (++spins > (1u << 22)) break; } }
        float fgv[2][8];
#pragma unroll
        for (int bj = 0; bj < 2; ++bj) ld8(fg + col0 + bj * HALF, fgv[bj]);
        float ssq[2][4];
#pragma unroll
        for (int ai = 0; ai < 2; ++ai)
#pragma unroll
            for (int m = 0; m < 4; ++m) ssq[ai][m] = __hip_atomic_load(sumsq + u.pm * BM + ai * HALF + wr * 64 + m * 16 + fr, __ATOMIC_RELAXED, __HIP_MEMORY_SCOPE_AGENT);
#pragma unroll
        for (int ai = 0; ai < 2; ++ai)
#pragma unroll
            for (int m = 0; m < 4; ++m) { const size_t off = (size_t)(u.pm * BM + ai * HALF + wr * 64 + m * 16 + fr) * DM + col0;
                const float rs = __builtin_amdgcn_rsqf(ssq[ai][m] * (1.f / DM) + EPS);
#pragma unroll
                for (int bj = 0; bj < 2; ++bj) { f32x4 y0, y1;
#pragma unroll
                    for (int j = 0; j < 4; ++j) { y0[j] = acc[ai][bj][m][0][j] * rs * fgv[bj][j]; y1[j] = acc[ai][bj][m][1][j] * rs * fgv[bj][4 + j]; }
                    *(f32x4*)(out + off + bj * HALF) = y0; *(f32x4*)(out + off + bj * HALF + 4) = y1; } }
    }
};

__device__ __forceinline__ void scan16(float& a, float& b) {
    float ap, bp;
    ap = dpp_shr<1>(a, 1.f); bp = dpp_shr<1>(b, 0.f); b = fmaf(a, bp, b); a *= ap;
    ap = dpp_shr<2>(a, 1.f); bp = dpp_shr<2>(b, 0.f); b = fmaf(a, bp, b); a *= ap;
    ap = dpp_shr<4>(a, 1.f); bp = dpp_shr<4>(b, 0.f); b = fmaf(a, bp, b); a *= ap;
    ap = dpp_shr<8>(a, 1.f); bp = dpp_shr<8>(b, 0.f); b = fmaf(a, bp, b); a *= ap;
}
__device__ __forceinline__ void gate_elem2(f32x2 xr, f32x2 xg, f32x2 nba, f32x2 nbx, f32x2 psp2, f32x2 uv, f32x2& a, f32x2& b) {
    const f32x2 tr = xr * (-1.4426950408889634f) + nba, tg = xg * (-1.4426950408889634f) + nbx;
    f32x2 er, eg; er.x = __builtin_amdgcn_exp2f(tr.x); er.y = __builtin_amdgcn_exp2f(tr.y); eg.x = __builtin_amdgcn_exp2f(tg.x); eg.y = __builtin_amdgcn_exp2f(tg.y);
    const f32x2 dr = er + 1.f, dg = eg + 1.f, dd = dr * dg;
    f32x2 inv; inv.x = __builtin_amdgcn_rcpf(dd.x); inv.y = __builtin_amdgcn_rcpf(dd.y);
    const f32x2 r = inv * dg, gi = inv * dr;
    const f32x2 la2 = psp2 * r;
    a.x = __builtin_amdgcn_exp2f(-la2.x); a.y = __builtin_amdgcn_exp2f(-la2.y);
    const f32x2 om = 1.f - a * a;
    f32x2 sq; sq.x = __builtin_amdgcn_sqrtf(om.x); sq.y = __builtin_amdgcn_sqrtf(om.y);
    b = sq * gi * uv;
}
struct GateParams { f32x2 nba[4], nbx[4], psp2[4]; };
__device__ __forceinline__ void gate_params(GateParams& P, const float* ba, const float* bx, const float* lam, int ch0) {
#pragma unroll
    for (int p = 0; p < 4; ++p) {
        const f32x2 vb = *(const f32x2*)(ba + ch0 + 2 * p), vx = *(const f32x2*)(bx + ch0 + 2 * p), vl = *(const f32x2*)(lam + ch0 + 2 * p);
        P.nba[p] = vb * (-1.4426950408889634f); P.nbx[p] = vx * (-1.4426950408889634f);
        const float z0 = -vl.x, z1 = -vl.y;
        P.psp2[p].x = 8.f * 1.4426950408889634f * (z0 > 20.f ? z0 : flog(1.f + fexp(z0)));
        P.psp2[p].y = 8.f * 1.4426950408889634f * (z1 > 20.f ? z1 : flog(1.f + fexp(z1)));
    }
}
#define GATE_PAIR(p, accv, uw_, a2, b2) do { const int n_ = (p) >> 1, q_ = ((p) & 1) * 2; \
        const unsigned uword_ = ((p) == 0) ? uw_.x : ((p) == 1) ? uw_.y : ((p) == 2) ? uw_.z : uw_.w; \
        gate_elem2((f32x2){accv[ai][0][m][n_][q_], accv[ai][0][m][n_][q_ + 1]}, (f32x2){accv[ai][1][m][n_][q_], accv[ai][1][m][n_][q_ + 1]}, \
                   P.nba[p], P.nbx[p], P.psp2[p], (f32x2){bf_lo(uword_), bf_hi(uword_)}, a2, b2); } while (0)
struct GatesOrder {
    int c, n;
    __device__ bool next(int i, Unit& u) const { if (i >= n) return false; const int j = c >> 3; int pm = (c & 7) * 8 + 4 * i + (j & 3), pn = (j >> 2) & 1, sub = (j >> 3) & 3;
        asm volatile("" : "+s"(pm), "+s"(pn), "+s"(sub)); u.pm = pm; u.pn = pn; u.sub = sub; return true; }
};
constexpr int GS_RA_OFF = 133120;
struct EpiGatesS {
    static constexpr bool PERM = true, APERM = true;
    unsigned char* ws; unsigned target; const float* ba; const float* bx; const float* lam; LAS unsigned char* lds;
    __device__ __forceinline__ void operator()(f32x4 (&acc)[2][2][4][2], const Unit& u, int wr, int wc, int fr, int fq) const {
        const bf16_t* U = (const bf16_t*)(ws + WS_UPRE); const bf16_t* Gt = (const bf16_t*)(ws + WS_G); bf16_t* Y = (bf16_t*)(ws + WS_HN);
        unsigned long long* TA = (unsigned long long*)(ws + WS_TA); unsigned* flags = (unsigned*)(ws + WS_GFLAG);
        const int ct0 = wc * 32 + 8 * fq, ch0 = u.sub * 256 + u.pn * 128 + ct0;
        const int chain = ((u.pm >> 3) * 4 + u.sub) * 2 + u.pn, p = u.pm & 7, tix = chain * 8 + p;
        const int bsrc = (fq * 16 + 15) << 2;
        LAS f32x4* RA = (LAS f32x4*)(lds + GS_RA_OFF);
        {
            GateParams P; gate_params(P, ba, bx, lam, ch0);
#pragma unroll
            for (int ai = 0; ai < 2; ++ai) {
                u32x4 uall[4];
#pragma unroll
                for (int m = 0; m < 4; ++m) uall[m] = *(const u32x4*)(U + (size_t)(u.pm * BM + ai * HALF + wr * 64 + 4 * fr + m) * DM + ch0);
#pragma unroll
                for (int n = 0; n < 2; ++n) { f32x4 tA[4], tB[4]; f32x4 agg;
#pragma unroll
                    for (int hq = 0; hq < 2; ++hq) { const int pq = 2 * n + hq; f32x2 a2[4], b2[4];
#pragma unroll
                        for (int m = 0; m < 4; ++m) { const u32x4 uw = uall[m]; GATE_PAIR(pq, acc, uw, a2[m], b2[m]); }
#pragma unroll
                        for (int m = 1; m < 4; ++m) { b2[m] = a2[m] * b2[m - 1] + b2[m]; a2[m] = a2[m] * a2[m - 1]; }
                        float pax = a2[3].x, pbx = b2[3].x, pay = a2[3].y, pby = b2[3].y; scan16(pax, pbx); scan16(pay, pby);
                        if (hq == 0) { agg[0] = pax; agg[1] = pbx; agg[2] = pay; agg[3] = pby;
                            if (fr == 15) RA[((ai * 2 + wr) * 128 + ct0) / 2 + pq] = agg; }
                        else { if (fr == 15) RA[((ai * 2 + wr) * 128 + ct0) / 2 + pq] = (f32x4){pax, pbx, pay, pby}; }
                        const f32x2 EA = {dpp_shr<1>(pax, 1.f), dpp_shr<1>(pay, 1.f)}, EB = {dpp_shr<1>(pbx, 0.f), dpp_shr<1>(pby, 0.f)};
#pragma unroll
                        for (int m = 0; m < 4; ++m) { const f32x2 Ae = a2[m] * EA, Be = a2[m] * EB + b2[m];
                            tA[m][2 * hq] = Ae.x; tA[m][2 * hq + 1] = Ae.y; tB[m][2 * hq] = Be.x; tB[m][2 * hq + 1] = Be.y; }
                        __builtin_amdgcn_sched_barrier(0); }
#pragma unroll
                    for (int m = 0; m < 4; ++m) { acc[ai][0][m][n] = tA[m]; acc[ai][1][m][n] = tB[m]; }
                    asm volatile("" ::: "memory"); __builtin_amdgcn_sched_barrier(0); }
            }
        }
        asm volatile("s_waitcnt lgkmcnt(0)" ::: "memory"); __builtin_amdgcn_s_barrier(); asm volatile("" ::: "memory");
        if (wr == 0) {
            float At[8], Bt[8];
#pragma unroll
            for (int j = 0; j < 8; ++j) { At[j] = 1.f; Bt[j] = 0.f; }
#pragma unroll
            for (int ri = 0; ri < 4; ++ri)
#pragma unroll
                for (int q = 0; q < 4; ++q) { const f32x4 v = RA[(ri * 128 + ct0) / 2 + q];
                    Bt[2 * q] = fmaf(v[0], Bt[2 * q], v[1]); At[2 * q] *= v[0]; Bt[2 * q + 1] = fmaf(v[2], Bt[2 * q + 1], v[3]); At[2 * q + 1] *= v[2]; }
            if (fr == 15) {
#pragma unroll
                for (int j = 0; j < 8; ++j) __hip_atomic_store(TA + (size_t)tix * 128 + ct0 + j, ((unsigned long long)__float_as_uint(Bt[j]) << 32) | __float_as_uint(At[j]), __ATOMIC_RELAXED, __HIP_MEMORY_SCOPE_AGENT);
            }
            asm volatile("s_waitcnt vmcnt(0)" ::: "memory");
            if (fr == 15 && fq == 0) __hip_atomic_fetch_add(flags + tix * 8, 1u, __ATOMIC_RELAXED, __HIP_MEMORY_SCOPE_AGENT);
        }
        float h[8];
        {
            const bool on = fr < p;
            if (on) { unsigned spins = 0;
                while (__hip_atomic_load(flags + (chain * 8 + fr) * 8, __ATOMIC_RELAXED, __HIP_MEMORY_SCOPE_AGENT) < target) { __builtin_amdgcn_s_sleep(2); if (++spins > (1u << 22)) break; } }
            float Ac[8], Bc[8];
#pragma unroll
            for (int j = 0; j < 8; ++j) { unsigned long long w = 0x000000003f800000ull;
                if (on) w = __hip_atomic_load(TA + (size_t)(chain * 8 + fr) * 128 + ct0 + j, __ATOMIC_RELAXED, __HIP_MEMORY_SCOPE_AGENT);
                Ac[j] = __uint_as_float((unsigned)w); Bc[j] = __uint_as_float((unsigned)(w >> 32)); }
#pragma unroll
            for (int j = 0; j < 8; ++j) { float a = Ac[j], b = Bc[j]; scan16(a, b); h[j] = __int_as_float(__builtin_amdgcn_ds_bpermute(bsrc, __float_as_int(b))); }
        }
#pragma unroll
        for (int ai = 0; ai < 2; ++ai) {
            const int nskip = (ai == 0) ? wr : 1;
            const int rfirst = (ai == 0) ? 0 : (1 + wr);
            for (int k = 0; k < nskip; ++k)
#pragma unroll
                for (int q = 0; q < 4; ++q) { const f32x4 v = RA[((rfirst + k) * 128 + ct0) / 2 + q];
                    h[2 * q] = fmaf(v[0], h[2 * q], v[1]); h[2 * q + 1] = fmaf(v[2], h[2 * q + 1], v[3]); }
            u32x4 gall[4];
#pragma unroll
            for (int m = 0; m < 4; ++m) gall[m] = *(const u32x4*)(Gt + (size_t)(u.pm * BM + ai * HALF + wr * 64 + 4 * fr + m) * DM + ch0);
            float hl[8];
#pragma unroll
            for (int m = 0; m < 4; ++m) { const size_t off = (size_t)(u.pm * BM + ai * HALF + wr * 64 + 4 * fr + m) * DM + ch0;
                const u32x4 gw = gall[m];
                const float gv[8] = {bf_lo(gw.x), bf_hi(gw.x), bf_lo(gw.y), bf_hi(gw.y), bf_lo(gw.z), bf_hi(gw.z), bf_lo(gw.w), bf_hi(gw.w)};
                float yv[8];
#pragma unroll
                for (int j = 0; j < 8; ++j) { const float hv = fmaf(acc[ai][0][m][j >> 2][j & 3], h[j], acc[ai][1][m][j >> 2][j & 3]); yv[j] = hv * gv[j];
                    if (m == 3) hl[j] = hv; }
                u32x4 w; w.x = cvt_pk_bf16(yv[0], yv[1]); w.y = cvt_pk_bf16(yv[2], yv[3]); w.z = cvt_pk_bf16(yv[4], yv[5]); w.w = cvt_pk_bf16(yv[6], yv[7]);
                *(u32x4*)(Y + off) = w; }
#pragma unroll
            for (int j = 0; j < 8; ++j) h[j] = __int_as_float(__builtin_amdgcn_ds_bpermute(bsrc, __float_as_int(hl[j])));
            asm volatile("" ::: "memory"); __builtin_amdgcn_sched_barrier(0);
        }
    }
};

struct EpiQKV {
    static constexpr bool PERM = true, APERM = false;
    unsigned char* ws; float* kmean; const float* sumsq; const float* shw; int shw_sub;
    __device__ __forceinline__ void operator()(const f32x4 (&acc)[2][2][4][2], const Unit& u, int wr, int wc, int fr, int fq) const {
        const int b = u.pm >> 3, sblk = u.pm & 7, pq = u.pn & 3; const bool second = u.pn >= 4;
        const int dcol = wc * 32 + 8 * fq;
        const float* sw = shw + (size_t)u.sub * shw_sub + (size_t)b * 2 * DM + u.pn * BM + dcol;
        f32x4 bv[2][2];
#pragma unroll
        for (int bj = 0; bj < 2; ++bj)
#pragma unroll
            for (int n = 0; n < 2; ++n) bv[bj][n] = *(const f32x4*)(sw + bj * HALF + 4 * n);
        const bool plain = (u.sub == 0 && second), km = (u.sub == 1 && !second);
        const size_t boff = plain ? WS_G : (u.sub == 0) ? WS_UPRE : (second ? WS_BIN : WS_HN);
        const size_t rstride = plain ? DM : DH;
        bf16_t* bp[2];
#pragma unroll
        for (int bj = 0; bj < 2; ++bj)
            bp[bj] = (bf16_t*)(ws + boff) + (plain ? (size_t)(u.pm * BM) * DM + pq * 256 + bj * HALF + dcol : ((size_t)(b * NH + 2 * pq + bj) * SEQ + sblk * 256) * DH + dcol);
        f32x4 s0[2], s1[2];
#pragma unroll
        for (int bj = 0; bj < 2; ++bj) { s0[bj] = (f32x4){0.f, 0.f, 0.f, 0.f}; s1[bj] = (f32x4){0.f, 0.f, 0.f, 0.f}; }
        float ssq[2][4];
#pragma unroll
        for (int ai = 0; ai < 2; ++ai)
#pragma unroll
            for (int m = 0; m < 4; ++m) ssq[ai][m] = sumsq[u.pm * BM + ai * HALF + wr * 64 + m * 16 + fr];
#pragma unroll
        for (int ai = 0; ai < 2; ++ai)
#pragma unroll
            for (int m = 0; m < 4; ++m) { const int r = ai * HALF + wr * 64 + m * 16 + fr;
                const float rs = __builtin_amdgcn_rsqf(ssq[ai][m] * (1.f / DM) + EPS);
#pragma unroll
                for (int bj = 0; bj < 2; ++bj) { f32x4 v0 = acc[ai][bj][m][0] * rs + bv[bj][0], v1 = acc[ai][bj][m][1] * rs + bv[bj][1];
                    if (plain) {
#pragma unroll
                        for (int j = 0; j < 4; ++j) { v0[j] = fsilu(v0[j]); v1[j] = fsilu(v1[j]); } }
                    s0[bj] += v0; s1[bj] += v1;
                    u32x4 w; w.x = cvt_pk_bf16(v0[0], v0[1]); w.y = cvt_pk_bf16(v0[2], v0[3]); w.z = cvt_pk_bf16(v1[0], v1[1]); w.w = cvt_pk_bf16(v1[2], v1[3]);
                    *(u32x4*)(bp[bj] + (size_t)r * rstride) = w; }
                asm volatile("" ::: "memory"); }
        if (km) {
#pragma unroll
            for (int bj = 0; bj < 2; ++bj)
#pragma unroll
                for (int j = 0; j < 4; ++j) { float t0 = s0[bj][j], t1 = s1[bj][j];
                    t0 += __shfl_xor(t0, 1); t0 += __shfl_xor(t0, 2); t0 += __shfl_xor(t0, 4); t0 += __shfl_xor(t0, 8);
                    t1 += __shfl_xor(t1, 1); t1 += __shfl_xor(t1, 2); t1 += __shfl_xor(t1, 4); t1 += __shfl_xor(t1, 8);
                    if (fr == 0) { float* kp = kmean + ((size_t)(b * NH + 2 * pq + bj) * 8 + sblk) * DH + dcol + j;
                        atomicAdd(kp, t0 * (1.f / 256.f)); atomicAdd(kp + 4, t1 * (1.f / 256.f)); } }
        }
    }
};

template <class Epi, class Sched>
__device__ __forceinline__ void gemm_phase(LAS unsigned char* lds, const Gemm g, const Sched& S, const Epi& E, int wv) {
    const int tid = opq_tid(wv), wid = __builtin_amdgcn_readfirstlane(tid >> 6), lane = tid & 63, wr = wid >> 2, wc = wid & 3, fr = lane & 15, fq = lane >> 4;
    const int K = g.K, nt = K / BK;
    unsigned voffA[2], voffB[2];
#pragma unroll
    for (int i = 0; i < 2; ++i) { int R, C; stage_rc(tid * 16 + i * 8192, R, C); const int Rb = Epi::PERM ? ((R & ~31) + perm32(R & 31)) : R;
        const int Ra = Epi::APERM ? ((R & 64) + 4 * (R & 15) + ((R >> 4) & 3)) : R;
        voffA[i] = (unsigned)(Ra * g.lda + C) * 2u; voffB[i] = (unsigned)(Rb * g.ldb + C) * 2u; }
    const size_t kstep = (size_t)(BK * 2);
    const size_t hstepA = (size_t)HALF * g.lda * 2, hstepB = (size_t)HALF * g.ldb * 2;
    const size_t tstepA = 2 * hstepA, tstepB = 2 * hstepB;
    const unsigned ldsw = (unsigned)wid * 1024u;
    const int aoff = lds_byte(wr * 64 + fr, fq * 8), boff = lds_byte(wc * 32 + fr, fq * 8);
#define PG8_SA(b, h) (((b) * 2 + (h)) * HTB)
#define PG8_SB(b, h) ((4 + (b) * 2 + (h)) * HTB)
#define PG8_STAGE(bufoff, gbase, voff) do { _Pragma("unroll") for (int _i = 0; _i < 2; ++_i) \
        __builtin_amdgcn_global_load_lds((const unsigned*)((const char*)(gbase) + (voff)[_i]), (LAS unsigned*)(lds + (bufoff) + ldsw + _i * 8192), 16, 0, 0); } while (0)
#define PG8_LDA(dst, b, h) do { _Pragma("unroll") for (int m = 0; m < 4; ++m) _Pragma("unroll") for (int k = 0; k < 2; ++k) dst[m][k] = *(const LAS bf16x8*)(lds + PG8_SA(b, h) + aoff + m * 2048 + k * 1024); } while (0)
#define PG8_LDB(dst, b, h) do { _Pragma("unroll") for (int n = 0; n < 2; ++n) _Pragma("unroll") for (int k = 0; k < 2; ++k) dst[n][k] = *(const LAS bf16x8*)(lds + PG8_SB(b, h) + boff + n * 2048 + k * 1024); } while (0)
#define PG8_MMA(ai, bj, At, Bt) do { __builtin_amdgcn_s_setprio(1); _Pragma("unroll") for (int m = 0; m < 4; ++m) _Pragma("unroll") for (int n = 0; n < 2; ++n) _Pragma("unroll") for (int k = 0; k < 2; ++k) \
        acc[ai][bj][m][n] = __builtin_amdgcn_mfma_f32_16x16x32_bf16(Bt[n][k], At[m][k], acc[ai][bj][m][n], 0, 0, 0); __builtin_amdgcn_s_setprio(0); } while (0)
#define PG8_WAIT_V(n) asm volatile("s_waitcnt vmcnt(" #n ")" ::: "memory")
#define PG8_WAIT_L(n) asm volatile("s_waitcnt lgkmcnt(" #n ")" ::: "memory")
#define PG8_BAR __builtin_amdgcn_s_barrier()
#define PG8_SCHED __builtin_amdgcn_sched_barrier(0)
#define PG8_UA(u) ((const char*)g.A + (size_t)(u).sub * g.a_sub + (size_t)(u).pm * tstepA)
#define PG8_UB(u) ((const char*)g.Bt + (size_t)(u).sub * g.b_sub + (size_t)(u).pn * tstepB)
    Unit cur, nxt; int ui = 0;
    if (!S.next(0, cur)) return;
    f32x4 acc[2][2][4][2];
#pragma unroll
    for (int a = 0; a < 2; ++a)
#pragma unroll
        for (int b = 0; b < 2; ++b)
#pragma unroll
            for (int m = 0; m < 4; ++m)
#pragma unroll
                for (int n = 0; n < 2; ++n) acc[a][b][m][n] = (f32x4){0.f, 0.f, 0.f, 0.f};
    bf16x8 At[4][2], B0[2][2], B1[2][2];
    const char* cA = PG8_UA(cur); const char* cB = PG8_UB(cur);
    PG8_STAGE(PG8_SB(0, 0), cB, voffB); PG8_STAGE(PG8_SB(0, 1), cB + hstepB, voffB); PG8_STAGE(PG8_SA(0, 0), cA, voffA); PG8_STAGE(PG8_SA(0, 1), cA + hstepA, voffA);
    if (wr == 1) PG8_BAR;
    PG8_WAIT_V(2); PG8_BAR;
    PG8_STAGE(PG8_SB(1, 0), cB + kstep, voffB); PG8_STAGE(PG8_SA(1, 0), cA + kstep, voffA); PG8_STAGE(PG8_SB(1, 1), cB + hstepB + kstep, voffB);
    PG8_WAIT_V(6); PG8_BAR;
    for (;;) {
        const bool has_next = S.next(ui + 1, nxt);
        const char* nA = has_next ? PG8_UA(nxt) : cA; const char* nB = has_next ? PG8_UB(nxt) : cB;
        for (int t = 0; t < nt; t += 2) {
            const bool last = (t == nt - 2);
            const char* a1 = cA + (size_t)(t + 1) * kstep;
            const char* a2 = last ? nA : cA + (size_t)(t + 2) * kstep; const char* b2 = last ? nB : cB + (size_t)(t + 2) * kstep;
            const char* a3 = a2 + kstep; const char* b3 = b2 + kstep;
            PG8_LDB(B0, 0, 0); PG8_LDB(B1, 0, 1); PG8_SCHED; PG8_LDA(At, 0, 0); PG8_STAGE(PG8_SA(1, 1), a1 + hstepA, voffA);
            PG8_WAIT_V(8); PG8_WAIT_L(0); PG8_BAR; PG8_MMA(0, 0, At, B0); PG8_MMA(0, 1, At, B1); PG8_BAR; PG8_SCHED;
            PG8_LDA(At, 0, 1); PG8_STAGE(PG8_SB(0, 0), b2, voffB); PG8_STAGE(PG8_SB(0, 1), b2 + hstepB, voffB); PG8_STAGE(PG8_SA(0, 0), a2, voffA);
            PG8_WAIT_V(8); PG8_WAIT_L(0); PG8_BAR; PG8_MMA(1, 0, At, B0); PG8_MMA(1, 1, At, B1); PG8_BAR; PG8_SCHED;
            PG8_LDB(B0, 1, 0); PG8_LDB(B1, 1, 1); PG8_SCHED; PG8_LDA(At, 1, 0); PG8_STAGE(PG8_SA(0, 1), a2 + hstepA, voffA);
            PG8_WAIT_V(8); PG8_WAIT_L(0); PG8_BAR; PG8_MMA(0, 0, At, B0); PG8_MMA(0, 1, At, B1); PG8_BAR; PG8_SCHED;
            PG8_LDA(At, 1, 1); PG8_STAGE(PG8_SB(1, 0), b3, voffB); PG8_STAGE(PG8_SB(1, 1), b3 + hstepB, voffB); PG8_STAGE(PG8_SA(1, 0), a3, voffA);
            PG8_WAIT_V(8); PG8_WAIT_L(0); PG8_BAR; PG8_MMA(1, 0, At, B0); PG8_MMA(1, 1, At, B1); PG8_BAR; PG8_SCHED;
        }
        if (wr == 0) PG8_BAR;
        { const int t2 = opq_tid(wv), w2 = __builtin_amdgcn_readfirstlane(t2 >> 6), l2 = t2 & 63; E(acc, cur, w2 >> 2, w2 & 3, l2 & 15, l2 >> 4); }
        if (!has_next) break;
#pragma unroll
        for (int a = 0; a < 2; ++a)
#pragma unroll
            for (int b = 0; b < 2; ++b)
#pragma unroll
                for (int m = 0; m < 4; ++m)
#pragma unroll
                    for (int n = 0; n < 2; ++n) acc[a][b][m][n] = (f32x4){0.f, 0.f, 0.f, 0.f};
        cur = nxt; cA = nA; cB = nB; ++ui;
        if (wr == 1) PG8_BAR;
    }
    PG8_WAIT_V(0);
    PG8_BAR;
#undef PG8_SA
#undef PG8_SB
#undef PG8_STAGE
#undef PG8_LDA
#undef PG8_LDB
#undef PG8_MMA
#undef PG8_WAIT_V
#undef PG8_WAIT_L
#undef PG8_BAR
#undef PG8_SCHED
#undef PG8_UA
#undef PG8_UB
}
}

namespace att {
constexpr float SCALE = 0.08838834764831845f;
constexpr float THR = 8.f;
constexpr int NW = 8, QBLK = 32, KVBLK = 64, QB = NW * QBLK, D = 128;
constexpr int SHM_V = KVBLK * D * 2, SHM_K = KVBLK * D * 2;
constexpr int ATT_LDS = 2 * SHM_V + 2 * SHM_K + NW * 64 * 4;
#define KSWZ(row, colB) ((row) * 256 + ((colB) ^ (((row) & 7) << 4)))
#define SBAR() __builtin_amdgcn_sched_barrier(0)
__device__ __forceinline__ int v_st(int k, int c) { const int kk = (k & ~0xC) | ((k & 4) << 1) | ((k & 8) >> 1); return ((kk >> 3) * 4 + (c >> 5)) * 512 + ((kk & 7) * 32 + (c & 31)) * 2; }
__device__ __forceinline__ int v_rd_base(int lane) { return ((lane & 3) << 3) | (((lane >> 2) & 3) << 6) | (((lane >> 4) & 1) << 5) | (((lane >> 5) & 1) << 8); }
constexpr int v_rd_off(int d0, int ks, int half) { return d0 * 512 + ks * 4096 + half * 2048; }
__device__ __forceinline__ int crow(int r, int hi) { return (r & 3) + 8 * (r >> 2) + 4 * hi; }
__device__ __forceinline__ bf16x8 load8(const bf16_t* p) { return *reinterpret_cast<const bf16x8*>(p); }
__device__ __forceinline__ void mask_tile(f32x16& p0, f32x16& p1, int dq) {
    const float NEG = -__builtin_inff();
#pragma unroll
    for (int r = 0; r < 16; ++r) {
        const int c = (r & 3) + 8 * (r >> 2);
        if (dq - c < 0) p0[r] = NEG;
        if (dq - c - 32 < 0) p1[r] = NEG;
    }
}
__device__ __forceinline__ void mask_all(f32x16& p0, f32x16& p1, bool off) {
    const float NEG = -__builtin_inff();
#pragma unroll
    for (int r = 0; r < 16; ++r) { p0[r] = off ? NEG : p0[r]; p1[r] = off ? NEG : p1[r]; }
}
__device__ __forceinline__ void partialSM(f32x16& p0, f32x16& p1, float& m_reg, float& mn, float& alpha, float rbias = 0.f) {
    float pmax = p0[0];
#pragma unroll
    for (int r = 1; r < 16; ++r) pmax = fmaxf(pmax, p0[r]);
#pragma unroll
    for (int r = 0; r < 16; ++r) pmax = fmaxf(pmax, p1[r]);
    { auto rr = __builtin_amdgcn_permlane32_swap(__float_as_uint(pmax), __float_as_uint(pmax), false, false);
      pmax = fmaxf(__uint_as_float(rr[0]), __uint_as_float(rr[1])); }
    constexpr float C2 = 1.4426950408889634f * SCALE;
    if (__builtin_expect(__all((pmax - m_reg) * SCALE <= THR), 1)) { mn = m_reg; alpha = 1.f; }
    else { mn = fmaxf(m_reg, pmax); alpha = __builtin_amdgcn_exp2f((m_reg - mn) * C2); m_reg = mn; }
    const float mnL = -mn * C2 + rbias;
#pragma unroll
    for (int r = 0; r < 16; ++r) p0[r] = fmaf(p0[r], C2, mnL);
#pragma unroll
    for (int r = 0; r < 16; ++r) p1[r] = fmaf(p1[r], C2, mnL);
#pragma unroll
    for (int r = 0; r < 16; ++r) p0[r] = __builtin_amdgcn_exp2f(p0[r]);
}
__device__ __forceinline__ void finishSM(f32x16& p0, f32x16& p1, float alpha, float& l_reg, bf16x8& pa0, bf16x8& pa1, bf16x8& pa2, bf16x8& pa3) {
#pragma unroll
    for (int r = 0; r < 16; ++r) p1[r] = __builtin_amdgcn_exp2f(p1[r]);
    float ps = 0;
#pragma unroll
    for (int r = 0; r < 16; ++r) ps += p0[r];
#pragma unroll
    for (int r = 0; r < 16; ++r) ps += p1[r];
    { auto rr = __builtin_amdgcn_permlane32_swap(__float_as_uint(ps), __float_as_uint(ps), false, false);
      ps = __uint_as_float(rr[0]) + __uint_as_float(rr[1]); }
    l_reg = l_reg * alpha + ps;
#define PK4(P, B_, OUT) do { unsigned a0 = cvt_pk_bf16(P[B_+0], P[B_+1]), a1 = cvt_pk_bf16(P[B_+2], P[B_+3]);                          \
        unsigned b0 = cvt_pk_bf16(P[B_+4], P[B_+5]), b1 = cvt_pk_bf16(P[B_+6], P[B_+7]);                                             \
        auto r0 = __builtin_amdgcn_permlane32_swap(a0, b0, false, false); auto r1 = __builtin_amdgcn_permlane32_swap(a1, b1, false, false); \
        u32x4 w = {r0[0], r1[0], r0[1], r1[1]}; OUT = *reinterpret_cast<bf16x8*>(&w); } while (0)
    PK4(p0, 0, pa0); PK4(p0, 8, pa1); PK4(p1, 0, pa2); PK4(p1, 8, pa3);
#undef PK4
}
template <int KB>
__device__ __forceinline__ void qkt(f32x16& p0, f32x16& p1, const char* K_lds, int r32, int hi, const bf16x8* qr) {
    p0 = f32x16{}; p1 = f32x16{};
    const char* kb[4];
#pragma unroll
    for (int dd = 0; dd < 4; ++dd) kb[dd] = K_lds + KB * SHM_K + KSWZ(r32, (dd * 16 + hi * 8) * 2);
#pragma unroll
    for (int d0 = 0; d0 < 8; ++d0) { const char* a = kb[d0 & 3] + (d0 >> 2) * 128;
        bf16x8 b0 = *reinterpret_cast<const bf16x8*>(a);
        bf16x8 b1 = *reinterpret_cast<const bf16x8*>(a + 32 * 256);
        p0 = __builtin_amdgcn_mfma_f32_32x32x16_bf16(b0, qr[d0], p0, 0, 0, 0);
        p1 = __builtin_amdgcn_mfma_f32_32x32x16_bf16(b1, qr[d0], p1, 0, 0, 0); }
}
template <int VB>
__device__ __forceinline__ void pv_tile(f32x16* o, int vb0, bf16x8 pa0, bf16x8 pa1, bf16x8 pa2, bf16x8 pa3) {
#define TRRD(dst, off) asm volatile("ds_read_b64_tr_b16 %0, %1 offset:%2" : "=&v"(dst) : "v"(vb0), "i"(off) : "memory")
#define PV_D0(d0) do { s16x4 l0, l1, l2, l3, h0, h1, h2, h3; constexpr int b_ = VB * SHM_V + v_rd_off(d0, 0, 0); \
        TRRD(l0, b_); TRRD(h0, b_ + 2048); TRRD(l1, b_ + 4096); TRRD(h1, b_ + 6144); TRRD(l2, b_ + 8192); TRRD(h2, b_ + 10240); TRRD(l3, b_ + 12288); TRRD(h3, b_ + 14336); \
        asm volatile("s_waitcnt lgkmcnt(0)" ::: "memory"); SBAR();   \
        o[d0] = __builtin_amdgcn_mfma_f32_32x32x16_bf16(pa0, (bf16x8){l0[0], l0[1], l0[2], l0[3], h0[0], h0[1], h0[2], h0[3]}, o[d0], 0, 0, 0);   \
        o[d0] = __builtin_amdgcn_mfma_f32_32x32x16_bf16(pa1, (bf16x8){l1[0], l1[1], l1[2], l1[3], h1[0], h1[1], h1[2], h1[3]}, o[d0], 0, 0, 0);   \
        o[d0] = __builtin_amdgcn_mfma_f32_32x32x16_bf16(pa2, (bf16x8){l2[0], l2[1], l2[2], l2[3], h2[0], h2[1], h2[2], h2[3]}, o[d0], 0, 0, 0);   \
        o[d0] = __builtin_amdgcn_mfma_f32_32x32x16_bf16(pa3, (bf16x8){l3[0], l3[1], l3[2], l3[3], h3[0], h3[1], h3[2], h3[3]}, o[d0], 0, 0, 0); } while (0)
    PV_D0(0); PV_D0(1); PV_D0(2); PV_D0(3);
#undef PV_D0
#undef TRRD
}

struct BlockRef { const bf16_t* Q; const bf16_t* K; const bf16_t* V; bf16_t* O; const bf16_t* Gt; const float* KM; int P0; };
struct Seam { bf16x8 qr[8]; bf16x8 st_v0, st_v1, st_k0, st_k1; };
#define ROW(p, k0, rr) ((p) + (size_t)((k0) + (rr)) * D + sc)
#define VMW() asm volatile("s_waitcnt vmcnt(0)" ::: "memory")
#define VMWN(n) asm volatile("s_waitcnt vmcnt(%0)" :: "i"(n) : "memory")
#define SLOAD_H(Kp, Vp, k0) do { S.st_v0 = load8(ROW(Vp, k0, sr)); S.st_v1 = load8(ROW(Vp, k0, 32 + sr));              \
                         S.st_k0 = load8(ROW(Kp, k0, sr)); S.st_k1 = load8(ROW(Kp, k0, 32 + sr)); } while (0)
#define SWRITE_HK(bf) do { *(bf16x8*)(K_lds + (bf) * SHM_K + kws) = S.st_k0; *(bf16x8*)(K_lds + (bf) * SHM_K + kws + 32 * 256) = S.st_k1; } while (0)
#define SWRITE_HV(bf) do { *(bf16x8*)(V_lds + (bf) * SHM_V + vst0) = S.st_v0; *(bf16x8*)(V_lds + (bf) * SHM_V + vst1) = S.st_v1; } while (0)
#define SWRITE_H(bf) do { SWRITE_HV(bf); SWRITE_HK(bf); } while (0)
__device__ __forceinline__ void moba_prime(const BlockRef& cur, char* lds, Seam& S, int wv) {
    const int tid = opq_tid(wv), wid = __builtin_amdgcn_readfirstlane(tid >> 6), lane = tid & 63, r32 = lane & 31, hi = lane >> 5;
    const int sr = tid >> 4, sc = (tid & 15) * 8, kws = KSWZ(sr, sc * 2); char* K_lds = lds + 2 * SHM_V;
#pragma unroll
    for (int d0 = 0; d0 < 8; ++d0) S.qr[d0] = load8(cur.Q + (size_t)(wid * QBLK + r32) * D + d0 * 16 + hi * 8);
    SLOAD_H(cur.K, cur.V, 0); VMW(); SWRITE_HK(0);
    __syncthreads();
}
__device__ __forceinline__ unsigned moba_select(const Seam& S, const float* KM, int qb, int hi) {
    if (qb <= 3) return (1u << qb) - 1u;
    float sc_[8];
#pragma unroll
    for (int j = 0; j < 8; ++j) sc_[j] = 0.f;
#pragma unroll
    for (int j = 0; j < 7; ++j) {
        if (j < qb) {
            float s = 0.f;
#pragma unroll
            for (int d0 = 0; d0 < 8; ++d0) {
                const f32x4 k0 = *(const f32x4*)(KM + j * D + d0 * 16 + hi * 8), k1 = *(const f32x4*)(KM + j * D + d0 * 16 + hi * 8 + 4);
                const bf16x8 q = S.qr[d0];
                s += bf1((bf16_t)q[0]) * k0[0] + bf1((bf16_t)q[1]) * k0[1] + bf1((bf16_t)q[2]) * k0[2] + bf1((bf16_t)q[3]) * k0[3]
                   + bf1((bf16_t)q[4]) * k1[0] + bf1((bf16_t)q[5]) * k1[1] + bf1((bf16_t)q[6]) * k1[2] + bf1((bf16_t)q[7]) * k1[3];
            }
            s += __shfl_xor(s, 32);
            sc_[j] = s;
        }
    }
    unsigned sel = 0u;
#pragma unroll
    for (int it = 0; it < 3; ++it) {
        float best = -__builtin_inff(); int bi = 0;
#pragma unroll
        for (int j = 0; j < 7; ++j) { const bool ok = (j < qb) && !((sel >> j) & 1u) && (sc_[j] > best); best = ok ? sc_[j] : best; bi = ok ? j : bi; }
        sel |= 1u << bi;
    }
    return sel;
}
__device__ __forceinline__ void moba_block(const BlockRef& cur, const BlockRef& nxt, char* lds, Seam& S, int wv) {
    const int tid = opq_tid(wv), wid = __builtin_amdgcn_readfirstlane(tid >> 6), lane = tid & 63, r32 = lane & 31, hi = lane >> 5;
    const int NT = cur.P0 / KVBLK + 4;
    const int qb = cur.P0 >> 8;
    const int qlo = cur.P0 + wid * QBLK, qm = qlo + r32 - 4 * hi;
    char* V_lds = lds; char* K_lds = lds + 2 * SHM_V;
    float* ws = (float*)(lds + 2 * SHM_V + 2 * SHM_K) + wid * 64; float* li_l = ws, * al_l = ws + 32;
    float m_reg = -1e30f, l_reg = 0; f32x16 o[4] = {};
    const int sr = tid >> 4, sc = (tid & 15) * 8, vst0 = v_st(sr, sc), vst1 = v_st(32 + sr, sc), kws = KSWZ(sr, sc * 2);
    const int vb0 = (int)(uintptr_t)V_lds + v_rd_base(lane);
    const bf16_t* Kh = cur.K; const bf16_t* Vh = cur.V;
    const bool need_sel = qb > 3;
    const float* kml = (const float*)(lds + 69632);
    if (need_sel) { if (tid < 224) ((f32x4*)(lds + 69632))[tid] = ((const f32x4*)cur.KM)[tid]; __syncthreads(); }
    const unsigned sel = moba_select(S, kml, qb, hi);
#define RESC(a) do { if (__any((a) < 1.f)) { if (hi == 0) al_l[r32] = (a); asm volatile("s_waitcnt lgkmcnt(0)" ::: "memory");              \
                     for (int d_ = 0; d_ < 4; ++d_) for (int r = 0; r < 16; ++r) o[d_][r] *= al_l[crow(r, hi)]; } } while (0)
#define KBASE(t) ((t) * KVBLK)
#define MASKT(P0_, P1_, t) do { const int kb_ = KBASE(t); rb_ = 0.f; \
        if (kb_ < cur.P0) { if (need_sel) rb_ = (((sel >> (kb_ >> 8)) & 1u) == 0u) ? -__builtin_inff() : 0.f; } \
        else if (kb_ + KVBLK - 1 > qlo) mask_tile(P0_, P1_, qm - kb_); } while (0)
#define SEAM_K0() do { VMWN(8); SWRITE_HK(0); SBAR(); } while (0)
    f32x16 pA0, pA1, pB0, pB1; float mnA, mnB, alA, alB, rb_ = 0.f; bf16x8 pa0, pa1, pa2, pa3;
    SWRITE_HV(0); SBAR();
    SLOAD_H(Kh, Vh, KBASE(1));
    SBAR(); qkt<0>(pA0, pA1, K_lds, r32, hi, S.qr);
    MASKT(pA0, pA1, 0); partialSM(pA0, pA1, m_reg, mnA, alA, rb_);
    VMW(); SWRITE_H(1);
    __syncthreads();
#define HALF_STEP(PX0, PX1, mnX, alX, PY0, PY1, alY, t, KB, VB, SB) do {                                                      \
        SBAR(); qkt<KB>(PX0, PX1, K_lds, r32, hi, S.qr);                                                                       \
        finishSM(PY0, PY1, alY, l_reg, pa0, pa1, pa2, pa3); SBAR();                                                           \
        if ((t) + 1 < NT) { SLOAD_H(Kh, Vh, KBASE((t) + 1)); SBAR(); }                                                        \
        pv_tile<VB>(o, vb0, pa0, pa1, pa2, pa3); MASKT(PX0, PX1, (t)); partialSM(PX0, PX1, m_reg, mnX, alX, rb_);                  \
        __syncthreads();                                                                                                      \
        if ((t) + 1 < NT) { VMW(); SWRITE_H(SB); }                                                                            \
        RESC(alX); __syncthreads(); } while (0)
    for (int t = 1; t + 1 < NT; t += 2) {
        HALF_STEP(pB0, pB1, mnB, alB, pA0, pA1, alA, t, 1, 0, 0);
        HALF_STEP(pA0, pA1, mnA, alA, pB0, pB1, alB, t + 1, 0, 1, 1);
    }
    SBAR(); qkt<1>(pB0, pB1, K_lds, r32, hi, S.qr); SBAR();
    SLOAD_H(nxt.K, nxt.V, 0); SBAR();
#pragma unroll
    for (int d0 = 0; d0 < 8; ++d0) S.qr[d0] = load8(nxt.Q + (size_t)(wid * QBLK + r32) * D + d0 * 16 + hi * 8);
    SBAR();
    finishSM(pA0, pA1, alA, l_reg, pa0, pa1, pa2, pa3); SBAR();
    pv_tile<0>(o, vb0, pa0, pa1, pa2, pa3);
    MASKT(pB0, pB1, NT - 1); partialSM(pB0, pB1, m_reg, mnB, alB, rb_); __syncthreads(); RESC(alB);
    finishSM(pB0, pB1, alB, l_reg, pa0, pa1, pa2, pa3); SBAR(); pv_tile<1>(o, vb0, pa0, pa1, pa2, pa3);
    SBAR(); SEAM_K0();
    if (hi == 0) li_l[r32] = l_reg; asm volatile("s_waitcnt lgkmcnt(0)" ::: "memory");
    bf16_t* Ow = cur.O + (size_t)(wid * QBLK) * DM; const bf16_t* Gw = cur.Gt + (size_t)(wid * QBLK) * DM + r32;
    bf16_t gl[16][4];
#pragma unroll
    for (int r = 0; r < 16; ++r)
#pragma unroll
        for (int d0 = 0; d0 < 4; ++d0) gl[r][d0] = Gw[(size_t)crow(r, hi) * DM + d0 * 32];
#pragma unroll
    for (int r = 0; r < 16; ++r) { const int orow = crow(r, hi); const float rl = __builtin_amdgcn_rcpf(li_l[orow]);
#pragma unroll
        for (int d0 = 0; d0 < 4; ++d0) { const float gv = bf1(gl[r][d0]);
            const float v = o[d0][r] * rl * gv;
            const float vn = __shfl_xor(v, 1);
            if ((r32 & 1) == 0) *(unsigned*)(Ow + (size_t)orow * DM + d0 * 32 + r32) = cvt_pk_bf16(v, vn); } }
    __syncthreads();
#undef RESC
#undef KBASE
#undef MASKT
#undef SEAM_K0
#undef HALF_STEP
}
#undef ROW
#undef VMW
#undef VMWN
#undef SLOAD_H
#undef SWRITE_HK
#undef SWRITE_HV
#undef SWRITE_H

__device__ __forceinline__ BlockRef mk_ref(int L, int pass, const bf16_t* Q, const bf16_t* K, const bf16_t* V, bf16_t* O, const bf16_t* Gt, const float* KM) {
    const int bh = L >> 2, x = L & 3, qb = pass ? 7 - x : x, b = bh >> 3, h = bh & 7;
    BlockRef r;
    r.Q = Q + ((size_t)bh * SEQ + (size_t)qb * QB) * D; r.K = K + (size_t)bh * SEQ * D; r.V = V + (size_t)bh * SEQ * D;
    r.O = O + ((size_t)b * SEQ + (size_t)qb * QB) * DM + h * DH; r.Gt = Gt + ((size_t)b * SEQ + (size_t)qb * QB) * DM + h * DH;
    r.KM = KM + (size_t)bh * 8 * D; r.P0 = qb * QB;
    return r;
}
__device__ __forceinline__ void attn_phase(char* lds, const bf16_t* Q, const bf16_t* K, const bf16_t* V, bf16_t* O, const bf16_t* Gt, const float* KM, int wv) {
    const int total = NB * NH * 4, stride = gridDim.x;
    int L = opq_bid(); if (L >= total) return;
    if (stride == 256) { const int xcd = L & 7, j = L >> 3; L = ((xcd * 8 + (j >> 2)) << 2) | (j & 3); }
    int pass = 0;
    BlockRef cur = mk_ref(L, 0, Q, K, V, O, Gt, KM);
    Seam S;
    moba_prime(cur, lds, S, wv);
    for (;;) {
        const bool more_pass = pass == 0, more_item = L + stride < total, last = !more_pass && !more_item;
        int passn = pass + 1, Ln = L;
        if (!more_pass) { passn = 0; Ln = more_item ? L + stride : L; }
        const BlockRef nxt = last ? cur : mk_ref(Ln, passn, Q, K, V, O, Gt, KM);
        moba_block(cur, nxt, lds, S, wv);
        if (last) break;
        cur = nxt; pass = passn; L = Ln;
    }
}
}

#ifndef REP_MASK
#define REP_MASK 0
#endif
#ifndef BAR_REP
#define BAR_REP 1
#endif
struct Args { const float* in[21]; float* out; unsigned char* ws; int ph_lo, ph_hi; };
typedef const __attribute__((address_space(4))) Args* ArgsP;
#define AIN(i) ((const float*)ap->in[i])

__device__ __forceinline__ void transpose_item(const float* W, int ldw, bf16_t* WT, int ldt, LAS float* scr, int lane) {
    float tv[32];
#pragma unroll
    for (int i = 0; i < 32; ++i) { const int kk = 2 * i + (lane >> 5); tv[i] = __builtin_nontemporal_load(W + (size_t)kk * ldw + (lane & 31)); }
#pragma unroll
    for (int i = 0; i < 32; ++i) { const int kk = 2 * i + (lane >> 5); scr[kk * 33 + (lane & 31)] = tv[i]; }
    asm volatile("s_waitcnt lgkmcnt(0)" ::: "memory");
    const int c = lane & 7;
#pragma unroll
    for (int j = 0; j < 4; ++j) { const int n = (lane >> 3) + 8 * j; const LAS float* s = scr + (8 * c) * 33 + n;
        u32x4 o; o.x = cvt_pk_bf16(s[0 * 33], s[1 * 33]); o.y = cvt_pk_bf16(s[2 * 33], s[3 * 33]); o.z = cvt_pk_bf16(s[4 * 33], s[5 * 33]); o.w = cvt_pk_bf16(s[6 * 33], s[7 * 33]);
        *(u32x4*)(WT + (size_t)n * ldt + 8 * c) = o; }
    asm volatile("s_waitcnt lgkmcnt(0)" ::: "memory");
}
__device__ __forceinline__ void transpose_mat(const float* W, int K, int N, bf16_t* WT, int item, LAS float* scr, int lane) {
    const int nblk = N / 32, kb = item / nblk, nb = item % nblk;
    transpose_item(W + (size_t)(64 * kb) * N + 32 * nb, N, WT + (size_t)(32 * nb) * K + 64 * kb, K, scr, lane);
}

template <bool SILU>
__device__ __forceinline__ void gemv_item(const float* vec, int vld, const float* W, int ldw, int n0, int k0, float* out, int old, const float* bias, LAS float* scr, int lane) {
    const float* wp = W + (size_t)k0 * ldw + n0 + lane;
#pragma unroll
    for (int i = 0; i < 8; ++i) { const int idx = i * 64 + lane, b = idx >> 6, kk = idx & 63; const float v = vec[(size_t)b * vld + k0 + kk]; scr[kk * 8 + b] = SILU ? fsilu(v) : v; }
    asm volatile("s_waitcnt lgkmcnt(0)" ::: "memory");
    float acc[8];
#pragma unroll
    for (int b = 0; b < 8; ++b) acc[b] = 0.f;
#pragma unroll 1
    for (int kh = 0; kh < 64; kh += 32) {
        float w[32];
#pragma unroll
        for (int kk = 0; kk < 32; ++kk) w[kk] = SILU ? __builtin_nontemporal_load(wp + (size_t)(kh + kk) * ldw) : wp[(size_t)(kh + kk) * ldw];
#pragma unroll
        for (int kk = 0; kk < 32; ++kk) {
            const f32x4 c0 = *(const LAS f32x4*)(scr + (kh + kk) * 8), c1 = *(const LAS f32x4*)(scr + (kh + kk) * 8 + 4);
            acc[0] += w[kk] * c0[0]; acc[1] += w[kk] * c0[1]; acc[2] += w[kk] * c0[2]; acc[3] += w[kk] * c0[3];
            acc[4] += w[kk] * c1[0]; acc[5] += w[kk] * c1[1]; acc[6] += w[kk] * c1[2]; acc[7] += w[kk] * c1[3];
            if ((kk & 3) == 3) __builtin_amdgcn_sched_barrier(0); }
    }
    const float bv = bias ? bias[n0 + lane] : 0.f;
#pragma unroll
    for (int b = 0; b < 8; ++b) atomicAdd(out + (size_t)b * old + n0 + lane, acc[b] + bv);
    asm volatile("s_waitcnt lgkmcnt(0)" ::: "memory");
}
__device__ __forceinline__ void prep0_phase(ArgsP ap, LAS unsigned char* lds, int wave, int lane) {
    unsigned char* ws = (unsigned char*)ap->ws;
    LAS float* scr = (LAS float*)(lds + wave * 16384);
    const int gw = opq_bid() * NWAVES + wave, NGW = gridDim.x * NWAVES;
    for (int r = gw; r < (MODV_LD / 64) * 16; r += NGW) {
        const int cgp = r >> 4, kc = r & 15;
        const float* W; int ldw, n0; const float* bias;
        if (cgp < 192) { const int l = cgp / 48; n0 = (cgp % 48) * 64; W = AIN(2) + (size_t)l * DM * 3 * DM; ldw = 3 * DM; bias = AIN(3) + l * 3 * DM; }
        else { n0 = (cgp - 192) * 64; W = AIN(15); ldw = 2 * DM; bias = AIN(16); }
        gemv_item<true>(AIN(1), DM, W, ldw, n0, kc * 64, (float*)(ws + WS_MODV) + (cgp * 64 - n0), MODV_LD, kc == 0 ? bias : nullptr, scr, lane);
    }
}
__device__ __forceinline__ void prep1_phase(ArgsP ap, LAS unsigned char* lds, int wave, int lane) {
    unsigned char* ws = (unsigned char*)ap->ws;
    LAS float* scr = (LAS float*)(lds + wave * 16384);
    const int gw = opq_bid() * NWAVES + wave, NGW = gridDim.x * NWAVES;
    constexpr int I_BIG = (DM / 64) * (2 * DM / 32);
    constexpr int I_SQ = (DM / 64) * (DM / 32);
    constexpr int I_G = (256 / 64) * (256 / 32);
    constexpr int N_T = 2 * I_BIG + 2 * I_SQ + 2 * I_BIG + I_BIG + 2 * I_SQ + 16 * I_G;
    constexpr int N_GEMV = 4 * 32 * 16;
    for (int it = gw; it < N_T + N_GEMV; it += NGW) {
        int r = it;
        if (r < N_GEMV) {
            const int slot = r >> 9, q = r & 511, cgp = q >> 4, kc = q & 15;
            const size_t woff = slot == 0 ? (size_t)DM * 2 * DM : slot == 3 ? (size_t)DM * 2 * DM : 0;
            const float* W = (slot == 0 ? AIN(5) : slot == 2 ? AIN(17) : AIN(18)) + woff;
            const int shcol = slot == 0 ? 1 * 3 * DM : slot == 1 ? 2 * 3 * DM : slot == 2 ? 4 * 3 * DM : 3 * 3 * DM;
            gemv_item<false>((const float*)(ws + WS_MODV) + shcol, MODV_LD, W, 2 * DM, cgp * 64, kc * 64, (float*)(ws + WS_SHW) + (size_t)slot * 8 * 2 * DM, 2 * DM, nullptr, scr, lane);
            continue;
        } r -= N_GEMV;
        const float* W; bf16_t* WT; int ldw, ldt;
        if (r < 6 * I_BIG + 0 * I_SQ && r < 2 * I_BIG) { const int l = r / I_BIG, item = r % I_BIG, kb = item / 64, nb = item % 64;
            W = AIN(5) + (size_t)l * DM * 2 * DM + (size_t)(64 * kb) * 2 * DM + 32 * nb; ldw = 2 * DM; WT = (bf16_t*)(ws + WS_WIN) + (size_t)l * 2 * DM * DM + (size_t)(32 * nb) * DM + 64 * kb; ldt = DM; }
        else if ((r -= 2 * I_BIG) < 2 * I_SQ) { const int l = r / I_SQ, item = r % I_SQ, kb = item / 32, nb = item % 32;
            W = AIN(13) + (size_t)l * DM * DM + (size_t)(64 * kb) * DM + 32 * nb; ldw = DM; WT = (bf16_t*)(ws + WS_WOUT) + (size_t)l * DM * DM + (size_t)(32 * nb) * DM + 64 * kb; ldt = DM; }
        else if ((r -= 2 * I_SQ) < 2 * I_BIG) { const int l = r / I_BIG, item = r % I_BIG, kb = item / 64, nb = item % 64;
            W = AIN(18) + (size_t)l * DM * 2 * DM + (size_t)(64 * kb) * 2 * DM + 32 * nb; ldw = 2 * DM; WT = (bf16_t*)(ws + (l ? WS_ATTIN1 : WS_ATTIN0)) + (size_t)(32 * nb) * DM + 64 * kb; ldt = DM; }
        else if ((r -= 2 * I_BIG) < I_BIG) { const int kb = r / 64, nb = r % 64;
            W = AIN(17) + (size_t)(64 * kb) * 2 * DM + 32 * nb; ldw = 2 * DM; WT = (bf16_t*)(ws + WS_WKV) + (size_t)(32 * nb) * DM + 64 * kb; ldt = DM; }
        else if ((r -= I_BIG) < 2 * I_SQ) { const int l = r / I_SQ, item = r % I_SQ, kb = item / 32, nb = item % 32;
            W = AIN(19) + (size_t)l * DM * DM + (size_t)(64 * kb) * DM + 32 * nb; ldw = DM; WT = (bf16_t*)(ws + WS_ATTOUT) + (size_t)l * DM * DM + (size_t)(32 * nb) * DM + 64 * kb; ldt = DM; }
        else { r -= 2 * I_SQ;
            const int mat = r / I_G, item = r % I_G, which = mat >> 3, lh = mat & 7;
            const int kb = item / 8, nb = item % 8, n0 = 32 * nb, drow = 256 * (n0 >> 7) + 128 * which + (n0 & 127);
            W = (which ? AIN(10) : AIN(8)) + (size_t)lh * 256 * 256 + (size_t)(64 * kb) * 256 + n0; ldw = 256;
            WT = (bf16_t*)(ws + WS_WG) + (size_t)lh * 512 * 256 + (size_t)drow * 256 + 64 * kb; ldt = 256; }
        transpose_item(W, ldw, WT, ldt, scr, lane);
    }
}

__device__ __forceinline__ void norm_phase(const float* xin, bf16_t* o1, const float* g1, const float* modv, int sh1, int sc1c,
                                            bf16_t* o2, const float* g2, int sh2, int sc2c, int wave, int lane) {
    const int gw = opq_bid() * NWAVES + wave, NGW = gridDim.x * NWAVES;
    for (int rb = gw; rb < MTOK / 8; rb += NGW) {
        const int r0 = rb * 8, b = r0 / SEQ;
        const float* mv = modv + (size_t)b * MODV_LD;
        f32x4 gs1[4], sf1[4], gs2[4], sf2[4];
#pragma unroll
        for (int j = 0; j < 4; ++j) { const int idx = 4 * lane + 256 * j;
            const f32x4 gv = *(const f32x4*)(g1 + idx), sc = *(const f32x4*)(mv + sc1c + idx); gs1[j] = gv * (sc + 1.f); sf1[j] = *(const f32x4*)(mv + sh1 + idx);
            if (o2) { const f32x4 gv2 = *(const f32x4*)(g2 + idx), sc2 = *(const f32x4*)(mv + sc2c + idx); gs2[j] = gv2 * (sc2 + 1.f); sf2[j] = *(const f32x4*)(mv + sh2 + idx); }
            else { gs2[j] = gs1[j]; sf2[j] = sf1[j]; } }
        for (int rr = 0; rr < 8; ++rr) {
            const size_t row = (size_t)(r0 + rr);
            const f32x4* xr = (const f32x4*)(xin + row * DM) + lane;
            f32x4 v[4]; float s = 0.f;
#pragma unroll
            for (int j = 0; j < 4; ++j) { v[j] = xr[64 * j]; s += (v[j].x * v[j].x + v[j].y * v[j].y) + (v[j].z * v[j].z + v[j].w * v[j].w); }
            const float rstd = 1.f / sqrtf(wave_sum(s) * (1.f / DM) + EPS);
#pragma unroll
            for (int j = 0; j < 4; ++j) { const f32x4 t = v[j] * rstd; const f32x4 y = t * gs1[j] + sf1[j];
                u32x2 w; w.x = cvt_pk_bf16(y.x, y.y); w.y = cvt_pk_bf16(y.z, y.w);
                *((u32x2*)(o1 + row * DM) + lane + 64 * j) = w;
                if (o2) { const f32x4 y2 = t * gs2[j] + sf2[j]; u32x2 w2; w2.x = cvt_pk_bf16(y2.x, y2.y); w2.y = cvt_pk_bf16(y2.z, y2.w);
                    *((u32x2*)(o2 + row * DM) + lane + 64 * j) = w2; } }
        }
    }
}
__device__ __forceinline__ void conv_phase(const bf16_t* UP, bf16_t* U, const float* cw, const float* cb, int tid) {
    const int ch = 8 * (tid & 127), sub = tid >> 7;
    float w0[8], w1[8], w2[8], w3[8], bb[8];
#pragma unroll
    for (int h = 0; h < 2; ++h) { const f32x4 a = *(const f32x4*)(cw + ch + 4 * h), b = *(const f32x4*)(cw + DM + ch + 4 * h), c = *(const f32x4*)(cw + 2 * DM + ch + 4 * h), d = *(const f32x4*)(cw + 3 * DM + ch + 4 * h), e = *(const f32x4*)(cb + ch + 4 * h);
#pragma unroll
        for (int j = 0; j < 4; ++j) { w0[4 * h + j] = a[j]; w1[4 * h + j] = b[j]; w2[4 * h + j] = c[j]; w3[4 * h + j] = d[j]; bb[4 * h + j] = e[j]; } }
    for (int it = opq_bid(); it < NB * 32; it += gridDim.x) {
        const int b = it >> 5, c = it & 31, t0 = c * 64 + sub * 16; const size_t base = ((size_t)b * SEQ + t0) * DM + ch;
        u32x4 rw[19];
#pragma unroll
        for (int t = 0; t < 19; ++t) rw[t] = (t0 + t - 3 >= 0) ? *(const u32x4*)(UP + base + (ptrdiff_t)(t - 3) * DM) : (u32x4){0u, 0u, 0u, 0u};
#pragma unroll
        for (int t = 0; t < 16; ++t) {
            unsigned ow[4];
#pragma unroll
            for (int q = 0; q < 4; ++q) { const unsigned a0 = rw[t][q], a1 = rw[t + 1][q], a2 = rw[t + 2][q], a3 = rw[t + 3][q];
                const float lo = bb[2 * q] + w0[2 * q] * bf_lo(a0) + w1[2 * q] * bf_lo(a1) + w2[2 * q] * bf_lo(a2) + w3[2 * q] * bf_lo(a3);
                const float hi = bb[2 * q + 1] + w0[2 * q + 1] * bf_hi(a0) + w1[2 * q + 1] * bf_hi(a1) + w2[2 * q + 1] * bf_hi(a2) + w3[2 * q + 1] * bf_hi(a3);
                ow[q] = cvt_pk_bf16(lo, hi); }
            *(u32x4*)(U + base + (size_t)t * DM) = (u32x4){ow[0], ow[1], ow[2], ow[3]}; }
    }
}

#define XB_TMO      128
#define XB_XCNT(j)  (256  + 64 * (j))
#define XB_XSUB(j)  (1280 + 64 * (j))
#define XB_XGEN(j)  (2304 + 64 * (j))
#define XB_TOP      3328
#define XB_TOPGEN   3392
#define XCD_BAR_WORDS 3456
#define XB_SPIN_CAP (1u << 18)
constexpr size_t WS_BAR = 16384;
constexpr int LDS_MISC = 131072 + 320;
__device__ __forceinline__ unsigned xb_ld(unsigned* p)              { return __hip_atomic_load(p, __ATOMIC_RELAXED, __HIP_MEMORY_SCOPE_AGENT); }
__device__ __forceinline__ unsigned xb_add(unsigned* p, unsigned v) { return __hip_atomic_fetch_add(p, v, __ATOMIC_RELAXED, __HIP_MEMORY_SCOPE_AGENT); }
__device__ __forceinline__ unsigned xb_xcc_id() { return (unsigned)__builtin_amdgcn_s_getreg((3 << 11) | 20) & 0xFu; }
#define XB_SPIN(cond, bar) do { unsigned _sp = 0; while (cond) { __builtin_amdgcn_s_sleep(1); \
    if ((++_sp & 255u) == 0u) { if (xb_ld(&(bar)[XB_TMO])) break; if (_sp > XB_SPIN_CAP) { atomicAdd(&(bar)[XB_TMO], 1u); break; } } } } while (0)
__device__ __forceinline__ void xcd_barrier_complete(unsigned* bar, unsigned x, unsigned& nloc, unsigned& nx) {
    const unsigned G = gridDim.x * gridDim.y * gridDim.z;
    unsigned sum, cnt, mine, sp = 0u;
    for (;;) {
        sum = 0u; cnt = 0u; mine = 0u;
#pragma unroll
        for (unsigned j = 0; j < 16; ++j) { const unsigned c = xb_ld(&bar[XB_XCNT(j)]); sum += c; cnt += (c > 0u) ? 1u : 0u; mine = (j == x) ? c : mine; }
        if (sum == G) break;
        __builtin_amdgcn_s_sleep(1);
        if ((++sp & 255u) == 0u) { if (xb_ld(&bar[XB_TMO])) break; if (sp > XB_SPIN_CAP) { atomicAdd(&bar[XB_TMO], 1u); break; } }
    }
    nloc = mine > 0u ? mine : 1u; nx = cnt > 0u ? cnt : 1u;
}
__device__ __forceinline__ void xcd_barrier(unsigned* bar, volatile LAS unsigned* st, int tid) {
    asm volatile("s_waitcnt vmcnt(0)" ::: "memory");
    __syncthreads();
    if (tid == 0) {
        const unsigned x = xb_xcc_id();
        __builtin_amdgcn_s_waitcnt(0);
        unsigned nloc = st[0], nx = st[1];
        if (nloc == 0u) { xcd_barrier_complete(bar, x, nloc, nx); st[0] = nloc; st[1] = nx; }
        const unsigned old = xb_add(&bar[XB_XSUB(x)], 1u);
        const unsigned gen = old / nloc;
        if (old + 1u == (gen + 1u) * nloc) {
            __builtin_amdgcn_fence(__ATOMIC_RELEASE, "agent");
            asm volatile("s_waitcnt vmcnt(0)" ::: "memory");
            const unsigned og = xb_add(&bar[XB_TOP], 1u);
            const unsigned tg = og / nx;
            if (og + 1u == (tg + 1u) * nx) xb_add(&bar[XB_TOPGEN], 1u);
            else XB_SPIN(xb_ld(&bar[XB_TOPGEN]) == tg, bar);
            __builtin_amdgcn_fence(__ATOMIC_ACQUIRE, "agent");
            xb_add(&bar[XB_XGEN(x)], 1u);
            asm volatile("s_waitcnt vmcnt(0)" ::: "memory");
        } else {
            XB_SPIN(xb_ld(&bar[XB_XGEN(x)]) == gen, bar);
            __builtin_amdgcn_fence(__ATOMIC_ACQUIRE, "agent");
            asm volatile("s_waitcnt vmcnt(0)" ::: "memory");
        }
    }
    __syncthreads();
}

constexpr int NPHASE = 14;
#ifndef PH_EN
#define PH_EN 0xFFFF
#endif
#define EN(b) ((PH_EN >> (b)) & 1)
#ifndef REP_MASK
#define REP_MASK 0
#endif
#define REPS(b) for (int rep_ = 0; rep_ < EN(b) * (1 + ((REP_MASK >> (b)) & 1)); ++rep_)
template <int ph>
__device__ __forceinline__ void run_phase(unsigned char* lds, int wv) {
    LAS unsigned char* ldsl = (LAS unsigned char*)lds;
    {
        ArgsP ap = (ArgsP)__builtin_amdgcn_kernarg_segment_ptr();
        asm volatile("" : "+s"(ap));
        const int G = gridDim.x;
        unsigned char* ws = (unsigned char*)ap->ws;
        float* modv = (float*)(ws + WS_MODV);
        float* kmean = (float*)(ws + WS_KMEAN);
        bf16_t* HN = (bf16_t*)(ws + WS_HN); bf16_t* HKV = (bf16_t*)(ws + WS_HKV); bf16_t* UPRE = (bf16_t*)(ws + WS_UPRE); bf16_t* GB = (bf16_t*)(ws + WS_G);
        bf16_t* LAb = (bf16_t*)(ws + WS_LA); bf16_t* BINb = (bf16_t*)(ws + WS_BIN);
        float* xw = (float*)ap->out;
        const int tid = opq_tid(wv), c = opq_bid();
        const int lane = tid & 63, wave = __builtin_amdgcn_readfirstlane(tid >> 6);
        float* sumsq = (float*)(ws + WS_SUMSQ); const float* shw = (const float*)(ws + WS_SHW);
        if (ph == 0) {
            if (EN(0)) prep0_phase(ap, ldsl, wave, lane);
        } else if (ph == 1) {
            REPS(1) norm_phase(AIN(0), HN, AIN(4), modv, 0, DM, nullptr, nullptr, 0, 0, wave, lane);
            if (EN(0)) prep1_phase(ap, ldsl, wave, lane);
        } else if (ph <= 7) {
            const int l = (ph - 2) / 3, k3 = (ph - 2) % 3, k = k3 == 0 ? 0 : k3 + 1;
            const float* xin = (l == 0) ? AIN(0) : xw;
            if (k == 0) {
                pg8::Gemm g{l == 0 ? HN : HKV, (const bf16_t*)(ws + WS_WIN) + (size_t)l * 2 * DM * DM, DM, DM, DM, 0, 0};
                int one = 1; asm volatile("" : "+s"(one));
                { pg8::InOrder S{c, one, 0};
                  pg8::EpiSplitConv E{ws, l == 0 ? nullptr : sumsq, shw, AIN(6) + l * 4 * DM, AIN(7) + l * DM, 4u * (unsigned)(l + 1), ldsl};
                  REPS(2) pg8::gemm_phase(ldsl, g, S, E, wv); }
                { pg8::InOrder S{c, one, 1};
                  pg8::EpiSplit E{UPRE, GB, l == 0 ? nullptr : sumsq, shw};
                  REPS(2) pg8::gemm_phase(ldsl, g, S, E, wv); }
            } else if (k == 1) {
                REPS(3) conv_phase(UPRE, HKV, AIN(6) + l * 4 * DM, AIN(7) + l * DM, tid);
            } else if (k == 2) {
                pg8::Gemm g{UPRE, (const bf16_t*)(ws + WS_WG) + (size_t)l * 4 * 512 * 256, DM, 256, 256, 256 * 2, 512 * 256 * 2};
                int two = 2; asm volatile("" : "+s"(two));
                pg8::GatesOrder S{c, two};
                pg8::EpiGatesS E{ws, 4u * (unsigned)(l + 1), AIN(9) + l * DM, AIN(11) + l * DM, AIN(12) + l * DM, ldsl};
                REPS(4) pg8::gemm_phase(ldsl, g, S, E, wv);
            } else {
                pg8::Gemm g{HN, (const bf16_t*)(ws + WS_WOUT) + (size_t)l * DM * DM, DM, DM, DM, 0, 0};
                pg8::MultiOrder S; S.init(MTOK, DM, 1, G, c);
                _Float16* x16 = (_Float16*)(ws + WS_X16);
                if (l == 0) { pg8::EpiResH<float, false> E{AIN(0), x16, modv + 2 * DM, modv, HKV, AIN(4) + DM, 3 * DM + DM, nullptr, nullptr, 0, sumsq};
                    REPS(7) pg8::gemm_phase(ldsl, g, S, E, wv); }
                else { pg8::EpiResH<_Float16, true> E{x16, x16, modv + l * 3 * DM + 2 * DM, modv, HKV, AIN(4) + (l + 1) * DM, (l + 1) * 3 * DM + DM,
                              LAb, AIN(14), 4 * 3 * DM + DM, sumsq + (size_t)l * MTOK};
                    REPS(7) pg8::gemm_phase(ldsl, g, S, E, wv); }
            }
        } else if (ph <= 13) {
            const int i = (ph - 8) / 3, k = (ph - 8) % 3, l = 2 + i;
            if (k == 0) {
                pg8::Gemm g{i == 0 ? HKV : LAb, (const bf16_t*)(ws + (i == 0 ? WS_ATTIN0 : WS_ATTIN1)), DM, DM, DM, (long)(WS_LA - WS_HKV), (long)(WS_WKV - WS_ATTIN0)};
                pg8::MultiOrder S; S.init(MTOK, 2 * DM, i == 0 ? 2 : 1, G, c);
                pg8::EpiQKV E{ws, kmean, sumsq + (size_t)(1 + i) * MTOK, shw + (size_t)(i == 0 ? 1 : 3) * 8 * 2 * DM, 8 * 2 * DM};
                REPS(9) pg8::gemm_phase(ldsl, g, S, E, wv);
            } else if (k == 1) {
                REPS(10) att::attn_phase((char*)lds, UPRE, HN, BINb, HKV, GB, kmean, wv);
            } else if (i == 0) {
                pg8::Gemm g{HKV, (const bf16_t*)(ws + WS_ATTOUT), DM, DM, DM, 0, 0};
                pg8::MultiOrder S; S.init(MTOK, DM, 1, G, c);
                _Float16* x16 = (_Float16*)(ws + WS_X16);
                pg8::EpiResH<_Float16, false> E{x16, x16, modv + l * 3 * DM + 2 * DM, modv, LAb, AIN(4) + 3 * DM, 3 * 3 * DM + DM, nullptr, nullptr, 0, sumsq + (size_t)2 * MTOK};
                REPS(11) pg8::gemm_phase(ldsl, g, S, E, wv);
            } else {
                pg8::Gemm g{HKV, (const bf16_t*)(ws + WS_ATTOUT) + (size_t)DM * DM, DM, DM, DM, 0, 0};
                pg8::MultiOrder S; S.init(MTOK, DM, 1, G, c);
                pg8::EpiFinal E{(const _Float16*)(ws + WS_X16), xw, modv + l * 3 * DM + 2 * DM, AIN(20), sumsq + (size_t)3 * MTOK, (unsigned*)(ws + WS_PCNT)};
                REPS(12) pg8::gemm_phase(ldsl, g, S, E, wv);
            }
        }
    }
}
__global__ void __launch_bounds__(NTHR, 2) yoco_fwd(Args a_) {
    extern __shared__ __attribute__((aligned(16))) unsigned char lds[];
    const int ph_lo = a_.ph_lo, ph_hi = a_.ph_hi;
    const int wv = __builtin_amdgcn_readfirstlane((int)threadIdx.x >> 6);
    if (ph_hi - ph_lo > 1) {
        if (threadIdx.x < 8) ((volatile LAS unsigned*)((LAS unsigned char*)lds + LDS_MISC))[threadIdx.x] = 0u;
        if (threadIdx.x == 0) (void)xb_add(&((unsigned*)(a_.ws + WS_BAR))[XB_XCNT(xb_xcc_id())], 1u);
        __syncthreads();
    }
#define SEAM(P) do { ArgsP ap_ = (ArgsP)__builtin_amdgcn_kernarg_segment_ptr(); asm volatile("" : "+s"(ap_)); \
        xcd_barrier((unsigned*)((unsigned char*)ap_->ws + WS_BAR), (volatile LAS unsigned*)((LAS unsigned char*)lds + LDS_MISC), opq_tid(wv)); } while (0)
#ifndef TPROBE_MASK
#define TPROBE_MASK 0
#endif
#define TPROBE_MULT 10
#define TP_ON(P) ((TPROBE_MASK >> (P)) & 1)
#define TP_BEGIN(P) if (TP_ON(P) && blockIdx.x == 0 && opq_tid(wv) == 0) { volatile LAS unsigned long long* tw_ = (volatile LAS unsigned long long*)((LAS unsigned char*)lds + LDS_MISC + 16); tw_[1] = __builtin_amdgcn_s_memrealtime(); }
#define TP_END(P) if (TP_ON(P) && blockIdx.x == 0 && opq_tid(wv) == 0) { volatile LAS unsigned long long* tw_ = (volatile LAS unsigned long long*)((LAS unsigned char*)lds + LDS_MISC + 16); tw_[0] = tw_[0] + (__builtin_amdgcn_s_memrealtime() - tw_[1]); }
#define RUN(P) if ((P) >= ph_lo && (P) < ph_hi) { TP_BEGIN(P) run_phase<P>(lds, wv); if ((P) + 1 < ph_hi) { for (int br_ = 0; br_ < BAR_REP; ++br_) SEAM(P); } TP_END(P) }
    RUN(0) RUN(1) RUN(2) RUN(3) RUN(4) RUN(5) RUN(6) RUN(7) RUN(8) RUN(9) RUN(10) RUN(11)
    RUN(12) RUN(13)
#undef RUN
#undef SEAM
    if (TPROBE_MASK != 0 && blockIdx.x == 0 && opq_tid(wv) == 0) {
        volatile LAS unsigned long long* tw_ = (volatile LAS unsigned long long*)((LAS unsigned char*)lds + LDS_MISC + 16);
        const unsigned long long span = tw_[0] * TPROBE_MULT, t0 = __builtin_amdgcn_s_memrealtime();
        while (__builtin_amdgcn_s_memrealtime() - t0 < span) __builtin_amdgcn_s_sleep(8);
    }
}

extern "C" void kernel_launch(void* const* d_in, const int* in_sizes, int n_in, void* d_out, int out_size, void* d_ws, size_t ws_size, hipStream_t stream) {
    static int grid = 0;
    if (grid == 0) {
        if (n_in != 21 || out_size != MTOK * DM || ws_size < WS_END) { fprintf(stderr, "kernel_launch: unexpected shapes (n_in %d out %d ws %zu)\n", n_in, out_size, ws_size); grid = -1; return; }
        int dev = 0, cus = 0, per_cu = 0;
        (void)hipGetDevice(&dev);
        if (hipDeviceGetAttribute(&cus, hipDeviceAttributeMultiprocessorCount, dev) != hipSuccess || cus <= 0) cus = 256;
        if (hipFuncSetAttribute((const void*)yoco_fwd, hipFuncAttributeMaxDynamicSharedMemorySize, LDS_BYTES) != hipSuccess) { fprintf(stderr, "kernel_launch: hipFuncSetAttribute failed\n"); grid = -1; return; }
        if (hipOccupancyMaxActiveBlocksPerMultiprocessor(&per_cu, (const void*)yoco_fwd, NTHR, LDS_BYTES) != hipSuccess || per_cu < 1) { fprintf(stderr, "kernel_launch: occupancy query says %d\n", per_cu); per_cu = 1; }
        (void)hipGetLastError();
        grid = cus > 256 ? 256 : cus;
    }
    if (grid < 0) return;
    (void)hipMemsetAsync((char*)d_ws + WS_CTL, 0, CTL_ZERO_BYTES, stream);
    Args a{};
    for (int i = 0; i < 21; ++i) a.in[i] = (const float*)d_in[i];
    a.out = (float*)d_out; a.ws = (unsigned char*)d_ws;
#if MK_MULTI_LAUNCH
    for (int ph = 0; ph < NPHASE; ++ph) { a.ph_lo = ph; a.ph_hi = ph + 1; hipLaunchKernelGGL(yoco_fwd, dim3(grid), dim3(NTHR), LDS_BYTES, stream, a); }
#else
    a.ph_lo = 0; a.ph_hi = NPHASE;
    void* kargs[] = {&a};
    hipError_t e = hipLaunchCooperativeKernel((const void*)yoco_fwd, dim3(grid), dim3(NTHR), kargs, LDS_BYTES, stream);
    if (e != hipSuccess) fprintf(stderr, "kernel_launch: cooperative launch failed: %s (grid %d)\n", hipGetErrorString(e), grid);
#endif
}
```

```cpp
#include <hip/hip_runtime.h>
#include <hip/hip_cooperative_groups.h>
#include <cstdio>
#include <cstdint>
namespace cg = cooperative_groups;

#ifndef MK_MULTI_LAUNCH
#define MK_MULTI_LAUNCH 0
#endif

constexpr int DM = 1024, NB = 8, SEQ = 2048, MTOK = NB * SEQ, NH = 8, DH = 128;
constexpr int MODV_LD = 14336;
constexpr float EPS = 1e-6f;
constexpr int NWAVES = 8, NTHR = 512;
constexpr int LDS_BYTES = 147456;

constexpr size_t MiB = 1u << 20;
constexpr size_t WS_CTL = 0, CTL_ZERO_BYTES = 1 * MiB + 256 * 1024;
constexpr size_t WS_MODV = 64 * 1024;
constexpr size_t WS_KMEAN = 512 * 1024;
constexpr size_t WS_GFLAG = 32 * 1024;
constexpr size_t WS_SHW = 768 * 1024;
constexpr size_t WS_PCNT = 48 * 1024;
constexpr size_t WS_CFLAG = 50 * 1024;
constexpr size_t WS_SUMSQ = 1 * MiB;
constexpr size_t WS_TA = 1 * MiB + 256 * 1024;
constexpr size_t WS_WIN = 2 * MiB;
constexpr size_t WS_WG = 10 * MiB;
constexpr size_t WS_WOUT = 12 * MiB;
constexpr size_t WS_ATTIN0 = 16 * MiB, WS_WKV = 20 * MiB, WS_ATTIN1 = 24 * MiB;
constexpr size_t WS_ATTOUT = 28 * MiB;
constexpr size_t WS_HN = 32 * MiB;
constexpr size_t WS_HKV = 64 * MiB;
constexpr size_t WS_UPRE = 96 * MiB;
constexpr size_t WS_G = 128 * MiB;
constexpr size_t WS_LA = 160 * MiB;
constexpr size_t WS_BIN = 192 * MiB;
constexpr size_t WS_X16 = 224 * MiB;
constexpr size_t WS_END = 256 * MiB;

typedef unsigned short bf16_t;
typedef short bf16x8 __attribute__((ext_vector_type(8)));
typedef short s16x4 __attribute__((ext_vector_type(4)));
typedef float f32x4 __attribute__((ext_vector_type(4)));
typedef float f32x2 __attribute__((ext_vector_type(2)));
typedef float f32x16 __attribute__((ext_vector_type(16)));
typedef unsigned u32x4 __attribute__((ext_vector_type(4)));
typedef unsigned u32x2 __attribute__((ext_vector_type(2)));
#define LAS __attribute__((address_space(3)))

__device__ __forceinline__ unsigned cvt_pk_bf16(float lo, float hi) { unsigned r; asm volatile("v_cvt_pk_bf16_f32 %0, %1, %2" : "=v"(r) : "v"(lo), "v"(hi)); return r; }
__device__ __forceinline__ float bf_lo(unsigned w) { return __uint_as_float(w << 16); }
__device__ __forceinline__ float bf_hi(unsigned w) { return __uint_as_float(w & 0xffff0000u); }
__device__ __forceinline__ float bf1(bf16_t h) { return __uint_as_float((unsigned)h << 16); }
__device__ __forceinline__ float fexp(float x) { return __builtin_amdgcn_exp2f(x * 1.4426950408889634f); }
__device__ __forceinline__ float flog(float x) { return __builtin_amdgcn_logf(x) * 0.6931471805599453f; }
__device__ __forceinline__ float fsigmoid(float x) { return __builtin_amdgcn_rcpf(1.f + fexp(-x)); }
__device__ __forceinline__ float fsilu(float x) { return x * fsigmoid(x); }
__device__ __forceinline__ int opq_tid(int wv) { int l; asm volatile("v_mbcnt_lo_u32_b32 %0, -1, 0\n\tv_mbcnt_hi_u32_b32 %0, -1, %0" : "=v"(l)); return wv * 64 + l; }
__device__ __forceinline__ int opq_bid() { int b = blockIdx.x; asm volatile("" : "+s"(b)); return b; }
__device__ __forceinline__ float wave_sum(float v) {
#pragma unroll
    for (int o = 1; o < 64; o <<= 1) v += __shfl_xor(v, o);
    return v;
}

namespace pg8 {
constexpr int BM = 256, BK = 64, HALF = 128, HTB = HALF * BK * 2, STAGE_BYTES = 8 * HTB, NXCD = 8, WGM = 8;
__host__ __device__ __forceinline__ int lds_byte(int r, int c) { const int st = (r >> 4) * 2 + (c >> 5), rr = r & 15, cc = c & 31, ob = rr * 64 + cc * 2; return st * 1024 + (ob ^ (((ob >> 9) & 1) << 5)); }
__host__ __device__ __forceinline__ void stage_rc(int b, int& R, int& C) { const int st = b / 1024, sb = b % 1024, swz = sb ^ (((sb >> 9) & 1) << 5); R = (st >> 1) * 16 + swz / 64; C = (st & 1) * 32 + (swz % 64) / 2; }
__host__ __device__ __forceinline__ int perm32(int rho) { const int n = rho >> 4, i = rho & 15; return 8 * (i >> 2) + 4 * n + (i & 3); }

struct Unit { int pm, pn, sub; };
struct Gemm { const bf16_t* A; const bf16_t* Bt; int lda, ldb, K; long a_sub, b_sub; };

struct MultiOrder {
    int nM, nN, nwg, nsub, G, c;
    __device__ void init(int M, int N, int nsub_, int G_, int c_) { nM = M / BM; nN = N / BM; nwg = nM * nN; nsub = nsub_; G = G_; c = c_; }
    __device__ bool next(int i, Unit& u) const {
        const long L = (long)i * G + c; if (L >= (long)nwg * nsub) return false;
        u.sub = (int)(L / nwg);
        int wgid = (int)(L % nwg); { const int q = nwg / NXCD, r = nwg % NXCD, xcd = wgid % NXCD, off = wgid / NXCD; wgid = (xcd < r ? xcd * (q + 1) : r * (q + 1) + (xcd - r) * q) + off; }
        const int nig = WGM * nN, gid = wgid / nig, fm = gid * WGM, gsz = (nM - fm) < WGM ? (nM - fm) : WGM;
        u.pm = fm + ((wgid % nig) % gsz); u.pn = (wgid % nig) / gsz; return true;
    }
};


template <int N> __device__ __forceinline__ float dpp_shr(float src, float ident) {
    return __int_as_float(__builtin_amdgcn_update_dpp(__float_as_int(ident), __float_as_int(src), 0x110 + N, 0xF, 0xF, false));
}
struct EpiSplit {
    static constexpr bool PERM = true, APERM = false;
    bf16_t* O0; bf16_t* O1; const float* sumsq; const float* shw;
    __device__ __forceinline__ void operator()(const f32x4 (&acc)[2][2][4][2], const Unit& u, int wr, int wc, int fr, int fq) const {
        const int row0 = u.pm * BM + wr * 64 + fr; int colt = u.pn * BM; bf16_t* base = O0;
        const int cfull = u.pn * BM + wc * 32 + 8 * fq;
        const bool gate_half = colt >= DM;
        if (gate_half) { base = O1; colt -= DM; }
        const int col0 = colt + wc * 32 + 8 * fq;
        f32x4 bv[2][2];
#pragma unroll
        for (int bj = 0; bj < 2; ++bj)
#pragma unroll
            for (int n = 0; n < 2; ++n) bv[bj][n] = sumsq ? *(const f32x4*)(shw + (size_t)(u.pm >> 3) * 2 * DM + cfull + bj * HALF + 4 * n) : (f32x4){0.f, 0.f, 0.f, 0.f};
        float ssq[2][4];
#pragma unroll
        for (int ai = 0; ai < 2; ++ai)
#pragma unroll
            for (int m = 0; m < 4; ++m) ssq[ai][m] = sumsq ? sumsq[row0 + ai * HALF + m * 16] : 0.f;
#pragma unroll
        for (int ai = 0; ai < 2; ++ai)
#pragma unroll
            for (int m = 0; m < 4; ++m) { const int row = row0 + ai * HALF + m * 16; bf16_t* rowp = base + (size_t)row * DM + col0;
                const float rs = sumsq ? __builtin_amdgcn_rsqf(ssq[ai][m] * (1.f / DM) + EPS) : 1.f;
#pragma unroll
                for (int bj = 0; bj < 2; ++bj) { f32x4 v0 = acc[ai][bj][m][0] * rs + bv[bj][0], v1 = acc[ai][bj][m][1] * rs + bv[bj][1];
                    if (gate_half) {
#pragma unroll
                        for (int j = 0; j < 4; ++j) { v0[j] = fsilu(v0[j]); v1[j] = fsilu(v1[j]); } }
                    u32x4 w; w.x = cvt_pk_bf16(v0[0], v0[1]); w.y = cvt_pk_bf16(v0[2], v0[3]); w.z = cvt_pk_bf16(v1[0], v1[1]); w.w = cvt_pk_bf16(v1[2], v1[3]);
                    *(u32x4*)(rowp + bj * HALF) = w; } }
    }
};

typedef _Float16 h16x8 __attribute__((ext_vector_type(8)));
__device__ __forceinline__ void ld8(const float* p, float (&v)[8]) { const f32x4 a = *(const f32x4*)p, b = *(const f32x4*)(p + 4); v[0] = a[0]; v[1] = a[1]; v[2] = a[2]; v[3] = a[3]; v[4] = b[0]; v[5] = b[1]; v[6] = b[2]; v[7] = b[3]; }
struct InOrder {
    int c, n, base;
    __device__ bool next(int i, Unit& u) const { if (i >= n) return false; const int j = c >> 3; int pm = (c & 7) * 8 + (j >> 2), pn = 4 * (i + base) + (j & 3), sub = 0;
        asm volatile("" : "+s"(pm), "+s"(pn), "+s"(sub)); u.pm = pm; u.pn = pn; u.sub = sub; return true; }
};
constexpr int CV_HL_OFF = 133120;
struct EpiSplitConv {
    static constexpr bool PERM = true, APERM = true;
    unsigned char* ws; const float* sumsq; const float* shw; const float* cw; const float* cb; unsigned target; LAS unsigned char* lds;
    __device__ __forceinline__ void operator()(f32x4 (&acc)[2][2][4][2], const Unit& u, int wr, int wc, int fr, int fq) const {
        const int pnl = u.pn & 3;
        const int cfull = u.pn * BM + wc * 32 + 8 * fq, ct = wc * 32 + 8 * fq, col0 = pnl * BM + ct;
        bf16_t* obase = (bf16_t*)(ws + WS_UPRE);
        f32x4 bv[2][2];
#pragma unroll
        for (int bj = 0; bj < 2; ++bj)
#pragma unroll
            for (int n = 0; n < 2; ++n) bv[bj][n] = sumsq ? *(const f32x4*)(shw + (size_t)(u.pm >> 3) * 2 * DM + cfull + bj * HALF + 4 * n) : (f32x4){0.f, 0.f, 0.f, 0.f};
        float ssq[2][4];
#pragma unroll
        for (int ai = 0; ai < 2; ++ai)
#pragma unroll
            for (int m = 0; m < 4; ++m) ssq[ai][m] = sumsq ? sumsq[u.pm * BM + ai * HALF + wr * 64 + 4 * fr + m] : 0.f;
#pragma unroll
        for (int ai = 0; ai < 2; ++ai)
#pragma unroll
            for (int m = 0; m < 4; ++m) { const float rs = sumsq ? __builtin_amdgcn_rsqf(ssq[ai][m] * (1.f / DM) + EPS) : 1.f;
#pragma unroll
                for (int bj = 0; bj < 2; ++bj) { acc[ai][bj][m][0] = acc[ai][bj][m][0] * rs + bv[bj][0]; acc[ai][bj][m][1] = acc[ai][bj][m][1] * rs + bv[bj][1]; } }
        const int tile = u.pm * 4 + pnl;
        unsigned long long* HX = (unsigned long long*)(ws + WS_BIN);
        unsigned* flags = (unsigned*)(ws + WS_CFLAG);
        LAS f32x4* HL = (LAS f32x4*)(lds + CV_HL_OFF);
#pragma unroll
        for (int ai = 0; ai < 2; ++ai)
#pragma unroll
            for (int k = 0; k < 3; ++k)
#pragma unroll
                for (int bj = 0; bj < 2; ++bj) {
                    if (fr == 15) { LAS f32x4* d = HL + (((ai * 2 + wr) * 3 + k) * 256 + bj * HALF + ct) / 4;
                        d[0] = acc[ai][bj][k + 1][0]; d[1] = acc[ai][bj][k + 1][1];
                        if (ai == 1 && wr == 1) { unsigned long long* g_ = HX + ((size_t)(tile * 3 + k) * 256 + bj * HALF + ct) / 2;
#pragma unroll
                            for (int n = 0; n < 2; ++n) { const f32x4 v = acc[1][bj][k + 1][n];
                                __hip_atomic_store(g_ + 2 * n, ((unsigned long long)__float_as_uint(v[1]) << 32) | __float_as_uint(v[0]), __ATOMIC_RELAXED, __HIP_MEMORY_SCOPE_AGENT);
                                __hip_atomic_store(g_ + 2 * n + 1, ((unsigned long long)__float_as_uint(v[3]) << 32) | __float_as_uint(v[2]), __ATOMIC_RELAXED, __HIP_MEMORY_SCOPE_AGENT); } } }
                    asm volatile("" ::: "memory"); __builtin_amdgcn_sched_barrier(0);
                }
        if (wr == 1) { asm volatile("s_waitcnt vmcnt(0)" ::: "memory");
            if (fr == 15 && fq == 0) __hip_atomic_fetch_add(flags + tile * 8, 1u, __ATOMIC_RELAXED, __HIP_MEMORY_SCOPE_AGENT); }
        asm volatile("s_waitcnt lgkmcnt(0)" ::: "memory"); __builtin_amdgcn_s_barrier(); asm volatile("" ::: "memory");
        const bool need_prev = (wr == 0) && ((u.pm & 7) != 0);
        if (need_prev) { unsigned spins = 0;
            while (__hip_atomic_load(flags + (tile - 4) * 8, __ATOMIC_RELAXED, __HIP_MEMORY_SCOPE_AGENT) < target) { __builtin_amdgcn_s_sleep(2); if (++spins > (1u << 22)) break; } }
#pragma unroll
        for (int ai = 0; ai < 2; ++ai)
#pragma unroll
            for (int bj = 0; bj < 2; ++bj)
#pragma unroll
                for (int n = 0; n < 2; ++n) {
                    f32x4 pr[3];
                    if (ai == 0 && wr == 0) {
#pragma unroll
                        for (int k = 0; k < 3; ++k) { unsigned long long wa = 0ull, wb = 0ull;
                            if (need_prev) { const unsigned long long* sp = HX + ((size_t)((tile - 4) * 3 + k) * 256 + bj * HALF + ct + 4 * n) / 2;
                                wa = __hip_atomic_load(sp, __ATOMIC_RELAXED, __HIP_MEMORY_SCOPE_AGENT); wb = __hip_atomic_load(sp + 1, __ATOMIC_RELAXED, __HIP_MEMORY_SCOPE_AGENT); }
                            pr[k] = (f32x4){__uint_as_float((unsigned)wa), __uint_as_float((unsigned)(wa >> 32)), __uint_as_float((unsigned)wb), __uint_as_float((unsigned)(wb >> 32))}; }
                    } else { const int prun = ai * 2 + wr - 1;
#pragma unroll
                        for (int k = 0; k < 3; ++k) pr[k] = HL[((prun * 3 + k) * 256 + bj * HALF + ct + 4 * n) / 4]; }
                    const int chg = pnl * BM + bj * HALF + ct + 4 * n;
                    const f32x4 w0 = *(const f32x4*)(cw + chg), w1 = *(const f32x4*)(cw + DM + chg), w2 = *(const f32x4*)(cw + 2 * DM + chg), w3 = *(const f32x4*)(cw + 3 * DM + chg), bb = *(const f32x4*)(cb + chg);
                    const f32x4 x0 = acc[ai][bj][0][n], x1 = acc[ai][bj][1][n], x2 = acc[ai][bj][2][n], x3 = acc[ai][bj][3][n];
                    f32x4 q1, q2, q3;
#pragma unroll
                    for (int j = 0; j < 4; ++j) { q1[j] = dpp_shr<1>(x3[j], pr[2][j]); q2[j] = dpp_shr<1>(x2[j], pr[1][j]); q3[j] = dpp_shr<1>(x1[j], pr[0][j]); }
                    const f32x4 y0 = bb + w0 * q3 + w1 * q2 + w2 * q1 + w3 * x0, y1 = bb + w0 * q2 + w1 * q1 + w2 * x0 + w3 * x1;
                    const f32x4 y2 = bb + w0 * q1 + w1 * x0 + w2 * x1 + w3 * x2, y3 = bb + w0 * x0 + w1 * x1 + w2 * x2 + w3 * x3;
                    bf16_t* op = obase + (size_t)(u.pm * BM + ai * HALF + wr * 64 + 4 * fr) * DM + col0 + bj * HALF + 4 * n;
                    { u32x2 w; w.x = cvt_pk_bf16(y0[0], y0[1]); w.y = cvt_pk_bf16(y0[2], y0[3]); *(u32x2*)(op) = w; }
                    { u32x2 w; w.x = cvt_pk_bf16(y1[0], y1[1]); w.y = cvt_pk_bf16(y1[2], y1[3]); *(u32x2*)(op + DM) = w; }
                    { u32x2 w; w.x = cvt_pk_bf16(y2[0], y2[1]); w.y = cvt_pk_bf16(y2[2], y2[3]); *(u32x2*)(op + 2 * DM) = w; }
                    { u32x2 w; w.x = cvt_pk_bf16(y3[0], y3[1]); w.y = cvt_pk_bf16(y3[2], y3[3]); *(u32x2*)(op + 3 * DM) = w; }
                    asm volatile("" ::: "memory"); __builtin_amdgcn_sched_barrier(0);
                }
    }
};

template <class TIn, bool HAS_A2>
struct EpiResH {
    static constexpr bool PERM = true, APERM = false;
    const TIn* xin; _Float16* xo; const float* gate; const float* modv; bf16_t* A1; const float* g1; int sc1; bf16_t* A2; const float* g2; int sc2; float* sumsq;
    __device__ __forceinline__ void operator()(const f32x4 (&acc)[2][2][4][2], const Unit& u, int wr, int wc, int fr, int fq) const {
        const int b = u.pm >> 3, col0 = u.pn * BM + wc * 32 + 8 * fq;
        float gv[2][8], gs1[2][8], gs2[HAS_A2 ? 2 : 1][8];
#pragma unroll
        for (int bj = 0; bj < 2; ++bj) { const int cc = col0 + bj * HALF;
            ld8(gate + (size_t)b * MODV_LD + cc, gv[bj]);
            { float gg[8], sc[8]; ld8(g1 + cc, gg); ld8(modv + (size_t)b * MODV_LD + sc1 + cc, sc);
#pragma unroll
              for (int j = 0; j < 8; ++j) gs1[bj][j] = gg[j] * (sc[j] + 1.f); }
            if constexpr (HAS_A2) { float gg[8], sc[8]; ld8(g2 + cc, gg); ld8(modv + (size_t)b * MODV_LD + sc2 + cc, sc);
#pragma unroll
              for (int j = 0; j < 8; ++j) gs2[bj][j] = gg[j] * (sc[j] + 1.f); } }
        constexpr int NG = (sizeof(TIn) == 4 || HAS_A2) ? 2 : 4;
#pragma unroll
        for (int ai = 0; ai < 2; ++ai) {
#pragma unroll
          for (int mh = 0; mh < 4; mh += NG) {
            float xv[sizeof(TIn) == 4 ? NG : 1][2][8]; h16x8 xh[sizeof(TIn) == 4 ? 1 : NG][2];
#pragma unroll
            for (int mm = 0; mm < NG; ++mm) { const size_t off = (size_t)(u.pm * BM + ai * HALF + wr * 64 + (mh + mm) * 16 + fr) * DM + col0;
#pragma unroll
                for (int bj = 0; bj < 2; ++bj) {
                    if constexpr (sizeof(TIn) == 4) ld8((const float*)xin + off + bj * HALF, xv[mm][bj]);
                    else xh[mm][bj] = *(const h16x8*)((const _Float16*)xin + off + bj * HALF); } }
            __builtin_amdgcn_sched_barrier(0);
#pragma unroll
            for (int mm = 0; mm < NG; ++mm) { const int m = mh + mm; const int row = u.pm * BM + ai * HALF + wr * 64 + m * 16 + fr; const size_t off = (size_t)row * DM + col0;
                float ss = 0.f;
#pragma unroll
                for (int bj = 0; bj < 2; ++bj) { float o[8]; h16x8 ho;
#pragma unroll
                    for (int j = 0; j < 8; ++j) { float xj; if constexpr (sizeof(TIn) == 4) xj = xv[mm][bj][j]; else xj = (float)xh[mm][bj][j];
                        o[j] = xj + gv[bj][j] * acc[ai][bj][m][j >> 2][j & 3]; ho[j] = (_Float16)o[j]; ss += o[j] * o[j]; }
                    *(h16x8*)(xo + off + bj * HALF) = ho;
                    if (A1) { u32x4 w; w.x = cvt_pk_bf16(o[0] * gs1[bj][0], o[1] * gs1[bj][1]); w.y = cvt_pk_bf16(o[2] * gs1[bj][2], o[3] * gs1[bj][3]);
                        w.z = cvt_pk_bf16(o[4] * gs1[bj][4], o[5] * gs1[bj][5]); w.w = cvt_pk_bf16(o[6] * gs1[bj][6], o[7] * gs1[bj][7]); *(u32x4*)(A1 + off + bj * HALF) = w; }
                    if constexpr (HAS_A2) { u32x4 w; w.x = cvt_pk_bf16(o[0] * gs2[bj][0], o[1] * gs2[bj][1]); w.y = cvt_pk_bf16(o[2] * gs2[bj][2], o[3] * gs2[bj][3]);
                        w.z = cvt_pk_bf16(o[4] * gs2[bj][4], o[5] * gs2[bj][5]); w.w = cvt_pk_bf16(o[6] * gs2[bj][6], o[7] * gs2[bj][7]); *(u32x4*)(A2 + off + bj * HALF) = w; } }
                if (sumsq) { ss += __shfl_xor(ss, 16); ss += __shfl_xor(ss, 32); if (fq == 0) atomicAdd(sumsq + row, ss); } }
            __builtin_amdgcn_sched_barrier(0);
          }
        }
    }
};

struct EpiFinal {
    static constexpr bool PERM = true, APERM = false;
    const _Float16* xin; float* out; const float* gate; const float* fg; float* sumsq; unsigned* cnt;
    __device__ __forceinline__ void operator()(f32x4 (&acc)[2][2][4][2], const Unit& u, int wr, int wc, int fr, int fq) const {
        const int b = u.pm >> 3, col0 = u.pn * BM + wc * 32 + 8 * fq;
        float gv[2][8];
#pragma unroll
        for (int bj = 0; bj < 2; ++bj) ld8(gate + (size_t)b * MODV_LD + col0 + bj * HALF, gv[bj]);
#pragma unroll
        for (int ai = 0; ai < 2; ++ai) {
            h16x8 xh[4][2];
#pragma unroll
            for (int m = 0; m < 4; ++m)
#pragma unroll
                for (int bj = 0; bj < 2; ++bj) xh[m][bj] = *(const h16x8*)(xin + (size_t)(u.pm * BM + ai * HALF + wr * 64 + m * 16 + fr) * DM + col0 + bj * HALF);
            __builtin_amdgcn_sched_barrier(0);
#pragma unroll
            for (int m = 0; m < 4; ++m) { const int row = u.pm * BM + ai * HALF + wr * 64 + m * 16 + fr;
                float ss = 0.f;
#pragma unroll
                for (int bj = 0; bj < 2; ++bj) { f32x4 o0, o1;
#pragma unroll
                    for (int j = 0; j < 4; ++j) { o0[j] = (float)xh[m][bj][j] + gv[bj][j] * acc[ai][bj][m][0][j]; o1[j] = (float)xh[m][bj][4 + j] + gv[bj][4 + j] * acc[ai][bj][m][1][j]; }
                    acc[ai][bj][m][0] = o0; acc[ai][bj][m][1] = o1;
                    ss += (o0[0] * o0[0] + o0[1] * o0[1]) + (o0[2] * o0[2] + o0[3] * o0[3]) + (o1[0] * o1[0] + o1[1] * o1[1]) + (o1[2] * o1[2] + o1[3] * o1[3]); }
                ss += __shfl_xor(ss, 16); ss += __shfl_xor(ss, 32); if (fq == 0) atomicAdd(sumsq + row, ss); }
            __builtin_amdgcn_sched_barrier(0);
        }
        asm volatile("s_waitcnt vmcnt(0)" ::: "memory");
        if (fr == 0 && fq == 0) __hip_atomic_fetch_add(cnt + u.pm * 8, 1u, __ATOMIC_RELAXED, __HIP_MEMORY_SCOPE_AGENT);
        { unsigned spins = 0;
          while (__hip_atomic_load(cnt + u.pm * 8, __ATOMIC_RELAXED, __HIP_MEMORY_SCOPE_AGENT) < 32u) { __builtin_amdgcn_s_sleep(2); if (++spins > (1u << 22)) break; } }
        float fgv[2][8];
#pragma unroll
        for (int bj = 0; bj < 2; ++bj) ld8(fg + col0 + bj * HALF, fgv[bj]);
        float ssq[2][4];
#pragma unroll
        for (int ai = 0; ai < 2; ++ai)
#pragma unroll
            for (int m = 0; m < 4; ++m) ssq[ai][m] = __hip_atomic_load(sumsq + u.pm * BM + ai * HALF + wr * 64 + m * 16 + fr, __ATOMIC_RELAXED, __HIP_MEMORY_SCOPE_AGENT);
#pragma unroll
        for (int ai = 0; ai < 2; ++ai)
#pragma unroll
            for (int m = 0; m < 4; ++m) { const size_t off = (size_t)(u.pm * BM + ai * HALF + wr * 64 + m * 16 + fr) * DM + col0;
                const float rs = __builtin_amdgcn_rsqf(ssq[ai][m] * (1.f / DM) + EPS);
#pragma unroll
                for (int bj = 0; bj < 2; ++bj) { f32x4 y0, y1;
#pragma unroll
                    for (int j = 0; j < 4; ++j) { y0[j] = acc[ai][bj][m][0][j] * rs * fgv[bj][j]; y1[j] = acc[ai][bj][m][1][j] * rs * fgv[bj][4 + j]; }
                    *(f32x4*)(out + off + bj * HALF) = y0; *(f32x4*)(out + off + bj * HALF + 4) = y1; } }
    }
};

__device__ __forceinline__ void scan16(float& a, float& b) {
    float ap, bp;
    ap = dpp_shr<1>(a, 1.f); bp = dpp_shr<1>(b, 0.f); b = fmaf(a, bp, b); a *= ap;
    ap = dpp_shr<2>(a, 1.f); bp = dpp_shr<2>(b, 0.f); b = fmaf(a, bp, b); a *= ap;
    ap = dpp_shr<4>(a, 1.f); bp = dpp_shr<4>(b, 0.f); b = fmaf(a, bp, b); a *= ap;
    ap = dpp_shr<8>(a, 1.f); bp = dpp_shr<8>(b, 0.f); b = fmaf(a, bp, b); a *= ap;
}
__device__ __forceinline__ void gate_elem2(f32x2 xr, f32x2 xg, f32x2 nba, f32x2 nbx, f32x2 psp2, f32x2 uv, f32x2& a, f32x2& b) {
    const f32x2 tr = xr * (-1.4426950408889634f) + nba, tg = xg * (-1.4426950408889634f) + nbx;
    f32x2 er, eg; er.x = __builtin_amdgcn_exp2f(tr.x); er.y = __builtin_amdgcn_exp2f(tr.y); eg.x = __builtin_amdgcn_exp2f(tg.x); eg.y = __builtin_amdgcn_exp2f(tg.y);
    const f32x2 dr = er + 1.f, dg = eg + 1.f, dd = dr * dg;
    f32x2 inv; inv.x = __builtin_amdgcn_rcpf(dd.x); inv.y = __builtin_amdgcn_rcpf(dd.y);
    const f32x2 r = inv * dg, gi = inv * dr;
    const f32x2 la2 = psp2 * r;
    a.x = __builtin_amdgcn_exp2f(-la2.x); a.y = __builtin_amdgcn_exp2f(-la2.y);
    const f32x2 om = 1.f - a * a;
    f32x2 sq; sq.x = __builtin_amdgcn_sqrtf(om.x); sq.y = __builtin_amdgcn_sqrtf(om.y);
    b = sq * gi * uv;
}
struct GateParams { f32x2 nba[4], nbx[4], psp2[4]; };
__device__ __forceinline__ void gate_params(GateParams& P, const float* ba, const float* bx, const float* lam, int ch0) {
#pragma unroll
    for (int p = 0; p < 4; ++p) {
        const f32x2 vb = *(const f32x2*)(ba + ch0 + 2 * p), vx = *(const f32x2*)(bx + ch0 + 2 * p), vl = *(const f32x2*)(lam + ch0 + 2 * p);
        P.nba[p] = vb * (-1.4426950408889634f); P.nbx[p] = vx * (-1.4426950408889634f);
        const float z0 = -vl.x, z1 = -vl.y;
        P.psp2[p].x = 8.f * 1.4426950408889634f * (z0 > 20.f ? z0 : flog(1.f + fexp(z0)));
        P.psp2[p].y = 8.f * 1.4426950408889634f * (z1 > 20.f ? z1 : flog(1.f + fexp(z1)));
    }
}
#define GATE_PAIR(p, accv, uw_, a2, b2) do { const int n_ = (p) >> 1, q_ = ((p) & 1) * 2; \
        const unsigned uword_ = ((p) == 0) ? uw_.x : ((p) == 1) ? uw_.y : ((p) == 2) ? uw_.z : uw_.w; \
        gate_elem2((f32x2){accv[ai][0][m][n_][q_], accv[ai][0][m][n_][q_ + 1]}, (f32x2){accv[ai][1][m][n_][q_], accv[ai][1][m][n_][q_ + 1]}, \
                   P.nba[p], P.nbx[p], P.psp2[p], (f32x2){bf_lo(uword_), bf_hi(uword_)}, a2, b2); } while (0)
struct GatesOrder {
    int c, n;
    __device__ bool next(int i, Unit& u) const { if (i >= n) return false; const int j = c >> 3; int pm = (c & 7) * 8 + 4 * i + (j & 3), pn = (j >> 2) & 1, sub = (j >> 3) & 3;
        asm volatile("" : "+s"(pm), "+s"(pn), "+s"(sub)); u.pm = pm; u.pn = pn; u.sub = sub; return true; }
};
constexpr int GS_RA_OFF = 133120;
struct EpiGatesS {
    static constexpr bool PERM = true, APERM = true;
    unsigned char* ws; unsigned target; const float* ba; const float* bx; const float* lam; LAS unsigned char* lds;
    __device__ __forceinline__ void operator()(f32x4 (&acc)[2][2][4][2], const Unit& u, int wr, int wc, int fr, int fq) const {
        const bf16_t* U = (const bf16_t*)(ws + WS_UPRE); const bf16_t* Gt = (const bf16_t*)(ws + WS_G); bf16_t* Y = (bf16_t*)(ws + WS_HN);
        unsigned long long* TA = (unsigned long long*)(ws + WS_TA); unsigned* flags = (unsigned*)(ws + WS_GFLAG);
        const int ct0 = wc * 32 + 8 * fq, ch0 = u.sub * 256 + u.pn * 128 + ct0;
        const int chain = ((u.pm >> 3) * 4 + u.sub) * 2 + u.pn, p = u.pm & 7, tix = chain * 8 + p;
        const int bsrc = (fq * 16 + 15) << 2;
        LAS f32x4* RA = (LAS f32x4*)(lds + GS_RA_OFF);
        {
            GateParams P; gate_params(P, ba, bx, lam, ch0);
#pragma unroll
            for (int ai = 0; ai < 2; ++ai) {
                u32x4 uall[4];
#pragma unroll
                for (int m = 0; m < 4; ++m) uall[m] = *(const u32x4*)(U + (size_t)(u.pm * BM + ai * HALF + wr * 64 + 4 * fr + m) * DM + ch0);
#pragma unroll
                for (int n = 0; n < 2; ++n) { f32x4 tA[4], tB[4]; f32x4 agg;
#pragma unroll
                    for (int hq = 0; hq < 2; ++hq) { const int pq = 2 * n + hq; f32x2 a2[4], b2[4];
#pragma unroll
                        for (int m = 0; m < 4; ++m) { const u32x4 uw = uall[m]; GATE_PAIR(pq, acc, uw, a2[m], b2[m]); }
#pragma unroll
                        for (int m = 1; m < 4; ++m) { b2[m] = a2[m] * b2[m - 1] + b2[m]; a2[m] = a2[m] * a2[m - 1]; }
                        float pax = a2[3].x, pbx = b2[3].x, pay = a2[3].y, pby = b2[3].y; scan16(pax, pbx); scan16(pay, pby);
                        if (hq == 0) { agg[0] = pax; agg[1] = pbx; agg[2] = pay; agg[3] = pby;
                            if (fr == 15) RA[((ai * 2 + wr) * 128 + ct0) / 2 + pq] = agg; }
                        else { if (fr == 15) RA[((ai * 2 + wr) * 128 + ct0) / 2 + pq] = (f32x4){pax, pbx, pay, pby}; }
                        const f32x2 EA = {dpp_shr<1>(pax, 1.f), dpp_shr<1>(pay, 1.f)}, EB = {dpp_shr<1>(pbx, 0.f), dpp_shr<1>(pby, 0.f)};
#pragma unroll
                        for (int m = 0; m < 4; ++m) { const f32x2 Ae = a2[m] * EA, Be = a2[m] * EB + b2[m];
                            tA[m][2 * hq] = Ae.x; tA[m][2 * hq + 1] = Ae.y; tB[m][2 * hq] = Be.x; tB[m][2 * hq + 1] = Be.y; }
                        __builtin_amdgcn_sched_barrier(0); }
#pragma unroll
                    for (int m = 0; m < 4; ++m) { acc[ai][0][m][n] = tA[m]; acc[ai][1][m][n] = tB[m]; }
                    asm volatile("" ::: "memory"); __builtin_amdgcn_sched_barrier(0); }
            }
        }
        asm volatile("s_waitcnt lgkmcnt(0)" ::: "memory"); __builtin_amdgcn_s_barrier(); asm volatile("" ::: "memory");
        if (wr == 0) {
            float At[8], Bt[8];
#pragma unroll
            for (int j = 0; j < 8; ++j) { At[j] = 1.f; Bt[j] = 0.f; }
#pragma unroll
            for (int ri = 0; ri < 4; ++ri)
#pragma unroll
                for (int q = 0; q < 4; ++q) { const f32x4 v = RA[(ri * 128 + ct0) / 2 + q];
                    Bt[2 * q] = fmaf(v[0], Bt[2 * q], v[1]); At[2 * q] *= v[0]; Bt[2 * q + 1] = fmaf(v[2], Bt[2 * q + 1], v[3]); At[2 * q + 1] *= v[2]; }
            if (fr == 15) {
#pragma unroll
                for (int j = 0; j < 8; ++j) __hip_atomic_store(TA + (size_t)tix * 128 + ct0 + j, ((unsigned long long)__float_as_uint(Bt[j]) << 32) | __float_as_uint(At[j]), __ATOMIC_RELAXED, __HIP_MEMORY_SCOPE_AGENT);
            }
            asm volatile("s_waitcnt vmcnt(0)" ::: "memory");
            if (fr == 15 && fq == 0) __hip_atomic_fetch_add(flags + tix * 8, 1u, __ATOMIC_RELAXED, __HIP_MEMORY_SCOPE_AGENT);
        }
        float h[8];
        {
            const bool on = fr < p;
            if (on) { unsigned spins = 0;
                while (__hip_atomic_load(flags + (chain * 8 + fr) * 8, __ATOMIC_RELAXED, __HIP_MEMORY_SCOPE_AGENT) < target) { __builtin_amdgcn_s_sleep(2); if (++spins > (1u << 22)) break; } }
            float Ac[8], Bc[8];
#pragma unroll
            for (int j = 0; j < 8; ++j) { unsigned long long w = 0x000000003f800000ull;
                if (on) w = __hip_atomic_load(TA + (size_t)(chain * 8 + fr) * 128 + ct0 + j, __ATOMIC_RELAXED, __HIP_MEMORY_SCOPE_AGENT);
                Ac[j] = __uint_as_float((unsigned)w); Bc[j] = __uint_as_float((unsigned)(w >> 32)); }
#pragma unroll
            for (int j = 0; j < 8; ++j) { float a = Ac[j], b = Bc[j]; scan16(a, b); h[j] = __int_as_float(__builtin_amdgcn_ds_bpermute(bsrc, __float_as_int(b))); }
        }
#pragma unroll
        for (int ai = 0; ai < 2; ++ai) {
            const int nskip = (ai == 0) ? wr : 1;
            const int rfirst = (ai == 0) ? 0 : (1 + wr);
            for (int k = 0; k < nskip; ++k)
#pragma unroll
                for (int q = 0; q < 4; ++q) { const f32x4 v = RA[((rfirst + k) * 128 + ct0) / 2 + q];
                    h[2 * q] = fmaf(v[0], h[2 * q], v[1]); h[2 * q + 1] = fmaf(v[2], h[2 * q + 1], v[3]); }
            u32x4 gall[4];
#pragma unroll
            for (int m = 0; m < 4; ++m) gall[m] = *(const u32x4*)(Gt + (size_t)(u.pm * BM + ai * HALF + wr * 64 + 4 * fr + m) * DM + ch0);
            float hl[8];
#pragma unroll
            for (int m = 0; m < 4; ++m) { const size_t off = (size_t)(u.pm * BM + ai * HALF + wr * 64 + 4 * fr + m) * DM + ch0;
                const u32x4 gw = gall[m];
                const float gv[8] = {bf_lo(gw.x), bf_hi(gw.x), bf_lo(gw.y), bf_hi(gw.y), bf_lo(gw.z), bf_hi(gw.z), bf_lo(gw.w), bf_hi(gw.w)};
                float yv[8];
#pragma unroll
                for (int j = 0; j < 8; ++j) { const float hv = fmaf(acc[ai][0][m][j >> 2][j & 3], h[j], acc[ai][1][m][j >> 2][j & 3]); yv[j] = hv * gv[j];
                    if (m == 3) hl[j] = hv; }
                u32x4 w; w.x = cvt_pk_bf16(yv[0], yv[1]); w.y = cvt_pk_bf16(yv[2], yv[3]); w.z = cvt_pk_bf16(yv[4], yv[5]); w.w = cvt_pk_bf16(yv[6], yv[7]);
                *(u32x4*)(Y + off) = w; }
#pragma unroll
            for (int j = 0; j < 8; ++j) h[j] = __int_as_float(__builtin_amdgcn_ds_bpermute(bsrc, __float_as_int(hl[j])));
            asm volatile("" ::: "memory"); __builtin_amdgcn_sched_barrier(0);
        }
    }
};

struct EpiQKV {
    static constexpr bool PERM = true, APERM = false;
    unsigned char* ws; float* kmean; const float* sumsq; const float* shw; int shw_sub;
    __device__ __forceinline__ void operator()(const f32x4 (&acc)[2][2][4][2], const Unit& u, int wr, int wc, int fr, int fq) const {
        const int b = u.pm >> 3, sblk = u.pm & 7, pq = u.pn & 3; const bool second = u.pn >= 4;
        const int dcol = wc * 32 + 8 * fq;
        const float* sw = shw + (size_t)u.sub * shw_sub + (size_t)b * 2 * DM + u.pn * BM + dcol;
        f32x4 bv[2][2];
#pragma unroll
        for (int bj = 0; bj < 2; ++bj)
#pragma unroll
            for (int n = 0; n < 2; ++n) bv[bj][n] = *(const f32x4*)(sw + bj * HALF + 4 * n);
        const bool plain = (u.sub == 0 && second), km = (u.sub == 1 && !second);
        const size_t boff = plain ? WS_G : (u.sub == 0) ? WS_UPRE : (second ? WS_BIN : WS_HN);
        const size_t rstride = plain ? DM : DH;
        bf16_t* bp[2];
#pragma unroll
        for (int bj = 0; bj < 2; ++bj)
            bp[bj] = (bf16_t*)(ws + boff) + (plain ? (size_t)(u.pm * BM) * DM + pq * 256 + bj * HALF + dcol : ((size_t)(b * NH + 2 * pq + bj) * SEQ + sblk * 256) * DH + dcol);
        f32x4 s0[2], s1[2];
#pragma unroll
        for (int bj = 0; bj < 2; ++bj) { s0[bj] = (f32x4){0.f, 0.f, 0.f, 0.f}; s1[bj] = (f32x4){0.f, 0.f, 0.f, 0.f}; }
        float ssq[2][4];
#pragma unroll
        for (int ai = 0; ai < 2; ++ai)
#pragma unroll
            for (int m = 0; m < 4; ++m) ssq[ai][m] = sumsq[u.pm * BM + ai * HALF + wr * 64 + m * 16 + fr];
#pragma unroll
        for (int ai = 0; ai < 2; ++ai)
#pragma unroll
            for (int m = 0; m < 4; ++m) { const int r = ai * HALF + wr * 64 + m * 16 + fr;
                const float rs = __builtin_amdgcn_rsqf(ssq[ai][m] * (1.f / DM) + EPS);
#pragma unroll
                for (int bj = 0; bj < 2; ++bj) { f32x4 v0 = acc[ai][bj][m][0] * rs + bv[bj][0], v1 = acc[ai][bj][m][1] * rs + bv[bj][1];
                    if (plain) {
#pragma unroll
                        for (int j = 0; j < 4; ++j) { v0[j] = fsilu(v0[j]); v1[j] = fsilu(v1[j]); } }
                    s0[bj] += v0; s1[bj] += v1;
                    u32x4 w; w.x = cvt_pk_bf16(v0[0], v0[1]); w.y = cvt_pk_bf16(v0[2], v0[3]); w.z = cvt_pk_bf16(v1[0], v1[1]); w.w = cvt_pk_bf16(v1[2], v1[3]);
                    *(u32x4*)(bp[bj] + (size_t)r * rstride) = w; }
                asm volatile("" ::: "memory"); }
        if (km) {
#pragma unroll
            for (int bj = 0; bj < 2; ++bj)
#pragma unroll
                for (int j = 0; j < 4; ++j) { float t0 = s0[bj][j], t1 = s1[bj][j];
                    t0 += __shfl_xor(t0, 1); t0 += __shfl_xor(t0, 2); t0 += __shfl_xor(t0, 4); t0 += __shfl_xor(t0, 8);
                    t1 += __shfl_xor(t1, 1); t1 += __shfl_xor(t1, 2); t1 += __shfl_xor(t1, 4); t1 += __shfl_xor(t1, 8);
                    if (fr == 0) { float* kp = kmean + ((size_t)(b * NH + 2 * pq + bj) * 8 + sblk) * DH + dcol + j;
                        atomicAdd(kp, t0 * (1.f / 256.f)); atomicAdd(kp + 4, t1 * (1.f / 256.f)); } }
        }
    }
};

template <class Epi, class Sched>
__device__ __forceinline__ void gemm_phase(LAS unsigned char* lds, const Gemm g, const Sched& S, const Epi& E, int wv) {
    const int tid = opq_tid(wv), wid = __builtin_amdgcn_readfirstlane(tid >> 6), lane = tid & 63, wr = wid >> 2, wc = wid & 3, fr = lane & 15, fq = lane >> 4;
    const int K = g.K, nt = K / BK;
    unsigned voffA[2], voffB[2];
#pragma unroll
    for (int i = 0; i < 2; ++i) { int R, C; stage_rc(tid * 16 + i * 8192, R, C); const int Rb = Epi::PERM ? ((R & ~31) + perm32(R & 31)) : R;
        const int Ra = Epi::APERM ? ((R & 64) + 4 * (R & 15) + ((R >> 4) & 3)) : R;
        voffA[i] = (unsigned)(Ra * g.lda + C) * 2u; voffB[i] = (unsigned)(Rb * g.ldb + C) * 2u; }
    const size_t kstep = (size_t)(BK * 2);
    const size_t hstepA = (size_t)HALF * g.lda * 2, hstepB = (size_t)HALF * g.ldb * 2;
    const size_t tstepA = 2 * hstepA, tstepB = 2 * hstepB;
    const unsigned ldsw = (unsigned)wid * 1024u;
    const int aoff = lds_byte(wr * 64 + fr, fq * 8), boff = lds_byte(wc * 32 + fr, fq * 8);
#define PG8_SA(b, h) (((b) * 2 + (h)) * HTB)
#define PG8_SB(b, h) ((4 + (b) * 2 + (h)) * HTB)
#define PG8_STAGE(bufoff, gbase, voff) do { _Pragma("unroll") for (int _i = 0; _i < 2; ++_i) \
        __builtin_amdgcn_global_load_lds((const unsigned*)((const char*)(gbase) + (voff)[_i]), (LAS unsigned*)(lds + (bufoff) + ldsw + _i * 8192), 16, 0, 0); } while (0)
#define PG8_LDA(dst, b, h) do { _Pragma("unroll") for (int m = 0; m < 4; ++m) _Pragma("unroll") for (int k = 0; k < 2; ++k) dst[m][k] = *(const LAS bf16x8*)(lds + PG8_SA(b, h) + aoff + m * 2048 + k * 1024); } while (0)
#define PG8_LDB(dst, b, h) do { _Pragma("unroll") for (int n = 0; n < 2; ++n) _Pragma("unroll") for (int k = 0; k < 2; ++k) dst[n][k] = *(const LAS bf16x8*)(lds + PG8_SB(b, h) + boff + n * 2048 + k * 1024); } while (0)
#define PG8_MMA(ai, bj, At, Bt) do { __builtin_amdgcn_s_setprio(1); _Pragma("unroll") for (int m = 0; m < 4; ++m) _Pragma("unroll") for (int n = 0; n < 2; ++n) _Pragma("unroll") for (int k = 0; k < 2; ++k) \
        acc[ai][bj][m][n] = __builtin_amdgcn_mfma_f32_16x16x32_bf16(Bt[n][k], At[m][k], acc[ai][bj][m][n], 0, 0, 0); __builtin_amdgcn_s_setprio(0); } while (0)
#define PG8_WAIT_V(n) asm volatile("s_waitcnt vmcnt(" #n ")" ::: "memory")
#define PG8_WAIT_L(n) asm volatile("s_waitcnt lgkmcnt(" #n ")" ::: "memory")
#define PG8_BAR __builtin_amdgcn_s_barrier()
#define PG8_SCHED __builtin_amdgcn_sched_barrier(0)
#define PG8_UA(u) ((const char*)g.A + (size_t)(u).sub * g.a_sub + (size_t)(u).pm * tstepA)
#define PG8_UB(u) ((const char*)g.Bt + (size_t)(u).sub * g.b_sub + (size_t)(u).pn * tstepB)
    Unit cur, nxt; int ui = 0;
    if (!S.next(0, cur)) return;
    f32x4 acc[2][2][4][2];
#pragma unroll
    for (int a = 0; a < 2; ++a)
#pragma unroll
        for (int b = 0; b < 2; ++b)
#pragma unroll
            for (int m = 0; m < 4; ++m)
#pragma unroll
                for (int n = 0; n < 2; ++n) acc[a][b][m][n] = (f32x4){0.f, 0.f, 0.f, 0.f};
    bf16x8 At[4][2], B0[2][2], B1[2][2];
    const char* cA = PG8_UA(cur); const char* cB = PG8_UB(cur);
    PG8_STAGE(PG8_SB(0, 0), cB, voffB); PG8_STAGE(PG8_SB(0, 1), cB + hstepB, voffB); PG8_STAGE(PG8_SA(0, 0), cA, voffA); PG8_STAGE(PG8_SA(0, 1), cA + hstepA, voffA);
    if (wr == 1) PG8_BAR;
    PG8_WAIT_V(2); PG8_BAR;
    PG8_STAGE(PG8_SB(1, 0), cB + kstep, voffB); PG8_STAGE(PG8_SA(1, 0), cA + kstep, voffA); PG8_STAGE(PG8_SB(1, 1), cB + hstepB + kstep, voffB);
    PG8_WAIT_V(6); PG8_BAR;
    for (;;) {
        const bool has_next = S.next(ui + 1, nxt);
        const char* nA = has_next ? PG8_UA(nxt) : cA; const char* nB = has_next ? PG8_UB(nxt) : cB;
        for (int t = 0; t < nt; t += 2) {
            const bool last = (t == nt - 2);
            const char* a1 = cA + (size_t)(t + 1) * kstep;
            const char* a2 = last ? nA : cA + (size_t)(t + 2) * kstep; const char* b2 = last ? nB : cB + (size_t)(t + 2) * kstep;
            const char* a3 = a2 + kstep; const char* b3 = b2 + kstep;
            PG8_LDB(B0, 0, 0); PG8_LDB(B1, 0, 1); PG8_SCHED; PG8_LDA(At, 0, 0); PG8_STAGE(PG8_SA(1, 1), a1 + hstepA, voffA);
            PG8_WAIT_V(8); PG8_WAIT_L(0); PG8_BAR; PG8_MMA(0, 0, At, B0); PG8_MMA(0, 1, At, B1); PG8_BAR; PG8_SCHED;
            PG8_LDA(At, 0, 1); PG8_STAGE(PG8_SB(0, 0), b2, voffB); PG8_STAGE(PG8_SB(0, 1), b2 + hstepB, voffB); PG8_STAGE(PG8_SA(0, 0), a2, voffA);
            PG8_WAIT_V(8); PG8_WAIT_L(0); PG8_BAR; PG8_MMA(1, 0, At, B0); PG8_MMA(1, 1, At, B1); PG8_BAR; PG8_SCHED;
            PG8_LDB(B0, 1, 0); PG8_LDB(B1, 1, 1); PG8_SCHED; PG8_LDA(At, 1, 0); PG8_STAGE(PG8_SA(0, 1), a2 + hstepA, voffA);
            PG8_WAIT_V(8); PG8_WAIT_L(0); PG8_BAR; PG8_MMA(0, 0, At, B0); PG8_MMA(0, 1, At, B1); PG8_BAR; PG8_SCHED;
            PG8_LDA(At, 1, 1); PG8_STAGE(PG8_SB(1, 0), b3, voffB); PG8_STAGE(PG8_SB(1, 1), b3 + hstepB, voffB); PG8_STAGE(PG8_SA(1, 0), a3, voffA);
            PG8_WAIT_V(8); PG8_WAIT_L(0); PG8_BAR; PG8_MMA(1, 0, At, B0); PG8_MMA(1, 1, At, B1); PG8_BAR; PG8_SCHED;
        }
        if (wr == 0) PG8_BAR;
        { const int t2 = opq_tid(wv), w2 = __builtin_amdgcn_readfirstlane(t2 >> 6), l2 = t2 & 63; E(acc, cur, w2 >> 2, w2 & 3, l2 & 15, l2 >> 4); }
        if (!has_next) break;
#pragma unroll
        for (int a = 0; a < 2; ++a)
#pragma unroll
            for (int b = 0; b < 2; ++b)
#pragma unroll
                for (int m = 0; m < 4; ++m)
#pragma unroll
                    for (int n = 0; n < 2; ++n) acc[a][b][m][n] = (f32x4){0.f, 0.f, 0.f, 0.f};
        cur = nxt; cA = nA; cB = nB; ++ui;
        if (wr == 1) PG8_BAR;
    }
    PG8_WAIT_V(0);
    PG8_BAR;
#undef PG8_SA
#undef PG8_SB
#undef PG8_STAGE
#undef PG8_LDA
#undef PG8_LDB
#undef PG8_MMA
#undef PG8_WAIT_V
#undef PG8_WAIT_L
#undef PG8_BAR
#undef PG8_SCHED
#undef PG8_UA
#undef PG8_UB
}
}

namespace att {
constexpr float SCALE = 0.08838834764831845f;
constexpr float THR = 8.f;
constexpr int NW = 8, QBLK = 32, KVBLK = 64, QB = NW * QBLK, D = 128;
constexpr int SHM_V = KVBLK * D * 2, SHM_K = KVBLK * D * 2;
constexpr int ATT_LDS = 2 * SHM_V + 2 * SHM_K + NW * 64 * 4;
#define KSWZ(row, colB) ((row) * 256 + ((colB) ^ (((row) & 7) << 4)))
#define SBAR() __builtin_amdgcn_sched_barrier(0)
__device__ __forceinline__ int v_st(int k, int c) { const int kk = (k & ~0xC) | ((k & 4) << 1) | ((k & 8) >> 1); return ((kk >> 3) * 4 + (c >> 5)) * 512 + ((kk & 7) * 32 + (c & 31)) * 2; }
__device__ __forceinline__ int v_rd_base(int lane) { return ((lane & 3) << 3) | (((lane >> 2) & 3) << 6) | (((lane >> 4) & 1) << 5) | (((lane >> 5) & 1) << 8); }
constexpr int v_rd_off(int d0, int ks, int half) { return d0 * 512 + ks * 4096 + half * 2048; }
__device__ __forceinline__ int crow(int r, int hi) { return (r & 3) + 8 * (r >> 2) + 4 * hi; }
__device__ __forceinline__ bf16x8 load8(const bf16_t* p) { return *reinterpret_cast<const bf16x8*>(p); }
__device__ __forceinline__ void mask_tile(f32x16& p0, f32x16& p1, int dq) {
    const float NEG = -__builtin_inff();
#pragma unroll
    for (int r = 0; r < 16; ++r) {
        const int c = (r & 3) + 8 * (r >> 2);
        if (dq - c < 0) p0[r] = NEG;
        if (dq - c - 32 < 0) p1[r] = NEG;
    }
}
__device__ __forceinline__ void mask_all(f32x16& p0, f32x16& p1, bool off) {
    const float NEG = -__builtin_inff();
#pragma unroll
    for (int r = 0; r < 16; ++r) { p0[r] = off ? NEG : p0[r]; p1[r] = off ? NEG : p1[r]; }
}
__device__ __forceinline__ void partialSM(f32x16& p0, f32x16& p1, float& m_reg, float& mn, float& alpha, float rbias = 0.f) {
    float pmax = p0[0];
#pragma unroll
    for (int r = 1; r < 16; ++r) pmax = fmaxf(pmax, p0[r]);
#pragma unroll
    for (int r = 0; r < 16; ++r) pmax = fmaxf(pmax, p1[r]);
    { auto rr = __builtin_amdgcn_permlane32_swap(__float_as_uint(pmax), __float_as_uint(pmax), false, false);
      pmax = fmaxf(__uint_as_float(rr[0]), __uint_as_float(rr[1])); }
    constexpr float C2 = 1.4426950408889634f * SCALE;
    if (__builtin_expect(__all((pmax - m_reg) * SCALE <= THR), 1)) { mn = m_reg; alpha = 1.f; }
    else { mn = fmaxf(m_reg, pmax); alpha = __builtin_amdgcn_exp2f((m_reg - mn) * C2); m_reg = mn; }
    const float mnL = -mn * C2 + rbias;
#pragma unroll
    for (int r = 0; r < 16; ++r) p0[r] = fmaf(p0[r], C2, mnL);
#pragma unroll
    for (int r = 0; r < 16; ++r) p1[r] = fmaf(p1[r], C2, mnL);
#pragma unroll
    for (int r = 0; r < 16; ++r) p0[r] = __builtin_amdgcn_exp2f(p0[r]);
}
__device__ __forceinline__ void finishSM(f32x16& p0, f32x16& p1, float alpha, float& l_reg, bf16x8& pa0, bf16x8& pa1, bf16x8& pa2, bf16x8& pa3) {
#pragma unroll
    for (int r = 0; r < 16; ++r) p1[r] = __builtin_amdgcn_exp2f(p1[r]);
    float ps = 0;
#pragma unroll
    for (int r = 0; r < 16; ++r) ps += p0[r];
#pragma unroll
    for (int r = 0; r < 16; ++r) ps += p1[r];
    { auto rr = __builtin_amdgcn_permlane32_swap(__float_as_uint(ps), __float_as_uint(ps), false, false);
      ps = __uint_as_float(rr[0]) + __uint_as_float(rr[1]); }
    l_reg = l_reg * alpha + ps;
#define PK4(P, B_, OUT) do { unsigned a0 = cvt_pk_bf16(P[B_+0], P[B_+1]), a1 = cvt_pk_bf16(P[B_+2], P[B_+3]);                          \
        unsigned b0 = cvt_pk_bf16(P[B_+4], P[B_+5]), b1 = cvt_pk_bf16(P[B_+6], P[B_+7]);                                             \
        auto r0 = __builtin_amdgcn_permlane32_swap(a0, b0, false, false); auto r1 = __builtin_amdgcn_permlane32_swap(a1, b1, false, false); \
        u32x4 w = {r0[0], r1[0], r0[1], r1[1]}; OUT = *reinterpret_cast<bf16x8*>(&w); } while (0)
    PK4(p0, 0, pa0); PK4(p0, 8, pa1); PK4(p1, 0, pa2); PK4(p1, 8, pa3);
#undef PK4
}
template <int KB>
__device__ __forceinline__ void qkt(f32x16& p0, f32x16& p1, const char* K_lds, int r32, int hi, const bf16x8* qr) {
    p0 = f32x16{}; p1 = f32x16{};
    const char* kb[4];
#pragma unroll
    for (int dd = 0; dd < 4; ++dd) kb[dd] = K_lds + KB * SHM_K + KSWZ(r32, (dd * 16 + hi * 8) * 2);
#pragma unroll
    for (int d0 = 0; d0 < 8; ++d0) { const char* a = kb[d0 & 3] + (d0 >> 2) * 128;
        bf16x8 b0 = *reinterpret_cast<const bf16x8*>(a);
        bf16x8 b1 = *reinterpret_cast<const bf16x8*>(a + 32 * 256);
        p0 = __builtin_amdgcn_mfma_f32_32x32x16_bf16(b0, qr[d0], p0, 0, 0, 0);
        p1 = __builtin_amdgcn_mfma_f32_32x32x16_bf16(b1, qr[d0], p1, 0, 0, 0); }
}
template <int VB>
__device__ __forceinline__ void pv_tile(f32x16* o, int vb0, bf16x8 pa0, bf16x8 pa1, bf16x8 pa2, bf16x8 pa3) {
#define TRRD(dst, off) asm volatile("ds_read_b64_tr_b16 %0, %1 offset:%2" : "=&v"(dst) : "v"(vb0), "i"(off) : "memory")
#define PV_D0(d0) do { s16x4 l0, l1, l2, l3, h0, h1, h2, h3; constexpr int b_ = VB * SHM_V + v_rd_off(d0, 0, 0); \
        TRRD(l0, b_); TRRD(h0, b_ + 2048); TRRD(l1, b_ + 4096); TRRD(h1, b_ + 6144); TRRD(l2, b_ + 8192); TRRD(h2, b_ + 10240); TRRD(l3, b_ + 12288); TRRD(h3, b_ + 14336); \
        asm volatile("s_waitcnt lgkmcnt(0)" ::: "memory"); SBAR();   \
        o[d0] = __builtin_amdgcn_mfma_f32_32x32x16_bf16(pa0, (bf16x8){l0[0], l0[1], l0[2], l0[3], h0[0], h0[1], h0[2], h0[3]}, o[d0], 0, 0, 0);   \
        o[d0] = __builtin_amdgcn_mfma_f32_32x32x16_bf16(pa1, (bf16x8){l1[0], l1[1], l1[2], l1[3], h1[0], h1[1], h1[2], h1[3]}, o[d0], 0, 0, 0);   \
        o[d0] = __builtin_amdgcn_mfma_f32_32x32x16_bf16(pa2, (bf16x8){l2[0], l2[1], l2[2], l2[3], h2[0], h2[1], h2[2], h2[3]}, o[d0], 0, 0, 0);   \
        o[d0] = __builtin_amdgcn_mfma_f32_32x32x16_bf16(pa3, (bf16x8){l3[0], l3[1], l3[2], l3[3], h3[0], h3[1], h3[2], h3[3]}, o[d0], 0, 0, 0); } while (0)
    PV_D0(0); PV_D0(1); PV_D0(2); PV_D0(3);
#undef PV_D0
#undef TRRD
}

struct BlockRef { const bf16_t* Q; const bf16_t* K; const bf16_t* V; bf16_t* O; const bf16_t* Gt; const float* KM; int P0; };
struct Seam { bf16x8 qr[8]; bf16x8 st_v0, st_v1, st_k0, st_k1; };
#define ROW(p, k0, rr) ((p) + (size_t)((k0) + (rr)) * D + sc)
#define VMW() asm volatile("s_waitcnt vmcnt(0)" ::: "memory")
#define VMWN(n) asm volatile("s_waitcnt vmcnt(%0)" :: "i"(n) : "memory")
#define SLOAD_H(Kp, Vp, k0) do { S.st_v0 = load8(ROW(Vp, k0, sr)); S.st_v1 = load8(ROW(Vp, k0, 32 + sr));              \
                         S.st_k0 = load8(ROW(Kp, k0, sr)); S.st_k1 = load8(ROW(Kp, k0, 32 + sr)); } while (0)
#define SWRITE_HK(bf) do { *(bf16x8*)(K_lds + (bf) * SHM_K + kws) = S.st_k0; *(bf16x8*)(K_lds + (bf) * SHM_K + kws + 32 * 256) = S.st_k1; } while (0)
#define SWRITE_HV(bf) do { *(bf16x8*)(V_lds + (bf) * SHM_V + vst0) = S.st_v0; *(bf16x8*)(V_lds + (bf) * SHM_V + vst1) = S.st_v1; } while (0)
#define SWRITE_H(bf) do { SWRITE_HV(bf); SWRITE_HK(bf); } while (0)
__device__ __forceinline__ void moba_prime(const BlockRef& cur, char* lds, Seam& S, int wv) {
    const int tid = opq_tid(wv), wid = __builtin_amdgcn_readfirstlane(tid >> 6), lane = tid & 63, r32 = lane & 31, hi = lane >> 5;
    const int sr = tid >> 4, sc = (tid & 15) * 8, kws = KSWZ(sr, sc * 2); char* K_lds = lds + 2 * SHM_V;
#pragma unroll
    for (int d0 = 0; d0 < 8; ++d0) S.qr[d0] = load8(cur.Q + (size_t)(wid * QBLK + r32) * D + d0 * 16 + hi * 8);
    SLOAD_H(cur.K, cur.V, 0); VMW(); SWRITE_HK(0);
    __syncthreads();
}
__device__ __forceinline__ unsigned moba_select(const Seam& S, const float* KM, int qb, int hi) {
    if (qb <= 3) return (1u << qb) - 1u;
    float sc_[8];
#pragma unroll
    for (int j = 0; j < 8; ++j) sc_[j] = 0.f;
#pragma unroll
    for (int j = 0; j < 7; ++j) {
        if (j < qb) {
            float s = 0.f;
#pragma unroll
            for (int d0 = 0; d0 < 8; ++d0) {
                const f32x4 k0 = *(const f32x4*)(KM + j * D + d0 * 16 + hi * 8), k1 = *(const f32x4*)(KM + j * D + d0 * 16 + hi * 8 + 4);
                const bf16x8 q = S.qr[d0];
                s += bf1((bf16_t)q[0]) * k0[0] + bf1((bf16_t)q[1]) * k0[1] + bf1((bf16_t)q[2]) * k0[2] + bf1((bf16_t)q[3]) * k0[3]
                   + bf1((bf16_t)q[4]) * k1[0] + bf1((bf16_t)q[5]) * k1[1] + bf1((bf16_t)q[6]) * k1[2] + bf1((bf16_t)q[7]) * k1[3];
            }
            s += __shfl_xor(s, 32);
            sc_[j] = s;
        }
    }
    unsigned sel = 0u;
#pragma unroll
    for (int it = 0; it < 3; ++it) {
        float best = -__builtin_inff(); int bi = 0;
#pragma unroll
        for (int j = 0; j < 7; ++j) { const bool ok = (j < qb) && !((sel >> j) & 1u) && (sc_[j] > best); best = ok ? sc_[j] : best; bi = ok ? j : bi; }
        sel |= 1u << bi;
    }
    return sel;
}
__device__ __forceinline__ void moba_block(const BlockRef& cur, const BlockRef& nxt, char* lds, Seam& S, int wv) {
    const int tid = opq_tid(wv), wid = __builtin_amdgcn_readfirstlane(tid >> 6), lane = tid & 63, r32 = lane & 31, hi = lane >> 5;
    const int NT = cur.P0 / KVBLK + 4;
    const int qb = cur.P0 >> 8;
    const int qlo = cur.P0 + wid * QBLK, qm = qlo + r32 - 4 * hi;
    char* V_lds = lds; char* K_lds = lds + 2 * SHM_V;
    float* ws = (float*)(lds + 2 * SHM_V + 2 * SHM_K) + wid * 64; float* li_l = ws, * al_l = ws + 32;
    float m_reg = -1e30f, l_reg = 0; f32x16 o[4] = {};
    const int sr = tid >> 4, sc = (tid & 15) * 8, vst0 = v_st(sr, sc), vst1 = v_st(32 + sr, sc), kws = KSWZ(sr, sc * 2);
    const int vb0 = (int)(uintptr_t)V_lds + v_rd_base(lane);
    const bf16_t* Kh = cur.K; const bf16_t* Vh = cur.V;
    const bool need_sel = qb > 3;
    const float* kml = (const float*)(lds + 69632);
    if (need_sel) { if (tid < 224) ((f32x4*)(lds + 69632))[tid] = ((const f32x4*)cur.KM)[tid]; __syncthreads(); }
    const unsigned sel = moba_select(S, kml, qb, hi);
#define RESC(a) do { if (__any((a) < 1.f)) { if (hi == 0) al_l[r32] = (a); asm volatile("s_waitcnt lgkmcnt(0)" ::: "memory");              \
                     for (int d_ = 0; d_ < 4; ++d_) for (int r = 0; r < 16; ++r) o[d_][r] *= al_l[crow(r, hi)]; } } while (0)
#define KBASE(t) ((t) * KVBLK)
#define MASKT(P0_, P1_, t) do { const int kb_ = KBASE(t); rb_ = 0.f; \
        if (kb_ < cur.P0) { if (need_sel) rb_ = (((sel >> (kb_ >> 8)) & 1u) == 0u) ? -__builtin_inff() : 0.f; } \
        else if (kb_ + KVBLK - 1 > qlo) mask_tile(P0_, P1_, qm - kb_); } while (0)
#define SEAM_K0() do { VMWN(8); SWRITE_HK(0); SBAR(); } while (0)
    f32x16 pA0, pA1, pB0, pB1; float mnA, mnB, alA, alB, rb_ = 0.f; bf16x8 pa0, pa1, pa2, pa3;
    SWRITE_HV(0); SBAR();
    SLOAD_H(Kh, Vh, KBASE(1));
    SBAR(); qkt<0>(pA0, pA1, K_lds, r32, hi, S.qr);
    MASKT(pA0, pA1, 0); partialSM(pA0, pA1, m_reg, mnA, alA, rb_);
    VMW(); SWRITE_H(1);
    __syncthreads();
#define HALF_STEP(PX0, PX1, mnX, alX, PY0, PY1, alY, t, KB, VB, SB) do {                                                      \
        SBAR(); qkt<KB>(PX0, PX1, K_lds, r32, hi, S.qr);                                                                       \
        finishSM(PY0, PY1, alY, l_reg, pa0, pa1, pa2, pa3); SBAR();                                                           \
        if ((t) + 1 < NT) { SLOAD_H(Kh, Vh, KBASE((t) + 1)); SBAR(); }                                                        \
        pv_tile<VB>(o, vb0, pa0, pa1, pa2, pa3); MASKT(PX0, PX1, (t)); partialSM(PX0, PX1, m_reg, mnX, alX, rb_);                  \
        __syncthreads();                                                                                                      \
        if ((t) + 1 < NT) { VMW(); SWRITE_H(SB); }                                                                            \
        RESC(alX); __syncthreads(); } while (0)
    for (int t = 1; t + 1 < NT; t += 2) {
        HALF_STEP(pB0, pB1, mnB, alB, pA0, pA1, alA, t, 1, 0, 0);
        HALF_STEP(pA0, pA1, mnA, alA, pB0, pB1, alB, t + 1, 0, 1, 1);
    }
    SBAR(); qkt<1>(pB0, pB1, K_lds, r32, hi, S.qr); SBAR();
    SLOAD_H(nxt.K, nxt.V, 0); SBAR();
#pragma unroll
    for (int d0 = 0; d0 < 8; ++d0) S.qr[d0] = load8(nxt.Q + (size_t)(wid * QBLK + r32) * D + d0 * 16 + hi * 8);
    SBAR();
    finishSM(pA0, pA1, alA, l_reg, pa0, pa1, pa2, pa3); SBAR();
    pv_tile<0>(o, vb0, pa0, pa1, pa2, pa3);
    MASKT(pB0, pB1, NT - 1); partialSM(pB0, pB1, m_reg, mnB, alB, rb_); __syncthreads(); RESC(alB);
    finishSM(pB0, pB1, alB, l_reg, pa0, pa1, pa2, pa3); SBAR(); pv_tile<1>(o, vb0, pa0, pa1, pa2, pa3);
    SBAR(); SEAM_K0();
    if (hi == 0) li_l[r32] = l_reg; asm volatile("s_waitcnt lgkmcnt(0)" ::: "memory");
    bf16_t* Ow = cur.O + (size_t)(wid * QBLK) * DM; const bf16_t* Gw = cur.Gt + (size_t)(wid * QBLK) * DM + r32;
    bf16_t gl[16][4];
#pragma unroll
    for (int r = 0; r < 16; ++r)
#pragma unroll
        for (int d0 = 0; d0 < 4; ++d0) gl[r][d0] = Gw[(size_t)crow(r, hi) * DM + d0 * 32];
#pragma unroll
    for (int r = 0; r < 16; ++r) { const int orow = crow(r, hi); const float rl = __builtin_amdgcn_rcpf(li_l[orow]);
#pragma unroll
        for (int d0 = 0; d0 < 4; ++d0) { const float gv = bf1(gl[r][d0]);
            const float v = o[d0][r] * rl * gv;
            const float vn = __shfl_xor(v, 1);
            if ((r32 & 1) == 0) *(unsigned*)(Ow + (size_t)orow * DM + d0 * 32 + r32) = cvt_pk_bf16(v, vn); } }
    __syncthreads();
#undef RESC
#undef KBASE
#undef MASKT
#undef SEAM_K0
#undef HALF_STEP
}
#undef ROW
#undef VMW
#undef VMWN
#undef SLOAD_H
#undef SWRITE_HK
#undef SWRITE_HV
#undef SWRITE_H

__device__ __forceinline__ BlockRef mk_ref(int L, int pass, const bf16_t* Q, const bf16_t* K, const bf16_t* V, bf16_t* O, const bf16_t* Gt, const float* KM) {
    const int bh = L >> 2, x = L & 3, qb = pass ? 7 - x : x, b = bh >> 3, h = bh & 7;
    BlockRef r;
    r.Q = Q + ((size_t)bh * SEQ + (size_t)qb * QB) * D; r.K = K + (size_t)bh * SEQ * D; r.V = V + (size_t)bh * SEQ * D;
    r.O = O + ((size_t)b * SEQ + (size_t)qb * QB) * DM + h * DH; r.Gt = Gt + ((size_t)b * SEQ + (size_t)qb * QB) * DM + h * DH;
    r.KM = KM + (size_t)bh * 8 * D; r.P0 = qb * QB;
    return r;
}
__device__ __forceinline__ void attn_phase(char* lds, const bf16_t* Q, const bf16_t* K, const bf16_t* V, bf16_t* O, const bf16_t* Gt, const float* KM, int wv) {
    const int total = NB * NH * 4, stride = gridDim.x;
    int L = opq_bid(); if (L >= total) return;
    if (stride == 256) { const int xcd = L & 7, j = L >> 3; L = ((xcd * 8 + (j >> 2)) << 2) | (j & 3); }
    int pass = 0;
    BlockRef cur = mk_ref(L, 0, Q, K, V, O, Gt, KM);
    Seam S;
    moba_prime(cur, lds, S, wv);
    for (;;) {
        const bool more_pass = pass == 0, more_item = L + stride < total, last = !more_pass && !more_item;
        int passn = pass + 1, Ln = L;
        if (!more_pass) { passn = 0; Ln = more_item ? L + stride : L; }
        const BlockRef nxt = last ? cur : mk_ref(Ln, passn, Q, K, V, O, Gt, KM);
        moba_block(cur, nxt, lds, S, wv);
        if (last) break;
        cur = nxt; pass = passn; L = Ln;
    }
}
}

#ifndef REP_MASK
#define REP_MASK 0
#endif
#ifndef BAR_REP
#define BAR_REP 1
#endif
struct Args { const float* in[21]; float* out; unsigned char* ws; int ph_lo, ph_hi; };
typedef const __attribute__((address_space(4))) Args* ArgsP;
#define AIN(i) ((const float*)ap->in[i])

__device__ __forceinline__ void transpose_item(const float* W, int ldw, bf16_t* WT, int ldt, LAS float* scr, int lane) {
    float tv[32];
#pragma unroll
    for (int i = 0; i < 32; ++i) { const int kk = 2 * i + (lane >> 5); tv[i] = __builtin_nontemporal_load(W + (size_t)kk * ldw + (lane & 31)); }
#pragma unroll
    for (int i = 0; i < 32; ++i) { const int kk = 2 * i + (lane >> 5); scr[kk * 33 + (lane & 31)] = tv[i]; }
    asm volatile("s_waitcnt lgkmcnt(0)" ::: "memory");
    const int c = lane & 7;
#pragma unroll
    for (int j = 0; j < 4; ++j) { const int n = (lane >> 3) + 8 * j; const LAS float* s = scr + (8 * c) * 33 + n;
        u32x4 o; o.x = cvt_pk_bf16(s[0 * 33], s[1 * 33]); o.y = cvt_pk_bf16(s[2 * 33], s[3 * 33]); o.z = cvt_pk_bf16(s[4 * 33], s[5 * 33]); o.w = cvt_pk_bf16(s[6 * 33], s[7 * 33]);
        *(u32x4*)(WT + (size_t)n * ldt + 8 * c) = o; }
    asm volatile("s_waitcnt lgkmcnt(0)" ::: "memory");
}
__device__ __forceinline__ void transpose_mat(const float* W, int K, int N, bf16_t* WT, int item, LAS float* scr, int lane) {
    const int nblk = N / 32, kb = item / nblk, nb = item % nblk;
    transpose_item(W + (size_t)(64 * kb) * N + 32 * nb, N, WT + (size_t)(32 * nb) * K + 64 * kb, K, scr, lane);
}

template <bool SILU>
__device__ __forceinline__ void gemv_item(const float* vec, int vld, const float* W, int ldw, int n0, int k0, float* out, int old, const float* bias, LAS float* scr, int lane) {
    const float* wp = W + (size_t)k0 * ldw + n0 + lane;
#pragma unroll
    for (int i = 0; i < 8; ++i) { const int idx = i * 64 + lane, b = idx >> 6, kk = idx & 63; const float v = vec[(size_t)b * vld + k0 + kk]; scr[kk * 8 + b] = SILU ? fsilu(v) : v; }
    asm volatile("s_waitcnt lgkmcnt(0)" ::: "memory");
    float acc[8];
#pragma unroll
    for (int b = 0; b < 8; ++b) acc[b] = 0.f;
#pragma unroll 1
    for (int kh = 0; kh < 64; kh += 32) {
        float w[32];
#pragma unroll
        for (int kk = 0; kk < 32; ++kk) w[kk] = SILU ? __builtin_nontemporal_load(wp + (size_t)(kh + kk) * ldw) : wp[(size_t)(kh + kk) * ldw];
#pragma unroll
        for (int kk = 0; kk < 32; ++kk) {
            const f32x4 c0 = *(const LAS f32x4*)(scr + (kh + kk) * 8), c1 = *(const LAS f32x4*)(scr + (kh + kk) * 8 + 4);
            acc[0] += w[kk] * c0[0]; acc[1] += w[kk] * c0[1]; acc[2] += w[kk] * c0[2]; acc[3] += w[kk] * c0[3];
            acc[4] += w[kk] * c1[0]; acc[5] += w[kk] * c1[1]; acc[6] += w[kk] * c1[2]; acc[7] += w[kk] * c1[3];
            if ((kk & 3) == 3) __builtin_amdgcn_sched_barrier(0); }
    }
    const float bv = bias ? bias[n0 + lane] : 0.f;
#pragma unroll
    for (int b = 0; b < 8; ++b) atomicAdd(out + (size_t)b * old + n0 + lane, acc[b] + bv);
    asm volatile("s_waitcnt lgkmcnt(0)" ::: "memory");
}
__device__ __forceinline__ void prep0_phase(ArgsP ap, LAS unsigned char* lds, int wave, int lane) {
    unsigned char* ws = (unsigned char*)ap->ws;
    LAS float* scr = (LAS float*)(lds + wave * 16384);
    const int gw = opq_bid() * NWAVES + wave, NGW = gridDim.x * NWAVES;
    for (int r = gw; r < (MODV_LD / 64) * 16; r += NGW) {
        const int cgp = r >> 4, kc = r & 15;
        const float* W; int ldw, n0; const float* bias;
        if (cgp < 192) { const int l = cgp / 48; n0 = (cgp % 48) * 64; W = AIN(2) + (size_t)l * DM * 3 * DM; ldw = 3 * DM; bias = AIN(3) + l * 3 * DM; }
        else { n0 = (cgp - 192) * 64; W = AIN(15); ldw = 2 * DM; bias = AIN(16); }
        gemv_item<true>(AIN(1), DM, W, ldw, n0, kc * 64, (float*)(ws + WS_MODV) + (cgp * 64 - n0), MODV_LD, kc == 0 ? bias : nullptr, scr, lane);
    }
}
__device__ __forceinline__ void prep1_phase(ArgsP ap, LAS unsigned char* lds, int wave, int lane) {
    unsigned char* ws = (unsigned char*)ap->ws;
    LAS float* scr = (LAS float*)(lds + wave * 16384);
    const int gw = opq_bid() * NWAVES + wave, NGW = gridDim.x * NWAVES;
    constexpr int I_BIG = (DM / 64) * (2 * DM / 32);
    constexpr int I_SQ = (DM / 64) * (DM / 32);
    constexpr int I_G = (256 / 64) * (256 / 32);
    constexpr int N_T = 2 * I_BIG + 2 * I_SQ + 2 * I_BIG + I_BIG + 2 * I_SQ + 16 * I_G;
    constexpr int N_GEMV = 4 * 32 * 16;
    for (int it = gw; it < N_T + N_GEMV; it += NGW) {
        int r = it;
        if (r < N_GEMV) {
            const int slot = r >> 9, q = r & 511, cgp = q >> 4, kc = q & 15;
            const size_t woff = slot == 0 ? (size_t)DM * 2 * DM : slot == 3 ? (size_t)DM * 2 * DM : 0;
            const float* W = (slot == 0 ? AIN(5) : slot == 2 ? AIN(17) : AIN(18)) + woff;
            const int shcol = slot == 0 ? 1 * 3 * DM : slot == 1 ? 2 * 3 * DM : slot == 2 ? 4 * 3 * DM : 3 * 3 * DM;
            gemv_item<false>((const float*)(ws + WS_MODV) + shcol, MODV_LD, W, 2 * DM, cgp * 64, kc * 64, (float*)(ws + WS_SHW) + (size_t)slot * 8 * 2 * DM, 2 * DM, nullptr, scr, lane);
            continue;
        } r -= N_GEMV;
        const float* W; bf16_t* WT; int ldw, ldt;
        if (r < 6 * I_BIG + 0 * I_SQ && r < 2 * I_BIG) { const int l = r / I_BIG, item = r % I_BIG, kb = item / 64, nb = item % 64;
            W = AIN(5) + (size_t)l * DM * 2 * DM + (size_t)(64 * kb) * 2 * DM + 32 * nb; ldw = 2 * DM; WT = (bf16_t*)(ws + WS_WIN) + (size_t)l * 2 * DM * DM + (size_t)(32 * nb) * DM + 64 * kb; ldt = DM; }
        else if ((r -= 2 * I_BIG) < 2 * I_SQ) { const int l = r / I_SQ, item = r % I_SQ, kb = item / 32, nb = item % 32;
            W = AIN(13) + (size_t)l * DM * DM + (size_t)(64 * kb) * DM + 32 * nb; ldw = DM; WT = (bf16_t*)(ws + WS_WOUT) + (size_t)l * DM * DM + (size_t)(32 * nb) * DM + 64 * kb; ldt = DM; }
        else if ((r -= 2 * I_SQ) < 2 * I_BIG) { const int l = r / I_BIG, item = r % I_BIG, kb = item / 64, nb = item % 64;
            W = AIN(18) + (size_t)l * DM * 2 * DM + (size_t)(64 * kb) * 2 * DM + 32 * nb; ldw = 2 * DM; WT = (bf16_t*)(ws + (l ? WS_ATTIN1 : WS_ATTIN0)) + (size_t)(32 * nb) * DM + 64 * kb; ldt = DM; }
        else if ((r -= 2 * I_BIG) < I_BIG) { const int kb = r / 64, nb = r % 64;
            W = AIN(17) + (size_t)(64 * kb) * 2 * DM + 32 * nb; ldw = 2 * DM; WT = (bf16_t*)(ws + WS_WKV) + (size_t)(32 * nb) * DM + 64 * kb; ldt = DM; }
        else if ((r -= I_BIG) < 2 * I_SQ) { const int l = r / I_SQ, item = r % I_SQ, kb = item / 32, nb = item % 32;
            W = AIN(19) + (size_t)l * DM * DM + (size_t)(64 * kb) * DM + 32 * nb; ldw = DM; WT = (bf16_t*)(ws + WS_ATTOUT) + (size_t)l * DM * DM + (size_t)(32 * nb) * DM + 64 * kb; ldt = DM; }
        else { r -= 2 * I_SQ;
            const int mat = r / I_G, item = r % I_G, which = mat >> 3, lh = mat & 7;
            const int kb = item / 8, nb = item % 8, n0 = 32 * nb, drow = 256 * (n0 >> 7) + 128 * which + (n0 & 127);
            W = (which ? AIN(10) : AIN(8)) + (size_t)lh * 256 * 256 + (size_t)(64 * kb) * 256 + n0; ldw = 256;
            WT = (bf16_t*)(ws + WS_WG) + (size_t)lh * 512 * 256 + (size_t)drow * 256 + 64 * kb; ldt = 256; }
        transpose_item(W, ldw, WT, ldt, scr, lane);
    }
}

__device__ __forceinline__ void norm_phase(const float* xin, bf16_t* o1, const float* g1, const float* modv, int sh1, int sc1c,
                                            bf16_t* o2, const float* g2, int sh2, int sc2c, int wave, int lane) {
    const int gw = opq_bid() * NWAVES + wave, NGW = gridDim.x * NWAVES;
    for (int rb = gw; rb < MTOK / 8; rb += NGW) {
        const int cb_ = rb >> 3, r0 = (NGW == 2048) ? ((cb_ & 7) * SEQ + (cb_ >> 3) * 64 + (rb & 7) * 8) : rb * 8, b = r0 / SEQ;
        const float* mv = modv + (size_t)b * MODV_LD;
        f32x4 gs1[4], sf1[4], gs2[4], sf2[4];
#pragma unroll
        for (int j = 0; j < 4; ++j) { const int idx = 4 * lane + 256 * j;
            const f32x4 gv = *(const f32x4*)(g1 + idx), sc = *(const f32x4*)(mv + sc1c + idx); gs1[j] = gv * (sc + 1.f); sf1[j] = *(const f32x4*)(mv + sh1 + idx);
            if (o2) { const f32x4 gv2 = *(const f32x4*)(g2 + idx), sc2 = *(const f32x4*)(mv + sc2c + idx); gs2[j] = gv2 * (sc2 + 1.f); sf2[j] = *(const f32x4*)(mv + sh2 + idx); }
            else { gs2[j] = gs1[j]; sf2[j] = sf1[j]; } }
        for (int rr = 0; rr < 8; ++rr) {
            const size_t row = (size_t)(r0 + rr);
            const f32x4* xr = (const f32x4*)(xin + row * DM) + lane;
            f32x4 v[4]; float s = 0.f;
#pragma unroll
            for (int j = 0; j < 4; ++j) { v[j] = xr[64 * j]; s += (v[j].x * v[j].x + v[j].y * v[j].y) + (v[j].z * v[j].z + v[j].w * v[j].w); }
            const float rstd = 1.f / sqrtf(wave_sum(s) * (1.f / DM) + EPS);
#pragma unroll
            for (int j = 0; j < 4; ++j) { const f32x4 t = v[j] * rstd; const f32x4 y = t * gs1[j] + sf1[j];
                u32x2 w; w.x = cvt_pk_bf16(y.x, y.y); w.y = cvt_pk_bf16(y.z, y.w);
                *((u32x2*)(o1 + row * DM) + lane + 64 * j) = w;
                if (o2) { const f32x4 y2 = t * gs2[j] + sf2[j]; u32x2 w2; w2.x = cvt_pk_bf16(y2.x, y2.y); w2.y = cvt_pk_bf16(y2.z, y2.w);
                    *((u32x2*)(o2 + row * DM) + lane + 64 * j) = w2; } }
        }
    }
}
__device__ __forceinline__ void conv_phase(const bf16_t* UP, bf16_t* U, const float* cw, const float* cb, int tid) {
    const int ch = 8 * (tid & 127), sub = tid >> 7;
    float w0[8], w1[8], w2[8], w3[8], bb[8];
#pragma unroll
    for (int h = 0; h < 2; ++h) { const f32x4 a = *(const f32x4*)(cw + ch + 4 * h), b = *(const f32x4*)(cw + DM + ch + 4 * h), c = *(const f32x4*)(cw + 2 * DM + ch + 4 * h), d = *(const f32x4*)(cw + 3 * DM + ch + 4 * h), e = *(const f32x4*)(cb + ch + 4 * h);
#pragma unroll
        for (int j = 0; j < 4; ++j) { w0[4 * h + j] = a[j]; w1[4 * h + j] = b[j]; w2[4 * h + j] = c[j]; w3[4 * h + j] = d[j]; bb[4 * h + j] = e[j]; } }
    for (int it = opq_bid(); it < NB * 32; it += gridDim.x) {
        const int b = it >> 5, c = it & 31, t0 = c * 64 + sub * 16; const size_t base = ((size_t)b * SEQ + t0) * DM + ch;
        u32x4 rw[19];
#pragma unroll
        for (int t = 0; t < 19; ++t) rw[t] = (t0 + t - 3 >= 0) ? *(const u32x4*)(UP + base + (ptrdiff_t)(t - 3) * DM) : (u32x4){0u, 0u, 0u, 0u};
#pragma unroll
        for (int t = 0; t < 16; ++t) {
            unsigned ow[4];
#pragma unroll
            for (int q = 0; q < 4; ++q) { const unsigned a0 = rw[t][q], a1 = rw[t + 1][q], a2 = rw[t + 2][q], a3 = rw[t + 3][q];
                const float lo = bb[2 * q] + w0[2 * q] * bf_lo(a0) + w1[2 * q] * bf_lo(a1) + w2[2 * q] * bf_lo(a2) + w3[2 * q] * bf_lo(a3);
                const float hi = bb[2 * q + 1] + w0[2 * q + 1] * bf_hi(a0) + w1[2 * q + 1] * bf_hi(a1) + w2[2 * q + 1] * bf_hi(a2) + w3[2 * q + 1] * bf_hi(a3);
                ow[q] = cvt_pk_bf16(lo, hi); }
            *(u32x4*)(U + base + (size_t)t * DM) = (u32x4){ow[0], ow[1], ow[2], ow[3]}; }
    }
}

#define XB_TMO      128
#define XB_XCNT(j)  (256  + 64 * (j))
#define XB_XSUB(j)  (1280 + 64 * (j))
#define XB_XGEN(j)  (2304 + 64 * (j))
#define XB_TOP      3328
#define XB_TOPGEN   3392
#define XCD_BAR_WORDS 3456
#define XB_SPIN_CAP (1u << 18)
constexpr size_t WS_BAR = 16384;
constexpr int LDS_MISC = 131072 + 320;
__device__ __forceinline__ unsigned xb_ld(unsigned* p)              { return __hip_atomic_load(p, __ATOMIC_RELAXED, __HIP_MEMORY_SCOPE_AGENT); }
__device__ __forceinline__ unsigned xb_add(unsigned* p, unsigned v) { return __hip_atomic_fetch_add(p, v, __ATOMIC_RELAXED, __HIP_MEMORY_SCOPE_AGENT); }
__device__ __forceinline__ unsigned xb_xcc_id() { return (unsigned)__builtin_amdgcn_s_getreg((3 << 11) | 20) & 0xFu; }
#define XB_SPIN(cond, bar) do { unsigned _sp = 0; while (cond) { __builtin_amdgcn_s_sleep(1); \
    if ((++_sp & 255u) == 0u) { if (xb_ld(&(bar)[XB_TMO])) break; if (_sp > XB_SPIN_CAP) { atomicAdd(&(bar)[XB_TMO], 1u); break; } } } } while (0)
__device__ __forceinline__ void xcd_barrier_complete(unsigned* bar, unsigned x, unsigned& nloc, unsigned& nx) {
    const unsigned G = gridDim.x * gridDim.y * gridDim.z;
    unsigned sum, cnt, mine, sp = 0u;
    for (;;) {
        sum = 0u; cnt = 0u; mine = 0u;
#pragma unroll
        for (unsigned j = 0; j < 16; ++j) { const unsigned c = xb_ld(&bar[XB_XCNT(j)]); sum += c; cnt += (c > 0u) ? 1u : 0u; mine = (j == x) ? c : mine; }
        if (sum == G) break;
        __builtin_amdgcn_s_sleep(1);
        if ((++sp & 255u) == 0u) { if (xb_ld(&bar[XB_TMO])) break; if (sp > XB_SPIN_CAP) { atomicAdd(&bar[XB_TMO], 1u); break; } }
    }
    nloc = mine > 0u ? mine : 1u; nx = cnt > 0u ? cnt : 1u;
}
__device__ __forceinline__ void xcd_barrier(unsigned* bar, volatile LAS unsigned* st, int tid) {
    asm volatile("s_waitcnt vmcnt(0)" ::: "memory");
    __syncthreads();
    if (tid == 0) {
        const unsigned x = xb_xcc_id();
        __builtin_amdgcn_s_waitcnt(0);
        unsigned nloc = st[0], nx = st[1];
        if (nloc == 0u) { xcd_barrier_complete(bar, x, nloc, nx); st[0] = nloc; st[1] = nx; }
        const unsigned old = xb_add(&bar[XB_XSUB(x)], 1u);
        const unsigned gen = old / nloc;
        if (old + 1u == (gen + 1u) * nloc) {
            __builtin_amdgcn_fence(__ATOMIC_RELEASE, "agent");
            asm volatile("s_waitcnt vmcnt(0)" ::: "memory");
            const unsigned og = xb_add(&bar[XB_TOP], 1u);
            const unsigned tg = og / nx;
            if (og + 1u == (tg + 1u) * nx) xb_add(&bar[XB_TOPGEN], 1u);
            else XB_SPIN(xb_ld(&bar[XB_TOPGEN]) == tg, bar);
            __builtin_amdgcn_fence(__ATOMIC_ACQUIRE, "agent");
            xb_add(&bar[XB_XGEN(x)], 1u);
            asm volatile("s_waitcnt vmcnt(0)" ::: "memory");
        } else {
            XB_SPIN(xb_ld(&bar[XB_XGEN(x)]) == gen, bar);
            __builtin_amdgcn_fence(__ATOMIC_ACQUIRE, "agent");
            asm volatile("s_waitcnt vmcnt(0)" ::: "memory");
        }
    }
    __syncthreads();
}

constexpr int NPHASE = 14;
#ifndef PH_EN
#define PH_EN 0xFFFF
#endif
#define EN(b) ((PH_EN >> (b)) & 1)
#ifndef REP_MASK
#define REP_MASK 0
#endif
#define REPS(b) for (int rep_ = 0; rep_ < EN(b) * (1 + ((REP_MASK >> (b)) & 1)); ++rep_)
template <int ph>
__device__ __forceinline__ void run_phase(unsigned char* lds, int wv) {
    LAS unsigned char* ldsl = (LAS unsigned char*)lds;
    {
        ArgsP ap = (ArgsP)__builtin_amdgcn_kernarg_segment_ptr();
        asm volatile("" : "+s"(ap));
        const int G = gridDim.x;
        unsigned char* ws = (unsigned char*)ap->ws;
        float* modv = (float*)(ws + WS_MODV);
        float* kmean = (float*)(ws + WS_KMEAN);
        bf16_t* HN = (bf16_t*)(ws + WS_HN); bf16_t* HKV = (bf16_t*)(ws + WS_HKV); bf16_t* UPRE = (bf16_t*)(ws + WS_UPRE); bf16_t* GB = (bf16_t*)(ws + WS_G);
        bf16_t* LAb = (bf16_t*)(ws + WS_LA); bf16_t* BINb = (bf16_t*)(ws + WS_BIN);
        float* xw = (float*)ap->out;
        const int tid = opq_tid(wv), c = opq_bid();
        const int lane = tid & 63, wave = __builtin_amdgcn_readfirstlane(tid >> 6);
        float* sumsq = (float*)(ws + WS_SUMSQ); const float* shw = (const float*)(ws + WS_SHW);
        if (ph == 0) {
            if (EN(0)) prep0_phase(ap, ldsl, wave, lane);
        } else if (ph == 1) {
            REPS(1) norm_phase(AIN(0), HN, AIN(4), modv, 0, DM, nullptr, nullptr, 0, 0, wave, lane);
            if (EN(0)) prep1_phase(ap, ldsl, wave, lane);
        } else if (ph <= 7) {
            const int l = (ph - 2) / 3, k3 = (ph - 2) % 3, k = k3 == 0 ? 0 : k3 + 1;
            const float* xin = (l == 0) ? AIN(0) : xw;
            if (k == 0) {
                pg8::Gemm g{l == 0 ? HN : HKV, (const bf16_t*)(ws + WS_WIN) + (size_t)l * 2 * DM * DM, DM, DM, DM, 0, 0};
                int one = 1; asm volatile("" : "+s"(one));
                { pg8::InOrder S{c, one, 0};
                  pg8::EpiSplitConv E{ws, l == 0 ? nullptr : sumsq, shw, AIN(6) + l * 4 * DM, AIN(7) + l * DM, 4u * (unsigned)(l + 1), ldsl};
                  REPS(2) pg8::gemm_phase(ldsl, g, S, E, wv); }
                { pg8::InOrder S{c, one, 1};
                  pg8::EpiSplit E{UPRE, GB, l == 0 ? nullptr : sumsq, shw};
                  REPS(2) pg8::gemm_phase(ldsl, g, S, E, wv); }
            } else if (k == 1) {
                REPS(3) conv_phase(UPRE, HKV, AIN(6) + l * 4 * DM, AIN(7) + l * DM, tid);
            } else if (k == 2) {
                pg8::Gemm g{UPRE, (const bf16_t*)(ws + WS_WG) + (size_t)l * 4 * 512 * 256, DM, 256, 256, 256 * 2, 512 * 256 * 2};
                int two = 2; asm volatile("" : "+s"(two));
                pg8::GatesOrder S{c, two};
                pg8::EpiGatesS E{ws, 4u * (unsigned)(l + 1), AIN(9) + l * DM, AIN(11) + l * DM, AIN(12) + l * DM, ldsl};
                REPS(4) pg8::gemm_phase(ldsl, g, S, E, wv);
            } else {
                pg8::Gemm g{HN, (const bf16_t*)(ws + WS_WOUT) + (size_t)l * DM * DM, DM, DM, DM, 0, 0};
                pg8::MultiOrder S; S.init(MTOK, DM, 1, G, c);
                _Float16* x16 = (_Float16*)(ws + WS_X16);
                if (l == 0) { pg8::EpiResH<float, false> E{AIN(0), x16, modv + 2 * DM, modv, HKV, AIN(4) + DM, 3 * DM + DM, nullptr, nullptr, 0, sumsq};
                    REPS(7) pg8::gemm_phase(ldsl, g, S, E, wv); }
                else { pg8::EpiResH<_Float16, true> E{x16, x16, modv + l * 3 * DM + 2 * DM, modv, HKV, AIN(4) + (l + 1) * DM, (l + 1) * 3 * DM + DM,
                              LAb, AIN(14), 4 * 3 * DM + DM, sumsq + (size_t)l * MTOK};
                    REPS(7) pg8::gemm_phase(ldsl, g, S, E, wv); }
            }
        } else if (ph <= 13) {
            const int i = (ph - 8) / 3, k = (ph - 8) % 3, l = 2 + i;
            if (k == 0) {
                pg8::Gemm g{i == 0 ? HKV : LAb, (const bf16_t*)(ws + (i == 0 ? WS_ATTIN0 : WS_ATTIN1)), DM, DM, DM, (long)(WS_LA - WS_HKV), (long)(WS_WKV - WS_ATTIN0)};
                pg8::MultiOrder S; S.init(MTOK, 2 * DM, i == 0 ? 2 : 1, G, c);
                pg8::EpiQKV E{ws, kmean, sumsq + (size_t)(1 + i) * MTOK, shw + (size_t)(i == 0 ? 1 : 3) * 8 * 2 * DM, 8 * 2 * DM};
                REPS(9) pg8::gemm_phase(ldsl, g, S, E, wv);
            } else if (k == 1) {
                REPS(10) att::attn_phase((char*)lds, UPRE, HN, BINb, HKV, GB, kmean, wv);
            } else if (i == 0) {
                pg8::Gemm g{HKV, (const bf16_t*)(ws + WS_ATTOUT), DM, DM, DM, 0, 0};
                pg8::MultiOrder S; S.init(MTOK, DM, 1, G, c);
                _Float16* x16 = (_Float16*)(ws + WS_X16);
                pg8::EpiResH<_Float16, false> E{x16, x16, modv + l * 3 * DM + 2 * DM, modv, LAb, AIN(4) + 3 * DM, 3 * 3 * DM + DM, nullptr, nullptr, 0, sumsq + (size_t)2 * MTOK};
                REPS(11) pg8::gemm_phase(ldsl, g, S, E, wv);
            } else {
                pg8::Gemm g{HKV, (const bf16_t*)(ws + WS_ATTOUT) + (size_t)DM * DM, DM, DM, DM, 0, 0};
                pg8::MultiOrder S; S.init(MTOK, DM, 1, G, c);
                pg8::EpiFinal E{(const _Float16*)(ws + WS_X16), xw, modv + l * 3 * DM + 2 * DM, AIN(20), sumsq + (size_t)3 * MTOK, (unsigned*)(ws + WS_PCNT)};
                REPS(12) pg8::gemm_phase(ldsl, g, S, E, wv);
            }
        }
    }
}
__global__ void __launch_bounds__(NTHR, 2) yoco_fwd(Args a_) {
    extern __shared__ __attribute__((aligned(16))) unsigned char lds[];
    const int ph_lo = a_.ph_lo, ph_hi = a_.ph_hi;
    const int wv = __builtin_amdgcn_readfirstlane((int)threadIdx.x >> 6);
    if (ph_hi - ph_lo > 1) {
        if (threadIdx.x < 8) ((volatile LAS unsigned*)((LAS unsigned char*)lds + LDS_MISC))[threadIdx.x] = 0u;
        if (threadIdx.x == 0) (void)xb_add(&((unsigned*)(a_.ws + WS_BAR))[XB_XCNT(xb_xcc_id())], 1u);
        __syncthreads();
    }
#define SEAM(P) do { ArgsP ap_ = (ArgsP)__builtin_amdgcn_kernarg_segment_ptr(); asm volatile("" : "+s"(ap_)); \
        xcd_barrier((unsigned*)((unsigned char*)ap_->ws + WS_BAR), (volatile LAS unsigned*)((LAS unsigned char*)lds + LDS_MISC), opq_tid(wv)); } while (0)
#ifndef TPROBE_MASK
#define TPROBE_MASK 0
#endif
#define TPROBE_MULT 10
#define TP_ON(P) ((TPROBE_MASK >> (P)) & 1)
#define TP_BEGIN(P) if (TP_ON(P) && blockIdx.x == 0 && opq_tid(wv) == 0) { volatile LAS unsigned long long* tw_ = (volatile LAS unsigned long long*)((LAS unsigned char*)lds + LDS_MISC + 16); tw_[1] = __builtin_amdgcn_s_memrealtime(); }
#define TP_END(P) if (TP_ON(P) && blockIdx.x == 0 && opq_tid(wv) == 0) { volatile LAS unsigned long long* tw_ = (volatile LAS unsigned long long*)((LAS unsigned char*)lds + LDS_MISC + 16); tw_[0] = tw_[0] + (__builtin_amdgcn_s_memrealtime() - tw_[1]); }
#define RUN(P) if ((P) >= ph_lo && (P) < ph_hi) { TP_BEGIN(P) run_phase<P>(lds, wv); if ((P) + 1 < ph_hi) { for (int br_ = 0; br_ < BAR_REP; ++br_) SEAM(P); } TP_END(P) }
    RUN(0) RUN(1) RUN(2) RUN(3) RUN(4) RUN(5) RUN(6) RUN(7) RUN(8) RUN(9) RUN(10) RUN(11)
    RUN(12) RUN(13)
#undef RUN
#undef SEAM
    if (TPROBE_MASK != 0 && blockIdx.x == 0 && opq_tid(wv) == 0) {
        volatile LAS unsigned long long* tw_ = (volatile LAS unsigned long long*)((LAS unsigned char*)lds + LDS_MISC + 16);
        const unsigned long long span = tw_[0] * TPROBE_MULT, t0 = __builtin_amdgcn_s_memrealtime();
        while (__builtin_amdgcn_s_memrealtime() - t0 < span) __builtin_amdgcn_s_sleep(8);
    }
}

extern "C" void kernel_launch(void* const* d_in, const int* in_sizes, int n_in, void* d_out, int out_size, void* d_ws, size_t ws_size, hipStream_t stream) {
    static int grid = 0;
    if (grid == 0) {
        if (n_in != 21 || out_size != MTOK * DM || ws_size < WS_END) { fprintf(stderr, "kernel_launch: unexpected shapes (n_in %d out %d ws %zu)\n", n_in, out_size, ws_size); grid = -1; return; }
        int dev = 0, cus = 0, per_cu = 0;
        (void)hipGetDevice(&dev);
        if (hipDeviceGetAttribute(&cus, hipDeviceAttributeMultiprocessorCount, dev) != hipSuccess || cus <= 0) cus = 256;
        if (hipFuncSetAttribute((const void*)yoco_fwd, hipFuncAttributeMaxDynamicSharedMemorySize, LDS_BYTES) != hipSuccess) { fprintf(stderr, "kernel_launch: hipFuncSetAttribute failed\n"); grid = -1; return; }
        if (hipOccupancyMaxActiveBlocksPerMultiprocessor(&per_cu, (const void*)yoco_fwd, NTHR, LDS_BYTES) != hipSuccess || per_cu < 1) { fprintf(stderr, "kernel_launch: occupancy query says %d\n", per_cu); per_cu = 1; }
        (void)hipGetLastError();
        grid = cus > 256 ? 256 : cus;
    }
    if (grid < 0) return;
    (void)hipMemsetAsync((char*)d_ws + WS_CTL, 0, CTL_ZERO_BYTES, stream);
    Args a{};
    for (int i = 0; i < 21; ++i) a.in[i] = (const float*)d_in[i];
    a.out = (float*)d_out; a.ws = (unsigned char*)d_ws;
#if MK_MULTI_LAUNCH
    for (int ph = 0; ph < NPHASE; ++ph) { a.ph_lo = ph; a.ph_hi = ph + 1; hipLaunchKernelGGL(yoco_fwd, dim3(grid), dim3(NTHR), LDS_BYTES, stream, a); }
#else
    a.ph_lo = 0; a.ph_hi = NPHASE;
    void* kargs[] = {&a};
    hipError_t e = hipLaunchCooperativeKernel((const void*)yoco_fwd, dim3(grid), dim3(NTHR), kargs, LDS_BYTES, stream);
    if (e != hipSuccess) fprintf(stderr, "kernel_launch: cooperative launch failed: %s (grid %d)\n", hipGetErrorString(e), grid);
#endif
}
```

```cpp
#include <hip/hip_runtime.h>
#include <hip/hip_cooperative_groups.h>
#include <cstdio>
#include <cstdint>
namespace cg = cooperative_groups;

#ifndef MK_MULTI_LAUNCH
#define MK_MULTI_LAUNCH 0
#endif

constexpr int DM = 1024, NB = 8, SEQ = 2048, MTOK = NB * SEQ, NH = 8, DH = 128;
constexpr int MODV_LD = 14336;
constexpr float EPS = 1e-6f;
constexpr int NWAVES = 8, NTHR = 512;
constexpr int LDS_BYTES = 147456;

constexpr size_t MiB = 1u << 20;
constexpr size_t WS_CTL = 0, CTL_ZERO_BYTES = 1 * MiB + 256 * 1024;
constexpr size_t WS_MODV = 64 * 1024;
constexpr size_t WS_KMEAN = 512 * 1024;
constexpr size_t WS_GFLAG = 32 * 1024;
constexpr size_t WS_SHW = 768 * 1024;
constexpr size_t WS_PCNT = 48 * 1024;
constexpr size_t WS_CFLAG = 50 * 1024;
constexpr size_t WS_SUMSQ = 1 * MiB;
constexpr size_t WS_TA = 1 * MiB + 256 * 1024;
constexpr size_t WS_WIN = 2 * MiB;
constexpr size_t WS_WG = 10 * MiB;
constexpr size_t WS_WOUT = 12 * MiB;
constexpr size_t WS_ATTIN0 = 16 * MiB, WS_WKV = 20 * MiB, WS_ATTIN1 = 24 * MiB;
constexpr size_t WS_ATTOUT = 28 * MiB;
constexpr size_t WS_HN = 32 * MiB;
constexpr size_t WS_HKV = 64 * MiB;
constexpr size_t WS_UPRE = 96 * MiB;
constexpr size_t WS_G = 128 * MiB;
constexpr size_t WS_LA = 160 * MiB;
constexpr size_t WS_BIN = 192 * MiB;
constexpr size_t WS_X16 = 224 * MiB;
constexpr size_t WS_END = 256 * MiB;

typedef unsigned short bf16_t;
typedef short bf16x8 __attribute__((ext_vector_type(8)));
typedef short s16x4 __attribute__((ext_vector_type(4)));
typedef float f32x4 __attribute__((ext_vector_type(4)));
typedef float f32x2 __attribute__((ext_vector_type(2)));
typedef float f32x16 __attribute__((ext_vector_type(16)));
typedef unsigned u32x4 __attribute__((ext_vector_type(4)));
typedef unsigned u32x2 __attribute__((ext_vector_type(2)));
#define LAS __attribute__((address_space(3)))

__device__ __forceinline__ unsigned cvt_pk_bf16(float lo, float hi) { unsigned r; asm volatile("v_cvt_pk_bf16_f32 %0, %1, %2" : "=v"(r) : "v"(lo), "v"(hi)); return r; }
__device__ __forceinline__ float bf_lo(unsigned w) { return __uint_as_float(w << 16); }
__device__ __forceinline__ float bf_hi(unsigned w) { return __uint_as_float(w & 0xffff0000u); }
__device__ __forceinline__ float bf1(bf16_t h) { return __uint_as_float((unsigned)h << 16); }
__device__ __forceinline__ float fexp(float x) { return __builtin_amdgcn_exp2f(x * 1.4426950408889634f); }
__device__ __forceinline__ float flog(float x) { return __builtin_amdgcn_logf(x) * 0.6931471805599453f; }
__device__ __forceinline__ float fsigmoid(float x) { return __builtin_amdgcn_rcpf(1.f + fexp(-x)); }
__device__ __forceinline__ float fsilu(float x) { return x * fsigmoid(x); }
__device__ __forceinline__ int opq_tid(int wv) { int l; asm volatile("v_mbcnt_lo_u32_b32 %0, -1, 0\n\tv_mbcnt_hi_u32_b32 %0, -1, %0" : "=v"(l)); return wv * 64 + l; }
__device__ __forceinline__ int opq_bid() { int b = blockIdx.x; asm volatile("" : "+s"(b)); return b; }
__device__ __forceinline__ float wave_sum(float v) {
#pragma unroll
    for (int o = 1; o < 64; o <<= 1) v += __shfl_xor(v, o);
    return v;
}

namespace pg8 {
constexpr int BM = 256, BK = 64, HALF = 128, HTB = HALF * BK * 2, STAGE_BYTES = 8 * HTB, NXCD = 8, WGM = 8;
__host__ __device__ __forceinline__ int lds_byte(int r, int c) { const int st = (r >> 4) * 2 + (c >> 5), rr = r & 15, cc = c & 31, ob = rr * 64 + cc * 2; return st * 1024 + (ob ^ (((ob >> 9) & 1) << 5)); }
__host__ __device__ __forceinline__ void stage_rc(int b, int& R, int& C) { const int st = b / 1024, sb = b % 1024, swz = sb ^ (((sb >> 9) & 1) << 5); R = (st >> 1) * 16 + swz / 64; C = (st & 1) * 32 + (swz % 64) / 2; }
__host__ __device__ __forceinline__ int perm32(int rho) { const int n = rho >> 4, i = rho & 15; return 8 * (i >> 2) + 4 * n + (i & 3); }

struct Unit { int pm, pn, sub; };
struct Gemm { const bf16_t* A; const bf16_t* Bt; int lda, ldb, K; long a_sub, b_sub; };

struct MultiOrder {
    int nM, nN, nwg, nsub, G, c;
    __device__ void init(int M, int N, int nsub_, int G_, int c_) { nM = M / BM; nN = N / BM; nwg = nM * nN; nsub = nsub_; G = G_; c = c_; }
    __device__ bool next(int i, Unit& u) const {
        const long L = (long)i * G + c; if (L >= (long)nwg * nsub) return false;
        u.sub = (int)(L / nwg);
        int wgid = (int)(L % nwg); { const int q = nwg / NXCD, r = nwg % NXCD, xcd = wgid % NXCD, off = wgid / NXCD; wgid = (xcd < r ? xcd * (q + 1) : r * (q + 1) + (xcd - r) * q) + off; }
        const int nig = WGM * nN, gid = wgid / nig, fm = gid * WGM, gsz = (nM - fm) < WGM ? (nM - fm) : WGM;
        u.pm = fm + ((wgid % nig) % gsz); u.pn = (wgid % nig) / gsz; return true;
    }
};


template <int N> __device__ __forceinline__ float dpp_shr(float src, float ident) {
    return __int_as_float(__builtin_amdgcn_update_dpp(__float_as_int(ident), __float_as_int(src), 0x110 + N, 0xF, 0xF, false));
}
struct EpiSplit {
    static constexpr bool PERM = true, APERM = false;
    bf16_t* O0; bf16_t* O1; const float* sumsq; const float* shw;
    __device__ __forceinline__ void operator()(const f32x4 (&acc)[2][2][4][2], const Unit& u, int wr, int wc, int fr, int fq) const {
        const int row0 = u.pm * BM + wr * 64 + fr; int colt = u.pn * BM; bf16_t* base = O0;
        const int cfull = u.pn * BM + wc * 32 + 8 * fq;
        const bool gate_half = colt >= DM;
        if (gate_half) { base = O1; colt -= DM; }
        const int col0 = colt + wc * 32 + 8 * fq;
        f32x4 bv[2][2];
#pragma unroll
        for (int bj = 0; bj < 2; ++bj)
#pragma unroll
            for (int n = 0; n < 2; ++n) bv[bj][n] = sumsq ? *(const f32x4*)(shw + (size_t)(u.pm >> 3) * 2 * DM + cfull + bj * HALF + 4 * n) : (f32x4){0.f, 0.f, 0.f, 0.f};
        float ssq[2][4];
#pragma unroll
        for (int ai = 0; ai < 2; ++ai)
#pragma unroll
            for (int m = 0; m < 4; ++m) ssq[ai][m] = sumsq ? sumsq[row0 + ai * HALF + m * 16] : 0.f;
#pragma unroll
        for (int ai = 0; ai < 2; ++ai)
#pragma unroll
            for (int m = 0; m < 4; ++m) { const int row = row0 + ai * HALF + m * 16; bf16_t* rowp = base + (size_t)row * DM + col0;
                const float rs = sumsq ? __builtin_amdgcn_rsqf(ssq[ai][m] * (1.f / DM) + EPS) : 1.f;
#pragma unroll
                for (int bj = 0; bj < 2; ++bj) { f32x4 v0 = acc[ai][bj][m][0] * rs + bv[bj][0], v1 = acc[ai][bj][m][1] * rs + bv[bj][1];
                    if (gate_half) {
#pragma unroll
                        for (int j = 0; j < 4; ++j) { v0[j] = fsilu(v0[j]); v1[j] = fsilu(v1[j]); } }
                    u32x4 w; w.x = cvt_pk_bf16(v0[0], v0[1]); w.y = cvt_pk_bf16(v0[2], v0[3]); w.z = cvt_pk_bf16(v1[0], v1[1]); w.w = cvt_pk_bf16(v1[2], v1[3]);
                    *(u32x4*)(rowp + bj * HALF) = w; } }
    }
};

typedef _Float16 h16x8 __attribute__((ext_vector_type(8)));
__device__ __forceinline__ void ld8(const float* p, float (&v)[8]) { const f32x4 a = *(const f32x4*)p, b = *(const f32x4*)(p + 4); v[0] = a[0]; v[1] = a[1]; v[2] = a[2]; v[3] = a[3]; v[4] = b[0]; v[5] = b[1]; v[6] = b[2]; v[7] = b[3]; }
struct InOrder {
    int c, n, base;
    __device__ bool next(int i, Unit& u) const { if (i >= n) return false; const int j = c >> 3; int pm = (c & 7) * 8 + (j >> 2), pn = 4 * (i + base) + (j & 3), sub = 0;
        asm volatile("" : "+s"(pm), "+s"(pn), "+s"(sub)); u.pm = pm; u.pn = pn; u.sub = sub; return true; }
};
constexpr int CV_HL_OFF = 133120;
struct EpiSplitConv {
    static constexpr bool PERM = true, APERM = true;
    unsigned char* ws; const float* sumsq; const float* shw; const float* cw; const float* cb; unsigned target; LAS unsigned char* lds;
    __device__ __forceinline__ void operator()(f32x4 (&acc)[2][2][4][2], const Unit& u, int wr, int wc, int fr, int fq) const {
        const int pnl = u.pn & 3;
        const int cfull = u.pn * BM + wc * 32 + 8 * fq, ct = wc * 32 + 8 * fq, col0 = pnl * BM + ct;
        bf16_t* obase = (bf16_t*)(ws + WS_UPRE);
        f32x4 bv[2][2];
#pragma unroll
        for (int bj = 0; bj < 2; ++bj)
#pragma unroll
            for (int n = 0; n < 2; ++n) bv[bj][n] = sumsq ? *(const f32x4*)(shw + (size_t)(u.pm >> 3) * 2 * DM + cfull + bj * HALF + 4 * n) : (f32x4){0.f, 0.f, 0.f, 0.f};
        float ssq[2][4];
#pragma unroll
        for (int ai = 0; ai < 2; ++ai)
#pragma unroll
            for (int m = 0; m < 4; ++m) ssq[ai][m] = sumsq ? sumsq[u.pm * BM + ai * HALF + wr * 64 + 4 * fr + m] : 0.f;
#pragma unroll
        for (int ai = 0; ai < 2; ++ai)
#pragma unroll
            for (int m = 0; m < 4; ++m) { const float rs = sumsq ? __builtin_amdgcn_rsqf(ssq[ai][m] * (1.f / DM) + EPS) : 1.f;
#pragma unroll
                for (int bj = 0; bj < 2; ++bj) { acc[ai][bj][m][0] = acc[ai][bj][m][0] * rs + bv[bj][0]; acc[ai][bj][m][1] = acc[ai][bj][m][1] * rs + bv[bj][1]; } }
        const int tile = u.pm * 4 + pnl;
        unsigned long long* HX = (unsigned long long*)(ws + WS_BIN);
        unsigned* flags = (unsigned*)(ws + WS_CFLAG);
        LAS f32x4* HL = (LAS f32x4*)(lds + CV_HL_OFF);
#pragma unroll
        for (int ai = 0; ai < 2; ++ai)
#pragma unroll
            for (int k = 0; k < 3; ++k)
#pragma unroll
                for (int bj = 0; bj < 2; ++bj) {
                    if (fr == 15) { LAS f32x4* d = HL + (((ai * 2 + wr) * 3 + k) * 256 + bj * HALF + ct) / 4;
                        d[0] = acc[ai][bj][k + 1][0]; d[1] = acc[ai][bj][k + 1][1];
                        if (ai == 1 && wr == 1) { unsigned long long* g_ = HX + ((size_t)(tile * 3 + k) * 256 + bj * HALF + ct) / 2;
#pragma unroll
                            for (int n = 0; n < 2; ++n) { const f32x4 v = acc[1][bj][k + 1][n];
                                __hip_atomic_store(g_ + 2 * n, ((unsigned long long)__float_as_uint(v[1]) << 32) | __float_as_uint(v[0]), __ATOMIC_RELAXED, __HIP_MEMORY_SCOPE_AGENT);
                                __hip_atomic_store(g_ + 2 * n + 1, ((unsigned long long)__float_as_uint(v[3]) << 32) | __float_as_uint(v[2]), __ATOMIC_RELAXED, __HIP_MEMORY_SCOPE_AGENT); } } }
                    asm volatile("" ::: "memory"); __builtin_amdgcn_sched_barrier(0);
                }
        if (wr == 1) { asm volatile("s_waitcnt vmcnt(0)" ::: "memory");
            if (fr == 15 && fq == 0) __hip_atomic_fetch_add(flags + tile * 8, 1u, __ATOMIC_RELAXED, __HIP_MEMORY_SCOPE_AGENT); }
        asm volatile("s_waitcnt lgkmcnt(0)" ::: "memory"); __builtin_amdgcn_s_barrier(); asm volatile("" ::: "memory");
        const bool need_prev = (wr == 0) && ((u.pm & 7) != 0);
        if (need_prev) { unsigned spins = 0;
            while (__hip_atomic_load(flags + (tile - 4) * 8, __ATOMIC_RELAXED, __HIP_MEMORY_SCOPE_AGENT) < target) { __builtin_amdgcn_s_sleep(2); if (++spins > (1u << 22)) break; } }
#pragma unroll
        for (int ai = 0; ai < 2; ++ai)
#pragma unroll
            for (int bj = 0; bj < 2; ++bj)
#pragma unroll
                for (int n = 0; n < 2; ++n) {
                    f32x4 pr[3];
                    if (ai == 0 && wr == 0) {
#pragma unroll
                        for (int k = 0; k < 3; ++k) { unsigned long long wa = 0ull, wb = 0ull;
                            if (need_prev) { const unsigned long long* sp = HX + ((size_t)((tile - 4) * 3 + k) * 256 + bj * HALF + ct + 4 * n) / 2;
                                wa = __hip_atomic_load(sp, __ATOMIC_RELAXED, __HIP_MEMORY_SCOPE_AGENT); wb = __hip_atomic_load(sp + 1, __ATOMIC_RELAXED, __HIP_MEMORY_SCOPE_AGENT); }
                            pr[k] = (f32x4){__uint_as_float((unsigned)wa), __uint_as_float((unsigned)(wa >> 32)), __uint_as_float((unsigned)wb), __uint_as_float((unsigned)(wb >> 32))}; }
                    } else { const int prun = ai * 2 + wr - 1;
#pragma unroll
                        for (int k = 0; k < 3; ++k) pr[k] = HL[((prun * 3 + k) * 256 + bj * HALF + ct + 4 * n) / 4]; }
                    const int chg = pnl * BM + bj * HALF + ct + 4 * n;
                    const f32x4 w0 = *(const f32x4*)(cw + chg), w1 = *(const f32x4*)(cw + DM + chg), w2 = *(const f32x4*)(cw + 2 * DM + chg), w3 = *(const f32x4*)(cw + 3 * DM + chg), bb = *(const f32x4*)(cb + chg);
                    const f32x4 x0 = acc[ai][bj][0][n], x1 = acc[ai][bj][1][n], x2 = acc[ai][bj][2][n], x3 = acc[ai][bj][3][n];
                    f32x4 q1, q2, q3;
#pragma unroll
                    for (int j = 0; j < 4; ++j) { q1[j] = dpp_shr<1>(x3[j], pr[2][j]); q2[j] = dpp_shr<1>(x2[j], pr[1][j]); q3[j] = dpp_shr<1>(x1[j], pr[0][j]); }
                    const f32x4 y0 = bb + w0 * q3 + w1 * q2 + w2 * q1 + w3 * x0, y1 = bb + w0 * q2 + w1 * q1 + w2 * x0 + w3 * x1;
                    const f32x4 y2 = bb + w0 * q1 + w1 * x0 + w2 * x1 + w3 * x2, y3 = bb + w0 * x0 + w1 * x1 + w2 * x2 + w3 * x3;
                    bf16_t* op = obase + (size_t)(u.pm * BM + ai * HALF + wr * 64 + 4 * fr) * DM + col0 + bj * HALF + 4 * n;
                    { u32x2 w; w.x = cvt_pk_bf16(y0[0], y0[1]); w.y = cvt_pk_bf16(y0[2], y0[3]); *(u32x2*)(op) = w; }
                    { u32x2 w; w.x = cvt_pk_bf16(y1[0], y1[1]); w.y = cvt_pk_bf16(y1[2], y1[3]); *(u32x2*)(op + DM) = w; }
                    { u32x2 w; w.x = cvt_pk_bf16(y2[0], y2[1]); w.y = cvt_pk_bf16(y2[2], y2[3]); *(u32x2*)(op + 2 * DM) = w; }
                    { u32x2 w; w.x = cvt_pk_bf16(y3[0], y3[1]); w.y = cvt_pk_bf16(y3[2], y3[3]); *(u32x2*)(op + 3 * DM) = w; }
                    asm volatile("" ::: "memory"); __builtin_amdgcn_sched_barrier(0);
                }
    }
};

template <class TIn, bool HAS_A2>
struct EpiResH {
    static constexpr bool PERM = true, APERM = false;
    const TIn* xin; _Float16* xo; const float* gate; const float* modv; bf16_t* A1; const float* g1; int sc1; bf16_t* A2; const float* g2; int sc2; float* sumsq;
    __device__ __forceinline__ void operator()(const f32x4 (&acc)[2][2][4][2], const Unit& u, int wr, int wc, int fr, int fq) const {
        const int b = u.pm >> 3, col0 = u.pn * BM + wc * 32 + 8 * fq;
        float gv[2][8], gs1[2][8], gs2[HAS_A2 ? 2 : 1][8];
#pragma unroll
        for (int bj = 0; bj < 2; ++bj) { const int cc = col0 + bj * HALF;
            ld8(gate + (size_t)b * MODV_LD + cc, gv[bj]);
            { float gg[8], sc[8]; ld8(g1 + cc, gg); ld8(modv + (size_t)b * MODV_LD + sc1 + cc, sc);
#pragma unroll
              for (int j = 0; j < 8; ++j) gs1[bj][j] = gg[j] * (sc[j] + 1.f); }
            if constexpr (HAS_A2) { float gg[8], sc[8]; ld8(g2 + cc, gg); ld8(modv + (size_t)b * MODV_LD + sc2 + cc, sc);
#pragma unroll
              for (int j = 0; j < 8; ++j) gs2[bj][j] = gg[j] * (sc[j] + 1.f); } }
        constexpr int NG = (sizeof(TIn) == 4 || HAS_A2) ? 2 : 4;
#pragma unroll
        for (int ai = 0; ai < 2; ++ai) {
#pragma unroll
          for (int mh = 0; mh < 4; mh += NG) {
            float xv[sizeof(TIn) == 4 ? NG : 1][2][8]; h16x8 xh[sizeof(TIn) == 4 ? 1 : NG][2];
#pragma unroll
            for (int mm = 0; mm < NG; ++mm) { const size_t off = (size_t)(u.pm * BM + ai * HALF + wr * 64 + (mh + mm) * 16 + fr) * DM + col0;
#pragma unroll
                for (int bj = 0; bj < 2; ++bj) {
                    if constexpr (sizeof(TIn) == 4) ld8((const float*)xin + off + bj * HALF, xv[mm][bj]);
                    else xh[mm][bj] = *(const h16x8*)((const _Float16*)xin + off + bj * HALF); } }
            __builtin_amdgcn_sched_barrier(0);
#pragma unroll
            for (int mm = 0; mm < NG; ++mm) { const int m = mh + mm; const int row = u.pm * BM + ai * HALF + wr * 64 + m * 16 + fr; const size_t off = (size_t)row * DM + col0;
                float ss = 0.f;
#pragma unroll
                for (int bj = 0; bj < 2; ++bj) { float o[8]; h16x8 ho;
#pragma unroll
                    for (int j = 0; j < 8; ++j) { float xj; if constexpr (sizeof(TIn) == 4) xj = xv[mm][bj][j]; else xj = (float)xh[mm][bj][j];
                        o[j] = xj + gv[bj][j] * acc[ai][bj][m][j >> 2][j & 3]; ho[j] = (_Float16)o[j]; ss += o[j] * o[j]; }
                    *(h16x8*)(xo + off + bj * HALF) = ho;
                    if (A1) { u32x4 w; w.x = cvt_pk_bf16(o[0] * gs1[bj][0], o[1] * gs1[bj][1]); w.y = cvt_pk_bf16(o[2] * gs1[bj][2], o[3] * gs1[bj][3]);
                        w.z = cvt_pk_bf16(o[4] * gs1[bj][4], o[5] * gs1[bj][5]); w.w = cvt_pk_bf16(o[6] * gs1[bj][6], o[7] * gs1[bj][7]); *(u32x4*)(A1 + off + bj * HALF) = w; }
                    if constexpr (HAS_A2) { u32x4 w; w.x = cvt_pk_bf16(o[0] * gs2[bj][0], o[1] * gs2[bj][1]); w.y = cvt_pk_bf16(o[2] * gs2[bj][2], o[3] * gs2[bj][3]);
                        w.z = cvt_pk_bf16(o[4] * gs2[bj][4], o[5] * gs2[bj][5]); w.w = cvt_pk_bf16(o[6] * gs2[bj][6], o[7] * gs2[bj][7]); *(u32x4*)(A2 + off + bj * HALF) = w; } }
                if (sumsq) { ss += __shfl_xor(ss, 16); ss += __shfl_xor(ss, 32); if (fq == 0) atomicAdd(sumsq + row, ss); } }
            __builtin_amdgcn_sched_barrier(0);
          }
        }
    }
};

struct EpiFinal {
    static constexpr bool PERM = true, APERM = false;
    const _Float16* xin; float* out; const float* gate; const float* fg; float* sumsq; unsigned* cnt;
    __device__ __forceinline__ void operator()(f32x4 (&acc)[2][2][4][2], const Unit& u, int wr, int wc, int fr, int fq) const {
        const int b = u.pm >> 3, col0 = u.pn * BM + wc * 32 + 8 * fq;
        float gv[2][8];
#pragma unroll
        for (int bj = 0; bj < 2; ++bj) ld8(gate + (size_t)b * MODV_LD + col0 + bj * HALF, gv[bj]);
#pragma unroll
        for (int ai = 0; ai < 2; ++ai) {
            h16x8 xh[4][2];
#pragma unroll
            for (int m = 0; m < 4; ++m)
#pragma unroll
                for (int bj = 0; bj < 2; ++bj) xh[m][bj] = *(const h16x8*)(xin + (size_t)(u.pm * BM + ai * HALF + wr * 64 + m * 16 + fr) * DM + col0 + bj * HALF);
            __builtin_amdgcn_sched_barrier(0);
#pragma unroll
            for (int m = 0; m < 4; ++m) { const int row = u.pm * BM + ai * HALF + wr * 64 + m * 16 + fr;
                float ss = 0.f;
#pragma unroll
                for (int bj = 0; bj < 2; ++bj) { f32x4 o0, o1;
#pragma unroll
                    for (int j = 0; j < 4; ++j) { o0[j] = (float)xh[m][bj][j] + gv[bj][j] * acc[ai][bj][m][0][j]; o1[j] = (float)xh[m][bj][4 + j] + gv[bj][4 + j] * acc[ai][bj][m][1][j]; }
                    acc[ai][bj][m][0] = o0; acc[ai][bj][m][1] = o1;
                    ss += (o0[0] * o0[0] + o0[1] * o0[1]) + (o0[2] * o0[2] + o0[3] * o0[3]) + (o1[0] * o1[0] + o1[1] * o1[1]) + (o1[2] * o1[2] + o1[3] * o1[3]); }
                ss += __shfl_xor(ss, 16); ss += __shfl_xor(ss, 32); if (fq == 0) atomicAdd(sumsq + row, ss); }
            __builtin_amdgcn_sched_barrier(0);
        }
        asm volatile("s_waitcnt vmcnt(0)" ::: "memory");
        if (fr == 0 && fq == 0) __hip_atomic_fetch_add(cnt + u.pm * 8, 1u, __ATOMIC_RELAXED, __HIP_MEMORY_SCOPE_AGENT);
        { unsigned spins = 0;
          while (__hip_atomic_load(cnt + u.pm * 8, __ATOMIC_RELAXED, __HIP_MEMORY_SCOPE_AGENT) < 32u) { __builtin_amdgcn_s_sleep(2); if (++spins > (1u << 22)) break; } }
        float fgv[2][8];
#pragma unroll
        for (int bj = 0; bj < 2; ++bj) ld8(fg + col0 + bj * HALF, fgv[bj]);
        float ssq[2][4];
#pragma unroll
        for (int ai = 0; ai < 2; ++ai)
#pragma unroll
            for (int m = 0; m < 4; ++m) ssq[ai][m] = __hip_atomic_load(sumsq + u.pm * BM + ai * HALF + wr * 64 + m * 16 + fr, __ATOMIC_RELAXED, __HIP_MEMORY_SCOPE_AGENT);
#pragma unroll
        for (int ai = 0; ai < 2; ++ai)
#pragma unroll
            for (int m = 0; m < 4; ++m) { const size_t off = (size_t)(u.pm * BM + ai * HALF + wr * 64 + m * 16 + fr) * DM + col0;
                const float rs = __builtin_amdgcn_rsqf(ssq[ai][m] * (1.f / DM) + EPS);
#pragma unroll
                for (int bj = 0; bj < 2; ++bj) { f32x4 y0, y1;
#pragma unroll
                    for (int j = 0; j < 4; ++j) { y0[j] = acc[ai][bj][m][0][j] * rs * fgv[bj][j]; y1[j] = acc[ai][bj][m][1][j] * rs * fgv[bj][4 + j]; }
                    *(f32x4*)(out + off + bj * HALF) = y0; *(f32x4*)(out + off + bj * HALF + 4) = y1; } }
    }
};

__device__ __forceinline__ void scan16(float& a, float& b) {
    float ap, bp;
    ap = dpp_shr<1>(a, 1.f); bp = dpp_shr<1>(b, 0.f); b = fmaf(a, bp, b); a *= ap;
    ap = dpp_shr<2>(a, 1.f); bp = dpp_shr<2>(b, 0.f); b = fmaf(a, bp, b); a *= ap;
    ap = dpp_shr<4>(a, 1.f); bp = dpp_shr<4>(b, 0.f); b = fmaf(a, bp, b); a *= ap;
    ap = dpp_shr<8>(a, 1.f); bp = dpp_shr<8>(b, 0.f); b = fmaf(a, bp, b); a *= ap;
}
__device__ __forceinline__ void gate_elem2(f32x2 xr, f32x2 xg, f32x2 nba, f32x2 nbx, f32x2 psp2, f32x2 uv, f32x2& a, f32x2& b) {
    const f32x2 tr = xr * (-1.4426950408889634f) + nba, tg = xg * (-1.4426950408889634f) + nbx;
    f32x2 er, eg; er.x = __builtin_amdgcn_exp2f(tr.x); er.y = __builtin_amdgcn_exp2f(tr.y); eg.x = __builtin_amdgcn_exp2f(tg.x); eg.y = __builtin_amdgcn_exp2f(tg.y);
    const f32x2 dr = er + 1.f, dg = eg + 1.f, dd = dr * dg;
    f32x2 inv; inv.x = __builtin_amdgcn_rcpf(dd.x); inv.y = __builtin_amdgcn_rcpf(dd.y);
    const f32x2 r = inv * dg, gi = inv * dr;
    const f32x2 la2 = psp2 * r;
    a.x = __builtin_amdgcn_exp2f(-la2.x); a.y = __builtin_amdgcn_exp2f(-la2.y);
    const f32x2 om = 1.f - a * a;
    f32x2 sq; sq.x = __builtin_amdgcn_sqrtf(om.x); sq.y = __builtin_amdgcn_sqrtf(om.y);
    b = sq * gi * uv;
}
struct GateParams { f32x2 nba[4], nbx[4], psp2[4]; };
__device__ __forceinline__ void gate_params(GateParams& P, const float* ba, const float* bx, const float* lam, int ch0) {
#pragma unroll
    for (int p = 0; p < 4; ++p) {
        const f32x2 vb = *(const f32x2*)(ba + ch0 + 2 * p), vx = *(const f32x2*)(bx + ch0 + 2 * p), vl = *(const f32x2*)(lam + ch0 + 2 * p);
        P.nba[p] = vb * (-1.4426950408889634f); P.nbx[p] = vx * (-1.4426950408889634f);
        const float z0 = -vl.x, z1 = -vl.y;
        P.psp2[p].x = 8.f * 1.4426950408889634f * (z0 > 20.f ? z0 : flog(1.f + fexp(z0)));
        P.psp2[p].y = 8.f * 1.4426950408889634f * (z1 > 20.f ? z1 : flog(1.f + fexp(z1)));
    }
}
#define GATE_PAIR(p, accv, uw_, a2, b2) do { const int n_ = (p) >> 1, q_ = ((p) & 1) * 2; \
        const unsigned uword_ = ((p) == 0) ? uw_.x : ((p) == 1) ? uw_.y : ((p) == 2) ? uw_.z : uw_.w; \
        gate_elem2((f32x2){accv[ai][0][m][n_][q_], accv[ai][0][m][n_][q_ + 1]}, (f32x2){accv[ai][1][m][n_][q_], accv[ai][1][m][n_][q_ + 1]}, \
                   P.nba[p], P.nbx[p], P.psp2[p], (f32x2){bf_lo(uword_), bf_hi(uword_)}, a2, b2); } while (0)
struct GatesOrder {
    int c, n;
    __device__ bool next(int i, Unit& u) const { if (i >= n) return false; const int j = c >> 3; int pm = (c & 7) * 8 + 4 * i + (j & 3), pn = (j >> 2) & 1, sub = (j >> 3) & 3;
        asm volatile("" : "+s"(pm), "+s"(pn), "+s"(sub)); u.pm = pm; u.pn = pn; u.sub = sub; return true; }
};
constexpr int GS_RA_OFF = 133120;
struct EpiGatesS {
    static constexpr bool PERM = true, APERM = true;
    unsigned char* ws; unsigned target; const float* ba; const float* bx; const float* lam; LAS unsigned char* lds;
    __device__ __forceinline__ void operator()(f32x4 (&acc)[2][2][4][2], const Unit& u, int wr, int wc, int fr, int fq) const {
        const bf16_t* U = (const bf16_t*)(ws + WS_UPRE); const bf16_t* Gt = (const bf16_t*)(ws + WS_G); bf16_t* Y = (bf16_t*)(ws + WS_HN);
        unsigned long long* TA = (unsigned long long*)(ws + WS_TA); unsigned* flags = (unsigned*)(ws + WS_GFLAG);
        const int ct0 = wc * 32 + 8 * fq, ch0 = u.sub * 256 + u.pn * 128 + ct0;
        const int chain = ((u.pm >> 3) * 4 + u.sub) * 2 + u.pn, p = u.pm & 7, tix = chain * 8 + p;
        const int bsrc = (fq * 16 + 15) << 2;
        LAS f32x4* RA = (LAS f32x4*)(lds + GS_RA_OFF);
        {
            GateParams P; gate_params(P, ba, bx, lam, ch0);
#pragma unroll
            for (int ai = 0; ai < 2; ++ai) {
                u32x4 uall[4];
#pragma unroll
                for (int m = 0; m < 4; ++m) uall[m] = *(const u32x4*)(U + (size_t)(u.pm * BM + ai * HALF + wr * 64 + 4 * fr + m) * DM + ch0);
#pragma unroll
                for (int n = 0; n < 2; ++n) { f32x4 tA[4], tB[4]; f32x4 agg;
#pragma unroll
                    for (int hq = 0; hq < 2; ++hq) { const int pq = 2 * n + hq; f32x2 a2[4], b2[4];
#pragma unroll
                        for (int m = 0; m < 4; ++m) { const u32x4 uw = uall[m]; GATE_PAIR(pq, acc, uw, a2[m], b2[m]); }
#pragma unroll
                        for (int m = 1; m < 4; ++m) { b2[m] = a2[m] * b2[m - 1] + b2[m]; a2[m] = a2[m] * a2[m - 1]; }
                        float pax = a2[3].x, pbx = b2[3].x, pay = a2[3].y, pby = b2[3].y; scan16(pax, pbx); scan16(pay, pby);
                        if (hq == 0) { agg[0] = pax; agg[1] = pbx; agg[2] = pay; agg[3] = pby;
                            if (fr == 15) RA[((ai * 2 + wr) * 128 + ct0) / 2 + pq] = agg; }
                        else { if (fr == 15) RA[((ai * 2 + wr) * 128 + ct0) / 2 + pq] = (f32x4){pax, pbx, pay, pby}; }
                        const f32x2 EA = {dpp_shr<1>(pax, 1.f), dpp_shr<1>(pay, 1.f)}, EB = {dpp_shr<1>(pbx, 0.f), dpp_shr<1>(pby, 0.f)};
#pragma unroll
                        for (int m = 0; m < 4; ++m) { const f32x2 Ae = a2[m] * EA, Be = a2[m] * EB + b2[m];
                            tA[m][2 * hq] = Ae.x; tA[m][2 * hq + 1] = Ae.y; tB[m][2 * hq] = Be.x; tB[m][2 * hq + 1] = Be.y; }
                        __builtin_amdgcn_sched_barrier(0); }
#pragma unroll
                    for (int m = 0; m < 4; ++m) { acc[ai][0][m][n] = tA[m]; acc[ai][1][m][n] = tB[m]; }
                    asm volatile("" ::: "memory"); __builtin_amdgcn_sched_barrier(0); }
            }
        }
        asm volatile("s_waitcnt lgkmcnt(0)" ::: "memory"); __builtin_amdgcn_s_barrier(); asm volatile("" ::: "memory");
        if (wr == 0) {
            float At[8], Bt[8];
#pragma unroll
            for (int j = 0; j < 8; ++j) { At[j] = 1.f; Bt[j] = 0.f; }
#pragma unroll
            for (int ri = 0; ri < 4; ++ri)
#pragma unroll
                for (int q = 0; q < 4; ++q) { const f32x4 v = RA[(ri * 128 + ct0) / 2 + q];
                    Bt[2 * q] = fmaf(v[0], Bt[2 * q], v[1]); At[2 * q] *= v[0]; Bt[2 * q + 1] = fmaf(v[2], Bt[2 * q + 1], v[3]); At[2 * q + 1] *= v[2]; }
            if (fr == 15) {
#pragma unroll
                for (int j = 0; j < 8; ++j) __hip_atomic_store(TA + (size_t)tix * 128 + ct0 + j, ((unsigned long long)__float_as_uint(Bt[j]) << 32) | __float_as_uint(At[j]), __ATOMIC_RELAXED, __HIP_MEMORY_SCOPE_AGENT);
            }
            asm volatile("s_waitcnt vmcnt(0)" ::: "memory");
            if (fr == 15 && fq == 0) __hip_atomic_fetch_add(flags + tix * 8, 1u, __ATOMIC_RELAXED, __HIP_MEMORY_SCOPE_AGENT);
        }
        float h[8];
        {
            const bool on = fr < p;
            if (on) { unsigned spins = 0;
                while (__hip_atomic_load(flags + (chain * 8 + fr) * 8, __ATOMIC_RELAXED, __HIP_MEMORY_SCOPE_AGENT) < target) { __builtin_amdgcn_s_sleep(2); if (++spins > (1u << 22)) break; } }
            float Ac[8], Bc[8];
#pragma unroll
            for (int j = 0; j < 8; ++j) { unsigned long long w = 0x000000003f800000ull;
                if (on) w = __hip_atomic_load(TA + (size_t)(chain * 8 + fr) * 128 + ct0 + j, __ATOMIC_RELAXED, __HIP_MEMORY_SCOPE_AGENT);
                Ac[j] = __uint_as_float((unsigned)w); Bc[j] = __uint_as_float((unsigned)(w >> 32)); }
#pragma unroll
            for (int j = 0; j < 8; ++j) { float a = Ac[j], b = Bc[j]; scan16(a, b); h[j] = __int_as_float(__builtin_amdgcn_ds_bpermute(bsrc, __float_as_int(b))); }
        }
#pragma unroll
        for (int ai = 0; ai < 2; ++ai) {
            const int nskip = (ai == 0) ? wr : 1;
            const int rfirst = (ai == 0) ? 0 : (1 + wr);
            for (int k = 0; k < nskip; ++k)
#pragma unroll
                for (int q = 0; q < 4; ++q) { const f32x4 v = RA[((rfirst + k) * 128 + ct0) / 2 + q];
                    h[2 * q] = fmaf(v[0], h[2 * q], v[1]); h[2 * q + 1] = fmaf(v[2], h[2 * q + 1], v[3]); }
            u32x4 gall[4];
#pragma unroll
            for (int m = 0; m < 4; ++m) gall[m] = *(const u32x4*)(Gt + (size_t)(u.pm * BM + ai * HALF + wr * 64 + 4 * fr + m) * DM + ch0);
            float hl[8];
#pragma unroll
            for (int m = 0; m < 4; ++m) { const size_t off = (size_t)(u.pm * BM + ai * HALF + wr * 64 + 4 * fr + m) * DM + ch0;
                const u32x4 gw = gall[m];
                const float gv[8] = {bf_lo(gw.x), bf_hi(gw.x), bf_lo(gw.y), bf_hi(gw.y), bf_lo(gw.z), bf_hi(gw.z), bf_lo(gw.w), bf_hi(gw.w)};
                float yv[8];
#pragma unroll
                for (int j = 0; j < 8; ++j) { const float hv = fmaf(acc[ai][0][m][j >> 2][j & 3], h[j], acc[ai][1][m][j >> 2][j & 3]); yv[j] = hv * gv[j];
                    if (m == 3) hl[j] = hv; }
                u32x4 w; w.x = cvt_pk_bf16(yv[0], yv[1]); w.y = cvt_pk_bf16(yv[2], yv[3]); w.z = cvt_pk_bf16(yv[4], yv[5]); w.w = cvt_pk_bf16(yv[6], yv[7]);
                *(u32x4*)(Y + off) = w; }
#pragma unroll
            for (int j = 0; j < 8; ++j) h[j] = __int_as_float(__builtin_amdgcn_ds_bpermute(bsrc, __float_as_int(hl[j])));
            asm volatile("" ::: "memory"); __builtin_amdgcn_sched_barrier(0);
        }
    }
};

struct EpiQKV {
    static constexpr bool PERM = true, APERM = false;
    unsigned char* ws; float* kmean; const float* sumsq; const float* shw; int shw_sub;
    __device__ __forceinline__ void operator()(const f32x4 (&acc)[2][2][4][2], const Unit& u, int wr, int wc, int fr, int fq) const {
        const int b = u.pm >> 3, sblk = u.pm & 7, pq = u.pn & 3; const bool second = u.pn >= 4;
        const int dcol = wc * 32 + 8 * fq;
        const float* sw = shw + (size_t)u.sub * shw_sub + (size_t)b * 2 * DM + u.pn * BM + dcol;
        f32x4 bv[2][2];
#pragma unroll
        for (int bj = 0; bj < 2; ++bj)
#pragma unroll
            for (int n = 0; n < 2; ++n) bv[bj][n] = *(const f32x4*)(sw + bj * HALF + 4 * n);
        const bool plain = (u.sub == 0 && second), km = (u.sub == 1 && !second);
        const size_t boff = plain ? WS_G : (u.sub == 0) ? WS_UPRE : (second ? WS_BIN : WS_HN);
        const size_t rstride = plain ? DM : DH;
        bf16_t* bp[2];
#pragma unroll
        for (int bj = 0; bj < 2; ++bj)
            bp[bj] = (bf16_t*)(ws + boff) + (plain ? (size_t)(u.pm * BM) * DM + pq * 256 + bj * HALF + dcol : ((size_t)(b * NH + 2 * pq + bj) * SEQ + sblk * 256) * DH + dcol);
        f32x4 s0[2], s1[2];
#pragma unroll
        for (int bj = 0; bj < 2; ++bj) { s0[bj] = (f32x4){0.f, 0.f, 0.f, 0.f}; s1[bj] = (f32x4){0.f, 0.f, 0.f, 0.f}; }
        float ssq[2][4];
#pragma unroll
        for (int ai = 0; ai < 2; ++ai)
#pragma unroll
            for (int m = 0; m < 4; ++m) ssq[ai][m] = sumsq[u.pm * BM + ai * HALF + wr * 64 + m * 16 + fr];
#pragma unroll
        for (int ai = 0; ai < 2; ++ai)
#pragma unroll
            for (int m = 0; m < 4; ++m) { const int r = ai * HALF + wr * 64 + m * 16 + fr;
                const float rs = __builtin_amdgcn_rsqf(ssq[ai][m] * (1.f / DM) + EPS);
#pragma unroll
                for (int bj = 0; bj < 2; ++bj) { f32x4 v0 = acc[ai][bj][m][0] * rs + bv[bj][0], v1 = acc[ai][bj][m][1] * rs + bv[bj][1];
                    if (plain) {
#pragma unroll
                        for (int j = 0; j < 4; ++j) { v0[j] = fsilu(v0[j]); v1[j] = fsilu(v1[j]); } }
                    s0[bj] += v0; s1[bj] += v1;
                    u32x4 w; w.x = cvt_pk_bf16(v0[0], v0[1]); w.y = cvt_pk_bf16(v0[2], v0[3]); w.z = cvt_pk_bf16(v1[0], v1[1]); w.w = cvt_pk_bf16(v1[2], v1[3]);
                    *(u32x4*)(bp[bj] + (size_t)r * rstride) = w; }
                asm volatile("" ::: "memory"); }
        if (km) {
#pragma unroll
            for (int bj = 0; bj < 2; ++bj)
#pragma unroll
                for (int j = 0; j < 4; ++j) { float t0 = s0[bj][j], t1 = s1[bj][j];
                    t0 += __shfl_xor(t0, 1); t0 += __shfl_xor(t0, 2); t0 += __shfl_xor(t0, 4); t0 += __shfl_xor(t0, 8);
                    t1 += __shfl_xor(t1, 1); t1 += __shfl_xor(t1, 2); t1 += __shfl_xor(t1, 4); t1 += __shfl_xor(t1, 8);
                    if (fr == 0) { float* kp = kmean + ((size_t)(b * NH + 2 * pq + bj) * 8 + sblk) * DH + dcol + j;
                        atomicAdd(kp, t0 * (1.f / 256.f)); atomicAdd(kp + 4, t1 * (1.f / 256.f)); } }
        }
    }
};

template <class Epi, class Sched>
__device__ __forceinline__ void gemm_phase(LAS unsigned char* lds, const Gemm g, const Sched& S, const Epi& E, int wv) {
    const int tid = opq_tid(wv), wid = __builtin_amdgcn_readfirstlane(tid >> 6), lane = tid & 63, wr = wid >> 2, wc = wid & 3, fr = lane & 15, fq = lane >> 4;
    const int K = g.K, nt = K / BK;
    unsigned voffA[2], voffB[2];
#pragma unroll
    for (int i = 0; i < 2; ++i) { int R, C; stage_rc(tid * 16 + i * 8192, R, C); const int Rb = Epi::PERM ? ((R & ~31) + perm32(R & 31)) : R;
        const int Ra = Epi::APERM ? ((R & 64) + 4 * (R & 15) + ((R >> 4) & 3)) : R;
        voffA[i] = (unsigned)(Ra * g.lda + C) * 2u; voffB[i] = (unsigned)(Rb * g.ldb + C) * 2u; }
    const size_t kstep = (size_t)(BK * 2);
    const size_t hstepA = (size_t)HALF * g.lda * 2, hstepB = (size_t)HALF * g.ldb * 2;
    const size_t tstepA = 2 * hstepA, tstepB = 2 * hstepB;
    const unsigned ldsw = (unsigned)wid * 1024u;
    const int aoff = lds_byte(wr * 64 + fr, fq * 8), boff = lds_byte(wc * 32 + fr, fq * 8);
#define PG8_SA(b, h) (((b) * 2 + (h)) * HTB)
#define PG8_SB(b, h) ((4 + (b) * 2 + (h)) * HTB)
#define PG8_STAGE(bufoff, gbase, voff) do { _Pragma("unroll") for (int _i = 0; _i < 2; ++_i) \
        __builtin_amdgcn_global_load_lds((const unsigned*)((const char*)(gbase) + (voff)[_i]), (LAS unsigned*)(lds + (bufoff) + ldsw + _i * 8192), 16, 0, 0); } while (0)
#define PG8_LDA(dst, b, h) do { _Pragma("unroll") for (int m = 0; m < 4; ++m) _Pragma("unroll") for (int k = 0; k < 2; ++k) dst[m][k] = *(const LAS bf16x8*)(lds + PG8_SA(b, h) + aoff + m * 2048 + k * 1024); } while (0)
#define PG8_LDB(dst, b, h) do { _Pragma("unroll") for (int n = 0; n < 2; ++n) _Pragma("unroll") for (int k = 0; k < 2; ++k) dst[n][k] = *(const LAS bf16x8*)(lds + PG8_SB(b, h) + boff + n * 2048 + k * 1024); } while (0)
#define PG8_MMA(ai, bj, At, Bt) do { __builtin_amdgcn_s_setprio(1); _Pragma("unroll") for (int m = 0; m < 4; ++m) _Pragma("unroll") for (int n = 0; n < 2; ++n) _Pragma("unroll") for (int k = 0; k < 2; ++k) \
        acc[ai][bj][m][n] = __builtin_amdgcn_mfma_f32_16x16x32_bf16(Bt[n][k], At[m][k], acc[ai][bj][m][n], 0, 0, 0); __builtin_amdgcn_s_setprio(0); } while (0)
#define PG8_WAIT_V(n) asm volatile("s_waitcnt vmcnt(" #n ")" ::: "memory")
#define PG8_WAIT_L(n) asm volatile("s_waitcnt lgkmcnt(" #n ")" ::: "memory")
#define PG8_BAR __builtin_amdgcn_s_barrier()
#define PG8_SCHED __builtin_amdgcn_sched_barrier(0)
#define PG8_UA(u) ((const char*)g.A + (size_t)(u).sub * g.a_sub + (size_t)(u).pm * tstepA)
#define PG8_UB(u) ((const char*)g.Bt + (size_t)(u).sub * g.b_sub + (size_t)(u).pn * tstepB)
    Unit cur, nxt; int ui = 0;
    if (!S.next(0, cur)) return;
    f32x4 acc[2][2][4][2];
#pragma unroll
    for (int a = 0; a < 2; ++a)
#pragma unroll
        for (int b = 0; b < 2; ++b)
#pragma unroll
            for (int m = 0; m < 4; ++m)
#pragma unroll
                for (int n = 0; n < 2; ++n) acc[a][b][m][n] = (f32x4){0.f, 0.f, 0.f, 0.f};
    bf16x8 At[4][2], B0[2][2], B1[2][2];
    const char* cA = PG8_UA(cur); const char* cB = PG8_UB(cur);
    PG8_STAGE(PG8_SB(0, 0), cB, voffB); PG8_STAGE(PG8_SB(0, 1), cB + hstepB, voffB); PG8_STAGE(PG8_SA(0, 0), cA, voffA); PG8_STAGE(PG8_SA(0, 1), cA + hstepA, voffA);
    if (wr == 1) PG8_BAR;
    PG8_WAIT_V(2); PG8_BAR;
    PG8_STAGE(PG8_SB(1, 0), cB + kstep, voffB); PG8_STAGE(PG8_SA(1, 0), cA + kstep, voffA); PG8_STAGE(PG8_SB(1, 1), cB + hstepB + kstep, voffB);
    PG8_WAIT_V(6); PG8_BAR;
    for (;;) {
        const bool has_next = S.next(ui + 1, nxt);
        const char* nA = has_next ? PG8_UA(nxt) : cA; const char* nB = has_next ? PG8_UB(nxt) : cB;
        for (int t = 0; t < nt; t += 2) {
            const bool last = (t == nt - 2);
            const char* a1 = cA + (size_t)(t + 1) * kstep;
            const char* a2 = last ? nA : cA + (size_t)(t + 2) * kstep; const char* b2 = last ? nB : cB + (size_t)(t + 2) * kstep;
            const char* a3 = a2 + kstep; const char* b3 = b2 + kstep;
            PG8_LDB(B0, 0, 0); PG8_LDB(B1, 0, 1); PG8_SCHED; PG8_LDA(At, 0, 0); PG8_STAGE(PG8_SA(1, 1), a1 + hstepA, voffA);
            PG8_WAIT_V(8); PG8_WAIT_L(0); PG8_BAR; PG8_MMA(0, 0, At, B0); PG8_MMA(0, 1, At, B1); PG8_BAR; PG8_SCHED;
            PG8_LDA(At, 0, 1); PG8_STAGE(PG8_SB(0, 0), b2, voffB); PG8_STAGE(PG8_SB(0, 1), b2 + hstepB, voffB); PG8_STAGE(PG8_SA(0, 0), a2, voffA);
            PG8_WAIT_V(8); PG8_WAIT_L(0); PG8_BAR; PG8_MMA(1, 0, At, B0); PG8_MMA(1, 1, At, B1); PG8_BAR; PG8_SCHED;
            PG8_LDB(B0, 1, 0); PG8_LDB(B1, 1, 1); PG8_SCHED; PG8_LDA(At, 1, 0); PG8_STAGE(PG8_SA(0, 1), a2 + hstepA, voffA);
            PG8_WAIT_V(8); PG8_WAIT_L(0); PG8_BAR; PG8_MMA(0, 0, At, B0); PG8_MMA(0, 1, At, B1); PG8_BAR; PG8_SCHED;
            PG8_LDA(At, 1, 1); PG8_STAGE(PG8_SB(1, 0), b3, voffB); PG8_STAGE(PG8_SB(1, 1), b3 + hstepB, voffB); PG8_STAGE(PG8_SA(1, 0), a3, voffA);
            PG8_WAIT_V(8); PG8_WAIT_L(0); PG8_BAR; PG8_MMA(1, 0, At, B0); PG8_MMA(1, 1, At, B1); PG8_BAR; PG8_SCHED;
        }
        if (wr == 0) PG8_BAR;
        { const int t2 = opq_tid(wv), w2 = __builtin_amdgcn_readfirstlane(t2 >> 6), l2 = t2 & 63; E(acc, cur, w2 >> 2, w2 & 3, l2 & 15, l2 >> 4); }
        if (!has_next) break;
#pragma unroll
        for (int a = 0; a < 2; ++a)
#pragma unroll
            for (int b = 0; b < 2; ++b)
#pragma unroll
                for (int m = 0; m < 4; ++m)
#pragma unroll
                    for (int n = 0; n < 2; ++n) acc[a][b][m][n] = (f32x4){0.f, 0.f, 0.f, 0.f};
        cur = nxt; cA = nA; cB = nB; ++ui;
        if (wr == 1) PG8_BAR;
    }
    PG8_WAIT_V(0);
    PG8_BAR;
#undef PG8_SA
#undef PG8_SB
#undef PG8_STAGE
#undef PG8_LDA
#undef PG8_LDB
#undef PG8_MMA
#undef PG8_WAIT_V
#undef PG8_WAIT_L
#undef PG8_BAR
#undef PG8_SCHED
#undef PG8_UA
#undef PG8_UB
}
}

namespace att {
constexpr float SCALE = 0.08838834764831845f;
constexpr float THR = 8.f;
constexpr int NW = 8, QBLK = 32, KVBLK = 64, QB = NW * QBLK, D = 128;
constexpr int SHM_V = KVBLK * D * 2, SHM_K = KVBLK * D * 2;
constexpr int ATT_LDS = 2 * SHM_V + 2 * SHM_K + NW * 64 * 4;
#define KSWZ(row, colB) ((row) * 256 + ((colB) ^ (((row) & 7) << 4)))
#define SBAR() __builtin_amdgcn_sched_barrier(0)
__device__ __forceinline__ int v_st(int k, int c) { const int kk = (k & ~0xC) | ((k & 4) << 1) | ((k & 8) >> 1); return ((kk >> 3) * 4 + (c >> 5)) * 512 + ((kk & 7) * 32 + (c & 31)) * 2; }
__device__ __forceinline__ int v_rd_base(int lane) { return ((lane & 3) << 3) | (((lane >> 2) & 3) << 6) | (((lane >> 4) & 1) << 5) | (((lane >> 5) & 1) << 8); }
constexpr int v_rd_off(int d0, int ks, int half) { return d0 * 512 + ks * 4096 + half * 2048; }
__device__ __forceinline__ int crow(int r, int hi) { return (r & 3) + 8 * (r >> 2) + 4 * hi; }
__device__ __forceinline__ bf16x8 load8(const bf16_t* p) { return *reinterpret_cast<const bf16x8*>(p); }
__device__ __forceinline__ void mask_tile(f32x16& p0, f32x16& p1, int dq) {
    const float NEG = -__builtin_inff();
#pragma unroll
    for (int r = 0; r < 16; ++r) {
        const int c = (r & 3) + 8 * (r >> 2);
        if (dq - c < 0) p0[r] = NEG;
        if (dq - c - 32 < 0) p1[r] = NEG;
    }
}
__device__ __forceinline__ void mask_all(f32x16& p0, f32x16& p1, bool off) {
    const float NEG = -__builtin_inff();
#pragma unroll
    for (int r = 0; r < 16; ++r) { p0[r] = off ? NEG : p0[r]; p1[r] = off ? NEG : p1[r]; }
}
__device__ __forceinline__ void partialSM(f32x16& p0, f32x16& p1, float& m_reg, float& mn, float& alpha, float rbias = 0.f) {
    float pmax = p0[0];
#pragma unroll
    for (int r = 1; r < 16; ++r) pmax = fmaxf(pmax, p0[r]);
#pragma unroll
    for (int r = 0; r < 16; ++r) pmax = fmaxf(pmax, p1[r]);
    { auto rr = __builtin_amdgcn_permlane32_swap(__float_as_uint(pmax), __float_as_uint(pmax), false, false);
      pmax = fmaxf(__uint_as_float(rr[0]), __uint_as_float(rr[1])); }
    constexpr float C2 = 1.4426950408889634f * SCALE;
    if (__builtin_expect(__all((pmax - m_reg) * SCALE <= THR), 1)) { mn = m_reg; alpha = 1.f; }
    else { mn = fmaxf(m_reg, pmax); alpha = __builtin_amdgcn_exp2f((m_reg - mn) * C2); m_reg = mn; }
    const float mnL = -mn * C2 + rbias;
#pragma unroll
    for (int r = 0; r < 16; ++r) p0[r] = fmaf(p0[r], C2, mnL);
#pragma unroll
    for (int r = 0; r < 16; ++r) p1[r] = fmaf(p1[r], C2, mnL);
#pragma unroll
    for (int r = 0; r < 16; ++r) p0[r] = __builtin_amdgcn_exp2f(p0[r]);
}
__device__ __forceinline__ void finishSM(f32x16& p0, f32x16& p1, float alpha, float& l_reg, bf16x8& pa0, bf16x8& pa1, bf16x8& pa2, bf16x8& pa3) {
#pragma unroll
    for (int r = 0; r < 16; ++r) p1[r] = __builtin_amdgcn_exp2f(p1[r]);
    float ps = 0;
#pragma unroll
    for (int r = 0; r < 16; ++r) ps += p0[r];
#pragma unroll
    for (int r = 0; r < 16; ++r) ps += p1[r];
    { auto rr = __builtin_amdgcn_permlane32_swap(__float_as_uint(ps), __float_as_uint(ps), false, false);
      ps = __uint_as_float(rr[0]) + __uint_as_float(rr[1]); }
    l_reg = l_reg * alpha + ps;
#define PK4(P, B_, OUT) do { unsigned a0 = cvt_pk_bf16(P[B_+0], P[B_+1]), a1 = cvt_pk_bf16(P[B_+2], P[B_+3]);                          \
        unsigned b0 = cvt_pk_bf16(P[B_+4], P[B_+5]), b1 = cvt_pk_bf16(P[B_+6], P[B_+7]);                                             \
        auto r0 = __builtin_amdgcn_permlane32_swap(a0, b0, false, false); auto r1 = __builtin_amdgcn_permlane32_swap(a1, b1, false, false); \
        u32x4 w = {r0[0], r1[0], r0[1], r1[1]}; OUT = *reinterpret_cast<bf16x8*>(&w); } while (0)
    PK4(p0, 0, pa0); PK4(p0, 8, pa1); PK4(p1, 0, pa2); PK4(p1, 8, pa3);
#undef PK4
}
template <int KB>
__device__ __forceinline__ void qkt(f32x16& p0, f32x16& p1, const char* K_lds, int r32, int hi, const bf16x8* qr) {
    p0 = f32x16{}; p1 = f32x16{};
    const char* kb[4];
#pragma unroll
    for (int dd = 0; dd < 4; ++dd) kb[dd] = K_lds + KB * SHM_K + KSWZ(r32, (dd * 16 + hi * 8) * 2);
#pragma unroll
    for (int d0 = 0; d0 < 8; ++d0) { const char* a = kb[d0 & 3] + (d0 >> 2) * 128;
        bf16x8 b0 = *reinterpret_cast<const bf16x8*>(a);
        bf16x8 b1 = *reinterpret_cast<const bf16x8*>(a + 32 * 256);
        p0 = __builtin_amdgcn_mfma_f32_32x32x16_bf16(b0, qr[d0], p0, 0, 0, 0);
        p1 = __builtin_amdgcn_mfma_f32_32x32x16_bf16(b1, qr[d0], p1, 0, 0, 0); }
}
template <int VB>
__device__ __forceinline__ void pv_tile(f32x16* o, int vb0, bf16x8 pa0, bf16x8 pa1, bf16x8 pa2, bf16x8 pa3) {
#define TRRD(dst, off) asm volatile("ds_read_b64_tr_b16 %0, %1 offset:%2" : "=&v"(dst) : "v"(vb0), "i"(off) : "memory")
#define PV_D0(d0) do { s16x4 l0, l1, l2, l3, h0, h1, h2, h3; constexpr int b_ = VB * SHM_V + v_rd_off(d0, 0, 0); \
        TRRD(l0, b_); TRRD(h0, b_ + 2048); TRRD(l1, b_ + 4096); TRRD(h1, b_ + 6144); TRRD(l2, b_ + 8192); TRRD(h2, b_ + 10240); TRRD(l3, b_ + 12288); TRRD(h3, b_ + 14336); \
        asm volatile("s_waitcnt lgkmcnt(0)" ::: "memory"); SBAR();   \
        o[d0] = __builtin_amdgcn_mfma_f32_32x32x16_bf16(pa0, (bf16x8){l0[0], l0[1], l0[2], l0[3], h0[0], h0[1], h0[2], h0[3]}, o[d0], 0, 0, 0);   \
        o[d0] = __builtin_amdgcn_mfma_f32_32x32x16_bf16(pa1, (bf16x8){l1[0], l1[1], l1[2], l1[3], h1[0], h1[1], h1[2], h1[3]}, o[d0], 0, 0, 0);   \
        o[d0] = __builtin_amdgcn_mfma_f32_32x32x16_bf16(pa2, (bf16x8){l2[0], l2[1], l2[2], l2[3], h2[0], h2[1], h2[2], h2[3]}, o[d0], 0, 0, 0);   \
        o[d0] = __builtin_amdgcn_mfma_f32_32x32x16_bf16(pa3, (bf16x8){l3[0], l3[1], l3[2], l3[3], h3[0], h3[1], h3[2], h3[3]}, o[d0], 0, 0, 0); } while (0)
    PV_D0(0); PV_D0(1); PV_D0(2); PV_D0(3);
#undef PV_D0
#undef TRRD
}

struct BlockRef { const bf16_t* Q; const bf16_t* K; const bf16_t* V; bf16_t* O; const bf16_t* Gt; const float* KM; int P0; };
struct Seam { bf16x8 qr[8]; bf16x8 st_v0, st_v1, st_k0, st_k1; };
#define ROW(p, k0, rr) ((p) + (size_t)((k0) + (rr)) * D + sc)
#define VMW() asm volatile("s_waitcnt vmcnt(0)" ::: "memory")
#define VMWN(n) asm volatile("s_waitcnt vmcnt(%0)" :: "i"(n) : "memory")
#define SLOAD_H(Kp, Vp, k0) do { S.st_v0 = load8(ROW(Vp, k0, sr)); S.st_v1 = load8(ROW(Vp, k0, 32 + sr));              \
                         S.st_k0 = load8(ROW(Kp, k0, sr)); S.st_k1 = load8(ROW(Kp, k0, 32 + sr)); } while (0)
#define SWRITE_HK(bf) do { *(bf16x8*)(K_lds + (bf) * SHM_K + kws) = S.st_k0; *(bf16x8*)(K_lds + (bf) * SHM_K + kws + 32 * 256) = S.st_k1; } while (0)
#define SWRITE_HV(bf) do { *(bf16x8*)(V_lds + (bf) * SHM_V + vst0) = S.st_v0; *(bf16x8*)(V_lds + (bf) * SHM_V + vst1) = S.st_v1; } while (0)
#define SWRITE_H(bf) do { SWRITE_HV(bf); SWRITE_HK(bf); } while (0)
__device__ __forceinline__ void moba_prime(const BlockRef& cur, char* lds, Seam& S, int wv) {
    const int tid = opq_tid(wv), wid = __builtin_amdgcn_readfirstlane(tid >> 6), lane = tid & 63, r32 = lane & 31, hi = lane >> 5;
    const int sr = tid >> 4, sc = (tid & 15) * 8, kws = KSWZ(sr, sc * 2); char* K_lds = lds + 2 * SHM_V;
#pragma unroll
    for (int d0 = 0; d0 < 8; ++d0) S.qr[d0] = load8(cur.Q + (size_t)(wid * QBLK + r32) * D + d0 * 16 + hi * 8);
    SLOAD_H(cur.K, cur.V, 0); VMW(); SWRITE_HK(0);
    __syncthreads();
}
__device__ __forceinline__ unsigned moba_select(const Seam& S, const float* KM, int qb, int hi) {
    if (qb <= 3) return (1u << qb) - 1u;
    float sc_[8];
#pragma unroll
    for (int j = 0; j < 8; ++j) sc_[j] = 0.f;
#pragma unroll
    for (int j = 0; j < 7; ++j) {
        if (j < qb) {
            float s = 0.f;
#pragma unroll
            for (int d0 = 0; d0 < 8; ++d0) {
                const f32x4 k0 = *(const f32x4*)(KM + j * D + d0 * 16 + hi * 8), k1 = *(const f32x4*)(KM + j * D + d0 * 16 + hi * 8 + 4);
                const bf16x8 q = S.qr[d0];
                s += bf1((bf16_t)q[0]) * k0[0] + bf1((bf16_t)q[1]) * k0[1] + bf1((bf16_t)q[2]) * k0[2] + bf1((bf16_t)q[3]) * k0[3]
                   + bf1((bf16_t)q[4]) * k1[0] + bf1((bf16_t)q[5]) * k1[1] + bf1((bf16_t)q[6]) * k1[2] + bf1((bf16_t)q[7]) * k1[3];
            }
            s += __shfl_xor(s, 32);
            sc_[j] = s;
        }
    }
    unsigned sel = 0u;
#pragma unroll
    for (int it = 0; it < 3; ++it) {
        float best = -__builtin_inff(); int bi = 0;
#pragma unroll
        for (int j = 0; j < 7; ++j) { const bool ok = (j < qb) && !((sel >> j) & 1u) && (sc_[j] > best); best = ok ? sc_[j] : best; bi = ok ? j : bi; }
        sel |= 1u << bi;
    }
    return sel;
}
__device__ __forceinline__ void moba_block(const BlockRef& cur, const BlockRef& nxt, char* lds, Seam& S, int wv) {
    const int tid = opq_tid(wv), wid = __builtin_amdgcn_readfirstlane(tid >> 6), lane = tid & 63, r32 = lane & 31, hi = lane >> 5;
    const int NT = cur.P0 / KVBLK + 4;
    const int qb = cur.P0 >> 8;
    const int qlo = cur.P0 + wid * QBLK, qm = qlo + r32 - 4 * hi;
    char* V_lds = lds; char* K_lds = lds + 2 * SHM_V;
    float* ws = (float*)(lds + 2 * SHM_V + 2 * SHM_K) + wid * 64; float* li_l = ws, * al_l = ws + 32;
    float m_reg = -1e30f, l_reg = 0; f32x16 o[4] = {};
    const int sr = tid >> 4, sc = (tid & 15) * 8, vst0 = v_st(sr, sc), vst1 = v_st(32 + sr, sc), kws = KSWZ(sr, sc * 2);
    const int vb0 = (int)(uintptr_t)V_lds + v_rd_base(lane);
    const bf16_t* Kh = cur.K; const bf16_t* Vh = cur.V;
    const bool need_sel = qb > 3;
    const float* kml = (const float*)(lds + 69632);
    if (need_sel) { if (tid < 224) ((f32x4*)(lds + 69632))[tid] = ((const f32x4*)cur.KM)[tid]; __syncthreads(); }
    const unsigned sel = moba_select(S, kml, qb, hi);
#define RESC(a) do { if (__any((a) < 1.f)) { if (hi == 0) al_l[r32] = (a); asm volatile("s_waitcnt lgkmcnt(0)" ::: "memory");              \
                     for (int d_ = 0; d_ < 4; ++d_) for (int r = 0; r < 16; ++r) o[d_][r] *= al_l[crow(r, hi)]; } } while (0)
#define KBASE(t) ((t) * KVBLK)
#define MASKT(P0_, P1_, t) do { const int kb_ = KBASE(t); rb_ = 0.f; \
        if (kb_ < cur.P0) { if (need_sel) rb_ = (((sel >> (kb_ >> 8)) & 1u) == 0u) ? -__builtin_inff() : 0.f; } \
        else if (kb_ + KVBLK - 1 > qlo) mask_tile(P0_, P1_, qm - kb_); } while (0)
#define SEAM_K0() do { VMWN(8); SWRITE_HK(0); SBAR(); } while (0)
    f32x16 pA0, pA1, pB0, pB1; float mnA, mnB, alA, alB, rb_ = 0.f; bf16x8 pa0, pa1, pa2, pa3;
    SWRITE_HV(0); SBAR();
    SLOAD_H(Kh, Vh, KBASE(1));
    SBAR(); qkt<0>(pA0, pA1, K_lds, r32, hi, S.qr);
    MASKT(pA0, pA1, 0); partialSM(pA0, pA1, m_reg, mnA, alA, rb_);
    VMW(); SWRITE_H(1);
    __syncthreads();
#define HALF_STEP(PX0, PX1, mnX, alX, PY0, PY1, alY, t, KB, VB, SB) do {                                                      \
        SBAR(); qkt<KB>(PX0, PX1, K_lds, r32, hi, S.qr);                                                                       \
        finishSM(PY0, PY1, alY, l_reg, pa0, pa1, pa2, pa3); SBAR();                                                           \
        if ((t) + 1 < NT) { SLOAD_H(Kh, Vh, KBASE((t) + 1)); SBAR(); }                                                        \
        pv_tile<VB>(o, vb0, pa0, pa1, pa2, pa3); MASKT(PX0, PX1, (t)); partialSM(PX0, PX1, m_reg, mnX, alX, rb_);                  \
        __syncthreads();                                                                                                      \
        if ((t) + 1 < NT) { VMW(); SWRITE_H(SB); }                                                                            \
        RESC(alX); __syncthreads(); } while (0)
    for (int t = 1; t + 1 < NT; t += 2) {
        HALF_STEP(pB0, pB1, mnB, alB, pA0, pA1, alA, t, 1, 0, 0);
        HALF_STEP(pA0, pA1, mnA, alA, pB0, pB1, alB, t + 1, 0, 1, 1);
    }
    SBAR(); qkt<1>(pB0, pB1, K_lds, r32, hi, S.qr); SBAR();
    SLOAD_H(nxt.K, nxt.V, 0); SBAR();
#pragma unroll
    for (int d0 = 0; d0 < 8; ++d0) S.qr[d0] = load8(nxt.Q + (size_t)(wid * QBLK + r32) * D + d0 * 16 + hi * 8);
    SBAR();
    finishSM(pA0, pA1, alA, l_reg, pa0, pa1, pa2, pa3); SBAR();
    pv_tile<0>(o, vb0, pa0, pa1, pa2, pa3);
    MASKT(pB0, pB1, NT - 1); partialSM(pB0, pB1, m_reg, mnB, alB, rb_); __syncthreads(); RESC(alB);
    finishSM(pB0, pB1, alB, l_reg, pa0, pa1, pa2, pa3); SBAR(); pv_tile<1>(o, vb0, pa0, pa1, pa2, pa3);
    SBAR(); SEAM_K0();
    if (hi == 0) li_l[r32] = l_reg; asm volatile("s_waitcnt lgkmcnt(0)" ::: "memory");
    bf16_t* Ow = cur.O + (size_t)(wid * QBLK) * DM; const bf16_t* Gw = cur.Gt + (size_t)(wid * QBLK) * DM + r32;
    bf16_t gl[16][4];
#pragma unroll
    for (int r = 0; r < 16; ++r)
#pragma unroll
        for (int d0 = 0; d0 < 4; ++d0) gl[r][d0] = Gw[(size_t)crow(r, hi) * DM + d0 * 32];
#pragma unroll
    for (int r = 0; r < 16; ++r) { const int orow = crow(r, hi); const float rl = __builtin_amdgcn_rcpf(li_l[orow]);
#pragma unroll
        for (int d0 = 0; d0 < 4; ++d0) { const float gv = bf1(gl[r][d0]);
            const float v = o[d0][r] * rl * gv;
            const float vn = __shfl_xor(v, 1);
            if ((r32 & 1) == 0) *(unsigned*)(Ow + (size_t)orow * DM + d0 * 32 + r32) = cvt_pk_bf16(v, vn); } }
    __syncthreads();
#undef RESC
#undef KBASE
#undef MASKT
#undef SEAM_K0
#undef HALF_STEP
}
#undef ROW
#undef VMW
#undef VMWN
#undef SLOAD_H
#undef SWRITE_HK
#undef SWRITE_HV
#undef SWRITE_H

__device__ __forceinline__ BlockRef mk_ref(int L, int pass, const bf16_t* Q, const bf16_t* K, const bf16_t* V, bf16_t* O, const bf16_t* Gt, const float* KM) {
    const int bh = L >> 2, x = L & 3, qb = pass ? 7 - x : x, b = bh >> 3, h = bh & 7;
    BlockRef r;
    r.Q = Q + ((size_t)bh * SEQ + (size_t)qb * QB) * D; r.K = K + (size_t)bh * SEQ * D; r.V = V + (size_t)bh * SEQ * D;
    r.O = O + ((size_t)b * SEQ + (size_t)qb * QB) * DM + h * DH; r.Gt = Gt + ((size_t)b * SEQ + (size_t)qb * QB) * DM + h * DH;
    r.KM = KM + (size_t)bh * 8 * D; r.P0 = qb * QB;
    return r;
}
__device__ __forceinline__ void attn_phase(char* lds, const bf16_t* Q, const bf16_t* K, const bf16_t* V, bf16_t* O, const bf16_t* Gt, const float* KM, int wv) {
    const int total = NB * NH * 4, stride = gridDim.x;
    int L = opq_bid(); if (L >= total) return;
    if (stride == 256) { const int xcd = L & 7, j = L >> 3; L = ((xcd * 8 + (j >> 2)) << 2) | (j & 3); }
    int pass = 0;
    BlockRef cur = mk_ref(L, 0, Q, K, V, O, Gt, KM);
    Seam S;
    moba_prime(cur, lds, S, wv);
    for (;;) {
        const bool more_pass = pass == 0, more_item = L + stride < total, last = !more_pass && !more_item;
        int passn = pass + 1, Ln = L;
        if (!more_pass) { passn = 0; Ln = more_item ? L + stride : L; }
        const BlockRef nxt = last ? cur : mk_ref(Ln, passn, Q, K, V, O, Gt, KM);
        moba_block(cur, nxt, lds, S, wv);
        if (last) break;
        cur = nxt; pass = passn; L = Ln;
    }
}
}

#ifndef REP_MASK
#define REP_MASK 0
#endif
#ifndef BAR_REP
#define BAR_REP 1
#endif
struct Args { const float* in[21]; float* out; unsigned char* ws; int ph_lo, ph_hi; };
typedef const __attribute__((address_space(4))) Args* ArgsP;
#define AIN(i) ((const float*)ap->in[i])

__device__ __forceinline__ void transpose_item(const float* W, int ldw, bf16_t* WT, int ldt, LAS float* scr, int lane) {
    float tv[32];
#pragma unroll
    for (int i = 0; i < 32; ++i) { const int kk = 2 * i + (lane >> 5); tv[i] = __builtin_nontemporal_load(W + (size_t)kk * ldw + (lane & 31)); }
#pragma unroll
    for (int i = 0; i < 32; ++i) { const int kk = 2 * i + (lane >> 5); scr[kk * 33 + (lane & 31)] = tv[i]; }
    asm volatile("s_waitcnt lgkmcnt(0)" ::: "memory");
    const int c = lane & 7;
#pragma unroll
    for (int j = 0; j < 4; ++j) { const int n = (lane >> 3) + 8 * j; const LAS float* s = scr + (8 * c) * 33 + n;
        u32x4 o; o.x = cvt_pk_bf16(s[0 * 33], s[1 * 33]); o.y = cvt_pk_bf16(s[2 * 33], s[3 * 33]); o.z = cvt_pk_bf16(s[4 * 33], s[5 * 33]); o.w = cvt_pk_bf16(s[6 * 33], s[7 * 33]);
        *(u32x4*)(WT + (size_t)n * ldt + 8 * c) = o; }
    asm volatile("s_waitcnt lgkmcnt(0)" ::: "memory");
}
__device__ __forceinline__ void transpose_mat(const float* W, int K, int N, bf16_t* WT, int item, LAS float* scr, int lane) {
    const int nblk = N / 32, kb = item / nblk, nb = item % nblk;
    transpose_item(W + (size_t)(64 * kb) * N + 32 * nb, N, WT + (size_t)(32 * nb) * K + 64 * kb, K, scr, lane);
}

template <bool SILU>
__device__ __forceinline__ void gemv_item(const float* vec, int vld, const float* W, int ldw, int n0, int k0, float* out, int old, const float* bias, LAS float* scr, int lane) {
    const float* wp = W + (size_t)k0 * ldw + n0 + lane;
#pragma unroll
    for (int i = 0; i < 8; ++i) { const int idx = i * 64 + lane, b = idx >> 6, kk = idx & 63; const float v = vec[(size_t)b * vld + k0 + kk]; scr[kk * 8 + b] = SILU ? fsilu(v) : v; }
    asm volatile("s_waitcnt lgkmcnt(0)" ::: "memory");
    float acc[8];
#pragma unroll
    for (int b = 0; b < 8; ++b) acc[b] = 0.f;
#pragma unroll 1
    for (int kh = 0; kh < 64; kh += 32) {
        float w[32];
#pragma unroll
        for (int kk = 0; kk < 32; ++kk) w[kk] = __builtin_nontemporal_load(wp + (size_t)(kh + kk) * ldw);
#pragma unroll
        for (int kk = 0; kk < 32; ++kk) {
            const f32x4 c0 = *(const LAS f32x4*)(scr + (kh + kk) * 8), c1 = *(const LAS f32x4*)(scr + (kh + kk) * 8 + 4);
            acc[0] += w[kk] * c0[0]; acc[1] += w[kk] * c0[1]; acc[2] += w[kk] * c0[2]; acc[3] += w[kk] * c0[3];
            acc[4] += w[kk] * c1[0]; acc[5] += w[kk] * c1[1]; acc[6] += w[kk] * c1[2]; acc[7] += w[kk] * c1[3];
            if ((kk & 3) == 3) __builtin_amdgcn_sched_barrier(0); }
    }
    const float bv = bias ? bias[n0 + lane] : 0.f;
#pragma unroll
    for (int b = 0; b < 8; ++b) atomicAdd(out + (size_t)b * old + n0 + lane, acc[b] + bv);
    asm volatile("s_waitcnt lgkmcnt(0)" ::: "memory");
}
__device__ __forceinline__ void prep0_phase(ArgsP ap, LAS unsigned char* lds, int wave, int lane) {
    unsigned char* ws = (unsigned char*)ap->ws;
    LAS float* scr = (LAS float*)(lds + wave * 16384);
    const int gw = opq_bid() * NWAVES + wave, NGW = gridDim.x * NWAVES;
    for (int r = gw; r < (MODV_LD / 64) * 16; r += NGW) {
        const int cgp = r >> 4, kc = r & 15;
        const float* W; int ldw, n0; const float* bias;
        if (cgp < 192) { const int l = cgp / 48; n0 = (cgp % 48) * 64; W = AIN(2) + (size_t)l * DM * 3 * DM; ldw = 3 * DM; bias = AIN(3) + l * 3 * DM; }
        else { n0 = (cgp - 192) * 64; W = AIN(15); ldw = 2 * DM; bias = AIN(16); }
        gemv_item<true>(AIN(1), DM, W, ldw, n0, kc * 64, (float*)(ws + WS_MODV) + (cgp * 64 - n0), MODV_LD, kc == 0 ? bias : nullptr, scr, lane);
    }
}
__device__ __forceinline__ void prep1_phase(ArgsP ap, LAS unsigned char* lds, int wave, int lane) {
    unsigned char* ws = (unsigned char*)ap->ws;
    LAS float* scr = (LAS float*)(lds + wave * 16384);
    const int gw = opq_bid() * NWAVES + wave, NGW = gridDim.x * NWAVES;
    constexpr int I_BIG = (DM / 64) * (2 * DM / 32);
    constexpr int I_SQ = (DM / 64) * (DM / 32);
    constexpr int I_G = (256 / 64) * (256 / 32);
    constexpr int N_T = 2 * I_BIG + 2 * I_SQ + 2 * I_BIG + I_BIG + 2 * I_SQ + 16 * I_G;
    constexpr int N_GEMV = 4 * 32 * 16;
    for (int it = gw; it < N_T + N_GEMV; it += NGW) {
        int r = it;
        if (r < N_GEMV) {
            const int slot = r >> 9, q = r & 511, cgp = q >> 4, kc = q & 15;
            const size_t woff = slot == 0 ? (size_t)DM * 2 * DM : slot == 3 ? (size_t)DM * 2 * DM : 0;
            const float* W = (slot == 0 ? AIN(5) : slot == 2 ? AIN(17) : AIN(18)) + woff;
            const int shcol = slot == 0 ? 1 * 3 * DM : slot == 1 ? 2 * 3 * DM : slot == 2 ? 4 * 3 * DM : 3 * 3 * DM;
            gemv_item<false>((const float*)(ws + WS_MODV) + shcol, MODV_LD, W, 2 * DM, cgp * 64, kc * 64, (float*)(ws + WS_SHW) + (size_t)slot * 8 * 2 * DM, 2 * DM, nullptr, scr, lane);
            continue;
        } r -= N_GEMV;
        const float* W; bf16_t* WT; int ldw, ldt;
        if (r < 6 * I_BIG + 0 * I_SQ && r < 2 * I_BIG) { const int l = r / I_BIG, item = r % I_BIG, kb = item / 64, nb = item % 64;
            W = AIN(5) + (size_t)l * DM * 2 * DM + (size_t)(64 * kb) * 2 * DM + 32 * nb; ldw = 2 * DM; WT = (bf16_t*)(ws + WS_WIN) + (size_t)l * 2 * DM * DM + (size_t)(32 * nb) * DM + 64 * kb; ldt = DM; }
        else if ((r -= 2 * I_BIG) < 2 * I_SQ) { const int l = r / I_SQ, item = r % I_SQ, kb = item / 32, nb = item % 32;
            W = AIN(13) + (size_t)l * DM * DM + (size_t)(64 * kb) * DM + 32 * nb; ldw = DM; WT = (bf16_t*)(ws + WS_WOUT) + (size_t)l * DM * DM + (size_t)(32 * nb) * DM + 64 * kb; ldt = DM; }
        else if ((r -= 2 * I_SQ) < 2 * I_BIG) { const int l = r / I_BIG, item = r % I_BIG, kb = item / 64, nb = item % 64;
            W = AIN(18) + (size_t)l * DM * 2 * DM + (size_t)(64 * kb) * 2 * DM + 32 * nb; ldw = 2 * DM; WT = (bf16_t*)(ws + (l ? WS_ATTIN1 : WS_ATTIN0)) + (size_t)(32 * nb) * DM + 64 * kb; ldt = DM; }
        else if ((r -= 2 * I_BIG) < I_BIG) { const int kb = r / 64, nb = r % 64;
            W = AIN(17) + (size_t)(64 * kb) * 2 * DM + 32 * nb; ldw = 2 * DM; WT = (bf16_t*)(ws + WS_WKV) + (size_t)(32 * nb) * DM + 64 * kb; ldt = DM; }
        else if ((r -= I_BIG) < 2 * I_SQ) { const int l = r / I_SQ, item = r % I_SQ, kb = item / 32, nb = item % 32;
            W = AIN(19) + (size_t)l * DM * DM + (size_t)(64 * kb) * DM + 32 * nb; ldw = DM; WT = (bf16_t*)(ws + WS_ATTOUT) + (size_t)l * DM * DM + (size_t)(32 * nb) * DM + 64 * kb; ldt = DM; }
        else { r -= 2 * I_SQ;
            const int mat = r / I_G, item = r % I_G, which = mat >> 3, lh = mat & 7;
            const int kb = item / 8, nb = item % 8, n0 = 32 * nb, drow = 256 * (n0 >> 7) + 128 * which + (n0 & 127);
            W = (which ? AIN(10) : AIN(8)) + (size_t)lh * 256 * 256 + (size_t)(64 * kb) * 256 + n0; ldw = 256;
            WT = (bf16_t*)(ws + WS_WG) + (size_t)lh * 512 * 256 + (size_t)drow * 256 + 64 * kb; ldt = 256; }
        transpose_item(W, ldw, WT, ldt, scr, lane);
    }
}

__device__ __forceinline__ void norm_phase(const float* xin, bf16_t* o1, const float* g1, const float* modv, int sh1, int sc1c,
                                            bf16_t* o2, const float* g2, int sh2, int sc2c, int wave, int lane) {
    const int gw = opq_bid() * NWAVES + wave, NGW = gridDim.x * NWAVES;
    for (int rb = gw; rb < MTOK / 8; rb += NGW) {
        const int cb_ = rb >> 3, r0 = (NGW == 2048) ? ((cb_ & 7) * SEQ + (cb_ >> 3) * 64 + (rb & 7) * 8) : rb * 8, b = r0 / SEQ;
        const float* mv = modv + (size_t)b * MODV_LD;
        f32x4 gs1[4], sf1[4], gs2[4], sf2[4];
#pragma unroll
        for (int j = 0; j < 4; ++j) { const int idx = 4 * lane + 256 * j;
            const f32x4 gv = *(const f32x4*)(g1 + idx), sc = *(const f32x4*)(mv + sc1c + idx); gs1[j] = gv * (sc + 1.f); sf1[j] = *(const f32x4*)(mv + sh1 + idx);
            if (o2) { const f32x4 gv2 = *(const f32x4*)(g2 + idx), sc2 = *(const f32x4*)(mv + sc2c + idx); gs2[j] = gv2 * (sc2 + 1.f); sf2[j] = *(const f32x4*)(mv + sh2 + idx); }
            else { gs2[j] = gs1[j]; sf2[j] = sf1[j]; } }
        for (int rr = 0; rr < 8; ++rr) {
            const size_t row = (size_t)(r0 + rr);
            const f32x4* xr = (const f32x4*)(xin + row * DM) + lane;
            f32x4 v[4]; float s = 0.f;
#pragma unroll
            for (int j = 0; j < 4; ++j) { v[j] = xr[64 * j]; s += (v[j].x * v[j].x + v[j].y * v[j].y) + (v[j].z * v[j].z + v[j].w * v[j].w); }
            const float rstd = 1.f / sqrtf(wave_sum(s) * (1.f / DM) + EPS);
#pragma unroll
            for (int j = 0; j < 4; ++j) { const f32x4 t = v[j] * rstd; const f32x4 y = t * gs1[j] + sf1[j];
                u32x2 w; w.x = cvt_pk_bf16(y.x, y.y); w.y = cvt_pk_bf16(y.z, y.w);
                *((u32x2*)(o1 + row * DM) + lane + 64 * j) = w;
                if (o2) { const f32x4 y2 = t * gs2[j] + sf2[j]; u32x2 w2; w2.x = cvt_pk_bf16(y2.x, y2.y); w2.y = cvt_pk_bf16(y2.z, y2.w);
                    *((u32x2*)(o2 + row * DM) + lane + 64 * j) = w2; } }
        }
    }
}
__device__ __forceinline__ void conv_phase(const bf16_t* UP, bf16_t* U, const float* cw, const float* cb, int tid) {
    const int ch = 8 * (tid & 127), sub = tid >> 7;
    float w0[8], w1[8], w2[8], w3[8], bb[8];
#pragma unroll
    for (int h = 0; h < 2; ++h) { const f32x4 a = *(const f32x4*)(cw + ch + 4 * h), b = *(const f32x4*)(cw + DM + ch + 4 * h), c = *(const f32x4*)(cw + 2 * DM + ch + 4 * h), d = *(const f32x4*)(cw + 3 * DM + ch + 4 * h), e = *(const f32x4*)(cb + ch + 4 * h);
#pragma unroll
        for (int j = 0; j < 4; ++j) { w0[4 * h + j] = a[j]; w1[4 * h + j] = b[j]; w2[4 * h + j] = c[j]; w3[4 * h + j] = d[j]; bb[4 * h + j] = e[j]; } }
    for (int it = opq_bid(); it < NB * 32; it += gridDim.x) {
        const int b = it >> 5, c = it & 31, t0 = c * 64 + sub * 16; const size_t base = ((size_t)b * SEQ + t0) * DM + ch;
        u32x4 rw[19];
#pragma unroll
        for (int t = 0; t < 19; ++t) rw[t] = (t0 + t - 3 >= 0) ? *(const u32x4*)(UP + base + (ptrdiff_t)(t - 3) * DM) : (u32x4){0u, 0u, 0u, 0u};
#pragma unroll
        for (int t = 0; t < 16; ++t) {
            unsigned ow[4];
#pragma unroll
            for (int q = 0; q < 4; ++q) { const unsigned a0 = rw[t][q], a1 = rw[t + 1][q], a2 = rw[t + 2][q], a3 = rw[t + 3][q];
                const float lo = bb[2 * q] + w0[2 * q] * bf_lo(a0) + w1[2 * q] * bf_lo(a1) + w2[2 * q] * bf_lo(a2) + w3[2 * q] * bf_lo(a3);
                const float hi = bb[2 * q + 1] + w0[2 * q + 1] * bf_hi(a0) + w1[2 * q + 1] * bf_hi(a1) + w2[2 * q + 1] * bf_hi(a2) + w3[2 * q + 1] * bf_hi(a3);
                ow[q] = cvt_pk_bf16(lo, hi); }
            *(u32x4*)(U + base + (size_t)t * DM) = (u32x4){ow[0], ow[1], ow[2], ow[3]}; }
    }
}

#define XB_TMO      128
#define XB_XCNT(j)  (256  + 64 * (j))
#define XB_XSUB(j)  (1280 + 64 * (j))
#define XB_XGEN(j)  (2304 + 64 * (j))
#define XB_TOP      3328
#define XB_TOPGEN   3392
#define XCD_BAR_WORDS 3456
#define XB_SPIN_CAP (1u << 18)
constexpr size_t WS_BAR = 16384;
constexpr int LDS_MISC = 131072 + 320;
__device__ __forceinline__ unsigned xb_ld(unsigned* p)              { return __hip_atomic_load(p, __ATOMIC_RELAXED, __HIP_MEMORY_SCOPE_AGENT); }
__device__ __forceinline__ unsigned xb_add(unsigned* p, unsigned v) { return __hip_atomic_fetch_add(p, v, __ATOMIC_RELAXED, __HIP_MEMORY_SCOPE_AGENT); }
__device__ __forceinline__ unsigned xb_xcc_id() { return (unsigned)__builtin_amdgcn_s_getreg((3 << 11) | 20) & 0xFu; }
#define XB_SPIN(cond, bar) do { unsigned _sp = 0; while (cond) { __builtin_amdgcn_s_sleep(1); \
    if ((++_sp & 255u) == 0u) { if (xb_ld(&(bar)[XB_TMO])) break; if (_sp > XB_SPIN_CAP) { atomicAdd(&(bar)[XB_TMO], 1u); break; } } } } while (0)
__device__ __forceinline__ void xcd_barrier_complete(unsigned* bar, unsigned x, unsigned& nloc, unsigned& nx) {
    const unsigned G = gridDim.x * gridDim.y * gridDim.z;
    unsigned sum, cnt, mine, sp = 0u;
    for (;;) {
        sum = 0u; cnt = 0u; mine = 0u;
#pragma unroll
        for (unsigned j = 0; j < 16; ++j) { const unsigned c = xb_ld(&bar[XB_XCNT(j)]); sum += c; cnt += (c > 0u) ? 1u : 0u; mine = (j == x) ? c : mine; }
        if (sum == G) break;
        __builtin_amdgcn_s_sleep(1);
        if ((++sp & 255u) == 0u) { if (xb_ld(&bar[XB_TMO])) break; if (sp > XB_SPIN_CAP) { atomicAdd(&bar[XB_TMO], 1u); break; } }
    }
    nloc = mine > 0u ? mine : 1u; nx = cnt > 0u ? cnt : 1u;
}
__device__ __forceinline__ void xcd_barrier(unsigned* bar, volatile LAS unsigned* st, int tid) {
    asm volatile("s_waitcnt vmcnt(0)" ::: "memory");
    __syncthreads();
    if (tid == 0) {
        const unsigned x = xb_xcc_id();
        __builtin_amdgcn_s_waitcnt(0);
        unsigned nloc = st[0], nx = st[1];
        if (nloc == 0u) { xcd_barrier_complete(bar, x, nloc, nx); st[0] = nloc; st[1] = nx; }
        const unsigned old = xb_add(&bar[XB_XSUB(x)], 1u);
        const unsigned gen = old / nloc;
        if (old + 1u == (gen + 1u) * nloc) {
            __builtin_amdgcn_fence(__ATOMIC_RELEASE, "agent");
            asm volatile("s_waitcnt vmcnt(0)" ::: "memory");
            const unsigned og = xb_add(&bar[XB_TOP], 1u);
            const unsigned tg = og / nx;
            if (og + 1u == (tg + 1u) * nx) xb_add(&bar[XB_TOPGEN], 1u);
            else XB_SPIN(xb_ld(&bar[XB_TOPGEN]) == tg, bar);
            __builtin_amdgcn_fence(__ATOMIC_ACQUIRE, "agent");
            xb_add(&bar[XB_XGEN(x)], 1u);
            asm volatile("s_waitcnt vmcnt(0)" ::: "memory");
        } else {
            XB_SPIN(xb_ld(&bar[XB_XGEN(x)]) == gen, bar);
            __builtin_amdgcn_fence(__ATOMIC_ACQUIRE, "agent");
            asm volatile("s_waitcnt vmcnt(0)" ::: "memory");
        }
    }
    __syncthreads();
}

constexpr int NPHASE = 14;
#ifndef PH_EN
#define PH_EN 0xFFFF
#endif
#define EN(b) ((PH_EN >> (b)) & 1)
#ifndef REP_MASK
#define REP_MASK 0
#endif
#define REPS(b) for (int rep_ = 0; rep_ < EN(b) * (1 + ((REP_MASK >> (b)) & 1)); ++rep_)
template <int ph>
__device__ __forceinline__ void run_phase(unsigned char* lds, int wv) {
    LAS unsigned char* ldsl = (LAS unsigned char*)lds;
    {
        ArgsP ap = (ArgsP)__builtin_amdgcn_kernarg_segment_ptr();
        asm volatile("" : "+s"(ap));
        const int G = gridDim.x;
        unsigned char* ws = (unsigned char*)ap->ws;
        float* modv = (float*)(ws + WS_MODV);
        float* kmean = (float*)(ws + WS_KMEAN);
        bf16_t* HN = (bf16_t*)(ws + WS_HN); bf16_t* HKV = (bf16_t*)(ws + WS_HKV); bf16_t* UPRE = (bf16_t*)(ws + WS_UPRE); bf16_t* GB = (bf16_t*)(ws + WS_G);
        bf16_t* LAb = (bf16_t*)(ws + WS_LA); bf16_t* BINb = (bf16_t*)(ws + WS_BIN);
        float* xw = (float*)ap->out;
        const int tid = opq_tid(wv), c = opq_bid();
        const int lane = tid & 63, wave = __builtin_amdgcn_readfirstlane(tid >> 6);
        float* sumsq = (float*)(ws + WS_SUMSQ); const float* shw = (const float*)(ws + WS_SHW);
        if (ph == 0) {
            if (EN(0)) prep0_phase(ap, ldsl, wave, lane);
        } else if (ph == 1) {
            REPS(1) norm_phase(AIN(0), HN, AIN(4), modv, 0, DM, nullptr, nullptr, 0, 0, wave, lane);
            if (EN(0)) prep1_phase(ap, ldsl, wave, lane);
        } else if (ph <= 7) {
            const int l = (ph - 2) / 3, k3 = (ph - 2) % 3, k = k3 == 0 ? 0 : k3 + 1;
            const float* xin = (l == 0) ? AIN(0) : xw;
            if (k == 0) {
                pg8::Gemm g{l == 0 ? HN : HKV, (const bf16_t*)(ws + WS_WIN) + (size_t)l * 2 * DM * DM, DM, DM, DM, 0, 0};
                int one = 1; asm volatile("" : "+s"(one));
                { pg8::InOrder S{c, one, 0};
                  pg8::EpiSplitConv E{ws, l == 0 ? nullptr : sumsq, shw, AIN(6) + l * 4 * DM, AIN(7) + l * DM, 4u * (unsigned)(l + 1), ldsl};
                  REPS(2) pg8::gemm_phase(ldsl, g, S, E, wv); }
                { pg8::InOrder S{c, one, 1};
                  pg8::EpiSplit E{UPRE, GB, l == 0 ? nullptr : sumsq, shw};
                  REPS(2) pg8::gemm_phase(ldsl, g, S, E, wv); }
            } else if (k == 1) {
                REPS(3) conv_phase(UPRE, HKV, AIN(6) + l * 4 * DM, AIN(7) + l * DM, tid);
            } else if (k == 2) {
                pg8::Gemm g{UPRE, (const bf16_t*)(ws + WS_WG) + (size_t)l * 4 * 512 * 256, DM, 256, 256, 256 * 2, 512 * 256 * 2};
                int two = 2; asm volatile("" : "+s"(two));
                pg8::GatesOrder S{c, two};
                pg8::EpiGatesS E{ws, 4u * (unsigned)(l + 1), AIN(9) + l * DM, AIN(11) + l * DM, AIN(12) + l * DM, ldsl};
                REPS(4) pg8::gemm_phase(ldsl, g, S, E, wv);
            } else {
                pg8::Gemm g{HN, (const bf16_t*)(ws + WS_WOUT) + (size_t)l * DM * DM, DM, DM, DM, 0, 0};
                pg8::MultiOrder S; S.init(MTOK, DM, 1, G, c);
                _Float16* x16 = (_Float16*)(ws + WS_X16);
                if (l == 0) { pg8::EpiResH<float, false> E{AIN(0), x16, modv + 2 * DM, modv, HKV, AIN(4) + DM, 3 * DM + DM, nullptr, nullptr, 0, sumsq};
                    REPS(7) pg8::gemm_phase(ldsl, g, S, E, wv); }
                else { pg8::EpiResH<_Float16, true> E{x16, x16, modv + l * 3 * DM + 2 * DM, modv, HKV, AIN(4) + (l + 1) * DM, (l + 1) * 3 * DM + DM,
                              LAb, AIN(14), 4 * 3 * DM + DM, sumsq + (size_t)l * MTOK};
                    REPS(7) pg8::gemm_phase(ldsl, g, S, E, wv); }
            }
        } else if (ph <= 13) {
            const int i = (ph - 8) / 3, k = (ph - 8) % 3, l = 2 + i;
            if (k == 0) {
                pg8::Gemm g{i == 0 ? HKV : LAb, (const bf16_t*)(ws + (i == 0 ? WS_ATTIN0 : WS_ATTIN1)), DM, DM, DM, (long)(WS_LA - WS_HKV), (long)(WS_WKV - WS_ATTIN0)};
                pg8::MultiOrder S; S.init(MTOK, 2 * DM, i == 0 ? 2 : 1, G, c);
                pg8::EpiQKV E{ws, kmean, sumsq + (size_t)(1 + i) * MTOK, shw + (size_t)(i == 0 ? 1 : 3) * 8 * 2 * DM, 8 * 2 * DM};
                REPS(9) pg8::gemm_phase(ldsl, g, S, E, wv);
            } else if (k == 1) {
                REPS(10) att::attn_phase((char*)lds, UPRE, HN, BINb, HKV, GB, kmean, wv);
            } else if (i == 0) {
                pg8::Gemm g{HKV, (const bf16_t*)(ws + WS_ATTOUT), DM, DM, DM, 0, 0};
                pg8::MultiOrder S; S.init(MTOK, DM, 1, G, c);
                _Float16* x16 = (_Float16*)(ws + WS_X16);
                pg8::EpiResH<_Float16, false> E{x16, x16, modv + l * 3 * DM + 2 * DM, modv, LAb, AIN(4) + 3 * DM, 3 * 3 * DM + DM, nullptr, nullptr, 0, sumsq + (size_t)2 * MTOK};
                REPS(11) pg8::gemm_phase(ldsl, g, S, E, wv);
            } else {
                pg8::Gemm g{HKV, (const bf16_t*)(ws + WS_ATTOUT) + (size_t)DM * DM, DM, DM, DM, 0, 0};
                pg8::MultiOrder S; S.init(MTOK, DM, 1, G, c);
                pg8::EpiFinal E{(const _Float16*)(ws + WS_X16), xw, modv + l * 3 * DM + 2 * DM, AIN(20), sumsq + (size_t)3 * MTOK, (unsigned*)(ws + WS_PCNT)};
                REPS(12) pg8::gemm_phase(ldsl, g, S, E, wv);
            }
        }
    }
}
__global__ void __launch_bounds__(NTHR, 2) yoco_fwd(Args a_) {
    extern __shared__ __attribute__((aligned(16))) unsigned char lds[];
    const int ph_lo = a_.ph_lo, ph_hi = a_.ph_hi;
    const int wv = __builtin_amdgcn_readfirstlane((int)threadIdx.x >> 6);
    if (ph_hi - ph_lo > 1) {
        if (threadIdx.x < 8) ((volatile LAS unsigned*)((LAS unsigned char*)lds + LDS_MISC))[threadIdx.x] = 0u;
        if (threadIdx.x == 0) (void)xb_add(&((unsigned*)(a_.ws + WS_BAR))[XB_XCNT(xb_xcc_id())], 1u);
        __syncthreads();
    }
#define SEAM(P) do { ArgsP ap_ = (ArgsP)__builtin_amdgcn_kernarg_segment_ptr(); asm volatile("" : "+s"(ap_)); \
        xcd_barrier((unsigned*)((unsigned char*)ap_->ws + WS_BAR), (volatile LAS unsigned*)((LAS unsigned char*)lds + LDS_MISC), opq_tid(wv)); } while (0)
#ifndef TPROBE_MASK
#define TPROBE_MASK 0
#endif
#define TPROBE_MULT 10
#define TP_ON(P) ((TPROBE_MASK >> (P)) & 1)
#define TP_BEGIN(P) if (TP_ON(P) && blockIdx.x == 0 && opq_tid(wv) == 0) { volatile LAS unsigned long long* tw_ = (volatile LAS unsigned long long*)((LAS unsigned char*)lds + LDS_MISC + 16); tw_[1] = __builtin_amdgcn_s_memrealtime(); }
#define TP_END(P) if (TP_ON(P) && blockIdx.x == 0 && opq_tid(wv) == 0) { volatile LAS unsigned long long* tw_ = (volatile LAS unsigned long long*)((LAS unsigned char*)lds + LDS_MISC + 16); tw_[0] = tw_[0] + (__builtin_amdgcn_s_memrealtime() - tw_[1]); }
#define RUN(P) if ((P) >= ph_lo && (P) < ph_hi) { TP_BEGIN(P) run_phase<P>(lds, wv); if ((P) + 1 < ph_hi) { for (int br_ = 0; br_ < BAR_REP; ++br_) SEAM(P); } TP_END(P) }
    RUN(0) RUN(1) RUN(2) RUN(3) RUN(4) RUN(5) RUN(6) RUN(7) RUN(8) RUN(9) RUN(10) RUN(11)
    RUN(12) RUN(13)
#undef RUN
#undef SEAM
    if (TPROBE_MASK != 0 && blockIdx.x == 0 && opq_tid(wv) == 0) {
        volatile LAS unsigned long long* tw_ = (volatile LAS unsigned long long*)((LAS unsigned char*)lds + LDS_MISC + 16);
        const unsigned long long span = tw_[0] * TPROBE_MULT, t0 = __builtin_amdgcn_s_memrealtime();
        while (__builtin_amdgcn_s_memrealtime() - t0 < span) __builtin_amdgcn_s_sleep(8);
    }
}

extern "C" void kernel_launch(void* const* d_in, const int* in_sizes, int n_in, void* d_out, int out_size, void* d_ws, size_t ws_size, hipStream_t stream) {
    static int grid = 0;
    if (grid == 0) {
        if (n_in != 21 || out_size != MTOK * DM || ws_size < WS_END) { fprintf(stderr, "kernel_launch: unexpected shapes (n_in %d out %d ws %zu)\n", n_in, out_size, ws_size); grid = -1; return; }
        int dev = 0, cus = 0, per_cu = 0;
        (void)hipGetDevice(&dev);
        if (hipDeviceGetAttribute(&cus, hipDeviceAttributeMultiprocessorCount, dev) != hipSuccess || cus <= 0) cus = 256;
        if (hipFuncSetAttribute((const void*)yoco_fwd, hipFuncAttributeMaxDynamicSharedMemorySize, LDS_BYTES) != hipSuccess) { fprintf(stderr, "kernel_launch: hipFuncSetAttribute failed\n"); grid = -1; return; }
        if (hipOccupancyMaxActiveBlocksPerMultiprocessor(&per_cu, (const void*)yoco_fwd, NTHR, LDS_BYTES) != hipSuccess || per_cu < 1) { fprintf(stderr, "kernel_launch: occupancy query says %d\n", per_cu); per_cu = 1; }
        (void)hipGetLastError();
        grid = cus > 256 ? 256 : cus;
    }
    if (grid < 0) return;
    (void)hipMemsetAsync((char*)d_ws + WS_CTL, 0, CTL_ZERO_BYTES, stream);
    Args a{};
    for (int i = 0; i < 21; ++i) a.in[i] = (const float*)d_in[i];
    a.out = (float*)d_out; a.ws = (unsigned char*)d_ws;
#if MK_MULTI_LAUNCH
    for (int ph = 0; ph < NPHASE; ++ph) { a.ph_lo = ph; a.ph_hi = ph + 1; hipLaunchKernelGGL(yoco_fwd, dim3(grid), dim3(NTHR), LDS_BYTES, stream, a); }
#else
    a.ph_lo = 0; a.ph_hi = NPHASE;
    void* kargs[] = {&a};
    hipError_t e = hipLaunchCooperativeKernel((const void*)yoco_fwd, dim3(grid), dim3(NTHR), kargs, LDS_BYTES, stream);
    if (e != hipSuccess) fprintf(stderr, "kernel_launch: cooperative launch failed: %s (grid %d)\n", hipGetErrorString(e), grid);
#endif
}
```

```cpp
#include <hip/hip_runtime.h>
#include <hip/hip_cooperative_groups.h>
#include <cstdio>
#include <cstdint>
namespace cg = cooperative_groups;

#ifndef MK_MULTI_LAUNCH
#define MK_MULTI_LAUNCH 0
#endif

constexpr int DM = 1024, NB = 8, SEQ = 2048, MTOK = NB * SEQ, NH = 8, DH = 128;
constexpr int MODV_LD = 14336;
constexpr float EPS = 1e-6f;
constexpr int NWAVES = 8, NTHR = 512;
constexpr int LDS_BYTES = 147456;

constexpr size_t MiB = 1u << 20;
constexpr size_t WS_CTL = 0, CTL_ZERO_BYTES = 1 * MiB + 256 * 1024;
constexpr size_t WS_MODV = 64 * 1024;
constexpr size_t WS_KMEAN = 512 * 1024;
constexpr size_t WS_GFLAG = 32 * 1024;
constexpr size_t WS_SHW = 768 * 1024;
constexpr size_t WS_PCNT = 48 * 1024;
constexpr size_t WS_CFLAG = 50 * 1024;
constexpr size_t WS_SUMSQ = 1 * MiB;
constexpr size_t WS_TA = 1 * MiB + 256 * 1024;
constexpr size_t WS_WIN = 2 * MiB;
constexpr size_t WS_WG = 10 * MiB;
constexpr size_t WS_WOUT = 12 * MiB;
constexpr size_t WS_ATTIN0 = 16 * MiB, WS_WKV = 20 * MiB, WS_ATTIN1 = 24 * MiB;
constexpr size_t WS_ATTOUT = 28 * MiB;
constexpr size_t WS_HN = 32 * MiB;
constexpr size_t WS_HKV = 64 * MiB;
constexpr size_t WS_UPRE = 96 * MiB;
constexpr size_t WS_G = 128 * MiB;
constexpr size_t WS_LA = 160 * MiB;
constexpr size_t WS_BIN = 192 * MiB;
constexpr size_t WS_X16 = 224 * MiB;
constexpr size_t WS_END = 256 * MiB;

typedef unsigned short bf16_t;
typedef short bf16x8 __attribute__((ext_vector_type(8)));
typedef short s16x4 __attribute__((ext_vector_type(4)));
typedef float f32x4 __attribute__((ext_vector_type(4)));
typedef float f32x2 __attribute__((ext_vector_type(2)));
typedef float f32x16 __attribute__((ext_vector_type(16)));
typedef unsigned u32x4 __attribute__((ext_vector_type(4)));
typedef unsigned u32x2 __attribute__((ext_vector_type(2)));
#define LAS __attribute__((address_space(3)))

__device__ __forceinline__ unsigned cvt_pk_bf16(float lo, float hi) { unsigned r; asm volatile("v_cvt_pk_bf16_f32 %0, %1, %2" : "=v"(r) : "v"(lo), "v"(hi)); return r; }
__device__ __forceinline__ float bf_lo(unsigned w) { return __uint_as_float(w << 16); }
__device__ __forceinline__ float bf_hi(unsigned w) { return __uint_as_float(w & 0xffff0000u); }
__device__ __forceinline__ float bf1(bf16_t h) { return __uint_as_float((unsigned)h << 16); }
__device__ __forceinline__ float fexp(float x) { return __builtin_amdgcn_exp2f(x * 1.4426950408889634f); }
__device__ __forceinline__ float flog(float x) { return __builtin_amdgcn_logf(x) * 0.6931471805599453f; }
__device__ __forceinline__ float fsigmoid(float x) { return __builtin_amdgcn_rcpf(1.f + fexp(-x)); }
__device__ __forceinline__ float fsilu(float x) { return x * fsigmoid(x); }
__device__ __forceinline__ int opq_tid(int wv) { int l; asm volatile("v_mbcnt_lo_u32_b32 %0, -1, 0\n\tv_mbcnt_hi_u32_b32 %0, -1, %0" : "=v"(l)); return wv * 64 + l; }
__device__ __forceinline__ int opq_bid() { int b = blockIdx.x; asm volatile("" : "+s"(b)); return b; }
__device__ __forceinline__ float wave_sum(float v) {
#pragma unroll
    for (int o = 1; o < 64; o <<= 1) v += __shfl_xor(v, o);
    return v;
}

namespace pg8 {
constexpr int BM = 256, BK = 64, HALF = 128, HTB = HALF * BK * 2, STAGE_BYTES = 8 * HTB, NXCD = 8, WGM = 8;
__host__ __device__ __forceinline__ int lds_byte(int r, int c) { const int st = (r >> 4) * 2 + (c >> 5), rr = r & 15, cc = c & 31, ob = rr * 64 + cc * 2; return st * 1024 + (ob ^ (((ob >> 9) & 1) << 5)); }
__host__ __device__ __forceinline__ void stage_rc(int b, int& R, int& C) { const int st = b / 1024, sb = b % 1024, swz = sb ^ (((sb >> 9) & 1) << 5); R = (st >> 1) * 16 + swz / 64; C = (st & 1) * 32 + (swz % 64) / 2; }
__host__ __device__ __forceinline__ int perm32(int rho) { const int n = rho >> 4, i = rho & 15; return 8 * (i >> 2) + 4 * n + (i & 3); }

struct Unit { int pm, pn, sub; };
struct Gemm { const bf16_t* A; const bf16_t* Bt; int lda, ldb, K; long a_sub, b_sub; };

struct MultiOrder {
    int nM, nN, nwg, nsub, G, c;
    __device__ void init(int M, int N, int nsub_, int G_, int c_) { nM = M / BM; nN = N / BM; nwg = nM * nN; nsub = nsub_; G = G_; c = c_; }
    __device__ bool next(int i, Unit& u) const {
        const long L = (long)i * G + c; if (L >= (long)nwg * nsub) return false;
        u.sub = (int)(L / nwg);
        int wgid = (int)(L % nwg); { const int q = nwg / NXCD, r = nwg % NXCD, xcd = wgid % NXCD, off = wgid / NXCD; wgid = (xcd < r ? xcd * (q + 1) : r * (q + 1) + (xcd - r) * q) + off; }
        const int nig = WGM * nN, gid = wgid / nig, fm = gid * WGM, gsz = (nM - fm) < WGM ? (nM - fm) : WGM;
        u.pm = fm + ((wgid % nig) % gsz); u.pn = (wgid % nig) / gsz; return true;
    }
};


template <int N> __device__ __forceinline__ float dpp_shr(float src, float ident) {
    return __int_as_float(__builtin_amdgcn_update_dpp(__float_as_int(ident), __float_as_int(src), 0x110 + N, 0xF, 0xF, false));
}
struct EpiSplit {
    static constexpr bool PERM = true, APERM = false;
    bf16_t* O0; bf16_t* O1; const float* sumsq; const float* shw;
    __device__ __forceinline__ void operator()(const f32x4 (&acc)[2][2][4][2], const Unit& u, int wr, int wc, int fr, int fq) const {
        const int row0 = u.pm * BM + wr * 64 + fr; int colt = u.pn * BM; bf16_t* base = O0;
        const int cfull = u.pn * BM + wc * 32 + 8 * fq;
        const bool gate_half = colt >= DM;
        if (gate_half) { base = O1; colt -= DM; }
        const int col0 = colt + wc * 32 + 8 * fq;
        f32x4 bv[2][2];
#pragma unroll
        for (int bj = 0; bj < 2; ++bj)
#pragma unroll
            for (int n = 0; n < 2; ++n) bv[bj][n] = sumsq ? *(const f32x4*)(shw + (size_t)(u.pm >> 3) * 2 * DM + cfull + bj * HALF + 4 * n) : (f32x4){0.f, 0.f, 0.f, 0.f};
        float ssq[2][4];
#pragma unroll
        for (int ai = 0; ai < 2; ++ai)
#pragma unroll
            for (int m = 0; m < 4; ++m) ssq[ai][m] = sumsq ? sumsq[row0 + ai * HALF + m * 16] : 0.f;
#pragma unroll
        for (int ai = 0; ai < 2; ++ai)
#pragma unroll
            for (int m = 0; m < 4; ++m) { const int row = row0 + ai * HALF + m * 16; bf16_t* rowp = base + (size_t)row * DM + col0;
                const float rs = sumsq ? __builtin_amdgcn_rsqf(ssq[ai][m] * (1.f / DM) + EPS) : 1.f;
#pragma unroll
                for (int bj = 0; bj < 2; ++bj) { f32x4 v0 = acc[ai][bj][m][0] * rs + bv[bj][0], v1 = acc[ai][bj][m][1] * rs + bv[bj][1];
                    if (gate_half) {
#pragma unroll
                        for (int j = 0; j < 4; ++j) { v0[j] = fsilu(v0[j]); v1[j] = fsilu(v1[j]); } }
                    u32x4 w; w.x = cvt_pk_bf16(v0[0], v0[1]); w.y = cvt_pk_bf16(v0[2], v0[3]); w.z = cvt_pk_bf16(v1[0], v1[1]); w.w = cvt_pk_bf16(v1[2], v1[3]);
                    *(u32x4*)(rowp + bj * HALF) = w; } }
    }
};

typedef _Float16 h16x8 __attribute__((ext_vector_type(8)));
__device__ __forceinline__ void ld8(const float* p, float (&v)[8]) { const f32x4 a = *(const f32x4*)p, b = *(const f32x4*)(p + 4); v[0] = a[0]; v[1] = a[1]; v[2] = a[2]; v[3] = a[3]; v[4] = b[0]; v[5] = b[1]; v[6] = b[2]; v[7] = b[3]; }
struct InOrder {
    int c, n, base;
    __device__ bool next(int i, Unit& u) const { if (i >= n) return false; const int j = c >> 3; int pm = (c & 7) * 8 + (j >> 2), pn = 4 * (i + base) + (j & 3), sub = 0;
        asm volatile("" : "+s"(pm), "+s"(pn), "+s"(sub)); u.pm = pm; u.pn = pn; u.sub = sub; return true; }
};
constexpr int CV_HL_OFF = 133120;
struct EpiSplitConv {
    static constexpr bool PERM = true, APERM = true;
    unsigned char* ws; const float* sumsq; const float* shw; const float* cw; const float* cb; unsigned target; LAS unsigned char* lds;
    __device__ __forceinline__ void operator()(f32x4 (&acc)[2][2][4][2], const Unit& u, int wr, int wc, int fr, int fq) const {
        const int pnl = u.pn & 3;
        const int cfull = u.pn * BM + wc * 32 + 8 * fq, ct = wc * 32 + 8 * fq, col0 = pnl * BM + ct;
        bf16_t* obase = (bf16_t*)(ws + WS_UPRE);
        f32x4 bv[2][2];
#pragma unroll
        for (int bj = 0; bj < 2; ++bj)
#pragma unroll
            for (int n = 0; n < 2; ++n) bv[bj][n] = sumsq ? *(const f32x4*)(shw + (size_t)(u.pm >> 3) * 2 * DM + cfull + bj * HALF + 4 * n) : (f32x4){0.f, 0.f, 0.f, 0.f};
        float ssq[2][4];
#pragma unroll
        for (int ai = 0; ai < 2; ++ai)
#pragma unroll
            for (int m = 0; m < 4; ++m) ssq[ai][m] = sumsq ? sumsq[u.pm * BM + ai * HALF + wr * 64 + 4 * fr + m] : 0.f;
#pragma unroll
        for (int ai = 0; ai < 2; ++ai)
#pragma unroll
            for (int m = 0; m < 4; ++m) { const float rs = sumsq ? __builtin_amdgcn_rsqf(ssq[ai][m] * (1.f / DM) + EPS) : 1.f;
#pragma unroll
                for (int bj = 0; bj < 2; ++bj) { acc[ai][bj][m][0] = acc[ai][bj][m][0] * rs + bv[bj][0]; acc[ai][bj][m][1] = acc[ai][bj][m][1] * rs + bv[bj][1]; } }
        const int tile = u.pm * 4 + pnl;
        unsigned long long* HX = (unsigned long long*)(ws + WS_BIN);
        unsigned* flags = (unsigned*)(ws + WS_CFLAG);
        LAS f32x4* HL = (LAS f32x4*)(lds + CV_HL_OFF);
#pragma unroll
        for (int ai = 0; ai < 2; ++ai)
#pragma unroll
            for (int k = 0; k < 3; ++k)
#pragma unroll
                for (int bj = 0; bj < 2; ++bj) {
                    if (fr == 15) { LAS f32x4* d = HL + (((ai * 2 + wr) * 3 + k) * 256 + bj * HALF + ct) / 4;
                        d[0] = acc[ai][bj][k + 1][0]; d[1] = acc[ai][bj][k + 1][1];
                        if (ai == 1 && wr == 1) { unsigned long long* g_ = HX + ((size_t)(tile * 3 + k) * 256 + bj * HALF + ct) / 2;
#pragma unroll
                            for (int n = 0; n < 2; ++n) { const f32x4 v = acc[1][bj][k + 1][n];
                                __hip_atomic_store(g_ + 2 * n, ((unsigned long long)__float_as_uint(v[1]) << 32) | __float_as_uint(v[0]), __ATOMIC_RELAXED, __HIP_MEMORY_SCOPE_AGENT);
                                __hip_atomic_store(g_ + 2 * n + 1, ((unsigned long long)__float_as_uint(v[3]) << 32) | __float_as_uint(v[2]), __ATOMIC_RELAXED, __HIP_MEMORY_SCOPE_AGENT); } } }
                    asm volatile("" ::: "memory"); __builtin_amdgcn_sched_barrier(0);
                }
        if (wr == 1) { asm volatile("s_waitcnt vmcnt(0)" ::: "memory");
            if (fr == 15 && fq == 0) __hip_atomic_fetch_add(flags + tile * 8, 1u, __ATOMIC_RELAXED, __HIP_MEMORY_SCOPE_AGENT); }
        asm volatile("s_waitcnt lgkmcnt(0)" ::: "memory"); __builtin_amdgcn_s_barrier(); asm volatile("" ::: "memory");
        const bool need_prev = (wr == 0) && ((u.pm & 7) != 0);
        if (need_prev) { unsigned spins = 0;
            while (__hip_atomic_load(flags + (tile - 4) * 8, __ATOMIC_RELAXED, __HIP_MEMORY_SCOPE_AGENT) < target) { __builtin_amdgcn_s_sleep(2); if (++spins > (1u << 22)) break; } }
#pragma unroll
        for (int ai = 0; ai < 2; ++ai)
#pragma unroll
            for (int bj = 0; bj < 2; ++bj)
#pragma unroll
                for (int n = 0; n < 2; ++n) {
                    f32x4 pr[3];
                    if (ai == 0 && wr == 0) {
#pragma unroll
                        for (int k = 0; k < 3; ++k) { unsigned long long wa = 0ull, wb = 0ull;
                            if (need_prev) { const unsigned long long* sp = HX + ((size_t)((tile - 4) * 3 + k) * 256 + bj * HALF + ct + 4 * n) / 2;
                                wa = __hip_atomic_load(sp, __ATOMIC_RELAXED, __HIP_MEMORY_SCOPE_AGENT); wb = __hip_atomic_load(sp + 1, __ATOMIC_RELAXED, __HIP_MEMORY_SCOPE_AGENT); }
                            pr[k] = (f32x4){__uint_as_float((unsigned)wa), __uint_as_float((unsigned)(wa >> 32)), __uint_as_float((unsigned)wb), __uint_as_float((unsigned)(wb >> 32))}; }
                    } else { const int prun = ai * 2 + wr - 1;
#pragma unroll
                        for (int k = 0; k < 3; ++k) pr[k] = HL[((prun * 3 + k) * 256 + bj * HALF + ct + 4 * n) / 4]; }
                    const int chg = pnl * BM + bj * HALF + ct + 4 * n;
                    const f32x4 w0 = *(const f32x4*)(cw + chg), w1 = *(const f32x4*)(cw + DM + chg), w2 = *(const f32x4*)(cw + 2 * DM + chg), w3 = *(const f32x4*)(cw + 3 * DM + chg), bb = *(const f32x4*)(cb + chg);
                    const f32x4 x0 = acc[ai][bj][0][n], x1 = acc[ai][bj][1][n], x2 = acc[ai][bj][2][n], x3 = acc[ai][bj][3][n];
                    f32x4 q1, q2, q3;
#pragma unroll
                    for (int j = 0; j < 4; ++j) { q1[j] = dpp_shr<1>(x3[j], pr[2][j]); q2[j] = dpp_shr<1>(x2[j], pr[1][j]); q3[j] = dpp_shr<1>(x1[j], pr[0][j]); }
                    const f32x4 y0 = bb + w0 * q3 + w1 * q2 + w2 * q1 + w3 * x0, y1 = bb + w0 * q2 + w1 * q1 + w2 * x0 + w3 * x1;
                    const f32x4 y2 = bb + w0 * q1 + w1 * x0 + w2 * x1 + w3 * x2, y3 = bb + w0 * x0 + w1 * x1 + w2 * x2 + w3 * x3;
                    bf16_t* op = obase + (size_t)(u.pm * BM + ai * HALF + wr * 64 + 4 * fr) * DM + col0 + bj * HALF + 4 * n;
                    { u32x2 w; w.x = cvt_pk_bf16(y0[0], y0[1]); w.y = cvt_pk_bf16(y0[2], y0[3]); *(u32x2*)(op) = w; }
                    { u32x2 w; w.x = cvt_pk_bf16(y1[0], y1[1]); w.y = cvt_pk_bf16(y1[2], y1[3]); *(u32x2*)(op + DM) = w; }
                    { u32x2 w; w.x = cvt_pk_bf16(y2[0], y2[1]); w.y = cvt_pk_bf16(y2[2], y2[3]); *(u32x2*)(op + 2 * DM) = w; }
                    { u32x2 w; w.x = cvt_pk_bf16(y3[0], y3[1]); w.y = cvt_pk_bf16(y3[2], y3[3]); *(u32x2*)(op + 3 * DM) = w; }
                    asm volatile("" ::: "memory"); __builtin_amdgcn_sched_barrier(0);
                }
    }
};

template <class TIn, bool HAS_A2>
struct EpiResH {
    static constexpr bool PERM = true, APERM = false;
    const TIn* xin; _Float16* xo; const float* gate; const float* modv; bf16_t* A1; const float* g1; int sc1; bf16_t* A2; const float* g2; int sc2; float* sumsq;
    __device__ __forceinline__ void operator()(const f32x4 (&acc)[2][2][4][2], const Unit& u, int wr, int wc, int fr, int fq) const {
        const int b = u.pm >> 3, col0 = u.pn * BM + wc * 32 + 8 * fq;
        float gv[2][8], gs1[2][8], gs2[HAS_A2 ? 2 : 1][8];
#pragma unroll
        for (int bj = 0; bj < 2; ++bj) { const int cc = col0 + bj * HALF;
            ld8(gate + (size_t)b * MODV_LD + cc, gv[bj]);
            { float gg[8], sc[8]; ld8(g1 + cc, gg); ld8(modv + (size_t)b * MODV_LD + sc1 + cc, sc);
#pragma unroll
              for (int j = 0; j < 8; ++j) gs1[bj][j] = gg[j] * (sc[j] + 1.f); }
            if constexpr (HAS_A2) { float gg[8], sc[8]; ld8(g2 + cc, gg); ld8(modv + (size_t)b * MODV_LD + sc2 + cc, sc);
#pragma unroll
              for (int j = 0; j < 8; ++j) gs2[bj][j] = gg[j] * (sc[j] + 1.f); } }
        constexpr int NG = (sizeof(TIn) == 4 || HAS_A2) ? 2 : 4;
#pragma unroll
        for (int ai = 0; ai < 2; ++ai) {
#pragma unroll
          for (int mh = 0; mh < 4; mh += NG) {
            float xv[sizeof(TIn) == 4 ? NG : 1][2][8]; h16x8 xh[sizeof(TIn) == 4 ? 1 : NG][2];
#pragma unroll
            for (int mm = 0; mm < NG; ++mm) { const size_t off = (size_t)(u.pm * BM + ai * HALF + wr * 64 + (mh + mm) * 16 + fr) * DM + col0;
#pragma unroll
                for (int bj = 0; bj < 2; ++bj) {
                    if constexpr (sizeof(TIn) == 4) ld8((const float*)xin + off + bj * HALF, xv[mm][bj]);
                    else xh[mm][bj] = *(const h16x8*)((const _Float16*)xin + off + bj * HALF); } }
            __builtin_amdgcn_sched_barrier(0);
#pragma unroll
            for (int mm = 0; mm < NG; ++mm) { const int m = mh + mm; const int row = u.pm * BM + ai * HALF + wr * 64 + m * 16 + fr; const size_t off = (size_t)row * DM + col0;
                float ss = 0.f;
#pragma unroll
                for (int bj = 0; bj < 2; ++bj) { float o[8]; h16x8 ho;
#pragma unroll
                    for (int j = 0; j < 8; ++j) { float xj; if constexpr (sizeof(TIn) == 4) xj = xv[mm][bj][j]; else xj = (float)xh[mm][bj][j];
                        o[j] = xj + gv[bj][j] * acc[ai][bj][m][j >> 2][j & 3]; ho[j] = (_Float16)o[j]; ss += o[j] * o[j]; }
                    *(h16x8*)(xo + off + bj * HALF) = ho;
                    if (A1) { u32x4 w; w.x = cvt_pk_bf16(o[0] * gs1[bj][0], o[1] * gs1[bj][1]); w.y = cvt_pk_bf16(o[2] * gs1[bj][2], o[3] * gs1[bj][3]);
                        w.z = cvt_pk_bf16(o[4] * gs1[bj][4], o[5] * gs1[bj][5]); w.w = cvt_pk_bf16(o[6] * gs1[bj][6], o[7] * gs1[bj][7]); *(u32x4*)(A1 + off + bj * HALF) = w; }
                    if constexpr (HAS_A2) { u32x4 w; w.x = cvt_pk_bf16(o[0] * gs2[bj][0], o[1] * gs2[bj][1]); w.y = cvt_pk_bf16(o[2] * gs2[bj][2], o[3] * gs2[bj][3]);
                        w.z = cvt_pk_bf16(o[4] * gs2[bj][4], o[5] * gs2[bj][5]); w.w = cvt_pk_bf16(o[6] * gs2[bj][6], o[7] * gs2[bj][7]); *(u32x4*)(A2 + off + bj * HALF) = w; } }
                if (sumsq) { ss += __shfl_xor(ss, 16); ss += __shfl_xor(ss, 32); if (fq == 0) atomicAdd(sumsq + row, ss); } }
            __builtin_amdgcn_sched_barrier(0);
          }
        }
    }
};

struct EpiFinal {
    static constexpr bool PERM = true, APERM = false;
    const _Float16* xin; float* out; const float* gate; const float* fg; float* sumsq; unsigned* cnt;
    __device__ __forceinline__ void operator()(f32x4 (&acc)[2][2][4][2], const Unit& u, int wr, int wc, int fr, int fq) const {
        const int b = u.pm >> 3, col0 = u.pn * BM + wc * 32 + 8 * fq;
        float gv[2][8];
#pragma unroll
        for (int bj = 0; bj < 2; ++bj) ld8(gate + (size_t)b * MODV_LD + col0 + bj * HALF, gv[bj]);
#pragma unroll
        for (int ai = 0; ai < 2; ++ai) {
            h16x8 xh[4][2];
#pragma unroll
            for (int m = 0; m < 4; ++m)
#pragma unroll
                for (int bj = 0; bj < 2; ++bj) xh[m][bj] = *(const h16x8*)(xin + (size_t)(u.pm * BM + ai * HALF + wr * 64 + m * 16 + fr) * DM + col0 + bj * HALF);
            __builtin_amdgcn_sched_barrier(0);
#pragma unroll
            for (int m = 0; m < 4; ++m) { const int row = u.pm * BM + ai * HALF + wr * 64 + m * 16 + fr;
                float ss = 0.f;
#pragma unroll
                for (int bj = 0; bj < 2; ++bj) { f32x4 o0, o1;
#pragma unroll
                    for (int j = 0; j < 4; ++j) { o0[j] = (float)xh[m][bj][j] + gv[bj][j] * acc[ai][bj][m][0][j]; o1[j] = (float)xh[m][bj][4 + j] + gv[bj][4 + j] * acc[ai][bj][m][1][j]; }
                    acc[ai][bj][m][0] = o0; acc[ai][bj][m][1] = o1;
                    ss += (o0[0] * o0[0] + o0[1] * o0[1]) + (o0[2] * o0[2] + o0[3] * o0[3]) + (o1[0] * o1[0] + o1[1] * o1[1]) + (o1[2] * o1[2] + o1[3] * o1[3]); }
                ss += __shfl_xor(ss, 16); ss += __shfl_xor(ss, 32); if (fq == 0) atomicAdd(sumsq + row, ss); }
            __builtin_amdgcn_sched_barrier(0);
        }
        asm volatile("s_waitcnt vmcnt(0)" ::: "memory");
        if (fr == 0 && fq == 0) __hip_atomic_fetch_add(cnt + u.pm * 8, 1u, __ATOMIC_RELAXED, __HIP_MEMORY_SCOPE_AGENT);
        { unsigned spins = 0;
          while (__hip_atomic_load(cnt + u.pm * 8, __ATOMIC_RELAXED, __HIP_MEMORY_SCOPE_AGENT) < 32u) { __builtin_amdgcn_s_sleep(2); if (++spins > (1u << 22)) break; } }
        float fgv[2][8];
#pragma unroll
        for (int bj = 0; bj < 2; ++bj) ld8(fg + col0 + bj * HALF, fgv[bj]);
        float ssq[2][4];
#pragma unroll
        for (int ai = 0; ai < 2; ++ai)
#pragma unroll
            for (int m = 0; m < 4; ++m) ssq[ai][m] = __hip_atomic_load(sumsq + u.pm * BM + ai * HALF + wr * 64 + m * 16 + fr, __ATOMIC_RELAXED, __HIP_MEMORY_SCOPE_AGENT);
#pragma unroll
        for (int ai = 0; ai < 2; ++ai)
#pragma unroll
            for (int m = 0; m < 4; ++m) { const size_t off = (size_t)(u.pm * BM + ai * HALF + wr * 64 + m * 16 + fr) * DM + col0;
                const float rs = __builtin_amdgcn_rsqf(ssq[ai][m] * (1.f / DM) + EPS);
#pragma unroll
                for (int bj = 0; bj < 2; ++bj) { f32x4 y0, y1;
#pragma unroll
                    for (int j = 0; j < 4; ++j) { y0[j] = acc[ai][bj][m][0][j] * rs * fgv[bj][j]; y1[j] = acc[ai][bj][m][1][j] * rs * fgv[bj][4 + j]; }
                    *(f32x4*)(out + off + bj * HALF) = y0; *(f32x4*)(out + off + bj * HALF + 4) = y1; } }
    }
};

__device__ __forceinline__ void scan16(float& a, float& b) {
    float ap, bp;
    ap = dpp_shr<1>(a, 1.f); bp = dpp_shr<1>(b, 0.f); b = fmaf(a, bp, b); a *= ap;
    ap = dpp_shr<2>(a, 1.f); bp = dpp_shr<2>(b, 0.f); b = fmaf(a, bp, b); a *= ap;
    ap = dpp_shr<4>(a, 1.f); bp = dpp_shr<4>(b, 0.f); b = fmaf(a, bp, b); a *= ap;
    ap = dpp_shr<8>(a, 1.f); bp = dpp_shr<8>(b, 0.f); b = fmaf(a, bp, b); a *= ap;
}
__device__ __forceinline__ void gate_elem2(f32x2 xr, f32x2 xg, f32x2 nba, f32x2 nbx, f32x2 psp2, f32x2 uv, f32x2& a, f32x2& b) {
    const f32x2 tr = xr * (-1.4426950408889634f) + nba, tg = xg * (-1.4426950408889634f) + nbx;
    f32x2 er, eg; er.x = __builtin_amdgcn_exp2f(tr.x); er.y = __builtin_amdgcn_exp2f(tr.y); eg.x = __builtin_amdgcn_exp2f(tg.x); eg.y = __builtin_amdgcn_exp2f(tg.y);
    const f32x2 dr = er + 1.f, dg = eg + 1.f, dd = dr * dg;
    f32x2 inv; inv.x = __builtin_amdgcn_rcpf(dd.x); inv.y = __builtin_amdgcn_rcpf(dd.y);
    const f32x2 r = inv * dg, gi = inv * dr;
    const f32x2 la2 = psp2 * r;
    a.x = __builtin_amdgcn_exp2f(-la2.x); a.y = __builtin_amdgcn_exp2f(-la2.y);
    const f32x2 om = 1.f - a * a;
    f32x2 sq; sq.x = __builtin_amdgcn_sqrtf(om.x); sq.y = __builtin_amdgcn_sqrtf(om.y);
    b = sq * gi * uv;
}
struct GateParams { f32x2 nba[4], nbx[4], psp2[4]; };
__device__ __forceinline__ void gate_params(GateParams& P, const float* ba, const float* bx, const float* lam, int ch0) {
#pragma unroll
    for (int p = 0; p < 4; ++p) {
        const f32x2 vb = *(const f32x2*)(ba + ch0 + 2 * p), vx = *(const f32x2*)(bx + ch0 + 2 * p), vl = *(const f32x2*)(lam + ch0 + 2 * p);
        P.nba[p] = vb * (-1.4426950408889634f); P.nbx[p] = vx * (-1.4426950408889634f);
        const float z0 = -vl.x, z1 = -vl.y;
        P.psp2[p].x = 8.f * 1.4426950408889634f * (z0 > 20.f ? z0 : flog(1.f + fexp(z0)));
        P.psp2[p].y = 8.f * 1.4426950408889634f * (z1 > 20.f ? z1 : flog(1.f + fexp(z1)));
    }
}
#define GATE_PAIR(p, accv, uw_, a2, b2) do { const int n_ = (p) >> 1, q_ = ((p) & 1) * 2; \
        const unsigned uword_ = ((p) == 0) ? uw_.x : ((p) == 1) ? uw_.y : ((p) == 2) ? uw_.z : uw_.w; \
        gate_elem2((f32x2){accv[ai][0][m][n_][q_], accv[ai][0][m][n_][q_ + 1]}, (f32x2){accv[ai][1][m][n_][q_], accv[ai][1][m][n_][q_ + 1]}, \
                   P.nba[p], P.nbx[p], P.psp2[p], (f32x2){bf_lo(uword_), bf_hi(uword_)}, a2, b2); } while (0)
struct GatesOrder {
    int c, n;
    __device__ bool next(int i, Unit& u) const { if (i >= n) return false; const int j = c >> 3; int pm = (c & 7) * 8 + 4 * i + (j & 3), pn = (j >> 2) & 1, sub = (j >> 3) & 3;
        asm volatile("" : "+s"(pm), "+s"(pn), "+s"(sub)); u.pm = pm; u.pn = pn; u.sub = sub; return true; }
};
constexpr int GS_RA_OFF = 133120;
struct EpiGatesS {
    static constexpr bool PERM = true, APERM = true;
    unsigned char* ws; unsigned target; const float* ba; const float* bx; const float* lam; LAS unsigned char* lds;
    __device__ __forceinline__ void operator()(f32x4 (&acc)[2][2][4][2], const Unit& u, int wr, int wc, int fr, int fq) const {
        const bf16_t* U = (const bf16_t*)(ws + WS_UPRE); const bf16_t* Gt = (const bf16_t*)(ws + WS_G); bf16_t* Y = (bf16_t*)(ws + WS_HN);
        unsigned long long* TA = (unsigned long long*)(ws + WS_TA); unsigned* flags = (unsigned*)(ws + WS_GFLAG);
        const int ct0 = wc * 32 + 8 * fq, ch0 = u.sub * 256 + u.pn * 128 + ct0;
        const int chain = ((u.pm >> 3) * 4 + u.sub) * 2 + u.pn, p = u.pm & 7, tix = chain * 8 + p;
        const int bsrc = (fq * 16 + 15) << 2;
        LAS f32x4* RA = (LAS f32x4*)(lds + GS_RA_OFF);
        {
            GateParams P; gate_params(P, ba, bx, lam, ch0);
#pragma unroll
            for (int ai = 0; ai < 2; ++ai) {
                u32x4 uall[4];
#pragma unroll
                for (int m = 0; m < 4; ++m) uall[m] = *(const u32x4*)(U + (size_t)(u.pm * BM + ai * HALF + wr * 64 + 4 * fr + m) * DM + ch0);
#pragma unroll
                for (int n = 0; n < 2; ++n) { f32x4 tA[4], tB[4]; f32x4 agg;
#pragma unroll
                    for (int hq = 0; hq < 2; ++hq) { const int pq = 2 * n + hq; f32x2 a2[4], b2[4];
#pragma unroll
                        for (int m = 0; m < 4; ++m) { const u32x4 uw = uall[m]; GATE_PAIR(pq, acc, uw, a2[m], b2[m]); }
#pragma unroll
                        for (int m = 1; m < 4; ++m) { b2[m] = a2[m] * b2[m - 1] + b2[m]; a2[m] = a2[m] * a2[m - 1]; }
                        float pax = a2[3].x, pbx = b2[3].x, pay = a2[3].y, pby = b2[3].y; scan16(pax, pbx); scan16(pay, pby);
                        if (hq == 0) { agg[0] = pax; agg[1] = pbx; agg[2] = pay; agg[3] = pby;
                            if (fr == 15) RA[((ai * 2 + wr) * 128 + ct0) / 2 + pq] = agg; }
                        else { if (fr == 15) RA[((ai * 2 + wr) * 128 + ct0) / 2 + pq] = (f32x4){pax, pbx, pay, pby}; }
                        const f32x2 EA = {dpp_shr<1>(pax, 1.f), dpp_shr<1>(pay, 1.f)}, EB = {dpp_shr<1>(pbx, 0.f), dpp_shr<1>(pby, 0.f)};
#pragma unroll
                        for (int m = 0; m < 4; ++m) { const f32x2 Ae = a2[m] * EA, Be = a2[m] * EB + b2[m];
                            tA[m][2 * hq] = Ae.x; tA[m][2 * hq + 1] = Ae.y; tB[m][2 * hq] = Be.x; tB[m][2 * hq + 1] = Be.y; }
                        __builtin_amdgcn_sched_barrier(0); }
#pragma unroll
                    for (int m = 0; m < 4; ++m) { acc[ai][0][m][n] = tA[m]; acc[ai][1][m][n] = tB[m]; }
                    asm volatile("" ::: "memory"); __builtin_amdgcn_sched_barrier(0); }
            }
        }
        asm volatile("s_waitcnt lgkmcnt(0)" ::: "memory"); __builtin_amdgcn_s_barrier(); asm volatile("" ::: "memory");
        if (wr == 0) {
            float At[8], Bt[8];
#pragma unroll
            for (int j = 0; j < 8; ++j) { At[j] = 1.f; Bt[j] = 0.f; }
#pragma unroll
            for (int ri = 0; ri < 4; ++ri)
#pragma unroll
                for (int q = 0; q < 4; ++q) { const f32x4 v = RA[(ri * 128 + ct0) / 2 + q];
                    Bt[2 * q] = fmaf(v[0], Bt[2 * q], v[1]); At[2 * q] *= v[0]; Bt[2 * q + 1] = fmaf(v[2], Bt[2 * q + 1], v[3]); At[2 * q + 1] *= v[2]; }
            if (fr == 15) {
#pragma unroll
                for (int j = 0; j < 8; ++j) __hip_atomic_store(TA + (size_t)tix * 128 + ct0 + j, ((unsigned long long)__float_as_uint(Bt[j]) << 32) | __float_as_uint(At[j]), __ATOMIC_RELAXED, __HIP_MEMORY_SCOPE_AGENT);
            }
            asm volatile("s_waitcnt vmcnt(0)" ::: "memory");
            if (fr == 15 && fq == 0) __hip_atomic_fetch_add(flags + tix * 8, 1u, __ATOMIC_RELAXED, __HIP_MEMORY_SCOPE_AGENT);
        }
        float h[8];
        {
            const bool on = fr < p;
            if (on) { unsigned spins = 0;
                while (__hip_atomic_load(flags + (chain * 8 + fr) * 8, __ATOMIC_RELAXED, __HIP_MEMORY_SCOPE_AGENT) < target) { __builtin_amdgcn_s_sleep(2); if (++spins > (1u << 22)) break; } }
            float Ac[8], Bc[8];
#pragma unroll
            for (int j = 0; j < 8; ++j) { unsigned long long w = 0x000000003f800000ull;
                if (on) w = __hip_atomic_load(TA + (size_t)(chain * 8 + fr) * 128 + ct0 + j, __ATOMIC_RELAXED, __HIP_MEMORY_SCOPE_AGENT);
                Ac[j] = __uint_as_float((unsigned)w); Bc[j] = __uint_as_float((unsigned)(w >> 32)); }
#pragma unroll
            for (int j = 0; j < 8; ++j) { float a = Ac[j], b = Bc[j]; scan16(a, b); h[j] = __int_as_float(__builtin_amdgcn_ds_bpermute(bsrc, __float_as_int(b))); }
        }
#pragma unroll
        for (int ai = 0; ai < 2; ++ai) {
            const int nskip = (ai == 0) ? wr : 1;
            const int rfirst = (ai == 0) ? 0 : (1 + wr);
            for (int k = 0; k < nskip; ++k)
#pragma unroll
                for (int q = 0; q < 4; ++q) { const f32x4 v = RA[((rfirst + k) * 128 + ct0) / 2 + q];
                    h[2 * q] = fmaf(v[0], h[2 * q], v[1]); h[2 * q + 1] = fmaf(v[2], h[2 * q + 1], v[3]); }
            u32x4 gall[4];
#pragma unroll
            for (int m = 0; m < 4; ++m) gall[m] = *(const u32x4*)(Gt + (size_t)(u.pm * BM + ai * HALF + wr * 64 + 4 * fr + m) * DM + ch0);
            float hl[8];
#pragma unroll
            for (int m = 0; m < 4; ++m) { const size_t off = (size_t)(u.pm * BM + ai * HALF + wr * 64 + 4 * fr + m) * DM + ch0;
                const u32x4 gw = gall[m];
                const float gv[8] = {bf_lo(gw.x), bf_hi(gw.x), bf_lo(gw.y), bf_hi(gw.y), bf_lo(gw.z), bf_hi(gw.z), bf_lo(gw.w), bf_hi(gw.w)};
                float yv[8];
#pragma unroll
                for (int j = 0; j < 8; ++j) { const float hv = fmaf(acc[ai][0][m][j >> 2][j & 3], h[j], acc[ai][1][m][j >> 2][j & 3]); yv[j] = hv * gv[j];
                    if (m == 3) hl[j] = hv; }
                u32x4 w; w.x = cvt_pk_bf16(yv[0], yv[1]); w.y = cvt_pk_bf16(yv[2], yv[3]); w.z = cvt_pk_bf16(yv[4], yv[5]); w.w = cvt_pk_bf16(yv[6], yv[7]);
                *(u32x4*)(Y + off) = w; }
#pragma unroll
            for (int j = 0; j < 8; ++j) h[j] = __int_as_float(__builtin_amdgcn_ds_bpermute(bsrc, __float_as_int(hl[j])));
            asm volatile("" ::: "memory"); __builtin_amdgcn_sched_barrier(0);
        }
    }
};

struct EpiQKV {
    static constexpr bool PERM = true, APERM = false;
    unsigned char* ws; float* kmean; const float* sumsq; const float* shw; int shw_sub;
    __device__ __forceinline__ void operator()(const f32x4 (&acc)[2][2][4][2], const Unit& u, int wr, int wc, int fr, int fq) const {
        const int b = u.pm >> 3, sblk = u.pm & 7, pq = u.pn & 3; const bool second = u.pn >= 4;
        const int dcol = wc * 32 + 8 * fq;
        const float* sw = shw + (size_t)u.sub * shw_sub + (size_t)b * 2 * DM + u.pn * BM + dcol;
        f32x4 bv[2][2];
#pragma unroll
        for (int bj = 0; bj < 2; ++bj)
#pragma unroll
            for (int n = 0; n < 2; ++n) bv[bj][n] = *(const f32x4*)(sw + bj * HALF + 4 * n);
        const bool plain = (u.sub == 0 && second), km = (u.sub == 1 && !second);
        const size_t boff = plain ? WS_G : (u.sub == 0) ? WS_UPRE : (second ? WS_BIN : WS_HN);
        const size_t rstride = plain ? DM : DH;
        bf16_t* bp[2];
#pragma unroll
        for (int bj = 0; bj < 2; ++bj)
            bp[bj] = (bf16_t*)(ws + boff) + (plain ? (size_t)(u.pm * BM) * DM + pq * 256 + bj * HALF + dcol : ((size_t)(b * NH + 2 * pq + bj) * SEQ + sblk * 256) * DH + dcol);
        f32x4 s0[2], s1[2];
#pragma unroll
        for (int bj = 0; bj < 2; ++bj) { s0[bj] = (f32x4){0.f, 0.f, 0.f, 0.f}; s1[bj] = (f32x4){0.f, 0.f, 0.f, 0.f}; }
        float ssq[2][4];
#pragma unroll
        for (int ai = 0; ai < 2; ++ai)
#pragma unroll
            for (int m = 0; m < 4; ++m) ssq[ai][m] = sumsq[u.pm * BM + ai * HALF + wr * 64 + m * 16 + fr];
#pragma unroll
        for (int ai = 0; ai < 2; ++ai)
#pragma unroll
            for (int m = 0; m < 4; ++m) { const int r = ai * HALF + wr * 64 + m * 16 + fr;
                const float rs = __builtin_amdgcn_rsqf(ssq[ai][m] * (1.f / DM) + EPS);
#pragma unroll
                for (int bj = 0; bj < 2; ++bj) { f32x4 v0 = acc[ai][bj][m][0] * rs + bv[bj][0], v1 = acc[ai][bj][m][1] * rs + bv[bj][1];
                    if (plain) {
#pragma unroll
                        for (int j = 0; j < 4; ++j) { v0[j] = fsilu(v0[j]); v1[j] = fsilu(v1[j]); } }
                    s0[bj] += v0; s1[bj] += v1;
                    u32x4 w; w.x = cvt_pk_bf16(v0[0], v0[1]); w.y = cvt_pk_bf16(v0[2], v0[3]); w.z = cvt_pk_bf16(v1[0], v1[1]); w.w = cvt_pk_bf16(v1[2], v1[3]);
                    *(u32x4*)(bp[bj] + (size_t)r * rstride) = w; }
                asm volatile("" ::: "memory"); }
        if (km) {
#pragma unroll
            for (int bj = 0; bj < 2; ++bj)
#pragma unroll
                for (int j = 0; j < 4; ++j) { float t0 = s0[bj][j], t1 = s1[bj][j];
                    t0 += __shfl_xor(t0, 1); t0 += __shfl_xor(t0, 2); t0 += __shfl_xor(t0, 4); t0 += __shfl_xor(t0, 8);
                    t1 += __shfl_xor(t1, 1); t1 += __shfl_xor(t1, 2); t1 += __shfl_xor(t1, 4); t1 += __shfl_xor(t1, 8);
                    if (fr == 0) { float* kp = kmean + ((size_t)(b * NH + 2 * pq + bj) * 8 + sblk) * DH + dcol + j;
                        atomicAdd(kp, t0 * (1.f / 256.f)); atomicAdd(kp + 4, t1 * (1.f / 256.f)); } }
        }
    }
};

template <class Epi, class Sched>
__device__ __forceinline__ void gemm_phase(LAS unsigned char* lds, const Gemm g, const Sched& S, const Epi& E, int wv) {
    const int tid = opq_tid(wv), wid = __builtin_amdgcn_readfirstlane(tid >> 6), lane = tid & 63, wr = wid >> 2, wc = wid & 3, fr = lane & 15, fq = lane >> 4;
    const int K = g.K, nt = K / BK;
    unsigned voffA[2], voffB[2];
#pragma unroll
    for (int i = 0; i < 2; ++i) { int R, C; stage_rc(tid * 16 + i * 8192, R, C); const int Rb = Epi::PERM ? ((R & ~31) + perm32(R & 31)) : R;
        const int Ra = Epi::APERM ? ((R & 64) + 4 * (R & 15) + ((R >> 4) & 3)) : R;
        voffA[i] = (unsigned)(Ra * g.lda + C) * 2u; voffB[i] = (unsigned)(Rb * g.ldb + C) * 2u; }
    const size_t kstep = (size_t)(BK * 2);
    const size_t hstepA = (size_t)HALF * g.lda * 2, hstepB = (size_t)HALF * g.ldb * 2;
    const size_t tstepA = 2 * hstepA, tstepB = 2 * hstepB;
    const unsigned ldsw = (unsigned)wid * 1024u;
    const int aoff = lds_byte(wr * 64 + fr, fq * 8), boff = lds_byte(wc * 32 + fr, fq * 8);
#define PG8_SA(b, h) (((b) * 2 + (h)) * HTB)
#define PG8_SB(b, h) ((4 + (b) * 2 + (h)) * HTB)
#define PG8_STAGE(bufoff, gbase, voff) do { _Pragma("unroll") for (int _i = 0; _i < 2; ++_i) \
        __builtin_amdgcn_global_load_lds((const unsigned*)((const char*)(gbase) + (voff)[_i]), (LAS unsigned*)(lds + (bufoff) + ldsw + _i * 8192), 16, 0, 0); } while (0)
#define PG8_LDA(dst, b, h) do { _Pragma("unroll") for (int m = 0; m < 4; ++m) _Pragma("unroll") for (int k = 0; k < 2; ++k) dst[m][k] = *(const LAS bf16x8*)(lds + PG8_SA(b, h) + aoff + m * 2048 + k * 1024); } while (0)
#define PG8_LDB(dst, b, h) do { _Pragma("unroll") for (int n = 0; n < 2; ++n) _Pragma("unroll") for (int k = 0; k < 2; ++k) dst[n][k] = *(const LAS bf16x8*)(lds + PG8_SB(b, h) + boff + n * 2048 + k * 1024); } while (0)
#define PG8_MMA(ai, bj, At, Bt) do { __builtin_amdgcn_s_setprio(1); _Pragma("unroll") for (int m = 0; m < 4; ++m) _Pragma("unroll") for (int n = 0; n < 2; ++n) _Pragma("unroll") for (int k = 0; k < 2; ++k) \
        acc[ai][bj][m][n] = __builtin_amdgcn_mfma_f32_16x16x32_bf16(Bt[n][k], At[m][k], acc[ai][bj][m][n], 0, 0, 0); __builtin_amdgcn_s_setprio(0); } while (0)
#define PG8_WAIT_V(n) asm volatile("s_waitcnt vmcnt(" #n ")" ::: "memory")
#define PG8_WAIT_L(n) asm volatile("s_waitcnt lgkmcnt(" #n ")" ::: "memory")
#define PG8_BAR __builtin_amdgcn_s_barrier()
#define PG8_SCHED __builtin_amdgcn_sched_barrier(0)
#define PG8_UA(u) ((const char*)g.A + (size_t)(u).sub * g.a_sub + (size_t)(u).pm * tstepA)
#define PG8_UB(u) ((const char*)g.Bt + (size_t)(u).sub * g.b_sub + (size_t)(u).pn * tstepB)
    Unit cur, nxt; int ui = 0;
    if (!S.next(0, cur)) return;
    f32x4 acc[2][2][4][2];
#pragma unroll
    for (int a = 0; a < 2; ++a)
#pragma unroll
        for (int b = 0; b < 2; ++b)
#pragma unroll
            for (int m = 0; m < 4; ++m)
#pragma unroll
                for (int n = 0; n < 2; ++n) acc[a][b][m][n] = (f32x4){0.f, 0.f, 0.f, 0.f};
    bf16x8 At[4][2], B0[2][2], B1[2][2];
    const char* cA = PG8_UA(cur); const char* cB = PG8_UB(cur);
    PG8_STAGE(PG8_SB(0, 0), cB, voffB); PG8_STAGE(PG8_SB(0, 1), cB + hstepB, voffB); PG8_STAGE(PG8_SA(0, 0), cA, voffA); PG8_STAGE(PG8_SA(0, 1), cA + hstepA, voffA);
    if (wr == 1) PG8_BAR;
    PG8_WAIT_V(2); PG8_BAR;
    PG8_STAGE(PG8_SB(1, 0), cB + kstep, voffB); PG8_STAGE(PG8_SA(1, 0), cA + kstep, voffA); PG8_STAGE(PG8_SB(1, 1), cB + hstepB + kstep, voffB);
    PG8_WAIT_V(6); PG8_BAR;
    for (;;) {
        const bool has_next = S.next(ui + 1, nxt);
        const char* nA = has_next ? PG8_UA(nxt) : cA; const char* nB = has_next ? PG8_UB(nxt) : cB;
        for (int t = 0; t < nt; t += 2) {
            const bool last = (t == nt - 2);
            const char* a1 = cA + (size_t)(t + 1) * kstep;
            const char* a2 = last ? nA : cA + (size_t)(t + 2) * kstep; const char* b2 = last ? nB : cB + (size_t)(t + 2) * kstep;
            const char* a3 = a2 + kstep; const char* b3 = b2 + kstep;
            PG8_LDB(B0, 0, 0); PG8_LDB(B1, 0, 1); PG8_SCHED; PG8_LDA(At, 0, 0); PG8_STAGE(PG8_SA(1, 1), a1 + hstepA, voffA);
            PG8_WAIT_V(8); PG8_WAIT_L(0); PG8_BAR; PG8_MMA(0, 0, At, B0); PG8_MMA(0, 1, At, B1); PG8_BAR; PG8_SCHED;
            PG8_LDA(At, 0, 1); PG8_STAGE(PG8_SB(0, 0), b2, voffB); PG8_STAGE(PG8_SB(0, 1), b2 + hstepB, voffB); PG8_STAGE(PG8_SA(0, 0), a2, voffA);
            PG8_WAIT_V(8); PG8_WAIT_L(0); PG8_BAR; PG8_MMA(1, 0, At, B0); PG8_MMA(1, 1, At, B1); PG8_BAR; PG8_SCHED;
            PG8_LDB(B0, 1, 0); PG8_LDB(B1, 1, 1); PG8_SCHED; PG8_LDA(At, 1, 0); PG8_STAGE(PG8_SA(0, 1), a2 + hstepA, voffA);
            PG8_WAIT_V(8); PG8_WAIT_L(0); PG8_BAR; PG8_MMA(0, 0, At, B0); PG8_MMA(0, 1, At, B1); PG8_BAR; PG8_SCHED;
            PG8_LDA(At, 1, 1); PG8_STAGE(PG8_SB(1, 0), b3, voffB); PG8_STAGE(PG8_SB(1, 1), b3 + hstepB, voffB); PG8_STAGE(PG8_SA(1, 0), a3, voffA);
            PG8_WAIT_V(8); PG8_WAIT_L(0); PG8_BAR; PG8_MMA(1, 0, At, B0); PG8_MMA(1, 1, At, B1); PG8_BAR; PG8_SCHED;
        }
        if (wr == 0) PG8_BAR;
        { const int t2 = opq_tid(wv), w2 = __builtin_amdgcn_readfirstlane(t2 >> 6), l2 = t2 & 63; E(acc, cur, w2 >> 2, w2 & 3, l2 & 15, l2 >> 4); }
        if (!has_next) break;
#pragma unroll
        for (int a = 0; a < 2; ++a)
#pragma unroll
            for (int b = 0; b < 2; ++b)
#pragma unroll
                for (int m = 0; m < 4; ++m)
#pragma unroll
                    for (int n = 0; n < 2; ++n) acc[a][b][m][n] = (f32x4){0.f, 0.f, 0.f, 0.f};
        cur = nxt; cA = nA; cB = nB; ++ui;
        if (wr == 1) PG8_BAR;
    }
    PG8_WAIT_V(0);
    PG8_BAR;
#undef PG8_SA
#undef PG8_SB
#undef PG8_STAGE
#undef PG8_LDA
#undef PG8_LDB
#undef PG8_MMA
#undef PG8_WAIT_V
#undef PG8_WAIT_L
#undef PG8_BAR
#undef PG8_SCHED
#undef PG8_UA
#undef PG8_UB
}
}

namespace att {
constexpr float SCALE = 0.08838834764831845f;
constexpr float THR = 8.f;
constexpr int NW = 8, QBLK = 32, KVBLK = 64, QB = NW * QBLK, D = 128;
constexpr int SHM_V = KVBLK * D * 2, SHM_K = KVBLK * D * 2;
constexpr int ATT_LDS = 2 * SHM_V + 2 * SHM_K + NW * 64 * 4;
#define KSWZ(row, colB) ((row) * 256 + ((colB) ^ (((row) & 7) << 4)))
#define SBAR() __builtin_amdgcn_sched_barrier(0)
__device__ __forceinline__ int v_st(int k, int c) { const int kk = (k & ~0xC) | ((k & 4) << 1) | ((k & 8) >> 1); return ((kk >> 3) * 4 + (c >> 5)) * 512 + ((kk & 7) * 32 + (c & 31)) * 2; }
__device__ __forceinline__ int v_rd_base(int lane) { return ((lane & 3) << 3) | (((lane >> 2) & 3) << 6) | (((lane >> 4) & 1) << 5) | (((lane >> 5) & 1) << 8); }
constexpr int v_rd_off(int d0, int ks, int half) { return d0 * 512 + ks * 4096 + half * 2048; }
__device__ __forceinline__ int crow(int r, int hi) { return (r & 3) + 8 * (r >> 2) + 4 * hi; }
__device__ __forceinline__ bf16x8 load8(const bf16_t* p) { return *reinterpret_cast<const bf16x8*>(p); }
__device__ __forceinline__ void mask_tile(f32x16& p0, f32x16& p1, int dq) {
    const float NEG = -__builtin_inff();
#pragma unroll
    for (int r = 0; r < 16; ++r) {
        const int c = (r & 3) + 8 * (r >> 2);
        if (dq - c < 0) p0[r] = NEG;
        if (dq - c - 32 < 0) p1[r] = NEG;
    }
}
__device__ __forceinline__ void mask_all(f32x16& p0, f32x16& p1, bool off) {
    const float NEG = -__builtin_inff();
#pragma unroll
    for (int r = 0; r < 16; ++r) { p0[r] = off ? NEG : p0[r]; p1[r] = off ? NEG : p1[r]; }
}
__device__ __forceinline__ void partialSM(f32x16& p0, f32x16& p1, float& m_reg, float& mn, float& alpha, float rbias = 0.f) {
    float pmax = p0[0];
#pragma unroll
    for (int r = 1; r < 16; ++r) pmax = fmaxf(pmax, p0[r]);
#pragma unroll
    for (int r = 0; r < 16; ++r) pmax = fmaxf(pmax, p1[r]);
    { auto rr = __builtin_amdgcn_permlane32_swap(__float_as_uint(pmax), __float_as_uint(pmax), false, false);
      pmax = fmaxf(__uint_as_float(rr[0]), __uint_as_float(rr[1])); }
    constexpr float C2 = 1.4426950408889634f * SCALE;
    if (__builtin_expect(__all((pmax - m_reg) * SCALE <= THR), 1)) { mn = m_reg; alpha = 1.f; }
    else { mn = fmaxf(m_reg, pmax); alpha = __builtin_amdgcn_exp2f((m_reg - mn) * C2); m_reg = mn; }
    const float mnL = -mn * C2 + rbias;
#pragma unroll
    for (int r = 0; r < 16; ++r) p0[r] = fmaf(p0[r], C2, mnL);
#pragma unroll
    for (int r = 0; r < 16; ++r) p1[r] = fmaf(p1[r], C2, mnL);
#pragma unroll
    for (int r = 0; r < 16; ++r) p0[r] = __builtin_amdgcn_exp2f(p0[r]);
}
__device__ __forceinline__ void finishSM(f32x16& p0, f32x16& p1, float alpha, float& l_reg, bf16x8& pa0, bf16x8& pa1, bf16x8& pa2, bf16x8& pa3) {
#pragma unroll
    for (int r = 0; r < 16; ++r) p1[r] = __builtin_amdgcn_exp2f(p1[r]);
    float ps = 0;
#pragma unroll
    for (int r = 0; r < 16; ++r) ps += p0[r];
#pragma unroll
    for (int r = 0; r < 16; ++r) ps += p1[r];
    { auto rr = __builtin_amdgcn_permlane32_swap(__float_as_uint(ps), __float_as_uint(ps), false, false);
      ps = __uint_as_float(rr[0]) + __uint_as_float(rr[1]); }
    l_reg = l_reg * alpha + ps;
#define PK4(P, B_, OUT) do { unsigned a0 = cvt_pk_bf16(P[B_+0], P[B_+1]), a1 = cvt_pk_bf16(P[B_+2], P[B_+3]);                          \
        unsigned b0 = cvt_pk_bf16(P[B_+4], P[B_+5]), b1 = cvt_pk_bf16(P[B_+6], P[B_+7]);                                             \
        auto r0 = __builtin_amdgcn_permlane32_swap(a0, b0, false, false); auto r1 = __builtin_amdgcn_permlane32_swap(a1, b1, false, false); \
        u32x4 w = {r0[0], r1[0], r0[1], r1[1]}; OUT = *reinterpret_cast<bf16x8*>(&w); } while (0)
    PK4(p0, 0, pa0); PK4(p0, 8, pa1); PK4(p1, 0, pa2); PK4(p1, 8, pa3);
#undef PK4
}
template <int KB>
__device__ __forceinline__ void qkt(f32x16& p0, f32x16& p1, const char* K_lds, int r32, int hi, const bf16x8* qr) {
    p0 = f32x16{}; p1 = f32x16{};
    const char* kb[4];
#pragma unroll
    for (int dd = 0; dd < 4; ++dd) kb[dd] = K_lds + KB * SHM_K + KSWZ(r32, (dd * 16 + hi * 8) * 2);
#pragma unroll
    for (int d0 = 0; d0 < 8; ++d0) { const char* a = kb[d0 & 3] + (d0 >> 2) * 128;
        bf16x8 b0 = *reinterpret_cast<const bf16x8*>(a);
        bf16x8 b1 = *reinterpret_cast<const bf16x8*>(a + 32 * 256);
        p0 = __builtin_amdgcn_mfma_f32_32x32x16_bf16(b0, qr[d0], p0, 0, 0, 0);
        p1 = __builtin_amdgcn_mfma_f32_32x32x16_bf16(b1, qr[d0], p1, 0, 0, 0); }
}
template <int VB>
__device__ __forceinline__ void pv_tile(f32x16* o, int vb0, bf16x8 pa0, bf16x8 pa1, bf16x8 pa2, bf16x8 pa3) {
#define TRRD(dst, off) asm volatile("ds_read_b64_tr_b16 %0, %1 offset:%2" : "=&v"(dst) : "v"(vb0), "i"(off) : "memory")
#define PV_D0(d0) do { s16x4 l0, l1, l2, l3, h0, h1, h2, h3; constexpr int b_ = VB * SHM_V + v_rd_off(d0, 0, 0); \
        TRRD(l0, b_); TRRD(h0, b_ + 2048); TRRD(l1, b_ + 4096); TRRD(h1, b_ + 6144); TRRD(l2, b_ + 8192); TRRD(h2, b_ + 10240); TRRD(l3, b_ + 12288); TRRD(h3, b_ + 14336); \
        asm volatile("s_waitcnt lgkmcnt(0)" ::: "memory"); SBAR();   \
        o[d0] = __builtin_amdgcn_mfma_f32_32x32x16_bf16(pa0, (bf16x8){l0[0], l0[1], l0[2], l0[3], h0[0], h0[1], h0[2], h0[3]}, o[d0], 0, 0, 0);   \
        o[d0] = __builtin_amdgcn_mfma_f32_32x32x16_bf16(pa1, (bf16x8){l1[0], l1[1], l1[2], l1[3], h1[0], h1[1], h1[2], h1[3]}, o[d0], 0, 0, 0);   \
        o[d0] = __builtin_amdgcn_mfma_f32_32x32x16_bf16(pa2, (bf16x8){l2[0], l2[1], l2[2], l2[3], h2[0], h2[1], h2[2], h2[3]}, o[d0], 0, 0, 0);   \
        o[d0] = __builtin_amdgcn_mfma_f32_32x32x16_bf16(pa3, (bf16x8){l3[0], l3[1], l3[2], l3[3], h3[0], h3[1], h3[2], h3[3]}, o[d0], 0, 0, 0); } while (0)
    PV_D0(0); PV_D0(1); PV_D0(2); PV_D0(3);
#undef PV_D0
#undef TRRD
}

struct BlockRef { const bf16_t* Q; const bf16_t* K; const bf16_t* V; bf16_t* O; const bf16_t* Gt; const float* KM; int P0; };
struct Seam { bf16x8 qr[8]; bf16x8 st_v0, st_v1, st_k0, st_k1; };
#define ROW(p, k0, rr) ((p) + (size_t)((k0) + (rr)) * D + sc)
#define VMW() asm volatile("s_waitcnt vmcnt(0)" ::: "memory")
#define VMWN(n) asm volatile("s_waitcnt vmcnt(%0)" :: "i"(n) : "memory")
#define SLOAD_H(Kp, Vp, k0) do { S.st_v0 = load8(ROW(Vp, k0, sr)); S.st_v1 = load8(ROW(Vp, k0, 32 + sr));              \
                         S.st_k0 = load8(ROW(Kp, k0, sr)); S.st_k1 = load8(ROW(Kp, k0, 32 + sr)); } while (0)
#define SWRITE_HK(bf) do { *(bf16x8*)(K_lds + (bf) * SHM_K + kws) = S.st_k0; *(bf16x8*)(K_lds + (bf) * SHM_K + kws + 32 * 256) = S.st_k1; } while (0)
#define SWRITE_HV(bf) do { *(bf16x8*)(V_lds + (bf) * SHM_V + vst0) = S.st_v0; *(bf16x8*)(V_lds + (bf) * SHM_V + vst1) = S.st_v1; } while (0)
#define SWRITE_H(bf) do { SWRITE_HV(bf); SWRITE_HK(bf); } while (0)
__device__ __forceinline__ void moba_prime(const BlockRef& cur, char* lds, Seam& S, int wv) {
    const int tid = opq_tid(wv), wid = __builtin_amdgcn_readfirstlane(tid >> 6), lane = tid & 63, r32 = lane & 31, hi = lane >> 5;
    const int sr = tid >> 4, sc = (tid & 15) * 8, kws = KSWZ(sr, sc * 2); char* K_lds = lds + 2 * SHM_V;
#pragma unroll
    for (int d0 = 0; d0 < 8; ++d0) S.qr[d0] = load8(cur.Q + (size_t)(wid * QBLK + r32) * D + d0 * 16 + hi * 8);
    SLOAD_H(cur.K, cur.V, 0); VMW(); SWRITE_HK(0);
    __syncthreads();
}
__device__ __forceinline__ unsigned moba_select(const Seam& S, const float* KM, int qb, int hi) {
    if (qb <= 3) return (1u << qb) - 1u;
    float sc_[8];
#pragma unroll
    for (int j = 0; j < 8; ++j) sc_[j] = 0.f;
#pragma unroll
    for (int j = 0; j < 7; ++j) {
        if (j < qb) {
            float s = 0.f;
#pragma unroll
            for (int d0 = 0; d0 < 8; ++d0) {
                const f32x4 k0 = *(const f32x4*)(KM + j * D + d0 * 16 + hi * 8), k1 = *(const f32x4*)(KM + j * D + d0 * 16 + hi * 8 + 4);
                const bf16x8 q = S.qr[d0];
                s += bf1((bf16_t)q[0]) * k0[0] + bf1((bf16_t)q[1]) * k0[1] + bf1((bf16_t)q[2]) * k0[2] + bf1((bf16_t)q[3]) * k0[3]
                   + bf1((bf16_t)q[4]) * k1[0] + bf1((bf16_t)q[5]) * k1[1] + bf1((bf16_t)q[6]) * k1[2] + bf1((bf16_t)q[7]) * k1[3];
            }
            s += __shfl_xor(s, 32);
            sc_[j] = s;
        }
    }
    unsigned sel = 0u;
#pragma unroll
    for (int it = 0; it < 3; ++it) {
        float best = -__builtin_inff(); int bi = 0;
#pragma unroll
        for (int j = 0; j < 7; ++j) { const bool ok = (j < qb) && !((sel >> j) & 1u) && (sc_[j] > best); best = ok ? sc_[j] : best; bi = ok ? j : bi; }
        sel |= 1u << bi;
    }
    return sel;
}
__device__ __forceinline__ void moba_block(const BlockRef& cur, const BlockRef& nxt, char* lds, Seam& S, int wv) {
    const int tid = opq_tid(wv), wid = __builtin_amdgcn_readfirstlane(tid >> 6), lane = tid & 63, r32 = lane & 31, hi = lane >> 5;
    const int NT = cur.P0 / KVBLK + 4;
    const int qb = cur.P0 >> 8;
    const int qlo = cur.P0 + wid * QBLK, qm = qlo + r32 - 4 * hi;
    char* V_lds = lds; char* K_lds = lds + 2 * SHM_V;
    float* ws = (float*)(lds + 2 * SHM_V + 2 * SHM_K) + wid * 64; float* li_l = ws, * al_l = ws + 32;
    float m_reg = -1e30f, l_reg = 0; f32x16 o[4] = {};
    const int sr = tid >> 4, sc = (tid & 15) * 8, vst0 = v_st(sr, sc), vst1 = v_st(32 + sr, sc), kws = KSWZ(sr, sc * 2);
    const int vb0 = (int)(uintptr_t)V_lds + v_rd_base(lane);
    const bf16_t* Kh = cur.K; const bf16_t* Vh = cur.V;
    const bool need_sel = qb > 3;
    const float* kml = (const float*)(lds + 69632);
    if (need_sel) { if (tid < 224) ((f32x4*)(lds + 69632))[tid] = ((const f32x4*)cur.KM)[tid]; __syncthreads(); }
    const unsigned sel = moba_select(S, kml, qb, hi);
#define RESC(a) do { if (__any((a) < 1.f)) { if (hi == 0) al_l[r32] = (a); asm volatile("s_waitcnt lgkmcnt(0)" ::: "memory");              \
                     for (int d_ = 0; d_ < 4; ++d_) for (int r = 0; r < 16; ++r) o[d_][r] *= al_l[crow(r, hi)]; } } while (0)
#define KBASE(t) ((t) * KVBLK)
#define MASKT(P0_, P1_, t) do { const int kb_ = KBASE(t); rb_ = 0.f; \
        if (kb_ < cur.P0) { if (need_sel) rb_ = (((sel >> (kb_ >> 8)) & 1u) == 0u) ? -__builtin_inff() : 0.f; } \
        else if (kb_ + KVBLK - 1 > qlo) mask_tile(P0_, P1_, qm - kb_); } while (0)
#define SEAM_K0() do { VMWN(8); SWRITE_HK(0); SBAR(); } while (0)
    f32x16 pA0, pA1, pB0, pB1; float mnA, mnB, alA, alB, rb_ = 0.f; bf16x8 pa0, pa1, pa2, pa3;
    SWRITE_HV(0); SBAR();
    SLOAD_H(Kh, Vh, KBASE(1));
    SBAR(); qkt<0>(pA0, pA1, K_lds, r32, hi, S.qr);
    MASKT(pA0, pA1, 0); partialSM(pA0, pA1, m_reg, mnA, alA, rb_);
    VMW(); SWRITE_H(1);
    __syncthreads();
#define HALF_STEP(PX0, PX1, mnX, alX, PY0, PY1, alY, t, KB, VB, SB) do {                                                      \
        SBAR(); qkt<KB>(PX0, PX1, K_lds, r32, hi, S.qr);                                                                       \
        finishSM(PY0, PY1, alY, l_reg, pa0, pa1, pa2, pa3); SBAR();                                                           \
        if ((t) + 1 < NT) { SLOAD_H(Kh, Vh, KBASE((t) + 1)); SBAR(); }                                                        \
        pv_tile<VB>(o, vb0, pa0, pa1, pa2, pa3); MASKT(PX0, PX1, (t)); partialSM(PX0, PX1, m_reg, mnX, alX, rb_);                  \
        __syncthreads();                                                                                                      \
        if ((t) + 1 < NT) { VMW(); SWRITE_H(SB); }                                                                            \
        RESC(alX); __syncthreads(); } while (0)
    for (int t = 1; t + 1 < NT; t += 2) {
        HALF_STEP(pB0, pB1, mnB, alB, pA0, pA1, alA, t, 1, 0, 0);
        HALF_STEP(pA0, pA1, mnA, alA, pB0, pB1, alB, t + 1, 0, 1, 1);
    }
    SBAR(); qkt<1>(pB0, pB1, K_lds, r32, hi, S.qr); SBAR();
    SLOAD_H(nxt.K, nxt.V, 0); SBAR();
#pragma unroll
    for (int d0 = 0; d0 < 8; ++d0) S.qr[d0] = load8(nxt.Q + (size_t)(wid * QBLK + r32) * D + d0 * 16 + hi * 8);
    SBAR();
    finishSM(pA0, pA1, alA, l_reg, pa0, pa1, pa2, pa3); SBAR();
    pv_tile<0>(o, vb0, pa0, pa1, pa2, pa3);
    MASKT(pB0, pB1, NT - 1); partialSM(pB0, pB1, m_reg, mnB, alB, rb_); __syncthreads(); RESC(alB);
    finishSM(pB0, pB1, alB, l_reg, pa0, pa1, pa2, pa3); SBAR(); pv_tile<1>(o, vb0, pa0, pa1, pa2, pa3);
    SBAR(); SEAM_K0();
    if (hi == 0) li_l[r32] = l_reg; asm volatile("s_waitcnt lgkmcnt(0)" ::: "memory");
    bf16_t* Ow = cur.O + (size_t)(wid * QBLK) * DM; const bf16_t* Gw = cur.Gt + (size_t)(wid * QBLK) * DM + r32;
    bf16_t gl[16][4];
#pragma unroll
    for (int r = 0; r < 16; ++r)
#pragma unroll
        for (int d0 = 0; d0 < 4; ++d0) gl[r][d0] = Gw[(size_t)crow(r, hi) * DM + d0 * 32];
#pragma unroll
    for (int r = 0; r < 16; ++r) { const int orow = crow(r, hi); const float rl = __builtin_amdgcn_rcpf(li_l[orow]);
#pragma unroll
        for (int d0 = 0; d0 < 4; ++d0) { const float gv = bf1(gl[r][d0]);
            const float v = o[d0][r] * rl * gv;
            const float vn = __shfl_xor(v, 1);
            if ((r32 & 1) == 0) *(unsigned*)(Ow + (size_t)orow * DM + d0 * 32 + r32) = cvt_pk_bf16(v, vn); } }
    __syncthreads();
#undef RESC
#undef KBASE
#undef MASKT
#undef SEAM_K0
#undef HALF_STEP
}
#undef ROW
#undef VMW
#undef VMWN
#undef SLOAD_H
#undef SWRITE_HK
#undef SWRITE_HV
#undef SWRITE_H

__device__ __forceinline__ BlockRef mk_ref(int L, int pass, const bf16_t* Q, const bf16_t* K, const bf16_t* V, bf16_t* O, const bf16_t* Gt, const float* KM) {
    const int bh = L >> 2, x = L & 3, qb = pass ? 7 - x : x, b = bh >> 3, h = bh & 7;
    BlockRef r;
    r.Q = Q + ((size_t)bh * SEQ + (size_t)qb * QB) * D; r.K = K + (size_t)bh * SEQ * D; r.V = V + (size_t)bh * SEQ * D;
    r.O = O + ((size_t)b * SEQ + (size_t)qb * QB) * DM + h * DH; r.Gt = Gt + ((size_t)b * SEQ + (size_t)qb * QB) * DM + h * DH;
    r.KM = KM + (size_t)bh * 8 * D; r.P0 = qb * QB;
    return r;
}
__device__ __forceinline__ void attn_phase(char* lds, const bf16_t* Q, const bf16_t* K, const bf16_t* V, bf16_t* O, const bf16_t* Gt, const float* KM, int wv) {
    const int total = NB * NH * 4, stride = gridDim.x;
    int L = opq_bid(); if (L >= total) return;
    if (stride == 256) { const int xcd = L & 7, j = L >> 3; L = ((xcd * 8 + (j >> 2)) << 2) | (j & 3); }
    int pass = 0;
    BlockRef cur = mk_ref(L, 0, Q, K, V, O, Gt, KM);
    Seam S;
    moba_prime(cur, lds, S, wv);
    for (;;) {
        const bool more_pass = pass == 0, more_item = L + stride < total, last = !more_pass && !more_item;
        int passn = pass + 1, Ln = L;
        if (!more_pass) { passn = 0; Ln = more_item ? L + stride : L; }
        const BlockRef nxt = last ? cur : mk_ref(Ln, passn, Q, K, V, O, Gt, KM);
        moba_block(cur, nxt, lds, S, wv);
        if (last) break;
        cur = nxt; pass = passn; L = Ln;
    }
}
}

#ifndef REP_MASK
#define REP_MASK 0
#endif
#ifndef BAR_REP
#define BAR_REP 1
#endif
struct Args { const float* in[21]; float* out; unsigned char* ws; int ph_lo, ph_hi; };
typedef const __attribute__((address_space(4))) Args* ArgsP;
#define AIN(i) ((const float*)ap->in[i])

__device__ __forceinline__ void transpose_item(const float* W, int ldw, bf16_t* WT, int ldt, LAS float* scr, int lane) {
    float tv[32];
#pragma unroll
    for (int i = 0; i < 32; ++i) { const int kk = 2 * i + (lane >> 5); tv[i] = __builtin_nontemporal_load(W + (size_t)kk * ldw + (lane & 31)); }
#pragma unroll
    for (int i = 0; i < 32; ++i) { const int kk = 2 * i + (lane >> 5); scr[kk * 33 + (lane & 31)] = tv[i]; }
    asm volatile("s_waitcnt lgkmcnt(0)" ::: "memory");
    const int c = lane & 7;
#pragma unroll
    for (int j = 0; j < 4; ++j) { const int n = (lane >> 3) + 8 * j; const LAS float* s = scr + (8 * c) * 33 + n;
        u32x4 o; o.x = cvt_pk_bf16(s[0 * 33], s[1 * 33]); o.y = cvt_pk_bf16(s[2 * 33], s[3 * 33]); o.z = cvt_pk_bf16(s[4 * 33], s[5 * 33]); o.w = cvt_pk_bf16(s[6 * 33], s[7 * 33]);
        *(u32x4*)(WT + (size_t)n * ldt + 8 * c) = o; }
    asm volatile("s_waitcnt lgkmcnt(0)" ::: "memory");
}
__device__ __forceinline__ void transpose_mat(const float* W, int K, int N, bf16_t* WT, int item, LAS float* scr, int lane) {
    const int nblk = N / 32, kb = item / nblk, nb = item % nblk;
    transpose_item(W + (size_t)(64 * kb) * N + 32 * nb, N, WT + (size_t)(32 * nb) * K + 64 * kb, K, scr, lane);
}

template <bool SILU>
__device__ __forceinline__ void gemv_item(const float* vec, int vld, const float* W, int ldw, int n0, int k0, float* out, int old, const float* bias, LAS float* scr, int lane) {
    const float* wp = W + (size_t)k0 * ldw + n0 + lane;
#pragma unroll
    for (int i = 0; i < 16; ++i) { const int idx = i * 64 + lane, b = idx >> 7, kk = idx & 127; const float v = vec[(size_t)b * vld + k0 + kk]; scr[kk * 8 + b] = SILU ? fsilu(v) : v; }
    asm volatile("s_waitcnt lgkmcnt(0)" ::: "memory");
    float acc[8];
#pragma unroll
    for (int b = 0; b < 8; ++b) acc[b] = 0.f;
#pragma unroll 1
    for (int kh = 0; kh < 128; kh += 32) {
        float w[32];
#pragma unroll
        for (int kk = 0; kk < 32; ++kk) w[kk] = __builtin_nontemporal_load(wp + (size_t)(kh + kk) * ldw);
#pragma unroll
        for (int kk = 0; kk < 32; ++kk) {
            const f32x4 c0 = *(const LAS f32x4*)(scr + (kh + kk) * 8), c1 = *(const LAS f32x4*)(scr + (kh + kk) * 8 + 4);
            acc[0] += w[kk] * c0[0]; acc[1] += w[kk] * c0[1]; acc[2] += w[kk] * c0[2]; acc[3] += w[kk] * c0[3];
            acc[4] += w[kk] * c1[0]; acc[5] += w[kk] * c1[1]; acc[6] += w[kk] * c1[2]; acc[7] += w[kk] * c1[3];
            if ((kk & 3) == 3) __builtin_amdgcn_sched_barrier(0); }
    }
    const float bv = bias ? bias[n0 + lane] : 0.f;
#pragma unroll
    for (int b = 0; b < 8; ++b) atomicAdd(out + (size_t)b * old + n0 + lane, acc[b] + bv);
    asm volatile("s_waitcnt lgkmcnt(0)" ::: "memory");
}
__device__ __forceinline__ void prep0_phase(ArgsP ap, LAS unsigned char* lds, int wave, int lane) {
    unsigned char* ws = (unsigned char*)ap->ws;
    LAS float* scr = (LAS float*)(lds + wave * 16384);
    const int gw = opq_bid() * NWAVES + wave, NGW = gridDim.x * NWAVES;
    for (int r = gw; r < (MODV_LD / 64) * 8; r += NGW) {
        const int cgp = r >> 3, kc = r & 7;
        const float* W; int ldw, n0; const float* bias;
        if (cgp < 192) { const int l = cgp / 48; n0 = (cgp % 48) * 64; W = AIN(2) + (size_t)l * DM * 3 * DM; ldw = 3 * DM; bias = AIN(3) + l * 3 * DM; }
        else { n0 = (cgp - 192) * 64; W = AIN(15); ldw = 2 * DM; bias = AIN(16); }
        gemv_item<true>(AIN(1), DM, W, ldw, n0, kc * 128, (float*)(ws + WS_MODV) + (cgp * 64 - n0), MODV_LD, kc == 0 ? bias : nullptr, scr, lane);
    }
}
__device__ __forceinline__ void prep1_phase(ArgsP ap, LAS unsigned char* lds, int wave, int lane) {
    unsigned char* ws = (unsigned char*)ap->ws;
    LAS float* scr = (LAS float*)(lds + wave * 16384);
    const int gw = opq_bid() * NWAVES + wave, NGW = gridDim.x * NWAVES;
    constexpr int I_BIG = (DM / 64) * (2 * DM / 32);
    constexpr int I_SQ = (DM / 64) * (DM / 32);
    constexpr int I_G = (256 / 64) * (256 / 32);
    constexpr int N_T = 2 * I_BIG + 2 * I_SQ + 2 * I_BIG + I_BIG + 2 * I_SQ + 16 * I_G;
    constexpr int N_GEMV = 4 * 32 * 8;
    for (int it = gw; it < N_T + N_GEMV; it += NGW) {
        int r = it;
        if (r < N_GEMV) {
            const int slot = r >> 8, q = r & 255, cgp = q >> 3, kc = q & 7;
            const size_t woff = slot == 0 ? (size_t)DM * 2 * DM : slot == 3 ? (size_t)DM * 2 * DM : 0;
            const float* W = (slot == 0 ? AIN(5) : slot == 2 ? AIN(17) : AIN(18)) + woff;
            const int shcol = slot == 0 ? 1 * 3 * DM : slot == 1 ? 2 * 3 * DM : slot == 2 ? 4 * 3 * DM : 3 * 3 * DM;
            gemv_item<false>((const float*)(ws + WS_MODV) + shcol, MODV_LD, W, 2 * DM, cgp * 64, kc * 128, (float*)(ws + WS_SHW) + (size_t)slot * 8 * 2 * DM, 2 * DM, nullptr, scr, lane);
            continue;
        } r -= N_GEMV;
        const float* W; bf16_t* WT; int ldw, ldt;
        if (r < 6 * I_BIG + 0 * I_SQ && r < 2 * I_BIG) { const int l = r / I_BIG, item = r % I_BIG, kb = item / 64, nb = item % 64;
            W = AIN(5) + (size_t)l * DM * 2 * DM + (size_t)(64 * kb) * 2 * DM + 32 * nb; ldw = 2 * DM; WT = (bf16_t*)(ws + WS_WIN) + (size_t)l * 2 * DM * DM + (size_t)(32 * nb) * DM + 64 * kb; ldt = DM; }
        else if ((r -= 2 * I_BIG) < 2 * I_SQ) { const int l = r / I_SQ, item = r % I_SQ, kb = item / 32, nb = item % 32;
            W = AIN(13) + (size_t)l * DM * DM + (size_t)(64 * kb) * DM + 32 * nb; ldw = DM; WT = (bf16_t*)(ws + WS_WOUT) + (size_t)l * DM * DM + (size_t)(32 * nb) * DM + 64 * kb; ldt = DM; }
        else if ((r -= 2 * I_SQ) < 2 * I_BIG) { const int l = r / I_BIG, item = r % I_BIG, kb = item / 64, nb = item % 64;
            W = AIN(18) + (size_t)l * DM * 2 * DM + (size_t)(64 * kb) * 2 * DM + 32 * nb; ldw = 2 * DM; WT = (bf16_t*)(ws + (l ? WS_ATTIN1 : WS_ATTIN0)) + (size_t)(32 * nb) * DM + 64 * kb; ldt = DM; }
        else if ((r -= 2 * I_BIG) < I_BIG) { const int kb = r / 64, nb = r % 64;
            W = AIN(17) + (size_t)(64 * kb) * 2 * DM + 32 * nb; ldw = 2 * DM; WT = (bf16_t*)(ws + WS_WKV) + (size_t)(32 * nb) * DM + 64 * kb; ldt = DM; }
        else if ((r -= I_BIG) < 2 * I_SQ) { const int l = r / I_SQ, item = r % I_SQ, kb = item / 32, nb = item % 32;
            W = AIN(19) + (size_t)l * DM * DM + (size_t)(64 * kb) * DM + 32 * nb; ldw = DM; WT = (bf16_t*)(ws + WS_ATTOUT) + (size_t)l * DM * DM + (size_t)(32 * nb) * DM + 64 * kb; ldt = DM; }
        else { r -= 2 * I_SQ;
            const int mat = r / I_G, item = r % I_G, which = mat >> 3, lh = mat & 7;
            const int kb = item / 8, nb = item % 8, n0 = 32 * nb, drow = 256 * (n0 >> 7) + 128 * which + (n0 & 127);
            W = (which ? AIN(10) : AIN(8)) + (size_t)lh * 256 * 256 + (size_t)(64 * kb) * 256 + n0; ldw = 256;
            WT = (bf16_t*)(ws + WS_WG) + (size_t)lh * 512 * 256 + (size_t)drow * 256 + 64 * kb; ldt = 256; }
        transpose_item(W, ldw, WT, ldt, scr, lane);
    }
}

__device__ __forceinline__ void norm_phase(const float* xin, bf16_t* o1, const float* g1, const float* modv, int sh1, int sc1c,
                                            bf16_t* o2, const float* g2, int sh2, int sc2c, int wave, int lane) {
    const int gw = opq_bid() * NWAVES + wave, NGW = gridDim.x * NWAVES;
    for (int rb = gw; rb < MTOK / 8; rb += NGW) {
        const int cb_ = rb >> 3, r0 = (NGW == 2048) ? ((cb_ & 7) * SEQ + (cb_ >> 3) * 64 + (rb & 7) * 8) : rb * 8, b = r0 / SEQ;
        const float* mv = modv + (size_t)b * MODV_LD;
        f32x4 gs1[4], sf1[4], gs2[4], sf2[4];
#pragma unroll
        for (int j = 0; j < 4; ++j) { const int idx = 4 * lane + 256 * j;
            const f32x4 gv = *(const f32x4*)(g1 + idx), sc = *(const f32x4*)(mv + sc1c + idx); gs1[j] = gv * (sc + 1.f); sf1[j] = *(const f32x4*)(mv + sh1 + idx);
            if (o2) { const f32x4 gv2 = *(const f32x4*)(g2 + idx), sc2 = *(const f32x4*)(mv + sc2c + idx); gs2[j] = gv2 * (sc2 + 1.f); sf2[j] = *(const f32x4*)(mv + sh2 + idx); }
            else { gs2[j] = gs1[j]; sf2[j] = sf1[j]; } }
        for (int rr = 0; rr < 8; ++rr) {
            const size_t row = (size_t)(r0 + rr);
            const f32x4* xr = (const f32x4*)(xin + row * DM) + lane;
            f32x4 v[4]; float s = 0.f;
#pragma unroll
            for (int j = 0; j < 4; ++j) { v[j] = xr[64 * j]; s += (v[j].x * v[j].x + v[j].y * v[j].y) + (v[j].z * v[j].z + v[j].w * v[j].w); }
            const float rstd = 1.f / sqrtf(wave_sum(s) * (1.f / DM) + EPS);
#pragma unroll
            for (int j = 0; j < 4; ++j) { const f32x4 t = v[j] * rstd; const f32x4 y = t * gs1[j] + sf1[j];
                u32x2 w; w.x = cvt_pk_bf16(y.x, y.y); w.y = cvt_pk_bf16(y.z, y.w);
                *((u32x2*)(o1 + row * DM) + lane + 64 * j) = w;
                if (o2) { const f32x4 y2 = t * gs2[j] + sf2[j]; u32x2 w2; w2.x = cvt_pk_bf16(y2.x, y2.y); w2.y = cvt_pk_bf16(y2.z, y2.w);
                    *((u32x2*)(o2 + row * DM) + lane + 64 * j) = w2; } }
        }
    }
}
__device__ __forceinline__ void conv_phase(const bf16_t* UP, bf16_t* U, const float* cw, const float* cb, int tid) {
    const int ch = 8 * (tid & 127), sub = tid >> 7;
    float w0[8], w1[8], w2[8], w3[8], bb[8];
#pragma unroll
    for (int h = 0; h < 2; ++h) { const f32x4 a = *(const f32x4*)(cw + ch + 4 * h), b = *(const f32x4*)(cw + DM + ch + 4 * h), c = *(const f32x4*)(cw + 2 * DM + ch + 4 * h), d = *(const f32x4*)(cw + 3 * DM + ch + 4 * h), e = *(const f32x4*)(cb + ch + 4 * h);
#pragma unroll
        for (int j = 0; j < 4; ++j) { w0[4 * h + j] = a[j]; w1[4 * h + j] = b[j]; w2[4 * h + j] = c[j]; w3[4 * h + j] = d[j]; bb[4 * h + j] = e[j]; } }
    for (int it = opq_bid(); it < NB * 32; it += gridDim.x) {
        const int b = it >> 5, c = it & 31, t0 = c * 64 + sub * 16; const size_t base = ((size_t)b * SEQ + t0) * DM + ch;
        u32x4 rw[19];
#pragma unroll
        for (int t = 0; t < 19; ++t) rw[t] = (t0 + t - 3 >= 0) ? *(const u32x4*)(UP + base + (ptrdiff_t)(t - 3) * DM) : (u32x4){0u, 0u, 0u, 0u};
#pragma unroll
        for (int t = 0; t < 16; ++t) {
            unsigned ow[4];
#pragma unroll
            for (int q = 0; q < 4; ++q) { const unsigned a0 = rw[t][q], a1 = rw[t + 1][q], a2 = rw[t + 2][q], a3 = rw[t + 3][q];
                const float lo = bb[2 * q] + w0[2 * q] * bf_lo(a0) + w1[2 * q] * bf_lo(a1) + w2[2 * q] * bf_lo(a2) + w3[2 * q] * bf_lo(a3);
                const float hi = bb[2 * q + 1] + w0[2 * q + 1] * bf_hi(a0) + w1[2 * q + 1] * bf_hi(a1) + w2[2 * q + 1] * bf_hi(a2) + w3[2 * q + 1] * bf_hi(a3);
                ow[q] = cvt_pk_bf16(lo, hi); }
            *(u32x4*)(U + base + (size_t)t * DM) = (u32x4){ow[0], ow[1], ow[2], ow[3]}; }
    }
}

#define XB_TMO      128
#define XB_XCNT(j)  (256  + 64 * (j))
#define XB_XSUB(j)  (1280 + 64 * (j))
#define XB_XGEN(j)  (2304 + 64 * (j))
#define XB_TOP      3328
#define XB_TOPGEN   3392
#define XCD_BAR_WORDS 3456
#define XB_SPIN_CAP (1u << 18)
constexpr size_t WS_BAR = 16384;
constexpr int LDS_MISC = 131072 + 320;
__device__ __forceinline__ unsigned xb_ld(unsigned* p)              { return __hip_atomic_load(p, __ATOMIC_RELAXED, __HIP_MEMORY_SCOPE_AGENT); }
__device__ __forceinline__ unsigned xb_add(unsigned* p, unsigned v) { return __hip_atomic_fetch_add(p, v, __ATOMIC_RELAXED, __HIP_MEMORY_SCOPE_AGENT); }
__device__ __forceinline__ unsigned xb_xcc_id() { return (unsigned)__builtin_amdgcn_s_getreg((3 << 11) | 20) & 0xFu; }
#define XB_SPIN(cond, bar) do { unsigned _sp = 0; while (cond) { __builtin_amdgcn_s_sleep(1); \
    if ((++_sp & 255u) == 0u) { if (xb_ld(&(bar)[XB_TMO])) break; if (_sp > XB_SPIN_CAP) { atomicAdd(&(bar)[XB_TMO], 1u); break; } } } } while (0)
__device__ __forceinline__ void xcd_barrier_complete(unsigned* bar, unsigned x, unsigned& nloc, unsigned& nx) {
    const unsigned G = gridDim.x * gridDim.y * gridDim.z;
    unsigned sum, cnt, mine, sp = 0u;
    for (;;) {
        sum = 0u; cnt = 0u; mine = 0u;
#pragma unroll
        for (unsigned j = 0; j < 16; ++j) { const unsigned c = xb_ld(&bar[XB_XCNT(j)]); sum += c; cnt += (c > 0u) ? 1u : 0u; mine = (j == x) ? c : mine; }
        if (sum == G) break;
        __builtin_amdgcn_s_sleep(1);
        if ((++sp & 255u) == 0u) { if (xb_ld(&bar[XB_TMO])) break; if (sp > XB_SPIN_CAP) { atomicAdd(&bar[XB_TMO], 1u); break; } }
    }
    nloc = mine > 0u ? mine : 1u; nx = cnt > 0u ? cnt : 1u;
}
__device__ __forceinline__ void xcd_barrier(unsigned* bar, volatile LAS unsigned* st, int tid) {
    asm volatile("s_waitcnt vmcnt(0)" ::: "memory");
    __syncthreads();
    if (tid == 0) {
        const unsigned x = xb_xcc_id();
        __builtin_amdgcn_s_waitcnt(0);
        unsigned nloc = st[0], nx = st[1];
        if (nloc == 0u) { xcd_barrier_complete(bar, x, nloc, nx); st[0] = nloc; st[1] = nx; }
        const unsigned old = xb_add(&bar[XB_XSUB(x)], 1u);
        const unsigned gen = old / nloc;
        if (old + 1u == (gen + 1u) * nloc) {
            __builtin_amdgcn_fence(__ATOMIC_RELEASE, "agent");
            asm volatile("s_waitcnt vmcnt(0)" ::: "memory");
            const unsigned og = xb_add(&bar[XB_TOP], 1u);
            const unsigned tg = og / nx;
            if (og + 1u == (tg + 1u) * nx) xb_add(&bar[XB_TOPGEN], 1u);
            else XB_SPIN(xb_ld(&bar[XB_TOPGEN]) == tg, bar);
            __builtin_amdgcn_fence(__ATOMIC_ACQUIRE, "agent");
            xb_add(&bar[XB_XGEN(x)], 1u);
            asm volatile("s_waitcnt vmcnt(0)" ::: "memory");
        } else {
            XB_SPIN(xb_ld(&bar[XB_XGEN(x)]) == gen, bar);
            __builtin_amdgcn_fence(__ATOMIC_ACQUIRE, "agent");
            asm volatile("s_waitcnt vmcnt(0)" ::: "memory");
        }
    }
    __syncthreads();
}

constexpr int NPHASE = 14;
#ifndef PH_EN
#define PH_EN 0xFFFF
#endif
#define EN(b) ((PH_EN >> (b)) & 1)
#ifndef REP_MASK
#define REP_MASK 0
#endif
#define REPS(b) for (int rep_ = 0; rep_ < EN(b) * (1 + ((REP_MASK >> (b)) & 1)); ++rep_)
template <int ph>
__device__ __forceinline__ void run_phase(unsigned char* lds, int wv) {
    LAS unsigned char* ldsl = (LAS unsigned char*)lds;
    {
        ArgsP ap = (ArgsP)__builtin_amdgcn_kernarg_segment_ptr();
        asm volatile("" : "+s"(ap));
        const int G = gridDim.x;
        unsigned char* ws = (unsigned char*)ap->ws;
        float* modv = (float*)(ws + WS_MODV);
        float* kmean = (float*)(ws + WS_KMEAN);
        bf16_t* HN = (bf16_t*)(ws + WS_HN); bf16_t* HKV = (bf16_t*)(ws + WS_HKV); bf16_t* UPRE = (bf16_t*)(ws + WS_UPRE); bf16_t* GB = (bf16_t*)(ws + WS_G);
        bf16_t* LAb = (bf16_t*)(ws + WS_LA); bf16_t* BINb = (bf16_t*)(ws + WS_BIN);
        float* xw = (float*)ap->out;
        const int tid = opq_tid(wv), c = opq_bid();
        const int lane = tid & 63, wave = __builtin_amdgcn_readfirstlane(tid >> 6);
        float* sumsq = (float*)(ws + WS_SUMSQ); const float* shw = (const float*)(ws + WS_SHW);
        if (ph == 0) {
            if (EN(0)) prep0_phase(ap, ldsl, wave, lane);
        } else if (ph == 1) {
            REPS(1) norm_phase(AIN(0), HN, AIN(4), modv, 0, DM, nullptr, nullptr, 0, 0, wave, lane);
            if (EN(0)) prep1_phase(ap, ldsl, wave, lane);
        } else if (ph <= 7) {
            const int l = (ph - 2) / 3, k3 = (ph - 2) % 3, k = k3 == 0 ? 0 : k3 + 1;
            const float* xin = (l == 0) ? AIN(0) : xw;
            if (k == 0) {
                pg8::Gemm g{l == 0 ? HN : HKV, (const bf16_t*)(ws + WS_WIN) + (size_t)l * 2 * DM * DM, DM, DM, DM, 0, 0};
                int one = 1; asm volatile("" : "+s"(one));
                { pg8::InOrder S{c, one, 0};
                  pg8::EpiSplitConv E{ws, l == 0 ? nullptr : sumsq, shw, AIN(6) + l * 4 * DM, AIN(7) + l * DM, 4u * (unsigned)(l + 1), ldsl};
                  REPS(2) pg8::gemm_phase(ldsl, g, S, E, wv); }
                { pg8::InOrder S{c, one, 1};
                  pg8::EpiSplit E{UPRE, GB, l == 0 ? nullptr : sumsq, shw};
                  REPS(2) pg8::gemm_phase(ldsl, g, S, E, wv); }
            } else if (k == 1) {
                REPS(3) conv_phase(UPRE, HKV, AIN(6) + l * 4 * DM, AIN(7) + l * DM, tid);
            } else if (k == 2) {
                pg8::Gemm g{UPRE, (const bf16_t*)(ws + WS_WG) + (size_t)l * 4 * 512 * 256, DM, 256, 256, 256 * 2, 512 * 256 * 2};
                int two = 2; asm volatile("" : "+s"(two));
                pg8::GatesOrder S{c, two};
                pg8::EpiGatesS E{ws, 4u * (unsigned)(l + 1), AIN(9) + l * DM, AIN(11) + l * DM, AIN(12) + l * DM, ldsl};
                REPS(4) pg8::gemm_phase(ldsl, g, S, E, wv);
            } else {
                pg8::Gemm g{HN, (const bf16_t*)(ws + WS_WOUT) + (size_t)l * DM * DM, DM, DM, DM, 0, 0};
                pg8::MultiOrder S; S.init(MTOK, DM, 1, G, c);
                _Float16* x16 = (_Float16*)(ws + WS_X16);
                if (l == 0) { pg8::EpiResH<float, false> E{AIN(0), x16, modv + 2 * DM, modv, HKV, AIN(4) + DM, 3 * DM + DM, nullptr, nullptr, 0, sumsq};
                    REPS(7) pg8::gemm_phase(ldsl, g, S, E, wv); }
                else { pg8::EpiResH<_Float16, true> E{x16, x16, modv + l * 3 * DM + 2 * DM, modv, HKV, AIN(4) + (l + 1) * DM, (l + 1) * 3 * DM + DM,
                              LAb, AIN(14), 4 * 3 * DM + DM, sumsq + (size_t)l * MTOK};
                    REPS(7) pg8::gemm_phase(ldsl, g, S, E, wv); }
            }
        } else if (ph <= 13) {
            const int i = (ph - 8) / 3, k = (ph - 8) % 3, l = 2 + i;
            if (k == 0) {
                pg8::Gemm g{i == 0 ? HKV : LAb, (const bf16_t*)(ws + (i == 0 ? WS_ATTIN0 : WS_ATTIN1)), DM, DM, DM, (long)(WS_LA - WS_HKV), (long)(WS_WKV - WS_ATTIN0)};
                pg8::MultiOrder S; S.init(MTOK, 2 * DM, i == 0 ? 2 : 1, G, c);
                pg8::EpiQKV E{ws, kmean, sumsq + (size_t)(1 + i) * MTOK, shw + (size_t)(i == 0 ? 1 : 3) * 8 * 2 * DM, 8 * 2 * DM};
                REPS(9) pg8::gemm_phase(ldsl, g, S, E, wv);
            } else if (k == 1) {
                REPS(10) att::attn_phase((char*)lds, UPRE, HN, BINb, HKV, GB, kmean, wv);
            } else if (i == 0) {
                pg8::Gemm g{HKV, (const bf16_t*)(ws + WS_ATTOUT), DM, DM, DM, 0, 0};
                pg8::MultiOrder S; S.init(MTOK, DM, 1, G, c);
                _Float16* x16 = (_Float16*)(ws + WS_X16);
                pg8::EpiResH<_Float16, false> E{x16, x16, modv + l * 3 * DM + 2 * DM, modv, LAb, AIN(4) + 3 * DM, 3 * 3 * DM + DM, nullptr, nullptr, 0, sumsq + (size_t)2 * MTOK};
                REPS(11) pg8::gemm_phase(ldsl, g, S, E, wv);
            } else {
                pg8::Gemm g{HKV, (const bf16_t*)(ws + WS_ATTOUT) + (size_t)DM * DM, DM, DM, DM, 0, 0};
                pg8::MultiOrder S; S.init(MTOK, DM, 1, G, c);
                pg8::EpiFinal E{(const _Float16*)(ws + WS_X16), xw, modv + l * 3 * DM + 2 * DM, AIN(20), sumsq + (size_t)3 * MTOK, (unsigned*)(ws + WS_PCNT)};
                REPS(12) pg8::gemm_phase(ldsl, g, S, E, wv);
            }
        }
    }
}
__global__ void __launch_bounds__(NTHR, 2) yoco_fwd(Args a_) {
    extern __shared__ __attribute__((aligned(16))) unsigned char lds[];
    const int ph_lo = a_.ph_lo, ph_hi = a_.ph_hi;
    const int wv = __builtin_amdgcn_readfirstlane((int)threadIdx.x >> 6);
    if (ph_hi - ph_lo > 1) {
        if (threadIdx.x < 8) ((volatile LAS unsigned*)((LAS unsigned char*)lds + LDS_MISC))[threadIdx.x] = 0u;
        if (threadIdx.x == 0) (void)xb_add(&((unsigned*)(a_.ws + WS_BAR))[XB_XCNT(xb_xcc_id())], 1u);
        __syncthreads();
    }
#define SEAM(P) do { ArgsP ap_ = (ArgsP)__builtin_amdgcn_kernarg_segment_ptr(); asm volatile("" : "+s"(ap_)); \
        xcd_barrier((unsigned*)((unsigned char*)ap_->ws + WS_BAR), (volatile LAS unsigned*)((LAS unsigned char*)lds + LDS_MISC), opq_tid(wv)); } while (0)
#ifndef TPROBE_MASK
#define TPROBE_MASK 0
#endif
#define TPROBE_MULT 10
#define TP_ON(P) ((TPROBE_MASK >> (P)) & 1)
#define TP_BEGIN(P) if (TP_ON(P) && blockIdx.x == 0 && opq_tid(wv) == 0) { volatile LAS unsigned long long* tw_ = (volatile LAS unsigned long long*)((LAS unsigned char*)lds + LDS_MISC + 16); tw_[1] = __builtin_amdgcn_s_memrealtime(); }
#define TP_END(P) if (TP_ON(P) && blockIdx.x == 0 && opq_tid(wv) == 0) { volatile LAS unsigned long long* tw_ = (volatile LAS unsigned long long*)((LAS unsigned char*)lds + LDS_MISC + 16); tw_[0] = tw_[0] + (__builtin_amdgcn_s_memrealtime() - tw_[1]); }
#define RUN(P) if ((P) >= ph_lo && (P) < ph_hi) { TP_BEGIN(P) run_phase<P>(lds, wv); if ((P) + 1 < ph_hi) { for (int br_ = 0; br_ < BAR_REP; ++br_) SEAM(P); } TP_END(P) }
    RUN(0) RUN(1) RUN(2) RUN(3) RUN(4) RUN(5) RUN(6) RUN(7) RUN(8) RUN(9) RUN(10) RUN(11)
    RUN(12) RUN(13)
#undef RUN
#undef SEAM
    if (TPROBE_MASK != 0 && blockIdx.x == 0 && opq_tid(wv) == 0) {
        volatile LAS unsigned long long* tw_ = (volatile LAS unsigned long long*)((LAS unsigned char*)lds + LDS_MISC + 16);
        const unsigned long long span = tw_[0] * TPROBE_MULT, t0 = __builtin_amdgcn_s_memrealtime();
        while (__builtin_amdgcn_s_memrealtime() - t0 < span) __builtin_amdgcn_s_sleep(8);
    }
}

extern "C" void kernel_launch(void* const* d_in, const int* in_sizes, int n_in, void* d_out, int out_size, void* d_ws, size_t ws_size, hipStream_t stream) {
    static int grid = 0;
    if (grid == 0) {
        if (n_in != 21 || out_size != MTOK * DM || ws_size < WS_END) { fprintf(stderr, "kernel_launch: unexpected shapes (n_in %d out %d ws %zu)\n", n_in, out_size, ws_size); grid = -1; return; }
        int dev = 0, cus = 0, per_cu = 0;
        (void)hipGetDevice(&dev);
        if (hipDeviceGetAttribute(&cus, hipDeviceAttributeMultiprocessorCount, dev) != hipSuccess || cus <= 0) cus = 256;
        if (hipFuncSetAttribute((const void*)yoco_fwd, hipFuncAttributeMaxDynamicSharedMemorySize, LDS_BYTES) != hipSuccess) { fprintf(stderr, "kernel_launch: hipFuncSetAttribute failed\n"); grid = -1; return; }
        if (hipOccupancyMaxActiveBlocksPerMultiprocessor(&per_cu, (const void*)yoco_fwd, NTHR, LDS_BYTES) != hipSuccess || per_cu < 1) { fprintf(stderr, "kernel_launch: occupancy query says %d\n", per_cu); per_cu = 1; }
        (void)hipGetLastError();
        grid = cus > 256 ? 256 : cus;
    }
    if (grid < 0) return;
    (void)hipMemsetAsync((char*)d_ws + WS_CTL, 0, CTL_ZERO_BYTES, stream);
    Args a{};
    for (int i = 0; i < 21; ++i) a.in[i] = (const float*)d_in[i];
    a.out = (float*)d_out; a.ws = (unsigned char*)d_ws;
#if MK_MULTI_LAUNCH
    for (int ph = 0; ph < NPHASE; ++ph) { a.ph_lo = ph; a.ph_hi = ph + 1; hipLaunchKernelGGL(yoco_fwd, dim3(grid), dim3(NTHR), LDS_BYTES, stream, a); }
#else
    a.ph_lo = 0; a.ph_hi = NPHASE;
    void* kargs[] = {&a};
    hipError_t e = hipLaunchCooperativeKernel((const void*)yoco_fwd, dim3(grid), dim3(NTHR), kargs, LDS_BYTES, stream);
    if (e != hipSuccess) fprintf(stderr, "kernel_launch: cooperative launch failed: %s (grid %d)\n", hipGetErrorString(e), grid);
#endif
}
```
